# Optimizing an MI355X kernel written in HIP

```python
import jax, jax.numpy as jnp
from jax import lax
import numpy as np

D_MODEL = 1024
BATCH = 4
SEQ = 8192
DEPTH = 4

GRID_W = 64
CTX_LEN = 256
N_MIXERS = 4
D_FF = -(-8 * D_MODEL // (3 * 256)) * 256
DEEPNORM_ALPHA = (2 * DEPTH) ** 0.25
DEEPNORM_BETA = (8 * DEPTH) ** -0.25
LN_EPS = 1e-5
RMS_EPS = 1e-6
ROPE_BASE = 10000.0
CHUNK = 64
NEG_INF = -1e30

RET_HEADS = 4
RET_DK = D_MODEL // RET_HEADS
RET_DV = 2 * RET_DK
NA_HEADS = 16
NA_DH = D_MODEL // NA_HEADS
NA_WIN_ROWS = 8
NA_WIN_COLS = 16
NA_QBLOCK_W = 16
NA_BAND_W = NA_QBLOCK_W + NA_WIN_COLS
MLA_HEADS = 16
MLA_NOPE = 64
MLA_ROPE = 32
MLA_V = 64
MLA_Q_LORA = 512
MLA_KV_LORA = 256
MLA_QBLOCK = 128
HG_EXPAND = 128
HG_HEADS = D_MODEL // HG_EXPAND
HG_DI = D_MODEL // HG_HEADS
HG_FDIM = HG_HEADS * HG_EXPAND

kernel_name = 'hybrid_interleaved_flow_backbone'


def layer_norm(x, g, b):
    xf = x.astype(jnp.float32)
    xc = xf - jnp.mean(xf, -1, keepdims=True)
    var = jnp.mean(xc * xc, -1, keepdims=True)
    return (xc * lax.rsqrt(var + LN_EPS) * g.astype(jnp.float32) + b.astype(jnp.float32)).astype(x.dtype)


def rms_norm(x, g=None):
    xf = x.astype(jnp.float32)
    y = xf * lax.rsqrt(jnp.mean(xf * xf, -1, keepdims=True) + RMS_EPS)
    if g is not None:
        y = y * g.astype(jnp.float32)
    return y.astype(x.dtype)


def modulate(h, shift, scale):
    return h * (1 + scale) + shift


def axial_rope(n_tokens, rot_dim):
    t = jnp.arange(n_tokens)
    rows = (t // GRID_W).astype(jnp.float32)
    cols = (t % GRID_W).astype(jnp.float32)
    n_freq = rot_dim // 4
    inv = ROPE_BASE ** (-jnp.arange(n_freq, dtype=jnp.float32) / n_freq)
    ang = jnp.concatenate([rows[:, None] * inv, cols[:, None] * inv], -1)
    return jnp.cos(ang)[:, None, :], jnp.sin(ang)[:, None, :]


def apply_rope(x, cos, sin):
    x1, x2 = jnp.split(x.astype(jnp.float32), 2, axis=-1)
    return jnp.concatenate([x1 * cos - x2 * sin, x1 * sin + x2 * cos], -1).astype(x.dtype)


def chunk_gla(q, k, v, log_f, s0):
    B, H, L, dk = q.shape
    dv = v.shape[-1]
    n = L // CHUNK

    def to_chunks(a):
        return a.astype(jnp.float32).reshape(B, H, n, CHUNK, a.shape[-1]).transpose(2, 0, 1, 3, 4)

    mask = jnp.tril(jnp.ones((CHUNK, CHUNK), bool))

    def step(S, inp):
        qi, ki, vi, gi = inp
        b = jnp.cumsum(gi, axis=-2)
        b_last = b[..., -1:, :]
        q_d = qi * jnp.exp(b)
        att = jnp.where(mask, jnp.einsum('bhtk,bhsk->bhts', q_d, ki * jnp.exp(-b)), 0.0)
        o = jnp.einsum('bhts,bhsv->bhtv', att, vi) + jnp.einsum('bhtk,bhkv->bhtv', q_d, S)
        S_new = jnp.exp(b_last[..., 0, :])[..., None] * S + jnp.einsum('bhsk,bhsv->bhkv', ki * jnp.exp(b_last - b), vi)
        return S_new, o

    S_fin, oc = lax.scan(step, s0, (to_chunks(q), to_chunks(k), to_chunks(v), to_chunks(log_f)))
    return oc.transpose(1, 2, 0, 3, 4).reshape(B, H, L, dv), S_fin


def bidirectional_scan(ctx_terms, lat_terms):
    qc, kcf, kcb, vc, gcf, gcb = ctx_terms
    ql, klf, klb, vl, glf, glb = lat_terms
    B, H, _, dk = qc.shape
    s0 = jnp.zeros((B, H, dk, vc.shape[-1]), jnp.float32)
    flip = lambda t: jnp.flip(t, axis=2)
    o_cf, s_cf = chunk_gla(qc, kcf, vc, gcf, s0)
    o_cb, s_cb = chunk_gla(flip(qc), flip(kcb), flip(vc), flip(gcb), s0)
    o_lf, _ = chunk_gla(ql, klf, vl, glf, s_cf)
    o_lb, _ = chunk_gla(flip(ql), flip(klb), flip(vl), flip(glb), s_cb)
    return o_cf + flip(o_cb), o_lf + flip(o_lb)


def retention_mixer(a_ctx, a_lat, w_in, decay_param, w_out, want_ctx):
    B, L, _ = a_lat.shape
    hk, hv = RET_HEADS * RET_DK, RET_HEADS * RET_DV
    log_gamma = -jnp.exp(decay_param.astype(jnp.float32))

    def project(a, rope):
        n = a.shape[1]
        q, k, v, g = jnp.split(a @ w_in, [hk, 2 * hk, 2 * hk + hv], axis=-1)
        q = q.reshape(B, n, RET_HEADS, RET_DK)
        k = k.reshape(B, n, RET_HEADS, RET_DK)
        if rope is not None:
            q, k = apply_rope(q, *rope), apply_rope(k, *rope)
        k = k * RET_DK ** -0.5
        v = v.reshape(B, n, RET_HEADS, RET_DV)
        decay = lambda lg: jnp.broadcast_to(lg[None, :, None, None], (B, RET_HEADS, n, RET_DK))
        qh, kh, vh = (t.transpose(0, 2, 1, 3) for t in (q, k, v))
        return (qh, kh, kh, vh, decay(log_gamma[0]), decay(log_gamma[1])), g

    ctx_terms, g_ctx = project(a_ctx, None)
    lat_terms, g_lat = project(a_lat, axial_rope(L, RET_DK))
    o_ctx, o_lat = bidirectional_scan(ctx_terms, lat_terms)

    def readout(o, g):
        n = o.shape[2]
        y = rms_norm(o).transpose(0, 2, 1, 3).reshape(B, n, hv).astype(g.dtype)
        return (jax.nn.silu(g) * y) @ w_out

    return (readout(o_ctx, g_ctx) if want_ctx else None), readout(o_lat, g_lat)


def neighbourhood_mixer(a_ctx, a_lat, w_qkv, rpb, w_out, want_ctx):
    B, L, _ = a_lat.shape
    Lc = a_ctx.shape[1]
    rows = L // GRID_W
    wr = min(NA_WIN_ROWS, rows)
    scale = NA_DH ** -0.5
    q, k, v = jnp.split(a_lat @ w_qkv, 3, axis=-1)
    grid = lambda t: t.reshape(B, rows, GRID_W, NA_HEADS, NA_DH)
    q, k, v = grid(q * scale), grid(k), grid(v)
    qc, kc, vc = (t.reshape(B, Lc, NA_HEADS, NA_DH) for t in jnp.split(a_ctx @ w_qkv, 3, axis=-1))

    n_cb = GRID_W // NA_QBLOCK_W
    band0 = np.clip(np.arange(n_cb) * NA_QBLOCK_W - NA_WIN_COLS // 2, 0, GRID_W - NA_BAND_W)
    kcol = band0[:, None] + np.arange(NA_BAND_W)
    qcol = np.arange(GRID_W).reshape(n_cb, NA_QBLOCK_W)
    wstart = np.clip(qcol - NA_WIN_COLS // 2, 0, GRID_W - NA_WIN_COLS)
    kc3 = kcol[:, None, :]
    col_ok = (kc3 >= wstart[..., None]) & (kc3 < wstart[..., None] + NA_WIN_COLS)
    c_idx = np.clip(kc3 - qcol[..., None] + NA_WIN_COLS - 1, 0, 2 * NA_WIN_COLS - 2)

    def row(r):
        rs = jnp.clip(r - wr // 2, 0, rows - wr)
        qr = lax.dynamic_index_in_dim(q, r, axis=1, keepdims=False).reshape(B, n_cb, NA_QBLOCK_W, NA_HEADS, NA_DH)
        kb = lax.dynamic_slice_in_dim(k, rs, wr, axis=1)[:, :, kcol]
        vb = lax.dynamic_slice_in_dim(v, rs, wr, axis=1)[:, :, kcol]
        r_idx = rs + jnp.arange(wr) - r + NA_WIN_ROWS - 1
        bias = rpb[:, r_idx[None, None, :, None], c_idx[:, :, None, :]]
        s_lat = jnp.einsum('bnqhd,brnkhd->bhnqrk', qr, kb).astype(jnp.float32) + bias[None].astype(jnp.float32)
        s_lat = jnp.where(col_ok[:, :, None, :], s_lat, NEG_INF).reshape(B, NA_HEADS, n_cb, NA_QBLOCK_W, wr * NA_BAND_W)
        s_ctx = jnp.einsum('bnqhd,bchd->bhnqc', qr, kc).astype(jnp.float32)
        p = jax.nn.softmax(jnp.concatenate([s_lat, s_ctx], -1), -1).astype(v.dtype)
        p_lat = p[..., :wr * NA_BAND_W].reshape(B, NA_HEADS, n_cb, NA_QBLOCK_W, wr, NA_BAND_W)
        o = jnp.einsum('bhnqrk,brnkhd->bnqhd', p_lat, vb) + jnp.einsum('bhnqc,bchd->bnqhd', p[..., wr * NA_BAND_W:], vc)
        return o.reshape(B, GRID_W, NA_HEADS * NA_DH)

    o_lat = lax.map(row, jnp.arange(rows)).transpose(1, 0, 2, 3).reshape(B, L, NA_HEADS * NA_DH)
    y_ctx = None
    if want_ctx:
        s = jnp.einsum('bqhd,bkhd->bhqk', qc * scale, kc).astype(jnp.float32)
        p = jax.nn.softmax(s, -1).astype(vc.dtype)
        y_ctx = jnp.einsum('bhqk,bkhd->bqhd', p, vc).reshape(B, Lc, NA_HEADS * NA_DH) @ w_out
    return y_ctx, o_lat @ w_out


def mla_mixer(a_ctx, a_lat, w_down, q_norm, kv_norm, w_uq, w_ukv, w_out, want_ctx):
    B, L, _ = a_lat.shape
    scale = (MLA_NOPE + MLA_ROPE) ** -0.5

    def project(a, rope):
        n = a.shape[1]
        cq, ckv, kr = jnp.split(a @ w_down, [MLA_Q_LORA, MLA_Q_LORA + MLA_KV_LORA], axis=-1)
        q = (rms_norm(cq, q_norm) @ w_uq).reshape(B, n, MLA_HEADS, MLA_NOPE + MLA_ROPE)
        kv = (rms_norm(ckv, kv_norm) @ w_ukv).reshape(B, n, MLA_HEADS, MLA_NOPE + MLA_V)
        q_nope, q_rope = jnp.split(q, [MLA_NOPE], axis=-1)
        k_nope, v = jnp.split(kv, [MLA_NOPE], axis=-1)
        kr = kr[:, :, None, :]
        if rope is not None:
            q_rope, kr = apply_rope(q_rope, *rope), apply_rope(kr, *rope)
        q = jnp.concatenate([q_nope, q_rope], -1) * scale
        k = jnp.concatenate([k_nope, jnp.broadcast_to(kr, (B, n, MLA_HEADS, MLA_ROPE))], -1)
        return q, k, v

    qc, kc, vc = project(a_ctx, None)
    ql, kl, vl = project(a_lat, axial_rope(L, MLA_ROPE))
    k_all = jnp.concatenate([kc, kl], axis=1)
    v_all = jnp.concatenate([vc, vl], axis=1)

    def attend(qb, keys, vals):
        s = jnp.einsum('bqhd,bkhd->bhqk', qb, keys).astype(jnp.float32)
        p = jax.nn.softmax(s, -1).astype(vals.dtype)
        return jnp.einsum('bhqk,bkhd->bqhd', p, vals)

    nb = L // MLA_QBLOCK
    qblocks = ql.reshape(B, nb, MLA_QBLOCK, MLA_HEADS, MLA_NOPE + MLA_ROPE).transpose(1, 0, 2, 3, 4)
    o = lax.map(lambda qb: attend(qb, k_all, v_all), qblocks)
    o_lat = o.transpose(1, 0, 2, 3, 4).reshape(B, L, MLA_HEADS * MLA_V)
    y_ctx = attend(qc, kc, vc).reshape(B, -1, MLA_HEADS * MLA_V) @ w_out if want_ctx else None
    return y_ctx, o_lat @ w_out


def hgrn2_mixer(a_ctx, a_lat, w_in, lower_bounds, norm_g, w_out, layer_idx, want_ctx):
    B = a_lat.shape[0]
    lb_soft = jax.nn.softmax(lower_bounds.astype(jnp.float32), axis=0)
    lb = (jnp.cumsum(lb_soft, axis=0) - lb_soft[0])[layer_idx]

    def project(a):
        n = a.shape[1]
        q, f_f, f_b, i, g = jnp.split(a @ w_in, [HG_FDIM, 2 * HG_FDIM, 3 * HG_FDIM, 3 * HG_FDIM + HG_HEADS * HG_DI], axis=-1)
        heads = lambda t, d: t.reshape(B, n, HG_HEADS, d).transpose(0, 2, 1, 3)
        q = heads(jax.nn.silu(q), HG_EXPAND) * HG_EXPAND ** -0.5

        def gate(f):
            forget = lb + (1 - lb) * jax.nn.sigmoid(f.astype(jnp.float32))
            return heads(1 - forget, HG_EXPAND), heads(jnp.log(forget), HG_EXPAND)

        kf, gf = gate(f_f)
        kb, gb = gate(f_b)
        return (q, kf, kb, heads(i, HG_DI), gf, gb), g

    ctx_terms, g_ctx = project(a_ctx)
    lat_terms, g_lat = project(a_lat)
    o_ctx, o_lat = bidirectional_scan(ctx_terms, lat_terms)

    def readout(o, g):
        n = o.shape[2]
        y = rms_norm(o, norm_g).transpose(0, 2, 1, 3).reshape(B, n, HG_HEADS * HG_DI).astype(g.dtype)
        return (y * jax.nn.silu(g)) @ w_out

    return (readout(o_ctx, g_ctx) if want_ctx else None), readout(o_lat, g_lat)


def swiglu(a, w13, w2):
    gate, up = jnp.split(a @ w13, 2, axis=-1)
    return (jax.nn.silu(gate) * up) @ w2


def setup_inputs(seed: int = 0) -> dict:
    key = jax.random.key(seed)
    ks = iter(jax.random.split(key, 32))
    nrm = lambda shape, std: std * jax.random.normal(next(ks), shape, jnp.float32)
    D, F, beta = D_MODEL, D_FF, DEEPNORM_BETA
    ret_decay_base = jnp.log(-jnp.log1p(-(2.0 ** (-5.0 - jnp.arange(RET_HEADS, dtype=jnp.float32)))))
    return {
        'x': nrm((BATCH, SEQ, D), 1.0),
        'c': nrm((BATCH, D), 1.0),
        'ctx': nrm((BATCH, CTX_LEN, D), 1.0),
        'c_ctx': nrm((D,), 1.0),
        'ada_w': nrm((DEPTH, D, 6 * D), D ** -0.5),
        'ada_b': nrm((DEPTH, 6 * D), 0.01),
        'ln_g': 1.0 + nrm((DEPTH, 2, D), 0.01),
        'ln_b': nrm((DEPTH, 2, D), 0.01),
        'ffn_w13': nrm((DEPTH, D, 2 * F), D ** -0.5),
        'ffn_w2': nrm((DEPTH, F, D), beta * F ** -0.5),
        'ret_w_in': nrm((D, 2 * RET_HEADS * RET_DK + 2 * RET_HEADS * RET_DV), D ** -0.5),
        'ret_decay': ret_decay_base[None, :] + nrm((2, RET_HEADS), 0.01),
        'ret_w_out': nrm((RET_HEADS * RET_DV, D), beta * (RET_HEADS * RET_DV) ** -0.5),
        'na_w_qkv': nrm((D, 3 * NA_HEADS * NA_DH), D ** -0.5),
        'na_rpb': nrm((NA_HEADS, 2 * NA_WIN_ROWS - 1, 2 * NA_WIN_COLS - 1), 0.02),
        'na_w_out': nrm((NA_HEADS * NA_DH, D), beta * (NA_HEADS * NA_DH) ** -0.5),
        'mla_w_down': nrm((D, MLA_Q_LORA + MLA_KV_LORA + MLA_ROPE), D ** -0.5),
        'mla_q_norm': 1.0 + nrm((MLA_Q_LORA,), 0.01),
        'mla_kv_norm': 1.0 + nrm((MLA_KV_LORA,), 0.01),
        'mla_w_uq': nrm((MLA_Q_LORA, MLA_HEADS * (MLA_NOPE + MLA_ROPE)), MLA_Q_LORA ** -0.5),
        'mla_w_ukv': nrm((MLA_KV_LORA, MLA_HEADS * (MLA_NOPE + MLA_V)), MLA_KV_LORA ** -0.5),
        'mla_w_out': nrm((MLA_HEADS * MLA_V, D), beta * (MLA_HEADS * MLA_V) ** -0.5),
        'hg_w_in': nrm((D, 3 * HG_FDIM + 2 * HG_HEADS * HG_DI), D ** -0.5),
        'hg_lower_bounds': nrm((DEPTH, HG_FDIM), 0.1),
        'hg_norm_g': 1.0 + nrm((HG_DI,), 0.01),
        'hg_w_out': nrm((HG_HEADS * HG_DI, D), beta * (HG_HEADS * HG_DI) ** -0.5),
    }


def reference(x, c, ctx, c_ctx, ada_w, ada_b, ln_g, ln_b, ffn_w13, ffn_w2,
              ret_w_in, ret_decay, ret_w_out,
              na_w_qkv, na_rpb, na_w_out,
              mla_w_down, mla_q_norm, mla_kv_norm, mla_w_uq, mla_w_ukv, mla_w_out,
              hg_w_in, hg_lower_bounds, hg_norm_g, hg_w_out):
    h_lat, h_ctx = x, ctx
    cond_lat = jax.nn.silu(c)[:, None, :]
    cond_ctx = jax.nn.silu(c_ctx)[None, None, :]
    for i in range(DEPTH):
        want_ctx = i < DEPTH - 1
        m_lat = jnp.split(cond_lat @ ada_w[i] + ada_b[i], 6, axis=-1)
        m_ctx = jnp.split(cond_ctx @ ada_w[i] + ada_b[i], 6, axis=-1)
        a_lat = modulate(h_lat, m_lat[0], m_lat[1])
        a_ctx = modulate(h_ctx, m_ctx[0], m_ctx[1])
        kind = i % N_MIXERS
        if kind == 0:
            y_ctx, y_lat = retention_mixer(a_ctx, a_lat, ret_w_in, ret_decay, ret_w_out, want_ctx)
        elif kind == 1:
            y_ctx, y_lat = neighbourhood_mixer(a_ctx, a_lat, na_w_qkv, na_rpb, na_w_out, want_ctx)
        elif kind == 2:
            y_ctx, y_lat = mla_mixer(a_ctx, a_lat, mla_w_down, mla_q_norm, mla_kv_norm, mla_w_uq, mla_w_ukv, mla_w_out, want_ctx)
        else:
            y_ctx, y_lat = hgrn2_mixer(a_ctx, a_lat, hg_w_in, hg_lower_bounds, hg_norm_g, hg_w_out, i, want_ctx)
        h_lat = layer_norm(DEEPNORM_ALPHA * h_lat + m_lat[2] * y_lat, ln_g[i, 0], ln_b[i, 0])
        f_lat = swiglu(modulate(h_lat, m_lat[3], m_lat[4]), ffn_w13[i], ffn_w2[i])
        h_lat = layer_norm(DEEPNORM_ALPHA * h_lat + m_lat[5] * f_lat, ln_g[i, 1], ln_b[i, 1])
        if want_ctx:
            h_ctx = layer_norm(DEEPNORM_ALPHA * h_ctx + m_ctx[2] * y_ctx, ln_g[i, 0], ln_b[i, 0])
            f_ctx = swiglu(modulate(h_ctx, m_ctx[3], m_ctx[4]), ffn_w13[i], ffn_w2[i])
            h_ctx = layer_norm(DEEPNORM_ALPHA * h_ctx + m_ctx[5] * f_ctx, ln_g[i, 1], ln_b[i, 1])
    return h_lat
```

```cpp
#include <hip/hip_runtime.h>
#include <hip/hip_cooperative_groups.h>
#include <cstdio>
#include <cstdint>
namespace cg = cooperative_groups;

#define DI __device__ __forceinline__
typedef unsigned short bf16_t;
typedef short bf16x8 __attribute__((ext_vector_type(8)));
typedef short s16x4 __attribute__((ext_vector_type(4)));
typedef float f32x4 __attribute__((ext_vector_type(4)));
typedef float f32x16 __attribute__((ext_vector_type(16)));
typedef unsigned u32x4 __attribute__((ext_vector_type(4)));
typedef unsigned u32x2 __attribute__((ext_vector_type(2)));

constexpr int NTHR = 512;
constexpr int T_ALL = 33792, PB = 8448, LC = 256, LL = 8192, DM = 1024, FF = 2816;
constexpr float ALPHA = 1.681792830507429f;
constexpr float LOG2E = 1.4426950408889634f;
constexpr size_t MiB = 1048576;

struct Params {
  const float *x, *c, *ctx, *cctx, *ada_w, *ada_b, *ln_g, *ln_b, *w13, *w2;
  const float *ret_w_in, *ret_decay, *ret_w_out, *na_w_qkv, *na_rpb, *na_w_out;
  const float *mla_w_down, *mla_q_norm, *mla_kv_norm, *mla_w_uq, *mla_w_ukv, *mla_w_out;
  const float *hg_w_in, *hg_lb, *hg_norm_g, *hg_w_out;
  float* out; char* ws;
};

constexpr size_t OFF_MODS = 0;
constexpr size_t OFF_TABR = 512 * 1024;
constexpr size_t OFF_TABM = OFF_TABR + 65536;
constexpr size_t OFF_LBV = OFF_TABM + 8192;
constexpr size_t OFF_RS = OFF_LBV + 4096;
constexpr size_t OFF_HCTX = 1 * MiB;
constexpr size_t OFF_A = 5 * MiB;
constexpr size_t OFF_W0 = 71 * MiB;
constexpr size_t OFF_BIG = 104 * MiB;
constexpr size_t OFF_WR = OFF_BIG;
constexpr size_t OFF_S = 180 * MiB;
constexpr size_t WS_NEED = 512 * MiB;
constexpr size_t W0_RETIN = OFF_W0, W0_RETOUT = W0_RETIN + (size_t)6144 * 1024 * 2, W0_W13 = W0_RETOUT + (size_t)1024 * 2048 * 2, W0_W2 = W0_W13 + (size_t)5632 * 1024 * 2;
constexpr size_t SZ_W13 = (size_t)5632 * 1024 * 2, SZ_W2 = (size_t)1024 * 2816 * 2, SZ_SQ = (size_t)1024 * 1024 * 2;
constexpr size_t W1_QKV = OFF_WR, W1_OUT = W1_QKV + (size_t)3072 * 1024 * 2, W1_W13 = W1_OUT + SZ_SQ, W1_W2 = W1_W13 + SZ_W13;
constexpr size_t W2_DOWN = W1_W2 + SZ_W2, W2_UQ = W2_DOWN + (size_t)896 * 1024 * 2, W2_UKV = W2_UQ + (size_t)1536 * 512 * 2, W2_OUT = W2_UKV + (size_t)2048 * 256 * 2, W2_W13 = W2_OUT + SZ_SQ, W2_W2 = W2_W13 + SZ_W13;
constexpr size_t W3_IN = W2_W2 + SZ_W2, W3_OUT = W3_IN + (size_t)5120 * 1024 * 2, W3_W13 = W3_OUT + SZ_SQ, W3_W2 = W3_W13 + SZ_W13, W3_END = W3_W2 + SZ_W2;
static_assert(W3_END <= OFF_S, "rest weights overflow");
static_assert(W0_W2 + SZ_W2 <= OFF_BIG, "W0 overflow");
constexpr size_t SZ_T2048 = (size_t)T_ALL * 2048 * 2, SZ_T1024 = (size_t)T_ALL * 1024 * 2;
constexpr size_t R_QK = OFF_BIG, R_V = R_QK + SZ_T2048, R_O = R_V + SZ_T2048;
static_assert(R_O + SZ_T2048 <= WS_NEED, "retention overflow");
constexpr size_t N_Q = OFF_S, N_K = N_Q + SZ_T1024, N_VT = N_K + SZ_T1024;
constexpr size_t M_D0 = OFF_S, M_Q = M_D0 + (size_t)T_ALL * 896 * 2, M_K = M_Q + (size_t)T_ALL * 1536 * 2, M_VT = M_K + (size_t)T_ALL * 1536 * 2;
static_assert(M_VT + SZ_T1024 <= WS_NEED, "mla overflow");
constexpr size_t H_P = OFF_S;
static_assert(H_P + (size_t)T_ALL * 5120 * 2 <= WS_NEED, "hgrn overflow");
constexpr size_t F_U = OFF_S;

typedef float f32x2 __attribute__((ext_vector_type(2)));
typedef __bf16 bf16x2_t __attribute__((ext_vector_type(2)));
DI unsigned pk2(float lo, float hi) { const f32x2 v = {lo, hi}; const bf16x2_t r = __builtin_convertvector(v, bf16x2_t); return __builtin_bit_cast(unsigned, r); }
DI float bflo(unsigned u) { return __uint_as_float(u << 16); }
DI float bfhi(unsigned u) { return __uint_as_float(u & 0xffff0000u); }
DI float bf2f(bf16_t v) { return __uint_as_float(((unsigned)v) << 16); }
DI bf16_t f2bf(float x) { return (bf16_t)(pk2(x, 0.f) & 0xffffu); }
DI float siluf(float x) { return x / (1.f + __expf(-x)); }
DI f32x4 mfma16(bf16x8 a, bf16x8 b, f32x4 c) { return __builtin_amdgcn_mfma_f32_16x16x32_bf16(a, b, c, 0, 0, 0); }
DI f32x16 mfma32(bf16x8 a, bf16x8 b, f32x16 c) { return __builtin_amdgcn_mfma_f32_32x32x16_bf16(a, b, c, 0, 0, 0); }
DI bf16x8 cat44(s16x4 lo, s16x4 hi) { return __builtin_shufflevector(lo, hi, 0, 1, 2, 3, 4, 5, 6, 7); }
DI bf16x8 pack8(float a0, float a1, float a2, float a3, float a4, float a5, float a6, float a7) {
  u32x4 p; p.x = pk2(a0, a1); p.y = pk2(a2, a3); p.z = pk2(a4, a5); p.w = pk2(a6, a7); return __builtin_bit_cast(bf16x8, p);
}
DI int clampi(int v, int lo, int hi) { return v < lo ? lo : (v > hi ? hi : v); }
DI float* hrow(float* hlat, float* hctx, int t) { const int b = t / PB, p = t - b * PB; return p < LC ? hctx + (size_t)(b * LC + p) * DM : hlat + (size_t)(b * LL + p - LC) * DM; }
DI const float* hrowc(const float* hlat, const float* hctx, int t) { const int b = t / PB, p = t - b * PB; return p < LC ? hctx + (size_t)(b * LC + p) * DM : hlat + (size_t)(b * LL + p - LC) * DM; }
DI int modvec(int t) { const int b = t / PB, p = t - b * PB; return p < LC ? 4 : b; }

template <int MODE> DI int srccol(int n) {
  if (MODE == 0) return n;
  if (MODE == 1) { const int c = n >> 5, s = (n >> 4) & 1, i = n & 15; return s * FF + 16 * c + i; }
  if (MODE == 2) { if (n >= 2048) return n; const int w = n & 255, j = w >> 1, s = w & 1; return (n & ~255) + s * 128 + j; }
  if (MODE == 3) { const int h = n / 96, w = n - h * 96; if (w < 64) return n; const int wp = w - 64, j = wp >> 1, s = wp & 1; return h * 96 + 64 + s * 16 + j; }
  if (MODE == 4) { if (n < 1024) return (n >> 6) * 128 + (n & 63); const int m = n - 1024; return (m >> 6) * 128 + 64 + (m & 63); }
  if (MODE == 5) return n < 800 ? n : -1;
  return n;
}
template <int MODE>
DI void convert_w(const float* __restrict__ src, int Nsrc, int K, bf16_t* __restrict__ dst, int Ndst, const float* __restrict__ kscale, float* ldsf) {
  const int tid = threadIdx.x, tn = Ndst / 64, tk = K / 64;
  for (int tile = blockIdx.x; tile < tn * tk; tile += gridDim.x) {
    const int n0 = (tile % tn) * 64, k0 = (tile / tn) * 64;
    __syncthreads();
    for (int e = tid; e < 4096; e += NTHR) {
      const int kk = e >> 6, nn = e & 63, sc = srccol<MODE>(n0 + nn);
      float v = sc >= 0 ? src[(size_t)(k0 + kk) * Nsrc + sc] : 0.f;
      if (kscale) v *= kscale[k0 + kk];
      ldsf[kk * 65 + nn] = v;
    }
    __syncthreads();
    { const int nn = tid >> 3, kc = tid & 7; const float* lp = ldsf + (kc * 8) * 65 + nn;
      u32x4 o; o.x = pk2(lp[0], lp[65]); o.y = pk2(lp[130], lp[195]); o.z = pk2(lp[260], lp[325]); o.w = pk2(lp[390], lp[455]);
      *(u32x4*)(dst + (size_t)(n0 + nn) * K + k0 + kc * 8) = o; }
  }
}

DI void ada_phase(const Params& p, float* ldsf) {
  const int tid = threadIdx.x, lane = tid & 63, w = tid >> 6;
  float* mods = (float*)(p.ws + OFF_MODS);
  __syncthreads();
  for (int e = tid; e < 5120; e += NTHR) { const int mv = e >> 10, k = e & 1023; const float cv = mv < 4 ? p.c[mv * 1024 + k] : p.cctx[k]; ldsf[e] = siluf(cv); }
  __syncthreads();
  float* red = ldsf + 5120;
  for (int item = blockIdx.x; item < 4 * 96; item += gridDim.x) {
    const int i = item / 96, n0 = (item % 96) * 64;
    const float* wp = p.ada_w + (size_t)i * 1024 * 6144 + n0 + lane;
    float a0 = 0.f, a1 = 0.f, a2 = 0.f, a3 = 0.f, a4 = 0.f;
#pragma unroll 8
    for (int kk = 0; kk < 128; ++kk) { const int k = w * 128 + kk; const float wv = wp[(size_t)k * 6144];
      a0 += ldsf[k] * wv; a1 += ldsf[1024 + k] * wv; a2 += ldsf[2048 + k] * wv; a3 += ldsf[3072 + k] * wv; a4 += ldsf[4096 + k] * wv; }
    red[(w * 5 + 0) * 64 + lane] = a0; red[(w * 5 + 1) * 64 + lane] = a1; red[(w * 5 + 2) * 64 + lane] = a2; red[(w * 5 + 3) * 64 + lane] = a3; red[(w * 5 + 4) * 64 + lane] = a4;
    __syncthreads();
    if (tid < 320) { const int mv = tid >> 6; float s = 0.f;
#pragma unroll
      for (int ww = 0; ww < 8; ++ww) s += red[(ww * 5 + mv) * 64 + lane];
      mods[(size_t)(i * 5 + mv) * 6144 + n0 + lane] = s + p.ada_b[i * 6144 + n0 + lane]; }
    __syncthreads();
  }
}
DI void tables_phase(const Params& p) {
  const int gt = blockIdx.x * NTHR + threadIdx.x, gn = gridDim.x * NTHR;
  float2* tabR = (float2*)(p.ws + OFF_TABR); float2* tabM = (float2*)(p.ws + OFF_TABM); float* lbv = (float*)(p.ws + OFF_LBV);
  for (int e = gt; e < 128 * 64; e += gn) { const int v = e >> 6, i = e & 63; const float inv = powf(10000.f, -(float)i / 64.f); const float ang = (float)v * inv; tabR[e] = make_float2(cosf(ang), sinf(ang)); }
  for (int e = gt; e < 128 * 8; e += gn) { const int v = e >> 3, i = e & 7; const float inv = powf(10000.f, -(float)i / 8.f); const float ang = (float)v * inv; tabM[e] = make_float2(cosf(ang), sinf(ang)); }
  for (int e = gt; e < 1024; e += gn) { const float l0 = p.hg_lb[e], l1 = p.hg_lb[1024 + e], l2 = p.hg_lb[2048 + e], l3 = p.hg_lb[3072 + e];
    const float mx = fmaxf(fmaxf(l0, l1), fmaxf(l2, l3)); const float e0 = expf(l0 - mx), e1 = expf(l1 - mx), e2 = expf(l2 - mx), e3 = expf(l3 - mx);
    lbv[e] = (e1 + e2 + e3) / (e0 + e1 + e2 + e3); }
}

DI void modulate_phase(const Params& p, const float* slat, const float* sctx, int layer) {
  const float* mods = (const float*)(p.ws + OFF_MODS); bf16_t* a = (bf16_t*)(p.ws + OFF_A);
  const int gt = blockIdx.x * NTHR + threadIdx.x, gn = gridDim.x * NTHR;
  for (int e = gt; e < T_ALL * 128; e += gn) {
    const int t = e >> 7, c0 = (e & 127) * 8; const float* s = hrowc(slat, sctx, t) + c0; const float* m = mods + (size_t)(layer * 5 + modvec(t)) * 6144;
    const f32x4 x0 = *(const f32x4*)s, x1 = *(const f32x4*)(s + 4), sh0 = *(const f32x4*)(m + c0), sh1 = *(const f32x4*)(m + c0 + 4), sc0 = *(const f32x4*)(m + 1024 + c0), sc1 = *(const f32x4*)(m + 1024 + c0 + 4);
    const f32x4 y0 = x0 * (1.f + sc0) + sh0, y1 = x1 * (1.f + sc1) + sh1;
    u32x4 o; o.x = pk2(y0[0], y0[1]); o.y = pk2(y0[2], y0[3]); o.z = pk2(y1[0], y1[1]); o.w = pk2(y1[2], y1[3]);
    *(u32x4*)(a + (size_t)t * 1024 + c0) = o;
  }
}
DI void ln_phase(const Params& p, int lnlayer, int lnidx, int ml, int js, bool write_a) {
  const float* mods = (const float*)(p.ws + OFF_MODS); bf16_t* a = (bf16_t*)(p.ws + OFF_A); float* hctx = (float*)(p.ws + OFF_HCTX);
  const int lane = threadIdx.x & 63, gw = blockIdx.x * 8 + (threadIdx.x >> 6), nw = gridDim.x * 8;
  const float* gp = p.ln_g + (size_t)(lnlayer * 2 + lnidx) * 1024; const float* bp = p.ln_b + (size_t)(lnlayer * 2 + lnidx) * 1024;
  for (int t = gw; t < T_ALL; t += nw) {
    float* hr = hrow(p.out, hctx, t);
    f32x4 v[4]; float s = 0.f;
#pragma unroll
    for (int i = 0; i < 4; ++i) { v[i] = *(const f32x4*)(hr + i * 256 + lane * 4); s += (v[i][0] + v[i][1]) + (v[i][2] + v[i][3]); }
#pragma unroll
    for (int o = 1; o < 64; o <<= 1) s += __shfl_xor(s, o);
    const float mean = s * (1.f / 1024.f); float q = 0.f;
#pragma unroll
    for (int i = 0; i < 4; ++i) { v[i] = v[i] - mean; q += (v[i][0] * v[i][0] + v[i][1] * v[i][1]) + (v[i][2] * v[i][2] + v[i][3] * v[i][3]); }
#pragma unroll
    for (int o = 1; o < 64; o <<= 1) q += __shfl_xor(q, o);
    const float rstd = rsqrtf(q * (1.f / 1024.f) + 1e-5f);
    const float* m = mods + (size_t)(ml * 5 + modvec(t)) * 6144 + (size_t)js * 1024;
#pragma unroll
    for (int i = 0; i < 4; ++i) { const int c0 = i * 256 + lane * 4;
      const f32x4 y = v[i] * rstd * *(const f32x4*)(gp + c0) + *(const f32x4*)(bp + c0);
      *(f32x4*)(hr + c0) = y;
      if (write_a) { const f32x4 z = y * (1.f + *(const f32x4*)(m + 1024 + c0)) + *(const f32x4*)(m + c0); u32x2 o; o.x = pk2(z[0], z[1]); o.y = pk2(z[2], z[3]); *(u32x2*)(a + (size_t)t * 1024 + c0) = o; } }
  }
}

struct GemmArgs { const bf16_t* A; int lda; const bf16_t* W; int ldw; int M, N, K; };
constexpr int LDT = 72;
template <bool TRANS, class Epi>
DI void gemm_phase(const GemmArgs g, const Epi epi, char* lds) {
  const int tid = threadIdx.x, lane = tid & 63, w = tid >> 6, wm = w & 3, wn = w >> 2, g4 = lane >> 4, l16 = lane & 15;
  const int nN = g.N / 128, ntiles = (g.M / 256) * nN, nk = g.K / 64;
  bf16_t* As = (bf16_t*)lds; bf16_t* Bs = As + 256 * LDT;
  for (int tile = blockIdx.x; tile < ntiles; tile += gridDim.x) {
    const int pm = tile / nN, pn = tile - pm * nN;
    const bf16_t* Ag = g.A + (size_t)(pm * 256) * g.lda; const bf16_t* Wg = g.W + (size_t)(pn * 128) * g.ldw;
    f32x4 acc[4][4];
#pragma unroll
    for (int i = 0; i < 4; ++i)
#pragma unroll
      for (int j = 0; j < 4; ++j) acc[i][j] = (f32x4){0.f, 0.f, 0.f, 0.f};
    u32x4 ra[4], rb[2];
#pragma unroll
    for (int i = 0; i < 4; ++i) { const int c = tid + NTHR * i; ra[i] = *(const u32x4*)(Ag + (size_t)(c >> 3) * g.lda + (c & 7) * 8); }
#pragma unroll
    for (int i = 0; i < 2; ++i) { const int c = tid + NTHR * i; rb[i] = *(const u32x4*)(Wg + (size_t)(c >> 3) * g.ldw + (c & 7) * 8); }
    for (int kt = 0; kt < nk; ++kt) {
      __syncthreads();
#pragma unroll
      for (int i = 0; i < 4; ++i) { const int c = tid + NTHR * i; *(u32x4*)(As + (c >> 3) * LDT + (c & 7) * 8) = ra[i]; }
#pragma unroll
      for (int i = 0; i < 2; ++i) { const int c = tid + NTHR * i; *(u32x4*)(Bs + (c >> 3) * LDT + (c & 7) * 8) = rb[i]; }
      __syncthreads();
      if (kt + 1 < nk) { const int k0 = (kt + 1) * 64;
#pragma unroll
        for (int i = 0; i < 4; ++i) { const int c = tid + NTHR * i; ra[i] = *(const u32x4*)(Ag + (size_t)(c >> 3) * g.lda + k0 + (c & 7) * 8); }
#pragma unroll
        for (int i = 0; i < 2; ++i) { const int c = tid + NTHR * i; rb[i] = *(const u32x4*)(Wg + (size_t)(c >> 3) * g.ldw + k0 + (c & 7) * 8); } }
#pragma unroll
      for (int ks = 0; ks < 2; ++ks) {
        bf16x8 af[4], wf[4];
#pragma unroll
        for (int i = 0; i < 4; ++i) af[i] = *(const bf16x8*)(As + (wm * 64 + i * 16 + l16) * LDT + ks * 32 + g4 * 8);
#pragma unroll
        for (int j = 0; j < 4; ++j) wf[j] = *(const bf16x8*)(Bs + (wn * 64 + j * 16 + l16) * LDT + ks * 32 + g4 * 8);
#pragma unroll
        for (int i = 0; i < 4; ++i)
#pragma unroll
          for (int j = 0; j < 4; ++j) acc[i][j] = TRANS ? mfma16(af[i], wf[j], acc[i][j]) : mfma16(wf[j], af[i], acc[i][j]);
      }
    }
    const int mb = pm * 256 + wm * 64, nb = pn * 128 + wn * 64;
    if constexpr (Epi::PAIR) {
#pragma unroll
      for (int i = 0; i < 4; ++i)
#pragma unroll
        for (int j = 0; j < 2; ++j) epi.pair(mb + i * 16 + l16, (nb >> 1) + 16 * j + 4 * g4, acc[i][2 * j], acc[i][2 * j + 1]);
    } else {
#pragma unroll
      for (int i = 0; i < 4; ++i)
#pragma unroll
        for (int j = 0; j < 4; ++j) { if (TRANS) epi(mb + i * 16 + 4 * g4, nb + j * 16 + l16, acc[i][j]); else epi(mb + i * 16 + l16, nb + j * 16 + 4 * g4, acc[i][j]); }
    }
  }
}
DI void st4bf(bf16_t* p, f32x4 v) { u32x2 o; o.x = pk2(v[0], v[1]); o.y = pk2(v[2], v[3]); *(u32x2*)p = o; }
struct EpiStore { static constexpr bool PAIR = false; bf16_t* d0; bf16_t* d1; int split, ld0, ld1; float s0;
  DI void operator()(int m, int n, f32x4 v) const { if (n < split) st4bf(d0 + (size_t)m * ld0 + n, v * s0); else st4bf(d1 + (size_t)m * ld1 + (n - split), v); } };
struct EpiVT { static constexpr bool PAIR = false; bf16_t* vt; const float* rs;
  DI void operator()(int m, int n, f32x4 v) const { const int b = m / PB, pos = m - b * PB;
    if (rs) { v[0] *= rs[2 * m + 1]; v[1] *= rs[2 * m + 3]; v[2] *= rs[2 * m + 5]; v[3] *= rs[2 * m + 7]; }
    st4bf(vt + ((size_t)(b * 1024 + n)) * PB + pos, v); } };
struct EpiResid { static constexpr bool PAIR = false; const float* slat; const float* sctx; float* dlat; float* dctx; const float* gate;
  DI void operator()(int m, int n, f32x4 v) const { const int mv = modvec(m); const f32x4 hv = *(const f32x4*)(hrowc(slat, sctx, m) + n); const f32x4 gt = *(const f32x4*)(gate + (size_t)mv * 6144 + n);
    *(f32x4*)(hrow(dlat, dctx, m) + n) = ALPHA * hv + gt * v; } };
struct EpiSwiglu { static constexpr bool PAIR = true; bf16_t* u;
  DI void pair(int m, int f, f32x4 gt, f32x4 up) const { f32x4 r; r[0] = siluf(gt[0]) * up[0]; r[1] = siluf(gt[1]) * up[1]; r[2] = siluf(gt[2]) * up[2]; r[3] = siluf(gt[3]) * up[3]; st4bf(u + (size_t)m * FF + f, r); } };
struct EpiRetQK { static constexpr bool PAIR = false; bf16_t* qk; const float2* tabR;
  DI void operator()(int m, int n, f32x4 v) const { const int b = m / PB, pp = m - b * PB;
    if (pp >= LC) { const int pos = pp - LC, row = pos >> 6, col = pos & 63; const int j0 = (n & 255) >> 1;
      const int vv = j0 < 64 ? row : col; const float2 c0 = tabR[vv * 64 + (j0 & 63)], c1 = tabR[vv * 64 + ((j0 + 1) & 63)];
      const float a0 = v[0] * c0.x - v[1] * c0.y, b0 = v[0] * c0.y + v[1] * c0.x, a1 = v[2] * c1.x - v[3] * c1.y, b1 = v[2] * c1.y + v[3] * c1.x; v = (f32x4){a0, b0, a1, b1}; }
    if (n >= 1024) v = v * 0.0625f;
    st4bf(qk + (size_t)m * 2048 + n, v); } };
struct EpiHg { static constexpr bool PAIR = false; bf16_t* ph;
  DI void operator()(int m, int n, f32x4 v) const { if (n < 1024) { v[0] = siluf(v[0]); v[1] = siluf(v[1]); v[2] = siluf(v[2]); v[3] = siluf(v[3]); v = v * 0.08838834764831845f; } st4bf(ph + (size_t)m * 5120 + n, v); } };
struct EpiMlaQ { static constexpr bool PAIR = false; bf16_t* q; const float* rs; const float2* tabM;
  DI void operator()(int m, int n, f32x4 v) const { v = v * (rs[2 * m] * 0.10206207261596577f * LOG2E); const int h = n / 96, w = n - h * 96; const int b = m / PB, pp = m - b * PB;
    if (w >= 64 && pp >= LC) { const int pos = pp - LC, row = pos >> 6, col = pos & 63; const int j0 = (w - 64) >> 1; const int vv = j0 < 8 ? row : col; const float2 c0 = tabM[vv * 8 + (j0 & 7)], c1 = tabM[vv * 8 + ((j0 + 1) & 7)];
      const float a0 = v[0] * c0.x - v[1] * c0.y, b0 = v[0] * c0.y + v[1] * c0.x, a1 = v[2] * c1.x - v[3] * c1.y, b1 = v[2] * c1.y + v[3] * c1.x; v = (f32x4){a0, b0, a1, b1}; }
    st4bf(q + (size_t)m * 1536 + n, v); } };
struct EpiMlaK { static constexpr bool PAIR = false; bf16_t* k; const float* rs;
  DI void operator()(int m, int n, f32x4 v) const { v = v * rs[2 * m + 1]; st4bf(k + (size_t)m * 1536 + (n >> 6) * 96 + (n & 63), v); } };

DI void mla_stats_phase(const Params& p) {
  const bf16_t* d0 = (const bf16_t*)(p.ws + M_D0); bf16_t* km = (bf16_t*)(p.ws + M_K); float* rs = (float*)(p.ws + OFF_RS); const float2* tabM = (const float2*)(p.ws + OFF_TABM);
  const int lane = threadIdx.x & 63, gw = blockIdx.x * 8 + (threadIdx.x >> 6), nw = gridDim.x * 8;
  for (int t = gw; t < T_ALL; t += nw) {
    const bf16_t* r = d0 + (size_t)t * 896;
    const u32x4 a = *(const u32x4*)(r + lane * 8); const u32x2 c = *(const u32x2*)(r + 512 + lane * 4);
    float sq = bflo(a.x) * bflo(a.x) + bfhi(a.x) * bfhi(a.x) + bflo(a.y) * bflo(a.y) + bfhi(a.y) * bfhi(a.y) + bflo(a.z) * bflo(a.z) + bfhi(a.z) * bfhi(a.z) + bflo(a.w) * bflo(a.w) + bfhi(a.w) * bfhi(a.w);
    float sk = bflo(c.x) * bflo(c.x) + bfhi(c.x) * bfhi(c.x) + bflo(c.y) * bflo(c.y) + bfhi(c.y) * bfhi(c.y);
#pragma unroll
    for (int o = 1; o < 64; o <<= 1) { sq += __shfl_xor(sq, o); sk += __shfl_xor(sk, o); }
    if (lane == 0) { rs[2 * t] = rsqrtf(sq * (1.f / 512.f) + 1e-6f); rs[2 * t + 1] = rsqrtf(sk * (1.f / 256.f) + 1e-6f); }
    if (lane < 16) { const int j = lane; float x1 = bf2f(r[768 + j]), x2 = bf2f(r[768 + 16 + j]); const int b = t / PB, pp = t - b * PB;
      if (pp >= LC) { const int pos = pp - LC, row = pos >> 6, col = pos & 63; const float2 cs = tabM[(j < 8 ? row : col) * 8 + (j & 7)]; const float o1 = x1 * cs.x - x2 * cs.y, o2 = x1 * cs.y + x2 * cs.x; x1 = o1; x2 = o2; }
      const unsigned pr = pk2(x1, x2);
#pragma unroll
      for (int h = 0; h < 16; ++h) *(unsigned*)(km + (size_t)t * 1536 + h * 96 + 64 + 2 * j) = pr; }
  }
}

constexpr int KLD = 104, VLD = 72;
DI void mla_attn_phase(const Params& p, char* lds) {
  const bf16_t* Qm = (const bf16_t*)(p.ws + M_Q); const bf16_t* Km = (const bf16_t*)(p.ws + M_K); const bf16_t* vT = (const bf16_t*)(p.ws + M_VT); bf16_t* o = (bf16_t*)(p.ws + OFF_A);
  const int tid = threadIdx.x, lane = tid & 63, w = tid >> 6, c = lane & 31, hh = lane >> 5;
  bf16_t* Ks = (bf16_t*)lds; bf16_t* Vs = Ks + 2 * 64 * KLD;
  for (int item = blockIdx.x; item < 2048 + 64; item += gridDim.x) {
    int b, h, qbase, nkt;
    if (item < 2048) { b = item >> 9; h = (item >> 5) & 15; qbase = LC + (item & 31) * 256; nkt = 132; } else { const int it = item - 2048; b = it >> 4; h = it & 15; qbase = 0; nkt = 4; }
    const size_t tokbase = (size_t)b * PB;
    const bf16_t* qp = Qm + (tokbase + qbase + w * 32 + c) * 1536 + h * 96 + hh * 8;
    bf16x8 qf[6];
#pragma unroll
    for (int ks = 0; ks < 6; ++ks) qf[ks] = *(const bf16x8*)(qp + ks * 16);
    const bf16_t* kg = Km + tokbase * 1536 + h * 96; const bf16_t* vg = vT + (size_t)(b * 16 + h) * 64 * PB;
    const int kr0 = tid / 12, kc0 = tid - kr0 * 12, e1 = tid + NTHR, kr1 = e1 / 12, kc1 = e1 - kr1 * 12; const bool k1ok = e1 < 768; const int vd = tid >> 3, vc = tid & 7;
    u32x4 rk0, rk1 = (u32x4){0, 0, 0, 0}, rv;
    rk0 = *(const u32x4*)(kg + (size_t)kr0 * 1536 + kc0 * 8); if (k1ok) rk1 = *(const u32x4*)(kg + (size_t)kr1 * 1536 + kc1 * 8); rv = *(const u32x4*)(vg + (size_t)vd * PB + vc * 8);
    __syncthreads();
    *(u32x4*)(Ks + kr0 * KLD + kc0 * 8) = rk0; if (k1ok) *(u32x4*)(Ks + kr1 * KLD + kc1 * 8) = rk1; *(u32x4*)(Vs + vd * VLD + vc * 8) = rv;
    __syncthreads();
    f32x16 oacc[2];
#pragma unroll
    for (int i = 0; i < 16; ++i) { oacc[0][i] = 0.f; oacc[1][i] = 0.f; }
    float mrow = -1e30f, lsum = 0.f;
    for (int kt = 0; kt < nkt; ++kt) {
      const int cur = kt & 1;
      if (kt + 1 < nkt) { const size_t key0 = (size_t)(kt + 1) * 64;
        rk0 = *(const u32x4*)(kg + (key0 + kr0) * 1536 + kc0 * 8); if (k1ok) rk1 = *(const u32x4*)(kg + (key0 + kr1) * 1536 + kc1 * 8); rv = *(const u32x4*)(vg + (size_t)vd * PB + key0 + vc * 8); }
      const bf16_t* Kc = Ks + cur * 64 * KLD; const bf16_t* Vc = Vs + cur * 64 * VLD;
      f32x16 sacc[2];
#pragma unroll
      for (int j = 0; j < 2; ++j) {
#pragma unroll
        for (int i = 0; i < 16; ++i) sacc[j][i] = 0.f;
#pragma unroll
        for (int ks = 0; ks < 6; ++ks) { const bf16x8 kf = *(const bf16x8*)(Kc + (32 * j + c) * KLD + ks * 16 + hh * 8); sacc[j] = mfma32(kf, qf[ks], sacc[j]); }
      }
      float mx = sacc[0][0];
#pragma unroll
      for (int j = 0; j < 2; ++j)
#pragma unroll
        for (int i = 0; i < 16; ++i) mx = fmaxf(mx, sacc[j][i]);
      mx = fmaxf(mx, __shfl_xor(mx, 32));
      const float mnew = fmaxf(mrow, mx), alpha = __builtin_amdgcn_exp2f(mrow - mnew); mrow = mnew;
      float ps = 0.f;
#pragma unroll
      for (int j = 0; j < 2; ++j)
#pragma unroll
        for (int i = 0; i < 16; ++i) { sacc[j][i] = __builtin_amdgcn_exp2f(sacc[j][i] - mnew); ps += sacc[j][i]; }
      lsum = lsum * alpha + ps;
#pragma unroll
      for (int i = 0; i < 16; ++i) { oacc[0][i] *= alpha; oacc[1][i] *= alpha; }
#pragma unroll
      for (int j = 0; j < 2; ++j)
#pragma unroll
        for (int s = 0; s < 2; ++s) {
          const bf16x8 pf = pack8(sacc[j][8 * s], sacc[j][8 * s + 1], sacc[j][8 * s + 2], sacc[j][8 * s + 3], sacc[j][8 * s + 4], sacc[j][8 * s + 5], sacc[j][8 * s + 6], sacc[j][8 * s + 7]);
#pragma unroll
          for (int dt = 0; dt < 2; ++dt) { const bf16_t* vp = Vc + (32 * dt + c) * VLD + 32 * j + 16 * s + 4 * hh;
            const bf16x8 vf = cat44(*(const s16x4*)vp, *(const s16x4*)(vp + 8)); oacc[dt] = mfma32(vf, pf, oacc[dt]); }
        }
      if (kt + 1 < nkt) { bf16_t* Kn = Ks + (cur ^ 1) * 64 * KLD; bf16_t* Vn = Vs + (cur ^ 1) * 64 * VLD;
        *(u32x4*)(Kn + kr0 * KLD + kc0 * 8) = rk0; if (k1ok) *(u32x4*)(Kn + kr1 * KLD + kc1 * 8) = rk1; *(u32x4*)(Vn + vd * VLD + vc * 8) = rv; }
      __syncthreads();
    }
    lsum += __shfl_xor(lsum, 32); const float inv = 1.f / lsum;
    bf16_t* op = o + (tokbase + qbase + w * 32 + c) * 1024 + h * 64 + 4 * hh;
#pragma unroll
    for (int dt = 0; dt < 2; ++dt)
#pragma unroll
      for (int rg = 0; rg < 4; ++rg) st4bf(op + 32 * dt + 8 * rg, (f32x4){oacc[dt][4 * rg] * inv, oacc[dt][4 * rg + 1] * inv, oacc[dt][4 * rg + 2] * inv, oacc[dt][4 * rg + 3] * inv});
  }
}

template <bool CTX>
DI void na_wave(const bf16_t* __restrict__ Q, const bf16_t* __restrict__ K, const bf16_t* __restrict__ vT, bf16_t* __restrict__ o, const float* rpb  , int b, int h, int r, int n, int lane) {
  constexpr int NT = CTX ? 16 : 32;
  const int g = lane >> 4, l16 = lane & 15; const size_t tokbase = (size_t)b * PB;
  const int qpos = CTX ? (n * 16 + l16) : (LC + r * 64 + n * 16 + l16);
  const int rs = clampi(r - 4, 0, 120), band0 = clampi(16 * n - 8, 0, 32);
  const bf16_t* qp = Q + (tokbase + qpos) * 1024 + h * 64 + g * 8;
  const bf16x8 q0 = *(const bf16x8*)qp, q1 = *(const bf16x8*)(qp + 32);
  f32x4 S[NT];
#pragma unroll
  for (int kt = 0; kt < NT; ++kt) {
    int kpos;
    if (!CTX && kt < 16) kpos = LC + (rs + (kt >> 1)) * 64 + band0 + 16 * (kt & 1) + l16; else kpos = 16 * (CTX ? kt : kt - 16) + l16;
    const bf16_t* kp = K + (tokbase + kpos) * 1024 + h * 64 + g * 8;
    f32x4 s = mfma16(*(const bf16x8*)kp, q0, (f32x4){0.f, 0.f, 0.f, 0.f}); s = mfma16(*(const bf16x8*)(kp + 32), q1, s);
    if (!CTX && kt < 16) { const int qcol = 16 * n + l16, wstart = clampi(qcol - 8, 0, 48); const float* bp = rpb + (rs + (kt >> 1) - r + 7) * 31;
#pragma unroll
      for (int rr = 0; rr < 4; ++rr) { const int kcol = band0 + 16 * (kt & 1) + 4 * g + rr; const bool ok = kcol >= wstart && kcol < wstart + 16;
        s[rr] = ok ? (s[rr] + bp[clampi(kcol - qcol + 15, 0, 30)]) * LOG2E : -1e30f; } }
    else s = s * LOG2E;
    S[kt] = s;
  }
  float mx = S[0][0];
#pragma unroll
  for (int kt = 0; kt < NT; ++kt) mx = fmaxf(fmaxf(fmaxf(mx, S[kt][0]), fmaxf(S[kt][1], S[kt][2])), S[kt][3]);
  mx = fmaxf(mx, __shfl_xor(mx, 16)); mx = fmaxf(mx, __shfl_xor(mx, 32));
  float ls = 0.f;
#pragma unroll
  for (int kt = 0; kt < NT; ++kt)
#pragma unroll
    for (int rr = 0; rr < 4; ++rr) { S[kt][rr] = __builtin_amdgcn_exp2f(S[kt][rr] - mx); ls += S[kt][rr]; }
  ls += __shfl_xor(ls, 16); ls += __shfl_xor(ls, 32);
  f32x4 O[4];
#pragma unroll
  for (int dt = 0; dt < 4; ++dt) O[dt] = (f32x4){0.f, 0.f, 0.f, 0.f};
  const bf16_t* vb = vT + ((size_t)(b * 16 + h) * 64 + l16) * PB;
#pragma unroll
  for (int kk = 0; kk < NT / 2; ++kk) {
    int pos0;
    if (!CTX && kk < 8) pos0 = LC + (rs + kk) * 64 + band0 + 4 * g; else pos0 = 32 * (CTX ? kk : kk - 8) + 4 * g;
    const bf16x8 pf = pack8(S[2 * kk][0], S[2 * kk][1], S[2 * kk][2], S[2 * kk][3], S[2 * kk + 1][0], S[2 * kk + 1][1], S[2 * kk + 1][2], S[2 * kk + 1][3]);
#pragma unroll
    for (int dt = 0; dt < 4; ++dt) { const bf16_t* vp = vb + (size_t)(dt * 16) * PB + pos0; const bf16x8 vf = cat44(*(const s16x4*)vp, *(const s16x4*)(vp + 16)); O[dt] = mfma16(vf, pf, O[dt]); }
  }
  const float inv = 1.f / ls; bf16_t* op = o + (tokbase + qpos) * 1024 + h * 64 + 4 * g;
#pragma unroll
  for (int dt = 0; dt < 4; ++dt) st4bf(op + 16 * dt, O[dt] * inv);
}
DI void na_attn_phase(const Params& p, char* lds) {
  const bf16_t* Q = (const bf16_t*)(p.ws + N_Q); const bf16_t* K = (const bf16_t*)(p.ws + N_K); const bf16_t* vT = (const bf16_t*)(p.ws + N_VT); bf16_t* o = (bf16_t*)(p.ws + OFF_A);
  float* rl = (float*)lds; const int tid = threadIdx.x, lane = tid & 63, w = tid >> 6;
  __syncthreads();
  for (int e = tid; e < 16 * 465; e += NTHR) rl[e] = p.na_rpb[e];
  __syncthreads();
  for (int item = blockIdx.x; item < 4096 + 128; item += gridDim.x) {
    if (item < 4096) { const int hhf = item & 1, n = (item >> 1) & 3, r = (item >> 3) & 127, b = item >> 10; const int h = hhf * 8 + w; na_wave<false>(Q, K, vT, o, rl + h * 465, b, h, r, n, lane); }
    else { const int it = item - 4096; const int hhf = it & 1, qb = (it >> 1) & 15, b = it >> 5; const int h = hhf * 8 + w; na_wave<true>(Q, K, vT, o, rl + h * 465, b, h, 0, qb, lane); }
  }
}

template <int DK> struct ScanLds { static constexpr int QLD = DK + 8, TLD = 72;
  static constexpr int OFF_QD = 0, OFF_KD = OFF_QD + 64 * QLD * 2, OFF_KDT = OFF_KD + 64 * QLD * 2, OFF_VT = OFF_KDT + DK * TLD * 2, OFF_ATT = OFF_VT + 64 * TLD * 2, OFF_ST = OFF_ATT + 64 * TLD * 2, OFF_EB = OFF_ST + 64 * QLD * 2, OFF_QS = OFF_EB + DK * 4, TOTAL = OFF_QS + 4 * DK * 4; };
DI int scan_pos(int dir, int i, int tl) { if (dir == 0) return i * 64 + tl; return i < 4 ? 255 - (i * 64 + tl) : 8447 - ((i - 4) * 64 + tl); }

template <int DK, bool HG>
DI void scan_phase(const Params& p, char* lds) {
  typedef ScanLds<DK> L;
  bf16_t* Qd = (bf16_t*)(lds + L::OFF_QD); bf16_t* Kd = (bf16_t*)(lds + L::OFF_KD); bf16_t* Kdt = (bf16_t*)(lds + L::OFF_KDT); bf16_t* Vt = (bf16_t*)(lds + L::OFF_VT);
  bf16_t* Att = (bf16_t*)(lds + L::OFF_ATT); bf16_t* St = (bf16_t*)(lds + L::OFF_ST); float* eb = (float*)(lds + L::OFF_EB); float* qs = (float*)(lds + L::OFF_QS);
  constexpr int QLD = L::QLD, TLD = L::TLD, KT = DK / 16 / 8;
  const int tid = threadIdx.x, lane = tid & 63, w = tid >> 6, g4 = lane >> 4, l16 = lane & 15;
  const int nitems = HG ? 64 : 128;
  const float* lbv = (const float*)(p.ws + OFF_LBV);
  for (int item = blockIdx.x; item < nitems; item += gridDim.x) {
    int b, h, sl; if (HG) { sl = item & 1; h = (item >> 1) & 7; b = item >> 4; } else { sl = item & 7; h = (item >> 3) & 3; b = item >> 5; }
    const size_t tokbase = (size_t)b * PB;
    const bf16_t *qsrc, *ksrc, *vsrc; int ldq, ldv; bf16_t* osrc; int ldo;
    if (HG) { const bf16_t* ph = (const bf16_t*)(p.ws + H_P); qsrc = ph + h * 128; ksrc = ph + 1024 + h * 128; vsrc = ph + 3072 + h * 128 + sl * 64; ldq = 5120; ldv = 5120; osrc = (bf16_t*)(p.ws + OFF_A) + h * 128 + sl * 64; ldo = 1024; }
    else { const bf16_t* qk = (const bf16_t*)(p.ws + R_QK); qsrc = qk + h * 256; ksrc = qk + 1024 + h * 256; vsrc = (const bf16_t*)(p.ws + R_V) + h * 512 + sl * 64; ldq = 2048; ldv = 2048; osrc = (bf16_t*)(p.ws + R_O) + h * 512 + sl * 64; ldo = 2048; }
    for (int dir = 0; dir < 2; ++dir) {
      float lg = 0.f; if (!HG) lg = -__expf(p.ret_decay[dir * 4 + h]);
      const bf16_t* fsrc = HG ? ksrc + dir * 1024 : ksrc;
      f32x4 sacc[KT][4];
#pragma unroll
      for (int a = 0; a < KT; ++a)
#pragma unroll
        for (int v = 0; v < 4; ++v) sacc[a][v] = (f32x4){0.f, 0.f, 0.f, 0.f};
      __syncthreads();
      for (int e = tid; e < 64 * QLD / 2; e += NTHR) ((unsigned*)St)[e] = 0u;
      for (int i = 0; i < 132; ++i) {
        if (HG) {
          const int k = tid & 127, qt = tid >> 7; const float lb = lbv[h * 128 + k];
          float bl[16], qv[16], kv[16]; float run = 0.f;
#pragma unroll
          for (int j = 0; j < 16; ++j) { const size_t row = (tokbase + scan_pos(dir, i, qt * 16 + j)); const float f = bf2f(fsrc[row * ldq + k]); qv[j] = bf2f(qsrc[row * ldq + k]);
            const float sg = 1.f / (1.f + __expf(-f)); const float fg = lb + (1.f - lb) * sg; kv[j] = 1.f - fg; run += __logf(fg); bl[j] = run; }
          qs[qt * DK + k] = run;
          __syncthreads();
          float off = 0.f;
#pragma unroll
          for (int q = 0; q < 3; ++q) if (q < qt) off += qs[q * DK + k];
          if (qt == 3) eb[k] = __expf(off + run);
#pragma unroll
          for (int j = 0; j < 16; ++j) { const int tl = qt * 16 + j; const float bb = bl[j] + off; const bf16_t qd = f2bf(qv[j] * __expf(bb)), kd = f2bf(kv[j] * __expf(-bb));
            Qd[tl * QLD + k] = qd; Kd[tl * QLD + k] = kd; Kdt[k * TLD + tl] = kd; }
        } else {
          if (tid < DK) eb[tid] = __expf(64.f * lg);
#pragma unroll
          for (int it = 0; it < 64 * (DK / 8) / NTHR; ++it) { const int e = tid + NTHR * it, tl = e / (DK / 8), kc = e % (DK / 8); const size_t row = tokbase + scan_pos(dir, i, tl);
            const u32x4 qr = *(const u32x4*)(qsrc + row * ldq + kc * 8), kr = *(const u32x4*)(ksrc + row * ldq + kc * 8);
            const float eq = __expf((float)(tl + 1) * lg), ek = __expf(-(float)(tl + 1) * lg);
            u32x4 qo, ko; qo.x = pk2(bflo(qr.x) * eq, bfhi(qr.x) * eq); qo.y = pk2(bflo(qr.y) * eq, bfhi(qr.y) * eq); qo.z = pk2(bflo(qr.z) * eq, bfhi(qr.z) * eq); qo.w = pk2(bflo(qr.w) * eq, bfhi(qr.w) * eq);
            ko.x = pk2(bflo(kr.x) * ek, bfhi(kr.x) * ek); ko.y = pk2(bflo(kr.y) * ek, bfhi(kr.y) * ek); ko.z = pk2(bflo(kr.z) * ek, bfhi(kr.z) * ek); ko.w = pk2(bflo(kr.w) * ek, bfhi(kr.w) * ek);
            *(u32x4*)(Qd + tl * QLD + kc * 8) = qo; *(u32x4*)(Kd + tl * QLD + kc * 8) = ko;
            bf16_t* kt = Kdt + (kc * 8) * TLD + tl;
            kt[0] = (bf16_t)(ko.x & 0xffff); kt[TLD] = (bf16_t)(ko.x >> 16); kt[2 * TLD] = (bf16_t)(ko.y & 0xffff); kt[3 * TLD] = (bf16_t)(ko.y >> 16);
            kt[4 * TLD] = (bf16_t)(ko.z & 0xffff); kt[5 * TLD] = (bf16_t)(ko.z >> 16); kt[6 * TLD] = (bf16_t)(ko.w & 0xffff); kt[7 * TLD] = (bf16_t)(ko.w >> 16); }
        }
        { const int tl = tid >> 3, vc = tid & 7; const size_t row = tokbase + scan_pos(dir, i, tl); const u32x4 vr = *(const u32x4*)(vsrc + row * ldv + vc * 8); bf16_t* vt = Vt + (vc * 8) * TLD + tl;
          vt[0] = (bf16_t)(vr.x & 0xffff); vt[TLD] = (bf16_t)(vr.x >> 16); vt[2 * TLD] = (bf16_t)(vr.y & 0xffff); vt[3 * TLD] = (bf16_t)(vr.y >> 16);
          vt[4 * TLD] = (bf16_t)(vr.z & 0xffff); vt[5 * TLD] = (bf16_t)(vr.z >> 16); vt[6 * TLD] = (bf16_t)(vr.w & 0xffff); vt[7 * TLD] = (bf16_t)(vr.w >> 16); }
        __syncthreads();
#pragma unroll
        for (int u = 0; u < 2; ++u) { const int id = 2 * w + u, ti = id >> 2, si = id & 3; f32x4 d = (f32x4){0.f, 0.f, 0.f, 0.f};
#pragma unroll
          for (int ks = 0; ks < DK / 32; ++ks) { const bf16x8 kf = *(const bf16x8*)(Kd + (16 * si + l16) * QLD + ks * 32 + g4 * 8), qf = *(const bf16x8*)(Qd + (16 * ti + l16) * QLD + ks * 32 + g4 * 8); d = mfma16(kf, qf, d); }
          const int t = 16 * ti + l16, s0 = 16 * si + 4 * g4;
#pragma unroll
          for (int rr = 0; rr < 4; ++rr) if (s0 + rr > t) d[rr] = 0.f;
          st4bf(Att + t * TLD + s0, d); }
        __syncthreads();
#pragma unroll
        for (int u = 0; u < 2; ++u) { const int id = 2 * w + u, vi = id >> 2, ti = id & 3; f32x4 d = (f32x4){0.f, 0.f, 0.f, 0.f};
#pragma unroll
          for (int ks = 0; ks < 2; ++ks) { const bf16x8 xf = *(const bf16x8*)(Vt + (16 * vi + l16) * TLD + ks * 32 + g4 * 8), yf = *(const bf16x8*)(Att + (16 * ti + l16) * TLD + ks * 32 + g4 * 8); d = mfma16(xf, yf, d); }
#pragma unroll
          for (int ks = 0; ks < DK / 32; ++ks) { const bf16x8 xf = *(const bf16x8*)(St + (16 * vi + l16) * QLD + ks * 32 + g4 * 8), yf = *(const bf16x8*)(Qd + (16 * ti + l16) * QLD + ks * 32 + g4 * 8); d = mfma16(xf, yf, d); }
          const size_t row = tokbase + scan_pos(dir, i, 16 * ti + l16); bf16_t* op = osrc + row * ldo + 16 * vi + 4 * g4;
          if (dir == 1) { const u32x2 old = *(const u32x2*)op; d[0] += bflo(old.x); d[1] += bfhi(old.x); d[2] += bflo(old.y); d[3] += bfhi(old.y); }
          st4bf(op, d); }
#pragma unroll
        for (int a = 0; a < KT; ++a) { const int ki = w * KT + a;
#pragma unroll
          for (int ks = 0; ks < 2; ++ks) { const bf16x8 xf = *(const bf16x8*)(Kdt + (16 * ki + l16) * TLD + ks * 32 + g4 * 8);
#pragma unroll
            for (int vi = 0; vi < 4; ++vi) { const bf16x8 yf = *(const bf16x8*)(Vt + (16 * vi + l16) * TLD + ks * 32 + g4 * 8); sacc[a][vi] = mfma16(xf, yf, sacc[a][vi]); } }
          const f32x4 e4 = *(const f32x4*)(eb + 16 * ki + 4 * g4);
#pragma unroll
          for (int vi = 0; vi < 4; ++vi) sacc[a][vi] = sacc[a][vi] * e4; }
        __syncthreads();
#pragma unroll
        for (int a = 0; a < KT; ++a) { const int ki = w * KT + a;
#pragma unroll
          for (int vi = 0; vi < 4; ++vi) st4bf(St + (16 * vi + l16) * QLD + 16 * ki + 4 * g4, sacc[a][vi]); }
      }
      __threadfence();
    }
  }
}

DI void ret_readout_phase(const Params& p) {
  bf16_t* O = (bf16_t*)(p.ws + R_O); const bf16_t* G = (const bf16_t*)(p.ws + R_QK);
  const int lane = threadIdx.x & 63, gw = blockIdx.x * 8 + (threadIdx.x >> 6), nw = gridDim.x * 8;
  for (int t = gw; t < T_ALL; t += nw) {
    bf16_t* op = O + (size_t)t * 2048 + lane * 32; const bf16_t* gp = G + (size_t)t * 2048 + lane * 32;
    u32x4 ov[4], gv[4]; float sq = 0.f;
#pragma unroll
    for (int i = 0; i < 4; ++i) { ov[i] = *(const u32x4*)(op + i * 8); gv[i] = *(const u32x4*)(gp + i * 8);
      sq += bflo(ov[i].x) * bflo(ov[i].x) + bfhi(ov[i].x) * bfhi(ov[i].x) + bflo(ov[i].y) * bflo(ov[i].y) + bfhi(ov[i].y) * bfhi(ov[i].y) + bflo(ov[i].z) * bflo(ov[i].z) + bfhi(ov[i].z) * bfhi(ov[i].z) + bflo(ov[i].w) * bflo(ov[i].w) + bfhi(ov[i].w) * bfhi(ov[i].w); }
    sq += __shfl_xor(sq, 1); sq += __shfl_xor(sq, 2); sq += __shfl_xor(sq, 4); sq += __shfl_xor(sq, 8);
    const float rstd = rsqrtf(sq * (1.f / 512.f) + 1e-6f);
#pragma unroll
    for (int i = 0; i < 4; ++i) { u32x4 r;
      r.x = pk2(siluf(bflo(gv[i].x)) * bflo(ov[i].x) * rstd, siluf(bfhi(gv[i].x)) * bfhi(ov[i].x) * rstd); r.y = pk2(siluf(bflo(gv[i].y)) * bflo(ov[i].y) * rstd, siluf(bfhi(gv[i].y)) * bfhi(ov[i].y) * rstd);
      r.z = pk2(siluf(bflo(gv[i].z)) * bflo(ov[i].z) * rstd, siluf(bfhi(gv[i].z)) * bfhi(ov[i].z) * rstd); r.w = pk2(siluf(bflo(gv[i].w)) * bflo(ov[i].w) * rstd, siluf(bfhi(gv[i].w)) * bfhi(ov[i].w) * rstd);
      *(u32x4*)(op + i * 8) = r; }
  }
}
DI void hg_readout_phase(const Params& p) {
  bf16_t* O = (bf16_t*)(p.ws + OFF_A); const bf16_t* ph = (const bf16_t*)(p.ws + H_P);
  const int lane = threadIdx.x & 63, gw = blockIdx.x * 8 + (threadIdx.x >> 6), nw = gridDim.x * 8;
  for (int t = gw; t < T_ALL; t += nw) {
    bf16_t* op = O + (size_t)t * 1024 + lane * 16; const bf16_t* gp = ph + (size_t)t * 5120 + 4096 + lane * 16; const float* ng = p.hg_norm_g + (lane & 7) * 16;
    u32x4 ov[2], gv[2]; float sq = 0.f;
#pragma unroll
    for (int i = 0; i < 2; ++i) { ov[i] = *(const u32x4*)(op + i * 8); gv[i] = *(const u32x4*)(gp + i * 8);
      sq += bflo(ov[i].x) * bflo(ov[i].x) + bfhi(ov[i].x) * bfhi(ov[i].x) + bflo(ov[i].y) * bflo(ov[i].y) + bfhi(ov[i].y) * bfhi(ov[i].y) + bflo(ov[i].z) * bflo(ov[i].z) + bfhi(ov[i].z) * bfhi(ov[i].z) + bflo(ov[i].w) * bflo(ov[i].w) + bfhi(ov[i].w) * bfhi(ov[i].w); }
    sq += __shfl_xor(sq, 1); sq += __shfl_xor(sq, 2); sq += __shfl_xor(sq, 4);
    const float rstd = rsqrtf(sq * (1.f / 128.f) + 1e-6f);
#pragma unroll
    for (int i = 0; i < 2; ++i) { u32x4 r; const float* n8 = ng + i * 8;
      r.x = pk2(siluf(bflo(gv[i].x)) * bflo(ov[i].x) * rstd * n8[0], siluf(bfhi(gv[i].x)) * bfhi(ov[i].x) * rstd * n8[1]); r.y = pk2(siluf(bflo(gv[i].y)) * bflo(ov[i].y) * rstd * n8[2], siluf(bfhi(gv[i].y)) * bfhi(ov[i].y) * rstd * n8[3]);
      r.z = pk2(siluf(bflo(gv[i].z)) * bflo(ov[i].z) * rstd * n8[4], siluf(bfhi(gv[i].z)) * bfhi(ov[i].z) * rstd * n8[5]); r.w = pk2(siluf(bflo(gv[i].w)) * bflo(ov[i].w) * rstd * n8[6], siluf(bfhi(gv[i].w)) * bfhi(ov[i].w) * rstd * n8[7]);
      *(u32x4*)(op + i * 8) = r; }
  }
}

constexpr int LDS_BYTES = ScanLds<256>::TOTAL;
static_assert(LDS_BYTES <= 163840, "LDS");
static_assert(LDS_BYTES >= (256 + 128) * LDT * 2 && LDS_BYTES >= 2 * 64 * (KLD + VLD) * 2 && LDS_BYTES >= (5120 + 8 * 5 * 64) * 4, "LDS phases");

DI void ffn_and_ln(const Params& p, cg::grid_group& grid, char* lds, int layer, const bf16_t* w13, const bf16_t* w2) {
  const float* mods = (const float*)(p.ws + OFF_MODS); float* hctx = (float*)(p.ws + OFF_HCTX); bf16_t* a = (bf16_t*)(p.ws + OFF_A); bf16_t* U = (bf16_t*)(p.ws + F_U);
  { GemmArgs g{a, 1024, w13, 1024, T_ALL, 5632, 1024}; EpiSwiglu e{U}; gemm_phase<false>(g, e, lds); }
  grid.sync();
  { GemmArgs g{U, FF, w2, FF, T_ALL, 1024, FF}; EpiResid e{p.out, hctx, p.out, hctx, mods + (size_t)layer * 5 * 6144 + 5 * 1024}; gemm_phase<false>(g, e, lds); }
  grid.sync();
  ln_phase(p, layer, 1, layer < 3 ? layer + 1 : 3, 0, layer < 3);
  grid.sync();
}

__global__ void __launch_bounds__(NTHR) mega(Params p) {
  __shared__ __attribute__((aligned(16))) char lds[LDS_BYTES];
  cg::grid_group grid = cg::this_grid();
  float* ldsf = (float*)lds;
  const float* mods = (const float*)(p.ws + OFF_MODS); float* hctx = (float*)(p.ws + OFF_HCTX); bf16_t* a = (bf16_t*)(p.ws + OFF_A);
  const float2* tabR = (const float2*)(p.ws + OFF_TABR); const float2* tabM = (const float2*)(p.ws + OFF_TABM); float* rs = (float*)(p.ws + OFF_RS);
  ada_phase(p, ldsf);
  tables_phase(p);
  convert_w<2>(p.ret_w_in, 6144, 1024, (bf16_t*)(p.ws + W0_RETIN), 6144, nullptr, ldsf);
  convert_w<0>(p.ret_w_out, 1024, 2048, (bf16_t*)(p.ws + W0_RETOUT), 1024, nullptr, ldsf);
  convert_w<1>(p.w13, 5632, 1024, (bf16_t*)(p.ws + W0_W13), 5632, nullptr, ldsf);
  convert_w<0>(p.w2, 1024, FF, (bf16_t*)(p.ws + W0_W2), 1024, nullptr, ldsf);
  grid.sync();
  modulate_phase(p, p.x, p.ctx, 0);
  grid.sync();
  { const bf16_t* wi = (const bf16_t*)(p.ws + W0_RETIN);
    { GemmArgs g{a, 1024, wi, 1024, T_ALL, 2048, 1024}; EpiRetQK e{(bf16_t*)(p.ws + R_QK), tabR}; gemm_phase<false>(g, e, lds); }
    { GemmArgs g{a, 1024, wi + (size_t)2048 * 1024, 1024, T_ALL, 2048, 1024}; EpiStore e{(bf16_t*)(p.ws + R_V), (bf16_t*)(p.ws + R_V), 1 << 30, 2048, 2048, 1.f}; gemm_phase<false>(g, e, lds); }
    grid.sync();
    scan_phase<256, false>(p, lds);
    grid.sync();
    { GemmArgs g{a, 1024, wi + (size_t)4096 * 1024, 1024, T_ALL, 2048, 1024}; EpiStore e{(bf16_t*)(p.ws + R_QK), (bf16_t*)(p.ws + R_QK), 1 << 30, 2048, 2048, 1.f}; gemm_phase<false>(g, e, lds); }
    grid.sync();
    ret_readout_phase(p);
    grid.sync();
    { GemmArgs g{(const bf16_t*)(p.ws + R_O), 2048, (const bf16_t*)(p.ws + W0_RETOUT), 2048, T_ALL, 1024, 2048}; EpiResid e{p.x, p.ctx, p.out, hctx, mods + 2 * 1024}; gemm_phase<false>(g, e, lds); }
    grid.sync();
    ln_phase(p, 0, 0, 0, 3, true);
    convert_w<0>(p.na_w_qkv, 3072, 1024, (bf16_t*)(p.ws + W1_QKV), 3072, nullptr, ldsf);
    convert_w<0>(p.na_w_out, 1024, 1024, (bf16_t*)(p.ws + W1_OUT), 1024, nullptr, ldsf);
    convert_w<1>(p.w13 + (size_t)1 * 1024 * 5632, 5632, 1024, (bf16_t*)(p.ws + W1_W13), 5632, nullptr, ldsf);
    convert_w<0>(p.w2 + (size_t)1 * FF * 1024, 1024, FF, (bf16_t*)(p.ws + W1_W2), 1024, nullptr, ldsf);
    convert_w<5>(p.mla_w_down, 800, 1024, (bf16_t*)(p.ws + W2_DOWN), 896, nullptr, ldsf);
    convert_w<3>(p.mla_w_uq, 1536, 512, (bf16_t*)(p.ws + W2_UQ), 1536, p.mla_q_norm, ldsf);
    convert_w<4>(p.mla_w_ukv, 2048, 256, (bf16_t*)(p.ws + W2_UKV), 2048, p.mla_kv_norm, ldsf);
    convert_w<0>(p.mla_w_out, 1024, 1024, (bf16_t*)(p.ws + W2_OUT), 1024, nullptr, ldsf);
    convert_w<1>(p.w13 + (size_t)2 * 1024 * 5632, 5632, 1024, (bf16_t*)(p.ws + W2_W13), 5632, nullptr, ldsf);
    convert_w<0>(p.w2 + (size_t)2 * FF * 1024, 1024, FF, (bf16_t*)(p.ws + W2_W2), 1024, nullptr, ldsf);
    convert_w<0>(p.hg_w_in, 5120, 1024, (bf16_t*)(p.ws + W3_IN), 5120, nullptr, ldsf);
    convert_w<0>(p.hg_w_out, 1024, 1024, (bf16_t*)(p.ws + W3_OUT), 1024, nullptr, ldsf);
    convert_w<1>(p.w13 + (size_t)3 * 1024 * 5632, 5632, 1024, (bf16_t*)(p.ws + W3_W13), 5632, nullptr, ldsf);
    convert_w<0>(p.w2 + (size_t)3 * FF * 1024, 1024, FF, (bf16_t*)(p.ws + W3_W2), 1024, nullptr, ldsf);
    grid.sync();
    ffn_and_ln(p, grid, lds, 0, (const bf16_t*)(p.ws + W0_W13), (const bf16_t*)(p.ws + W0_W2));
  }
  { const bf16_t* wq = (const bf16_t*)(p.ws + W1_QKV);
    { GemmArgs g{a, 1024, wq, 1024, T_ALL, 2048, 1024}; EpiStore e{(bf16_t*)(p.ws + N_Q), (bf16_t*)(p.ws + N_K), 1024, 1024, 1024, 0.125f}; gemm_phase<false>(g, e, lds); }
    { GemmArgs g{a, 1024, wq + (size_t)2048 * 1024, 1024, T_ALL, 1024, 1024}; EpiVT e{(bf16_t*)(p.ws + N_VT), nullptr}; gemm_phase<true>(g, e, lds); }
    grid.sync();
    na_attn_phase(p, lds);
    grid.sync();
    { GemmArgs g{a, 1024, (const bf16_t*)(p.ws + W1_OUT), 1024, T_ALL, 1024, 1024}; EpiResid e{p.out, hctx, p.out, hctx, mods + (size_t)1 * 5 * 6144 + 2 * 1024}; gemm_phase<false>(g, e, lds); }
    grid.sync();
    ln_phase(p, 1, 0, 1, 3, true);
    grid.sync();
    ffn_and_ln(p, grid, lds, 1, (const bf16_t*)(p.ws + W1_W13), (const bf16_t*)(p.ws + W1_W2));
  }
  { const bf16_t* d0 = (const bf16_t*)(p.ws + M_D0);
    { GemmArgs g{a, 1024, (const bf16_t*)(p.ws + W2_DOWN), 1024, T_ALL, 896, 1024}; EpiStore e{(bf16_t*)(p.ws + M_D0), (bf16_t*)(p.ws + M_D0), 1 << 30, 896, 896, 1.f}; gemm_phase<false>(g, e, lds); }
    grid.sync();
    mla_stats_phase(p);
    grid.sync();
    { GemmArgs g{d0, 896, (const bf16_t*)(p.ws + W2_UQ), 512, T_ALL, 1536, 512}; EpiMlaQ e{(bf16_t*)(p.ws + M_Q), rs, tabM}; gemm_phase<false>(g, e, lds); }
    { GemmArgs g{d0 + 512, 896, (const bf16_t*)(p.ws + W2_UKV), 256, T_ALL, 1024, 256}; EpiMlaK e{(bf16_t*)(p.ws + M_K), rs}; gemm_phase<false>(g, e, lds); }
    { GemmArgs g{d0 + 512, 896, (const bf16_t*)(p.ws + W2_UKV) + (size_t)1024 * 256, 256, T_ALL, 1024, 256}; EpiVT e{(bf16_t*)(p.ws + M_VT), rs}; gemm_phase<true>(g, e, lds); }
    grid.sync();
    mla_attn_phase(p, lds);
    grid.sync();
    { GemmArgs g{a, 1024, (const bf16_t*)(p.ws + W2_OUT), 1024, T_ALL, 1024, 1024}; EpiResid e{p.out, hctx, p.out, hctx, mods + (size_t)2 * 5 * 6144 + 2 * 1024}; gemm_phase<false>(g, e, lds); }
    grid.sync();
    ln_phase(p, 2, 0, 2, 3, true);
    grid.sync();
    ffn_and_ln(p, grid, lds, 2, (const bf16_t*)(p.ws + W2_W13), (const bf16_t*)(p.ws + W2_W2));
  }
  { { GemmArgs g{a, 1024, (const bf16_t*)(p.ws + W3_IN), 1024, T_ALL, 5120, 1024}; EpiHg e{(bf16_t*)(p.ws + H_P)}; gemm_phase<false>(g, e, lds); }
    grid.sync();
    scan_phase<128, true>(p, lds);
    grid.sync();
    hg_readout_phase(p);
    grid.sync();
    { GemmArgs g{a, 1024, (const bf16_t*)(p.ws + W3_OUT), 1024, T_ALL, 1024, 1024}; EpiResid e{p.out, hctx, p.out, hctx, mods + (size_t)3 * 5 * 6144 + 2 * 1024}; gemm_phase<false>(g, e, lds); }
    grid.sync();
    ln_phase(p, 3, 0, 3, 3, true);
    grid.sync();
    ffn_and_ln(p, grid, lds, 3, (const bf16_t*)(p.ws + W3_W13), (const bf16_t*)(p.ws + W3_W2));
  }
}

extern "C" void kernel_launch(void* const* d_in, const int* in_sizes, int n_in, void* d_out, int out_size, void* d_ws, size_t ws_size, hipStream_t stream) {
  static int grid_blocks = 0;
  if (!grid_blocks) {
    int dev = 0, cus = 0, per_cu = 0;
    (void)hipGetDevice(&dev);
    (void)hipDeviceGetAttribute(&cus, hipDeviceAttributeMultiprocessorCount, dev);
    (void)hipOccupancyMaxActiveBlocksPerMultiprocessor(&per_cu, mega, NTHR, 0);
    if (per_cu != 1) per_cu = 1;
    grid_blocks = cus * per_cu;
  }
  if (ws_size < WS_NEED) { fprintf(stderr, "workspace too small: %zu\n", ws_size); return; }
  Params p{};
  const float** f = (const float**)&p;
  for (int i = 0; i < 26; ++i) f[i] = (const float*)d_in[i];
  p.out = (float*)d_out; p.ws = (char*)d_ws;
  void* args[] = {&p};
  hipError_t e = hipLaunchCooperativeKernel((void*)mega, dim3(grid_blocks), dim3(NTHR), args, 0, stream);
  if (e != hipSuccess) fprintf(stderr, "cooperative launch failed: %s (grid %d)\n", hipGetErrorString(e), grid_blocks);
}
```

```cpp
#include <hip/hip_runtime.h>
#include <hip/hip_cooperative_groups.h>
#include <cstdio>
#include <cstdint>
namespace cg = cooperative_groups;

#define DI __device__ __forceinline__
typedef unsigned short bf16_t;
typedef short bf16x8 __attribute__((ext_vector_type(8)));
typedef short s16x4 __attribute__((ext_vector_type(4)));
typedef float f32x4 __attribute__((ext_vector_type(4)));
typedef float f32x16 __attribute__((ext_vector_type(16)));
typedef unsigned u32x4 __attribute__((ext_vector_type(4)));
typedef unsigned u32x2 __attribute__((ext_vector_type(2)));

constexpr int NTHR = 512;
constexpr int T_ALL = 33792, PB = 8448, LC = 256, LL = 8192, DM = 1024, FF = 2816;
constexpr float ALPHA = 1.681792830507429f;
constexpr float LOG2E = 1.4426950408889634f;
constexpr size_t MiB = 1048576;

struct Params {
  const float *x, *c, *ctx, *cctx, *ada_w, *ada_b, *ln_g, *ln_b, *w13, *w2;
  const float *ret_w_in, *ret_decay, *ret_w_out, *na_w_qkv, *na_rpb, *na_w_out;
  const float *mla_w_down, *mla_q_norm, *mla_kv_norm, *mla_w_uq, *mla_w_ukv, *mla_w_out;
  const float *hg_w_in, *hg_lb, *hg_norm_g, *hg_w_out;
  float* out; char* ws;
};

constexpr size_t OFF_MODS = 0;
constexpr size_t OFF_TABR = 512 * 1024;
constexpr size_t OFF_TABM = OFF_TABR + 65536;
constexpr size_t OFF_LBV = OFF_TABM + 8192;
constexpr size_t OFF_RS = OFF_LBV + 4096;
constexpr size_t OFF_HCTX = 1 * MiB;
constexpr size_t OFF_A = 5 * MiB;
constexpr size_t OFF_W0 = 71 * MiB;
constexpr size_t OFF_BIG = 104 * MiB;
constexpr size_t OFF_WR = OFF_BIG;
constexpr size_t OFF_S = 180 * MiB;
constexpr size_t WS_NEED = 512 * MiB;
constexpr size_t W0_RETIN = OFF_W0, W0_RETOUT = W0_RETIN + (size_t)6144 * 1024 * 2, W0_W13 = W0_RETOUT + (size_t)1024 * 2048 * 2, W0_W2 = W0_W13 + (size_t)5632 * 1024 * 2;
constexpr size_t SZ_W13 = (size_t)5632 * 1024 * 2, SZ_W2 = (size_t)1024 * 2816 * 2, SZ_SQ = (size_t)1024 * 1024 * 2;
constexpr size_t W1_QKV = OFF_WR, W1_OUT = W1_QKV + (size_t)3072 * 1024 * 2, W1_W13 = W1_OUT + SZ_SQ, W1_W2 = W1_W13 + SZ_W13;
constexpr size_t W2_DOWN = W1_W2 + SZ_W2, W2_UQ = W2_DOWN + (size_t)896 * 1024 * 2, W2_UKV = W2_UQ + (size_t)1536 * 512 * 2, W2_OUT = W2_UKV + (size_t)2048 * 256 * 2, W2_W13 = W2_OUT + SZ_SQ, W2_W2 = W2_W13 + SZ_W13;
constexpr size_t W3_IN = W2_W2 + SZ_W2, W3_OUT = W3_IN + (size_t)5120 * 1024 * 2, W3_W13 = W3_OUT + SZ_SQ, W3_W2 = W3_W13 + SZ_W13, W3_END = W3_W2 + SZ_W2;
static_assert(W3_END <= OFF_S, "rest weights overflow");
static_assert(W0_W2 + SZ_W2 <= OFF_BIG, "W0 overflow");
constexpr size_t SZ_T2048 = (size_t)T_ALL * 2048 * 2, SZ_T1024 = (size_t)T_ALL * 1024 * 2;
constexpr size_t R_QK = OFF_BIG, R_V = R_QK + SZ_T2048, R_O = R_V + SZ_T2048;
static_assert(R_O + SZ_T2048 <= WS_NEED, "retention overflow");
constexpr size_t N_Q = OFF_S, N_K = N_Q + SZ_T1024, N_VT = N_K + SZ_T1024;
constexpr size_t M_D0 = OFF_S, M_Q = M_D0 + (size_t)T_ALL * 896 * 2, M_K = M_Q + (size_t)T_ALL * 1536 * 2, M_VT = M_K + (size_t)T_ALL * 1536 * 2;
static_assert(M_VT + SZ_T1024 <= WS_NEED, "mla overflow");
constexpr size_t H_P = OFF_S;
static_assert(H_P + (size_t)T_ALL * 5120 * 2 <= WS_NEED, "hgrn overflow");
constexpr size_t F_U = OFF_S;

typedef float f32x2 __attribute__((ext_vector_type(2)));
typedef __bf16 bf16x2_t __attribute__((ext_vector_type(2)));
DI unsigned pk2(float lo, float hi) { const f32x2 v = {lo, hi}; const bf16x2_t r = __builtin_convertvector(v, bf16x2_t); return __builtin_bit_cast(unsigned, r); }
DI float bflo(unsigned u) { return __uint_as_float(u << 16); }
DI float bfhi(unsigned u) { return __uint_as_float(u & 0xffff0000u); }
DI float bf2f(bf16_t v) { return __uint_as_float(((unsigned)v) << 16); }
DI bf16_t f2bf(float x) { return (bf16_t)(pk2(x, 0.f) & 0xffffu); }
DI float siluf(float x) { return x / (1.f + __expf(-x)); }
DI f32x4 mfma16(bf16x8 a, bf16x8 b, f32x4 c) { return __builtin_amdgcn_mfma_f32_16x16x32_bf16(a, b, c, 0, 0, 0); }
DI f32x16 mfma32(bf16x8 a, bf16x8 b, f32x16 c) { return __builtin_amdgcn_mfma_f32_32x32x16_bf16(a, b, c, 0, 0, 0); }
DI bf16x8 cat44(s16x4 lo, s16x4 hi) { return __builtin_shufflevector(lo, hi, 0, 1, 2, 3, 4, 5, 6, 7); }
DI bf16x8 pack8(float a0, float a1, float a2, float a3, float a4, float a5, float a6, float a7) {
  u32x4 p; p.x = pk2(a0, a1); p.y = pk2(a2, a3); p.z = pk2(a4, a5); p.w = pk2(a6, a7); return __builtin_bit_cast(bf16x8, p);
}
DI int clampi(int v, int lo, int hi) { return v < lo ? lo : (v > hi ? hi : v); }
DI float* hrow(float* hlat, float* hctx, int t) { const int b = t / PB, p = t - b * PB; return p < LC ? hctx + (size_t)(b * LC + p) * DM : hlat + (size_t)(b * LL + p - LC) * DM; }
DI const float* hrowc(const float* hlat, const float* hctx, int t) { const int b = t / PB, p = t - b * PB; return p < LC ? hctx + (size_t)(b * LC + p) * DM : hlat + (size_t)(b * LL + p - LC) * DM; }
DI int modvec(int t) { const int b = t / PB, p = t - b * PB; return p < LC ? 4 : b; }

template <int MODE> DI int srccol(int n) {
  if (MODE == 0) return n;
  if (MODE == 1) { const int c = n >> 5, s = (n >> 4) & 1, i = n & 15; return s * FF + 16 * c + i; }
  if (MODE == 2) { if (n >= 2048) return n; const int w = n & 255, j = w >> 1, s = w & 1; return (n & ~255) + s * 128 + j; }
  if (MODE == 3) { const int h = n / 96, w = n - h * 96; if (w < 64) return n; const int wp = w - 64, j = wp >> 1, s = wp & 1; return h * 96 + 64 + s * 16 + j; }
  if (MODE == 4) { if (n < 1024) return (n >> 6) * 128 + (n & 63); const int m = n - 1024; return (m >> 6) * 128 + 64 + (m & 63); }
  if (MODE == 5) return n < 800 ? n : -1;
  return n;
}
template <int MODE>
DI void convert_w(const float* __restrict__ src, int Nsrc, int K, bf16_t* __restrict__ dst, int Ndst, const float* __restrict__ kscale, float* ldsf) {
  const int tid = threadIdx.x, tn = Ndst / 64, tk = K / 64;
  for (int tile = blockIdx.x; tile < tn * tk; tile += gridDim.x) {
    const int n0 = (tile % tn) * 64, k0 = (tile / tn) * 64;
    __syncthreads();
    for (int e = tid; e < 4096; e += NTHR) {
      const int kk = e >> 6, nn = e & 63, sc = srccol<MODE>(n0 + nn);
      float v = sc >= 0 ? src[(size_t)(k0 + kk) * Nsrc + sc] : 0.f;
      if (kscale) v *= kscale[k0 + kk];
      ldsf[kk * 65 + nn] = v;
    }
    __syncthreads();
    { const int nn = tid >> 3, kc = tid & 7; const float* lp = ldsf + (kc * 8) * 65 + nn;
      u32x4 o; o.x = pk2(lp[0], lp[65]); o.y = pk2(lp[130], lp[195]); o.z = pk2(lp[260], lp[325]); o.w = pk2(lp[390], lp[455]);
      *(u32x4*)(dst + (size_t)(n0 + nn) * K + k0 + kc * 8) = o; }
  }
}

DI void ada_phase(const Params& p, float* ldsf) {
  const int tid = threadIdx.x, lane = tid & 63, w = tid >> 6;
  float* mods = (float*)(p.ws + OFF_MODS);
  __syncthreads();
  for (int e = tid; e < 5120; e += NTHR) { const int mv = e >> 10, k = e & 1023; const float cv = mv < 4 ? p.c[mv * 1024 + k] : p.cctx[k]; ldsf[e] = siluf(cv); }
  __syncthreads();
  float* red = ldsf + 5120;
  for (int item = blockIdx.x; item < 4 * 96; item += gridDim.x) {
    const int i = item / 96, n0 = (item % 96) * 64;
    const float* wp = p.ada_w + (size_t)i * 1024 * 6144 + n0 + lane;
    float a0 = 0.f, a1 = 0.f, a2 = 0.f, a3 = 0.f, a4 = 0.f;
#pragma unroll 8
    for (int kk = 0; kk < 128; ++kk) { const int k = w * 128 + kk; const float wv = wp[(size_t)k * 6144];
      a0 += ldsf[k] * wv; a1 += ldsf[1024 + k] * wv; a2 += ldsf[2048 + k] * wv; a3 += ldsf[3072 + k] * wv; a4 += ldsf[4096 + k] * wv; }
    red[(w * 5 + 0) * 64 + lane] = a0; red[(w * 5 + 1) * 64 + lane] = a1; red[(w * 5 + 2) * 64 + lane] = a2; red[(w * 5 + 3) * 64 + lane] = a3; red[(w * 5 + 4) * 64 + lane] = a4;
    __syncthreads();
    if (tid < 320) { const int mv = tid >> 6; float s = 0.f;
#pragma unroll
      for (int ww = 0; ww < 8; ++ww) s += red[(ww * 5 + mv) * 64 + lane];
      mods[(size_t)(i * 5 + mv) * 6144 + n0 + lane] = s + p.ada_b[i * 6144 + n0 + lane]; }
    __syncthreads();
  }
}
DI void tables_phase(const Params& p) {
  const int gt = blockIdx.x * NTHR + threadIdx.x, gn = gridDim.x * NTHR;
  float2* tabR = (float2*)(p.ws + OFF_TABR); float2* tabM = (float2*)(p.ws + OFF_TABM); float* lbv = (float*)(p.ws + OFF_LBV);
  for (int e = gt; e < 128 * 64; e += gn) { const int v = e >> 6, i = e & 63; const float inv = powf(10000.f, -(float)i / 64.f); const float ang = (float)v * inv; tabR[e] = make_float2(cosf(ang), sinf(ang)); }
  for (int e = gt; e < 128 * 8; e += gn) { const int v = e >> 3, i = e & 7; const float inv = powf(10000.f, -(float)i / 8.f); const float ang = (float)v * inv; tabM[e] = make_float2(cosf(ang), sinf(ang)); }
  for (int e = gt; e < 1024; e += gn) { const float l0 = p.hg_lb[e], l1 = p.hg_lb[1024 + e], l2 = p.hg_lb[2048 + e], l3 = p.hg_lb[3072 + e];
    const float mx = fmaxf(fmaxf(l0, l1), fmaxf(l2, l3)); const float e0 = expf(l0 - mx), e1 = expf(l1 - mx), e2 = expf(l2 - mx), e3 = expf(l3 - mx);
    lbv[e] = (e1 + e2 + e3) / (e0 + e1 + e2 + e3); }
}

DI void modulate_phase(const Params& p, const float* slat, const float* sctx, int layer) {
  const float* mods = (const float*)(p.ws + OFF_MODS); bf16_t* a = (bf16_t*)(p.ws + OFF_A);
  const int gt = blockIdx.x * NTHR + threadIdx.x, gn = gridDim.x * NTHR;
  for (int e = gt; e < T_ALL * 128; e += gn) {
    const int t = e >> 7, c0 = (e & 127) * 8; const float* s = hrowc(slat, sctx, t) + c0; const float* m = mods + (size_t)(layer * 5 + modvec(t)) * 6144;
    const f32x4 x0 = *(const f32x4*)s, x1 = *(const f32x4*)(s + 4), sh0 = *(const f32x4*)(m + c0), sh1 = *(const f32x4*)(m + c0 + 4), sc0 = *(const f32x4*)(m + 1024 + c0), sc1 = *(const f32x4*)(m + 1024 + c0 + 4);
    const f32x4 y0 = x0 * (1.f + sc0) + sh0, y1 = x1 * (1.f + sc1) + sh1;
    u32x4 o; o.x = pk2(y0[0], y0[1]); o.y = pk2(y0[2], y0[3]); o.z = pk2(y1[0], y1[1]); o.w = pk2(y1[2], y1[3]);
    *(u32x4*)(a + (size_t)t * 1024 + c0) = o;
  }
}
DI void ln_phase(const Params& p, int lnlayer, int lnidx, int ml, int js, bool write_a) {
  const float* mods = (const float*)(p.ws + OFF_MODS); bf16_t* a = (bf16_t*)(p.ws + OFF_A); float* hctx = (float*)(p.ws + OFF_HCTX);
  const int lane = threadIdx.x & 63, gw = blockIdx.x * 8 + (threadIdx.x >> 6), nw = gridDim.x * 8;
  const float* gp = p.ln_g + (size_t)(lnlayer * 2 + lnidx) * 1024; const float* bp = p.ln_b + (size_t)(lnlayer * 2 + lnidx) * 1024;
  for (int t = gw; t < T_ALL; t += nw) {
    float* hr = hrow(p.out, hctx, t);
    f32x4 v[4]; float s = 0.f;
#pragma unroll
    for (int i = 0; i < 4; ++i) { v[i] = *(const f32x4*)(hr + i * 256 + lane * 4); s += (v[i][0] + v[i][1]) + (v[i][2] + v[i][3]); }
#pragma unroll
    for (int o = 1; o < 64; o <<= 1) s += __shfl_xor(s, o);
    const float mean = s * (1.f / 1024.f); float q = 0.f;
#pragma unroll
    for (int i = 0; i < 4; ++i) { v[i] = v[i] - mean; q += (v[i][0] * v[i][0] + v[i][1] * v[i][1]) + (v[i][2] * v[i][2] + v[i][3] * v[i][3]); }
#pragma unroll
    for (int o = 1; o < 64; o <<= 1) q += __shfl_xor(q, o);
    const float rstd = rsqrtf(q * (1.f / 1024.f) + 1e-5f);
    const float* m = mods + (size_t)(ml * 5 + modvec(t)) * 6144 + (size_t)js * 1024;
#pragma unroll
    for (int i = 0; i < 4; ++i) { const int c0 = i * 256 + lane * 4;
      const f32x4 y = v[i] * rstd * *(const f32x4*)(gp + c0) + *(const f32x4*)(bp + c0);
      *(f32x4*)(hr + c0) = y;
      if (write_a) { const f32x4 z = y * (1.f + *(const f32x4*)(m + 1024 + c0)) + *(const f32x4*)(m + c0); u32x2 o; o.x = pk2(z[0], z[1]); o.y = pk2(z[2], z[3]); *(u32x2*)(a + (size_t)t * 1024 + c0) = o; } }
  }
}

struct GemmArgs { const bf16_t* A; int lda; const bf16_t* W; int ldw; int M, N, K; };
constexpr int LDT = 72;
template <bool TRANS, class Epi>
DI void gemm_phase(const GemmArgs g, const Epi epi, char* lds) {
  const int tid = threadIdx.x, lane = tid & 63, w = tid >> 6, wm = w & 3, wn = w >> 2, g4 = lane >> 4, l16 = lane & 15;
  const int nN = g.N / 128, ntiles = (g.M / 256) * nN, nk = g.K / 64;
  bf16_t* As = (bf16_t*)lds; bf16_t* Bs = As + 256 * LDT;
  for (int tile = blockIdx.x; tile < ntiles; tile += gridDim.x) {
    const int pm = tile / nN, pn = tile - pm * nN;
    const bf16_t* Ag = g.A + (size_t)(pm * 256) * g.lda; const bf16_t* Wg = g.W + (size_t)(pn * 128) * g.ldw;
    f32x4 acc[4][4];
#pragma unroll
    for (int i = 0; i < 4; ++i)
#pragma unroll
      for (int j = 0; j < 4; ++j) acc[i][j] = (f32x4){0.f, 0.f, 0.f, 0.f};
    u32x4 ra[4], rb[2];
#pragma unroll
    for (int i = 0; i < 4; ++i) { const int c = tid + NTHR * i; ra[i] = *(const u32x4*)(Ag + (size_t)(c >> 3) * g.lda + (c & 7) * 8); }
#pragma unroll
    for (int i = 0; i < 2; ++i) { const int c = tid + NTHR * i; rb[i] = *(const u32x4*)(Wg + (size_t)(c >> 3) * g.ldw + (c & 7) * 8); }
    for (int kt = 0; kt < nk; ++kt) {
      __syncthreads();
#pragma unroll
      for (int i = 0; i < 4; ++i) { const int c = tid + NTHR * i; *(u32x4*)(As + (c >> 3) * LDT + (c & 7) * 8) = ra[i]; }
#pragma unroll
      for (int i = 0; i < 2; ++i) { const int c = tid + NTHR * i; *(u32x4*)(Bs + (c >> 3) * LDT + (c & 7) * 8) = rb[i]; }
      __syncthreads();
      if (kt + 1 < nk) { const int k0 = (kt + 1) * 64;
#pragma unroll
        for (int i = 0; i < 4; ++i) { const int c = tid + NTHR * i; ra[i] = *(const u32x4*)(Ag + (size_t)(c >> 3) * g.lda + k0 + (c & 7) * 8); }
#pragma unroll
        for (int i = 0; i < 2; ++i) { const int c = tid + NTHR * i; rb[i] = *(const u32x4*)(Wg + (size_t)(c >> 3) * g.ldw + k0 + (c & 7) * 8); } }
#pragma unroll
      for (int ks = 0; ks < 2; ++ks) {
        bf16x8 af[4], wf[4];
#pragma unroll
        for (int i = 0; i < 4; ++i) af[i] = *(const bf16x8*)(As + (wm * 64 + i * 16 + l16) * LDT + ks * 32 + g4 * 8);
#pragma unroll
        for (int j = 0; j < 4; ++j) wf[j] = *(const bf16x8*)(Bs + (wn * 64 + j * 16 + l16) * LDT + ks * 32 + g4 * 8);
#pragma unroll
        for (int i = 0; i < 4; ++i)
#pragma unroll
          for (int j = 0; j < 4; ++j) acc[i][j] = TRANS ? mfma16(af[i], wf[j], acc[i][j]) : mfma16(wf[j], af[i], acc[i][j]);
      }
    }
    const int mb = pm * 256 + wm * 64, nb = pn * 128 + wn * 64;
    if constexpr (Epi::PAIR) {
#pragma unroll
      for (int i = 0; i < 4; ++i)
#pragma unroll
        for (int j = 0; j < 2; ++j) epi.pair(mb + i * 16 + l16, (nb >> 1) + 16 * j + 4 * g4, acc[i][2 * j], acc[i][2 * j + 1]);
    } else {
#pragma unroll
      for (int i = 0; i < 4; ++i)
#pragma unroll
        for (int j = 0; j < 4; ++j) { if (TRANS) epi(mb + i * 16 + 4 * g4, nb + j * 16 + l16, acc[i][j]); else epi(mb + i * 16 + l16, nb + j * 16 + 4 * g4, acc[i][j]); }
    }
  }
}
DI void st4bf(bf16_t* p, f32x4 v) { u32x2 o; o.x = pk2(v[0], v[1]); o.y = pk2(v[2], v[3]); *(u32x2*)p = o; }
struct EpiStore { static constexpr bool PAIR = false; bf16_t* d0; bf16_t* d1; int split, ld0, ld1; float s0;
  DI void operator()(int m, int n, f32x4 v) const { if (n < split) st4bf(d0 + (size_t)m * ld0 + n, v * s0); else st4bf(d1 + (size_t)m * ld1 + (n - split), v); } };
struct EpiVT { static constexpr bool PAIR = false; bf16_t* vt; const float* rs;
  DI void operator()(int m, int n, f32x4 v) const { const int b = m / PB, pos = m - b * PB;
    if (rs) { v[0] *= rs[2 * m + 1]; v[1] *= rs[2 * m + 3]; v[2] *= rs[2 * m + 5]; v[3] *= rs[2 * m + 7]; }
    st4bf(vt + ((size_t)(b * 1024 + n)) * PB + pos, v); } };
struct EpiResid { static constexpr bool PAIR = false; const float* slat; const float* sctx; float* dlat; float* dctx; const float* gate;
  DI void operator()(int m, int n, f32x4 v) const { const int mv = modvec(m); const f32x4 hv = *(const f32x4*)(hrowc(slat, sctx, m) + n); const f32x4 gt = *(const f32x4*)(gate + (size_t)mv * 6144 + n);
    *(f32x4*)(hrow(dlat, dctx, m) + n) = ALPHA * hv + gt * v; } };
struct EpiSwiglu { static constexpr bool PAIR = true; bf16_t* u;
  DI void pair(int m, int f, f32x4 gt, f32x4 up) const { f32x4 r; r[0] = siluf(gt[0]) * up[0]; r[1] = siluf(gt[1]) * up[1]; r[2] = siluf(gt[2]) * up[2]; r[3] = siluf(gt[3]) * up[3]; st4bf(u + (size_t)m * FF + f, r); } };
struct EpiRetQK { static constexpr bool PAIR = false; bf16_t* qk; const float2* tabR;
  DI void operator()(int m, int n, f32x4 v) const { const int b = m / PB, pp = m - b * PB;
    if (pp >= LC) { const int pos = pp - LC, row = pos >> 6, col = pos & 63; const int j0 = (n & 255) >> 1;
      const int vv = j0 < 64 ? row : col; const float2 c0 = tabR[vv * 64 + (j0 & 63)], c1 = tabR[vv * 64 + ((j0 + 1) & 63)];
      const float a0 = v[0] * c0.x - v[1] * c0.y, b0 = v[0] * c0.y + v[1] * c0.x, a1 = v[2] * c1.x - v[3] * c1.y, b1 = v[2] * c1.y + v[3] * c1.x; v = (f32x4){a0, b0, a1, b1}; }
    if (n >= 1024) v = v * 0.0625f;
    st4bf(qk + (size_t)m * 2048 + n, v); } };
struct EpiHg { static constexpr bool PAIR = false; bf16_t* ph;
  DI void operator()(int m, int n, f32x4 v) const { if (n < 1024) { v[0] = siluf(v[0]); v[1] = siluf(v[1]); v[2] = siluf(v[2]); v[3] = siluf(v[3]); v = v * 0.08838834764831845f; } st4bf(ph + (size_t)m * 5120 + n, v); } };
struct EpiMlaQ { static constexpr bool PAIR = false; bf16_t* q; const float* rs; const float2* tabM;
  DI void operator()(int m, int n, f32x4 v) const { v = v * (rs[2 * m] * 0.10206207261596577f * LOG2E); const int h = n / 96, w = n - h * 96; const int b = m / PB, pp = m - b * PB;
    if (w >= 64 && pp >= LC) { const int pos = pp - LC, row = pos >> 6, col = pos & 63; const int j0 = (w - 64) >> 1; const int vv = j0 < 8 ? row : col; const float2 c0 = tabM[vv * 8 + (j0 & 7)], c1 = tabM[vv * 8 + ((j0 + 1) & 7)];
      const float a0 = v[0] * c0.x - v[1] * c0.y, b0 = v[0] * c0.y + v[1] * c0.x, a1 = v[2] * c1.x - v[3] * c1.y, b1 = v[2] * c1.y + v[3] * c1.x; v = (f32x4){a0, b0, a1, b1}; }
    st4bf(q + (size_t)m * 1536 + n, v); } };
struct EpiMlaK { static constexpr bool PAIR = false; bf16_t* k; const float* rs;
  DI void operator()(int m, int n, f32x4 v) const { v = v * rs[2 * m + 1]; st4bf(k + (size_t)m * 1536 + (n >> 6) * 96 + (n & 63), v); } };

DI void mla_stats_phase(const Params& p) {
  const bf16_t* d0 = (const bf16_t*)(p.ws + M_D0); bf16_t* km = (bf16_t*)(p.ws + M_K); float* rs = (float*)(p.ws + OFF_RS); const float2* tabM = (const float2*)(p.ws + OFF_TABM);
  const int lane = threadIdx.x & 63, gw = blockIdx.x * 8 + (threadIdx.x >> 6), nw = gridDim.x * 8;
  for (int t = gw; t < T_ALL; t += nw) {
    const bf16_t* r = d0 + (size_t)t * 896;
    const u32x4 a = *(const u32x4*)(r + lane * 8); const u32x2 c = *(const u32x2*)(r + 512 + lane * 4);
    float sq = bflo(a.x) * bflo(a.x) + bfhi(a.x) * bfhi(a.x) + bflo(a.y) * bflo(a.y) + bfhi(a.y) * bfhi(a.y) + bflo(a.z) * bflo(a.z) + bfhi(a.z) * bfhi(a.z) + bflo(a.w) * bflo(a.w) + bfhi(a.w) * bfhi(a.w);
    float sk = bflo(c.x) * bflo(c.x) + bfhi(c.x) * bfhi(c.x) + bflo(c.y) * bflo(c.y) + bfhi(c.y) * bfhi(c.y);
#pragma unroll
    for (int o = 1; o < 64; o <<= 1) { sq += __shfl_xor(sq, o); sk += __shfl_xor(sk, o); }
    if (lane == 0) { rs[2 * t] = rsqrtf(sq * (1.f / 512.f) + 1e-6f); rs[2 * t + 1] = rsqrtf(sk * (1.f / 256.f) + 1e-6f); }
    if (lane < 16) { const int j = lane; float x1 = bf2f(r[768 + j]), x2 = bf2f(r[768 + 16 + j]); const int b = t / PB, pp = t - b * PB;
      if (pp >= LC) { const int pos = pp - LC, row = pos >> 6, col = pos & 63; const float2 cs = tabM[(j < 8 ? row : col) * 8 + (j & 7)]; const float o1 = x1 * cs.x - x2 * cs.y, o2 = x1 * cs.y + x2 * cs.x; x1 = o1; x2 = o2; }
      const unsigned pr = pk2(x1, x2);
#pragma unroll
      for (int h = 0; h < 16; ++h) *(unsigned*)(km + (size_t)t * 1536 + h * 96 + 64 + 2 * j) = pr; }
  }
}

constexpr int KLD = 104, VLD = 72;
DI void mla_attn_phase(const Params& p, char* lds) {
  const bf16_t* Qm = (const bf16_t*)(p.ws + M_Q); const bf16_t* Km = (const bf16_t*)(p.ws + M_K); const bf16_t* vT = (const bf16_t*)(p.ws + M_VT); bf16_t* o = (bf16_t*)(p.ws + OFF_A);
  const int tid = threadIdx.x, lane = tid & 63, w = tid >> 6, c = lane & 31, hh = lane >> 5;
  bf16_t* Ks = (bf16_t*)lds; bf16_t* Vs = Ks + 2 * 64 * KLD;
  for (int item = blockIdx.x; item < 2048 + 64; item += gridDim.x) {
    int b, h, qbase, nkt;
    if (item < 2048) { b = item >> 9; h = (item >> 5) & 15; qbase = LC + (item & 31) * 256; nkt = 132; } else { const int it = item - 2048; b = it >> 4; h = it & 15; qbase = 0; nkt = 4; }
    const size_t tokbase = (size_t)b * PB;
    const bf16_t* qp = Qm + (tokbase + qbase + w * 32 + c) * 1536 + h * 96 + hh * 8;
    bf16x8 qf[6];
#pragma unroll
    for (int ks = 0; ks < 6; ++ks) qf[ks] = *(const bf16x8*)(qp + ks * 16);
    const bf16_t* kg = Km + tokbase * 1536 + h * 96; const bf16_t* vg = vT + (size_t)(b * 16 + h) * 64 * PB;
    const int kr0 = tid / 12, kc0 = tid - kr0 * 12, e1 = tid + NTHR, kr1 = e1 / 12, kc1 = e1 - kr1 * 12; const bool k1ok = e1 < 768; const int vd = tid >> 3, vc = tid & 7;
    u32x4 rk0, rk1 = (u32x4){0, 0, 0, 0}, rv;
    rk0 = *(const u32x4*)(kg + (size_t)kr0 * 1536 + kc0 * 8); if (k1ok) rk1 = *(const u32x4*)(kg + (size_t)kr1 * 1536 + kc1 * 8); rv = *(const u32x4*)(vg + (size_t)vd * PB + vc * 8);
    __syncthreads();
    *(u32x4*)(Ks + kr0 * KLD + kc0 * 8) = rk0; if (k1ok) *(u32x4*)(Ks + kr1 * KLD + kc1 * 8) = rk1; *(u32x4*)(Vs + vd * VLD + vc * 8) = rv;
    __syncthreads();
    f32x16 oacc[2];
#pragma unroll
    for (int i = 0; i < 16; ++i) { oacc[0][i] = 0.f; oacc[1][i] = 0.f; }
    float mrow = -1e30f, lsum = 0.f;
    for (int kt = 0; kt < nkt; ++kt) {
      const int cur = kt & 1;
      if (kt + 1 < nkt) { const size_t key0 = (size_t)(kt + 1) * 64;
        rk0 = *(const u32x4*)(kg + (key0 + kr0) * 1536 + kc0 * 8); if (k1ok) rk1 = *(const u32x4*)(kg + (key0 + kr1) * 1536 + kc1 * 8); rv = *(const u32x4*)(vg + (size_t)vd * PB + key0 + vc * 8); }
      const bf16_t* Kc = Ks + cur * 64 * KLD; const bf16_t* Vc = Vs + cur * 64 * VLD;
      f32x16 sacc[2];
#pragma unroll
      for (int j = 0; j < 2; ++j) {
#pragma unroll
        for (int i = 0; i < 16; ++i) sacc[j][i] = 0.f;
#pragma unroll
        for (int ks = 0; ks < 6; ++ks) { const bf16x8 kf = *(const bf16x8*)(Kc + (32 * j + c) * KLD + ks * 16 + hh * 8); sacc[j] = mfma32(kf, qf[ks], sacc[j]); }
      }
      float mx = sacc[0][0];
#pragma unroll
      for (int j = 0; j < 2; ++j)
#pragma unroll
        for (int i = 0; i < 16; ++i) mx = fmaxf(mx, sacc[j][i]);
      mx = fmaxf(mx, __shfl_xor(mx, 32));
      const float mnew = fmaxf(mrow, mx), alpha = __builtin_amdgcn_exp2f(mrow - mnew); mrow = mnew;
      float ps = 0.f;
#pragma unroll
      for (int j = 0; j < 2; ++j)
#pragma unroll
        for (int i = 0; i < 16; ++i) { sacc[j][i] = __builtin_amdgcn_exp2f(sacc[j][i] - mnew); ps += sacc[j][i]; }
      lsum = lsum * alpha + ps;
#pragma unroll
      for (int i = 0; i < 16; ++i) { oacc[0][i] *= alpha; oacc[1][i] *= alpha; }
#pragma unroll
      for (int j = 0; j < 2; ++j)
#pragma unroll
        for (int s = 0; s < 2; ++s) {
          const bf16x8 pf = pack8(sacc[j][8 * s], sacc[j][8 * s + 1], sacc[j][8 * s + 2], sacc[j][8 * s + 3], sacc[j][8 * s + 4], sacc[j][8 * s + 5], sacc[j][8 * s + 6], sacc[j][8 * s + 7]);
#pragma unroll
          for (int dt = 0; dt < 2; ++dt) { const bf16_t* vp = Vc + (32 * dt + c) * VLD + 32 * j + 16 * s + 4 * hh;
            const bf16x8 vf = cat44(*(const s16x4*)vp, *(const s16x4*)(vp + 8)); oacc[dt] = mfma32(vf, pf, oacc[dt]); }
        }
      if (kt + 1 < nkt) { bf16_t* Kn = Ks + (cur ^ 1) * 64 * KLD; bf16_t* Vn = Vs + (cur ^ 1) * 64 * VLD;
        *(u32x4*)(Kn + kr0 * KLD + kc0 * 8) = rk0; if (k1ok) *(u32x4*)(Kn + kr1 * KLD + kc1 * 8) = rk1; *(u32x4*)(Vn + vd * VLD + vc * 8) = rv; }
      __syncthreads();
    }
    lsum += __shfl_xor(lsum, 32); const float inv = 1.f / lsum;
    bf16_t* op = o + (tokbase + qbase + w * 32 + c) * 1024 + h * 64 + 4 * hh;
#pragma unroll
    for (int dt = 0; dt < 2; ++dt)
#pragma unroll
      for (int rg = 0; rg < 4; ++rg) st4bf(op + 32 * dt + 8 * rg, (f32x4){oacc[dt][4 * rg] * inv, oacc[dt][4 * rg + 1] * inv, oacc[dt][4 * rg + 2] * inv, oacc[dt][4 * rg + 3] * inv});
  }
}

template <bool CTX>
DI void na_wave(const bf16_t* __restrict__ Q, const bf16_t* __restrict__ K, const bf16_t* __restrict__ vT, bf16_t* __restrict__ o, const float* rpb  , int b, int h, int r, int n, int lane) {
  constexpr int NT = CTX ? 16 : 32;
  const int g = lane >> 4, l16 = lane & 15; const size_t tokbase = (size_t)b * PB;
  const int qpos = CTX ? (n * 16 + l16) : (LC + r * 64 + n * 16 + l16);
  const int rs = clampi(r - 4, 0, 120), band0 = clampi(16 * n - 8, 0, 32);
  const bf16_t* qp = Q + (tokbase + qpos) * 1024 + h * 64 + g * 8;
  const bf16x8 q0 = *(const bf16x8*)qp, q1 = *(const bf16x8*)(qp + 32);
  f32x4 S[NT];
#pragma unroll
  for (int kt = 0; kt < NT; ++kt) {
    int kpos;
    if (!CTX && kt < 16) kpos = LC + (rs + (kt >> 1)) * 64 + band0 + 16 * (kt & 1) + l16; else kpos = 16 * (CTX ? kt : kt - 16) + l16;
    const bf16_t* kp = K + (tokbase + kpos) * 1024 + h * 64 + g * 8;
    f32x4 s = mfma16(*(const bf16x8*)kp, q0, (f32x4){0.f, 0.f, 0.f, 0.f}); s = mfma16(*(const bf16x8*)(kp + 32), q1, s);
    if (!CTX && kt < 16) { const int qcol = 16 * n + l16, wstart = clampi(qcol - 8, 0, 48); const float* bp = rpb + (rs + (kt >> 1) - r + 7) * 31;
#pragma unroll
      for (int rr = 0; rr < 4; ++rr) { const int kcol = band0 + 16 * (kt & 1) + 4 * g + rr; const bool ok = kcol >= wstart && kcol < wstart + 16;
        s[rr] = ok ? (s[rr] + bp[clampi(kcol - qcol + 15, 0, 30)]) * LOG2E : -1e30f; } }
    else s = s * LOG2E;
    S[kt] = s;
  }
  float mx = S[0][0];
#pragma unroll
  for (int kt = 0; kt < NT; ++kt) mx = fmaxf(fmaxf(fmaxf(mx, S[kt][0]), fmaxf(S[kt][1], S[kt][2])), S[kt][3]);
  mx = fmaxf(mx, __shfl_xor(mx, 16)); mx = fmaxf(mx, __shfl_xor(mx, 32));
  float ls = 0.f;
#pragma unroll
  for (int kt = 0; kt < NT; ++kt)
#pragma unroll
    for (int rr = 0; rr < 4; ++rr) { S[kt][rr] = __builtin_amdgcn_exp2f(S[kt][rr] - mx); ls += S[kt][rr]; }
  ls += __shfl_xor(ls, 16); ls += __shfl_xor(ls, 32);
  f32x4 O[4];
#pragma unroll
  for (int dt = 0; dt < 4; ++dt) O[dt] = (f32x4){0.f, 0.f, 0.f, 0.f};
  const bf16_t* vb = vT + ((size_t)(b * 16 + h) * 64 + l16) * PB;
#pragma unroll
  for (int kk = 0; kk < NT / 2; ++kk) {
    int pos0;
    if (!CTX && kk < 8) pos0 = LC + (rs + kk) * 64 + band0 + 4 * g; else pos0 = 32 * (CTX ? kk : kk - 8) + 4 * g;
    const bf16x8 pf = pack8(S[2 * kk][0], S[2 * kk][1], S[2 * kk][2], S[2 * kk][3], S[2 * kk + 1][0], S[2 * kk + 1][1], S[2 * kk + 1][2], S[2 * kk + 1][3]);
#pragma unroll
    for (int dt = 0; dt < 4; ++dt) { const bf16_t* vp = vb + (size_t)(dt * 16) * PB + pos0; const bf16x8 vf = cat44(*(const s16x4*)vp, *(const s16x4*)(vp + 16)); O[dt] = mfma16(vf, pf, O[dt]); }
  }
  const float inv = 1.f / ls; bf16_t* op = o + (tokbase + qpos) * 1024 + h * 64 + 4 * g;
#pragma unroll
  for (int dt = 0; dt < 4; ++dt) st4bf(op + 16 * dt, O[dt] * inv);
}
DI void na_attn_phase(const Params& p, char* lds) {
  const bf16_t* Q = (const bf16_t*)(p.ws + N_Q); const bf16_t* K = (const bf16_t*)(p.ws + N_K); const bf16_t* vT = (const bf16_t*)(p.ws + N_VT); bf16_t* o = (bf16_t*)(p.ws + OFF_A);
  float* rl = (float*)lds; const int tid = threadIdx.x, lane = tid & 63, w = tid >> 6;
  __syncthreads();
  for (int e = tid; e < 16 * 465; e += NTHR) rl[e] = p.na_rpb[e];
  __syncthreads();
  for (int item = blockIdx.x; item < 4096 + 128; item += gridDim.x) {
    if (item < 4096) { const int hhf = item & 1, n = (item >> 1) & 3, r = (item >> 3) & 127, b = item >> 10; const int h = hhf * 8 + w; na_wave<false>(Q, K, vT, o, rl + h * 465, b, h, r, n, lane); }
    else { const int it = item - 4096; const int hhf = it & 1, qb = (it >> 1) & 15, b = it >> 5; const int h = hhf * 8 + w; na_wave<true>(Q, K, vT, o, rl + h * 465, b, h, 0, qb, lane); }
  }
}

template <int DK> struct ScanLds { static constexpr int QLD = DK + 8, TLD = 72;
  static constexpr int OFF_QD = 0, OFF_KD = OFF_QD + 64 * QLD * 2, OFF_VT = OFF_KD + 64 * QLD * 2, OFF_ATT = OFF_VT + 64 * TLD * 2, OFF_ST = OFF_ATT + 64 * TLD * 2, OFF_EB = OFF_ST + 64 * QLD * 2, OFF_QS = OFF_EB + DK * 4, TOTAL = OFF_QS + 4 * DK * 4; };
DI int scan_pos(int dir, int i, int tl) { if (dir == 0) return i * 64 + tl; return i < 4 ? 255 - (i * 64 + tl) : 8447 - ((i - 4) * 64 + tl); }
DI bf16x8 gather8(const bf16_t* p, int stride) {
  const unsigned a0 = p[0], a1 = p[stride], a2 = p[2 * stride], a3 = p[3 * stride], a4 = p[4 * stride], a5 = p[5 * stride], a6 = p[6 * stride], a7 = p[7 * stride];
  u32x4 r; r.x = a0 | (a1 << 16); r.y = a2 | (a3 << 16); r.z = a4 | (a5 << 16); r.w = a6 | (a7 << 16); return __builtin_bit_cast(bf16x8, r);
}

template <int DK, bool HG>
DI void scan_phase(const Params& p, char* lds) {
  typedef ScanLds<DK> L;
  bf16_t* Qd = (bf16_t*)(lds + L::OFF_QD); bf16_t* Kd = (bf16_t*)(lds + L::OFF_KD); bf16_t* Vt = (bf16_t*)(lds + L::OFF_VT);
  bf16_t* Att = (bf16_t*)(lds + L::OFF_ATT); bf16_t* St = (bf16_t*)(lds + L::OFF_ST); float* eb = (float*)(lds + L::OFF_EB); float* qs = (float*)(lds + L::OFF_QS);
  constexpr int QLD = L::QLD, TLD = L::TLD, KT = DK / 16 / 8;
  const int tid = threadIdx.x, lane = tid & 63, w = tid >> 6, g4 = lane >> 4, l16 = lane & 15;
  const int nitems = HG ? 128 : 256;
  const float* lbv = (const float*)(p.ws + OFF_LBV);
  for (int item = blockIdx.x; item < nitems; item += gridDim.x) {
    int b, h, sl, dir; if (HG) { sl = item & 1; h = (item >> 1) & 7; b = (item >> 4) & 3; dir = item >> 6; } else { sl = item & 7; h = (item >> 3) & 3; b = (item >> 5) & 3; dir = item >> 7; }
    const size_t tokbase = (size_t)b * PB;
    const bf16_t *qsrc, *ksrc, *vsrc; int ldq, ldv; bf16_t *octx, *olat; int ldo;
    if (HG) { const bf16_t* ph = (const bf16_t*)(p.ws + H_P); qsrc = ph + h * 128; ksrc = ph + 1024 + dir * 1024 + h * 128; vsrc = ph + 3072 + h * 128 + sl * 64; ldq = 5120; ldv = 5120; ldo = 1024;
      octx = (bf16_t*)(p.ws + (dir ? OFF_W0 : OFF_A)) + tokbase * 1024 + h * 128 + sl * 64; olat = octx + (size_t)LC * 1024; }
    else { const bf16_t* qk = (const bf16_t*)(p.ws + R_QK); qsrc = qk + h * 256; ksrc = qk + 1024 + h * 256; vsrc = (const bf16_t*)(p.ws + R_V) + h * 512 + sl * 64; ldq = 2048; ldv = 2048; ldo = 2048;
      if (dir == 0) { octx = (bf16_t*)(p.ws + R_O) + tokbase * 2048 + h * 512 + sl * 64; olat = octx + (size_t)LC * 2048; }
      else { octx = (bf16_t*)(p.ws + OFF_HCTX) + (size_t)b * LC * 2048 + h * 512 + sl * 64; olat = (bf16_t*)p.out + (size_t)b * LL * 2048 + h * 512 + sl * 64; } }
    float lg = 0.f; if (!HG) lg = -__expf(p.ret_decay[dir * 4 + h]);
    float lb = 0.f; if (HG) lb = lbv[h * 128 + (tid & 127)];
    f32x4 sacc[KT][4];
#pragma unroll
    for (int a = 0; a < KT; ++a)
#pragma unroll
      for (int v = 0; v < 4; ++v) sacc[a][v] = (f32x4){0.f, 0.f, 0.f, 0.f};
    u32x4 rq[4], rk[4], rvv; unsigned short rf[16], rqq[16]; float bl[16], qv[16], kv[16];
    const int vtl = tid & 63, vvc = tid >> 6;
    auto issue = [&](int i) {
      if (HG) { const int k = tid & 127, qt = tid >> 7;
#pragma unroll
        for (int j = 0; j < 16; ++j) { const size_t row = tokbase + scan_pos(dir, i, qt * 16 + j); rf[j] = ksrc[row * ldq + k]; rqq[j] = qsrc[row * ldq + k]; } }
      else {
#pragma unroll
        for (int it = 0; it < 4; ++it) { const int e = tid + NTHR * it, tl = e >> 5, kc = e & 31; const size_t row = tokbase + scan_pos(dir, i, tl); rq[it] = *(const u32x4*)(qsrc + row * ldq + kc * 8); rk[it] = *(const u32x4*)(ksrc + row * ldq + kc * 8); } }
      { const size_t row = tokbase + scan_pos(dir, i, vtl); rvv = *(const u32x4*)(vsrc + row * ldv + vvc * 8); }
    };
    auto prep = [&]() {
      const int k = tid & 127, qt = tid >> 7; float run = 0.f;
#pragma unroll
      for (int j = 0; j < 16; ++j) { const float f = bf2f(rf[j]); qv[j] = bf2f(rqq[j]); const float sg = 1.f / (1.f + __expf(-f)); const float fg = lb + (1.f - lb) * sg; kv[j] = 1.f - fg; run += __logf(fg); bl[j] = run; }
      qs[qt * DK + k] = run;
    };
    __syncthreads();
    issue(0); if (HG) prep();
    __syncthreads();
    for (int i = 0; i < 132; ++i) {
      if (HG) { const int k = tid & 127, qt = tid >> 7; float off = 0.f;
#pragma unroll
        for (int q = 0; q < 3; ++q) if (q < qt) off += qs[q * DK + k];
        if (qt == 3) eb[k] = __expf(off + bl[15]);
#pragma unroll
        for (int j = 0; j < 16; ++j) { const int tl = qt * 16 + j; const float bb = bl[j] + off; Qd[tl * QLD + k] = f2bf(qv[j] * __expf(bb)); Kd[tl * QLD + k] = f2bf(kv[j] * __expf(-bb)); } }
      else {
        if (tid < DK) eb[tid] = __expf(64.f * lg);
#pragma unroll
        for (int it = 0; it < 4; ++it) { const int e = tid + NTHR * it, tl = e >> 5, kc = e & 31; const u32x4 qr = rq[it], kr = rk[it];
          const float eq = __expf((float)(tl + 1) * lg), ek = __expf(-(float)(tl + 1) * lg);
          u32x4 qo, ko; qo.x = pk2(bflo(qr.x) * eq, bfhi(qr.x) * eq); qo.y = pk2(bflo(qr.y) * eq, bfhi(qr.y) * eq); qo.z = pk2(bflo(qr.z) * eq, bfhi(qr.z) * eq); qo.w = pk2(bflo(qr.w) * eq, bfhi(qr.w) * eq);
          ko.x = pk2(bflo(kr.x) * ek, bfhi(kr.x) * ek); ko.y = pk2(bflo(kr.y) * ek, bfhi(kr.y) * ek); ko.z = pk2(bflo(kr.z) * ek, bfhi(kr.z) * ek); ko.w = pk2(bflo(kr.w) * ek, bfhi(kr.w) * ek);
          *(u32x4*)(Qd + tl * QLD + kc * 8) = qo; *(u32x4*)(Kd + tl * QLD + kc * 8) = ko; } }
      { bf16_t* vt = Vt + (vvc * 8) * TLD + vtl; const u32x4 vr = rvv;
        vt[0] = (bf16_t)(vr.x & 0xffff); vt[TLD] = (bf16_t)(vr.x >> 16); vt[2 * TLD] = (bf16_t)(vr.y & 0xffff); vt[3 * TLD] = (bf16_t)(vr.y >> 16);
        vt[4 * TLD] = (bf16_t)(vr.z & 0xffff); vt[5 * TLD] = (bf16_t)(vr.z >> 16); vt[6 * TLD] = (bf16_t)(vr.w & 0xffff); vt[7 * TLD] = (bf16_t)(vr.w >> 16); }
#pragma unroll
      for (int a = 0; a < KT; ++a) { const int ki = w * KT + a;
#pragma unroll
        for (int vi = 0; vi < 4; ++vi) st4bf(St + (16 * vi + l16) * QLD + 16 * ki + 4 * g4, sacc[a][vi]); }
      __syncthreads();
      if (i + 1 < 132) issue(i + 1);
#pragma unroll
      for (int u = 0; u < 2; ++u) { const int id = 2 * w + u, ti = id >> 2, si = id & 3; f32x4 d = (f32x4){0.f, 0.f, 0.f, 0.f};
        if (si <= ti) {
#pragma unroll
          for (int ks = 0; ks < DK / 32; ++ks) { const bf16x8 kf = *(const bf16x8*)(Kd + (16 * si + l16) * QLD + ks * 32 + g4 * 8), qf = *(const bf16x8*)(Qd + (16 * ti + l16) * QLD + ks * 32 + g4 * 8); d = mfma16(kf, qf, d); } }
        const int t = 16 * ti + l16, s0 = 16 * si + 4 * g4;
#pragma unroll
        for (int rr = 0; rr < 4; ++rr) if (s0 + rr > t) d[rr] = 0.f;
        st4bf(Att + t * TLD + s0, d); }
      __syncthreads();
#pragma unroll
      for (int u = 0; u < 2; ++u) { const int id = 2 * w + u, vi = id >> 2, ti = id & 3; f32x4 d = (f32x4){0.f, 0.f, 0.f, 0.f};
#pragma unroll
        for (int ks = 0; ks < 2; ++ks) { const bf16x8 xf = *(const bf16x8*)(Vt + (16 * vi + l16) * TLD + ks * 32 + g4 * 8), yf = *(const bf16x8*)(Att + (16 * ti + l16) * TLD + ks * 32 + g4 * 8); d = mfma16(xf, yf, d); }
#pragma unroll
        for (int ks = 0; ks < DK / 32; ++ks) { const bf16x8 xf = *(const bf16x8*)(St + (16 * vi + l16) * QLD + ks * 32 + g4 * 8), yf = *(const bf16x8*)(Qd + (16 * ti + l16) * QLD + ks * 32 + g4 * 8); d = mfma16(xf, yf, d); }
        const int pos = scan_pos(dir, i, 16 * ti + l16); bf16_t* op = (pos < LC ? octx + (size_t)pos * ldo : olat + (size_t)(pos - LC) * ldo) + 16 * vi + 4 * g4;
        st4bf(op, d); }
#pragma unroll
      for (int a = 0; a < KT; ++a) { const int ki = w * KT + a;
#pragma unroll
        for (int ks = 0; ks < 2; ++ks) { const bf16x8 xf = gather8(Kd + (ks * 32 + g4 * 8) * QLD + 16 * ki + l16, QLD);
#pragma unroll
          for (int vi = 0; vi < 4; ++vi) { const bf16x8 yf = *(const bf16x8*)(Vt + (16 * vi + l16) * TLD + ks * 32 + g4 * 8); sacc[a][vi] = mfma16(xf, yf, sacc[a][vi]); } }
        const f32x4 e4 = *(const f32x4*)(eb + 16 * ki + 4 * g4);
#pragma unroll
        for (int vi = 0; vi < 4; ++vi) sacc[a][vi] = sacc[a][vi] * e4; }
      if (HG && i + 1 < 132) prep();
      __syncthreads();
    }
  }
}

DI float bsum2(unsigned a, unsigned b, float& lo, float& hi) { lo = bflo(a) + bflo(b); hi = bfhi(a) + bfhi(b); return lo * lo + hi * hi; }
DI void ret_readout_phase(const Params& p) {
  bf16_t* O = (bf16_t*)(p.ws + R_O); const bf16_t* G = (const bf16_t*)(p.ws + R_QK);
  const int lane = threadIdx.x & 63, gw = blockIdx.x * 8 + (threadIdx.x >> 6), nw = gridDim.x * 8;
  for (int t = gw; t < T_ALL; t += nw) {
    const int b = t / PB, pp = t - b * PB;
    const bf16_t* ob = (pp < LC ? (const bf16_t*)(p.ws + OFF_HCTX) + (size_t)(b * LC + pp) * 2048 : (const bf16_t*)p.out + (size_t)(b * LL + pp - LC) * 2048) + lane * 32;
    bf16_t* op = O + (size_t)t * 2048 + lane * 32; const bf16_t* gp = G + (size_t)t * 2048 + lane * 32;
    float ov[32]; u32x4 gv[4]; float sq = 0.f;
#pragma unroll
    for (int i = 0; i < 4; ++i) { const u32x4 x = *(const u32x4*)(op + i * 8), y = *(const u32x4*)(ob + i * 8); gv[i] = *(const u32x4*)(gp + i * 8);
      sq += bsum2(x.x, y.x, ov[8 * i], ov[8 * i + 1]) + bsum2(x.y, y.y, ov[8 * i + 2], ov[8 * i + 3]) + bsum2(x.z, y.z, ov[8 * i + 4], ov[8 * i + 5]) + bsum2(x.w, y.w, ov[8 * i + 6], ov[8 * i + 7]); }
    sq += __shfl_xor(sq, 1); sq += __shfl_xor(sq, 2); sq += __shfl_xor(sq, 4); sq += __shfl_xor(sq, 8);
    const float rstd = rsqrtf(sq * (1.f / 512.f) + 1e-6f);
#pragma unroll
    for (int i = 0; i < 4; ++i) { u32x4 r;
      r.x = pk2(siluf(bflo(gv[i].x)) * ov[8 * i] * rstd, siluf(bfhi(gv[i].x)) * ov[8 * i + 1] * rstd); r.y = pk2(siluf(bflo(gv[i].y)) * ov[8 * i + 2] * rstd, siluf(bfhi(gv[i].y)) * ov[8 * i + 3] * rstd);
      r.z = pk2(siluf(bflo(gv[i].z)) * ov[8 * i + 4] * rstd, siluf(bfhi(gv[i].z)) * ov[8 * i + 5] * rstd); r.w = pk2(siluf(bflo(gv[i].w)) * ov[8 * i + 6] * rstd, siluf(bfhi(gv[i].w)) * ov[8 * i + 7] * rstd);
      *(u32x4*)(op + i * 8) = r; }
  }
}
DI void hg_readout_phase(const Params& p) {
  bf16_t* O = (bf16_t*)(p.ws + OFF_A); const bf16_t* OB = (const bf16_t*)(p.ws + OFF_W0); const bf16_t* ph = (const bf16_t*)(p.ws + H_P);
  const int lane = threadIdx.x & 63, gw = blockIdx.x * 8 + (threadIdx.x >> 6), nw = gridDim.x * 8;
  for (int t = gw; t < T_ALL; t += nw) {
    bf16_t* op = O + (size_t)t * 1024 + lane * 16; const bf16_t* ob = OB + (size_t)t * 1024 + lane * 16; const bf16_t* gp = ph + (size_t)t * 5120 + 4096 + lane * 16; const float* ng = p.hg_norm_g + (lane & 7) * 16;
    float ov[16]; u32x4 gv[2]; float sq = 0.f;
#pragma unroll
    for (int i = 0; i < 2; ++i) { const u32x4 x = *(const u32x4*)(op + i * 8), y = *(const u32x4*)(ob + i * 8); gv[i] = *(const u32x4*)(gp + i * 8);
      sq += bsum2(x.x, y.x, ov[8 * i], ov[8 * i + 1]) + bsum2(x.y, y.y, ov[8 * i + 2], ov[8 * i + 3]) + bsum2(x.z, y.z, ov[8 * i + 4], ov[8 * i + 5]) + bsum2(x.w, y.w, ov[8 * i + 6], ov[8 * i + 7]); }
    sq += __shfl_xor(sq, 1); sq += __shfl_xor(sq, 2); sq += __shfl_xor(sq, 4);
    const float rstd = rsqrtf(sq * (1.f / 128.f) + 1e-6f);
#pragma unroll
    for (int i = 0; i < 2; ++i) { u32x4 r; const float* n8 = ng + i * 8;
      r.x = pk2(siluf(bflo(gv[i].x)) * ov[8 * i] * rstd * n8[0], siluf(bfhi(gv[i].x)) * ov[8 * i + 1] * rstd * n8[1]); r.y = pk2(siluf(bflo(gv[i].y)) * ov[8 * i + 2] * rstd * n8[2], siluf(bfhi(gv[i].y)) * ov[8 * i + 3] * rstd * n8[3]);
      r.z = pk2(siluf(bflo(gv[i].z)) * ov[8 * i + 4] * rstd * n8[4], siluf(bfhi(gv[i].z)) * ov[8 * i + 5] * rstd * n8[5]); r.w = pk2(siluf(bflo(gv[i].w)) * ov[8 * i + 6] * rstd * n8[6], siluf(bfhi(gv[i].w)) * ov[8 * i + 7] * rstd * n8[7]);
      *(u32x4*)(op + i * 8) = r; }
  }
}

constexpr int LDS_BYTES = ScanLds<256>::TOTAL;
static_assert(LDS_BYTES <= 163840, "LDS");
static_assert(LDS_BYTES >= (256 + 128) * LDT * 2 && LDS_BYTES >= 2 * 64 * (KLD + VLD) * 2 && LDS_BYTES >= (5120 + 8 * 5 * 64) * 4, "LDS phases");

DI void ffn_and_ln(const Params& p, cg::grid_group& grid, char* lds, int layer, const bf16_t* w13, const bf16_t* w2) {
  const float* mods = (const float*)(p.ws + OFF_MODS); float* hctx = (float*)(p.ws + OFF_HCTX); bf16_t* a = (bf16_t*)(p.ws + OFF_A); bf16_t* U = (bf16_t*)(p.ws + F_U);
  { GemmArgs g{a, 1024, w13, 1024, T_ALL, 5632, 1024}; EpiSwiglu e{U}; gemm_phase<false>(g, e, lds); }
  grid.sync();
  { GemmArgs g{U, FF, w2, FF, T_ALL, 1024, FF}; EpiResid e{p.out, hctx, p.out, hctx, mods + (size_t)layer * 5 * 6144 + 5 * 1024}; gemm_phase<false>(g, e, lds); }
  grid.sync();
  ln_phase(p, layer, 1, layer < 3 ? layer + 1 : 3, 0, layer < 3);
  grid.sync();
}

__global__ void __launch_bounds__(NTHR) mega(Params p) {
  __shared__ __attribute__((aligned(16))) char lds[LDS_BYTES];
  cg::grid_group grid = cg::this_grid();
  float* ldsf = (float*)lds;
  const float* mods = (const float*)(p.ws + OFF_MODS); float* hctx = (float*)(p.ws + OFF_HCTX); bf16_t* a = (bf16_t*)(p.ws + OFF_A);
  const float2* tabR = (const float2*)(p.ws + OFF_TABR); const float2* tabM = (const float2*)(p.ws + OFF_TABM); float* rs = (float*)(p.ws + OFF_RS);
  ada_phase(p, ldsf);
  tables_phase(p);
  convert_w<2>(p.ret_w_in, 6144, 1024, (bf16_t*)(p.ws + W0_RETIN), 6144, nullptr, ldsf);
  convert_w<0>(p.ret_w_out, 1024, 2048, (bf16_t*)(p.ws + W0_RETOUT), 1024, nullptr, ldsf);
  convert_w<1>(p.w13, 5632, 1024, (bf16_t*)(p.ws + W0_W13), 5632, nullptr, ldsf);
  convert_w<0>(p.w2, 1024, FF, (bf16_t*)(p.ws + W0_W2), 1024, nullptr, ldsf);
  grid.sync();
  modulate_phase(p, p.x, p.ctx, 0);
  grid.sync();
  { const bf16_t* wi = (const bf16_t*)(p.ws + W0_RETIN);
    { GemmArgs g{a, 1024, wi, 1024, T_ALL, 2048, 1024}; EpiRetQK e{(bf16_t*)(p.ws + R_QK), tabR}; gemm_phase<false>(g, e, lds); }
    { GemmArgs g{a, 1024, wi + (size_t)2048 * 1024, 1024, T_ALL, 2048, 1024}; EpiStore e{(bf16_t*)(p.ws + R_V), (bf16_t*)(p.ws + R_V), 1 << 30, 2048, 2048, 1.f}; gemm_phase<false>(g, e, lds); }
    grid.sync();
    scan_phase<256, false>(p, lds);
    grid.sync();
    { GemmArgs g{a, 1024, wi + (size_t)4096 * 1024, 1024, T_ALL, 2048, 1024}; EpiStore e{(bf16_t*)(p.ws + R_QK), (bf16_t*)(p.ws + R_QK), 1 << 30, 2048, 2048, 1.f}; gemm_phase<false>(g, e, lds); }
    grid.sync();
    ret_readout_phase(p);
    grid.sync();
    { GemmArgs g{(const bf16_t*)(p.ws + R_O), 2048, (const bf16_t*)(p.ws + W0_RETOUT), 2048, T_ALL, 1024, 2048}; EpiResid e{p.x, p.ctx, p.out, hctx, mods + 2 * 1024}; gemm_phase<false>(g, e, lds); }
    grid.sync();
    ln_phase(p, 0, 0, 0, 3, true);
    convert_w<0>(p.na_w_qkv, 3072, 1024, (bf16_t*)(p.ws + W1_QKV), 3072, nullptr, ldsf);
    convert_w<0>(p.na_w_out, 1024, 1024, (bf16_t*)(p.ws + W1_OUT), 1024, nullptr, ldsf);
    convert_w<1>(p.w13 + (size_t)1 * 1024 * 5632, 5632, 1024, (bf16_t*)(p.ws + W1_W13), 5632, nullptr, ldsf);
    convert_w<0>(p.w2 + (size_t)1 * FF * 1024, 1024, FF, (bf16_t*)(p.ws + W1_W2), 1024, nullptr, ldsf);
    convert_w<5>(p.mla_w_down, 800, 1024, (bf16_t*)(p.ws + W2_DOWN), 896, nullptr, ldsf);
    convert_w<3>(p.mla_w_uq, 1536, 512, (bf16_t*)(p.ws + W2_UQ), 1536, p.mla_q_norm, ldsf);
    convert_w<4>(p.mla_w_ukv, 2048, 256, (bf16_t*)(p.ws + W2_UKV), 2048, p.mla_kv_norm, ldsf);
    convert_w<0>(p.mla_w_out, 1024, 1024, (bf16_t*)(p.ws + W2_OUT), 1024, nullptr, ldsf);
    convert_w<1>(p.w13 + (size_t)2 * 1024 * 5632, 5632, 1024, (bf16_t*)(p.ws + W2_W13), 5632, nullptr, ldsf);
    convert_w<0>(p.w2 + (size_t)2 * FF * 1024, 1024, FF, (bf16_t*)(p.ws + W2_W2), 1024, nullptr, ldsf);
    convert_w<0>(p.hg_w_in, 5120, 1024, (bf16_t*)(p.ws + W3_IN), 5120, nullptr, ldsf);
    convert_w<0>(p.hg_w_out, 1024, 1024, (bf16_t*)(p.ws + W3_OUT), 1024, nullptr, ldsf);
    convert_w<1>(p.w13 + (size_t)3 * 1024 * 5632, 5632, 1024, (bf16_t*)(p.ws + W3_W13), 5632, nullptr, ldsf);
    convert_w<0>(p.w2 + (size_t)3 * FF * 1024, 1024, FF, (bf16_t*)(p.ws + W3_W2), 1024, nullptr, ldsf);
    grid.sync();
    ffn_and_ln(p, grid, lds, 0, (const bf16_t*)(p.ws + W0_W13), (const bf16_t*)(p.ws + W0_W2));
  }
  { const bf16_t* wq = (const bf16_t*)(p.ws + W1_QKV);
    { GemmArgs g{a, 1024, wq, 1024, T_ALL, 2048, 1024}; EpiStore e{(bf16_t*)(p.ws + N_Q), (bf16_t*)(p.ws + N_K), 1024, 1024, 1024, 0.125f}; gemm_phase<false>(g, e, lds); }
    { GemmArgs g{a, 1024, wq + (size_t)2048 * 1024, 1024, T_ALL, 1024, 1024}; EpiVT e{(bf16_t*)(p.ws + N_VT), nullptr}; gemm_phase<true>(g, e, lds); }
    grid.sync();
    na_attn_phase(p, lds);
    grid.sync();
    { GemmArgs g{a, 1024, (const bf16_t*)(p.ws + W1_OUT), 1024, T_ALL, 1024, 1024}; EpiResid e{p.out, hctx, p.out, hctx, mods + (size_t)1 * 5 * 6144 + 2 * 1024}; gemm_phase<false>(g, e, lds); }
    grid.sync();
    ln_phase(p, 1, 0, 1, 3, true);
    grid.sync();
    ffn_and_ln(p, grid, lds, 1, (const bf16_t*)(p.ws + W1_W13), (const bf16_t*)(p.ws + W1_W2));
  }
  { const bf16_t* d0 = (const bf16_t*)(p.ws + M_D0);
    { GemmArgs g{a, 1024, (const bf16_t*)(p.ws + W2_DOWN), 1024, T_ALL, 896, 1024}; EpiStore e{(bf16_t*)(p.ws + M_D0), (bf16_t*)(p.ws + M_D0), 1 << 30, 896, 896, 1.f}; gemm_phase<false>(g, e, lds); }
    grid.sync();
    mla_stats_phase(p);
    grid.sync();
    { GemmArgs g{d0, 896, (const bf16_t*)(p.ws + W2_UQ), 512, T_ALL, 1536, 512}; EpiMlaQ e{(bf16_t*)(p.ws + M_Q), rs, tabM}; gemm_phase<false>(g, e, lds); }
    { GemmArgs g{d0 + 512, 896, (const bf16_t*)(p.ws + W2_UKV), 256, T_ALL, 1024, 256}; EpiMlaK e{(bf16_t*)(p.ws + M_K), rs}; gemm_phase<false>(g, e, lds); }
    { GemmArgs g{d0 + 512, 896, (const bf16_t*)(p.ws + W2_UKV) + (size_t)1024 * 256, 256, T_ALL, 1024, 256}; EpiVT e{(bf16_t*)(p.ws + M_VT), rs}; gemm_phase<true>(g, e, lds); }
    grid.sync();
    mla_attn_phase(p, lds);
    grid.sync();
    { GemmArgs g{a, 1024, (const bf16_t*)(p.ws + W2_OUT), 1024, T_ALL, 1024, 1024}; EpiResid e{p.out, hctx, p.out, hctx, mods + (size_t)2 * 5 * 6144 + 2 * 1024}; gemm_phase<false>(g, e, lds); }
    grid.sync();
    ln_phase(p, 2, 0, 2, 3, true);
    grid.sync();
    ffn_and_ln(p, grid, lds, 2, (const bf16_t*)(p.ws + W2_W13), (const bf16_t*)(p.ws + W2_W2));
  }
  { { GemmArgs g{a, 1024, (const bf16_t*)(p.ws + W3_IN), 1024, T_ALL, 5120, 1024}; EpiHg e{(bf16_t*)(p.ws + H_P)}; gemm_phase<false>(g, e, lds); }
    grid.sync();
    scan_phase<128, true>(p, lds);
    grid.sync();
    hg_readout_phase(p);
    grid.sync();
    { GemmArgs g{a, 1024, (const bf16_t*)(p.ws + W3_OUT), 1024, T_ALL, 1024, 1024}; EpiResid e{p.out, hctx, p.out, hctx, mods + (size_t)3 * 5 * 6144 + 2 * 1024}; gemm_phase<false>(g, e, lds); }
    grid.sync();
    ln_phase(p, 3, 0, 3, 3, true);
    grid.sync();
    ffn_and_ln(p, grid, lds, 3, (const bf16_t*)(p.ws + W3_W13), (const bf16_t*)(p.ws + W3_W2));
  }
}

extern "C" void kernel_launch(void* const* d_in, const int* in_sizes, int n_in, void* d_out, int out_size, void* d_ws, size_t ws_size, hipStream_t stream) {
  static int grid_blocks = 0;
  if (!grid_blocks) {
    int dev = 0, cus = 0, per_cu = 0;
    (void)hipGetDevice(&dev);
    (void)hipDeviceGetAttribute(&cus, hipDeviceAttributeMultiprocessorCount, dev);
    (void)hipOccupancyMaxActiveBlocksPerMultiprocessor(&per_cu, mega, NTHR, 0);
    if (per_cu != 1) per_cu = 1;
    grid_blocks = cus * per_cu;
  }
  if (ws_size < WS_NEED) { fprintf(stderr, "workspace too small: %zu\n", ws_size); return; }
  Params p{};
  const float** f = (const float**)&p;
  for (int i = 0; i < 26; ++i) f[i] = (const float*)d_in[i];
  p.out = (float*)d_out; p.ws = (char*)d_ws;
  void* args[] = {&p};
  hipError_t e = hipLaunchCooperativeKernel((void*)mega, dim3(grid_blocks), dim3(NTHR), args, 0, stream);
  if (e != hipSuccess) fprintf(stderr, "cooperative launch failed: %s (grid %d)\n", hipGetErrorString(e), grid_blocks);
}
```

```cpp
#include <hip/hip_runtime.h>
#include <hip/hip_cooperative_groups.h>
#include <cstdio>
#include <cstdint>
namespace cg = cooperative_groups;

#define DI __device__ __forceinline__
DI int tid_() { int t = threadIdx.x; asm volatile("" : "+v"(t)); return t; }
typedef unsigned short bf16_t;
typedef short bf16x8 __attribute__((ext_vector_type(8)));
typedef short s16x4 __attribute__((ext_vector_type(4)));
typedef float f32x4 __attribute__((ext_vector_type(4)));
typedef float f32x16 __attribute__((ext_vector_type(16)));
typedef unsigned u32x4 __attribute__((ext_vector_type(4)));
typedef unsigned u32x2 __attribute__((ext_vector_type(2)));

constexpr int NTHR = 512;
constexpr int T_ALL = 33792, PB = 8448, LC = 256, LL = 8192, DM = 1024, FF = 2816;
constexpr float ALPHA = 1.681792830507429f;
constexpr float LOG2E = 1.4426950408889634f;
constexpr size_t MiB = 1048576;

struct Params {
  const float *x, *c, *ctx, *cctx, *ada_w, *ada_b, *ln_g, *ln_b, *w13, *w2;
  const float *ret_w_in, *ret_decay, *ret_w_out, *na_w_qkv, *na_rpb, *na_w_out;
  const float *mla_w_down, *mla_q_norm, *mla_kv_norm, *mla_w_uq, *mla_w_ukv, *mla_w_out;
  const float *hg_w_in, *hg_lb, *hg_norm_g, *hg_w_out;
  float* out; char* ws;
};

constexpr size_t OFF_MODS = 0;
constexpr size_t OFF_TABR = 512 * 1024;
constexpr size_t OFF_TABM = OFF_TABR + 65536;
constexpr size_t OFF_LBV = OFF_TABM + 8192;
constexpr size_t OFF_RS = OFF_LBV + 4096;
constexpr size_t OFF_HCTX = 1 * MiB;
constexpr size_t OFF_A = 5 * MiB;
constexpr size_t OFF_W0 = 71 * MiB;
constexpr size_t OFF_BIG = 104 * MiB;
constexpr size_t OFF_WR = OFF_BIG;
constexpr size_t OFF_S = 180 * MiB;
constexpr size_t WS_NEED = 512 * MiB;
constexpr size_t W0_RETIN = OFF_W0, W0_RETOUT = W0_RETIN + (size_t)6144 * 1024 * 2, W0_W13 = W0_RETOUT + (size_t)1024 * 2048 * 2, W0_W2 = W0_W13 + (size_t)5632 * 1024 * 2;
constexpr size_t SZ_W13 = (size_t)5632 * 1024 * 2, SZ_W2 = (size_t)1024 * 2816 * 2, SZ_SQ = (size_t)1024 * 1024 * 2;
constexpr size_t W1_QKV = OFF_WR, W1_OUT = W1_QKV + (size_t)3072 * 1024 * 2, W1_W13 = W1_OUT + SZ_SQ, W1_W2 = W1_W13 + SZ_W13;
constexpr size_t W2_DOWN = W1_W2 + SZ_W2, W2_UQ = W2_DOWN + (size_t)1024 * 1024 * 2, W2_UKV = W2_UQ + (size_t)1536 * 512 * 2, W2_OUT = W2_UKV + (size_t)2048 * 256 * 2, W2_W13 = W2_OUT + SZ_SQ, W2_W2 = W2_W13 + SZ_W13;
constexpr size_t W3_IN = W2_W2 + SZ_W2, W3_OUT = W3_IN + (size_t)5120 * 1024 * 2, W3_W13 = W3_OUT + SZ_SQ, W3_W2 = W3_W13 + SZ_W13, W3_END = W3_W2 + SZ_W2;
static_assert(W3_END <= OFF_S, "rest weights overflow");
static_assert(W0_W2 + SZ_W2 <= OFF_BIG, "W0 overflow");
constexpr size_t SZ_T2048 = (size_t)T_ALL * 2048 * 2, SZ_T1024 = (size_t)T_ALL * 1024 * 2;
constexpr size_t R_QK = OFF_BIG, R_V = R_QK + SZ_T2048, R_O = R_V + SZ_T2048;
static_assert(R_O + SZ_T2048 <= WS_NEED, "retention overflow");
constexpr size_t N_Q = OFF_S, N_K = N_Q + SZ_T1024, N_VT = N_K + SZ_T1024;
constexpr size_t M_D0 = OFF_S, M_Q = M_D0 + (size_t)T_ALL * 1024 * 2, M_K = M_Q + (size_t)T_ALL * 1536 * 2, M_VT = M_K + (size_t)T_ALL * 1536 * 2;
static_assert(M_VT + SZ_T1024 <= WS_NEED, "mla overflow");
constexpr size_t H_P = OFF_S;
static_assert(H_P + (size_t)T_ALL * 5120 * 2 <= WS_NEED, "hgrn overflow");
constexpr size_t F_U = OFF_S;

typedef float f32x2 __attribute__((ext_vector_type(2)));
typedef __bf16 bf16x2_t __attribute__((ext_vector_type(2)));
DI unsigned pk2(float lo, float hi) { const f32x2 v = {lo, hi}; const bf16x2_t r = __builtin_convertvector(v, bf16x2_t); return __builtin_bit_cast(unsigned, r); }
DI float bflo(unsigned u) { return __uint_as_float(u << 16); }
DI float bfhi(unsigned u) { return __uint_as_float(u & 0xffff0000u); }
DI float bf2f(bf16_t v) { return __uint_as_float(((unsigned)v) << 16); }
DI bf16_t f2bf(float x) { return (bf16_t)(pk2(x, 0.f) & 0xffffu); }
DI float siluf(float x) { return x / (1.f + __expf(-x)); }
DI f32x4 mfma16(bf16x8 a, bf16x8 b, f32x4 c) { return __builtin_amdgcn_mfma_f32_16x16x32_bf16(a, b, c, 0, 0, 0); }
DI f32x16 mfma32(bf16x8 a, bf16x8 b, f32x16 c) { return __builtin_amdgcn_mfma_f32_32x32x16_bf16(a, b, c, 0, 0, 0); }
DI bf16x8 cat44(s16x4 lo, s16x4 hi) { return __builtin_shufflevector(lo, hi, 0, 1, 2, 3, 4, 5, 6, 7); }
DI bf16x8 pack8(float a0, float a1, float a2, float a3, float a4, float a5, float a6, float a7) {
  u32x4 p; p.x = pk2(a0, a1); p.y = pk2(a2, a3); p.z = pk2(a4, a5); p.w = pk2(a6, a7); return __builtin_bit_cast(bf16x8, p);
}
DI int clampi(int v, int lo, int hi) { return v < lo ? lo : (v > hi ? hi : v); }
DI float* hrow(float* hlat, float* hctx, int t) { const int b = t / PB, p = t - b * PB; return p < LC ? hctx + (size_t)(b * LC + p) * DM : hlat + (size_t)(b * LL + p - LC) * DM; }
DI const float* hrowc(const float* hlat, const float* hctx, int t) { const int b = t / PB, p = t - b * PB; return p < LC ? hctx + (size_t)(b * LC + p) * DM : hlat + (size_t)(b * LL + p - LC) * DM; }
DI int modvec(int t) { const int b = t / PB, p = t - b * PB; return p < LC ? 4 : b; }

template <int MODE> DI int srccol(int n) {
  if (MODE == 0) return n;
  if (MODE == 1) { const int c = n >> 5, s = (n >> 4) & 1, i = n & 15; return s * FF + 16 * c + i; }
  if (MODE == 2) { if (n >= 2048) return n; const int w = n & 255, j = w >> 1, s = w & 1; return (n & ~255) + s * 128 + j; }
  if (MODE == 3) { const int h = n / 96, w = n - h * 96; if (w < 64) return n; const int wp = w - 64, j = wp >> 1, s = wp & 1; return h * 96 + 64 + s * 16 + j; }
  if (MODE == 4) { if (n < 1024) return (n >> 6) * 128 + (n & 63); const int m = n - 1024; return (m >> 6) * 128 + 64 + (m & 63); }
  if (MODE == 5) return n < 800 ? n : -1;
  return n;
}
template <int MODE>
DI void convert_w(const float* __restrict__ src, int Nsrc, int K, bf16_t* __restrict__ dst, int Ndst, const float* __restrict__ kscale, float* ldsf) {
  const int tid = threadIdx.x, tn = Ndst / 64, tk = K / 64;
  for (int tile = blockIdx.x; tile < tn * tk; tile += gridDim.x) {
    const int n0 = (tile % tn) * 64, k0 = (tile / tn) * 64;
    __syncthreads();
    for (int e = tid; e < 4096; e += NTHR) {
      const int kk = e >> 6, nn = e & 63, sc = srccol<MODE>(n0 + nn);
      float v = sc >= 0 ? src[(size_t)(k0 + kk) * Nsrc + sc] : 0.f;
      if (kscale) v *= kscale[k0 + kk];
      ldsf[kk * 65 + nn] = v;
    }
    __syncthreads();
    { const int nn = tid >> 3, kc = tid & 7; const float* lp = ldsf + (kc * 8) * 65 + nn;
      u32x4 o; o.x = pk2(lp[0], lp[65]); o.y = pk2(lp[130], lp[195]); o.z = pk2(lp[260], lp[325]); o.w = pk2(lp[390], lp[455]);
      *(u32x4*)(dst + (size_t)(n0 + nn) * K + k0 + kc * 8) = o; }
  }
}

DI void ada_phase(const Params& p, float* ldsf) {
  const int tid = threadIdx.x, lane = tid & 63, w = tid >> 6;
  float* mods = (float*)(p.ws + OFF_MODS);
  __syncthreads();
  for (int e = tid; e < 5120; e += NTHR) { const int mv = e >> 10, k = e & 1023; const float cv = mv < 4 ? p.c[mv * 1024 + k] : p.cctx[k]; ldsf[e] = siluf(cv); }
  __syncthreads();
  float* red = ldsf + 5120;
  for (int item = blockIdx.x; item < 4 * 96; item += gridDim.x) {
    const int i = item / 96, n0 = (item % 96) * 64;
    const float* wp = p.ada_w + (size_t)i * 1024 * 6144 + n0 + lane;
    float a0 = 0.f, a1 = 0.f, a2 = 0.f, a3 = 0.f, a4 = 0.f;
#pragma unroll 8
    for (int kk = 0; kk < 128; ++kk) { const int k = w * 128 + kk; const float wv = wp[(size_t)k * 6144];
      a0 += ldsf[k] * wv; a1 += ldsf[1024 + k] * wv; a2 += ldsf[2048 + k] * wv; a3 += ldsf[3072 + k] * wv; a4 += ldsf[4096 + k] * wv; }
    red[(w * 5 + 0) * 64 + lane] = a0; red[(w * 5 + 1) * 64 + lane] = a1; red[(w * 5 + 2) * 64 + lane] = a2; red[(w * 5 + 3) * 64 + lane] = a3; red[(w * 5 + 4) * 64 + lane] = a4;
    __syncthreads();
    if (tid < 320) { const int mv = tid >> 6; float s = 0.f;
#pragma unroll
      for (int ww = 0; ww < 8; ++ww) s += red[(ww * 5 + mv) * 64 + lane];
      mods[(size_t)(i * 5 + mv) * 6144 + n0 + lane] = s + p.ada_b[i * 6144 + n0 + lane]; }
    __syncthreads();
  }
}
DI void tables_phase(const Params& p) {
  const int gt = blockIdx.x * NTHR + threadIdx.x, gn = gridDim.x * NTHR;
  float2* tabR = (float2*)(p.ws + OFF_TABR); float2* tabM = (float2*)(p.ws + OFF_TABM); float* lbv = (float*)(p.ws + OFF_LBV);
  for (int e = gt; e < 128 * 64; e += gn) { const int v = e >> 6, i = e & 63; const float inv = powf(10000.f, -(float)i / 64.f); const float ang = (float)v * inv; tabR[e] = make_float2(cosf(ang), sinf(ang)); }
  for (int e = gt; e < 128 * 8; e += gn) { const int v = e >> 3, i = e & 7; const float inv = powf(10000.f, -(float)i / 8.f); const float ang = (float)v * inv; tabM[e] = make_float2(cosf(ang), sinf(ang)); }
  for (int e = gt; e < 1024; e += gn) { const float l0 = p.hg_lb[e], l1 = p.hg_lb[1024 + e], l2 = p.hg_lb[2048 + e], l3 = p.hg_lb[3072 + e];
    const float mx = fmaxf(fmaxf(l0, l1), fmaxf(l2, l3)); const float e0 = expf(l0 - mx), e1 = expf(l1 - mx), e2 = expf(l2 - mx), e3 = expf(l3 - mx);
    lbv[e] = (e1 + e2 + e3) / (e0 + e1 + e2 + e3); }
}

DI void modulate_phase(const Params& p, const float* slat, const float* sctx, int layer) {
  const float* mods = (const float*)(p.ws + OFF_MODS); bf16_t* a = (bf16_t*)(p.ws + OFF_A);
  const int gt = blockIdx.x * NTHR + threadIdx.x, gn = gridDim.x * NTHR;
  for (int e = gt; e < T_ALL * 128; e += gn) {
    const int t = e >> 7, c0 = (e & 127) * 8; const float* s = hrowc(slat, sctx, t) + c0; const float* m = mods + (size_t)(layer * 5 + modvec(t)) * 6144;
    const f32x4 x0 = *(const f32x4*)s, x1 = *(const f32x4*)(s + 4), sh0 = *(const f32x4*)(m + c0), sh1 = *(const f32x4*)(m + c0 + 4), sc0 = *(const f32x4*)(m + 1024 + c0), sc1 = *(const f32x4*)(m + 1024 + c0 + 4);
    const f32x4 y0 = x0 * (1.f + sc0) + sh0, y1 = x1 * (1.f + sc1) + sh1;
    u32x4 o; o.x = pk2(y0[0], y0[1]); o.y = pk2(y0[2], y0[3]); o.z = pk2(y1[0], y1[1]); o.w = pk2(y1[2], y1[3]);
    *(u32x4*)(a + (size_t)t * 1024 + c0) = o;
  }
}
DI void ln_phase(const Params& p, int lnlayer, int lnidx, int ml, int js, bool write_a) {
  const float* mods = (const float*)(p.ws + OFF_MODS); bf16_t* a = (bf16_t*)(p.ws + OFF_A); float* hctx = (float*)(p.ws + OFF_HCTX);
  const int tid = threadIdx.x, lane = tid & 63, gw = blockIdx.x * 8 + (tid >> 6), nw = gridDim.x * 8;
  const float* gp = p.ln_g + (size_t)(lnlayer * 2 + lnidx) * 1024; const float* bp = p.ln_b + (size_t)(lnlayer * 2 + lnidx) * 1024;
  for (int t = gw; t < T_ALL; t += nw) {
    float* hr = hrow(p.out, hctx, t);
    f32x4 v[4]; float s = 0.f;
#pragma unroll
    for (int i = 0; i < 4; ++i) { v[i] = *(const f32x4*)(hr + i * 256 + lane * 4); s += (v[i][0] + v[i][1]) + (v[i][2] + v[i][3]); }
#pragma unroll
    for (int o = 1; o < 64; o <<= 1) s += __shfl_xor(s, o);
    const float mean = s * (1.f / 1024.f); float q = 0.f;
#pragma unroll
    for (int i = 0; i < 4; ++i) { v[i] = v[i] - mean; q += (v[i][0] * v[i][0] + v[i][1] * v[i][1]) + (v[i][2] * v[i][2] + v[i][3] * v[i][3]); }
#pragma unroll
    for (int o = 1; o < 64; o <<= 1) q += __shfl_xor(q, o);
    const float rstd = rsqrtf(q * (1.f / 1024.f) + 1e-5f);
    const float* m = mods + (size_t)(ml * 5 + modvec(t)) * 6144 + (size_t)js * 1024;
#pragma unroll
    for (int i = 0; i < 4; ++i) { const int c0 = i * 256 + lane * 4;
      const f32x4 y = v[i] * rstd * *(const f32x4*)(gp + c0) + *(const f32x4*)(bp + c0);
      *(f32x4*)(hr + c0) = y;
      if (write_a) { const f32x4 z = y * (1.f + *(const f32x4*)(m + 1024 + c0)) + *(const f32x4*)(m + c0); u32x2 o; o.x = pk2(z[0], z[1]); o.y = pk2(z[2], z[3]); *(u32x2*)(a + (size_t)t * 1024 + c0) = o; } }
  }
}

namespace pg8 {
#define PG8_LAS __attribute__((address_space(3)))
typedef unsigned short bf16_t;
typedef short bf16x8 __attribute__((ext_vector_type(8)));
typedef float f32x4 __attribute__((ext_vector_type(4)));
typedef unsigned u32x4 __attribute__((ext_vector_type(4)));
constexpr int BM = 256, BK = 64, HALF = 128, HTB = HALF * BK * 2  , STAGE_BYTES = 8 * HTB, NXCD = 8, WGM = 8;

__host__ __device__ __forceinline__ int lds_byte(int r, int c) { const int st = (r >> 4) * 2 + (c >> 5), rr = r & 15, cc = c & 31, ob = rr * 64 + cc * 2; return st * 1024 + (ob ^ (((ob >> 9) & 1) << 5)); }
__host__ __device__ __forceinline__ void stage_rc(int b, int& R, int& C) { const int st = b / 1024, sb = b % 1024, swz = sb ^ (((sb >> 9) & 1) << 5); R = (st >> 1) * 16 + swz / 64; C = (st & 1) * 32 + (swz % 64) / 2; }
__host__ __device__ __forceinline__ int perm32(int rho) { const int n = rho >> 4, i = rho & 15; return 8 * (i >> 2) + 4 * n + (i & 3); }

struct Unit { int pm, pn; };
struct Gemm { const bf16_t* A; const bf16_t* Bt; int M, N, K; };

struct StaticOrder {
    int nM, nN, nwg, G, c;
    __host__ __device__ void init(int M, int N, int G_, int c_) { nM = M / BM; nN = N / BM; nwg = nM * nN; G = G_; c = c_; }
    __host__ __device__ bool next(int i, Unit& u) const {
        const long L = (long)i * G + c; if (L >= nwg) return false;
        int wgid = (int)L; { const int q = nwg / NXCD, r = nwg % NXCD, xcd = wgid % NXCD, off = wgid / NXCD; wgid = (xcd < r ? xcd * (q + 1) : r * (q + 1) + (xcd - r) * q) + off; }
        const int nig = WGM * nN, gid = wgid / nig, fm = gid * WGM, gsz = (nM - fm) < WGM ? (nM - fm) : WGM;
        u.pm = fm + ((wgid % nig) % gsz); u.pn = (wgid % nig) / gsz; return true;
    }
    __device__ __forceinline__ void a_ready(const Unit&) const {}
    __device__ __forceinline__ void done(const Unit&) const {}
};
template <class Epi, class Sched, bool ALIGN_EPI = false, bool SP2 = false>
__device__ __forceinline__ void gemm_phase(PG8_LAS unsigned char* lds, const Gemm g, const Sched& S, const Epi& E) {
    const int tid = tid_(), wid = __builtin_amdgcn_readfirstlane(tid >> 6), lane = tid & 63, wr = wid >> 2, wc = wid & 3, fr = lane & 15, fq = lane >> 4;
    const int K = g.K, nt = K / BK;
    unsigned voffA[2], voffB[2];
#pragma unroll
    for (int i = 0; i < 2; ++i) { int R, C; stage_rc(tid * 16 + i * 8192, R, C); const int Rb = Epi::PERM ? ((R & ~31) + perm32(R & 31)) : R;
        voffA[i] = (unsigned)(R * K + C) * 2u; voffB[i] = (unsigned)(Rb * K + C) * 2u; }
    const size_t kstep = (size_t)(BK * 2);
    const size_t hstep = (size_t)HALF * K * 2;
    const size_t tstep = 2 * hstep;
    const unsigned ldsw = (unsigned)wid * 1024u;
    const int aoff = lds_byte(wr * 64 + fr, fq * 8), boff = lds_byte(wc * 32 + fr, fq * 8);
#define PG8_SA(b, h) (((b) * 2 + (h)) * HTB)
#define PG8_SB(b, h) ((4 + (b) * 2 + (h)) * HTB)
#define PG8_STAGE(bufoff, gbase, voff) do { _Pragma("unroll") for (int _i = 0; _i < 2; ++_i) \
        __builtin_amdgcn_global_load_lds((const unsigned*)((const char*)(gbase) + (voff)[_i]), (PG8_LAS unsigned*)(lds + (bufoff) + ldsw + _i * 8192), 16, 0, 0); } while (0)
#define PG8_LDA(dst, b, h) do { _Pragma("unroll") for (int m = 0; m < 4; ++m) _Pragma("unroll") for (int k = 0; k < 2; ++k) dst[m][k] = *(const PG8_LAS bf16x8*)(lds + PG8_SA(b, h) + aoff + m * 2048 + k * 1024); } while (0)
#define PG8_LDB(dst, b, h) do { _Pragma("unroll") for (int n = 0; n < 2; ++n) _Pragma("unroll") for (int k = 0; k < 2; ++k) dst[n][k] = *(const PG8_LAS bf16x8*)(lds + PG8_SB(b, h) + boff + n * 2048 + k * 1024); } while (0)
#define PG8_MMA(ai, bj, At, Bt) do { __builtin_amdgcn_s_setprio(1); _Pragma("unroll") for (int m = 0; m < 4; ++m) _Pragma("unroll") for (int n = 0; n < 2; ++n) _Pragma("unroll") for (int k = 0; k < 2; ++k) \
        acc[ai][bj][m][n] = __builtin_amdgcn_mfma_f32_16x16x32_bf16(Bt[n][k], At[m][k], acc[ai][bj][m][n], 0, 0, 0); __builtin_amdgcn_s_setprio(0); } while (0)
#define PG8_WAIT_V(n) asm volatile("s_waitcnt vmcnt(" #n ")" ::: "memory")
#define PG8_WAIT_L(n) asm volatile("s_waitcnt lgkmcnt(" #n ")" ::: "memory")
#define PG8_BAR __builtin_amdgcn_s_barrier()
#define PG8_SCHED __builtin_amdgcn_sched_barrier(0)
    Unit cur, nxt; int ui = 0;
    if (!S.next(0, cur)) return;
    f32x4 acc[2][2][4][2];
#pragma unroll
    for (int a = 0; a < 2; ++a)
#pragma unroll
        for (int b = 0; b < 2; ++b)
#pragma unroll
            for (int m = 0; m < 4; ++m)
#pragma unroll
                for (int n = 0; n < 2; ++n) acc[a][b][m][n] = (f32x4){0.f, 0.f, 0.f, 0.f};
    bf16x8 At[4][2], B0[2][2], B1[2][2];
    const char* cA = (const char*)g.A + (size_t)cur.pm * tstep; const char* cB = (const char*)g.Bt + (size_t)cur.pn * tstep;
    S.a_ready(cur);
    if constexpr (SP2) {
        PG8_STAGE(PG8_SB(0, 0), cB, voffB); PG8_STAGE(PG8_SB(0, 1), cB + hstep, voffB); PG8_STAGE(PG8_SA(0, 0), cA, voffA); PG8_STAGE(PG8_SA(0, 1), cA + hstep, voffA);
        if (wr == 1) PG8_BAR;
        PG8_WAIT_V(2); PG8_BAR;
        PG8_STAGE(PG8_SB(1, 0), cB + kstep, voffB); PG8_STAGE(PG8_SA(1, 0), cA + kstep, voffA); PG8_STAGE(PG8_SB(1, 1), cB + hstep + kstep, voffB);
        PG8_WAIT_V(6); PG8_BAR;
    } else {
        PG8_STAGE(PG8_SB(0, 0), cB, voffB); PG8_STAGE(PG8_SA(0, 0), cA, voffA); PG8_STAGE(PG8_SB(0, 1), cB + hstep, voffB); PG8_STAGE(PG8_SA(0, 1), cA + hstep, voffA);
        if (wr == 1) PG8_BAR;
        PG8_WAIT_V(4); PG8_BAR;
        PG8_STAGE(PG8_SB(1, 0), cB + kstep, voffB); PG8_STAGE(PG8_SA(1, 0), cA + kstep, voffA); PG8_STAGE(PG8_SB(1, 1), cB + hstep + kstep, voffB);
        PG8_WAIT_V(6); PG8_BAR;
    }
    for (;;) {
        const bool has_next = S.next(ui + 1, nxt);
        const char* nA = has_next ? (const char*)g.A + (size_t)nxt.pm * tstep : cA; const char* nB = has_next ? (const char*)g.Bt + (size_t)nxt.pn * tstep : cB;
        for (int t = 0; t < nt; t += 2) {
            const bool last = (t == nt - 2);
            const char* a1 = cA + (size_t)(t + 1) * kstep;
            const char* a2 = last ? nA : cA + (size_t)(t + 2) * kstep; const char* b2 = last ? nB : cB + (size_t)(t + 2) * kstep;
            const char* a3 = a2 + kstep; const char* b3 = b2 + kstep;
            if (last && has_next) S.a_ready(nxt);
            if constexpr (SP2) {
            PG8_LDB(B0, 0, 0); PG8_LDB(B1, 0, 1); PG8_SCHED; PG8_LDA(At, 0, 0); PG8_STAGE(PG8_SA(1, 1), a1 + hstep, voffA);
            PG8_WAIT_V(8); PG8_WAIT_L(0); PG8_BAR; PG8_MMA(0, 0, At, B0); PG8_MMA(0, 1, At, B1); PG8_BAR; PG8_SCHED;
            PG8_LDA(At, 0, 1); PG8_STAGE(PG8_SB(0, 0), b2, voffB); PG8_STAGE(PG8_SB(0, 1), b2 + hstep, voffB); PG8_STAGE(PG8_SA(0, 0), a2, voffA);
            PG8_WAIT_V(8); PG8_WAIT_L(0); PG8_BAR; PG8_MMA(1, 0, At, B0); PG8_MMA(1, 1, At, B1); PG8_BAR; PG8_SCHED;
            PG8_LDB(B0, 1, 0); PG8_LDB(B1, 1, 1); PG8_SCHED; PG8_LDA(At, 1, 0); PG8_STAGE(PG8_SA(0, 1), a2 + hstep, voffA);
            PG8_WAIT_V(8); PG8_WAIT_L(0); PG8_BAR; PG8_MMA(0, 0, At, B0); PG8_MMA(0, 1, At, B1); PG8_BAR; PG8_SCHED;
            PG8_LDA(At, 1, 1); PG8_STAGE(PG8_SB(1, 0), b3, voffB); PG8_STAGE(PG8_SB(1, 1), b3 + hstep, voffB); PG8_STAGE(PG8_SA(1, 0), a3, voffA);
            PG8_WAIT_V(8); PG8_WAIT_L(0); PG8_BAR; PG8_MMA(1, 0, At, B0); PG8_MMA(1, 1, At, B1); PG8_BAR; PG8_SCHED;
            } else {
            PG8_LDB(B0, 0, 0); PG8_SCHED; PG8_LDA(At, 0, 0); PG8_STAGE(PG8_SA(1, 1), a1 + hstep, voffA);
            PG8_WAIT_L(8); PG8_BAR; PG8_WAIT_L(0); PG8_MMA(0, 0, At, B0); PG8_BAR; PG8_SCHED;
            PG8_LDB(B1, 0, 1); PG8_STAGE(PG8_SB(0, 0), b2, voffB);
            PG8_BAR; PG8_WAIT_L(0); PG8_MMA(0, 1, At, B1); PG8_BAR;
            PG8_LDA(At, 0, 1); PG8_STAGE(PG8_SA(0, 0), a2, voffA);
            PG8_BAR; PG8_WAIT_L(0); PG8_MMA(1, 0, At, B0); PG8_BAR; PG8_SCHED;
            PG8_STAGE(PG8_SB(0, 1), b2 + hstep, voffB);
            PG8_WAIT_V(6); PG8_BAR; PG8_MMA(1, 1, At, B1); PG8_BAR;
            PG8_LDB(B0, 1, 0); PG8_SCHED; PG8_LDA(At, 1, 0); PG8_STAGE(PG8_SA(0, 1), a2 + hstep, voffA);
            PG8_WAIT_L(8); PG8_BAR; PG8_WAIT_L(0); PG8_MMA(0, 0, At, B0); PG8_BAR; PG8_SCHED;
            PG8_LDB(B1, 1, 1); PG8_STAGE(PG8_SB(1, 0), b3, voffB);
            PG8_BAR; PG8_WAIT_L(0); PG8_MMA(0, 1, At, B1); PG8_BAR;
            PG8_LDA(At, 1, 1); PG8_STAGE(PG8_SA(1, 0), a3, voffA);
            PG8_BAR; PG8_WAIT_L(0); PG8_MMA(1, 0, At, B0); PG8_BAR; PG8_SCHED;
            PG8_STAGE(PG8_SB(1, 1), b3 + hstep, voffB);
            PG8_WAIT_V(6); PG8_BAR; PG8_MMA(1, 1, At, B1); PG8_BAR;
            }
        }
        if constexpr (ALIGN_EPI) { if (wr == 0) PG8_BAR; }
        if constexpr (!Epi::AFTER_DRAIN) { E(acc, cur, wr, wc, fr, fq); S.done(cur); }
        if (!has_next) break;
#pragma unroll
        for (int a = 0; a < 2; ++a)
#pragma unroll
            for (int b = 0; b < 2; ++b)
#pragma unroll
                for (int m = 0; m < 4; ++m)
#pragma unroll
                    for (int n = 0; n < 2; ++n) acc[a][b][m][n] = (f32x4){0.f, 0.f, 0.f, 0.f};
        cur = nxt; cA = nA; cB = nB; ++ui;
        if constexpr (ALIGN_EPI) { if (wr == 1) PG8_BAR; }
    }
    PG8_WAIT_V(0);
    if constexpr (!ALIGN_EPI) { if (wr == 0) PG8_BAR; }
    PG8_BAR;
    if constexpr (Epi::AFTER_DRAIN) { E.fused(acc, cur, wr, wc, fr, fq, lds, wid, lane); S.done(cur); }
#undef PG8_SA
#undef PG8_SB
#undef PG8_STAGE
#undef PG8_LDA
#undef PG8_LDB
#undef PG8_MMA
#undef PG8_WAIT_V
#undef PG8_WAIT_L
#undef PG8_BAR
#undef PG8_SCHED
}
}

template <class E4> struct EpiWrap { static constexpr bool PERM = false, AFTER_DRAIN = false; E4 e;
  DI void operator()(const f32x4 (&acc)[2][2][4][2], const pg8::Unit& u, int wr, int wc, int fr, int fq) const {
#pragma unroll
    for (int ai = 0; ai < 2; ++ai)
#pragma unroll
      for (int m = 0; m < 4; ++m) { const int row = u.pm * 256 + ai * 128 + wr * 64 + m * 16 + fr;
#pragma unroll
        for (int bj = 0; bj < 2; ++bj) { const int col = u.pn * 256 + bj * 128 + wc * 32 + 4 * fq;
          if constexpr (E4::PAIR) e.pair(row, ((col - 4 * fq) >> 1) + 4 * fq, acc[ai][bj][m][0], acc[ai][bj][m][1]);
          else { e(row, col, acc[ai][bj][m][0]); e(row, col + 16, acc[ai][bj][m][1]); } }
        asm volatile("" ::: "memory"); }
  } };
template <class E4>
DI void big_gemm(const bf16_t* A, const bf16_t* W, int M, int N, int K, const E4& e4, char* lds) {
  __syncthreads();
  pg8::Gemm g{A, W, M, N, K}; pg8::StaticOrder S; S.init(M, N, (int)gridDim.x, (int)blockIdx.x); EpiWrap<E4> E{e4};
  pg8::gemm_phase<EpiWrap<E4>, pg8::StaticOrder, true, true>((PG8_LAS unsigned char*)lds, g, S, E);
  __syncthreads();
}
struct GemmArgs { const bf16_t* A; int lda; const bf16_t* W; int ldw; int M, N, K; };
constexpr int LDT = 72;
template <bool TRANS, class Epi>
DI void gemm_phase(const GemmArgs g, const Epi epi, char* lds) {
  const int tid = threadIdx.x, lane = tid & 63, w = tid >> 6, wm = w & 3, wn = w >> 2, g4 = lane >> 4, l16 = lane & 15;
  const int nN = g.N / 128, ntiles = (g.M / 256) * nN, nk = g.K / 64;
  bf16_t* As = (bf16_t*)lds; bf16_t* Bs = As + 256 * LDT;
  for (int tile = blockIdx.x; tile < ntiles; tile += gridDim.x) {
    const int pm = tile / nN, pn = tile - pm * nN;
    const bf16_t* Ag = g.A + (size_t)(pm * 256) * g.lda; const bf16_t* Wg = g.W + (size_t)(pn * 128) * g.ldw;
    f32x4 acc[4][4];
#pragma unroll
    for (int i = 0; i < 4; ++i)
#pragma unroll
      for (int j = 0; j < 4; ++j) acc[i][j] = (f32x4){0.f, 0.f, 0.f, 0.f};
    u32x4 ra[4], rb[2];
#pragma unroll
    for (int i = 0; i < 4; ++i) { const int c = tid + NTHR * i; ra[i] = *(const u32x4*)(Ag + (size_t)(c >> 3) * g.lda + (c & 7) * 8); }
#pragma unroll
    for (int i = 0; i < 2; ++i) { const int c = tid + NTHR * i; rb[i] = *(const u32x4*)(Wg + (size_t)(c >> 3) * g.ldw + (c & 7) * 8); }
    for (int kt = 0; kt < nk; ++kt) {
      __syncthreads();
#pragma unroll
      for (int i = 0; i < 4; ++i) { const int c = tid + NTHR * i; *(u32x4*)(As + (c >> 3) * LDT + (c & 7) * 8) = ra[i]; }
#pragma unroll
      for (int i = 0; i < 2; ++i) { const int c = tid + NTHR * i; *(u32x4*)(Bs + (c >> 3) * LDT + (c & 7) * 8) = rb[i]; }
      __syncthreads();
      if (kt + 1 < nk) { const int k0 = (kt + 1) * 64;
#pragma unroll
        for (int i = 0; i < 4; ++i) { const int c = tid + NTHR * i; ra[i] = *(const u32x4*)(Ag + (size_t)(c >> 3) * g.lda + k0 + (c & 7) * 8); }
#pragma unroll
        for (int i = 0; i < 2; ++i) { const int c = tid + NTHR * i; rb[i] = *(const u32x4*)(Wg + (size_t)(c >> 3) * g.ldw + k0 + (c & 7) * 8); } }
#pragma unroll
      for (int ks = 0; ks < 2; ++ks) {
        bf16x8 af[4], wf[4];
#pragma unroll
        for (int i = 0; i < 4; ++i) af[i] = *(const bf16x8*)(As + (wm * 64 + i * 16 + l16) * LDT + ks * 32 + g4 * 8);
#pragma unroll
        for (int j = 0; j < 4; ++j) wf[j] = *(const bf16x8*)(Bs + (wn * 64 + j * 16 + l16) * LDT + ks * 32 + g4 * 8);
#pragma unroll
        for (int i = 0; i < 4; ++i)
#pragma unroll
          for (int j = 0; j < 4; ++j) acc[i][j] = TRANS ? mfma16(af[i], wf[j], acc[i][j]) : mfma16(wf[j], af[i], acc[i][j]);
      }
    }
    const int mb = pm * 256 + wm * 64, nb = pn * 128 + wn * 64;
    if constexpr (Epi::PAIR) {
#pragma unroll
      for (int i = 0; i < 4; ++i)
#pragma unroll
        for (int j = 0; j < 2; ++j) epi.pair(mb + i * 16 + l16, (nb >> 1) + 16 * j + 4 * g4, acc[i][2 * j], acc[i][2 * j + 1]);
    } else {
#pragma unroll
      for (int i = 0; i < 4; ++i)
#pragma unroll
        for (int j = 0; j < 4; ++j) { if (TRANS) epi(mb + i * 16 + 4 * g4, nb + j * 16 + l16, acc[i][j]); else epi(mb + i * 16 + l16, nb + j * 16 + 4 * g4, acc[i][j]); }
    }
  }
}
DI void st4bf(bf16_t* p, f32x4 v) { u32x2 o; o.x = pk2(v[0], v[1]); o.y = pk2(v[2], v[3]); *(u32x2*)p = o; }
struct EpiStore { static constexpr bool PAIR = false; bf16_t* d0; bf16_t* d1; int split, ld0, ld1; float s0;
  DI void operator()(int m, int n, f32x4 v) const { if (n < split) st4bf(d0 + (size_t)m * ld0 + n, v * s0); else st4bf(d1 + (size_t)m * ld1 + (n - split), v); } };
struct EpiVT { static constexpr bool PAIR = false; bf16_t* vt; const float* rs;
  DI void operator()(int m, int n, f32x4 v) const { const int b = m / PB, pos = m - b * PB;
    if (rs) { v[0] *= rs[2 * m + 1]; v[1] *= rs[2 * m + 3]; v[2] *= rs[2 * m + 5]; v[3] *= rs[2 * m + 7]; }
    st4bf(vt + ((size_t)(b * 1024 + n)) * PB + pos, v); } };
struct EpiResid { static constexpr bool PAIR = false; const float* slat; const float* sctx; float* dlat; float* dctx; const float* gate;
  DI void operator()(int m, int n, f32x4 v) const { const int mv = modvec(m); const f32x4 hv = *(const f32x4*)(hrowc(slat, sctx, m) + n); const f32x4 gt = *(const f32x4*)(gate + (size_t)mv * 6144 + n);
    *(f32x4*)(hrow(dlat, dctx, m) + n) = ALPHA * hv + gt * v; } };
struct EpiSwiglu { static constexpr bool PAIR = true; bf16_t* u;
  DI void pair(int m, int f, f32x4 gt, f32x4 up) const { f32x4 r; r[0] = siluf(gt[0]) * up[0]; r[1] = siluf(gt[1]) * up[1]; r[2] = siluf(gt[2]) * up[2]; r[3] = siluf(gt[3]) * up[3]; st4bf(u + (size_t)m * FF + f, r); } };
struct EpiRetQK { static constexpr bool PAIR = false; bf16_t* qk; const float2* tabR;
  DI void operator()(int m, int n, f32x4 v) const { const int b = m / PB, pp = m - b * PB;
    if (pp >= LC) { const int pos = pp - LC, row = pos >> 6, col = pos & 63; const int j0 = (n & 255) >> 1;
      const int vv = j0 < 64 ? row : col; const float2 c0 = tabR[vv * 64 + (j0 & 63)], c1 = tabR[vv * 64 + ((j0 + 1) & 63)];
      const float a0 = v[0] * c0.x - v[1] * c0.y, b0 = v[0] * c0.y + v[1] * c0.x, a1 = v[2] * c1.x - v[3] * c1.y, b1 = v[2] * c1.y + v[3] * c1.x; v = (f32x4){a0, b0, a1, b1}; }
    if (n >= 1024) v = v * 0.0625f;
    st4bf(qk + (size_t)m * 2048 + n, v); } };
struct EpiHg { static constexpr bool PAIR = false; bf16_t* ph;
  DI void operator()(int m, int n, f32x4 v) const { if (n < 1024) { v[0] = siluf(v[0]); v[1] = siluf(v[1]); v[2] = siluf(v[2]); v[3] = siluf(v[3]); v = v * 0.08838834764831845f; } st4bf(ph + (size_t)m * 5120 + n, v); } };
struct EpiMlaQ { static constexpr bool PAIR = false; bf16_t* q; const float* rs; const float2* tabM;
  DI void operator()(int m, int n, f32x4 v) const { v = v * (rs[2 * m] * 0.10206207261596577f * LOG2E); const int h = n / 96, w = n - h * 96; const int b = m / PB, pp = m - b * PB;
    if (w >= 64 && pp >= LC) { const int pos = pp - LC, row = pos >> 6, col = pos & 63; const int j0 = (w - 64) >> 1; const int vv = j0 < 8 ? row : col; const float2 c0 = tabM[vv * 8 + (j0 & 7)], c1 = tabM[vv * 8 + ((j0 + 1) & 7)];
      const float a0 = v[0] * c0.x - v[1] * c0.y, b0 = v[0] * c0.y + v[1] * c0.x, a1 = v[2] * c1.x - v[3] * c1.y, b1 = v[2] * c1.y + v[3] * c1.x; v = (f32x4){a0, b0, a1, b1}; }
    st4bf(q + (size_t)m * 1536 + n, v); } };
struct EpiMlaK { static constexpr bool PAIR = false; bf16_t* k; const float* rs;
  DI void operator()(int m, int n, f32x4 v) const { v = v * rs[2 * m + 1]; st4bf(k + (size_t)m * 1536 + (n >> 6) * 96 + (n & 63), v); } };

DI void mla_stats_phase(const Params& p) {
  const bf16_t* d0 = (const bf16_t*)(p.ws + M_D0); bf16_t* km = (bf16_t*)(p.ws + M_K); float* rs = (float*)(p.ws + OFF_RS); const float2* tabM = (const float2*)(p.ws + OFF_TABM);
  const int tid = threadIdx.x, lane = tid & 63, gw = blockIdx.x * 8 + (tid >> 6), nw = gridDim.x * 8;
  for (int t = gw; t < T_ALL; t += nw) {
    const bf16_t* r = d0 + (size_t)t * 1024;
    const u32x4 a = *(const u32x4*)(r + lane * 8); const u32x2 c = *(const u32x2*)(r + 512 + lane * 4);
    float sq = bflo(a.x) * bflo(a.x) + bfhi(a.x) * bfhi(a.x) + bflo(a.y) * bflo(a.y) + bfhi(a.y) * bfhi(a.y) + bflo(a.z) * bflo(a.z) + bfhi(a.z) * bfhi(a.z) + bflo(a.w) * bflo(a.w) + bfhi(a.w) * bfhi(a.w);
    float sk = bflo(c.x) * bflo(c.x) + bfhi(c.x) * bfhi(c.x) + bflo(c.y) * bflo(c.y) + bfhi(c.y) * bfhi(c.y);
#pragma unroll
    for (int o = 1; o < 64; o <<= 1) { sq += __shfl_xor(sq, o); sk += __shfl_xor(sk, o); }
    if (lane == 0) { rs[2 * t] = rsqrtf(sq * (1.f / 512.f) + 1e-6f); rs[2 * t + 1] = rsqrtf(sk * (1.f / 256.f) + 1e-6f); }
    if (lane < 16) { const int j = lane; float x1 = bf2f(r[768 + j]), x2 = bf2f(r[768 + 16 + j]); const int b = t / PB, pp = t - b * PB;
      if (pp >= LC) { const int pos = pp - LC, row = pos >> 6, col = pos & 63; const float2 cs = tabM[(j < 8 ? row : col) * 8 + (j & 7)]; const float o1 = x1 * cs.x - x2 * cs.y, o2 = x1 * cs.y + x2 * cs.x; x1 = o1; x2 = o2; }
      const unsigned pr = pk2(x1, x2);
#pragma unroll
      for (int h = 0; h < 16; ++h) *(unsigned*)(km + (size_t)t * 1536 + h * 96 + 64 + 2 * j) = pr; }
  }
}

constexpr int KLD = 104, VLD = 72;
DI void mla_attn_phase(const Params& p, char* lds) {
  const bf16_t* Qm = (const bf16_t*)(p.ws + M_Q); const bf16_t* Km = (const bf16_t*)(p.ws + M_K); const bf16_t* vT = (const bf16_t*)(p.ws + M_VT); bf16_t* o = (bf16_t*)(p.ws + OFF_A);
  const int tid = threadIdx.x, lane = tid & 63, w = tid >> 6, c = lane & 31, hh = lane >> 5;
  bf16_t* Ks = (bf16_t*)lds; bf16_t* Vs = Ks + 2 * 64 * KLD;
  for (int item = blockIdx.x; item < 2048 + 64; item += gridDim.x) {
    int b, h, qbase, nkt;
    if (item < 2048) { b = item >> 9; h = (item >> 5) & 15; qbase = LC + (item & 31) * 256; nkt = 132; } else { const int it = item - 2048; b = it >> 4; h = it & 15; qbase = 0; nkt = 4; }
    const size_t tokbase = (size_t)b * PB;
    const bf16_t* qp = Qm + (tokbase + qbase + w * 32 + c) * 1536 + h * 96 + hh * 8;
    bf16x8 qf[6];
#pragma unroll
    for (int ks = 0; ks < 6; ++ks) qf[ks] = *(const bf16x8*)(qp + ks * 16);
    const bf16_t* kg = Km + tokbase * 1536 + h * 96; const bf16_t* vg = vT + (size_t)(b * 16 + h) * 64 * PB;
    const int kr0 = tid / 12, kc0 = tid - kr0 * 12, e1 = tid + NTHR, kr1 = e1 / 12, kc1 = e1 - kr1 * 12; const bool k1ok = e1 < 768; const int vd = tid >> 3, vc = tid & 7;
    u32x4 rk0, rk1 = (u32x4){0, 0, 0, 0}, rv;
    rk0 = *(const u32x4*)(kg + (size_t)kr0 * 1536 + kc0 * 8); if (k1ok) rk1 = *(const u32x4*)(kg + (size_t)kr1 * 1536 + kc1 * 8); rv = *(const u32x4*)(vg + (size_t)vd * PB + vc * 8);
    __syncthreads();
    *(u32x4*)(Ks + kr0 * KLD + kc0 * 8) = rk0; if (k1ok) *(u32x4*)(Ks + kr1 * KLD + kc1 * 8) = rk1; *(u32x4*)(Vs + vd * VLD + vc * 8) = rv;
    __syncthreads();
    f32x16 oacc[2];
#pragma unroll
    for (int i = 0; i < 16; ++i) { oacc[0][i] = 0.f; oacc[1][i] = 0.f; }
    float mrow = -1e30f, lsum = 0.f;
    for (int kt = 0; kt < nkt; ++kt) {
      const int cur = kt & 1;
      if (kt + 1 < nkt) { const size_t key0 = (size_t)(kt + 1) * 64;
        rk0 = *(const u32x4*)(kg + (key0 + kr0) * 1536 + kc0 * 8); if (k1ok) rk1 = *(const u32x4*)(kg + (key0 + kr1) * 1536 + kc1 * 8); rv = *(const u32x4*)(vg + (size_t)vd * PB + key0 + vc * 8); }
      const bf16_t* Kc = Ks + cur * 64 * KLD; const bf16_t* Vc = Vs + cur * 64 * VLD;
      f32x16 sacc[2];
#pragma unroll
      for (int j = 0; j < 2; ++j) {
#pragma unroll
        for (int i = 0; i < 16; ++i) sacc[j][i] = 0.f;
#pragma unroll
        for (int ks = 0; ks < 6; ++ks) { const bf16x8 kf = *(const bf16x8*)(Kc + (32 * j + c) * KLD + ks * 16 + hh * 8); sacc[j] = mfma32(kf, qf[ks], sacc[j]); }
      }
      float mx = sacc[0][0];
#pragma unroll
      for (int j = 0; j < 2; ++j)
#pragma unroll
        for (int i = 0; i < 16; ++i) mx = fmaxf(mx, sacc[j][i]);
      mx = fmaxf(mx, __shfl_xor(mx, 32));
      const float mnew = fmaxf(mrow, mx), alpha = __builtin_amdgcn_exp2f(mrow - mnew); mrow = mnew;
      float ps = 0.f;
#pragma unroll
      for (int j = 0; j < 2; ++j)
#pragma unroll
        for (int i = 0; i < 16; ++i) { sacc[j][i] = __builtin_amdgcn_exp2f(sacc[j][i] - mnew); ps += sacc[j][i]; }
      lsum = lsum * alpha + ps;
#pragma unroll
      for (int i = 0; i < 16; ++i) { oacc[0][i] *= alpha; oacc[1][i] *= alpha; }
#pragma unroll
      for (int j = 0; j < 2; ++j)
#pragma unroll
        for (int s = 0; s < 2; ++s) {
          const bf16x8 pf = pack8(sacc[j][8 * s], sacc[j][8 * s + 1], sacc[j][8 * s + 2], sacc[j][8 * s + 3], sacc[j][8 * s + 4], sacc[j][8 * s + 5], sacc[j][8 * s + 6], sacc[j][8 * s + 7]);
#pragma unroll
          for (int dt = 0; dt < 2; ++dt) { const bf16_t* vp = Vc + (32 * dt + c) * VLD + 32 * j + 16 * s + 4 * hh;
            const bf16x8 vf = cat44(*(const s16x4*)vp, *(const s16x4*)(vp + 8)); oacc[dt] = mfma32(vf, pf, oacc[dt]); }
        }
      if (kt + 1 < nkt) { bf16_t* Kn = Ks + (cur ^ 1) * 64 * KLD; bf16_t* Vn = Vs + (cur ^ 1) * 64 * VLD;
        *(u32x4*)(Kn + kr0 * KLD + kc0 * 8) = rk0; if (k1ok) *(u32x4*)(Kn + kr1 * KLD + kc1 * 8) = rk1; *(u32x4*)(Vn + vd * VLD + vc * 8) = rv; }
      __syncthreads();
    }
    lsum += __shfl_xor(lsum, 32); const float inv = 1.f / lsum;
    bf16_t* op = o + (tokbase + qbase + w * 32 + c) * 1024 + h * 64 + 4 * hh;
#pragma unroll
    for (int dt = 0; dt < 2; ++dt)
#pragma unroll
      for (int rg = 0; rg < 4; ++rg) st4bf(op + 32 * dt + 8 * rg, (f32x4){oacc[dt][4 * rg] * inv, oacc[dt][4 * rg + 1] * inv, oacc[dt][4 * rg + 2] * inv, oacc[dt][4 * rg + 3] * inv});
  }
}

template <bool CTX>
DI void na_wave(const bf16_t* __restrict__ Q, const bf16_t* __restrict__ K, const bf16_t* __restrict__ vT, bf16_t* __restrict__ o, const float* rpb  , int b, int h, int r, int n, int lane) {
  constexpr int NT = CTX ? 16 : 32;
  const int g = lane >> 4, l16 = lane & 15; const size_t tokbase = (size_t)b * PB;
  const int qpos = CTX ? (n * 16 + l16) : (LC + r * 64 + n * 16 + l16);
  const int rs = clampi(r - 4, 0, 120), band0 = clampi(16 * n - 8, 0, 32);
  const bf16_t* qp = Q + (tokbase + qpos) * 1024 + h * 64 + g * 8;
  const bf16x8 q0 = *(const bf16x8*)qp, q1 = *(const bf16x8*)(qp + 32);
  f32x4 S[NT];
#pragma unroll
  for (int kt = 0; kt < NT; ++kt) {
    int kpos;
    if (!CTX && kt < 16) kpos = LC + (rs + (kt >> 1)) * 64 + band0 + 16 * (kt & 1) + l16; else kpos = 16 * (CTX ? kt : kt - 16) + l16;
    const bf16_t* kp = K + (tokbase + kpos) * 1024 + h * 64 + g * 8;
    f32x4 s = mfma16(*(const bf16x8*)kp, q0, (f32x4){0.f, 0.f, 0.f, 0.f}); s = mfma16(*(const bf16x8*)(kp + 32), q1, s);
    if (!CTX && kt < 16) { const int qcol = 16 * n + l16, wstart = clampi(qcol - 8, 0, 48); const float* bp = rpb + (rs + (kt >> 1) - r + 7) * 31;
#pragma unroll
      for (int rr = 0; rr < 4; ++rr) { const int kcol = band0 + 16 * (kt & 1) + 4 * g + rr; const bool ok = kcol >= wstart && kcol < wstart + 16;
        s[rr] = ok ? (s[rr] + bp[clampi(kcol - qcol + 15, 0, 30)]) * LOG2E : -1e30f; } }
    else s = s * LOG2E;
    S[kt] = s;
  }
  float mx = S[0][0];
#pragma unroll
  for (int kt = 0; kt < NT; ++kt) mx = fmaxf(fmaxf(fmaxf(mx, S[kt][0]), fmaxf(S[kt][1], S[kt][2])), S[kt][3]);
  mx = fmaxf(mx, __shfl_xor(mx, 16)); mx = fmaxf(mx, __shfl_xor(mx, 32));
  float ls = 0.f;
#pragma unroll
  for (int kt = 0; kt < NT; ++kt)
#pragma unroll
    for (int rr = 0; rr < 4; ++rr) { S[kt][rr] = __builtin_amdgcn_exp2f(S[kt][rr] - mx); ls += S[kt][rr]; }
  ls += __shfl_xor(ls, 16); ls += __shfl_xor(ls, 32);
  f32x4 O[4];
#pragma unroll
  for (int dt = 0; dt < 4; ++dt) O[dt] = (f32x4){0.f, 0.f, 0.f, 0.f};
  const bf16_t* vb = vT + ((size_t)(b * 16 + h) * 64 + l16) * PB;
#pragma unroll
  for (int kk = 0; kk < NT / 2; ++kk) {
    int pos0;
    if (!CTX && kk < 8) pos0 = LC + (rs + kk) * 64 + band0 + 4 * g; else pos0 = 32 * (CTX ? kk : kk - 8) + 4 * g;
    const bf16x8 pf = pack8(S[2 * kk][0], S[2 * kk][1], S[2 * kk][2], S[2 * kk][3], S[2 * kk + 1][0], S[2 * kk + 1][1], S[2 * kk + 1][2], S[2 * kk + 1][3]);
#pragma unroll
    for (int dt = 0; dt < 4; ++dt) { const bf16_t* vp = vb + (size_t)(dt * 16) * PB + pos0; const bf16x8 vf = cat44(*(const s16x4*)vp, *(const s16x4*)(vp + 16)); O[dt] = mfma16(vf, pf, O[dt]); }
  }
  const float inv = 1.f / ls; bf16_t* op = o + (tokbase + qpos) * 1024 + h * 64 + 4 * g;
#pragma unroll
  for (int dt = 0; dt < 4; ++dt) st4bf(op + 16 * dt, O[dt] * inv);
}
DI void na_attn_phase(const Params& p, char* lds) {
  const bf16_t* Q = (const bf16_t*)(p.ws + N_Q); const bf16_t* K = (const bf16_t*)(p.ws + N_K); const bf16_t* vT = (const bf16_t*)(p.ws + N_VT); bf16_t* o = (bf16_t*)(p.ws + OFF_A);
  float* rl = (float*)lds; const int tid = threadIdx.x, lane = tid & 63, w = tid >> 6;
  __syncthreads();
  for (int e = tid; e < 16 * 465; e += NTHR) rl[e] = p.na_rpb[e];
  __syncthreads();
  for (int item = blockIdx.x; item < 4096 + 128; item += gridDim.x) {
    if (item < 4096) { const int hhf = item & 1, n = (item >> 1) & 3, r = (item >> 3) & 127, b = item >> 10; const int h = hhf * 8 + w; na_wave<false>(Q, K, vT, o, rl + h * 465, b, h, r, n, lane); }
    else { const int it = item - 4096; const int hhf = it & 1, qb = (it >> 1) & 15, b = it >> 5; const int h = hhf * 8 + w; na_wave<true>(Q, K, vT, o, rl + h * 465, b, h, 0, qb, lane); }
  }
}

template <int DK> struct ScanLds { static constexpr int QLD = DK + 8, TLD = 72;
  static constexpr int OFF_QD = 0, OFF_KD = OFF_QD + 64 * QLD * 2, OFF_VT = OFF_KD + 64 * QLD * 2, OFF_ATT = OFF_VT + 64 * TLD * 2, OFF_ST = OFF_ATT + 64 * TLD * 2, OFF_EB = OFF_ST + 64 * QLD * 2, OFF_QS = OFF_EB + DK * 4, TOTAL = OFF_QS + 4 * DK * 4; };
DI int scan_pos(int dir, int i, int tl) { if (dir == 0) return i * 64 + tl; return i < 4 ? 255 - (i * 64 + tl) : 8447 - ((i - 4) * 64 + tl); }
DI bf16x8 gather8(const bf16_t* p, int stride) {
  const unsigned a0 = p[0], a1 = p[stride], a2 = p[2 * stride], a3 = p[3 * stride], a4 = p[4 * stride], a5 = p[5 * stride], a6 = p[6 * stride], a7 = p[7 * stride];
  u32x4 r; r.x = a0 | (a1 << 16); r.y = a2 | (a3 << 16); r.z = a4 | (a5 << 16); r.w = a6 | (a7 << 16); return __builtin_bit_cast(bf16x8, r);
}

template <int DK, bool HG>
DI void scan_phase(const Params& p, char* lds) {
  typedef ScanLds<DK> L;
  bf16_t* Qd = (bf16_t*)(lds + L::OFF_QD); bf16_t* Kd = (bf16_t*)(lds + L::OFF_KD); bf16_t* Vt = (bf16_t*)(lds + L::OFF_VT);
  bf16_t* Att = (bf16_t*)(lds + L::OFF_ATT); bf16_t* St = (bf16_t*)(lds + L::OFF_ST); float* eb = (float*)(lds + L::OFF_EB); float* qs = (float*)(lds + L::OFF_QS);
  constexpr int QLD = L::QLD, TLD = L::TLD, KT = DK / 16 / 8;
  const int tid = tid_(), lane = tid & 63, w = tid >> 6, g4 = lane >> 4, l16 = lane & 15;
  const int nitems = HG ? 128 : 256;
  const float* lbv = (const float*)(p.ws + OFF_LBV);
  for (int item = blockIdx.x; item < nitems; item += gridDim.x) {
    int b, h, sl, dir; if (HG) { sl = item & 1; h = (item >> 1) & 7; b = (item >> 4) & 3; dir = item >> 6; } else { sl = item & 7; h = (item >> 3) & 3; b = (item >> 5) & 3; dir = item >> 7; }
    const size_t tokbase = (size_t)b * PB;
    const bf16_t *qsrc, *ksrc, *vsrc; int ldq, ldv; bf16_t *octx, *olat; int ldo;
    if (HG) { const bf16_t* ph = (const bf16_t*)(p.ws + H_P); qsrc = ph + h * 128; ksrc = ph + 1024 + dir * 1024 + h * 128; vsrc = ph + 3072 + h * 128 + sl * 64; ldq = 5120; ldv = 5120; ldo = 1024;
      octx = (bf16_t*)(p.ws + (dir ? OFF_W0 : OFF_A)) + tokbase * 1024 + h * 128 + sl * 64; olat = octx + (size_t)LC * 1024; }
    else { const bf16_t* qk = (const bf16_t*)(p.ws + R_QK); qsrc = qk + h * 256; ksrc = qk + 1024 + h * 256; vsrc = (const bf16_t*)(p.ws + R_V) + h * 512 + sl * 64; ldq = 2048; ldv = 2048; ldo = 2048;
      if (dir == 0) { octx = (bf16_t*)(p.ws + R_O) + tokbase * 2048 + h * 512 + sl * 64; olat = octx + (size_t)LC * 2048; }
      else { octx = (bf16_t*)(p.ws + OFF_HCTX) + (size_t)b * LC * 2048 + h * 512 + sl * 64; olat = (bf16_t*)p.out + (size_t)b * LL * 2048 + h * 512 + sl * 64; } }
    float lg = 0.f; if (!HG) lg = -__expf(p.ret_decay[dir * 4 + h]);
    float lb = 0.f; if (HG) lb = lbv[h * 128 + (tid & 127)];
    f32x4 sacc[KT][4];
#pragma unroll
    for (int a = 0; a < KT; ++a)
#pragma unroll
      for (int v = 0; v < 4; ++v) sacc[a][v] = (f32x4){0.f, 0.f, 0.f, 0.f};
    u32x4 rq[4], rk[4], rvv; unsigned short rf[16], rqq[16]; float bl[16], qv[16], kv[16];
    const int vtl = tid & 63, vvc = tid >> 6;
    auto issue = [&](int i) {
      if (HG) { const int k = tid & 127, qt = tid >> 7;
#pragma unroll
        for (int j = 0; j < 16; ++j) { const size_t row = tokbase + scan_pos(dir, i, qt * 16 + j); rf[j] = ksrc[row * ldq + k]; rqq[j] = qsrc[row * ldq + k]; } }
      else {
#pragma unroll
        for (int it = 0; it < 4; ++it) { const int e = tid + NTHR * it, tl = e >> 5, kc = e & 31; const size_t row = tokbase + scan_pos(dir, i, tl); rq[it] = *(const u32x4*)(qsrc + row * ldq + kc * 8); rk[it] = *(const u32x4*)(ksrc + row * ldq + kc * 8); } }
      { const size_t row = tokbase + scan_pos(dir, i, vtl); rvv = *(const u32x4*)(vsrc + row * ldv + vvc * 8); }
    };
    auto prep = [&]() {
      const int k = tid & 127, qt = tid >> 7; float run = 0.f;
#pragma unroll
      for (int j = 0; j < 16; ++j) { const float f = bf2f(rf[j]); qv[j] = bf2f(rqq[j]); const float sg = 1.f / (1.f + __expf(-f)); const float fg = lb + (1.f - lb) * sg; kv[j] = 1.f - fg; run += __logf(fg); bl[j] = run; }
      qs[qt * DK + k] = run;
    };
    __syncthreads();
    issue(0); if (HG) prep();
    __syncthreads();
    for (int i = 0; i < 132; ++i) {
      if (HG) { const int k = tid & 127, qt = tid >> 7; float off = 0.f;
#pragma unroll
        for (int q = 0; q < 3; ++q) if (q < qt) off += qs[q * DK + k];
        if (qt == 3) eb[k] = __expf(off + bl[15]);
#pragma unroll
        for (int j = 0; j < 16; ++j) { const int tl = qt * 16 + j; const float bb = bl[j] + off; Qd[tl * QLD + k] = f2bf(qv[j] * __expf(bb)); Kd[tl * QLD + k] = f2bf(kv[j] * __expf(-bb)); } }
      else {
        if (tid < DK) eb[tid] = __expf(64.f * lg);
#pragma unroll
        for (int it = 0; it < 4; ++it) { const int e = tid + NTHR * it, tl = e >> 5, kc = e & 31; const u32x4 qr = rq[it], kr = rk[it];
          const float eq = __expf((float)(tl + 1) * lg), ek = __expf(-(float)(tl + 1) * lg);
          u32x4 qo, ko; qo.x = pk2(bflo(qr.x) * eq, bfhi(qr.x) * eq); qo.y = pk2(bflo(qr.y) * eq, bfhi(qr.y) * eq); qo.z = pk2(bflo(qr.z) * eq, bfhi(qr.z) * eq); qo.w = pk2(bflo(qr.w) * eq, bfhi(qr.w) * eq);
          ko.x = pk2(bflo(kr.x) * ek, bfhi(kr.x) * ek); ko.y = pk2(bflo(kr.y) * ek, bfhi(kr.y) * ek); ko.z = pk2(bflo(kr.z) * ek, bfhi(kr.z) * ek); ko.w = pk2(bflo(kr.w) * ek, bfhi(kr.w) * ek);
          *(u32x4*)(Qd + tl * QLD + kc * 8) = qo; *(u32x4*)(Kd + tl * QLD + kc * 8) = ko; } }
      { bf16_t* vt = Vt + (vvc * 8) * TLD + vtl; const u32x4 vr = rvv;
        vt[0] = (bf16_t)(vr.x & 0xffff); vt[TLD] = (bf16_t)(vr.x >> 16); vt[2 * TLD] = (bf16_t)(vr.y & 0xffff); vt[3 * TLD] = (bf16_t)(vr.y >> 16);
        vt[4 * TLD] = (bf16_t)(vr.z & 0xffff); vt[5 * TLD] = (bf16_t)(vr.z >> 16); vt[6 * TLD] = (bf16_t)(vr.w & 0xffff); vt[7 * TLD] = (bf16_t)(vr.w >> 16); }
#pragma unroll
      for (int a = 0; a < KT; ++a) { const int ki = w * KT + a;
#pragma unroll
        for (int vi = 0; vi < 4; ++vi) st4bf(St + (16 * vi + l16) * QLD + 16 * ki + 4 * g4, sacc[a][vi]); }
      __syncthreads();
      if (i + 1 < 132) issue(i + 1);
#pragma unroll
      for (int u = 0; u < 2; ++u) { const int id = 2 * w + u, ti = id >> 2, si = id & 3; f32x4 d = (f32x4){0.f, 0.f, 0.f, 0.f};
        if (si <= ti) {
#pragma unroll
          for (int ks = 0; ks < DK / 32; ++ks) { const bf16x8 kf = *(const bf16x8*)(Kd + (16 * si + l16) * QLD + ks * 32 + g4 * 8), qf = *(const bf16x8*)(Qd + (16 * ti + l16) * QLD + ks * 32 + g4 * 8); d = mfma16(kf, qf, d); } }
        const int t = 16 * ti + l16, s0 = 16 * si + 4 * g4;
#pragma unroll
        for (int rr = 0; rr < 4; ++rr) if (s0 + rr > t) d[rr] = 0.f;
        st4bf(Att + t * TLD + s0, d); }
      __syncthreads();
#pragma unroll
      for (int u = 0; u < 2; ++u) { const int id = 2 * w + u, vi = id >> 2, ti = id & 3; f32x4 d = (f32x4){0.f, 0.f, 0.f, 0.f};
#pragma unroll
        for (int ks = 0; ks < 2; ++ks) { const bf16x8 xf = *(const bf16x8*)(Vt + (16 * vi + l16) * TLD + ks * 32 + g4 * 8), yf = *(const bf16x8*)(Att + (16 * ti + l16) * TLD + ks * 32 + g4 * 8); d = mfma16(xf, yf, d); }
#pragma unroll
        for (int ks = 0; ks < DK / 32; ++ks) { const bf16x8 xf = *(const bf16x8*)(St + (16 * vi + l16) * QLD + ks * 32 + g4 * 8), yf = *(const bf16x8*)(Qd + (16 * ti + l16) * QLD + ks * 32 + g4 * 8); d = mfma16(xf, yf, d); }
        const int pos = scan_pos(dir, i, 16 * ti + l16); bf16_t* op = (pos < LC ? octx + (size_t)pos * ldo : olat + (size_t)(pos - LC) * ldo) + 16 * vi + 4 * g4;
        st4bf(op, d); }
#pragma unroll
      for (int a = 0; a < KT; ++a) { const int ki = w * KT + a;
#pragma unroll
        for (int ks = 0; ks < 2; ++ks) { const bf16x8 xf = gather8(Kd + (ks * 32 + g4 * 8) * QLD + 16 * ki + l16, QLD);
#pragma unroll
          for (int vi = 0; vi < 4; ++vi) { const bf16x8 yf = *(const bf16x8*)(Vt + (16 * vi + l16) * TLD + ks * 32 + g4 * 8); sacc[a][vi] = mfma16(xf, yf, sacc[a][vi]); } }
        const f32x4 e4 = *(const f32x4*)(eb + 16 * ki + 4 * g4);
#pragma unroll
        for (int vi = 0; vi < 4; ++vi) sacc[a][vi] = sacc[a][vi] * e4; }
      if (HG && i + 1 < 132) prep();
      __syncthreads();
    }
  }
}

DI float bsum2(unsigned a, unsigned b, float& lo, float& hi) { lo = bflo(a) + bflo(b); hi = bfhi(a) + bfhi(b); return lo * lo + hi * hi; }
DI void ret_readout_phase(const Params& p) {
  bf16_t* O = (bf16_t*)(p.ws + R_O); const bf16_t* G = (const bf16_t*)(p.ws + R_QK);
  const int tid = threadIdx.x, lane = tid & 63, gw = blockIdx.x * 8 + (tid >> 6), nw = gridDim.x * 8;
  for (int t = gw; t < T_ALL; t += nw) {
    const int b = t / PB, pp = t - b * PB;
    const bf16_t* ob = (pp < LC ? (const bf16_t*)(p.ws + OFF_HCTX) + (size_t)(b * LC + pp) * 2048 : (const bf16_t*)p.out + (size_t)(b * LL + pp - LC) * 2048) + lane * 32;
    bf16_t* op = O + (size_t)t * 2048 + lane * 32; const bf16_t* gp = G + (size_t)t * 2048 + lane * 32;
    float ov[32]; u32x4 gv[4]; float sq = 0.f;
#pragma unroll
    for (int i = 0; i < 4; ++i) { const u32x4 x = *(const u32x4*)(op + i * 8), y = *(const u32x4*)(ob + i * 8); gv[i] = *(const u32x4*)(gp + i * 8);
      sq += bsum2(x.x, y.x, ov[8 * i], ov[8 * i + 1]) + bsum2(x.y, y.y, ov[8 * i + 2], ov[8 * i + 3]) + bsum2(x.z, y.z, ov[8 * i + 4], ov[8 * i + 5]) + bsum2(x.w, y.w, ov[8 * i + 6], ov[8 * i + 7]); }
    sq += __shfl_xor(sq, 1); sq += __shfl_xor(sq, 2); sq += __shfl_xor(sq, 4); sq += __shfl_xor(sq, 8);
    const float rstd = rsqrtf(sq * (1.f / 512.f) + 1e-6f);
#pragma unroll
    for (int i = 0; i < 4; ++i) { u32x4 r;
      r.x = pk2(siluf(bflo(gv[i].x)) * ov[8 * i] * rstd, siluf(bfhi(gv[i].x)) * ov[8 * i + 1] * rstd); r.y = pk2(siluf(bflo(gv[i].y)) * ov[8 * i + 2] * rstd, siluf(bfhi(gv[i].y)) * ov[8 * i + 3] * rstd);
      r.z = pk2(siluf(bflo(gv[i].z)) * ov[8 * i + 4] * rstd, siluf(bfhi(gv[i].z)) * ov[8 * i + 5] * rstd); r.w = pk2(siluf(bflo(gv[i].w)) * ov[8 * i + 6] * rstd, siluf(bfhi(gv[i].w)) * ov[8 * i + 7] * rstd);
      *(u32x4*)(op + i * 8) = r; }
  }
}
DI void hg_readout_phase(const Params& p) {
  bf16_t* O = (bf16_t*)(p.ws + OFF_A); const bf16_t* OB = (const bf16_t*)(p.ws + OFF_W0); const bf16_t* ph = (const bf16_t*)(p.ws + H_P);
  const int tid = threadIdx.x, lane = tid & 63, gw = blockIdx.x * 8 + (tid >> 6), nw = gridDim.x * 8;
  for (int t = gw; t < T_ALL; t += nw) {
    bf16_t* op = O + (size_t)t * 1024 + lane * 16; const bf16_t* ob = OB + (size_t)t * 1024 + lane * 16; const bf16_t* gp = ph + (size_t)t * 5120 + 4096 + lane * 16; const float* ng = p.hg_norm_g + (lane & 7) * 16;
    float ov[16]; u32x4 gv[2]; float sq = 0.f;
#pragma unroll
    for (int i = 0; i < 2; ++i) { const u32x4 x = *(const u32x4*)(op + i * 8), y = *(const u32x4*)(ob + i * 8); gv[i] = *(const u32x4*)(gp + i * 8);
      sq += bsum2(x.x, y.x, ov[8 * i], ov[8 * i + 1]) + bsum2(x.y, y.y, ov[8 * i + 2], ov[8 * i + 3]) + bsum2(x.z, y.z, ov[8 * i + 4], ov[8 * i + 5]) + bsum2(x.w, y.w, ov[8 * i + 6], ov[8 * i + 7]); }
    sq += __shfl_xor(sq, 1); sq += __shfl_xor(sq, 2); sq += __shfl_xor(sq, 4);
    const float rstd = rsqrtf(sq * (1.f / 128.f) + 1e-6f);
#pragma unroll
    for (int i = 0; i < 2; ++i) { u32x4 r; const float* n8 = ng + i * 8;
      r.x = pk2(siluf(bflo(gv[i].x)) * ov[8 * i] * rstd * n8[0], siluf(bfhi(gv[i].x)) * ov[8 * i + 1] * rstd * n8[1]); r.y = pk2(siluf(bflo(gv[i].y)) * ov[8 * i + 2] * rstd * n8[2], siluf(bfhi(gv[i].y)) * ov[8 * i + 3] * rstd * n8[3]);
      r.z = pk2(siluf(bflo(gv[i].z)) * ov[8 * i + 4] * rstd * n8[4], siluf(bfhi(gv[i].z)) * ov[8 * i + 5] * rstd * n8[5]); r.w = pk2(siluf(bflo(gv[i].w)) * ov[8 * i + 6] * rstd * n8[6], siluf(bfhi(gv[i].w)) * ov[8 * i + 7] * rstd * n8[7]);
      *(u32x4*)(op + i * 8) = r; }
  }
}

constexpr int LDS_BYTES = ScanLds<256>::TOTAL > pg8::STAGE_BYTES ? ScanLds<256>::TOTAL : pg8::STAGE_BYTES;
static_assert(LDS_BYTES <= 163840, "LDS");
static_assert(LDS_BYTES >= (256 + 128) * LDT * 2 && LDS_BYTES >= 2 * 64 * (KLD + VLD) * 2 && LDS_BYTES >= (5120 + 8 * 5 * 64) * 4, "LDS phases");

DI void ffn_and_ln(const Params& p, cg::grid_group& grid, char* lds, int layer, const bf16_t* w13, const bf16_t* w2) {
  const float* mods = (const float*)(p.ws + OFF_MODS); float* hctx = (float*)(p.ws + OFF_HCTX); bf16_t* a = (bf16_t*)(p.ws + OFF_A); bf16_t* U = (bf16_t*)(p.ws + F_U);
  { EpiSwiglu e{U}; big_gemm(a, w13, T_ALL, 5632, 1024, e, lds); }
  grid.sync();
  { EpiResid e{p.out, hctx, p.out, hctx, mods + (size_t)layer * 5 * 6144 + 5 * 1024}; big_gemm(U, w2, T_ALL, 1024, FF, e, lds); }
  grid.sync();
  ln_phase(p, layer, 1, layer < 3 ? layer + 1 : 3, 0, layer < 3);
  grid.sync();
}

__global__ void __launch_bounds__(NTHR) mega(Params p) {
  __shared__ __attribute__((aligned(16))) char lds[LDS_BYTES];
  cg::grid_group grid = cg::this_grid();
  float* ldsf = (float*)lds;
  const float* mods = (const float*)(p.ws + OFF_MODS); float* hctx = (float*)(p.ws + OFF_HCTX); bf16_t* a = (bf16_t*)(p.ws + OFF_A);
  const float2* tabR = (const float2*)(p.ws + OFF_TABR); const float2* tabM = (const float2*)(p.ws + OFF_TABM); float* rs = (float*)(p.ws + OFF_RS);
  ada_phase(p, ldsf);
  tables_phase(p);
  convert_w<2>(p.ret_w_in, 6144, 1024, (bf16_t*)(p.ws + W0_RETIN), 6144, nullptr, ldsf);
  convert_w<0>(p.ret_w_out, 1024, 2048, (bf16_t*)(p.ws + W0_RETOUT), 1024, nullptr, ldsf);
  convert_w<1>(p.w13, 5632, 1024, (bf16_t*)(p.ws + W0_W13), 5632, nullptr, ldsf);
  convert_w<0>(p.w2, 1024, FF, (bf16_t*)(p.ws + W0_W2), 1024, nullptr, ldsf);
  grid.sync();
  modulate_phase(p, p.x, p.ctx, 0);
  grid.sync();
  { const bf16_t* wi = (const bf16_t*)(p.ws + W0_RETIN);
    { EpiRetQK e{(bf16_t*)(p.ws + R_QK), tabR}; big_gemm(a, wi, T_ALL, 2048, 1024, e, lds); }
    { EpiStore e{(bf16_t*)(p.ws + R_V), (bf16_t*)(p.ws + R_V), 1 << 30, 2048, 2048, 1.f}; big_gemm(a, wi + (size_t)2048 * 1024, T_ALL, 2048, 1024, e, lds); }
    grid.sync();
    scan_phase<256, false>(p, lds);
    grid.sync();
    { EpiStore e{(bf16_t*)(p.ws + R_QK), (bf16_t*)(p.ws + R_QK), 1 << 30, 2048, 2048, 1.f}; big_gemm(a, wi + (size_t)4096 * 1024, T_ALL, 2048, 1024, e, lds); }
    grid.sync();
    ret_readout_phase(p);
    grid.sync();
    { EpiResid e{p.x, p.ctx, p.out, hctx, mods + 2 * 1024}; big_gemm((const bf16_t*)(p.ws + R_O), (const bf16_t*)(p.ws + W0_RETOUT), T_ALL, 1024, 2048, e, lds); }
    grid.sync();
    ln_phase(p, 0, 0, 0, 3, true);
    convert_w<0>(p.na_w_qkv, 3072, 1024, (bf16_t*)(p.ws + W1_QKV), 3072, nullptr, ldsf);
    convert_w<0>(p.na_w_out, 1024, 1024, (bf16_t*)(p.ws + W1_OUT), 1024, nullptr, ldsf);
    convert_w<1>(p.w13 + (size_t)1 * 1024 * 5632, 5632, 1024, (bf16_t*)(p.ws + W1_W13), 5632, nullptr, ldsf);
    convert_w<0>(p.w2 + (size_t)1 * FF * 1024, 1024, FF, (bf16_t*)(p.ws + W1_W2), 1024, nullptr, ldsf);
    convert_w<5>(p.mla_w_down, 800, 1024, (bf16_t*)(p.ws + W2_DOWN), 1024, nullptr, ldsf);
    convert_w<3>(p.mla_w_uq, 1536, 512, (bf16_t*)(p.ws + W2_UQ), 1536, p.mla_q_norm, ldsf);
    convert_w<4>(p.mla_w_ukv, 2048, 256, (bf16_t*)(p.ws + W2_UKV), 2048, p.mla_kv_norm, ldsf);
    convert_w<0>(p.mla_w_out, 1024, 1024, (bf16_t*)(p.ws + W2_OUT), 1024, nullptr, ldsf);
    convert_w<1>(p.w13 + (size_t)2 * 1024 * 5632, 5632, 1024, (bf16_t*)(p.ws + W2_W13), 5632, nullptr, ldsf);
    convert_w<0>(p.w2 + (size_t)2 * FF * 1024, 1024, FF, (bf16_t*)(p.ws + W2_W2), 1024, nullptr, ldsf);
    convert_w<0>(p.hg_w_in, 5120, 1024, (bf16_t*)(p.ws + W3_IN), 5120, nullptr, ldsf);
    convert_w<0>(p.hg_w_out, 1024, 1024, (bf16_t*)(p.ws + W3_OUT), 1024, nullptr, ldsf);
    convert_w<1>(p.w13 + (size_t)3 * 1024 * 5632, 5632, 1024, (bf16_t*)(p.ws + W3_W13), 5632, nullptr, ldsf);
    convert_w<0>(p.w2 + (size_t)3 * FF * 1024, 1024, FF, (bf16_t*)(p.ws + W3_W2), 1024, nullptr, ldsf);
    grid.sync();
    ffn_and_ln(p, grid, lds, 0, (const bf16_t*)(p.ws + W0_W13), (const bf16_t*)(p.ws + W0_W2));
  }
  { const bf16_t* wq = (const bf16_t*)(p.ws + W1_QKV);
    { EpiStore e{(bf16_t*)(p.ws + N_Q), (bf16_t*)(p.ws + N_K), 1024, 1024, 1024, 0.125f}; big_gemm(a, wq, T_ALL, 2048, 1024, e, lds); }
    { GemmArgs g{a, 1024, wq + (size_t)2048 * 1024, 1024, T_ALL, 1024, 1024}; EpiVT e{(bf16_t*)(p.ws + N_VT), nullptr}; gemm_phase<true>(g, e, lds); }
    grid.sync();
    na_attn_phase(p, lds);
    grid.sync();
    { EpiResid e{p.out, hctx, p.out, hctx, mods + (size_t)1 * 5 * 6144 + 2 * 1024}; big_gemm(a, (const bf16_t*)(p.ws + W1_OUT), T_ALL, 1024, 1024, e, lds); }
    grid.sync();
    ln_phase(p, 1, 0, 1, 3, true);
    grid.sync();
    ffn_and_ln(p, grid, lds, 1, (const bf16_t*)(p.ws + W1_W13), (const bf16_t*)(p.ws + W1_W2));
  }
  { const bf16_t* d0 = (const bf16_t*)(p.ws + M_D0);
    { EpiStore e{(bf16_t*)(p.ws + M_D0), (bf16_t*)(p.ws + M_D0), 1 << 30, 1024, 1024, 1.f}; big_gemm(a, (const bf16_t*)(p.ws + W2_DOWN), T_ALL, 1024, 1024, e, lds); }
    grid.sync();
    mla_stats_phase(p);
    grid.sync();
    { GemmArgs g{d0, 1024, (const bf16_t*)(p.ws + W2_UQ), 512, T_ALL, 1536, 512}; EpiMlaQ e{(bf16_t*)(p.ws + M_Q), rs, tabM}; gemm_phase<false>(g, e, lds); }
    { GemmArgs g{d0 + 512, 1024, (const bf16_t*)(p.ws + W2_UKV), 256, T_ALL, 1024, 256}; EpiMlaK e{(bf16_t*)(p.ws + M_K), rs}; gemm_phase<false>(g, e, lds); }
    { GemmArgs g{d0 + 512, 1024, (const bf16_t*)(p.ws + W2_UKV) + (size_t)1024 * 256, 256, T_ALL, 1024, 256}; EpiVT e{(bf16_t*)(p.ws + M_VT), rs}; gemm_phase<true>(g, e, lds); }
    grid.sync();
    mla_attn_phase(p, lds);
    grid.sync();
    { EpiResid e{p.out, hctx, p.out, hctx, mods + (size_t)2 * 5 * 6144 + 2 * 1024}; big_gemm(a, (const bf16_t*)(p.ws + W2_OUT), T_ALL, 1024, 1024, e, lds); }
    grid.sync();
    ln_phase(p, 2, 0, 2, 3, true);
    grid.sync();
    ffn_and_ln(p, grid, lds, 2, (const bf16_t*)(p.ws + W2_W13), (const bf16_t*)(p.ws + W2_W2));
  }
  { { EpiHg e{(bf16_t*)(p.ws + H_P)}; big_gemm(a, (const bf16_t*)(p.ws + W3_IN), T_ALL, 5120, 1024, e, lds); }
    grid.sync();
    scan_phase<128, true>(p, lds);
    grid.sync();
    hg_readout_phase(p);
    grid.sync();
    { EpiResid e{p.out, hctx, p.out, hctx, mods + (size_t)3 * 5 * 6144 + 2 * 1024}; big_gemm(a, (const bf16_t*)(p.ws + W3_OUT), T_ALL, 1024, 1024, e, lds); }
    grid.sync();
    ln_phase(p, 3, 0, 3, 3, true);
    grid.sync();
    ffn_and_ln(p, grid, lds, 3, (const bf16_t*)(p.ws + W3_W13), (const bf16_t*)(p.ws + W3_W2));
  }
}

extern "C" void kernel_launch(void* const* d_in, const int* in_sizes, int n_in, void* d_out, int out_size, void* d_ws, size_t ws_size, hipStream_t stream) {
  static int grid_blocks = 0;
  if (!grid_blocks) {
    int dev = 0, cus = 0, per_cu = 0;
    (void)hipGetDevice(&dev);
    (void)hipDeviceGetAttribute(&cus, hipDeviceAttributeMultiprocessorCount, dev);
    (void)hipOccupancyMaxActiveBlocksPerMultiprocessor(&per_cu, mega, NTHR, 0);
    if (per_cu != 1) per_cu = 1;
    grid_blocks = cus * per_cu;
  }
  if (ws_size < WS_NEED) { fprintf(stderr, "workspace too small: %zu\n", ws_size); return; }
  Params p{};
  const float** f = (const float**)&p;
  for (int i = 0; i < 26; ++i) f[i] = (const float*)d_in[i];
  p.out = (float*)d_out; p.ws = (char*)d_ws;
  void* args[] = {&p};
  hipError_t e = hipLaunchCooperativeKernel((void*)mega, dim3(grid_blocks), dim3(NTHR), args, 0, stream);
  if (e != hipSuccess) fprintf(stderr, "cooperative launch failed: %s (grid %d)\n", hipGetErrorString(e), grid_blocks);
}
```

```cpp
#include <hip/hip_runtime.h>
#include <hip/hip_cooperative_groups.h>
#include <cstdio>
#include <cstdint>
namespace cg = cooperative_groups;

#define DI __device__ __forceinline__
DI int tid_() { int t = threadIdx.x; asm volatile("" : "+v"(t)); return t; }
typedef unsigned short bf16_t;
typedef short bf16x8 __attribute__((ext_vector_type(8)));
typedef short s16x4 __attribute__((ext_vector_type(4)));
typedef float f32x4 __attribute__((ext_vector_type(4)));
typedef float f32x16 __attribute__((ext_vector_type(16)));
typedef unsigned u32x4 __attribute__((ext_vector_type(4)));
typedef unsigned u32x2 __attribute__((ext_vector_type(2)));

constexpr int NTHR = 512;
constexpr int T_ALL = 33792, PB = 8448, LC = 256, LL = 8192, DM = 1024, FF = 2816;
constexpr float ALPHA = 1.681792830507429f;
constexpr float LOG2E = 1.4426950408889634f;
constexpr size_t MiB = 1048576;

struct Params {
  const float *x, *c, *ctx, *cctx, *ada_w, *ada_b, *ln_g, *ln_b, *w13, *w2;
  const float *ret_w_in, *ret_decay, *ret_w_out, *na_w_qkv, *na_rpb, *na_w_out;
  const float *mla_w_down, *mla_q_norm, *mla_kv_norm, *mla_w_uq, *mla_w_ukv, *mla_w_out;
  const float *hg_w_in, *hg_lb, *hg_norm_g, *hg_w_out;
  float* out; char* ws;
};

constexpr size_t OFF_MODS = 0;
constexpr size_t OFF_TABR = 512 * 1024;
constexpr size_t OFF_TABM = OFF_TABR + 65536;
constexpr size_t OFF_LBV = OFF_TABM + 8192;
constexpr size_t OFF_RS = OFF_LBV + 4096;
constexpr size_t OFF_BAR = 896 * 1024;
constexpr size_t OFF_HCTX = 1 * MiB;
constexpr size_t OFF_A = 5 * MiB;
constexpr size_t OFF_W0 = 71 * MiB;
constexpr size_t OFF_BIG = 104 * MiB;
constexpr size_t OFF_WR = OFF_BIG;
constexpr size_t OFF_S = 180 * MiB;
constexpr size_t WS_NEED = 512 * MiB;
constexpr size_t W0_RETIN = OFF_W0, W0_RETOUT = W0_RETIN + (size_t)6144 * 1024 * 2, W0_W13 = W0_RETOUT + (size_t)1024 * 2048 * 2, W0_W2 = W0_W13 + (size_t)5632 * 1024 * 2;
constexpr size_t SZ_W13 = (size_t)5632 * 1024 * 2, SZ_W2 = (size_t)1024 * 2816 * 2, SZ_SQ = (size_t)1024 * 1024 * 2;
constexpr size_t W1_QKV = OFF_WR, W1_OUT = W1_QKV + (size_t)3072 * 1024 * 2, W1_W13 = W1_OUT + SZ_SQ, W1_W2 = W1_W13 + SZ_W13;
constexpr size_t W2_DOWN = W1_W2 + SZ_W2, W2_UQ = W2_DOWN + (size_t)1024 * 1024 * 2, W2_UKV = W2_UQ + (size_t)1536 * 512 * 2, W2_OUT = W2_UKV + (size_t)2048 * 256 * 2, W2_W13 = W2_OUT + SZ_SQ, W2_W2 = W2_W13 + SZ_W13;
constexpr size_t W3_IN = W2_W2 + SZ_W2, W3_OUT = W3_IN + (size_t)5120 * 1024 * 2, W3_W13 = W3_OUT + SZ_SQ, W3_W2 = W3_W13 + SZ_W13, W3_END = W3_W2 + SZ_W2;
static_assert(W3_END <= OFF_S, "rest weights overflow");
static_assert(W0_W2 + SZ_W2 <= OFF_BIG, "W0 overflow");
constexpr size_t SZ_T2048 = (size_t)T_ALL * 2048 * 2, SZ_T1024 = (size_t)T_ALL * 1024 * 2;
constexpr size_t R_QK = OFF_BIG, R_V = R_QK + SZ_T2048, R_O = R_V + SZ_T2048;
static_assert(R_O + SZ_T2048 <= WS_NEED, "retention overflow");
constexpr size_t N_Q = OFF_S, N_K = N_Q + SZ_T1024, N_VT = N_K + SZ_T1024;
constexpr size_t M_D0 = OFF_S, M_Q = M_D0 + (size_t)T_ALL * 1024 * 2, M_K = M_Q + (size_t)T_ALL * 1536 * 2, M_VT = M_K + (size_t)T_ALL * 1536 * 2;
static_assert(M_VT + SZ_T1024 <= WS_NEED, "mla overflow");
constexpr size_t H_P = OFF_S;
static_assert(H_P + (size_t)T_ALL * 5120 * 2 <= WS_NEED, "hgrn overflow");
constexpr size_t F_U = OFF_S;

typedef float f32x2 __attribute__((ext_vector_type(2)));
typedef __bf16 bf16x2_t __attribute__((ext_vector_type(2)));
DI unsigned pk2(float lo, float hi) { const f32x2 v = {lo, hi}; const bf16x2_t r = __builtin_convertvector(v, bf16x2_t); return __builtin_bit_cast(unsigned, r); }
DI float bflo(unsigned u) { return __uint_as_float(u << 16); }
DI float bfhi(unsigned u) { return __uint_as_float(u & 0xffff0000u); }
DI float bf2f(bf16_t v) { return __uint_as_float(((unsigned)v) << 16); }
DI bf16_t f2bf(float x) { return (bf16_t)(pk2(x, 0.f) & 0xffffu); }
DI float siluf(float x) { return x / (1.f + __expf(-x)); }
DI f32x4 mfma16(bf16x8 a, bf16x8 b, f32x4 c) { return __builtin_amdgcn_mfma_f32_16x16x32_bf16(a, b, c, 0, 0, 0); }
DI f32x16 mfma32(bf16x8 a, bf16x8 b, f32x16 c) { return __builtin_amdgcn_mfma_f32_32x32x16_bf16(a, b, c, 0, 0, 0); }
DI bf16x8 cat44(s16x4 lo, s16x4 hi) { return __builtin_shufflevector(lo, hi, 0, 1, 2, 3, 4, 5, 6, 7); }
DI bf16x8 pack8(float a0, float a1, float a2, float a3, float a4, float a5, float a6, float a7) {
  u32x4 p; p.x = pk2(a0, a1); p.y = pk2(a2, a3); p.z = pk2(a4, a5); p.w = pk2(a6, a7); return __builtin_bit_cast(bf16x8, p);
}
DI int clampi(int v, int lo, int hi) { return v < lo ? lo : (v > hi ? hi : v); }
DI float* hrow(float* hlat, float* hctx, int t) { const int b = t / PB, p = t - b * PB; return p < LC ? hctx + (size_t)(b * LC + p) * DM : hlat + (size_t)(b * LL + p - LC) * DM; }
DI const float* hrowc(const float* hlat, const float* hctx, int t) { const int b = t / PB, p = t - b * PB; return p < LC ? hctx + (size_t)(b * LC + p) * DM : hlat + (size_t)(b * LL + p - LC) * DM; }
DI int modvec(int t) { const int b = t / PB, p = t - b * PB; return p < LC ? 4 : b; }

template <int MODE> DI int srccol(int n) {
  if (MODE == 0) return n;
  if (MODE == 1) { const int c = n >> 5, s = (n >> 4) & 1, i = n & 15; return s * FF + 16 * c + i; }
  if (MODE == 2) { if (n >= 2048) return n; const int w = n & 255, j = w >> 1, s = w & 1; return (n & ~255) + s * 128 + j; }
  if (MODE == 3) { const int h = n / 96, w = n - h * 96; if (w < 64) return n; const int wp = w - 64, j = wp >> 1, s = wp & 1; return h * 96 + 64 + s * 16 + j; }
  if (MODE == 4) { if (n < 1024) return (n >> 6) * 128 + (n & 63); const int m = n - 1024; return (m >> 6) * 128 + 64 + (m & 63); }
  if (MODE == 5) return n < 800 ? n : -1;
  return n;
}
template <int MODE>
DI void convert_w(const float* __restrict__ src, int Nsrc, int K, bf16_t* __restrict__ dst, int Ndst, const float* __restrict__ kscale, float* ldsf) {
  const int tid = threadIdx.x, tn = Ndst / 64, tk = K / 64;
  for (int tile = blockIdx.x; tile < tn * tk; tile += gridDim.x) {
    const int n0 = (tile % tn) * 64, k0 = (tile / tn) * 64;
    __syncthreads();
    for (int e = tid; e < 4096; e += NTHR) {
      const int kk = e >> 6, nn = e & 63, sc = srccol<MODE>(n0 + nn);
      float v = sc >= 0 ? src[(size_t)(k0 + kk) * Nsrc + sc] : 0.f;
      if (kscale) v *= kscale[k0 + kk];
      ldsf[kk * 65 + nn] = v;
    }
    __syncthreads();
    { const int nn = tid >> 3, kc = tid & 7; const float* lp = ldsf + (kc * 8) * 65 + nn;
      u32x4 o; o.x = pk2(lp[0], lp[65]); o.y = pk2(lp[130], lp[195]); o.z = pk2(lp[260], lp[325]); o.w = pk2(lp[390], lp[455]);
      *(u32x4*)(dst + (size_t)(n0 + nn) * K + k0 + kc * 8) = o; }
  }
}

DI void ada_phase(const Params& p, float* ldsf) {
  const int tid = threadIdx.x, lane = tid & 63, w = tid >> 6;
  float* mods = (float*)(p.ws + OFF_MODS);
  __syncthreads();
  for (int e = tid; e < 5120; e += NTHR) { const int mv = e >> 10, k = e & 1023; const float cv = mv < 4 ? p.c[mv * 1024 + k] : p.cctx[k]; ldsf[e] = siluf(cv); }
  __syncthreads();
  float* red = ldsf + 5120;
  for (int item = blockIdx.x; item < 4 * 96; item += gridDim.x) {
    const int i = item / 96, n0 = (item % 96) * 64;
    const float* wp = p.ada_w + (size_t)i * 1024 * 6144 + n0 + lane;
    float a0 = 0.f, a1 = 0.f, a2 = 0.f, a3 = 0.f, a4 = 0.f;
#pragma unroll 8
    for (int kk = 0; kk < 128; ++kk) { const int k = w * 128 + kk; const float wv = wp[(size_t)k * 6144];
      a0 += ldsf[k] * wv; a1 += ldsf[1024 + k] * wv; a2 += ldsf[2048 + k] * wv; a3 += ldsf[3072 + k] * wv; a4 += ldsf[4096 + k] * wv; }
    red[(w * 5 + 0) * 64 + lane] = a0; red[(w * 5 + 1) * 64 + lane] = a1; red[(w * 5 + 2) * 64 + lane] = a2; red[(w * 5 + 3) * 64 + lane] = a3; red[(w * 5 + 4) * 64 + lane] = a4;
    __syncthreads();
    if (tid < 320) { const int mv = tid >> 6; float s = 0.f;
#pragma unroll
      for (int ww = 0; ww < 8; ++ww) s += red[(ww * 5 + mv) * 64 + lane];
      mods[(size_t)(i * 5 + mv) * 6144 + n0 + lane] = s + p.ada_b[i * 6144 + n0 + lane]; }
    __syncthreads();
  }
}
DI void tables_phase(const Params& p) {
  const int gt = blockIdx.x * NTHR + threadIdx.x, gn = gridDim.x * NTHR;
  float2* tabR = (float2*)(p.ws + OFF_TABR); float2* tabM = (float2*)(p.ws + OFF_TABM); float* lbv = (float*)(p.ws + OFF_LBV);
  for (int e = gt; e < 128 * 64; e += gn) { const int v = e >> 6, i = e & 63; const float inv = powf(10000.f, -(float)i / 64.f); const float ang = (float)v * inv; tabR[e] = make_float2(cosf(ang), sinf(ang)); }
  for (int e = gt; e < 128 * 8; e += gn) { const int v = e >> 3, i = e & 7; const float inv = powf(10000.f, -(float)i / 8.f); const float ang = (float)v * inv; tabM[e] = make_float2(cosf(ang), sinf(ang)); }
  for (int e = gt; e < 1024; e += gn) { const float l0 = p.hg_lb[e], l1 = p.hg_lb[1024 + e], l2 = p.hg_lb[2048 + e], l3 = p.hg_lb[3072 + e];
    const float mx = fmaxf(fmaxf(l0, l1), fmaxf(l2, l3)); const float e0 = expf(l0 - mx), e1 = expf(l1 - mx), e2 = expf(l2 - mx), e3 = expf(l3 - mx);
    lbv[e] = (e1 + e2 + e3) / (e0 + e1 + e2 + e3); }
}

DI void modulate_phase(const Params& p, const float* slat, const float* sctx, int layer) {
  const float* mods = (const float*)(p.ws + OFF_MODS); bf16_t* a = (bf16_t*)(p.ws + OFF_A);
  const int gt = blockIdx.x * NTHR + threadIdx.x, gn = gridDim.x * NTHR;
  for (int e = gt; e < T_ALL * 128; e += gn) {
    const int t = e >> 7, c0 = (e & 127) * 8; const float* s = hrowc(slat, sctx, t) + c0; const float* m = mods + (size_t)(layer * 5 + modvec(t)) * 6144;
    const f32x4 x0 = *(const f32x4*)s, x1 = *(const f32x4*)(s + 4), sh0 = *(const f32x4*)(m + c0), sh1 = *(const f32x4*)(m + c0 + 4), sc0 = *(const f32x4*)(m + 1024 + c0), sc1 = *(const f32x4*)(m + 1024 + c0 + 4);
    const f32x4 y0 = x0 * (1.f + sc0) + sh0, y1 = x1 * (1.f + sc1) + sh1;
    u32x4 o; o.x = pk2(y0[0], y0[1]); o.y = pk2(y0[2], y0[3]); o.z = pk2(y1[0], y1[1]); o.w = pk2(y1[2], y1[3]);
    *(u32x4*)(a + (size_t)t * 1024 + c0) = o;
  }
}
DI void ln_phase(const Params& p, int lnlayer, int lnidx, int ml, int js, bool write_a) {
  const float* mods = (const float*)(p.ws + OFF_MODS); bf16_t* a = (bf16_t*)(p.ws + OFF_A); float* hctx = (float*)(p.ws + OFF_HCTX);
  const int tid = threadIdx.x, lane = tid & 63, gw = blockIdx.x * 8 + (tid >> 6), nw = gridDim.x * 8;
  const float* gp = p.ln_g + (size_t)(lnlayer * 2 + lnidx) * 1024; const float* bp = p.ln_b + (size_t)(lnlayer * 2 + lnidx) * 1024;
  for (int t = gw; t < T_ALL; t += nw) {
    float* hr = hrow(p.out, hctx, t);
    f32x4 v[4]; float s = 0.f;
#pragma unroll
    for (int i = 0; i < 4; ++i) { v[i] = *(const f32x4*)(hr + i * 256 + lane * 4); s += (v[i][0] + v[i][1]) + (v[i][2] + v[i][3]); }
#pragma unroll
    for (int o = 1; o < 64; o <<= 1) s += __shfl_xor(s, o);
    const float mean = s * (1.f / 1024.f); float q = 0.f;
#pragma unroll
    for (int i = 0; i < 4; ++i) { v[i] = v[i] - mean; q += (v[i][0] * v[i][0] + v[i][1] * v[i][1]) + (v[i][2] * v[i][2] + v[i][3] * v[i][3]); }
#pragma unroll
    for (int o = 1; o < 64; o <<= 1) q += __shfl_xor(q, o);
    const float rstd = rsqrtf(q * (1.f / 1024.f) + 1e-5f);
    const float* m = mods + (size_t)(ml * 5 + modvec(t)) * 6144 + (size_t)js * 1024;
#pragma unroll
    for (int i = 0; i < 4; ++i) { const int c0 = i * 256 + lane * 4;
      const f32x4 y = v[i] * rstd * *(const f32x4*)(gp + c0) + *(const f32x4*)(bp + c0);
      *(f32x4*)(hr + c0) = y;
      if (write_a) { const f32x4 z = y * (1.f + *(const f32x4*)(m + 1024 + c0)) + *(const f32x4*)(m + c0); u32x2 o; o.x = pk2(z[0], z[1]); o.y = pk2(z[2], z[3]); *(u32x2*)(a + (size_t)t * 1024 + c0) = o; } }
  }
}

namespace pg8 {
#define PG8_LAS __attribute__((address_space(3)))
typedef unsigned short bf16_t;
typedef short bf16x8 __attribute__((ext_vector_type(8)));
typedef float f32x4 __attribute__((ext_vector_type(4)));
typedef unsigned u32x4 __attribute__((ext_vector_type(4)));
constexpr int BM = 256, BK = 64, HALF = 128, HTB = HALF * BK * 2  , STAGE_BYTES = 8 * HTB, NXCD = 8, WGM = 8;

__host__ __device__ __forceinline__ int lds_byte(int r, int c) { const int st = (r >> 4) * 2 + (c >> 5), rr = r & 15, cc = c & 31, ob = rr * 64 + cc * 2; return st * 1024 + (ob ^ (((ob >> 9) & 1) << 5)); }
__host__ __device__ __forceinline__ void stage_rc(int b, int& R, int& C) { const int st = b / 1024, sb = b % 1024, swz = sb ^ (((sb >> 9) & 1) << 5); R = (st >> 1) * 16 + swz / 64; C = (st & 1) * 32 + (swz % 64) / 2; }
__host__ __device__ __forceinline__ int perm32(int rho) { const int n = rho >> 4, i = rho & 15; return 8 * (i >> 2) + 4 * n + (i & 3); }

struct Unit { int pm, pn; };
struct Gemm { const bf16_t* A; const bf16_t* Bt; int M, N, K; };

struct StaticOrder {
    int nM, nN, nwg, G, c;
    __host__ __device__ void init(int M, int N, int G_, int c_) { nM = M / BM; nN = N / BM; nwg = nM * nN; G = G_; c = c_; }
    __host__ __device__ bool next(int i, Unit& u) const {
        const long L = (long)i * G + c; if (L >= nwg) return false;
        int wgid = (int)L; { const int q = nwg / NXCD, r = nwg % NXCD, xcd = wgid % NXCD, off = wgid / NXCD; wgid = (xcd < r ? xcd * (q + 1) : r * (q + 1) + (xcd - r) * q) + off; }
        const int nig = WGM * nN, gid = wgid / nig, fm = gid * WGM, gsz = (nM - fm) < WGM ? (nM - fm) : WGM;
        u.pm = fm + ((wgid % nig) % gsz); u.pn = (wgid % nig) / gsz; return true;
    }
    __device__ __forceinline__ void a_ready(const Unit&) const {}
    __device__ __forceinline__ void done(const Unit&) const {}
};
template <class Epi, class Sched, bool ALIGN_EPI = false, bool SP2 = false>
__device__ __forceinline__ void gemm_phase(PG8_LAS unsigned char* lds, const Gemm g, const Sched& S, const Epi& E) {
    const int tid = tid_(), wid = __builtin_amdgcn_readfirstlane(tid >> 6), lane = tid & 63, wr = wid >> 2, wc = wid & 3, fr = lane & 15, fq = lane >> 4;
    const int K = g.K, nt = K / BK;
    unsigned voffA[2], voffB[2];
#pragma unroll
    for (int i = 0; i < 2; ++i) { int R, C; stage_rc(tid * 16 + i * 8192, R, C); const int Rb = Epi::PERM ? ((R & ~31) + perm32(R & 31)) : R;
        voffA[i] = (unsigned)(R * K + C) * 2u; voffB[i] = (unsigned)(Rb * K + C) * 2u; }
    const size_t kstep = (size_t)(BK * 2);
    const size_t hstep = (size_t)HALF * K * 2;
    const size_t tstep = 2 * hstep;
    const unsigned ldsw = (unsigned)wid * 1024u;
    const int aoff = lds_byte(wr * 64 + fr, fq * 8), boff = lds_byte(wc * 32 + fr, fq * 8);
#define PG8_SA(b, h) (((b) * 2 + (h)) * HTB)
#define PG8_SB(b, h) ((4 + (b) * 2 + (h)) * HTB)
#define PG8_STAGE(bufoff, gbase, voff) do { _Pragma("unroll") for (int _i = 0; _i < 2; ++_i) \
        __builtin_amdgcn_global_load_lds((const unsigned*)((const char*)(gbase) + (voff)[_i]), (PG8_LAS unsigned*)(lds + (bufoff) + ldsw + _i * 8192), 16, 0, 0); } while (0)
#define PG8_LDA(dst, b, h) do { _Pragma("unroll") for (int m = 0; m < 4; ++m) _Pragma("unroll") for (int k = 0; k < 2; ++k) dst[m][k] = *(const PG8_LAS bf16x8*)(lds + PG8_SA(b, h) + aoff + m * 2048 + k * 1024); } while (0)
#define PG8_LDB(dst, b, h) do { _Pragma("unroll") for (int n = 0; n < 2; ++n) _Pragma("unroll") for (int k = 0; k < 2; ++k) dst[n][k] = *(const PG8_LAS bf16x8*)(lds + PG8_SB(b, h) + boff + n * 2048 + k * 1024); } while (0)
#define PG8_MMA(ai, bj, At, Bt) do { __builtin_amdgcn_s_setprio(1); _Pragma("unroll") for (int m = 0; m < 4; ++m) _Pragma("unroll") for (int n = 0; n < 2; ++n) _Pragma("unroll") for (int k = 0; k < 2; ++k) \
        acc[ai][bj][m][n] = __builtin_amdgcn_mfma_f32_16x16x32_bf16(Bt[n][k], At[m][k], acc[ai][bj][m][n], 0, 0, 0); __builtin_amdgcn_s_setprio(0); } while (0)
#define PG8_WAIT_V(n) asm volatile("s_waitcnt vmcnt(" #n ")" ::: "memory")
#define PG8_WAIT_L(n) asm volatile("s_waitcnt lgkmcnt(" #n ")" ::: "memory")
#define PG8_BAR __builtin_amdgcn_s_barrier()
#define PG8_SCHED __builtin_amdgcn_sched_barrier(0)
    Unit cur, nxt; int ui = 0;
    if (!S.next(0, cur)) return;
    f32x4 acc[2][2][4][2];
#pragma unroll
    for (int a = 0; a < 2; ++a)
#pragma unroll
        for (int b = 0; b < 2; ++b)
#pragma unroll
            for (int m = 0; m < 4; ++m)
#pragma unroll
                for (int n = 0; n < 2; ++n) acc[a][b][m][n] = (f32x4){0.f, 0.f, 0.f, 0.f};
    bf16x8 At[4][2], B0[2][2], B1[2][2];
    const char* cA = (const char*)g.A + (size_t)cur.pm * tstep; const char* cB = (const char*)g.Bt + (size_t)cur.pn * tstep;
    S.a_ready(cur);
    if constexpr (SP2) {
        PG8_STAGE(PG8_SB(0, 0), cB, voffB); PG8_STAGE(PG8_SB(0, 1), cB + hstep, voffB); PG8_STAGE(PG8_SA(0, 0), cA, voffA); PG8_STAGE(PG8_SA(0, 1), cA + hstep, voffA);
        if (wr == 1) PG8_BAR;
        PG8_WAIT_V(2); PG8_BAR;
        PG8_STAGE(PG8_SB(1, 0), cB + kstep, voffB); PG8_STAGE(PG8_SA(1, 0), cA + kstep, voffA); PG8_STAGE(PG8_SB(1, 1), cB + hstep + kstep, voffB);
        PG8_WAIT_V(6); PG8_BAR;
    } else {
        PG8_STAGE(PG8_SB(0, 0), cB, voffB); PG8_STAGE(PG8_SA(0, 0), cA, voffA); PG8_STAGE(PG8_SB(0, 1), cB + hstep, voffB); PG8_STAGE(PG8_SA(0, 1), cA + hstep, voffA);
        if (wr == 1) PG8_BAR;
        PG8_WAIT_V(4); PG8_BAR;
        PG8_STAGE(PG8_SB(1, 0), cB + kstep, voffB); PG8_STAGE(PG8_SA(1, 0), cA + kstep, voffA); PG8_STAGE(PG8_SB(1, 1), cB + hstep + kstep, voffB);
        PG8_WAIT_V(6); PG8_BAR;
    }
    for (;;) {
        const bool has_next = S.next(ui + 1, nxt);
        const char* nA = has_next ? (const char*)g.A + (size_t)nxt.pm * tstep : cA; const char* nB = has_next ? (const char*)g.Bt + (size_t)nxt.pn * tstep : cB;
        for (int t = 0; t < nt; t += 2) {
            const bool last = (t == nt - 2);
            const char* a1 = cA + (size_t)(t + 1) * kstep;
            const char* a2 = last ? nA : cA + (size_t)(t + 2) * kstep; const char* b2 = last ? nB : cB + (size_t)(t + 2) * kstep;
            const char* a3 = a2 + kstep; const char* b3 = b2 + kstep;
            if (last && has_next) S.a_ready(nxt);
            if constexpr (SP2) {
            PG8_LDB(B0, 0, 0); PG8_LDB(B1, 0, 1); PG8_SCHED; PG8_LDA(At, 0, 0); PG8_STAGE(PG8_SA(1, 1), a1 + hstep, voffA);
            PG8_WAIT_V(8); PG8_WAIT_L(0); PG8_BAR; PG8_MMA(0, 0, At, B0); PG8_MMA(0, 1, At, B1); PG8_BAR; PG8_SCHED;
            PG8_LDA(At, 0, 1); PG8_STAGE(PG8_SB(0, 0), b2, voffB); PG8_STAGE(PG8_SB(0, 1), b2 + hstep, voffB); PG8_STAGE(PG8_SA(0, 0), a2, voffA);
            PG8_WAIT_V(8); PG8_WAIT_L(0); PG8_BAR; PG8_MMA(1, 0, At, B0); PG8_MMA(1, 1, At, B1); PG8_BAR; PG8_SCHED;
            PG8_LDB(B0, 1, 0); PG8_LDB(B1, 1, 1); PG8_SCHED; PG8_LDA(At, 1, 0); PG8_STAGE(PG8_SA(0, 1), a2 + hstep, voffA);
            PG8_WAIT_V(8); PG8_WAIT_L(0); PG8_BAR; PG8_MMA(0, 0, At, B0); PG8_MMA(0, 1, At, B1); PG8_BAR; PG8_SCHED;
            PG8_LDA(At, 1, 1); PG8_STAGE(PG8_SB(1, 0), b3, voffB); PG8_STAGE(PG8_SB(1, 1), b3 + hstep, voffB); PG8_STAGE(PG8_SA(1, 0), a3, voffA);
            PG8_WAIT_V(8); PG8_WAIT_L(0); PG8_BAR; PG8_MMA(1, 0, At, B0); PG8_MMA(1, 1, At, B1); PG8_BAR; PG8_SCHED;
            } else {
            PG8_LDB(B0, 0, 0); PG8_SCHED; PG8_LDA(At, 0, 0); PG8_STAGE(PG8_SA(1, 1), a1 + hstep, voffA);
            PG8_WAIT_L(8); PG8_BAR; PG8_WAIT_L(0); PG8_MMA(0, 0, At, B0); PG8_BAR; PG8_SCHED;
            PG8_LDB(B1, 0, 1); PG8_STAGE(PG8_SB(0, 0), b2, voffB);
            PG8_BAR; PG8_WAIT_L(0); PG8_MMA(0, 1, At, B1); PG8_BAR;
            PG8_LDA(At, 0, 1); PG8_STAGE(PG8_SA(0, 0), a2, voffA);
            PG8_BAR; PG8_WAIT_L(0); PG8_MMA(1, 0, At, B0); PG8_BAR; PG8_SCHED;
            PG8_STAGE(PG8_SB(0, 1), b2 + hstep, voffB);
            PG8_WAIT_V(6); PG8_BAR; PG8_MMA(1, 1, At, B1); PG8_BAR;
            PG8_LDB(B0, 1, 0); PG8_SCHED; PG8_LDA(At, 1, 0); PG8_STAGE(PG8_SA(0, 1), a2 + hstep, voffA);
            PG8_WAIT_L(8); PG8_BAR; PG8_WAIT_L(0); PG8_MMA(0, 0, At, B0); PG8_BAR; PG8_SCHED;
            PG8_LDB(B1, 1, 1); PG8_STAGE(PG8_SB(1, 0), b3, voffB);
            PG8_BAR; PG8_WAIT_L(0); PG8_MMA(0, 1, At, B1); PG8_BAR;
            PG8_LDA(At, 1, 1); PG8_STAGE(PG8_SA(1, 0), a3, voffA);
            PG8_BAR; PG8_WAIT_L(0); PG8_MMA(1, 0, At, B0); PG8_BAR; PG8_SCHED;
            PG8_STAGE(PG8_SB(1, 1), b3 + hstep, voffB);
            PG8_WAIT_V(6); PG8_BAR; PG8_MMA(1, 1, At, B1); PG8_BAR;
            }
        }
        if constexpr (ALIGN_EPI) { if (wr == 0) PG8_BAR; }
        if constexpr (!Epi::AFTER_DRAIN) { E(acc, cur, wr, wc, fr, fq); S.done(cur); }
        if (!has_next) break;
#pragma unroll
        for (int a = 0; a < 2; ++a)
#pragma unroll
            for (int b = 0; b < 2; ++b)
#pragma unroll
                for (int m = 0; m < 4; ++m)
#pragma unroll
                    for (int n = 0; n < 2; ++n) acc[a][b][m][n] = (f32x4){0.f, 0.f, 0.f, 0.f};
        cur = nxt; cA = nA; cB = nB; ++ui;
        if constexpr (ALIGN_EPI) { if (wr == 1) PG8_BAR; }
    }
    PG8_WAIT_V(0);
    if constexpr (!ALIGN_EPI) { if (wr == 0) PG8_BAR; }
    PG8_BAR;
    if constexpr (Epi::AFTER_DRAIN) { E.fused(acc, cur, wr, wc, fr, fq, lds, wid, lane); S.done(cur); }
#undef PG8_SA
#undef PG8_SB
#undef PG8_STAGE
#undef PG8_LDA
#undef PG8_LDB
#undef PG8_MMA
#undef PG8_WAIT_V
#undef PG8_WAIT_L
#undef PG8_BAR
#undef PG8_SCHED
}
}

template <class E4> struct EpiWrap { static constexpr bool PERM = false, AFTER_DRAIN = false; E4 e;
  DI void operator()(const f32x4 (&acc)[2][2][4][2], const pg8::Unit& u, int wr, int wc, int fr, int fq) const {
#pragma unroll
    for (int ai = 0; ai < 2; ++ai)
#pragma unroll
      for (int m = 0; m < 4; ++m) { const int row = u.pm * 256 + ai * 128 + wr * 64 + m * 16 + fr;
#pragma unroll
        for (int bj = 0; bj < 2; ++bj) { const int col = u.pn * 256 + bj * 128 + wc * 32 + 4 * fq;
          if constexpr (E4::PAIR) e.pair(row, ((col - 4 * fq) >> 1) + 4 * fq, acc[ai][bj][m][0], acc[ai][bj][m][1]);
          else { e(row, col, acc[ai][bj][m][0]); e(row, col + 16, acc[ai][bj][m][1]); } }
        asm volatile("" ::: "memory"); }
  } };
template <class E4>
DI void big_gemm(const bf16_t* A, const bf16_t* W, int M, int N, int K, const E4& e4, char* lds) {
  __syncthreads();
  pg8::Gemm g{A, W, M, N, K}; pg8::StaticOrder S; S.init(M, N, (int)gridDim.x, (int)blockIdx.x); EpiWrap<E4> E{e4};
  pg8::gemm_phase<EpiWrap<E4>, pg8::StaticOrder, true, true>((PG8_LAS unsigned char*)lds, g, S, E);
  __syncthreads();
}
struct GemmArgs { const bf16_t* A; int lda; const bf16_t* W; int ldw; int M, N, K; };
constexpr int LDT = 72;
template <bool TRANS, class Epi>
DI void gemm_phase(const GemmArgs g, const Epi epi, char* lds) {
  const int tid = threadIdx.x, lane = tid & 63, w = tid >> 6, wm = w & 3, wn = w >> 2, g4 = lane >> 4, l16 = lane & 15;
  const int nN = g.N / 128, ntiles = (g.M / 256) * nN, nk = g.K / 64;
  bf16_t* As = (bf16_t*)lds; bf16_t* Bs = As + 256 * LDT;
  for (int tile = blockIdx.x; tile < ntiles; tile += gridDim.x) {
    const int pm = tile / nN, pn = tile - pm * nN;
    const bf16_t* Ag = g.A + (size_t)(pm * 256) * g.lda; const bf16_t* Wg = g.W + (size_t)(pn * 128) * g.ldw;
    f32x4 acc[4][4];
#pragma unroll
    for (int i = 0; i < 4; ++i)
#pragma unroll
      for (int j = 0; j < 4; ++j) acc[i][j] = (f32x4){0.f, 0.f, 0.f, 0.f};
    u32x4 ra[4], rb[2];
#pragma unroll
    for (int i = 0; i < 4; ++i) { const int c = tid + NTHR * i; ra[i] = *(const u32x4*)(Ag + (size_t)(c >> 3) * g.lda + (c & 7) * 8); }
#pragma unroll
    for (int i = 0; i < 2; ++i) { const int c = tid + NTHR * i; rb[i] = *(const u32x4*)(Wg + (size_t)(c >> 3) * g.ldw + (c & 7) * 8); }
    for (int kt = 0; kt < nk; ++kt) {
      __syncthreads();
#pragma unroll
      for (int i = 0; i < 4; ++i) { const int c = tid + NTHR * i; *(u32x4*)(As + (c >> 3) * LDT + (c & 7) * 8) = ra[i]; }
#pragma unroll
      for (int i = 0; i < 2; ++i) { const int c = tid + NTHR * i; *(u32x4*)(Bs + (c >> 3) * LDT + (c & 7) * 8) = rb[i]; }
      __syncthreads();
      if (kt + 1 < nk) { const int k0 = (kt + 1) * 64;
#pragma unroll
        for (int i = 0; i < 4; ++i) { const int c = tid + NTHR * i; ra[i] = *(const u32x4*)(Ag + (size_t)(c >> 3) * g.lda + k0 + (c & 7) * 8); }
#pragma unroll
        for (int i = 0; i < 2; ++i) { const int c = tid + NTHR * i; rb[i] = *(const u32x4*)(Wg + (size_t)(c >> 3) * g.ldw + k0 + (c & 7) * 8); } }
#pragma unroll
      for (int ks = 0; ks < 2; ++ks) {
        bf16x8 af[4], wf[4];
#pragma unroll
        for (int i = 0; i < 4; ++i) af[i] = *(const bf16x8*)(As + (wm * 64 + i * 16 + l16) * LDT + ks * 32 + g4 * 8);
#pragma unroll
        for (int j = 0; j < 4; ++j) wf[j] = *(const bf16x8*)(Bs + (wn * 64 + j * 16 + l16) * LDT + ks * 32 + g4 * 8);
#pragma unroll
        for (int i = 0; i < 4; ++i)
#pragma unroll
          for (int j = 0; j < 4; ++j) acc[i][j] = TRANS ? mfma16(af[i], wf[j], acc[i][j]) : mfma16(wf[j], af[i], acc[i][j]);
      }
    }
    const int mb = pm * 256 + wm * 64, nb = pn * 128 + wn * 64;
    if constexpr (Epi::PAIR) {
#pragma unroll
      for (int i = 0; i < 4; ++i)
#pragma unroll
        for (int j = 0; j < 2; ++j) epi.pair(mb + i * 16 + l16, (nb >> 1) + 16 * j + 4 * g4, acc[i][2 * j], acc[i][2 * j + 1]);
    } else {
#pragma unroll
      for (int i = 0; i < 4; ++i)
#pragma unroll
        for (int j = 0; j < 4; ++j) { if (TRANS) epi(mb + i * 16 + 4 * g4, nb + j * 16 + l16, acc[i][j]); else epi(mb + i * 16 + l16, nb + j * 16 + 4 * g4, acc[i][j]); }
    }
  }
}
DI void st4bf(bf16_t* p, f32x4 v) { u32x2 o; o.x = pk2(v[0], v[1]); o.y = pk2(v[2], v[3]); *(u32x2*)p = o; }
struct EpiStore { static constexpr bool PAIR = false; bf16_t* d0; bf16_t* d1; int split, ld0, ld1; float s0;
  DI void operator()(int m, int n, f32x4 v) const { if (n < split) st4bf(d0 + (size_t)m * ld0 + n, v * s0); else st4bf(d1 + (size_t)m * ld1 + (n - split), v); } };
struct EpiVT { static constexpr bool PAIR = false; bf16_t* vt; const float* rs;
  DI void operator()(int m, int n, f32x4 v) const { const int b = m / PB, pos = m - b * PB;
    if (rs) { v[0] *= rs[2 * m + 1]; v[1] *= rs[2 * m + 3]; v[2] *= rs[2 * m + 5]; v[3] *= rs[2 * m + 7]; }
    st4bf(vt + ((size_t)(b * 1024 + n)) * PB + pos, v); } };
struct EpiResid { static constexpr bool PAIR = false; const float* slat; const float* sctx; float* dlat; float* dctx; const float* gate;
  DI void operator()(int m, int n, f32x4 v) const { const int mv = modvec(m); const f32x4 hv = *(const f32x4*)(hrowc(slat, sctx, m) + n); const f32x4 gt = *(const f32x4*)(gate + (size_t)mv * 6144 + n);
    *(f32x4*)(hrow(dlat, dctx, m) + n) = ALPHA * hv + gt * v; } };
struct EpiSwiglu { static constexpr bool PAIR = true; bf16_t* u;
  DI void pair(int m, int f, f32x4 gt, f32x4 up) const { f32x4 r; r[0] = siluf(gt[0]) * up[0]; r[1] = siluf(gt[1]) * up[1]; r[2] = siluf(gt[2]) * up[2]; r[3] = siluf(gt[3]) * up[3]; st4bf(u + (size_t)m * FF + f, r); } };
struct EpiRetQK { static constexpr bool PAIR = false; bf16_t* qk; const float2* tabR;
  DI void operator()(int m, int n, f32x4 v) const { const int b = m / PB, pp = m - b * PB;
    if (pp >= LC) { const int pos = pp - LC, row = pos >> 6, col = pos & 63; const int j0 = (n & 255) >> 1;
      const int vv = j0 < 64 ? row : col; const float2 c0 = tabR[vv * 64 + (j0 & 63)], c1 = tabR[vv * 64 + ((j0 + 1) & 63)];
      const float a0 = v[0] * c0.x - v[1] * c0.y, b0 = v[0] * c0.y + v[1] * c0.x, a1 = v[2] * c1.x - v[3] * c1.y, b1 = v[2] * c1.y + v[3] * c1.x; v = (f32x4){a0, b0, a1, b1}; }
    if (n >= 1024) v = v * 0.0625f;
    st4bf(qk + (size_t)m * 2048 + n, v); } };
struct EpiHg { static constexpr bool PAIR = false; bf16_t* ph;
  DI void operator()(int m, int n, f32x4 v) const { if (n < 1024) { v[0] = siluf(v[0]); v[1] = siluf(v[1]); v[2] = siluf(v[2]); v[3] = siluf(v[3]); v = v * 0.08838834764831845f; } st4bf(ph + (size_t)m * 5120 + n, v); } };
struct EpiMlaQ { static constexpr bool PAIR = false; bf16_t* q; const float* rs; const float2* tabM;
  DI void operator()(int m, int n, f32x4 v) const { v = v * (rs[2 * m] * 0.10206207261596577f * LOG2E); const int h = n / 96, w = n - h * 96; const int b = m / PB, pp = m - b * PB;
    if (w >= 64 && pp >= LC) { const int pos = pp - LC, row = pos >> 6, col = pos & 63; const int j0 = (w - 64) >> 1; const int vv = j0 < 8 ? row : col; const float2 c0 = tabM[vv * 8 + (j0 & 7)], c1 = tabM[vv * 8 + ((j0 + 1) & 7)];
      const float a0 = v[0] * c0.x - v[1] * c0.y, b0 = v[0] * c0.y + v[1] * c0.x, a1 = v[2] * c1.x - v[3] * c1.y, b1 = v[2] * c1.y + v[3] * c1.x; v = (f32x4){a0, b0, a1, b1}; }
    st4bf(q + (size_t)m * 1536 + n, v); } };
struct EpiMlaK { static constexpr bool PAIR = false; bf16_t* k; const float* rs;
  DI void operator()(int m, int n, f32x4 v) const { v = v * rs[2 * m + 1]; st4bf(k + (size_t)m * 1536 + (n >> 6) * 96 + (n & 63), v); } };

DI void mla_stats_phase(const Params& p) {
  const bf16_t* d0 = (const bf16_t*)(p.ws + M_D0); bf16_t* km = (bf16_t*)(p.ws + M_K); float* rs = (float*)(p.ws + OFF_RS); const float2* tabM = (const float2*)(p.ws + OFF_TABM);
  const int tid = threadIdx.x, lane = tid & 63, gw = blockIdx.x * 8 + (tid >> 6), nw = gridDim.x * 8;
  for (int t = gw; t < T_ALL; t += nw) {
    const bf16_t* r = d0 + (size_t)t * 1024;
    const u32x4 a = *(const u32x4*)(r + lane * 8); const u32x2 c = *(const u32x2*)(r + 512 + lane * 4);
    float sq = bflo(a.x) * bflo(a.x) + bfhi(a.x) * bfhi(a.x) + bflo(a.y) * bflo(a.y) + bfhi(a.y) * bfhi(a.y) + bflo(a.z) * bflo(a.z) + bfhi(a.z) * bfhi(a.z) + bflo(a.w) * bflo(a.w) + bfhi(a.w) * bfhi(a.w);
    float sk = bflo(c.x) * bflo(c.x) + bfhi(c.x) * bfhi(c.x) + bflo(c.y) * bflo(c.y) + bfhi(c.y) * bfhi(c.y);
#pragma unroll
    for (int o = 1; o < 64; o <<= 1) { sq += __shfl_xor(sq, o); sk += __shfl_xor(sk, o); }
    if (lane == 0) { rs[2 * t] = rsqrtf(sq * (1.f / 512.f) + 1e-6f); rs[2 * t + 1] = rsqrtf(sk * (1.f / 256.f) + 1e-6f); }
    if (lane < 16) { const int j = lane; float x1 = bf2f(r[768 + j]), x2 = bf2f(r[768 + 16 + j]); const int b = t / PB, pp = t - b * PB;
      if (pp >= LC) { const int pos = pp - LC, row = pos >> 6, col = pos & 63; const float2 cs = tabM[(j < 8 ? row : col) * 8 + (j & 7)]; const float o1 = x1 * cs.x - x2 * cs.y, o2 = x1 * cs.y + x2 * cs.x; x1 = o1; x2 = o2; }
      const unsigned pr = pk2(x1, x2);
#pragma unroll
      for (int h = 0; h < 16; ++h) *(unsigned*)(km + (size_t)t * 1536 + h * 96 + 64 + 2 * j) = pr; }
  }
}

constexpr int KLD = 104, VLD = 72;
DI void mla_attn_phase(const Params& p, char* lds) {
  const bf16_t* Qm = (const bf16_t*)(p.ws + M_Q); const bf16_t* Km = (const bf16_t*)(p.ws + M_K); const bf16_t* vT = (const bf16_t*)(p.ws + M_VT); bf16_t* o = (bf16_t*)(p.ws + OFF_A);
  const int tid = threadIdx.x, lane = tid & 63, w = tid >> 6, c = lane & 31, hh = lane >> 5;
  constexpr int KB = 64 * KLD, VB = 64 * VLD;
  bf16_t* Ks = (bf16_t*)lds; bf16_t* Vs = Ks + 3 * KB;
  for (int item = blockIdx.x; item < 2048 + 64; item += gridDim.x) {
    int b, h, qbase, nkt;
    if (item < 2048) { b = item >> 9; h = (item >> 5) & 15; qbase = LC + (item & 31) * 256; nkt = 132; } else { const int it = item - 2048; b = it >> 4; h = it & 15; qbase = 0; nkt = 4; }
    const size_t tokbase = (size_t)b * PB;
    const bf16_t* qp = Qm + (tokbase + qbase + w * 32 + c) * 1536 + h * 96 + hh * 8;
    bf16x8 qf[6];
#pragma unroll
    for (int ks = 0; ks < 6; ++ks) qf[ks] = *(const bf16x8*)(qp + ks * 16);
    const bf16_t* kg = Km + tokbase * 1536 + h * 96; const bf16_t* vg = vT + (size_t)(b * 16 + h) * 64 * PB;
    const int kr0 = tid / 12, kc0 = tid - kr0 * 12, e1 = tid + NTHR, kr1 = e1 / 12, kc1 = e1 - kr1 * 12; const bool k1ok = e1 < 768; const int vd = tid >> 3, vc = tid & 7;
    u32x4 rk0, rk1 = (u32x4){0, 0, 0, 0}, rv;
    auto gload = [&](int t) { const size_t key0 = (size_t)t * 64;
      rk0 = *(const u32x4*)(kg + (key0 + kr0) * 1536 + kc0 * 8); if (k1ok) rk1 = *(const u32x4*)(kg + (key0 + kr1) * 1536 + kc1 * 8); rv = *(const u32x4*)(vg + (size_t)vd * PB + key0 + vc * 8); };
    auto lstore = [&](int buf) { bf16_t* Kn = Ks + buf * KB; bf16_t* Vn = Vs + buf * VB;
      *(u32x4*)(Kn + kr0 * KLD + kc0 * 8) = rk0; if (k1ok) *(u32x4*)(Kn + kr1 * KLD + kc1 * 8) = rk1; *(u32x4*)(Vn + vd * VLD + vc * 8) = rv; };
    f32x16 oacc[2];
#pragma unroll
    for (int i = 0; i < 16; ++i) { oacc[0][i] = 0.f; oacc[1][i] = 0.f; }
    float mrow = -1e30f, lsum = 0.f;
    auto qk = [&](int buf, f32x16 (&s)[2]) { const bf16_t* Kc = Ks + buf * KB;
#pragma unroll
      for (int j = 0; j < 2; ++j) {
#pragma unroll
        for (int i = 0; i < 16; ++i) s[j][i] = 0.f;
#pragma unroll
        for (int ks = 0; ks < 6; ++ks) { const bf16x8 kf = *(const bf16x8*)(Kc + (32 * j + c) * KLD + ks * 16 + hh * 8); s[j] = mfma32(kf, qf[ks], s[j]); }
      } };
    auto smpv = [&](int buf, f32x16 (&s)[2]) { const bf16_t* Vc = Vs + buf * VB;
      float mx = s[0][0];
#pragma unroll
      for (int j = 0; j < 2; ++j)
#pragma unroll
        for (int i = 0; i < 16; ++i) mx = fmaxf(mx, s[j][i]);
      mx = fmaxf(mx, __shfl_xor(mx, 32));
      const float mnew = fmaxf(mrow, mx), alpha = __builtin_amdgcn_exp2f(mrow - mnew); mrow = mnew;
      float ps = 0.f;
#pragma unroll
      for (int j = 0; j < 2; ++j)
#pragma unroll
        for (int i = 0; i < 16; ++i) { s[j][i] = __builtin_amdgcn_exp2f(s[j][i] - mnew); ps += s[j][i]; }
      lsum = lsum * alpha + ps;
#pragma unroll
      for (int i = 0; i < 16; ++i) { oacc[0][i] *= alpha; oacc[1][i] *= alpha; }
#pragma unroll
      for (int j = 0; j < 2; ++j)
#pragma unroll
        for (int sx = 0; sx < 2; ++sx) {
          const bf16x8 pf = pack8(s[j][8 * sx], s[j][8 * sx + 1], s[j][8 * sx + 2], s[j][8 * sx + 3], s[j][8 * sx + 4], s[j][8 * sx + 5], s[j][8 * sx + 6], s[j][8 * sx + 7]);
#pragma unroll
          for (int dt = 0; dt < 2; ++dt) { const bf16_t* vp = Vc + (32 * dt + c) * VLD + 32 * j + 16 * sx + 4 * hh;
            const bf16x8 vf = cat44(*(const s16x4*)vp, *(const s16x4*)(vp + 8)); oacc[dt] = mfma32(vf, pf, oacc[dt]); }
        } };
    __syncthreads();
    gload(0); lstore(0); gload(1); lstore(1); if (nkt > 2) gload(2);
    __syncthreads();
    f32x16 sA[2], sB[2];
    qk(0, sA);
    int b0 = 0, b1 = 1, b2 = 2;
    for (int kt = 0; kt < nkt; kt += 2) {
      __syncthreads();
      if (kt + 2 < nkt) { lstore(b2); if (kt + 3 < nkt) gload(kt + 3); }
      qk(b1, sB);
      smpv(b0, sA);
      __syncthreads();
      if (kt + 3 < nkt) { lstore(b0); if (kt + 4 < nkt) gload(kt + 4); }
      if (kt + 2 < nkt) qk(b2, sA);
      smpv(b1, sB);
      { const int t0 = b0; b0 = b2; b2 = b1; b1 = t0; }
    }
    lsum += __shfl_xor(lsum, 32); const float inv = 1.f / lsum;
    bf16_t* op = o + (tokbase + qbase + w * 32 + c) * 1024 + h * 64 + 4 * hh;
#pragma unroll
    for (int dt = 0; dt < 2; ++dt)
#pragma unroll
      for (int rg = 0; rg < 4; ++rg) st4bf(op + 32 * dt + 8 * rg, (f32x4){oacc[dt][4 * rg] * inv, oacc[dt][4 * rg + 1] * inv, oacc[dt][4 * rg + 2] * inv, oacc[dt][4 * rg + 3] * inv});
  }
}

template <bool CTX>
DI void na_wave(const bf16_t* __restrict__ Q, const bf16_t* __restrict__ K, const bf16_t* __restrict__ vT, bf16_t* __restrict__ o, const float* rpb  , int b, int h, int r, int n, int lane) {
  constexpr int NT = CTX ? 16 : 32;
  const int g = lane >> 4, l16 = lane & 15; const size_t tokbase = (size_t)b * PB;
  const int qpos = CTX ? (n * 16 + l16) : (LC + r * 64 + n * 16 + l16);
  const int rs = clampi(r - 4, 0, 120), band0 = clampi(16 * n - 8, 0, 32);
  const bf16_t* qp = Q + (tokbase + qpos) * 1024 + h * 64 + g * 8;
  const bf16x8 q0 = *(const bf16x8*)qp, q1 = *(const bf16x8*)(qp + 32);
  f32x4 S[NT];
#pragma unroll
  for (int kt = 0; kt < NT; ++kt) {
    int kpos;
    if (!CTX && kt < 16) kpos = LC + (rs + (kt >> 1)) * 64 + band0 + 16 * (kt & 1) + l16; else kpos = 16 * (CTX ? kt : kt - 16) + l16;
    const bf16_t* kp = K + (tokbase + kpos) * 1024 + h * 64 + g * 8;
    f32x4 s = mfma16(*(const bf16x8*)kp, q0, (f32x4){0.f, 0.f, 0.f, 0.f}); s = mfma16(*(const bf16x8*)(kp + 32), q1, s);
    if (!CTX && kt < 16) { const int qcol = 16 * n + l16, wstart = clampi(qcol - 8, 0, 48); const float* bp = rpb + (rs + (kt >> 1) - r + 7) * 31;
#pragma unroll
      for (int rr = 0; rr < 4; ++rr) { const int kcol = band0 + 16 * (kt & 1) + 4 * g + rr; const bool ok = kcol >= wstart && kcol < wstart + 16;
        s[rr] = ok ? (s[rr] + bp[clampi(kcol - qcol + 15, 0, 30)]) * LOG2E : -1e30f; } }
    else s = s * LOG2E;
    S[kt] = s;
  }
  float mx = S[0][0];
#pragma unroll
  for (int kt = 0; kt < NT; ++kt) mx = fmaxf(fmaxf(fmaxf(mx, S[kt][0]), fmaxf(S[kt][1], S[kt][2])), S[kt][3]);
  mx = fmaxf(mx, __shfl_xor(mx, 16)); mx = fmaxf(mx, __shfl_xor(mx, 32));
  float ls = 0.f;
#pragma unroll
  for (int kt = 0; kt < NT; ++kt)
#pragma unroll
    for (int rr = 0; rr < 4; ++rr) { S[kt][rr] = __builtin_amdgcn_exp2f(S[kt][rr] - mx); ls += S[kt][rr]; }
  ls += __shfl_xor(ls, 16); ls += __shfl_xor(ls, 32);
  f32x4 O[4];
#pragma unroll
  for (int dt = 0; dt < 4; ++dt) O[dt] = (f32x4){0.f, 0.f, 0.f, 0.f};
  const bf16_t* vb = vT + ((size_t)(b * 16 + h) * 64 + l16) * PB;
#pragma unroll
  for (int kk = 0; kk < NT / 2; ++kk) {
    int pos0;
    if (!CTX && kk < 8) pos0 = LC + (rs + kk) * 64 + band0 + 4 * g; else pos0 = 32 * (CTX ? kk : kk - 8) + 4 * g;
    const bf16x8 pf = pack8(S[2 * kk][0], S[2 * kk][1], S[2 * kk][2], S[2 * kk][3], S[2 * kk + 1][0], S[2 * kk + 1][1], S[2 * kk + 1][2], S[2 * kk + 1][3]);
#pragma unroll
    for (int dt = 0; dt < 4; ++dt) { const bf16_t* vp = vb + (size_t)(dt * 16) * PB + pos0; const bf16x8 vf = cat44(*(const s16x4*)vp, *(const s16x4*)(vp + 16)); O[dt] = mfma16(vf, pf, O[dt]); }
  }
  const float inv = 1.f / ls; bf16_t* op = o + (tokbase + qpos) * 1024 + h * 64 + 4 * g;
#pragma unroll
  for (int dt = 0; dt < 4; ++dt) st4bf(op + 16 * dt, O[dt] * inv);
}
DI void na_attn_phase(const Params& p, char* lds) {
  const bf16_t* Q = (const bf16_t*)(p.ws + N_Q); const bf16_t* K = (const bf16_t*)(p.ws + N_K); const bf16_t* vT = (const bf16_t*)(p.ws + N_VT); bf16_t* o = (bf16_t*)(p.ws + OFF_A);
  float* rl = (float*)lds; const int tid = threadIdx.x, lane = tid & 63, w = tid >> 6;
  __syncthreads();
  for (int e = tid; e < 16 * 465; e += NTHR) rl[e] = p.na_rpb[e];
  __syncthreads();
  for (int item = blockIdx.x; item < 4096 + 128; item += gridDim.x) {
    if (item < 4096) { const int hhf = item & 1, n = (item >> 1) & 3, r = (item >> 3) & 127, b = item >> 10; const int h = hhf * 8 + w; na_wave<false>(Q, K, vT, o, rl + h * 465, b, h, r, n, lane); }
    else { const int it = item - 4096; const int hhf = it & 1, qb = (it >> 1) & 15, b = it >> 5; const int h = hhf * 8 + w; na_wave<true>(Q, K, vT, o, rl + h * 465, b, h, 0, qb, lane); }
  }
}

template <int DK> struct ScanLds { static constexpr int QLD = DK + 8, TLD = 72;
  static constexpr int OFF_QD = 0, OFF_KD = OFF_QD + 64 * QLD * 2, OFF_VT = OFF_KD + 64 * QLD * 2, OFF_ATT = OFF_VT + 64 * TLD * 2, OFF_ST = OFF_ATT + 64 * TLD * 2, OFF_EB = OFF_ST + 64 * QLD * 2, OFF_QS = OFF_EB + DK * 4, TOTAL = OFF_QS + 4 * DK * 4; };
DI int scan_pos(int dir, int i, int tl) { if (dir == 0) return i * 64 + tl; return i < 4 ? 255 - (i * 64 + tl) : 8447 - ((i - 4) * 64 + tl); }
DI bf16x8 gather8(const bf16_t* p, int stride) {
  const unsigned a0 = p[0], a1 = p[stride], a2 = p[2 * stride], a3 = p[3 * stride], a4 = p[4 * stride], a5 = p[5 * stride], a6 = p[6 * stride], a7 = p[7 * stride];
  u32x4 r; r.x = a0 | (a1 << 16); r.y = a2 | (a3 << 16); r.z = a4 | (a5 << 16); r.w = a6 | (a7 << 16); return __builtin_bit_cast(bf16x8, r);
}

template <int DK, bool HG>
DI void scan_phase(const Params& p, char* lds) {
  typedef ScanLds<DK> L;
  bf16_t* Qd = (bf16_t*)(lds + L::OFF_QD); bf16_t* Kd = (bf16_t*)(lds + L::OFF_KD); bf16_t* Vt = (bf16_t*)(lds + L::OFF_VT);
  bf16_t* Att = (bf16_t*)(lds + L::OFF_ATT); bf16_t* St = (bf16_t*)(lds + L::OFF_ST); float* eb = (float*)(lds + L::OFF_EB); float* qs = (float*)(lds + L::OFF_QS);
  constexpr int QLD = L::QLD, TLD = L::TLD, KT = DK / 16 / 8;
  const int tid = tid_(), lane = tid & 63, w = tid >> 6, g4 = lane >> 4, l16 = lane & 15;
  const int nitems = HG ? 128 : 256;
  const float* lbv = (const float*)(p.ws + OFF_LBV);
  for (int item = blockIdx.x; item < nitems; item += gridDim.x) {
    int b, h, sl, dir; if (HG) { sl = item & 1; h = (item >> 1) & 7; b = (item >> 4) & 3; dir = item >> 6; } else { sl = item & 7; h = (item >> 3) & 3; b = (item >> 5) & 3; dir = item >> 7; }
    const size_t tokbase = (size_t)b * PB;
    const bf16_t *qsrc, *ksrc, *vsrc; int ldq, ldv; bf16_t *octx, *olat; int ldo;
    if (HG) { const bf16_t* ph = (const bf16_t*)(p.ws + H_P); qsrc = ph + h * 128; ksrc = ph + 1024 + dir * 1024 + h * 128; vsrc = ph + 3072 + h * 128 + sl * 64; ldq = 5120; ldv = 5120; ldo = 1024;
      octx = (bf16_t*)(p.ws + (dir ? OFF_W0 : OFF_A)) + tokbase * 1024 + h * 128 + sl * 64; olat = octx + (size_t)LC * 1024; }
    else { const bf16_t* qk = (const bf16_t*)(p.ws + R_QK); qsrc = qk + h * 256; ksrc = qk + 1024 + h * 256; vsrc = (const bf16_t*)(p.ws + R_V) + h * 512 + sl * 64; ldq = 2048; ldv = 2048; ldo = 2048;
      if (dir == 0) { octx = (bf16_t*)(p.ws + R_O) + tokbase * 2048 + h * 512 + sl * 64; olat = octx + (size_t)LC * 2048; }
      else { octx = (bf16_t*)(p.ws + OFF_HCTX) + (size_t)b * LC * 2048 + h * 512 + sl * 64; olat = (bf16_t*)p.out + (size_t)b * LL * 2048 + h * 512 + sl * 64; } }
    float lg = 0.f; if (!HG) lg = -__expf(p.ret_decay[dir * 4 + h]);
    float lb = 0.f; if (HG) lb = lbv[h * 128 + (tid & 127)];
    f32x4 sacc[KT][4];
#pragma unroll
    for (int a = 0; a < KT; ++a)
#pragma unroll
      for (int v = 0; v < 4; ++v) sacc[a][v] = (f32x4){0.f, 0.f, 0.f, 0.f};
    u32x4 rq[4], rk[4], rvv; unsigned short rf[16], rqq[16]; float bl[16], qv[16], kv[16];
    const int vtl = tid & 63, vvc = tid >> 6;
    auto issue = [&](int i) {
      if (HG) { const int k = tid & 127, qt = tid >> 7;
#pragma unroll
        for (int j = 0; j < 16; ++j) { const size_t row = tokbase + scan_pos(dir, i, qt * 16 + j); rf[j] = ksrc[row * ldq + k]; rqq[j] = qsrc[row * ldq + k]; } }
      else {
#pragma unroll
        for (int it = 0; it < 4; ++it) { const int e = tid + NTHR * it, tl = e >> 5, kc = e & 31; const size_t row = tokbase + scan_pos(dir, i, tl); rq[it] = *(const u32x4*)(qsrc + row * ldq + kc * 8); rk[it] = *(const u32x4*)(ksrc + row * ldq + kc * 8); } }
      { const size_t row = tokbase + scan_pos(dir, i, vtl); rvv = *(const u32x4*)(vsrc + row * ldv + vvc * 8); }
    };
    auto prep = [&]() {
      const int k = tid & 127, qt = tid >> 7; float run = 0.f;
#pragma unroll
      for (int j = 0; j < 16; ++j) { const float f = bf2f(rf[j]); qv[j] = bf2f(rqq[j]); const float sg = 1.f / (1.f + __expf(-f)); const float fg = lb + (1.f - lb) * sg; kv[j] = 1.f - fg; run += __logf(fg); bl[j] = run; }
      qs[qt * DK + k] = run;
    };
    __syncthreads();
    issue(0); if (HG) prep();
    __syncthreads();
    for (int i = 0; i < 132; ++i) {
      if (HG) { const int k = tid & 127, qt = tid >> 7; float off = 0.f;
#pragma unroll
        for (int q = 0; q < 3; ++q) if (q < qt) off += qs[q * DK + k];
        if (qt == 3) eb[k] = __expf(off + bl[15]);
#pragma unroll
        for (int j = 0; j < 16; ++j) { const int tl = qt * 16 + j; const float bb = bl[j] + off; Qd[tl * QLD + k] = f2bf(qv[j] * __expf(bb)); Kd[tl * QLD + k] = f2bf(kv[j] * __expf(-bb)); } }
      else {
        if (tid < DK) eb[tid] = __expf(64.f * lg);
#pragma unroll
        for (int it = 0; it < 4; ++it) { const int e = tid + NTHR * it, tl = e >> 5, kc = e & 31; const u32x4 qr = rq[it], kr = rk[it];
          const float eq = __expf((float)(tl + 1) * lg), ek = __expf(-(float)(tl + 1) * lg);
          u32x4 qo, ko; qo.x = pk2(bflo(qr.x) * eq, bfhi(qr.x) * eq); qo.y = pk2(bflo(qr.y) * eq, bfhi(qr.y) * eq); qo.z = pk2(bflo(qr.z) * eq, bfhi(qr.z) * eq); qo.w = pk2(bflo(qr.w) * eq, bfhi(qr.w) * eq);
          ko.x = pk2(bflo(kr.x) * ek, bfhi(kr.x) * ek); ko.y = pk2(bflo(kr.y) * ek, bfhi(kr.y) * ek); ko.z = pk2(bflo(kr.z) * ek, bfhi(kr.z) * ek); ko.w = pk2(bflo(kr.w) * ek, bfhi(kr.w) * ek);
          *(u32x4*)(Qd + tl * QLD + kc * 8) = qo; *(u32x4*)(Kd + tl * QLD + kc * 8) = ko; } }
      { bf16_t* vt = Vt + (vvc * 8) * TLD + vtl; const u32x4 vr = rvv;
        vt[0] = (bf16_t)(vr.x & 0xffff); vt[TLD] = (bf16_t)(vr.x >> 16); vt[2 * TLD] = (bf16_t)(vr.y & 0xffff); vt[3 * TLD] = (bf16_t)(vr.y >> 16);
        vt[4 * TLD] = (bf16_t)(vr.z & 0xffff); vt[5 * TLD] = (bf16_t)(vr.z >> 16); vt[6 * TLD] = (bf16_t)(vr.w & 0xffff); vt[7 * TLD] = (bf16_t)(vr.w >> 16); }
#pragma unroll
      for (int a = 0; a < KT; ++a) { const int ki = w * KT + a;
#pragma unroll
        for (int vi = 0; vi < 4; ++vi) st4bf(St + (16 * vi + l16) * QLD + 16 * ki + 4 * g4, sacc[a][vi]); }
      __syncthreads();
      if (i + 1 < 132) issue(i + 1);
#pragma unroll
      for (int u = 0; u < 2; ++u) { const int id = 2 * w + u, ti = id >> 2, si = id & 3; f32x4 d = (f32x4){0.f, 0.f, 0.f, 0.f};
        if (si <= ti) {
#pragma unroll
          for (int ks = 0; ks < DK / 32; ++ks) { const bf16x8 kf = *(const bf16x8*)(Kd + (16 * si + l16) * QLD + ks * 32 + g4 * 8), qf = *(const bf16x8*)(Qd + (16 * ti + l16) * QLD + ks * 32 + g4 * 8); d = mfma16(kf, qf, d); } }
        const int t = 16 * ti + l16, s0 = 16 * si + 4 * g4;
#pragma unroll
        for (int rr = 0; rr < 4; ++rr) if (s0 + rr > t) d[rr] = 0.f;
        st4bf(Att + t * TLD + s0, d); }
      __syncthreads();
#pragma unroll
      for (int u = 0; u < 2; ++u) { const int id = 2 * w + u, vi = id >> 2, ti = id & 3; f32x4 d = (f32x4){0.f, 0.f, 0.f, 0.f};
#pragma unroll
        for (int ks = 0; ks < 2; ++ks) { const bf16x8 xf = *(const bf16x8*)(Vt + (16 * vi + l16) * TLD + ks * 32 + g4 * 8), yf = *(const bf16x8*)(Att + (16 * ti + l16) * TLD + ks * 32 + g4 * 8); d = mfma16(xf, yf, d); }
#pragma unroll
        for (int ks = 0; ks < DK / 32; ++ks) { const bf16x8 xf = *(const bf16x8*)(St + (16 * vi + l16) * QLD + ks * 32 + g4 * 8), yf = *(const bf16x8*)(Qd + (16 * ti + l16) * QLD + ks * 32 + g4 * 8); d = mfma16(xf, yf, d); }
        const int pos = scan_pos(dir, i, 16 * ti + l16); bf16_t* op = (pos < LC ? octx + (size_t)pos * ldo : olat + (size_t)(pos - LC) * ldo) + 16 * vi + 4 * g4;
        st4bf(op, d); }
#pragma unroll
      for (int a = 0; a < KT; ++a) { const int ki = w * KT + a;
#pragma unroll
        for (int ks = 0; ks < 2; ++ks) { const bf16x8 xf = gather8(Kd + (ks * 32 + g4 * 8) * QLD + 16 * ki + l16, QLD);
#pragma unroll
          for (int vi = 0; vi < 4; ++vi) { const bf16x8 yf = *(const bf16x8*)(Vt + (16 * vi + l16) * TLD + ks * 32 + g4 * 8); sacc[a][vi] = mfma16(xf, yf, sacc[a][vi]); } }
        const f32x4 e4 = *(const f32x4*)(eb + 16 * ki + 4 * g4);
#pragma unroll
        for (int vi = 0; vi < 4; ++vi) sacc[a][vi] = sacc[a][vi] * e4; }
      if (HG && i + 1 < 132) prep();
      __syncthreads();
    }
  }
}

DI float bsum2(unsigned a, unsigned b, float& lo, float& hi) { lo = bflo(a) + bflo(b); hi = bfhi(a) + bfhi(b); return lo * lo + hi * hi; }
DI void ret_readout_phase(const Params& p) {
  bf16_t* O = (bf16_t*)(p.ws + R_O); const bf16_t* G = (const bf16_t*)(p.ws + R_QK);
  const int tid = threadIdx.x, lane = tid & 63, gw = blockIdx.x * 8 + (tid >> 6), nw = gridDim.x * 8;
  for (int t = gw; t < T_ALL; t += nw) {
    const int b = t / PB, pp = t - b * PB;
    const bf16_t* ob = (pp < LC ? (const bf16_t*)(p.ws + OFF_HCTX) + (size_t)(b * LC + pp) * 2048 : (const bf16_t*)p.out + (size_t)(b * LL + pp - LC) * 2048) + lane * 32;
    bf16_t* op = O + (size_t)t * 2048 + lane * 32; const bf16_t* gp = G + (size_t)t * 2048 + lane * 32;
    float ov[32]; u32x4 gv[4]; float sq = 0.f;
#pragma unroll
    for (int i = 0; i < 4; ++i) { const u32x4 x = *(const u32x4*)(op + i * 8), y = *(const u32x4*)(ob + i * 8); gv[i] = *(const u32x4*)(gp + i * 8);
      sq += bsum2(x.x, y.x, ov[8 * i], ov[8 * i + 1]) + bsum2(x.y, y.y, ov[8 * i + 2], ov[8 * i + 3]) + bsum2(x.z, y.z, ov[8 * i + 4], ov[8 * i + 5]) + bsum2(x.w, y.w, ov[8 * i + 6], ov[8 * i + 7]); }
    sq += __shfl_xor(sq, 1); sq += __shfl_xor(sq, 2); sq += __shfl_xor(sq, 4); sq += __shfl_xor(sq, 8);
    const float rstd = rsqrtf(sq * (1.f / 512.f) + 1e-6f);
#pragma unroll
    for (int i = 0; i < 4; ++i) { u32x4 r;
      r.x = pk2(siluf(bflo(gv[i].x)) * ov[8 * i] * rstd, siluf(bfhi(gv[i].x)) * ov[8 * i + 1] * rstd); r.y = pk2(siluf(bflo(gv[i].y)) * ov[8 * i + 2] * rstd, siluf(bfhi(gv[i].y)) * ov[8 * i + 3] * rstd);
      r.z = pk2(siluf(bflo(gv[i].z)) * ov[8 * i + 4] * rstd, siluf(bfhi(gv[i].z)) * ov[8 * i + 5] * rstd); r.w = pk2(siluf(bflo(gv[i].w)) * ov[8 * i + 6] * rstd, siluf(bfhi(gv[i].w)) * ov[8 * i + 7] * rstd);
      *(u32x4*)(op + i * 8) = r; }
  }
}
DI void hg_readout_phase(const Params& p) {
  bf16_t* O = (bf16_t*)(p.ws + OFF_A); const bf16_t* OB = (const bf16_t*)(p.ws + OFF_W0); const bf16_t* ph = (const bf16_t*)(p.ws + H_P);
  const int tid = threadIdx.x, lane = tid & 63, gw = blockIdx.x * 8 + (tid >> 6), nw = gridDim.x * 8;
  for (int t = gw; t < T_ALL; t += nw) {
    bf16_t* op = O + (size_t)t * 1024 + lane * 16; const bf16_t* ob = OB + (size_t)t * 1024 + lane * 16; const bf16_t* gp = ph + (size_t)t * 5120 + 4096 + lane * 16; const float* ng = p.hg_norm_g + (lane & 7) * 16;
    float ov[16]; u32x4 gv[2]; float sq = 0.f;
#pragma unroll
    for (int i = 0; i < 2; ++i) { const u32x4 x = *(const u32x4*)(op + i * 8), y = *(const u32x4*)(ob + i * 8); gv[i] = *(const u32x4*)(gp + i * 8);
      sq += bsum2(x.x, y.x, ov[8 * i], ov[8 * i + 1]) + bsum2(x.y, y.y, ov[8 * i + 2], ov[8 * i + 3]) + bsum2(x.z, y.z, ov[8 * i + 4], ov[8 * i + 5]) + bsum2(x.w, y.w, ov[8 * i + 6], ov[8 * i + 7]); }
    sq += __shfl_xor(sq, 1); sq += __shfl_xor(sq, 2); sq += __shfl_xor(sq, 4);
    const float rstd = rsqrtf(sq * (1.f / 128.f) + 1e-6f);
#pragma unroll
    for (int i = 0; i < 2; ++i) { u32x4 r; const float* n8 = ng + i * 8;
      r.x = pk2(siluf(bflo(gv[i].x)) * ov[8 * i] * rstd * n8[0], siluf(bfhi(gv[i].x)) * ov[8 * i + 1] * rstd * n8[1]); r.y = pk2(siluf(bflo(gv[i].y)) * ov[8 * i + 2] * rstd * n8[2], siluf(bfhi(gv[i].y)) * ov[8 * i + 3] * rstd * n8[3]);
      r.z = pk2(siluf(bflo(gv[i].z)) * ov[8 * i + 4] * rstd * n8[4], siluf(bfhi(gv[i].z)) * ov[8 * i + 5] * rstd * n8[5]); r.w = pk2(siluf(bflo(gv[i].w)) * ov[8 * i + 6] * rstd * n8[6], siluf(bfhi(gv[i].w)) * ov[8 * i + 7] * rstd * n8[7]);
      *(u32x4*)(op + i * 8) = r; }
  }
}

#define XB_TMO      128
#define XB_XCNT(j)  (256  + 64 * (j))
#define XB_XSUB(j)  (1280 + 64 * (j))
#define XB_XGEN(j)  (2304 + 64 * (j))
#define XB_TOP      3328
#define XB_TOPGEN   3392
#define XCD_BAR_WORDS 3456
#define XB_SPIN_CAP (1u << 23)
#define LAS PG8_LAS

__device__ __forceinline__ unsigned xb_ld(unsigned* p)              { return __hip_atomic_load(p, __ATOMIC_RELAXED, __HIP_MEMORY_SCOPE_AGENT); }
__device__ __forceinline__ unsigned xb_add(unsigned* p, unsigned v) { return __hip_atomic_fetch_add(p, v, __ATOMIC_RELAXED, __HIP_MEMORY_SCOPE_AGENT); }
__device__ __forceinline__ unsigned xb_xcc_id() { return (unsigned)__builtin_amdgcn_s_getreg((3 << 11) | 20) & 0xFu; }
#define XB_SPIN(cond, bar) do { unsigned _sp = 0; while (cond) { __builtin_amdgcn_s_sleep(1); \
    if ((++_sp & 255u) == 0u) { if (xb_ld(&(bar)[XB_TMO])) break; if (_sp > XB_SPIN_CAP) { atomicAdd(&(bar)[XB_TMO], 1u); break; } } } } while (0)

struct XcdBarrier {
    unsigned* bar; unsigned x;
    volatile LAS unsigned* st;
};

__device__ __forceinline__ XcdBarrier xcd_barrier_post(unsigned* bar, volatile LAS unsigned* st) {
    XcdBarrier b; b.bar = bar; b.x = xb_xcc_id(); b.st = st;
    if (threadIdx.x == 0) (void)xb_add(&bar[XB_XCNT(b.x)], 1u);
    return b;
}
__device__ __forceinline__ void xcd_barrier_complete(unsigned* bar, unsigned x, unsigned& nloc, unsigned& nx) {
    const unsigned G = gridDim.x * gridDim.y * gridDim.z;
    unsigned sum, cnt, mine, sp = 0u;
    for (;;) {
        sum = 0u; cnt = 0u; mine = 0u;
#pragma unroll
        for (unsigned j = 0; j < 16; ++j) { const unsigned c = xb_ld(&bar[XB_XCNT(j)]); sum += c; cnt += (c > 0u) ? 1u : 0u; mine = (j == x) ? c : mine; }
        if (sum == G) break;
        __builtin_amdgcn_s_sleep(1);
        if ((++sp & 255u) == 0u) { if (xb_ld(&bar[XB_TMO])) break; if (sp > XB_SPIN_CAP) { atomicAdd(&bar[XB_TMO], 1u); break; } }
    }
    nloc = mine > 0u ? mine : 1u; nx = cnt > 0u ? cnt : 1u;
}

__device__ __forceinline__ void xcd_barrier(const XcdBarrier& b) {
    asm volatile("s_waitcnt vmcnt(0)" ::: "memory");
    __syncthreads();
    if (threadIdx.x == 0) {
        unsigned* bar = b.bar;
        __builtin_amdgcn_s_waitcnt(0);
        unsigned nloc = b.st[0], nx = b.st[1];
        if (nloc == 0u) { xcd_barrier_complete(bar, b.x, nloc, nx); b.st[0] = nloc; b.st[1] = nx; }
        const unsigned old = xb_add(&bar[XB_XSUB(b.x)], 1u);
        const unsigned gen = old / nloc;
        if (old + 1u == (gen + 1u) * nloc) {
            __builtin_amdgcn_fence(__ATOMIC_RELEASE, "agent");
            asm volatile("s_waitcnt vmcnt(0)" ::: "memory");
            const unsigned og = xb_add(&bar[XB_TOP], 1u);
            const unsigned tg = og / nx;
            if (og + 1u == (tg + 1u) * nx) xb_add(&bar[XB_TOPGEN], 1u);
            else XB_SPIN(xb_ld(&bar[XB_TOPGEN]) == tg, bar);
            __builtin_amdgcn_fence(__ATOMIC_ACQUIRE, "agent");
            xb_add(&bar[XB_XGEN(b.x)], 1u);
            asm volatile("s_waitcnt vmcnt(0)" ::: "memory");
        } else {
            XB_SPIN(xb_ld(&bar[XB_XGEN(b.x)]) == gen, bar);
            __builtin_amdgcn_fence(__ATOMIC_ACQUIRE, "agent");
            asm volatile("s_waitcnt vmcnt(0)" ::: "memory");
        }
    }
    __syncthreads();
}

constexpr int LDS_BYTES = ScanLds<256>::TOTAL > pg8::STAGE_BYTES ? ScanLds<256>::TOTAL : pg8::STAGE_BYTES;
static_assert(LDS_BYTES <= 163840, "LDS");
static_assert(LDS_BYTES >= (256 + 128) * LDT * 2 && LDS_BYTES >= 3 * 64 * (KLD + VLD) * 2 && LDS_BYTES >= (5120 + 8 * 5 * 64) * 4, "LDS phases");

DI void ffn_and_ln(const Params& p, const XcdBarrier& xb, char* lds, int layer, const bf16_t* w13, const bf16_t* w2) {
  const float* mods = (const float*)(p.ws + OFF_MODS); float* hctx = (float*)(p.ws + OFF_HCTX); bf16_t* a = (bf16_t*)(p.ws + OFF_A); bf16_t* U = (bf16_t*)(p.ws + F_U);
  { EpiSwiglu e{U}; big_gemm(a, w13, T_ALL, 5632, 1024, e, lds); }
  xcd_barrier(xb);
  { EpiResid e{p.out, hctx, p.out, hctx, mods + (size_t)layer * 5 * 6144 + 5 * 1024}; big_gemm(U, w2, T_ALL, 1024, FF, e, lds); }
  xcd_barrier(xb);
  ln_phase(p, layer, 1, layer < 3 ? layer + 1 : 3, 0, layer < 3);
  xcd_barrier(xb);
}

__global__ void __launch_bounds__(NTHR) mega(Params p) {
  __shared__ __attribute__((aligned(16))) char lds[LDS_BYTES];
  cg::grid_group grid = cg::this_grid();
  __shared__ uint4 xb_words;
  if (threadIdx.x == 0) xb_words = make_uint4(0u, 0u, 0u, 0u);
  __syncthreads();
  const XcdBarrier xb = xcd_barrier_post((unsigned*)(p.ws + OFF_BAR), (volatile LAS unsigned*)&xb_words);
  float* ldsf = (float*)lds;
  const float* mods = (const float*)(p.ws + OFF_MODS); float* hctx = (float*)(p.ws + OFF_HCTX); bf16_t* a = (bf16_t*)(p.ws + OFF_A);
  const float2* tabR = (const float2*)(p.ws + OFF_TABR); const float2* tabM = (const float2*)(p.ws + OFF_TABM); float* rs = (float*)(p.ws + OFF_RS);
  ada_phase(p, ldsf);
  tables_phase(p);
  convert_w<2>(p.ret_w_in, 6144, 1024, (bf16_t*)(p.ws + W0_RETIN), 6144, nullptr, ldsf);
  convert_w<0>(p.ret_w_out, 1024, 2048, (bf16_t*)(p.ws + W0_RETOUT), 1024, nullptr, ldsf);
  convert_w<1>(p.w13, 5632, 1024, (bf16_t*)(p.ws + W0_W13), 5632, nullptr, ldsf);
  convert_w<0>(p.w2, 1024, FF, (bf16_t*)(p.ws + W0_W2), 1024, nullptr, ldsf);
  grid.sync();
  modulate_phase(p, p.x, p.ctx, 0);
  xcd_barrier(xb);
  { const bf16_t* wi = (const bf16_t*)(p.ws + W0_RETIN);
    { EpiRetQK e{(bf16_t*)(p.ws + R_QK), tabR}; big_gemm(a, wi, T_ALL, 2048, 1024, e, lds); }
    { EpiStore e{(bf16_t*)(p.ws + R_V), (bf16_t*)(p.ws + R_V), 1 << 30, 2048, 2048, 1.f}; big_gemm(a, wi + (size_t)2048 * 1024, T_ALL, 2048, 1024, e, lds); }
    xcd_barrier(xb);
    scan_phase<256, false>(p, lds);
    xcd_barrier(xb);
    { EpiStore e{(bf16_t*)(p.ws + R_QK), (bf16_t*)(p.ws + R_QK), 1 << 30, 2048, 2048, 1.f}; big_gemm(a, wi + (size_t)4096 * 1024, T_ALL, 2048, 1024, e, lds); }
    xcd_barrier(xb);
    ret_readout_phase(p);
    xcd_barrier(xb);
    { EpiResid e{p.x, p.ctx, p.out, hctx, mods + 2 * 1024}; big_gemm((const bf16_t*)(p.ws + R_O), (const bf16_t*)(p.ws + W0_RETOUT), T_ALL, 1024, 2048, e, lds); }
    xcd_barrier(xb);
    ln_phase(p, 0, 0, 0, 3, true);
    convert_w<0>(p.na_w_qkv, 3072, 1024, (bf16_t*)(p.ws + W1_QKV), 3072, nullptr, ldsf);
    convert_w<0>(p.na_w_out, 1024, 1024, (bf16_t*)(p.ws + W1_OUT), 1024, nullptr, ldsf);
    convert_w<1>(p.w13 + (size_t)1 * 1024 * 5632, 5632, 1024, (bf16_t*)(p.ws + W1_W13), 5632, nullptr, ldsf);
    convert_w<0>(p.w2 + (size_t)1 * FF * 1024, 1024, FF, (bf16_t*)(p.ws + W1_W2), 1024, nullptr, ldsf);
    convert_w<5>(p.mla_w_down, 800, 1024, (bf16_t*)(p.ws + W2_DOWN), 1024, nullptr, ldsf);
    convert_w<3>(p.mla_w_uq, 1536, 512, (bf16_t*)(p.ws + W2_UQ), 1536, p.mla_q_norm, ldsf);
    convert_w<4>(p.mla_w_ukv, 2048, 256, (bf16_t*)(p.ws + W2_UKV), 2048, p.mla_kv_norm, ldsf);
    convert_w<0>(p.mla_w_out, 1024, 1024, (bf16_t*)(p.ws + W2_OUT), 1024, nullptr, ldsf);
    convert_w<1>(p.w13 + (size_t)2 * 1024 * 5632, 5632, 1024, (bf16_t*)(p.ws + W2_W13), 5632, nullptr, ldsf);
    convert_w<0>(p.w2 + (size_t)2 * FF * 1024, 1024, FF, (bf16_t*)(p.ws + W2_W2), 1024, nullptr, ldsf);
    convert_w<0>(p.hg_w_in, 5120, 1024, (bf16_t*)(p.ws + W3_IN), 5120, nullptr, ldsf);
    convert_w<0>(p.hg_w_out, 1024, 1024, (bf16_t*)(p.ws + W3_OUT), 1024, nullptr, ldsf);
    convert_w<1>(p.w13 + (size_t)3 * 1024 * 5632, 5632, 1024, (bf16_t*)(p.ws + W3_W13), 5632, nullptr, ldsf);
    convert_w<0>(p.w2 + (size_t)3 * FF * 1024, 1024, FF, (bf16_t*)(p.ws + W3_W2), 1024, nullptr, ldsf);
    xcd_barrier(xb);
    ffn_and_ln(p, xb, lds, 0, (const bf16_t*)(p.ws + W0_W13), (const bf16_t*)(p.ws + W0_W2));
  }
  { const bf16_t* wq = (const bf16_t*)(p.ws + W1_QKV);
    { EpiStore e{(bf16_t*)(p.ws + N_Q), (bf16_t*)(p.ws + N_K), 1024, 1024, 1024, 0.125f}; big_gemm(a, wq, T_ALL, 2048, 1024, e, lds); }
    { GemmArgs g{a, 1024, wq + (size_t)2048 * 1024, 1024, T_ALL, 1024, 1024}; EpiVT e{(bf16_t*)(p.ws + N_VT), nullptr}; gemm_phase<true>(g, e, lds); }
    xcd_barrier(xb);
    na_attn_phase(p, lds);
    xcd_barrier(xb);
    { EpiResid e{p.out, hctx, p.out, hctx, mods + (size_t)1 * 5 * 6144 + 2 * 1024}; big_gemm(a, (const bf16_t*)(p.ws + W1_OUT), T_ALL, 1024, 1024, e, lds); }
    xcd_barrier(xb);
    ln_phase(p, 1, 0, 1, 3, true);
    xcd_barrier(xb);
    ffn_and_ln(p, xb, lds, 1, (const bf16_t*)(p.ws + W1_W13), (const bf16_t*)(p.ws + W1_W2));
  }
  { const bf16_t* d0 = (const bf16_t*)(p.ws + M_D0);
    { EpiStore e{(bf16_t*)(p.ws + M_D0), (bf16_t*)(p.ws + M_D0), 1 << 30, 1024, 1024, 1.f}; big_gemm(a, (const bf16_t*)(p.ws + W2_DOWN), T_ALL, 1024, 1024, e, lds); }
    xcd_barrier(xb);
    mla_stats_phase(p);
    xcd_barrier(xb);
    { GemmArgs g{d0, 1024, (const bf16_t*)(p.ws + W2_UQ), 512, T_ALL, 1536, 512}; EpiMlaQ e{(bf16_t*)(p.ws + M_Q), rs, tabM}; gemm_phase<false>(g, e, lds); }
    { GemmArgs g{d0 + 512, 1024, (const bf16_t*)(p.ws + W2_UKV), 256, T_ALL, 1024, 256}; EpiMlaK e{(bf16_t*)(p.ws + M_K), rs}; gemm_phase<false>(g, e, lds); }
    { GemmArgs g{d0 + 512, 1024, (const bf16_t*)(p.ws + W2_UKV) + (size_t)1024 * 256, 256, T_ALL, 1024, 256}; EpiVT e{(bf16_t*)(p.ws + M_VT), rs}; gemm_phase<true>(g, e, lds); }
    xcd_barrier(xb);
    mla_attn_phase(p, lds);
    xcd_barrier(xb);
    { EpiResid e{p.out, hctx, p.out, hctx, mods + (size_t)2 * 5 * 6144 + 2 * 1024}; big_gemm(a, (const bf16_t*)(p.ws + W2_OUT), T_ALL, 1024, 1024, e, lds); }
    xcd_barrier(xb);
    ln_phase(p, 2, 0, 2, 3, true);
    xcd_barrier(xb);
    ffn_and_ln(p, xb, lds, 2, (const bf16_t*)(p.ws + W2_W13), (const bf16_t*)(p.ws + W2_W2));
  }
  { { EpiHg e{(bf16_t*)(p.ws + H_P)}; big_gemm(a, (const bf16_t*)(p.ws + W3_IN), T_ALL, 5120, 1024, e, lds); }
    xcd_barrier(xb);
    scan_phase<128, true>(p, lds);
    xcd_barrier(xb);
    hg_readout_phase(p);
    xcd_barrier(xb);
    { EpiResid e{p.out, hctx, p.out, hctx, mods + (size_t)3 * 5 * 6144 + 2 * 1024}; big_gemm(a, (const bf16_t*)(p.ws + W3_OUT), T_ALL, 1024, 1024, e, lds); }
    xcd_barrier(xb);
    ln_phase(p, 3, 0, 3, 3, true);
    xcd_barrier(xb);
    ffn_and_ln(p, xb, lds, 3, (const bf16_t*)(p.ws + W3_W13), (const bf16_t*)(p.ws + W3_W2));
  }
}

extern "C" void kernel_launch(void* const* d_in, const int* in_sizes, int n_in, void* d_out, int out_size, void* d_ws, size_t ws_size, hipStream_t stream) {
  static int grid_blocks = 0;
  if (!grid_blocks) {
    int dev = 0, cus = 0, per_cu = 0;
    (void)hipGetDevice(&dev);
    (void)hipDeviceGetAttribute(&cus, hipDeviceAttributeMultiprocessorCount, dev);
    (void)hipOccupancyMaxActiveBlocksPerMultiprocessor(&per_cu, mega, NTHR, 0);
    if (per_cu != 1) per_cu = 1;
    grid_blocks = cus * per_cu;
  }
  if (ws_size < WS_NEED) { fprintf(stderr, "workspace too small: %zu\n", ws_size); return; }
  Params p{};
  const float** f = (const float**)&p;
  for (int i = 0; i < 26; ++i) f[i] = (const float*)d_in[i];
  p.out = (float*)d_out; p.ws = (char*)d_ws;
  (void)hipMemsetAsync((char*)d_ws + OFF_BAR, 0, XCD_BAR_WORDS * 4, stream);
  void* args[] = {&p};
  hipError_t e = hipLaunchCooperativeKernel((void*)mega, dim3(grid_blocks), dim3(NTHR), args, 0, stream);
  if (e != hipSuccess) fprintf(stderr, "cooperative launch failed: %s (grid %d)\n", hipGetErrorString(e), grid_blocks);
}
```

```cpp
#include <hip/hip_runtime.h>
#include <hip/hip_cooperative_groups.h>
#include <cstdio>
#include <cstdint>
namespace cg = cooperative_groups;

#define DI __device__ __forceinline__
DI int tid_() { int t = threadIdx.x; asm volatile("" : "+v"(t)); return t; }
typedef unsigned short bf16_t;
typedef short bf16x8 __attribute__((ext_vector_type(8)));
typedef short s16x4 __attribute__((ext_vector_type(4)));
typedef float f32x4 __attribute__((ext_vector_type(4)));
typedef float f32x16 __attribute__((ext_vector_type(16)));
typedef unsigned u32x4 __attribute__((ext_vector_type(4)));
typedef unsigned u32x2 __attribute__((ext_vector_type(2)));

constexpr int NTHR = 512;
constexpr int T_ALL = 33792, PB = 8448, LC = 256, LL = 8192, DM = 1024, FF = 2816;
constexpr float ALPHA = 1.681792830507429f;
constexpr float LOG2E = 1.4426950408889634f;
constexpr size_t MiB = 1048576;

struct Params {
  const float *x, *c, *ctx, *cctx, *ada_w, *ada_b, *ln_g, *ln_b, *w13, *w2;
  const float *ret_w_in, *ret_decay, *ret_w_out, *na_w_qkv, *na_rpb, *na_w_out;
  const float *mla_w_down, *mla_q_norm, *mla_kv_norm, *mla_w_uq, *mla_w_ukv, *mla_w_out;
  const float *hg_w_in, *hg_lb, *hg_norm_g, *hg_w_out;
  float* out; char* ws;
};

constexpr size_t OFF_MODS = 0;
constexpr size_t OFF_TABR = 512 * 1024;
constexpr size_t OFF_TABM = OFF_TABR + 65536;
constexpr size_t OFF_LBV = OFF_TABM + 8192;
constexpr size_t OFF_RS = OFF_LBV + 4096;
constexpr size_t OFF_BAR = 896 * 1024;
constexpr size_t OFF_HCTX = 1 * MiB;
constexpr size_t OFF_A = 5 * MiB;
constexpr size_t OFF_W0 = 71 * MiB;
constexpr size_t OFF_BIG = 104 * MiB;
constexpr size_t OFF_WR = OFF_BIG;
constexpr size_t OFF_S = 180 * MiB;
constexpr size_t WS_NEED = 512 * MiB;
constexpr size_t OFF_LNS = 510 * MiB;
constexpr size_t W0_RETIN = OFF_W0, W0_RETOUT = W0_RETIN + (size_t)6144 * 1024 * 2, W0_W13 = W0_RETOUT + (size_t)1024 * 2048 * 2, W0_W2 = W0_W13 + (size_t)5632 * 1024 * 2;
constexpr size_t SZ_W13 = (size_t)5632 * 1024 * 2, SZ_W2 = (size_t)1024 * 2816 * 2, SZ_SQ = (size_t)1024 * 1024 * 2;
constexpr size_t W1_QKV = OFF_WR, W1_OUT = W1_QKV + (size_t)3072 * 1024 * 2, W1_W13 = W1_OUT + SZ_SQ, W1_W2 = W1_W13 + SZ_W13;
constexpr size_t W2_DOWN = W1_W2 + SZ_W2, W2_UQ = W2_DOWN + (size_t)1024 * 1024 * 2, W2_UKV = W2_UQ + (size_t)1536 * 512 * 2, W2_OUT = W2_UKV + (size_t)2048 * 256 * 2, W2_W13 = W2_OUT + SZ_SQ, W2_W2 = W2_W13 + SZ_W13;
constexpr size_t W3_IN = W2_W2 + SZ_W2, W3_OUT = W3_IN + (size_t)5120 * 1024 * 2, W3_W13 = W3_OUT + SZ_SQ, W3_W2 = W3_W13 + SZ_W13, W3_END = W3_W2 + SZ_W2;
static_assert(W3_END <= OFF_S, "rest weights overflow");
static_assert(W0_W2 + SZ_W2 <= OFF_BIG, "W0 overflow");
constexpr size_t SZ_T2048 = (size_t)T_ALL * 2048 * 2, SZ_T1024 = (size_t)T_ALL * 1024 * 2;
constexpr size_t R_QK = OFF_BIG, R_V = R_QK + SZ_T2048, R_O = R_V + SZ_T2048;
static_assert(R_O + SZ_T2048 <= WS_NEED, "retention overflow");
constexpr size_t N_Q = OFF_S, N_K = N_Q + SZ_T1024, N_VT = N_K + SZ_T1024;
constexpr size_t M_D0 = OFF_S, M_Q = M_D0 + (size_t)T_ALL * 1024 * 2, M_K = M_Q + (size_t)T_ALL * 1536 * 2, M_VT = M_K + (size_t)T_ALL * 1536 * 2;
static_assert(M_VT + SZ_T1024 <= WS_NEED, "mla overflow");
constexpr size_t H_P = OFF_S;
static_assert(H_P + (size_t)T_ALL * 5120 * 2 <= WS_NEED, "hgrn overflow");
constexpr size_t F_U = OFF_S;

typedef float f32x2 __attribute__((ext_vector_type(2)));
typedef __bf16 bf16x2_t __attribute__((ext_vector_type(2)));
DI unsigned pk2(float lo, float hi) { const f32x2 v = {lo, hi}; const bf16x2_t r = __builtin_convertvector(v, bf16x2_t); return __builtin_bit_cast(unsigned, r); }
DI float bflo(unsigned u) { return __uint_as_float(u << 16); }
DI float bfhi(unsigned u) { return __uint_as_float(u & 0xffff0000u); }
DI float bf2f(bf16_t v) { return __uint_as_float(((unsigned)v) << 16); }
DI bf16_t f2bf(float x) { return (bf16_t)(pk2(x, 0.f) & 0xffffu); }
DI float siluf(float x) { return x / (1.f + __expf(-x)); }
DI f32x4 mfma16(bf16x8 a, bf16x8 b, f32x4 c) { return __builtin_amdgcn_mfma_f32_16x16x32_bf16(a, b, c, 0, 0, 0); }
DI f32x16 mfma32(bf16x8 a, bf16x8 b, f32x16 c) { return __builtin_amdgcn_mfma_f32_32x32x16_bf16(a, b, c, 0, 0, 0); }
DI bf16x8 cat44(s16x4 lo, s16x4 hi) { return __builtin_shufflevector(lo, hi, 0, 1, 2, 3, 4, 5, 6, 7); }
DI bf16x8 pack8(float a0, float a1, float a2, float a3, float a4, float a5, float a6, float a7) {
  u32x4 p; p.x = pk2(a0, a1); p.y = pk2(a2, a3); p.z = pk2(a4, a5); p.w = pk2(a6, a7); return __builtin_bit_cast(bf16x8, p);
}
DI int clampi(int v, int lo, int hi) { return v < lo ? lo : (v > hi ? hi : v); }
DI float* hrow(float* hlat, float* hctx, int t) { const int b = t / PB, p = t - b * PB; return p < LC ? hctx + (size_t)(b * LC + p) * DM : hlat + (size_t)(b * LL + p - LC) * DM; }
DI const float* hrowc(const float* hlat, const float* hctx, int t) { const int b = t / PB, p = t - b * PB; return p < LC ? hctx + (size_t)(b * LC + p) * DM : hlat + (size_t)(b * LL + p - LC) * DM; }
DI int modvec(int t) { const int b = t / PB, p = t - b * PB; return p < LC ? 4 : b; }

template <int MODE> DI int srccol(int n) {
  if (MODE == 0) return n;
  if (MODE == 1) { const int c = n >> 5, s = (n >> 4) & 1, i = n & 15; return s * FF + 16 * c + i; }
  if (MODE == 2) { if (n >= 2048) return n; const int w = n & 255, j = w >> 1, s = w & 1; return (n & ~255) + s * 128 + j; }
  if (MODE == 3) { const int h = n / 96, w = n - h * 96; if (w < 64) return n; const int wp = w - 64, j = wp >> 1, s = wp & 1; return h * 96 + 64 + s * 16 + j; }
  if (MODE == 4) { if (n < 1024) return (n >> 6) * 128 + (n & 63); const int m = n - 1024; return (m >> 6) * 128 + 64 + (m & 63); }
  if (MODE == 5) return n < 800 ? n : -1;
  return n;
}
template <int MODE>
DI void convert_w(const float* __restrict__ src, int Nsrc, int K, bf16_t* __restrict__ dst, int Ndst, const float* __restrict__ kscale, float* ldsf) {
  const int tid = threadIdx.x, tn = Ndst / 64, tk = K / 64;
  for (int tile = blockIdx.x; tile < tn * tk; tile += gridDim.x) {
    const int n0 = (tile % tn) * 64, k0 = (tile / tn) * 64;
    __syncthreads();
    for (int e = tid; e < 4096; e += NTHR) {
      const int kk = e >> 6, nn = e & 63, sc = srccol<MODE>(n0 + nn);
      float v = sc >= 0 ? src[(size_t)(k0 + kk) * Nsrc + sc] : 0.f;
      if (kscale) v *= kscale[k0 + kk];
      ldsf[kk * 65 + nn] = v;
    }
    __syncthreads();
    { const int nn = tid >> 3, kc = tid & 7; const float* lp = ldsf + (kc * 8) * 65 + nn;
      u32x4 o; o.x = pk2(lp[0], lp[65]); o.y = pk2(lp[130], lp[195]); o.z = pk2(lp[260], lp[325]); o.w = pk2(lp[390], lp[455]);
      *(u32x4*)(dst + (size_t)(n0 + nn) * K + k0 + kc * 8) = o; }
  }
}

DI void ada_phase(const Params& p, float* ldsf) {
  const int tid = threadIdx.x, lane = tid & 63, w = tid >> 6;
  float* mods = (float*)(p.ws + OFF_MODS);
  __syncthreads();
  for (int e = tid; e < 5120; e += NTHR) { const int mv = e >> 10, k = e & 1023; const float cv = mv < 4 ? p.c[mv * 1024 + k] : p.cctx[k]; ldsf[e] = siluf(cv); }
  __syncthreads();
  float* red = ldsf + 5120;
  for (int item = blockIdx.x; item < 4 * 96; item += gridDim.x) {
    const int i = item / 96, n0 = (item % 96) * 64;
    const float* wp = p.ada_w + (size_t)i * 1024 * 6144 + n0 + lane;
    float a0 = 0.f, a1 = 0.f, a2 = 0.f, a3 = 0.f, a4 = 0.f;
#pragma unroll 8
    for (int kk = 0; kk < 128; ++kk) { const int k = w * 128 + kk; const float wv = wp[(size_t)k * 6144];
      a0 += ldsf[k] * wv; a1 += ldsf[1024 + k] * wv; a2 += ldsf[2048 + k] * wv; a3 += ldsf[3072 + k] * wv; a4 += ldsf[4096 + k] * wv; }
    red[(w * 5 + 0) * 64 + lane] = a0; red[(w * 5 + 1) * 64 + lane] = a1; red[(w * 5 + 2) * 64 + lane] = a2; red[(w * 5 + 3) * 64 + lane] = a3; red[(w * 5 + 4) * 64 + lane] = a4;
    __syncthreads();
    if (tid < 320) { const int mv = tid >> 6; float s = 0.f;
#pragma unroll
      for (int ww = 0; ww < 8; ++ww) s += red[(ww * 5 + mv) * 64 + lane];
      mods[(size_t)(i * 5 + mv) * 6144 + n0 + lane] = s + p.ada_b[i * 6144 + n0 + lane]; }
    __syncthreads();
  }
}
DI void tables_phase(const Params& p) {
  const int gt = blockIdx.x * NTHR + threadIdx.x, gn = gridDim.x * NTHR;
  float2* tabR = (float2*)(p.ws + OFF_TABR); float2* tabM = (float2*)(p.ws + OFF_TABM); float* lbv = (float*)(p.ws + OFF_LBV);
  for (int e = gt; e < 128 * 64; e += gn) { const int v = e >> 6, i = e & 63; const float inv = powf(10000.f, -(float)i / 64.f); const float ang = (float)v * inv; tabR[e] = make_float2(cosf(ang), sinf(ang)); }
  for (int e = gt; e < 128 * 8; e += gn) { const int v = e >> 3, i = e & 7; const float inv = powf(10000.f, -(float)i / 8.f); const float ang = (float)v * inv; tabM[e] = make_float2(cosf(ang), sinf(ang)); }
  for (int e = gt; e < 1024; e += gn) { const float l0 = p.hg_lb[e], l1 = p.hg_lb[1024 + e], l2 = p.hg_lb[2048 + e], l3 = p.hg_lb[3072 + e];
    const float mx = fmaxf(fmaxf(l0, l1), fmaxf(l2, l3)); const float e0 = expf(l0 - mx), e1 = expf(l1 - mx), e2 = expf(l2 - mx), e3 = expf(l3 - mx);
    lbv[e] = (e1 + e2 + e3) / (e0 + e1 + e2 + e3); }
}

DI void modulate_phase(const Params& p, const float* slat, const float* sctx, int layer) {
  const float* mods = (const float*)(p.ws + OFF_MODS); bf16_t* a = (bf16_t*)(p.ws + OFF_A);
  const int gt = blockIdx.x * NTHR + threadIdx.x, gn = gridDim.x * NTHR;
  for (int e = gt; e < T_ALL * 128; e += gn) {
    const int t = e >> 7, c0 = (e & 127) * 8; const float* s = hrowc(slat, sctx, t) + c0; const float* m = mods + (size_t)(layer * 5 + modvec(t)) * 6144;
    const f32x4 x0 = *(const f32x4*)s, x1 = *(const f32x4*)(s + 4), sh0 = *(const f32x4*)(m + c0), sh1 = *(const f32x4*)(m + c0 + 4), sc0 = *(const f32x4*)(m + 1024 + c0), sc1 = *(const f32x4*)(m + 1024 + c0 + 4);
    const f32x4 y0 = x0 * (1.f + sc0) + sh0, y1 = x1 * (1.f + sc1) + sh1;
    u32x4 o; o.x = pk2(y0[0], y0[1]); o.y = pk2(y0[2], y0[3]); o.z = pk2(y1[0], y1[1]); o.w = pk2(y1[2], y1[3]);
    *(u32x4*)(a + (size_t)t * 1024 + c0) = o;
  }
}
DI void ln_phase(const Params& p, int lnlayer, int lnidx, int ml, int js, bool final_out) {
  const float* mods = (const float*)(p.ws + OFF_MODS); bf16_t* a = (bf16_t*)(p.ws + OFF_A); float* hctx = (float*)(p.ws + OFF_HCTX); float2* lns = (float2*)(p.ws + OFF_LNS);
  const int tid = threadIdx.x, lane = tid & 63, gw = blockIdx.x * 8 + (tid >> 6), nw = gridDim.x * 8;
  const float* gp = p.ln_g + (size_t)(lnlayer * 2 + lnidx) * 1024; const float* bp = p.ln_b + (size_t)(lnlayer * 2 + lnidx) * 1024;
  for (int t = gw; t < T_ALL; t += nw) {
    float* hr = hrow(p.out, hctx, t);
    f32x4 v[4]; float s = 0.f;
#pragma unroll
    for (int i = 0; i < 4; ++i) { v[i] = *(const f32x4*)(hr + i * 256 + lane * 4); s += (v[i][0] + v[i][1]) + (v[i][2] + v[i][3]); }
#pragma unroll
    for (int o = 1; o < 64; o <<= 1) s += __shfl_xor(s, o);
    const float mean = s * (1.f / 1024.f); float q = 0.f;
#pragma unroll
    for (int i = 0; i < 4; ++i) { v[i] = v[i] - mean; q += (v[i][0] * v[i][0] + v[i][1] * v[i][1]) + (v[i][2] * v[i][2] + v[i][3] * v[i][3]); }
#pragma unroll
    for (int o = 1; o < 64; o <<= 1) q += __shfl_xor(q, o);
    const float rstd = rsqrtf(q * (1.f / 1024.f) + 1e-5f);
    if (!final_out && lane == 0) lns[t] = make_float2(mean, rstd);
    const float* m = mods + (size_t)(ml * 5 + modvec(t)) * 6144 + (size_t)js * 1024;
#pragma unroll
    for (int i = 0; i < 4; ++i) { const int c0 = i * 256 + lane * 4;
      const f32x4 y = v[i] * rstd * *(const f32x4*)(gp + c0) + *(const f32x4*)(bp + c0);
      if (final_out) *(f32x4*)(hr + c0) = y;
      else { const f32x4 z = y * (1.f + *(const f32x4*)(m + 1024 + c0)) + *(const f32x4*)(m + c0); u32x2 o; o.x = pk2(z[0], z[1]); o.y = pk2(z[2], z[3]); *(u32x2*)(a + (size_t)t * 1024 + c0) = o; } }
  }
}

namespace pg8 {
#define PG8_LAS __attribute__((address_space(3)))
typedef unsigned short bf16_t;
typedef short bf16x8 __attribute__((ext_vector_type(8)));
typedef float f32x4 __attribute__((ext_vector_type(4)));
typedef unsigned u32x4 __attribute__((ext_vector_type(4)));
constexpr int BM = 256, BK = 64, HALF = 128, HTB = HALF * BK * 2  , STAGE_BYTES = 8 * HTB, NXCD = 8, WGM = 8;

__host__ __device__ __forceinline__ int lds_byte(int r, int c) { const int st = (r >> 4) * 2 + (c >> 5), rr = r & 15, cc = c & 31, ob = rr * 64 + cc * 2; return st * 1024 + (ob ^ (((ob >> 9) & 1) << 5)); }
__host__ __device__ __forceinline__ void stage_rc(int b, int& R, int& C) { const int st = b / 1024, sb = b % 1024, swz = sb ^ (((sb >> 9) & 1) << 5); R = (st >> 1) * 16 + swz / 64; C = (st & 1) * 32 + (swz % 64) / 2; }
__host__ __device__ __forceinline__ int perm32(int rho) { const int n = rho >> 4, i = rho & 15; return 8 * (i >> 2) + 4 * n + (i & 3); }

struct Unit { int pm, pn; };
struct Gemm { const bf16_t* A; const bf16_t* Bt; int M, N, K; };

struct StaticOrder {
    int nM, nN, nwg, G, c;
    __host__ __device__ void init(int M, int N, int G_, int c_) { nM = M / BM; nN = N / BM; nwg = nM * nN; G = G_; c = c_; }
    __host__ __device__ bool next(int i, Unit& u) const {
        const long L = (long)i * G + c; if (L >= nwg) return false;
        int wgid = (int)L; { const int q = nwg / NXCD, r = nwg % NXCD, xcd = wgid % NXCD, off = wgid / NXCD; wgid = (xcd < r ? xcd * (q + 1) : r * (q + 1) + (xcd - r) * q) + off; }
        const int nig = WGM * nN, gid = wgid / nig, fm = gid * WGM, gsz = (nM - fm) < WGM ? (nM - fm) : WGM;
        u.pm = fm + ((wgid % nig) % gsz); u.pn = (wgid % nig) / gsz; return true;
    }
    __device__ __forceinline__ void a_ready(const Unit&) const {}
    __device__ __forceinline__ void done(const Unit&) const {}
};
template <class Epi, class Sched, bool ALIGN_EPI = false, bool SP2 = false>
__device__ __forceinline__ void gemm_phase(PG8_LAS unsigned char* lds, const Gemm g, const Sched& S, const Epi& E) {
    const int tid = tid_(), wid = __builtin_amdgcn_readfirstlane(tid >> 6), lane = tid & 63, wr = wid >> 2, wc = wid & 3, fr = lane & 15, fq = lane >> 4;
    const int K = g.K, nt = K / BK;
    unsigned voffA[2], voffB[2];
#pragma unroll
    for (int i = 0; i < 2; ++i) { int R, C; stage_rc(tid * 16 + i * 8192, R, C); const int Rb = Epi::PERM ? ((R & ~31) + perm32(R & 31)) : R;
        voffA[i] = (unsigned)(R * K + C) * 2u; voffB[i] = (unsigned)(Rb * K + C) * 2u; }
    const size_t kstep = (size_t)(BK * 2);
    const size_t hstep = (size_t)HALF * K * 2;
    const size_t tstep = 2 * hstep;
    const unsigned ldsw = (unsigned)wid * 1024u;
    const int aoff = lds_byte(wr * 64 + fr, fq * 8), boff = lds_byte(wc * 32 + fr, fq * 8);
#define PG8_SA(b, h) (((b) * 2 + (h)) * HTB)
#define PG8_SB(b, h) ((4 + (b) * 2 + (h)) * HTB)
#define PG8_STAGE(bufoff, gbase, voff) do { _Pragma("unroll") for (int _i = 0; _i < 2; ++_i) \
        __builtin_amdgcn_global_load_lds((const unsigned*)((const char*)(gbase) + (voff)[_i]), (PG8_LAS unsigned*)(lds + (bufoff) + ldsw + _i * 8192), 16, 0, 0); } while (0)
#define PG8_LDA(dst, b, h) do { _Pragma("unroll") for (int m = 0; m < 4; ++m) _Pragma("unroll") for (int k = 0; k < 2; ++k) dst[m][k] = *(const PG8_LAS bf16x8*)(lds + PG8_SA(b, h) + aoff + m * 2048 + k * 1024); } while (0)
#define PG8_LDB(dst, b, h) do { _Pragma("unroll") for (int n = 0; n < 2; ++n) _Pragma("unroll") for (int k = 0; k < 2; ++k) dst[n][k] = *(const PG8_LAS bf16x8*)(lds + PG8_SB(b, h) + boff + n * 2048 + k * 1024); } while (0)
#define PG8_MMA(ai, bj, At, Bt) do { __builtin_amdgcn_s_setprio(1); _Pragma("unroll") for (int m = 0; m < 4; ++m) _Pragma("unroll") for (int n = 0; n < 2; ++n) _Pragma("unroll") for (int k = 0; k < 2; ++k) \
        acc[ai][bj][m][n] = __builtin_amdgcn_mfma_f32_16x16x32_bf16(Bt[n][k], At[m][k], acc[ai][bj][m][n], 0, 0, 0); __builtin_amdgcn_s_setprio(0); } while (0)
#define PG8_WAIT_V(n) asm volatile("s_waitcnt vmcnt(" #n ")" ::: "memory")
#define PG8_WAIT_L(n) asm volatile("s_waitcnt lgkmcnt(" #n ")" ::: "memory")
#define PG8_BAR __builtin_amdgcn_s_barrier()
#define PG8_SCHED __builtin_amdgcn_sched_barrier(0)
    Unit cur, nxt; int ui = 0;
    if (!S.next(0, cur)) return;
    f32x4 acc[2][2][4][2];
#pragma unroll
    for (int a = 0; a < 2; ++a)
#pragma unroll
        for (int b = 0; b < 2; ++b)
#pragma unroll
            for (int m = 0; m < 4; ++m)
#pragma unroll
                for (int n = 0; n < 2; ++n) acc[a][b][m][n] = (f32x4){0.f, 0.f, 0.f, 0.f};
    bf16x8 At[4][2], B0[2][2], B1[2][2];
    const char* cA = (const char*)g.A + (size_t)cur.pm * tstep; const char* cB = (const char*)g.Bt + (size_t)cur.pn * tstep;
    S.a_ready(cur);
    if constexpr (SP2) {
        PG8_STAGE(PG8_SB(0, 0), cB, voffB); PG8_STAGE(PG8_SB(0, 1), cB + hstep, voffB); PG8_STAGE(PG8_SA(0, 0), cA, voffA); PG8_STAGE(PG8_SA(0, 1), cA + hstep, voffA);
        if (wr == 1) PG8_BAR;
        PG8_WAIT_V(2); PG8_BAR;
        PG8_STAGE(PG8_SB(1, 0), cB + kstep, voffB); PG8_STAGE(PG8_SA(1, 0), cA + kstep, voffA); PG8_STAGE(PG8_SB(1, 1), cB + hstep + kstep, voffB);
        PG8_WAIT_V(6); PG8_BAR;
    } else {
        PG8_STAGE(PG8_SB(0, 0), cB, voffB); PG8_STAGE(PG8_SA(0, 0), cA, voffA); PG8_STAGE(PG8_SB(0, 1), cB + hstep, voffB); PG8_STAGE(PG8_SA(0, 1), cA + hstep, voffA);
        if (wr == 1) PG8_BAR;
        PG8_WAIT_V(4); PG8_BAR;
        PG8_STAGE(PG8_SB(1, 0), cB + kstep, voffB); PG8_STAGE(PG8_SA(1, 0), cA + kstep, voffA); PG8_STAGE(PG8_SB(1, 1), cB + hstep + kstep, voffB);
        PG8_WAIT_V(6); PG8_BAR;
    }
    for (;;) {
        const bool has_next = S.next(ui + 1, nxt);
        const char* nA = has_next ? (const char*)g.A + (size_t)nxt.pm * tstep : cA; const char* nB = has_next ? (const char*)g.Bt + (size_t)nxt.pn * tstep : cB;
        for (int t = 0; t < nt; t += 2) {
            const bool last = (t == nt - 2);
            const char* a1 = cA + (size_t)(t + 1) * kstep;
            const char* a2 = last ? nA : cA + (size_t)(t + 2) * kstep; const char* b2 = last ? nB : cB + (size_t)(t + 2) * kstep;
            const char* a3 = a2 + kstep; const char* b3 = b2 + kstep;
            if (last && has_next) S.a_ready(nxt);
            if constexpr (SP2) {
            PG8_LDB(B0, 0, 0); PG8_LDB(B1, 0, 1); PG8_SCHED; PG8_LDA(At, 0, 0); PG8_STAGE(PG8_SA(1, 1), a1 + hstep, voffA);
            PG8_WAIT_V(8); PG8_WAIT_L(0); PG8_BAR; PG8_MMA(0, 0, At, B0); PG8_MMA(0, 1, At, B1); PG8_BAR; PG8_SCHED;
            PG8_LDA(At, 0, 1); PG8_STAGE(PG8_SB(0, 0), b2, voffB); PG8_STAGE(PG8_SB(0, 1), b2 + hstep, voffB); PG8_STAGE(PG8_SA(0, 0), a2, voffA);
            PG8_WAIT_V(8); PG8_WAIT_L(0); PG8_BAR; PG8_MMA(1, 0, At, B0); PG8_MMA(1, 1, At, B1); PG8_BAR; PG8_SCHED;
            PG8_LDB(B0, 1, 0); PG8_LDB(B1, 1, 1); PG8_SCHED; PG8_LDA(At, 1, 0); PG8_STAGE(PG8_SA(0, 1), a2 + hstep, voffA);
            PG8_WAIT_V(8); PG8_WAIT_L(0); PG8_BAR; PG8_MMA(0, 0, At, B0); PG8_MMA(0, 1, At, B1); PG8_BAR; PG8_SCHED;
            PG8_LDA(At, 1, 1); PG8_STAGE(PG8_SB(1, 0), b3, voffB); PG8_STAGE(PG8_SB(1, 1), b3 + hstep, voffB); PG8_STAGE(PG8_SA(1, 0), a3, voffA);
            PG8_WAIT_V(8); PG8_WAIT_L(0); PG8_BAR; PG8_MMA(1, 0, At, B0); PG8_MMA(1, 1, At, B1); PG8_BAR; PG8_SCHED;
            } else {
            PG8_LDB(B0, 0, 0); PG8_SCHED; PG8_LDA(At, 0, 0); PG8_STAGE(PG8_SA(1, 1), a1 + hstep, voffA);
            PG8_WAIT_L(8); PG8_BAR; PG8_WAIT_L(0); PG8_MMA(0, 0, At, B0); PG8_BAR; PG8_SCHED;
            PG8_LDB(B1, 0, 1); PG8_STAGE(PG8_SB(0, 0), b2, voffB);
            PG8_BAR; PG8_WAIT_L(0); PG8_MMA(0, 1, At, B1); PG8_BAR;
            PG8_LDA(At, 0, 1); PG8_STAGE(PG8_SA(0, 0), a2, voffA);
            PG8_BAR; PG8_WAIT_L(0); PG8_MMA(1, 0, At, B0); PG8_BAR; PG8_SCHED;
            PG8_STAGE(PG8_SB(0, 1), b2 + hstep, voffB);
            PG8_WAIT_V(6); PG8_BAR; PG8_MMA(1, 1, At, B1); PG8_BAR;
            PG8_LDB(B0, 1, 0); PG8_SCHED; PG8_LDA(At, 1, 0); PG8_STAGE(PG8_SA(0, 1), a2 + hstep, voffA);
            PG8_WAIT_L(8); PG8_BAR; PG8_WAIT_L(0); PG8_MMA(0, 0, At, B0); PG8_BAR; PG8_SCHED;
            PG8_LDB(B1, 1, 1); PG8_STAGE(PG8_SB(1, 0), b3, voffB);
            PG8_BAR; PG8_WAIT_L(0); PG8_MMA(0, 1, At, B1); PG8_BAR;
            PG8_LDA(At, 1, 1); PG8_STAGE(PG8_SA(1, 0), a3, voffA);
            PG8_BAR; PG8_WAIT_L(0); PG8_MMA(1, 0, At, B0); PG8_BAR; PG8_SCHED;
            PG8_STAGE(PG8_SB(1, 1), b3 + hstep, voffB);
            PG8_WAIT_V(6); PG8_BAR; PG8_MMA(1, 1, At, B1); PG8_BAR;
            }
        }
        if constexpr (ALIGN_EPI) { if (wr == 0) PG8_BAR; }
        if constexpr (!Epi::AFTER_DRAIN) { E(acc, cur, wr, wc, fr, fq); S.done(cur); }
        if (!has_next) break;
#pragma unroll
        for (int a = 0; a < 2; ++a)
#pragma unroll
            for (int b = 0; b < 2; ++b)
#pragma unroll
                for (int m = 0; m < 4; ++m)
#pragma unroll
                    for (int n = 0; n < 2; ++n) acc[a][b][m][n] = (f32x4){0.f, 0.f, 0.f, 0.f};
        cur = nxt; cA = nA; cB = nB; ++ui;
        if constexpr (ALIGN_EPI) { if (wr == 1) PG8_BAR; }
    }
    PG8_WAIT_V(0);
    if constexpr (!ALIGN_EPI) { if (wr == 0) PG8_BAR; }
    PG8_BAR;
    if constexpr (Epi::AFTER_DRAIN) { E.fused(acc, cur, wr, wc, fr, fq, lds, wid, lane); S.done(cur); }
#undef PG8_SA
#undef PG8_SB
#undef PG8_STAGE
#undef PG8_LDA
#undef PG8_LDB
#undef PG8_MMA
#undef PG8_WAIT_V
#undef PG8_WAIT_L
#undef PG8_BAR
#undef PG8_SCHED
}
}

template <class E4> struct EpiWrap { static constexpr bool PERM = false, AFTER_DRAIN = false; E4 e;
  DI void operator()(const f32x4 (&acc)[2][2][4][2], const pg8::Unit& u, int wr, int wc, int fr, int fq) const {
#pragma unroll
    for (int ai = 0; ai < 2; ++ai)
#pragma unroll
      for (int m = 0; m < 4; ++m) { const int row = u.pm * 256 + ai * 128 + wr * 64 + m * 16 + fr;
#pragma unroll
        for (int bj = 0; bj < 2; ++bj) { const int col = u.pn * 256 + bj * 128 + wc * 32 + 4 * fq;
          if constexpr (E4::PAIR) e.pair(row, ((col - 4 * fq) >> 1) + 4 * fq, acc[ai][bj][m][0], acc[ai][bj][m][1]);
          else { e(row, col, acc[ai][bj][m][0]); e(row, col + 16, acc[ai][bj][m][1]); } }
        asm volatile("" ::: "memory"); }
  } };
template <class E4>
DI void big_gemm(const bf16_t* A, const bf16_t* W, int M, int N, int K, const E4& e4, char* lds) {
  __syncthreads();
  pg8::Gemm g{A, W, M, N, K}; pg8::StaticOrder S; S.init(M, N, (int)gridDim.x, (int)blockIdx.x); EpiWrap<E4> E{e4};
  pg8::gemm_phase<EpiWrap<E4>, pg8::StaticOrder, true, true>((PG8_LAS unsigned char*)lds, g, S, E);
  __syncthreads();
}
struct GemmArgs { const bf16_t* A; int lda; const bf16_t* W; int ldw; int M, N, K; };
constexpr int LDT = 72;
template <bool TRANS, class Epi>
DI void gemm_phase(const GemmArgs g, const Epi epi, char* lds) {
  const int tid = threadIdx.x, lane = tid & 63, w = tid >> 6, wm = w & 3, wn = w >> 2, g4 = lane >> 4, l16 = lane & 15;
  const int nN = g.N / 128, ntiles = (g.M / 256) * nN, nk = g.K / 64;
  bf16_t* As = (bf16_t*)lds; bf16_t* Bs = As + 256 * LDT;
  for (int tile = blockIdx.x; tile < ntiles; tile += gridDim.x) {
    const int pm = tile / nN, pn = tile - pm * nN;
    const bf16_t* Ag = g.A + (size_t)(pm * 256) * g.lda; const bf16_t* Wg = g.W + (size_t)(pn * 128) * g.ldw;
    f32x4 acc[4][4];
#pragma unroll
    for (int i = 0; i < 4; ++i)
#pragma unroll
      for (int j = 0; j < 4; ++j) acc[i][j] = (f32x4){0.f, 0.f, 0.f, 0.f};
    u32x4 ra[4], rb[2];
#pragma unroll
    for (int i = 0; i < 4; ++i) { const int c = tid + NTHR * i; ra[i] = *(const u32x4*)(Ag + (size_t)(c >> 3) * g.lda + (c & 7) * 8); }
#pragma unroll
    for (int i = 0; i < 2; ++i) { const int c = tid + NTHR * i; rb[i] = *(const u32x4*)(Wg + (size_t)(c >> 3) * g.ldw + (c & 7) * 8); }
    for (int kt = 0; kt < nk; ++kt) {
      __syncthreads();
#pragma unroll
      for (int i = 0; i < 4; ++i) { const int c = tid + NTHR * i; *(u32x4*)(As + (c >> 3) * LDT + (c & 7) * 8) = ra[i]; }
#pragma unroll
      for (int i = 0; i < 2; ++i) { const int c = tid + NTHR * i; *(u32x4*)(Bs + (c >> 3) * LDT + (c & 7) * 8) = rb[i]; }
      __syncthreads();
      if (kt + 1 < nk) { const int k0 = (kt + 1) * 64;
#pragma unroll
        for (int i = 0; i < 4; ++i) { const int c = tid + NTHR * i; ra[i] = *(const u32x4*)(Ag + (size_t)(c >> 3) * g.lda + k0 + (c & 7) * 8); }
#pragma unroll
        for (int i = 0; i < 2; ++i) { const int c = tid + NTHR * i; rb[i] = *(const u32x4*)(Wg + (size_t)(c >> 3) * g.ldw + k0 + (c & 7) * 8); } }
#pragma unroll
      for (int ks = 0; ks < 2; ++ks) {
        bf16x8 af[4], wf[4];
#pragma unroll
        for (int i = 0; i < 4; ++i) af[i] = *(const bf16x8*)(As + (wm * 64 + i * 16 + l16) * LDT + ks * 32 + g4 * 8);
#pragma unroll
        for (int j = 0; j < 4; ++j) wf[j] = *(const bf16x8*)(Bs + (wn * 64 + j * 16 + l16) * LDT + ks * 32 + g4 * 8);
#pragma unroll
        for (int i = 0; i < 4; ++i)
#pragma unroll
          for (int j = 0; j < 4; ++j) acc[i][j] = TRANS ? mfma16(af[i], wf[j], acc[i][j]) : mfma16(wf[j], af[i], acc[i][j]);
      }
    }
    const int mb = pm * 256 + wm * 64, nb = pn * 128 + wn * 64;
    if constexpr (Epi::PAIR) {
#pragma unroll
      for (int i = 0; i < 4; ++i)
#pragma unroll
        for (int j = 0; j < 2; ++j) epi.pair(mb + i * 16 + l16, (nb >> 1) + 16 * j + 4 * g4, acc[i][2 * j], acc[i][2 * j + 1]);
    } else {
#pragma unroll
      for (int i = 0; i < 4; ++i)
#pragma unroll
        for (int j = 0; j < 4; ++j) { if (TRANS) epi(mb + i * 16 + 4 * g4, nb + j * 16 + l16, acc[i][j]); else epi(mb + i * 16 + l16, nb + j * 16 + 4 * g4, acc[i][j]); }
    }
  }
}
DI void st4bf(bf16_t* p, f32x4 v) { u32x2 o; o.x = pk2(v[0], v[1]); o.y = pk2(v[2], v[3]); *(u32x2*)p = o; }
struct EpiStore { static constexpr bool PAIR = false; bf16_t* d0; bf16_t* d1; int split, ld0, ld1; float s0;
  DI void operator()(int m, int n, f32x4 v) const { if (n < split) st4bf(d0 + (size_t)m * ld0 + n, v * s0); else st4bf(d1 + (size_t)m * ld1 + (n - split), v); } };
struct EpiVT { static constexpr bool PAIR = false; bf16_t* vt; const float* rs;
  DI void operator()(int m, int n, f32x4 v) const { const int b = m / PB, pos = m - b * PB;
    if (rs) { v[0] *= rs[2 * m + 1]; v[1] *= rs[2 * m + 3]; v[2] *= rs[2 * m + 5]; v[3] *= rs[2 * m + 7]; }
    st4bf(vt + ((size_t)(b * 1024 + n)) * PB + pos, v); } };
struct EpiResid { static constexpr bool PAIR = false; const float* slat; const float* sctx; float* dlat; float* dctx; const float* gate;
  const float2* lns; const float* lg; const float* lb;
  DI void operator()(int m, int n, f32x4 v) const { const int mv = modvec(m); f32x4 hv = *(const f32x4*)(hrowc(slat, sctx, m) + n); const f32x4 gt = *(const f32x4*)(gate + (size_t)mv * 6144 + n);
    if (lns) { const float2 st = lns[m]; hv = (hv - st.x) * st.y * *(const f32x4*)(lg + n) + *(const f32x4*)(lb + n); }
    *(f32x4*)(hrow(dlat, dctx, m) + n) = ALPHA * hv + gt * v; } };
struct EpiSwiglu { static constexpr bool PAIR = true; bf16_t* u;
  DI void pair(int m, int f, f32x4 gt, f32x4 up) const { f32x4 r; r[0] = siluf(gt[0]) * up[0]; r[1] = siluf(gt[1]) * up[1]; r[2] = siluf(gt[2]) * up[2]; r[3] = siluf(gt[3]) * up[3]; st4bf(u + (size_t)m * FF + f, r); } };
struct EpiRetQK { static constexpr bool PAIR = false; bf16_t* qk; const float2* tabR;
  DI void operator()(int m, int n, f32x4 v) const { const int b = m / PB, pp = m - b * PB;
    if (pp >= LC) { const int pos = pp - LC, row = pos >> 6, col = pos & 63; const int j0 = (n & 255) >> 1;
      const int vv = j0 < 64 ? row : col; const float2 c0 = tabR[vv * 64 + (j0 & 63)], c1 = tabR[vv * 64 + ((j0 + 1) & 63)];
      const float a0 = v[0] * c0.x - v[1] * c0.y, b0 = v[0] * c0.y + v[1] * c0.x, a1 = v[2] * c1.x - v[3] * c1.y, b1 = v[2] * c1.y + v[3] * c1.x; v = (f32x4){a0, b0, a1, b1}; }
    if (n >= 1024) v = v * 0.0625f;
    st4bf(qk + (size_t)m * 2048 + n, v); } };
struct EpiHg { static constexpr bool PAIR = false; bf16_t* ph;
  DI void operator()(int m, int n, f32x4 v) const { if (n < 1024) { v[0] = siluf(v[0]); v[1] = siluf(v[1]); v[2] = siluf(v[2]); v[3] = siluf(v[3]); v = v * 0.08838834764831845f; } st4bf(ph + (size_t)m * 5120 + n, v); } };
struct EpiMlaQ { static constexpr bool PAIR = false; bf16_t* q; const float* rs; const float2* tabM;
  DI void operator()(int m, int n, f32x4 v) const { v = v * (rs[2 * m] * 0.10206207261596577f * LOG2E); const int h = n / 96, w = n - h * 96; const int b = m / PB, pp = m - b * PB;
    if (w >= 64 && pp >= LC) { const int pos = pp - LC, row = pos >> 6, col = pos & 63; const int j0 = (w - 64) >> 1; const int vv = j0 < 8 ? row : col; const float2 c0 = tabM[vv * 8 + (j0 & 7)], c1 = tabM[vv * 8 + ((j0 + 1) & 7)];
      const float a0 = v[0] * c0.x - v[1] * c0.y, b0 = v[0] * c0.y + v[1] * c0.x, a1 = v[2] * c1.x - v[3] * c1.y, b1 = v[2] * c1.y + v[3] * c1.x; v = (f32x4){a0, b0, a1, b1}; }
    st4bf(q + (size_t)m * 1536 + n, v); } };
struct EpiMlaK { static constexpr bool PAIR = false; bf16_t* k; const float* rs;
  DI void operator()(int m, int n, f32x4 v) const { v = v * rs[2 * m + 1]; st4bf(k + (size_t)m * 1536 + (n >> 6) * 96 + (n & 63), v); } };

DI void mla_stats_phase(const Params& p) {
  const bf16_t* d0 = (const bf16_t*)(p.ws + M_D0); bf16_t* km = (bf16_t*)(p.ws + M_K); float* rs = (float*)(p.ws + OFF_RS); const float2* tabM = (const float2*)(p.ws + OFF_TABM);
  const int tid = threadIdx.x, lane = tid & 63, gw = blockIdx.x * 8 + (tid >> 6), nw = gridDim.x * 8;
  for (int t = gw; t < T_ALL; t += nw) {
    const bf16_t* r = d0 + (size_t)t * 1024;
    const u32x4 a = *(const u32x4*)(r + lane * 8); const u32x2 c = *(const u32x2*)(r + 512 + lane * 4);
    float sq = bflo(a.x) * bflo(a.x) + bfhi(a.x) * bfhi(a.x) + bflo(a.y) * bflo(a.y) + bfhi(a.y) * bfhi(a.y) + bflo(a.z) * bflo(a.z) + bfhi(a.z) * bfhi(a.z) + bflo(a.w) * bflo(a.w) + bfhi(a.w) * bfhi(a.w);
    float sk = bflo(c.x) * bflo(c.x) + bfhi(c.x) * bfhi(c.x) + bflo(c.y) * bflo(c.y) + bfhi(c.y) * bfhi(c.y);
#pragma unroll
    for (int o = 1; o < 64; o <<= 1) { sq += __shfl_xor(sq, o); sk += __shfl_xor(sk, o); }
    if (lane == 0) { rs[2 * t] = rsqrtf(sq * (1.f / 512.f) + 1e-6f); rs[2 * t + 1] = rsqrtf(sk * (1.f / 256.f) + 1e-6f); }
    if (lane < 16) { const int j = lane; float x1 = bf2f(r[768 + j]), x2 = bf2f(r[768 + 16 + j]); const int b = t / PB, pp = t - b * PB;
      if (pp >= LC) { const int pos = pp - LC, row = pos >> 6, col = pos & 63; const float2 cs = tabM[(j < 8 ? row : col) * 8 + (j & 7)]; const float o1 = x1 * cs.x - x2 * cs.y, o2 = x1 * cs.y + x2 * cs.x; x1 = o1; x2 = o2; }
      const unsigned pr = pk2(x1, x2);
#pragma unroll
      for (int h = 0; h < 16; ++h) *(unsigned*)(km + (size_t)t * 1536 + h * 96 + 64 + 2 * j) = pr; }
  }
}

constexpr int KLD = 104, VLD = 72;
DI void mla_attn_phase(const Params& p, char* lds) {
  const bf16_t* Qm = (const bf16_t*)(p.ws + M_Q); const bf16_t* Km = (const bf16_t*)(p.ws + M_K); const bf16_t* vT = (const bf16_t*)(p.ws + M_VT); bf16_t* o = (bf16_t*)(p.ws + OFF_A);
  const int tid = threadIdx.x, lane = tid & 63, w = tid >> 6, c = lane & 31, hh = lane >> 5;
  constexpr int KB = 64 * KLD, VB = 64 * VLD;
  bf16_t* Ks = (bf16_t*)lds; bf16_t* Vs = Ks + 3 * KB;
  for (int item = blockIdx.x; item < 2048 + 64; item += gridDim.x) {
    int b, h, qbase, nkt;
    if (item < 2048) { b = item >> 9; h = (item >> 5) & 15; qbase = LC + (item & 31) * 256; nkt = 132; } else { const int it = item - 2048; b = it >> 4; h = it & 15; qbase = 0; nkt = 4; }
    const size_t tokbase = (size_t)b * PB;
    const bf16_t* qp = Qm + (tokbase + qbase + w * 32 + c) * 1536 + h * 96 + hh * 8;
    bf16x8 qf[6];
#pragma unroll
    for (int ks = 0; ks < 6; ++ks) qf[ks] = *(const bf16x8*)(qp + ks * 16);
    const bf16_t* kg = Km + tokbase * 1536 + h * 96; const bf16_t* vg = vT + (size_t)(b * 16 + h) * 64 * PB;
    const int kr0 = tid / 12, kc0 = tid - kr0 * 12, e1 = tid + NTHR, kr1 = e1 / 12, kc1 = e1 - kr1 * 12; const bool k1ok = e1 < 768; const int vd = tid >> 3, vc = tid & 7;
    u32x4 rk0, rk1 = (u32x4){0, 0, 0, 0}, rv;
    auto gload = [&](int t) { const size_t key0 = (size_t)t * 64;
      rk0 = *(const u32x4*)(kg + (key0 + kr0) * 1536 + kc0 * 8); if (k1ok) rk1 = *(const u32x4*)(kg + (key0 + kr1) * 1536 + kc1 * 8); rv = *(const u32x4*)(vg + (size_t)vd * PB + key0 + vc * 8); };
    auto lstore = [&](int buf) { bf16_t* Kn = Ks + buf * KB; bf16_t* Vn = Vs + buf * VB;
      *(u32x4*)(Kn + kr0 * KLD + kc0 * 8) = rk0; if (k1ok) *(u32x4*)(Kn + kr1 * KLD + kc1 * 8) = rk1; *(u32x4*)(Vn + vd * VLD + vc * 8) = rv; };
    f32x16 oacc[2];
#pragma unroll
    for (int i = 0; i < 16; ++i) { oacc[0][i] = 0.f; oacc[1][i] = 0.f; }
    float mrow = -1e30f, lsum = 0.f;
    auto qk = [&](int buf, f32x16 (&s)[2]) { const bf16_t* Kc = Ks + buf * KB;
#pragma unroll
      for (int j = 0; j < 2; ++j) {
#pragma unroll
        for (int i = 0; i < 16; ++i) s[j][i] = 0.f;
#pragma unroll
        for (int ks = 0; ks < 6; ++ks) { const bf16x8 kf = *(const bf16x8*)(Kc + (32 * j + c) * KLD + ks * 16 + hh * 8); s[j] = mfma32(kf, qf[ks], s[j]); }
      } };
    auto smpv = [&](int buf, f32x16 (&s)[2]) { const bf16_t* Vc = Vs + buf * VB;
      float mx = s[0][0];
#pragma unroll
      for (int j = 0; j < 2; ++j)
#pragma unroll
        for (int i = 0; i < 16; ++i) mx = fmaxf(mx, s[j][i]);
      mx = fmaxf(mx, __shfl_xor(mx, 32));
      const float mnew = fmaxf(mrow, mx), alpha = __builtin_amdgcn_exp2f(mrow - mnew); mrow = mnew;
      float ps = 0.f;
#pragma unroll
      for (int j = 0; j < 2; ++j)
#pragma unroll
        for (int i = 0; i < 16; ++i) { s[j][i] = __builtin_amdgcn_exp2f(s[j][i] - mnew); ps += s[j][i]; }
      lsum = lsum * alpha + ps;
#pragma unroll
      for (int i = 0; i < 16; ++i) { oacc[0][i] *= alpha; oacc[1][i] *= alpha; }
#pragma unroll
      for (int j = 0; j < 2; ++j)
#pragma unroll
        for (int sx = 0; sx < 2; ++sx) {
          const bf16x8 pf = pack8(s[j][8 * sx], s[j][8 * sx + 1], s[j][8 * sx + 2], s[j][8 * sx + 3], s[j][8 * sx + 4], s[j][8 * sx + 5], s[j][8 * sx + 6], s[j][8 * sx + 7]);
#pragma unroll
          for (int dt = 0; dt < 2; ++dt) { const bf16_t* vp = Vc + (32 * dt + c) * VLD + 32 * j + 16 * sx + 4 * hh;
            const bf16x8 vf = cat44(*(const s16x4*)vp, *(const s16x4*)(vp + 8)); oacc[dt] = mfma32(vf, pf, oacc[dt]); }
        } };
    __syncthreads();
    gload(0); lstore(0); gload(1); lstore(1); if (nkt > 2) gload(2);
    __syncthreads();
    f32x16 sA[2], sB[2];
    qk(0, sA);
    int b0 = 0, b1 = 1, b2 = 2;
    for (int kt = 0; kt < nkt; kt += 2) {
      __syncthreads();
      if (kt + 2 < nkt) { lstore(b2); if (kt + 3 < nkt) gload(kt + 3); }
      qk(b1, sB);
      smpv(b0, sA);
      __syncthreads();
      if (kt + 3 < nkt) { lstore(b0); if (kt + 4 < nkt) gload(kt + 4); }
      if (kt + 2 < nkt) qk(b2, sA);
      smpv(b1, sB);
      { const int t0 = b0; b0 = b2; b2 = b1; b1 = t0; }
    }
    lsum += __shfl_xor(lsum, 32); const float inv = 1.f / lsum;
    bf16_t* op = o + (tokbase + qbase + w * 32 + c) * 1024 + h * 64 + 4 * hh;
#pragma unroll
    for (int dt = 0; dt < 2; ++dt)
#pragma unroll
      for (int rg = 0; rg < 4; ++rg) st4bf(op + 32 * dt + 8 * rg, (f32x4){oacc[dt][4 * rg] * inv, oacc[dt][4 * rg + 1] * inv, oacc[dt][4 * rg + 2] * inv, oacc[dt][4 * rg + 3] * inv});
  }
}

constexpr int NKC = 72, NVC = 264;
template <bool CTX>
DI void na_wave(const bf16_t* __restrict__ Q, const bf16_t* __restrict__ K, const bf16_t* __restrict__ vT, bf16_t* __restrict__ o, const float* rpb  ,
                const bf16_t* Kc, const bf16_t* Vc  , int b, int h, int r, int n, int lane) {
  constexpr int NT = CTX ? 16 : 32;
  const int g = lane >> 4, l16 = lane & 15; const size_t tokbase = (size_t)b * PB;
  const int qpos = CTX ? (n * 16 + l16) : (LC + r * 64 + n * 16 + l16);
  const int rs = clampi(r - 4, 0, 120), band0 = clampi(16 * n - 8, 0, 32);
  const bf16_t* qp = Q + (tokbase + qpos) * 1024 + h * 64 + g * 8;
  const bf16x8 q0 = *(const bf16x8*)qp, q1 = *(const bf16x8*)(qp + 32);
  f32x4 S[NT];
#pragma unroll
  for (int kt = 0; kt < NT; ++kt) {
    f32x4 s;
    if (!CTX && kt < 16) {
      const int kpos = LC + (rs + (kt >> 1)) * 64 + band0 + 16 * (kt & 1) + l16;
      const bf16_t* kp = K + (tokbase + kpos) * 1024 + h * 64 + g * 8;
      s = mfma16(*(const bf16x8*)kp, q0, (f32x4){0.f, 0.f, 0.f, 0.f}); s = mfma16(*(const bf16x8*)(kp + 32), q1, s);
      const int qcol = 16 * n + l16, wstart = clampi(qcol - 8, 0, 48); const float* bp = rpb + (rs + (kt >> 1) - r + 7) * 31;
#pragma unroll
      for (int rr = 0; rr < 4; ++rr) { const int kcol = band0 + 16 * (kt & 1) + 4 * g + rr; const bool ok = kcol >= wstart && kcol < wstart + 16;
        s[rr] = ok ? (s[rr] + bp[clampi(kcol - qcol + 15, 0, 30)]) * LOG2E : -1e30f; }
    } else {
      const bf16_t* kp = Kc + (16 * (CTX ? kt : kt - 16) + l16) * NKC + g * 8;
      s = mfma16(*(const bf16x8*)kp, q0, (f32x4){0.f, 0.f, 0.f, 0.f}); s = mfma16(*(const bf16x8*)(kp + 32), q1, s);
      s = s * LOG2E;
    }
    S[kt] = s;
    if ((kt & 3) == 3) asm volatile("" ::: "memory");
  }
  float mx = S[0][0];
#pragma unroll
  for (int kt = 0; kt < NT; ++kt) mx = fmaxf(fmaxf(fmaxf(mx, S[kt][0]), fmaxf(S[kt][1], S[kt][2])), S[kt][3]);
  mx = fmaxf(mx, __shfl_xor(mx, 16)); mx = fmaxf(mx, __shfl_xor(mx, 32));
  float ls = 0.f;
#pragma unroll
  for (int kt = 0; kt < NT; ++kt)
#pragma unroll
    for (int rr = 0; rr < 4; ++rr) { S[kt][rr] = __builtin_amdgcn_exp2f(S[kt][rr] - mx); ls += S[kt][rr]; }
  ls += __shfl_xor(ls, 16); ls += __shfl_xor(ls, 32);
  f32x4 O[4];
#pragma unroll
  for (int dt = 0; dt < 4; ++dt) O[dt] = (f32x4){0.f, 0.f, 0.f, 0.f};
  const bf16_t* vb = vT + ((size_t)(b * 16 + h) * 64 + l16) * PB;
#pragma unroll
  for (int kk = 0; kk < NT / 2; ++kk) {
    const bf16x8 pf = pack8(S[2 * kk][0], S[2 * kk][1], S[2 * kk][2], S[2 * kk][3], S[2 * kk + 1][0], S[2 * kk + 1][1], S[2 * kk + 1][2], S[2 * kk + 1][3]);
    if (!CTX && kk < 8) {
      const int pos0 = LC + (rs + kk) * 64 + band0 + 4 * g;
#pragma unroll
      for (int dt = 0; dt < 4; ++dt) { const bf16_t* vp = vb + (size_t)(dt * 16) * PB + pos0; const bf16x8 vf = cat44(*(const s16x4*)vp, *(const s16x4*)(vp + 16)); O[dt] = mfma16(vf, pf, O[dt]); }
    } else {
      const int pos0 = 32 * (CTX ? kk : kk - 8) + 4 * g;
#pragma unroll
      for (int dt = 0; dt < 4; ++dt) { const bf16_t* vp = Vc + (dt * 16 + l16) * NVC + pos0; const bf16x8 vf = cat44(*(const s16x4*)vp, *(const s16x4*)(vp + 16)); O[dt] = mfma16(vf, pf, O[dt]); }
    }
    if ((kk & 1) == 1) asm volatile("" ::: "memory");
  }
  const float inv = 1.f / ls; bf16_t* op = o + (tokbase + qpos) * 1024 + h * 64 + 4 * g;
#pragma unroll
  for (int dt = 0; dt < 4; ++dt) st4bf(op + 16 * dt, O[dt] * inv);
}
DI void na_attn_phase(const Params& p, char* lds) {
  const bf16_t* Q = (const bf16_t*)(p.ws + N_Q); const bf16_t* K = (const bf16_t*)(p.ws + N_K); const bf16_t* vT = (const bf16_t*)(p.ws + N_VT); bf16_t* o = (bf16_t*)(p.ws + OFF_A);
  bf16_t* Kc = (bf16_t*)lds; bf16_t* Vc = Kc + 256 * NKC; float* rl = (float*)(Vc + 64 * NVC);
  const int tid = threadIdx.x, lane = tid & 63, w = tid >> 6;
  for (int item = blockIdx.x; item < 256; item += gridDim.x) {
    const int qtr = item & 3, h = (item >> 2) & 15, b = item >> 6; const size_t tokbase = (size_t)b * PB;
    __syncthreads();
#pragma unroll
    for (int i = 0; i < 4; ++i) { const int e = tid + NTHR * i; const int key = e >> 3, kc = e & 7; *(u32x4*)(Kc + key * NKC + kc * 8) = *(const u32x4*)(K + (tokbase + key) * 1024 + h * 64 + kc * 8); }
#pragma unroll
    for (int i = 0; i < 4; ++i) { const int e = tid + NTHR * i; const int d = e >> 5, pc = e & 31; *(u32x4*)(Vc + d * NVC + pc * 8) = *(const u32x4*)(vT + ((size_t)(b * 16 + h) * 64 + d) * PB + pc * 8); }
    for (int e = tid; e < 465; e += NTHR) rl[e] = p.na_rpb[h * 465 + e];
    __syncthreads();
#pragma unroll 1
    for (int j = 0; j < 16; ++j) { const int qi = j * 8 + w; int ln = lane; asm volatile("" : "+v"(ln)); na_wave<false>(Q, K, vT, o, rl, Kc, Vc, b, h, qtr * 32 + (qi >> 2), qi & 3, ln); }
    if (w < 4) na_wave<true>(Q, K, vT, o, rl, Kc, Vc, b, h, 0, qtr * 4 + w, lane);
  }
}

template <int DK> struct ScanLds { static constexpr int QLD = DK + 8, TLD = 72;
  static constexpr int OFF_QD = 0, OFF_KD = OFF_QD + 64 * QLD * 2, OFF_VT = OFF_KD + 64 * QLD * 2, OFF_ATT = OFF_VT + 64 * TLD * 2, OFF_ST = OFF_ATT + 64 * TLD * 2, OFF_EB = OFF_ST + 64 * QLD * 2, OFF_QS = OFF_EB + DK * 4, TOTAL = OFF_QS + 8 * DK * 4; };
DI int scan_pos(int dir, int i, int tl) { if (dir == 0) return i * 64 + tl; return i < 4 ? 255 - (i * 64 + tl) : 8447 - ((i - 4) * 64 + tl); }
DI bf16x8 gather8(const bf16_t* p, int stride) {
  const unsigned a0 = p[0], a1 = p[stride], a2 = p[2 * stride], a3 = p[3 * stride], a4 = p[4 * stride], a5 = p[5 * stride], a6 = p[6 * stride], a7 = p[7 * stride];
  u32x4 r; r.x = a0 | (a1 << 16); r.y = a2 | (a3 << 16); r.z = a4 | (a5 << 16); r.w = a6 | (a7 << 16); return __builtin_bit_cast(bf16x8, r);
}

template <int DK, bool HG>
DI void scan_phase(const Params& p, char* lds) {
  typedef ScanLds<DK> L;
  bf16_t* Qd = (bf16_t*)(lds + L::OFF_QD); bf16_t* Kd = (bf16_t*)(lds + L::OFF_KD); bf16_t* Vt = (bf16_t*)(lds + L::OFF_VT);
  bf16_t* Att = (bf16_t*)(lds + L::OFF_ATT); bf16_t* St = (bf16_t*)(lds + L::OFF_ST); float* eb = (float*)(lds + L::OFF_EB); float* qs = (float*)(lds + L::OFF_QS);
  constexpr int QLD = L::QLD, TLD = L::TLD, KT = DK / 16 / 8;
  const int tid = tid_(), lane = tid & 63, w = tid >> 6, g4 = lane >> 4, l16 = lane & 15;
  const int nitems = HG ? 128 : 256;
  const float* lbv = (const float*)(p.ws + OFF_LBV);
  for (int item = blockIdx.x; item < nitems; item += gridDim.x) {
    int b, h, sl, dir; if (HG) { sl = item & 1; h = (item >> 1) & 7; b = (item >> 4) & 3; dir = item >> 6; } else { sl = item & 7; h = (item >> 3) & 3; b = (item >> 5) & 3; dir = item >> 7; }
    const size_t tokbase = (size_t)b * PB;
    const bf16_t *qsrc, *ksrc, *vsrc; int ldq, ldv; bf16_t *octx, *olat; int ldo;
    if (HG) { const bf16_t* ph = (const bf16_t*)(p.ws + H_P); qsrc = ph + h * 128; ksrc = ph + 1024 + dir * 1024 + h * 128; vsrc = ph + 3072 + h * 128 + sl * 64; ldq = 5120; ldv = 5120; ldo = 1024;
      octx = (bf16_t*)(p.ws + (dir ? OFF_W0 : OFF_A)) + tokbase * 1024 + h * 128 + sl * 64; olat = octx + (size_t)LC * 1024; }
    else { const bf16_t* qk = (const bf16_t*)(p.ws + R_QK); qsrc = qk + h * 256; ksrc = qk + 1024 + h * 256; vsrc = (const bf16_t*)(p.ws + R_V) + h * 512 + sl * 64; ldq = 2048; ldv = 2048; ldo = 2048;
      if (dir == 0) { octx = (bf16_t*)(p.ws + R_O) + tokbase * 2048 + h * 512 + sl * 64; olat = octx + (size_t)LC * 2048; }
      else { octx = (bf16_t*)(p.ws + OFF_HCTX) + (size_t)b * LC * 2048 + h * 512 + sl * 64; olat = (bf16_t*)p.out + (size_t)b * LL * 2048 + h * 512 + sl * 64; } }
    float lg = 0.f; if (!HG) lg = -__expf(p.ret_decay[dir * 4 + h]);
    float lb0 = 0.f, lb1 = 0.f; if (HG) { lb0 = lbv[h * 128 + 2 * (tid & 63)]; lb1 = lbv[h * 128 + 2 * (tid & 63) + 1]; }
    f32x4 sacc[KT][4];
#pragma unroll
    for (int a = 0; a < KT; ++a)
#pragma unroll
      for (int v = 0; v < 4; ++v) sacc[a][v] = (f32x4){0.f, 0.f, 0.f, 0.f};
    u32x4 rq[4], rk[4], rvv; unsigned rf[8], rqq[8]; float bl[16], qv[16], kv[16];
    const int vtl = tid & 63, vvc = tid >> 6;
    auto issue = [&](int i) {
      if (HG) { const int kp = tid & 63, seg = tid >> 6;
#pragma unroll
        for (int j = 0; j < 8; ++j) { const size_t row = tokbase + scan_pos(dir, i, seg * 8 + j); rf[j] = *(const unsigned*)(ksrc + row * ldq + 2 * kp); rqq[j] = *(const unsigned*)(qsrc + row * ldq + 2 * kp); } }
      else {
#pragma unroll
        for (int it = 0; it < 4; ++it) { const int e = tid + NTHR * it, tl = e >> 5, kc = e & 31; const size_t row = tokbase + scan_pos(dir, i, tl); rq[it] = *(const u32x4*)(qsrc + row * ldq + kc * 8); rk[it] = *(const u32x4*)(ksrc + row * ldq + kc * 8); } }
      { const size_t row = tokbase + scan_pos(dir, i, vtl); rvv = *(const u32x4*)(vsrc + row * ldv + vvc * 8); }
    };
    auto prep = [&]() {
      const int kp = tid & 63, seg = tid >> 6; float run0 = 1.f, run1 = 1.f;
#pragma unroll
      for (int j = 0; j < 8; ++j) { const float f0 = bflo(rf[j]), f1 = bfhi(rf[j]); qv[2 * j] = bflo(rqq[j]); qv[2 * j + 1] = bfhi(rqq[j]);
        const float s0 = __builtin_amdgcn_rcpf(1.f + __expf(-f0)), s1 = __builtin_amdgcn_rcpf(1.f + __expf(-f1)); const float g0 = lb0 + (1.f - lb0) * s0, g1 = lb1 + (1.f - lb1) * s1;
        kv[2 * j] = 1.f - g0; kv[2 * j + 1] = 1.f - g1; run0 *= g0; run1 *= g1; bl[2 * j] = run0; bl[2 * j + 1] = run1; }
      qs[seg * DK + 2 * kp] = run0; qs[seg * DK + 2 * kp + 1] = run1;
    };
    __syncthreads();
    issue(0); if (HG) prep();
    __syncthreads();
    for (int i = 0; i < 132; ++i) {
      if (HG) { const int kp = tid & 63, seg = tid >> 6; float off0 = 1.f, off1 = 1.f;
#pragma unroll
        for (int q = 0; q < 7; ++q) if (q < seg) { off0 *= qs[q * DK + 2 * kp]; off1 *= qs[q * DK + 2 * kp + 1]; }
        if (seg == 7) { eb[2 * kp] = off0 * bl[14]; eb[2 * kp + 1] = off1 * bl[15]; }
#pragma unroll
        for (int j = 0; j < 8; ++j) { const int tl = seg * 8 + j; const float p0 = bl[2 * j] * off0, p1 = bl[2 * j + 1] * off1;
          *(unsigned*)(Qd + tl * QLD + 2 * kp) = pk2(qv[2 * j] * p0, qv[2 * j + 1] * p1);
          *(unsigned*)(Kd + tl * QLD + 2 * kp) = pk2(kv[2 * j] * __builtin_amdgcn_rcpf(p0), kv[2 * j + 1] * __builtin_amdgcn_rcpf(p1)); } }
      else {
        if (tid < DK) eb[tid] = __expf(64.f * lg);
#pragma unroll
        for (int it = 0; it < 4; ++it) { const int e = tid + NTHR * it, tl = e >> 5, kc = e & 31; const u32x4 qr = rq[it], kr = rk[it];
          const float eq = __expf((float)(tl + 1) * lg), ek = __expf(-(float)(tl + 1) * lg);
          u32x4 qo, ko; qo.x = pk2(bflo(qr.x) * eq, bfhi(qr.x) * eq); qo.y = pk2(bflo(qr.y) * eq, bfhi(qr.y) * eq); qo.z = pk2(bflo(qr.z) * eq, bfhi(qr.z) * eq); qo.w = pk2(bflo(qr.w) * eq, bfhi(qr.w) * eq);
          ko.x = pk2(bflo(kr.x) * ek, bfhi(kr.x) * ek); ko.y = pk2(bflo(kr.y) * ek, bfhi(kr.y) * ek); ko.z = pk2(bflo(kr.z) * ek, bfhi(kr.z) * ek); ko.w = pk2(bflo(kr.w) * ek, bfhi(kr.w) * ek);
          *(u32x4*)(Qd + tl * QLD + kc * 8) = qo; *(u32x4*)(Kd + tl * QLD + kc * 8) = ko; } }
      { bf16_t* vt = Vt + (vvc * 8) * TLD + vtl; const u32x4 vr = rvv;
        vt[0] = (bf16_t)(vr.x & 0xffff); vt[TLD] = (bf16_t)(vr.x >> 16); vt[2 * TLD] = (bf16_t)(vr.y & 0xffff); vt[3 * TLD] = (bf16_t)(vr.y >> 16);
        vt[4 * TLD] = (bf16_t)(vr.z & 0xffff); vt[5 * TLD] = (bf16_t)(vr.z >> 16); vt[6 * TLD] = (bf16_t)(vr.w & 0xffff); vt[7 * TLD] = (bf16_t)(vr.w >> 16); }
#pragma unroll
      for (int a = 0; a < KT; ++a) { const int ki = w * KT + a;
#pragma unroll
        for (int vi = 0; vi < 4; ++vi) st4bf(St + (16 * vi + l16) * QLD + 16 * ki + 4 * g4, sacc[a][vi]); }
      __syncthreads();
      if (i + 1 < 132) issue(i + 1);
#pragma unroll
      for (int u = 0; u < 2; ++u) { const int id = 2 * w + u, ti = id >> 2, si = id & 3; f32x4 d = (f32x4){0.f, 0.f, 0.f, 0.f};
        if (si <= ti) {
#pragma unroll
          for (int ks = 0; ks < DK / 32; ++ks) { const bf16x8 kf = *(const bf16x8*)(Kd + (16 * si + l16) * QLD + ks * 32 + g4 * 8), qf = *(const bf16x8*)(Qd + (16 * ti + l16) * QLD + ks * 32 + g4 * 8); d = mfma16(kf, qf, d); } }
        const int t = 16 * ti + l16, s0 = 16 * si + 4 * g4;
#pragma unroll
        for (int rr = 0; rr < 4; ++rr) if (s0 + rr > t) d[rr] = 0.f;
        st4bf(Att + t * TLD + s0, d); }
      __syncthreads();
#pragma unroll
      for (int u = 0; u < 2; ++u) { const int id = 2 * w + u, vi = id >> 2, ti = id & 3; f32x4 d = (f32x4){0.f, 0.f, 0.f, 0.f};
#pragma unroll
        for (int ks = 0; ks < 2; ++ks) { const bf16x8 xf = *(const bf16x8*)(Vt + (16 * vi + l16) * TLD + ks * 32 + g4 * 8), yf = *(const bf16x8*)(Att + (16 * ti + l16) * TLD + ks * 32 + g4 * 8); d = mfma16(xf, yf, d); }
#pragma unroll
        for (int ks = 0; ks < DK / 32; ++ks) { const bf16x8 xf = *(const bf16x8*)(St + (16 * vi + l16) * QLD + ks * 32 + g4 * 8), yf = *(const bf16x8*)(Qd + (16 * ti + l16) * QLD + ks * 32 + g4 * 8); d = mfma16(xf, yf, d); }
        const int pos = scan_pos(dir, i, 16 * ti + l16); bf16_t* op = (pos < LC ? octx + (size_t)pos * ldo : olat + (size_t)(pos - LC) * ldo) + 16 * vi + 4 * g4;
        st4bf(op, d); }
#pragma unroll
      for (int a = 0; a < KT; ++a) { const int ki = w * KT + a;
#pragma unroll
        for (int ks = 0; ks < 2; ++ks) { const bf16x8 xf = gather8(Kd + (ks * 32 + g4 * 8) * QLD + 16 * ki + l16, QLD);
#pragma unroll
          for (int vi = 0; vi < 4; ++vi) { const bf16x8 yf = *(const bf16x8*)(Vt + (16 * vi + l16) * TLD + ks * 32 + g4 * 8); sacc[a][vi] = mfma16(xf, yf, sacc[a][vi]); } }
        const f32x4 e4 = *(const f32x4*)(eb + 16 * ki + 4 * g4);
#pragma unroll
        for (int vi = 0; vi < 4; ++vi) sacc[a][vi] = sacc[a][vi] * e4; }
      if (HG && i + 1 < 132) prep();
      __syncthreads();
    }
  }
}

DI float bsum2(unsigned a, unsigned b, float& lo, float& hi) { lo = bflo(a) + bflo(b); hi = bfhi(a) + bfhi(b); return lo * lo + hi * hi; }
DI void ret_readout_phase(const Params& p) {
  bf16_t* O = (bf16_t*)(p.ws + R_O); const bf16_t* G = (const bf16_t*)(p.ws + R_QK);
  const int tid = threadIdx.x, lane = tid & 63, gw = blockIdx.x * 8 + (tid >> 6), nw = gridDim.x * 8;
  for (int t = gw; t < T_ALL; t += nw) {
    const int b = t / PB, pp = t - b * PB;
    const bf16_t* ob = (pp < LC ? (const bf16_t*)(p.ws + OFF_HCTX) + (size_t)(b * LC + pp) * 2048 : (const bf16_t*)p.out + (size_t)(b * LL + pp - LC) * 2048) + lane * 32;
    bf16_t* op = O + (size_t)t * 2048 + lane * 32; const bf16_t* gp = G + (size_t)t * 2048 + lane * 32;
    float ov[32]; u32x4 gv[4]; float sq = 0.f;
#pragma unroll
    for (int i = 0; i < 4; ++i) { const u32x4 x = *(const u32x4*)(op + i * 8), y = *(const u32x4*)(ob + i * 8); gv[i] = *(const u32x4*)(gp + i * 8);
      sq += bsum2(x.x, y.x, ov[8 * i], ov[8 * i + 1]) + bsum2(x.y, y.y, ov[8 * i + 2], ov[8 * i + 3]) + bsum2(x.z, y.z, ov[8 * i + 4], ov[8 * i + 5]) + bsum2(x.w, y.w, ov[8 * i + 6], ov[8 * i + 7]); }
    sq += __shfl_xor(sq, 1); sq += __shfl_xor(sq, 2); sq += __shfl_xor(sq, 4); sq += __shfl_xor(sq, 8);
    const float rstd = rsqrtf(sq * (1.f / 512.f) + 1e-6f);
#pragma unroll
    for (int i = 0; i < 4; ++i) { u32x4 r;
      r.x = pk2(siluf(bflo(gv[i].x)) * ov[8 * i] * rstd, siluf(bfhi(gv[i].x)) * ov[8 * i + 1] * rstd); r.y = pk2(siluf(bflo(gv[i].y)) * ov[8 * i + 2] * rstd, siluf(bfhi(gv[i].y)) * ov[8 * i + 3] * rstd);
      r.z = pk2(siluf(bflo(gv[i].z)) * ov[8 * i + 4] * rstd, siluf(bfhi(gv[i].z)) * ov[8 * i + 5] * rstd); r.w = pk2(siluf(bflo(gv[i].w)) * ov[8 * i + 6] * rstd, siluf(bfhi(gv[i].w)) * ov[8 * i + 7] * rstd);
      *(u32x4*)(op + i * 8) = r; }
  }
}
DI void hg_readout_phase(const Params& p) {
  bf16_t* O = (bf16_t*)(p.ws + OFF_A); const bf16_t* OB = (const bf16_t*)(p.ws + OFF_W0); const bf16_t* ph = (const bf16_t*)(p.ws + H_P);
  const int tid = threadIdx.x, lane = tid & 63, gw = blockIdx.x * 8 + (tid >> 6), nw = gridDim.x * 8;
  for (int t = gw; t < T_ALL; t += nw) {
    bf16_t* op = O + (size_t)t * 1024 + lane * 16; const bf16_t* ob = OB + (size_t)t * 1024 + lane * 16; const bf16_t* gp = ph + (size_t)t * 5120 + 4096 + lane * 16; const float* ng = p.hg_norm_g + (lane & 7) * 16;
    float ov[16]; u32x4 gv[2]; float sq = 0.f;
#pragma unroll
    for (int i = 0; i < 2; ++i) { const u32x4 x = *(const u32x4*)(op + i * 8), y = *(const u32x4*)(ob + i * 8); gv[i] = *(const u32x4*)(gp + i * 8);
      sq += bsum2(x.x, y.x, ov[8 * i], ov[8 * i + 1]) + bsum2(x.y, y.y, ov[8 * i + 2], ov[8 * i + 3]) + bsum2(x.z, y.z, ov[8 * i + 4], ov[8 * i + 5]) + bsum2(x.w, y.w, ov[8 * i + 6], ov[8 * i + 7]); }
    sq += __shfl_xor(sq, 1); sq += __shfl_xor(sq, 2); sq += __shfl_xor(sq, 4);
    const float rstd = rsqrtf(sq * (1.f / 128.f) + 1e-6f);
#pragma unroll
    for (int i = 0; i < 2; ++i) { u32x4 r; const float* n8 = ng + i * 8;
      r.x = pk2(siluf(bflo(gv[i].x)) * ov[8 * i] * rstd * n8[0], siluf(bfhi(gv[i].x)) * ov[8 * i + 1] * rstd * n8[1]); r.y = pk2(siluf(bflo(gv[i].y)) * ov[8 * i + 2] * rstd * n8[2], siluf(bfhi(gv[i].y)) * ov[8 * i + 3] * rstd * n8[3]);
      r.z = pk2(siluf(bflo(gv[i].z)) * ov[8 * i + 4] * rstd * n8[4], siluf(bfhi(gv[i].z)) * ov[8 * i + 5] * rstd * n8[5]); r.w = pk2(siluf(bflo(gv[i].w)) * ov[8 * i + 6] * rstd * n8[6], siluf(bfhi(gv[i].w)) * ov[8 * i + 7] * rstd * n8[7]);
      *(u32x4*)(op + i * 8) = r; }
  }
}

#define XB_TMO      128
#define XB_XCNT(j)  (256  + 64 * (j))
#define XB_XSUB(j)  (1280 + 64 * (j))
#define XB_XGEN(j)  (2304 + 64 * (j))
#define XB_TOP      3328
#define XB_TOPGEN   3392
#define XCD_BAR_WORDS 3456
#define XB_SPIN_CAP (1u << 23)
#define LAS PG8_LAS

__device__ __forceinline__ unsigned xb_ld(unsigned* p)              { return __hip_atomic_load(p, __ATOMIC_RELAXED, __HIP_MEMORY_SCOPE_AGENT); }
__device__ __forceinline__ unsigned xb_add(unsigned* p, unsigned v) { return __hip_atomic_fetch_add(p, v, __ATOMIC_RELAXED, __HIP_MEMORY_SCOPE_AGENT); }
__device__ __forceinline__ unsigned xb_xcc_id() { return (unsigned)__builtin_amdgcn_s_getreg((3 << 11) | 20) & 0xFu; }
#define XB_SPIN(cond, bar) do { unsigned _sp = 0; while (cond) { __builtin_amdgcn_s_sleep(1); \
    if ((++_sp & 255u) == 0u) { if (xb_ld(&(bar)[XB_TMO])) break; if (_sp > XB_SPIN_CAP) { atomicAdd(&(bar)[XB_TMO], 1u); break; } } } } while (0)

struct XcdBarrier {
    unsigned* bar; unsigned x;
    volatile LAS unsigned* st;
};

__device__ __forceinline__ XcdBarrier xcd_barrier_post(unsigned* bar, volatile LAS unsigned* st) {
    XcdBarrier b; b.bar = bar; b.x = xb_xcc_id(); b.st = st;
    if (threadIdx.x == 0) (void)xb_add(&bar[XB_XCNT(b.x)], 1u);
    return b;
}
__device__ __forceinline__ void xcd_barrier_complete(unsigned* bar, unsigned x, unsigned& nloc, unsigned& nx) {
    const unsigned G = gridDim.x * gridDim.y * gridDim.z;
    unsigned sum, cnt, mine, sp = 0u;
    for (;;) {
        sum = 0u; cnt = 0u; mine = 0u;
#pragma unroll
        for (unsigned j = 0; j < 16; ++j) { const unsigned c = xb_ld(&bar[XB_XCNT(j)]); sum += c; cnt += (c > 0u) ? 1u : 0u; mine = (j == x) ? c : mine; }
        if (sum == G) break;
        __builtin_amdgcn_s_sleep(1);
        if ((++sp & 255u) == 0u) { if (xb_ld(&bar[XB_TMO])) break; if (sp > XB_SPIN_CAP) { atomicAdd(&bar[XB_TMO], 1u); break; } }
    }
    nloc = mine > 0u ? mine : 1u; nx = cnt > 0u ? cnt : 1u;
}

__device__ __forceinline__ void xcd_barrier(const XcdBarrier& b) {
    asm volatile("s_waitcnt vmcnt(0)" ::: "memory");
    __syncthreads();
    if (threadIdx.x == 0) {
        unsigned* bar = b.bar;
        __builtin_amdgcn_s_waitcnt(0);
        unsigned nloc = b.st[0], nx = b.st[1];
        if (nloc == 0u) { xcd_barrier_complete(bar, b.x, nloc, nx); b.st[0] = nloc; b.st[1] = nx; }
        const unsigned old = xb_add(&bar[XB_XSUB(b.x)], 1u);
        const unsigned gen = old / nloc;
        if (old + 1u == (gen + 1u) * nloc) {
            __builtin_amdgcn_fence(__ATOMIC_RELEASE, "agent");
            asm volatile("s_waitcnt vmcnt(0)" ::: "memory");
            const unsigned og = xb_add(&bar[XB_TOP], 1u);
            const unsigned tg = og / nx;
            if (og + 1u == (tg + 1u) * nx) xb_add(&bar[XB_TOPGEN], 1u);
            else XB_SPIN(xb_ld(&bar[XB_TOPGEN]) == tg, bar);
            __builtin_amdgcn_fence(__ATOMIC_ACQUIRE, "agent");
            xb_add(&bar[XB_XGEN(b.x)], 1u);
            asm volatile("s_waitcnt vmcnt(0)" ::: "memory");
        } else {
            XB_SPIN(xb_ld(&bar[XB_XGEN(b.x)]) == gen, bar);
            __builtin_amdgcn_fence(__ATOMIC_ACQUIRE, "agent");
            asm volatile("s_waitcnt vmcnt(0)" ::: "memory");
        }
    }
    __syncthreads();
}

constexpr int LDS_BYTES = ScanLds<256>::TOTAL > pg8::STAGE_BYTES ? ScanLds<256>::TOTAL : pg8::STAGE_BYTES;
static_assert(LDS_BYTES <= 163840, "LDS");
static_assert(LDS_BYTES >= (256 + 128) * LDT * 2 && LDS_BYTES >= 3 * 64 * (KLD + VLD) * 2 && LDS_BYTES >= (5120 + 8 * 5 * 64) * 4, "LDS phases");

DI void ffn_and_ln(const Params& p, const XcdBarrier& xb, char* lds, int layer, const bf16_t* w13, const bf16_t* w2) {
  const float* mods = (const float*)(p.ws + OFF_MODS); float* hctx = (float*)(p.ws + OFF_HCTX); bf16_t* a = (bf16_t*)(p.ws + OFF_A); bf16_t* U = (bf16_t*)(p.ws + F_U);
  { EpiSwiglu e{U}; big_gemm(a, w13, T_ALL, 5632, 1024, e, lds); }
  xcd_barrier(xb);
  { EpiResid e{p.out, hctx, p.out, hctx, mods + (size_t)layer * 5 * 6144 + 5 * 1024, (const float2*)(p.ws + OFF_LNS), p.ln_g + (size_t)(layer * 2) * 1024, p.ln_b + (size_t)(layer * 2) * 1024}; big_gemm(U, w2, T_ALL, 1024, FF, e, lds); }
  xcd_barrier(xb);
  ln_phase(p, layer, 1, layer < 3 ? layer + 1 : 3, 0, layer == 3);
  xcd_barrier(xb);
}

__global__ void __launch_bounds__(NTHR) mega(Params p) {
  __shared__ __attribute__((aligned(16))) char lds[LDS_BYTES];
  cg::grid_group grid = cg::this_grid();
  __shared__ uint4 xb_words;
  if (threadIdx.x == 0) xb_words = make_uint4(0u, 0u, 0u, 0u);
  __syncthreads();
  const XcdBarrier xb = xcd_barrier_post((unsigned*)(p.ws + OFF_BAR), (volatile LAS unsigned*)&xb_words);
  float* ldsf = (float*)lds;
  const float* mods = (const float*)(p.ws + OFF_MODS); float* hctx = (float*)(p.ws + OFF_HCTX); bf16_t* a = (bf16_t*)(p.ws + OFF_A);
  const float2* tabR = (const float2*)(p.ws + OFF_TABR); const float2* tabM = (const float2*)(p.ws + OFF_TABM); float* rs = (float*)(p.ws + OFF_RS);
  ada_phase(p, ldsf);
  tables_phase(p);
  convert_w<2>(p.ret_w_in, 6144, 1024, (bf16_t*)(p.ws + W0_RETIN), 6144, nullptr, ldsf);
  convert_w<0>(p.ret_w_out, 1024, 2048, (bf16_t*)(p.ws + W0_RETOUT), 1024, nullptr, ldsf);
  convert_w<1>(p.w13, 5632, 1024, (bf16_t*)(p.ws + W0_W13), 5632, nullptr, ldsf);
  convert_w<0>(p.w2, 1024, FF, (bf16_t*)(p.ws + W0_W2), 1024, nullptr, ldsf);
  grid.sync();
  modulate_phase(p, p.x, p.ctx, 0);
  xcd_barrier(xb);
  { const bf16_t* wi = (const bf16_t*)(p.ws + W0_RETIN);
    { EpiRetQK e{(bf16_t*)(p.ws + R_QK), tabR}; big_gemm(a, wi, T_ALL, 2048, 1024, e, lds); }
    { EpiStore e{(bf16_t*)(p.ws + R_V), (bf16_t*)(p.ws + R_V), 1 << 30, 2048, 2048, 1.f}; big_gemm(a, wi + (size_t)2048 * 1024, T_ALL, 2048, 1024, e, lds); }
    xcd_barrier(xb);
    scan_phase<256, false>(p, lds);
    xcd_barrier(xb);
    { EpiStore e{(bf16_t*)(p.ws + R_QK), (bf16_t*)(p.ws + R_QK), 1 << 30, 2048, 2048, 1.f}; big_gemm(a, wi + (size_t)4096 * 1024, T_ALL, 2048, 1024, e, lds); }
    xcd_barrier(xb);
    ret_readout_phase(p);
    xcd_barrier(xb);
    { EpiResid e{p.x, p.ctx, p.out, hctx, mods + 2 * 1024, nullptr, nullptr, nullptr}; big_gemm((const bf16_t*)(p.ws + R_O), (const bf16_t*)(p.ws + W0_RETOUT), T_ALL, 1024, 2048, e, lds); }
    xcd_barrier(xb);
    ln_phase(p, 0, 0, 0, 3, false);
    convert_w<0>(p.na_w_qkv, 3072, 1024, (bf16_t*)(p.ws + W1_QKV), 3072, nullptr, ldsf);
    convert_w<0>(p.na_w_out, 1024, 1024, (bf16_t*)(p.ws + W1_OUT), 1024, nullptr, ldsf);
    convert_w<1>(p.w13 + (size_t)1 * 1024 * 5632, 5632, 1024, (bf16_t*)(p.ws + W1_W13), 5632, nullptr, ldsf);
    convert_w<0>(p.w2 + (size_t)1 * FF * 1024, 1024, FF, (bf16_t*)(p.ws + W1_W2), 1024, nullptr, ldsf);
    convert_w<5>(p.mla_w_down, 800, 1024, (bf16_t*)(p.ws + W2_DOWN), 1024, nullptr, ldsf);
    convert_w<3>(p.mla_w_uq, 1536, 512, (bf16_t*)(p.ws + W2_UQ), 1536, p.mla_q_norm, ldsf);
    convert_w<4>(p.mla_w_ukv, 2048, 256, (bf16_t*)(p.ws + W2_UKV), 2048, p.mla_kv_norm, ldsf);
    convert_w<0>(p.mla_w_out, 1024, 1024, (bf16_t*)(p.ws + W2_OUT), 1024, nullptr, ldsf);
    convert_w<1>(p.w13 + (size_t)2 * 1024 * 5632, 5632, 1024, (bf16_t*)(p.ws + W2_W13), 5632, nullptr, ldsf);
    convert_w<0>(p.w2 + (size_t)2 * FF * 1024, 1024, FF, (bf16_t*)(p.ws + W2_W2), 1024, nullptr, ldsf);
    convert_w<0>(p.hg_w_in, 5120, 1024, (bf16_t*)(p.ws + W3_IN), 5120, nullptr, ldsf);
    convert_w<0>(p.hg_w_out, 1024, 1024, (bf16_t*)(p.ws + W3_OUT), 1024, nullptr, ldsf);
    convert_w<1>(p.w13 + (size_t)3 * 1024 * 5632, 5632, 1024, (bf16_t*)(p.ws + W3_W13), 5632, nullptr, ldsf);
    convert_w<0>(p.w2 + (size_t)3 * FF * 1024, 1024, FF, (bf16_t*)(p.ws + W3_W2), 1024, nullptr, ldsf);
    xcd_barrier(xb);
    ffn_and_ln(p, xb, lds, 0, (const bf16_t*)(p.ws + W0_W13), (const bf16_t*)(p.ws + W0_W2));
  }
  { const bf16_t* wq = (const bf16_t*)(p.ws + W1_QKV);
    { EpiStore e{(bf16_t*)(p.ws + N_Q), (bf16_t*)(p.ws + N_K), 1024, 1024, 1024, 0.125f}; big_gemm(a, wq, T_ALL, 2048, 1024, e, lds); }
    { GemmArgs g{a, 1024, wq + (size_t)2048 * 1024, 1024, T_ALL, 1024, 1024}; EpiVT e{(bf16_t*)(p.ws + N_VT), nullptr}; gemm_phase<true>(g, e, lds); }
    xcd_barrier(xb);
    na_attn_phase(p, lds);
    xcd_barrier(xb);
    { EpiResid e{p.out, hctx, p.out, hctx, mods + (size_t)1 * 5 * 6144 + 2 * 1024, (const float2*)(p.ws + OFF_LNS), p.ln_g + (size_t)(0 * 2 + 1) * 1024, p.ln_b + (size_t)(0 * 2 + 1) * 1024}; big_gemm(a, (const bf16_t*)(p.ws + W1_OUT), T_ALL, 1024, 1024, e, lds); }
    xcd_barrier(xb);
    ln_phase(p, 1, 0, 1, 3, false);
    xcd_barrier(xb);
    ffn_and_ln(p, xb, lds, 1, (const bf16_t*)(p.ws + W1_W13), (const bf16_t*)(p.ws + W1_W2));
  }
  { const bf16_t* d0 = (const bf16_t*)(p.ws + M_D0);
    { EpiStore e{(bf16_t*)(p.ws + M_D0), (bf16_t*)(p.ws + M_D0), 1 << 30, 1024, 1024, 1.f}; big_gemm(a, (const bf16_t*)(p.ws + W2_DOWN), T_ALL, 1024, 1024, e, lds); }
    xcd_barrier(xb);
    mla_stats_phase(p);
    xcd_barrier(xb);
    { GemmArgs g{d0, 1024, (const bf16_t*)(p.ws + W2_UQ), 512, T_ALL, 1536, 512}; EpiMlaQ e{(bf16_t*)(p.ws + M_Q), rs, tabM}; gemm_phase<false>(g, e, lds); }
    { GemmArgs g{d0 + 512, 1024, (const bf16_t*)(p.ws + W2_UKV), 256, T_ALL, 1024, 256}; EpiMlaK e{(bf16_t*)(p.ws + M_K), rs}; gemm_phase<false>(g, e, lds); }
    { GemmArgs g{d0 + 512, 1024, (const bf16_t*)(p.ws + W2_UKV) + (size_t)1024 * 256, 256, T_ALL, 1024, 256}; EpiVT e{(bf16_t*)(p.ws + M_VT), rs}; gemm_phase<true>(g, e, lds); }
    xcd_barrier(xb);
    mla_attn_phase(p, lds);
    xcd_barrier(xb);
    { EpiResid e{p.out, hctx, p.out, hctx, mods + (size_t)2 * 5 * 6144 + 2 * 1024, (const float2*)(p.ws + OFF_LNS), p.ln_g + (size_t)(1 * 2 + 1) * 1024, p.ln_b + (size_t)(1 * 2 + 1) * 1024}; big_gemm(a, (const bf16_t*)(p.ws + W2_OUT), T_ALL, 1024, 1024, e, lds); }
    xcd_barrier(xb);
    ln_phase(p, 2, 0, 2, 3, false);
    xcd_barrier(xb);
    ffn_and_ln(p, xb, lds, 2, (const bf16_t*)(p.ws + W2_W13), (const bf16_t*)(p.ws + W2_W2));
  }
  { { EpiHg e{(bf16_t*)(p.ws + H_P)}; big_gemm(a, (const bf16_t*)(p.ws + W3_IN), T_ALL, 5120, 1024, e, lds); }
    xcd_barrier(xb);
    scan_phase<128, true>(p, lds);
    xcd_barrier(xb);
    hg_readout_phase(p);
    xcd_barrier(xb);
    { EpiResid e{p.out, hctx, p.out, hctx, mods + (size_t)3 * 5 * 6144 + 2 * 1024, (const float2*)(p.ws + OFF_LNS), p.ln_g + (size_t)(2 * 2 + 1) * 1024, p.ln_b + (size_t)(2 * 2 + 1) * 1024}; big_gemm(a, (const bf16_t*)(p.ws + W3_OUT), T_ALL, 1024, 1024, e, lds); }
    xcd_barrier(xb);
    ln_phase(p, 3, 0, 3, 3, false);
    xcd_barrier(xb);
    ffn_and_ln(p, xb, lds, 3, (const bf16_t*)(p.ws + W3_W13), (const bf16_t*)(p.ws + W3_W2));
  }
}

extern "C" void kernel_launch(void* const* d_in, const int* in_sizes, int n_in, void* d_out, int out_size, void* d_ws, size_t ws_size, hipStream_t stream) {
  static int grid_blocks = 0;
  if (!grid_blocks) {
    int dev = 0, cus = 0, per_cu = 0;
    (void)hipGetDevice(&dev);
    (void)hipDeviceGetAttribute(&cus, hipDeviceAttributeMultiprocessorCount, dev);
    (void)hipOccupancyMaxActiveBlocksPerMultiprocessor(&per_cu, mega, NTHR, 0);
    if (per_cu != 1) per_cu = 1;
    grid_blocks = cus * per_cu;
  }
  if (ws_size < WS_NEED) { fprintf(stderr, "workspace too small: %zu\n", ws_size); return; }
  Params p{};
  const float** f = (const float**)&p;
  for (int i = 0; i < 26; ++i) f[i] = (const float*)d_in[i];
  p.out = (float*)d_out; p.ws = (char*)d_ws;
  (void)hipMemsetAsync((char*)d_ws + OFF_BAR, 0, XCD_BAR_WORDS * 4, stream);
  void* args[] = {&p};
  hipError_t e = hipLaunchCooperativeKernel((void*)mega, dim3(grid_blocks), dim3(NTHR), args, 0, stream);
  if (e != hipSuccess) fprintf(stderr, "cooperative launch failed: %s (grid %d)\n", hipGetErrorString(e), grid_blocks);
}
```

```cpp
#include <hip/hip_runtime.h>
#include <hip/hip_cooperative_groups.h>
#include <cstdio>
#include <cstdint>
namespace cg = cooperative_groups;

#define DI __device__ __forceinline__
DI int tid_() { int t = threadIdx.x; asm volatile("" : "+v"(t)); return t; }
typedef unsigned short bf16_t;
typedef short bf16x8 __attribute__((ext_vector_type(8)));
typedef short s16x4 __attribute__((ext_vector_type(4)));
typedef float f32x4 __attribute__((ext_vector_type(4)));
typedef float f32x16 __attribute__((ext_vector_type(16)));
typedef unsigned u32x4 __attribute__((ext_vector_type(4)));
typedef unsigned u32x2 __attribute__((ext_vector_type(2)));

constexpr int NTHR = 512;
constexpr int T_ALL = 33792, PB = 8448, LC = 256, LL = 8192, DM = 1024, FF = 2816;
constexpr float ALPHA = 1.681792830507429f;
constexpr float LOG2E = 1.4426950408889634f;
constexpr size_t MiB = 1048576;

struct Params {
  const float *x, *c, *ctx, *cctx, *ada_w, *ada_b, *ln_g, *ln_b, *w13, *w2;
  const float *ret_w_in, *ret_decay, *ret_w_out, *na_w_qkv, *na_rpb, *na_w_out;
  const float *mla_w_down, *mla_q_norm, *mla_kv_norm, *mla_w_uq, *mla_w_ukv, *mla_w_out;
  const float *hg_w_in, *hg_lb, *hg_norm_g, *hg_w_out;
  float* out; char* ws;
};

constexpr size_t OFF_MODS = 0;
constexpr size_t OFF_TABR = 512 * 1024;
constexpr size_t OFF_TABM = OFF_TABR + 65536;
constexpr size_t OFF_LBV = OFF_TABM + 8192;
constexpr size_t OFF_RS = OFF_LBV + 4096;
constexpr size_t OFF_BAR = 896 * 1024;
constexpr size_t OFF_HCTX = 1 * MiB;
constexpr size_t OFF_A = 5 * MiB;
constexpr size_t OFF_W0 = 71 * MiB;
constexpr size_t OFF_BIG = 104 * MiB;
constexpr size_t OFF_WR = OFF_BIG;
constexpr size_t OFF_S = 180 * MiB;
constexpr size_t WS_NEED = 512 * MiB;
constexpr size_t OFF_LNS = 510 * MiB;
constexpr size_t W0_RETIN = OFF_W0, W0_RETOUT = W0_RETIN + (size_t)6144 * 1024 * 2, W0_W13 = W0_RETOUT + (size_t)1024 * 2048 * 2, W0_W2 = W0_W13 + (size_t)5632 * 1024 * 2;
constexpr size_t SZ_W13 = (size_t)5632 * 1024 * 2, SZ_W2 = (size_t)1024 * 2816 * 2, SZ_SQ = (size_t)1024 * 1024 * 2;
constexpr size_t W1_QKV = OFF_WR, W1_OUT = W1_QKV + (size_t)3072 * 1024 * 2, W1_W13 = W1_OUT + SZ_SQ, W1_W2 = W1_W13 + SZ_W13;
constexpr size_t W2_DOWN = W1_W2 + SZ_W2, W2_UQ = W2_DOWN + (size_t)1024 * 1024 * 2, W2_UKV = W2_UQ + (size_t)1536 * 512 * 2, W2_OUT = W2_UKV + (size_t)2048 * 256 * 2, W2_W13 = W2_OUT + SZ_SQ, W2_W2 = W2_W13 + SZ_W13;
constexpr size_t W3_IN = W2_W2 + SZ_W2, W3_OUT = W3_IN + (size_t)5120 * 1024 * 2, W3_W13 = W3_OUT + SZ_SQ, W3_W2 = W3_W13 + SZ_W13, W3_END = W3_W2 + SZ_W2;
static_assert(W3_END <= OFF_S, "rest weights overflow");
static_assert(W0_W2 + SZ_W2 <= OFF_BIG, "W0 overflow");
constexpr size_t SZ_T2048 = (size_t)T_ALL * 2048 * 2, SZ_T1024 = (size_t)T_ALL * 1024 * 2;
constexpr size_t R_QK = OFF_BIG, R_V = R_QK + SZ_T2048, R_O = R_V + SZ_T2048;
static_assert(R_O + SZ_T2048 <= WS_NEED, "retention overflow");
constexpr size_t N_Q = OFF_S, N_K = N_Q + SZ_T1024, N_VT = N_K + SZ_T1024;
constexpr size_t M_D0 = OFF_S, M_Q = M_D0 + (size_t)T_ALL * 1024 * 2, M_K = M_Q + (size_t)T_ALL * 1536 * 2, M_VT = M_K + (size_t)T_ALL * 1536 * 2;
static_assert(M_VT + SZ_T1024 <= WS_NEED, "mla overflow");
constexpr size_t H_P = OFF_S;
static_assert(H_P + (size_t)T_ALL * 5120 * 2 <= WS_NEED, "hgrn overflow");
constexpr size_t F_U = OFF_S;

typedef float f32x2 __attribute__((ext_vector_type(2)));
typedef __bf16 bf16x2_t __attribute__((ext_vector_type(2)));
DI unsigned pk2(float lo, float hi) { const f32x2 v = {lo, hi}; const bf16x2_t r = __builtin_convertvector(v, bf16x2_t); return __builtin_bit_cast(unsigned, r); }
DI float bflo(unsigned u) { return __uint_as_float(u << 16); }
DI float bfhi(unsigned u) { return __uint_as_float(u & 0xffff0000u); }
DI float bf2f(bf16_t v) { return __uint_as_float(((unsigned)v) << 16); }
DI bf16_t f2bf(float x) { return (bf16_t)(pk2(x, 0.f) & 0xffffu); }
DI float siluf(float x) { return x / (1.f + __expf(-x)); }
DI f32x4 mfma16(bf16x8 a, bf16x8 b, f32x4 c) { return __builtin_amdgcn_mfma_f32_16x16x32_bf16(a, b, c, 0, 0, 0); }
DI f32x16 mfma32(bf16x8 a, bf16x8 b, f32x16 c) { return __builtin_amdgcn_mfma_f32_32x32x16_bf16(a, b, c, 0, 0, 0); }
DI bf16x8 cat44(s16x4 lo, s16x4 hi) { return __builtin_shufflevector(lo, hi, 0, 1, 2, 3, 4, 5, 6, 7); }
DI bf16x8 pack8(float a0, float a1, float a2, float a3, float a4, float a5, float a6, float a7) {
  u32x4 p; p.x = pk2(a0, a1); p.y = pk2(a2, a3); p.z = pk2(a4, a5); p.w = pk2(a6, a7); return __builtin_bit_cast(bf16x8, p);
}
DI int clampi(int v, int lo, int hi) { return v < lo ? lo : (v > hi ? hi : v); }
DI float* hrow(float* hlat, float* hctx, int t) { const int b = t / PB, p = t - b * PB; return p < LC ? hctx + (size_t)(b * LC + p) * DM : hlat + (size_t)(b * LL + p - LC) * DM; }
DI const float* hrowc(const float* hlat, const float* hctx, int t) { const int b = t / PB, p = t - b * PB; return p < LC ? hctx + (size_t)(b * LC + p) * DM : hlat + (size_t)(b * LL + p - LC) * DM; }
DI int modvec(int t) { const int b = t / PB, p = t - b * PB; return p < LC ? 4 : b; }

template <int MODE> DI int srccol(int n) {
  if (MODE == 0) return n;
  if (MODE == 1) { const int c = n >> 5, s = (n >> 4) & 1, i = n & 15; return s * FF + 16 * c + i; }
  if (MODE == 2) { if (n >= 2048) return n; const int w = n & 255, j = w >> 1, s = w & 1; return (n & ~255) + s * 128 + j; }
  if (MODE == 3) { const int h = n / 96, w = n - h * 96; if (w < 64) return n; const int wp = w - 64, j = wp >> 1, s = wp & 1; return h * 96 + 64 + s * 16 + j; }
  if (MODE == 4) { if (n < 1024) return (n >> 6) * 128 + (n & 63); const int m = n - 1024; return (m >> 6) * 128 + 64 + (m & 63); }
  if (MODE == 5) return n < 800 ? n : -1;
  return n;
}
template <int MODE> DI f32x4 cvt_load4(const float* __restrict__ row, int n) {
  if (MODE == 2 && n < 2048) { const int w = n & 255, j = w >> 1; const float* b = row + (n & ~255) + j; const f32x2 lo = *(const f32x2*)b, hi = *(const f32x2*)(b + 128); return (f32x4){lo[0], hi[0], lo[1], hi[1]}; }
  if (MODE == 3) { return (f32x4){row[srccol<3>(n)], row[srccol<3>(n + 1)], row[srccol<3>(n + 2)], row[srccol<3>(n + 3)]}; }
  const int sc = srccol<MODE>(n); if (sc < 0) return (f32x4){0.f, 0.f, 0.f, 0.f};
  return *(const f32x4*)(row + sc);
}
template <int MODE>
DI void convert_w(const float* __restrict__ src, int Nsrc, int K, bf16_t* __restrict__ dst, int Ndst, const float* __restrict__ kscale, float* ldsf) {
  const int tid = threadIdx.x, tn = Ndst / 64, tk = K / 64;
  for (int tile = blockIdx.x; tile < tn * tk; tile += gridDim.x) {
    const int n0 = (tile % tn) * 64, k0 = (tile / tn) * 64;
    __syncthreads();
#pragma unroll
    for (int i = 0; i < 2; ++i) { const int kk = (tid >> 4) + 32 * i, nn = (tid & 15) * 4;
      f32x4 v = cvt_load4<MODE>(src + (size_t)(k0 + kk) * Nsrc, n0 + nn);
      if (kscale) v = v * kscale[k0 + kk];
      float* lp = ldsf + kk * 65 + nn; lp[0] = v[0]; lp[1] = v[1]; lp[2] = v[2]; lp[3] = v[3]; }
    __syncthreads();
    { const int nn = tid >> 3, kc = tid & 7; const float* lp = ldsf + (kc * 8) * 65 + nn;
      u32x4 o; o.x = pk2(lp[0], lp[65]); o.y = pk2(lp[130], lp[195]); o.z = pk2(lp[260], lp[325]); o.w = pk2(lp[390], lp[455]);
      *(u32x4*)(dst + (size_t)(n0 + nn) * K + k0 + kc * 8) = o; }
  }
}

DI void ada_phase(const Params& p, float* ldsf) {
  const int tid = threadIdx.x, lane = tid & 63, w = tid >> 6;
  float* mods = (float*)(p.ws + OFF_MODS);
  __syncthreads();
  for (int e = tid; e < 5120; e += NTHR) { const int mv = e >> 10, k = e & 1023; const float cv = mv < 4 ? p.c[mv * 1024 + k] : p.cctx[k]; ldsf[e] = siluf(cv); }
  __syncthreads();
  float* red = ldsf + 5120;
  for (int item = blockIdx.x; item < 4 * 96; item += gridDim.x) {
    const int i = item / 96, n0 = (item % 96) * 64;
    const float* wp = p.ada_w + (size_t)i * 1024 * 6144 + n0 + lane;
    float a0 = 0.f, a1 = 0.f, a2 = 0.f, a3 = 0.f, a4 = 0.f;
#pragma unroll 8
    for (int kk = 0; kk < 128; ++kk) { const int k = w * 128 + kk; const float wv = wp[(size_t)k * 6144];
      a0 += ldsf[k] * wv; a1 += ldsf[1024 + k] * wv; a2 += ldsf[2048 + k] * wv; a3 += ldsf[3072 + k] * wv; a4 += ldsf[4096 + k] * wv; }
    red[(w * 5 + 0) * 64 + lane] = a0; red[(w * 5 + 1) * 64 + lane] = a1; red[(w * 5 + 2) * 64 + lane] = a2; red[(w * 5 + 3) * 64 + lane] = a3; red[(w * 5 + 4) * 64 + lane] = a4;
    __syncthreads();
    if (tid < 320) { const int mv = tid >> 6; float s = 0.f;
#pragma unroll
      for (int ww = 0; ww < 8; ++ww) s += red[(ww * 5 + mv) * 64 + lane];
      mods[(size_t)(i * 5 + mv) * 6144 + n0 + lane] = s + p.ada_b[i * 6144 + n0 + lane]; }
    __syncthreads();
  }
}
DI void tables_phase(const Params& p) {
  const int gt = blockIdx.x * NTHR + threadIdx.x, gn = gridDim.x * NTHR;
  float2* tabR = (float2*)(p.ws + OFF_TABR); float2* tabM = (float2*)(p.ws + OFF_TABM); float* lbv = (float*)(p.ws + OFF_LBV);
  for (int e = gt; e < 128 * 64; e += gn) { const int v = e >> 6, i = e & 63; const float inv = powf(10000.f, -(float)i / 64.f); const float ang = (float)v * inv; tabR[e] = make_float2(cosf(ang), sinf(ang)); }
  for (int e = gt; e < 128 * 8; e += gn) { const int v = e >> 3, i = e & 7; const float inv = powf(10000.f, -(float)i / 8.f); const float ang = (float)v * inv; tabM[e] = make_float2(cosf(ang), sinf(ang)); }
  for (int e = gt; e < 1024; e += gn) { const float l0 = p.hg_lb[e], l1 = p.hg_lb[1024 + e], l2 = p.hg_lb[2048 + e], l3 = p.hg_lb[3072 + e];
    const float mx = fmaxf(fmaxf(l0, l1), fmaxf(l2, l3)); const float e0 = expf(l0 - mx), e1 = expf(l1 - mx), e2 = expf(l2 - mx), e3 = expf(l3 - mx);
    lbv[e] = (e1 + e2 + e3) / (e0 + e1 + e2 + e3); }
}

DI void modulate_phase(const Params& p, const float* slat, const float* sctx, int layer) {
  const float* mods = (const float*)(p.ws + OFF_MODS); bf16_t* a = (bf16_t*)(p.ws + OFF_A);
  const int gt = blockIdx.x * NTHR + threadIdx.x, gn = gridDim.x * NTHR;
  for (int e = gt; e < T_ALL * 128; e += gn) {
    const int t = e >> 7, c0 = (e & 127) * 8; const float* s = hrowc(slat, sctx, t) + c0; const float* m = mods + (size_t)(layer * 5 + modvec(t)) * 6144;
    const f32x4 x0 = *(const f32x4*)s, x1 = *(const f32x4*)(s + 4), sh0 = *(const f32x4*)(m + c0), sh1 = *(const f32x4*)(m + c0 + 4), sc0 = *(const f32x4*)(m + 1024 + c0), sc1 = *(const f32x4*)(m + 1024 + c0 + 4);
    const f32x4 y0 = x0 * (1.f + sc0) + sh0, y1 = x1 * (1.f + sc1) + sh1;
    u32x4 o; o.x = pk2(y0[0], y0[1]); o.y = pk2(y0[2], y0[3]); o.z = pk2(y1[0], y1[1]); o.w = pk2(y1[2], y1[3]);
    *(u32x4*)(a + (size_t)t * 1024 + c0) = o;
  }
}
DI void ln_phase(const Params& p, int lnlayer, int lnidx, int ml, int js, bool final_out) {
  const float* mods = (const float*)(p.ws + OFF_MODS); bf16_t* a = (bf16_t*)(p.ws + OFF_A); float* hctx = (float*)(p.ws + OFF_HCTX); float2* lns = (float2*)(p.ws + OFF_LNS);
  const int tid = threadIdx.x, lane = tid & 63, gw = blockIdx.x * 8 + (tid >> 6), nw = gridDim.x * 8;
  const float* gp = p.ln_g + (size_t)(lnlayer * 2 + lnidx) * 1024; const float* bp = p.ln_b + (size_t)(lnlayer * 2 + lnidx) * 1024;
  for (int t = gw; t < T_ALL; t += nw) {
    float* hr = hrow(p.out, hctx, t);
    f32x4 v[4]; float s = 0.f;
#pragma unroll
    for (int i = 0; i < 4; ++i) { v[i] = *(const f32x4*)(hr + i * 256 + lane * 4); s += (v[i][0] + v[i][1]) + (v[i][2] + v[i][3]); }
#pragma unroll
    for (int o = 1; o < 64; o <<= 1) s += __shfl_xor(s, o);
    const float mean = s * (1.f / 1024.f); float q = 0.f;
#pragma unroll
    for (int i = 0; i < 4; ++i) { v[i] = v[i] - mean; q += (v[i][0] * v[i][0] + v[i][1] * v[i][1]) + (v[i][2] * v[i][2] + v[i][3] * v[i][3]); }
#pragma unroll
    for (int o = 1; o < 64; o <<= 1) q += __shfl_xor(q, o);
    const float rstd = rsqrtf(q * (1.f / 1024.f) + 1e-5f);
    if (!final_out && lane == 0) lns[t] = make_float2(mean, rstd);
    const float* m = mods + (size_t)(ml * 5 + modvec(t)) * 6144 + (size_t)js * 1024;
#pragma unroll
    for (int i = 0; i < 4; ++i) { const int c0 = i * 256 + lane * 4;
      const f32x4 y = v[i] * rstd * *(const f32x4*)(gp + c0) + *(const f32x4*)(bp + c0);
      if (final_out) *(f32x4*)(hr + c0) = y;
      else { const f32x4 z = y * (1.f + *(const f32x4*)(m + 1024 + c0)) + *(const f32x4*)(m + c0); u32x2 o; o.x = pk2(z[0], z[1]); o.y = pk2(z[2], z[3]); *(u32x2*)(a + (size_t)t * 1024 + c0) = o; } }
  }
}

namespace pg8 {
#define PG8_LAS __attribute__((address_space(3)))
typedef unsigned short bf16_t;
typedef short bf16x8 __attribute__((ext_vector_type(8)));
typedef float f32x4 __attribute__((ext_vector_type(4)));
typedef unsigned u32x4 __attribute__((ext_vector_type(4)));
constexpr int BM = 256, BK = 64, HALF = 128, HTB = HALF * BK * 2  , STAGE_BYTES = 8 * HTB, NXCD = 8, WGM = 8;

__host__ __device__ __forceinline__ int lds_byte(int r, int c) { const int st = (r >> 4) * 2 + (c >> 5), rr = r & 15, cc = c & 31, ob = rr * 64 + cc * 2; return st * 1024 + (ob ^ (((ob >> 9) & 1) << 5)); }
__host__ __device__ __forceinline__ void stage_rc(int b, int& R, int& C) { const int st = b / 1024, sb = b % 1024, swz = sb ^ (((sb >> 9) & 1) << 5); R = (st >> 1) * 16 + swz / 64; C = (st & 1) * 32 + (swz % 64) / 2; }
__host__ __device__ __forceinline__ int perm32(int rho) { const int n = rho >> 4, i = rho & 15; return 8 * (i >> 2) + 4 * n + (i & 3); }

struct Unit { int pm, pn; };
struct Gemm { const bf16_t* A; const bf16_t* Bt; int M, N, K; };

struct StaticOrder {
    int nM, nN, nwg, G, c, lat;
    __host__ __device__ void init(int M, int N, int G_, int c_, int lat_ = 0) { lat = lat_; nM = lat ? 128 : M / BM; nN = N / BM; nwg = nM * nN; G = G_; c = c_; }
    __host__ __device__ bool next(int i, Unit& u) const {
        const long L = (long)i * G + c; if (L >= nwg) return false;
        int wgid = (int)L; { const int q = nwg / NXCD, r = nwg % NXCD, xcd = wgid % NXCD, off = wgid / NXCD; wgid = (xcd < r ? xcd * (q + 1) : r * (q + 1) + (xcd - r) * q) + off; }
        const int nig = WGM * nN, gid = wgid / nig, fm = gid * WGM, gsz = (nM - fm) < WGM ? (nM - fm) : WGM;
        u.pm = fm + ((wgid % nig) % gsz); u.pn = (wgid % nig) / gsz; if (lat) u.pm += (u.pm >> 5) + 1; return true;
    }
    __device__ __forceinline__ void a_ready(const Unit&) const {}
    __device__ __forceinline__ void done(const Unit&) const {}
};
template <class Epi, class Sched, bool ALIGN_EPI = false, bool SP2 = false>
__device__ __forceinline__ void gemm_phase(PG8_LAS unsigned char* lds, const Gemm g, const Sched& S, const Epi& E) {
    const int tid = tid_(), wid = __builtin_amdgcn_readfirstlane(tid >> 6), lane = tid & 63, wr = wid >> 2, wc = wid & 3, fr = lane & 15, fq = lane >> 4;
    const int K = g.K, nt = K / BK;
    unsigned voffA[2], voffB[2];
#pragma unroll
    for (int i = 0; i < 2; ++i) { int R, C; stage_rc(tid * 16 + i * 8192, R, C); const int Rb = Epi::PERM ? ((R & ~31) + perm32(R & 31)) : R;
        voffA[i] = (unsigned)(R * K + C) * 2u; voffB[i] = (unsigned)(Rb * K + C) * 2u; }
    const size_t kstep = (size_t)(BK * 2);
    const size_t hstep = (size_t)HALF * K * 2;
    const size_t tstep = 2 * hstep;
    const unsigned ldsw = (unsigned)wid * 1024u;
    const int aoff = lds_byte(wr * 64 + fr, fq * 8), boff = lds_byte(wc * 32 + fr, fq * 8);
#define PG8_SA(b, h) (((b) * 2 + (h)) * HTB)
#define PG8_SB(b, h) ((4 + (b) * 2 + (h)) * HTB)
#define PG8_STAGE(bufoff, gbase, voff) do { _Pragma("unroll") for (int _i = 0; _i < 2; ++_i) \
        __builtin_amdgcn_global_load_lds((const unsigned*)((const char*)(gbase) + (voff)[_i]), (PG8_LAS unsigned*)(lds + (bufoff) + ldsw + _i * 8192), 16, 0, 0); } while (0)
#define PG8_LDA(dst, b, h) do { _Pragma("unroll") for (int m = 0; m < 4; ++m) _Pragma("unroll") for (int k = 0; k < 2; ++k) dst[m][k] = *(const PG8_LAS bf16x8*)(lds + PG8_SA(b, h) + aoff + m * 2048 + k * 1024); } while (0)
#define PG8_LDB(dst, b, h) do { _Pragma("unroll") for (int n = 0; n < 2; ++n) _Pragma("unroll") for (int k = 0; k < 2; ++k) dst[n][k] = *(const PG8_LAS bf16x8*)(lds + PG8_SB(b, h) + boff + n * 2048 + k * 1024); } while (0)
#define PG8_MMA(ai, bj, At, Bt) do { __builtin_amdgcn_s_setprio(1); _Pragma("unroll") for (int m = 0; m < 4; ++m) _Pragma("unroll") for (int n = 0; n < 2; ++n) _Pragma("unroll") for (int k = 0; k < 2; ++k) \
        acc[ai][bj][m][n] = __builtin_amdgcn_mfma_f32_16x16x32_bf16(Bt[n][k], At[m][k], acc[ai][bj][m][n], 0, 0, 0); __builtin_amdgcn_s_setprio(0); } while (0)
#define PG8_WAIT_V(n) asm volatile("s_waitcnt vmcnt(" #n ")" ::: "memory")
#define PG8_WAIT_L(n) asm volatile("s_waitcnt lgkmcnt(" #n ")" ::: "memory")
#define PG8_BAR __builtin_amdgcn_s_barrier()
#define PG8_SCHED __builtin_amdgcn_sched_barrier(0)
    Unit cur, nxt; int ui = 0;
    if (!S.next(0, cur)) return;
    f32x4 acc[2][2][4][2];
#pragma unroll
    for (int a = 0; a < 2; ++a)
#pragma unroll
        for (int b = 0; b < 2; ++b)
#pragma unroll
            for (int m = 0; m < 4; ++m)
#pragma unroll
                for (int n = 0; n < 2; ++n) acc[a][b][m][n] = (f32x4){0.f, 0.f, 0.f, 0.f};
    bf16x8 At[4][2], B0[2][2], B1[2][2];
    const char* cA = (const char*)g.A + (size_t)cur.pm * tstep; const char* cB = (const char*)g.Bt + (size_t)cur.pn * tstep;
    S.a_ready(cur);
    if constexpr (SP2) {
        PG8_STAGE(PG8_SB(0, 0), cB, voffB); PG8_STAGE(PG8_SB(0, 1), cB + hstep, voffB); PG8_STAGE(PG8_SA(0, 0), cA, voffA); PG8_STAGE(PG8_SA(0, 1), cA + hstep, voffA);
        if (wr == 1) PG8_BAR;
        PG8_WAIT_V(2); PG8_BAR;
        PG8_STAGE(PG8_SB(1, 0), cB + kstep, voffB); PG8_STAGE(PG8_SA(1, 0), cA + kstep, voffA); PG8_STAGE(PG8_SB(1, 1), cB + hstep + kstep, voffB);
        PG8_WAIT_V(6); PG8_BAR;
    } else {
        PG8_STAGE(PG8_SB(0, 0), cB, voffB); PG8_STAGE(PG8_SA(0, 0), cA, voffA); PG8_STAGE(PG8_SB(0, 1), cB + hstep, voffB); PG8_STAGE(PG8_SA(0, 1), cA + hstep, voffA);
        if (wr == 1) PG8_BAR;
        PG8_WAIT_V(4); PG8_BAR;
        PG8_STAGE(PG8_SB(1, 0), cB + kstep, voffB); PG8_STAGE(PG8_SA(1, 0), cA + kstep, voffA); PG8_STAGE(PG8_SB(1, 1), cB + hstep + kstep, voffB);
        PG8_WAIT_V(6); PG8_BAR;
    }
    for (;;) {
        const bool has_next = S.next(ui + 1, nxt);
        const char* nA = has_next ? (const char*)g.A + (size_t)nxt.pm * tstep : cA; const char* nB = has_next ? (const char*)g.Bt + (size_t)nxt.pn * tstep : cB;
        for (int t = 0; t < nt; t += 2) {
            const bool last = (t == nt - 2);
            const char* a1 = cA + (size_t)(t + 1) * kstep;
            const char* a2 = last ? nA : cA + (size_t)(t + 2) * kstep; const char* b2 = last ? nB : cB + (size_t)(t + 2) * kstep;
            const char* a3 = a2 + kstep; const char* b3 = b2 + kstep;
            if (last && has_next) S.a_ready(nxt);
            if constexpr (SP2) {
            PG8_LDB(B0, 0, 0); PG8_LDB(B1, 0, 1); PG8_SCHED; PG8_LDA(At, 0, 0); PG8_STAGE(PG8_SA(1, 1), a1 + hstep, voffA);
            PG8_WAIT_V(8); PG8_WAIT_L(0); PG8_BAR; PG8_MMA(0, 0, At, B0); PG8_MMA(0, 1, At, B1); PG8_BAR; PG8_SCHED;
            PG8_LDA(At, 0, 1); PG8_STAGE(PG8_SB(0, 0), b2, voffB); PG8_STAGE(PG8_SB(0, 1), b2 + hstep, voffB); PG8_STAGE(PG8_SA(0, 0), a2, voffA);
            PG8_WAIT_V(8); PG8_WAIT_L(0); PG8_BAR; PG8_MMA(1, 0, At, B0); PG8_MMA(1, 1, At, B1); PG8_BAR; PG8_SCHED;
            PG8_LDB(B0, 1, 0); PG8_LDB(B1, 1, 1); PG8_SCHED; PG8_LDA(At, 1, 0); PG8_STAGE(PG8_SA(0, 1), a2 + hstep, voffA);
            PG8_WAIT_V(8); PG8_WAIT_L(0); PG8_BAR; PG8_MMA(0, 0, At, B0); PG8_MMA(0, 1, At, B1); PG8_BAR; PG8_SCHED;
            PG8_LDA(At, 1, 1); PG8_STAGE(PG8_SB(1, 0), b3, voffB); PG8_STAGE(PG8_SB(1, 1), b3 + hstep, voffB); PG8_STAGE(PG8_SA(1, 0), a3, voffA);
            PG8_WAIT_V(8); PG8_WAIT_L(0); PG8_BAR; PG8_MMA(1, 0, At, B0); PG8_MMA(1, 1, At, B1); PG8_BAR; PG8_SCHED;
            } else {
            PG8_LDB(B0, 0, 0); PG8_SCHED; PG8_LDA(At, 0, 0); PG8_STAGE(PG8_SA(1, 1), a1 + hstep, voffA);
            PG8_WAIT_L(8); PG8_BAR; PG8_WAIT_L(0); PG8_MMA(0, 0, At, B0); PG8_BAR; PG8_SCHED;
            PG8_LDB(B1, 0, 1); PG8_STAGE(PG8_SB(0, 0), b2, voffB);
            PG8_BAR; PG8_WAIT_L(0); PG8_MMA(0, 1, At, B1); PG8_BAR;
            PG8_LDA(At, 0, 1); PG8_STAGE(PG8_SA(0, 0), a2, voffA);
            PG8_BAR; PG8_WAIT_L(0); PG8_MMA(1, 0, At, B0); PG8_BAR; PG8_SCHED;
            PG8_STAGE(PG8_SB(0, 1), b2 + hstep, voffB);
            PG8_WAIT_V(6); PG8_BAR; PG8_MMA(1, 1, At, B1); PG8_BAR;
            PG8_LDB(B0, 1, 0); PG8_SCHED; PG8_LDA(At, 1, 0); PG8_STAGE(PG8_SA(0, 1), a2 + hstep, voffA);
            PG8_WAIT_L(8); PG8_BAR; PG8_WAIT_L(0); PG8_MMA(0, 0, At, B0); PG8_BAR; PG8_SCHED;
            PG8_LDB(B1, 1, 1); PG8_STAGE(PG8_SB(1, 0), b3, voffB);
            PG8_BAR; PG8_WAIT_L(0); PG8_MMA(0, 1, At, B1); PG8_BAR;
            PG8_LDA(At, 1, 1); PG8_STAGE(PG8_SA(1, 0), a3, voffA);
            PG8_BAR; PG8_WAIT_L(0); PG8_MMA(1, 0, At, B0); PG8_BAR; PG8_SCHED;
            PG8_STAGE(PG8_SB(1, 1), b3 + hstep, voffB);
            PG8_WAIT_V(6); PG8_BAR; PG8_MMA(1, 1, At, B1); PG8_BAR;
            }
        }
        if constexpr (ALIGN_EPI) { if (wr == 0) PG8_BAR; }
        if constexpr (!Epi::AFTER_DRAIN) { E(acc, cur, wr, wc, fr, fq); S.done(cur); }
        if (!has_next) break;
#pragma unroll
        for (int a = 0; a < 2; ++a)
#pragma unroll
            for (int b = 0; b < 2; ++b)
#pragma unroll
                for (int m = 0; m < 4; ++m)
#pragma unroll
                    for (int n = 0; n < 2; ++n) acc[a][b][m][n] = (f32x4){0.f, 0.f, 0.f, 0.f};
        cur = nxt; cA = nA; cB = nB; ++ui;
        if constexpr (ALIGN_EPI) { if (wr == 1) PG8_BAR; }
    }
    PG8_WAIT_V(0);
    if constexpr (!ALIGN_EPI) { if (wr == 0) PG8_BAR; }
    PG8_BAR;
    if constexpr (Epi::AFTER_DRAIN) { E.fused(acc, cur, wr, wc, fr, fq, lds, wid, lane); S.done(cur); }
#undef PG8_SA
#undef PG8_SB
#undef PG8_STAGE
#undef PG8_LDA
#undef PG8_LDB
#undef PG8_MMA
#undef PG8_WAIT_V
#undef PG8_WAIT_L
#undef PG8_BAR
#undef PG8_SCHED
}
}

template <class E4> struct EpiWrap { static constexpr bool PERM = false, AFTER_DRAIN = false; E4 e;
  DI void operator()(const f32x4 (&acc)[2][2][4][2], const pg8::Unit& u, int wr, int wc, int fr, int fq) const {
#pragma unroll
    for (int ai = 0; ai < 2; ++ai)
#pragma unroll
      for (int m = 0; m < 4; ++m) { const int row = u.pm * 256 + ai * 128 + wr * 64 + m * 16 + fr;
#pragma unroll
        for (int bj = 0; bj < 2; ++bj) { const int col = u.pn * 256 + bj * 128 + wc * 32 + 4 * fq;
          if constexpr (E4::PAIR) e.pair(row, ((col - 4 * fq) >> 1) + 4 * fq, acc[ai][bj][m][0], acc[ai][bj][m][1]);
          else { e(row, col, acc[ai][bj][m][0]); e(row, col + 16, acc[ai][bj][m][1]); } }
        asm volatile("" ::: "memory"); }
  } };
template <class E4>
DI void big_gemm(const bf16_t* A, const bf16_t* W, int M, int N, int K, const E4& e4, char* lds, int lat_only = 0) {
  __syncthreads();
  pg8::Gemm g{A, W, M, N, K}; pg8::StaticOrder S; S.init(M, N, (int)gridDim.x, (int)blockIdx.x, lat_only); EpiWrap<E4> E{e4};
  pg8::gemm_phase<EpiWrap<E4>, pg8::StaticOrder, true, true>((PG8_LAS unsigned char*)lds, g, S, E);
  __syncthreads();
}
struct GemmArgs { const bf16_t* A; int lda; const bf16_t* W; int ldw; int M, N, K; };
constexpr int LDT = 72;
template <bool TRANS, class Epi>
DI void gemm_phase(const GemmArgs g, const Epi epi, char* lds) {
  const int tid = threadIdx.x, lane = tid & 63, w = tid >> 6, wm = w & 3, wn = w >> 2, g4 = lane >> 4, l16 = lane & 15;
  const int nN = g.N / 128, ntiles = (g.M / 256) * nN, nk = g.K / 64;
  bf16_t* As = (bf16_t*)lds; bf16_t* Bs = As + 256 * LDT;
  for (int tile = blockIdx.x; tile < ntiles; tile += gridDim.x) {
    const int pm = tile / nN, pn = tile - pm * nN;
    const bf16_t* Ag = g.A + (size_t)(pm * 256) * g.lda; const bf16_t* Wg = g.W + (size_t)(pn * 128) * g.ldw;
    f32x4 acc[4][4];
#pragma unroll
    for (int i = 0; i < 4; ++i)
#pragma unroll
      for (int j = 0; j < 4; ++j) acc[i][j] = (f32x4){0.f, 0.f, 0.f, 0.f};
    u32x4 ra[4], rb[2];
#pragma unroll
    for (int i = 0; i < 4; ++i) { const int c = tid + NTHR * i; ra[i] = *(const u32x4*)(Ag + (size_t)(c >> 3) * g.lda + (c & 7) * 8); }
#pragma unroll
    for (int i = 0; i < 2; ++i) { const int c = tid + NTHR * i; rb[i] = *(const u32x4*)(Wg + (size_t)(c >> 3) * g.ldw + (c & 7) * 8); }
    for (int kt = 0; kt < nk; ++kt) {
      __syncthreads();
#pragma unroll
      for (int i = 0; i < 4; ++i) { const int c = tid + NTHR * i; *(u32x4*)(As + (c >> 3) * LDT + (c & 7) * 8) = ra[i]; }
#pragma unroll
      for (int i = 0; i < 2; ++i) { const int c = tid + NTHR * i; *(u32x4*)(Bs + (c >> 3) * LDT + (c & 7) * 8) = rb[i]; }
      __syncthreads();
      if (kt + 1 < nk) { const int k0 = (kt + 1) * 64;
#pragma unroll
        for (int i = 0; i < 4; ++i) { const int c = tid + NTHR * i; ra[i] = *(const u32x4*)(Ag + (size_t)(c >> 3) * g.lda + k0 + (c & 7) * 8); }
#pragma unroll
        for (int i = 0; i < 2; ++i) { const int c = tid + NTHR * i; rb[i] = *(const u32x4*)(Wg + (size_t)(c >> 3) * g.ldw + k0 + (c & 7) * 8); } }
#pragma unroll
      for (int ks = 0; ks < 2; ++ks) {
        bf16x8 af[4], wf[4];
#pragma unroll
        for (int i = 0; i < 4; ++i) af[i] = *(const bf16x8*)(As + (wm * 64 + i * 16 + l16) * LDT + ks * 32 + g4 * 8);
#pragma unroll
        for (int j = 0; j < 4; ++j) wf[j] = *(const bf16x8*)(Bs + (wn * 64 + j * 16 + l16) * LDT + ks * 32 + g4 * 8);
#pragma unroll
        for (int i = 0; i < 4; ++i)
#pragma unroll
          for (int j = 0; j < 4; ++j) acc[i][j] = TRANS ? mfma16(af[i], wf[j], acc[i][j]) : mfma16(wf[j], af[i], acc[i][j]);
      }
    }
    const int mb = pm * 256 + wm * 64, nb = pn * 128 + wn * 64;
    if constexpr (Epi::PAIR) {
#pragma unroll
      for (int i = 0; i < 4; ++i)
#pragma unroll
        for (int j = 0; j < 2; ++j) epi.pair(mb + i * 16 + l16, (nb >> 1) + 16 * j + 4 * g4, acc[i][2 * j], acc[i][2 * j + 1]);
    } else {
#pragma unroll
      for (int i = 0; i < 4; ++i)
#pragma unroll
        for (int j = 0; j < 4; ++j) { if (TRANS) epi(mb + i * 16 + 4 * g4, nb + j * 16 + l16, acc[i][j]); else epi(mb + i * 16 + l16, nb + j * 16 + 4 * g4, acc[i][j]); }
    }
  }
}
DI void st4bf(bf16_t* p, f32x4 v) { u32x2 o; o.x = pk2(v[0], v[1]); o.y = pk2(v[2], v[3]); *(u32x2*)p = o; }
struct EpiStore { static constexpr bool PAIR = false; bf16_t* d0; bf16_t* d1; int split, ld0, ld1; float s0;
  DI void operator()(int m, int n, f32x4 v) const { if (n < split) st4bf(d0 + (size_t)m * ld0 + n, v * s0); else st4bf(d1 + (size_t)m * ld1 + (n - split), v); } };
struct EpiVT { static constexpr bool PAIR = false; bf16_t* vt; const float* rs;
  DI void operator()(int m, int n, f32x4 v) const { const int b = m / PB, pos = m - b * PB;
    if (rs) { v[0] *= rs[2 * m + 1]; v[1] *= rs[2 * m + 3]; v[2] *= rs[2 * m + 5]; v[3] *= rs[2 * m + 7]; }
    st4bf(vt + ((size_t)(b * 1024 + n)) * PB + pos, v); } };
struct EpiResid { static constexpr bool PAIR = false; const float* slat; const float* sctx; float* dlat; float* dctx; const float* gate;
  const float2* lns; const float* lg; const float* lb;
  DI void operator()(int m, int n, f32x4 v) const { const int mv = modvec(m); f32x4 hv = *(const f32x4*)(hrowc(slat, sctx, m) + n); const f32x4 gt = *(const f32x4*)(gate + (size_t)mv * 6144 + n);
    if (lns) { const float2 st = lns[m]; hv = (hv - st.x) * st.y * *(const f32x4*)(lg + n) + *(const f32x4*)(lb + n); }
    *(f32x4*)(hrow(dlat, dctx, m) + n) = ALPHA * hv + gt * v; } };
struct EpiSwiglu { static constexpr bool PAIR = true; bf16_t* u;
  DI void pair(int m, int f, f32x4 gt, f32x4 up) const { f32x4 r; r[0] = siluf(gt[0]) * up[0]; r[1] = siluf(gt[1]) * up[1]; r[2] = siluf(gt[2]) * up[2]; r[3] = siluf(gt[3]) * up[3]; st4bf(u + (size_t)m * FF + f, r); } };
struct EpiRetQK { static constexpr bool PAIR = false; bf16_t* qk; const float2* tabR;
  DI void operator()(int m, int n, f32x4 v) const { const int b = m / PB, pp = m - b * PB;
    if (pp >= LC) { const int pos = pp - LC, row = pos >> 6, col = pos & 63; const int j0 = (n & 255) >> 1;
      const int vv = j0 < 64 ? row : col; const float2 c0 = tabR[vv * 64 + (j0 & 63)], c1 = tabR[vv * 64 + ((j0 + 1) & 63)];
      const float a0 = v[0] * c0.x - v[1] * c0.y, b0 = v[0] * c0.y + v[1] * c0.x, a1 = v[2] * c1.x - v[3] * c1.y, b1 = v[2] * c1.y + v[3] * c1.x; v = (f32x4){a0, b0, a1, b1}; }
    if (n >= 1024) v = v * 0.0625f;
    st4bf(qk + (size_t)m * 2048 + n, v); } };
struct EpiHg { static constexpr bool PAIR = false; bf16_t* ph;
  DI void operator()(int m, int n, f32x4 v) const { if (n < 1024) { v[0] = siluf(v[0]); v[1] = siluf(v[1]); v[2] = siluf(v[2]); v[3] = siluf(v[3]); v = v * 0.08838834764831845f; } st4bf(ph + (size_t)m * 5120 + n, v); } };
struct EpiMlaQ { static constexpr bool PAIR = false; bf16_t* q; const float* rs; const float2* tabM;
  DI void operator()(int m, int n, f32x4 v) const { v = v * (rs[2 * m] * 0.10206207261596577f * LOG2E); const int h = n / 96, w = n - h * 96; const int b = m / PB, pp = m - b * PB;
    if (w >= 64 && pp >= LC) { const int pos = pp - LC, row = pos >> 6, col = pos & 63; const int j0 = (w - 64) >> 1; const int vv = j0 < 8 ? row : col; const float2 c0 = tabM[vv * 8 + (j0 & 7)], c1 = tabM[vv * 8 + ((j0 + 1) & 7)];
      const float a0 = v[0] * c0.x - v[1] * c0.y, b0 = v[0] * c0.y + v[1] * c0.x, a1 = v[2] * c1.x - v[3] * c1.y, b1 = v[2] * c1.y + v[3] * c1.x; v = (f32x4){a0, b0, a1, b1}; }
    st4bf(q + (size_t)m * 1536 + n, v); } };
struct EpiMlaK { static constexpr bool PAIR = false; bf16_t* k; const float* rs;
  DI void operator()(int m, int n, f32x4 v) const { v = v * rs[2 * m + 1]; st4bf(k + (size_t)m * 1536 + (n >> 6) * 96 + (n & 63), v); } };

DI void mla_stats_phase(const Params& p) {
  const bf16_t* d0 = (const bf16_t*)(p.ws + M_D0); bf16_t* km = (bf16_t*)(p.ws + M_K); float* rs = (float*)(p.ws + OFF_RS); const float2* tabM = (const float2*)(p.ws + OFF_TABM);
  const int tid = threadIdx.x, lane = tid & 63, gw = blockIdx.x * 8 + (tid >> 6), nw = gridDim.x * 8;
  for (int t = gw; t < T_ALL; t += nw) {
    const bf16_t* r = d0 + (size_t)t * 1024;
    const u32x4 a = *(const u32x4*)(r + lane * 8); const u32x2 c = *(const u32x2*)(r + 512 + lane * 4);
    float sq = bflo(a.x) * bflo(a.x) + bfhi(a.x) * bfhi(a.x) + bflo(a.y) * bflo(a.y) + bfhi(a.y) * bfhi(a.y) + bflo(a.z) * bflo(a.z) + bfhi(a.z) * bfhi(a.z) + bflo(a.w) * bflo(a.w) + bfhi(a.w) * bfhi(a.w);
    float sk = bflo(c.x) * bflo(c.x) + bfhi(c.x) * bfhi(c.x) + bflo(c.y) * bflo(c.y) + bfhi(c.y) * bfhi(c.y);
#pragma unroll
    for (int o = 1; o < 64; o <<= 1) { sq += __shfl_xor(sq, o); sk += __shfl_xor(sk, o); }
    if (lane == 0) { rs[2 * t] = rsqrtf(sq * (1.f / 512.f) + 1e-6f); rs[2 * t + 1] = rsqrtf(sk * (1.f / 256.f) + 1e-6f); }
    if (lane < 16) { const int j = lane; float x1 = bf2f(r[768 + j]), x2 = bf2f(r[768 + 16 + j]); const int b = t / PB, pp = t - b * PB;
      if (pp >= LC) { const int pos = pp - LC, row = pos >> 6, col = pos & 63; const float2 cs = tabM[(j < 8 ? row : col) * 8 + (j & 7)]; const float o1 = x1 * cs.x - x2 * cs.y, o2 = x1 * cs.y + x2 * cs.x; x1 = o1; x2 = o2; }
      const unsigned pr = pk2(x1, x2);
#pragma unroll
      for (int h = 0; h < 16; ++h) *(unsigned*)(km + (size_t)t * 1536 + h * 96 + 64 + 2 * j) = pr; }
  }
}

constexpr int KLD = 104, VLD = 72;
DI void mla_attn_phase(const Params& p, char* lds) {
  const bf16_t* Qm = (const bf16_t*)(p.ws + M_Q); const bf16_t* Km = (const bf16_t*)(p.ws + M_K); const bf16_t* vT = (const bf16_t*)(p.ws + M_VT); bf16_t* o = (bf16_t*)(p.ws + OFF_A);
  const int tid = threadIdx.x, lane = tid & 63, w = tid >> 6, c = lane & 31, hh = lane >> 5;
  constexpr int KB = 64 * KLD, VB = 64 * VLD;
  bf16_t* Ks = (bf16_t*)lds; bf16_t* Vs = Ks + 3 * KB;
  for (int item = blockIdx.x; item < 2048 + 64; item += gridDim.x) {
    int b, h, qbase, nkt;
    if (item < 2048) { b = item >> 9; h = (item >> 5) & 15; qbase = LC + (item & 31) * 256; nkt = 132; } else { const int it = item - 2048; b = it >> 4; h = it & 15; qbase = 0; nkt = 4; }
    const size_t tokbase = (size_t)b * PB;
    const bf16_t* qp = Qm + (tokbase + qbase + w * 32 + c) * 1536 + h * 96 + hh * 8;
    bf16x8 qf[6];
#pragma unroll
    for (int ks = 0; ks < 6; ++ks) qf[ks] = *(const bf16x8*)(qp + ks * 16);
    const bf16_t* kg = Km + tokbase * 1536 + h * 96; const bf16_t* vg = vT + (size_t)(b * 16 + h) * 64 * PB;
    const int kr0 = tid / 12, kc0 = tid - kr0 * 12, e1 = tid + NTHR, kr1 = e1 / 12, kc1 = e1 - kr1 * 12; const bool k1ok = e1 < 768; const int vd = tid >> 3, vc = tid & 7;
    u32x4 rk0, rk1 = (u32x4){0, 0, 0, 0}, rv;
    auto gload = [&](int t) { const size_t key0 = (size_t)t * 64;
      rk0 = *(const u32x4*)(kg + (key0 + kr0) * 1536 + kc0 * 8); if (k1ok) rk1 = *(const u32x4*)(kg + (key0 + kr1) * 1536 + kc1 * 8); rv = *(const u32x4*)(vg + (size_t)vd * PB + key0 + vc * 8); };
    auto lstore = [&](int buf) { bf16_t* Kn = Ks + buf * KB; bf16_t* Vn = Vs + buf * VB;
      *(u32x4*)(Kn + kr0 * KLD + kc0 * 8) = rk0; if (k1ok) *(u32x4*)(Kn + kr1 * KLD + kc1 * 8) = rk1; *(u32x4*)(Vn + vd * VLD + vc * 8) = rv; };
    f32x16 oacc[2];
#pragma unroll
    for (int i = 0; i < 16; ++i) { oacc[0][i] = 0.f; oacc[1][i] = 0.f; }
    float mrow = -1e30f, lsum = 0.f;
    auto qk = [&](int buf, f32x16 (&s)[2]) { const bf16_t* Kc = Ks + buf * KB;
#pragma unroll
      for (int j = 0; j < 2; ++j) {
#pragma unroll
        for (int i = 0; i < 16; ++i) s[j][i] = 0.f;
#pragma unroll
        for (int ks = 0; ks < 6; ++ks) { const bf16x8 kf = *(const bf16x8*)(Kc + (32 * j + c) * KLD + ks * 16 + hh * 8); s[j] = mfma32(kf, qf[ks], s[j]); }
      } };
    auto smpv = [&](int buf, f32x16 (&s)[2]) { const bf16_t* Vc = Vs + buf * VB;
      float mx = s[0][0];
#pragma unroll
      for (int j = 0; j < 2; ++j)
#pragma unroll
        for (int i = 0; i < 16; ++i) mx = fmaxf(mx, s[j][i]);
      if (__builtin_amdgcn_ballot_w64(mx > mrow + 8.f) != 0ull) {
        mx = fmaxf(mx, __shfl_xor(mx, 32));
        const float mnew = fmaxf(mrow, mx), alpha = __builtin_amdgcn_exp2f(mrow - mnew); mrow = mnew;
        lsum *= alpha;
#pragma unroll
        for (int i = 0; i < 16; ++i) { oacc[0][i] *= alpha; oacc[1][i] *= alpha; }
      }
      float ps0 = 0.f, ps1 = 0.f;
#pragma unroll
      for (int j = 0; j < 2; ++j)
#pragma unroll
        for (int i = 0; i < 16; i += 2) { s[j][i] = __builtin_amdgcn_exp2f(s[j][i] - mrow); ps0 += s[j][i]; s[j][i + 1] = __builtin_amdgcn_exp2f(s[j][i + 1] - mrow); ps1 += s[j][i + 1]; }
      lsum += ps0 + ps1;
#pragma unroll
      for (int j = 0; j < 2; ++j)
#pragma unroll
        for (int sx = 0; sx < 2; ++sx) {
          const bf16x8 pf = pack8(s[j][8 * sx], s[j][8 * sx + 1], s[j][8 * sx + 2], s[j][8 * sx + 3], s[j][8 * sx + 4], s[j][8 * sx + 5], s[j][8 * sx + 6], s[j][8 * sx + 7]);
#pragma unroll
          for (int dt = 0; dt < 2; ++dt) { const bf16_t* vp = Vc + (32 * dt + c) * VLD + 32 * j + 16 * sx + 4 * hh;
            const bf16x8 vf = cat44(*(const s16x4*)vp, *(const s16x4*)(vp + 8)); oacc[dt] = mfma32(vf, pf, oacc[dt]); }
        } };
    __syncthreads();
    gload(0); lstore(0); gload(1); lstore(1); if (nkt > 2) gload(2);
    __syncthreads();
    f32x16 sA[2], sB[2];
    qk(0, sA);
    int b0 = 0, b1 = 1, b2 = 2;
    for (int kt = 0; kt < nkt; kt += 2) {
      __syncthreads();
      if (kt + 2 < nkt) { lstore(b2); if (kt + 3 < nkt) gload(kt + 3); }
      qk(b1, sB);
      smpv(b0, sA);
      __syncthreads();
      if (kt + 3 < nkt) { lstore(b0); if (kt + 4 < nkt) gload(kt + 4); }
      if (kt + 2 < nkt) qk(b2, sA);
      smpv(b1, sB);
      { const int t0 = b0; b0 = b2; b2 = b1; b1 = t0; }
    }
    lsum += __shfl_xor(lsum, 32); const float inv = 1.f / lsum;
    bf16_t* op = o + (tokbase + qbase + w * 32 + c) * 1024 + h * 64 + 4 * hh;
#pragma unroll
    for (int dt = 0; dt < 2; ++dt)
#pragma unroll
      for (int rg = 0; rg < 4; ++rg) st4bf(op + 32 * dt + 8 * rg, (f32x4){oacc[dt][4 * rg] * inv, oacc[dt][4 * rg + 1] * inv, oacc[dt][4 * rg + 2] * inv, oacc[dt][4 * rg + 3] * inv});
  }
}

constexpr int NKC = 72, NVC = 264;
constexpr int NWK = 72, NWV = 584;
constexpr int NA_OFF_VC = 256 * NKC * 2, NA_OFF_RPB = NA_OFF_VC + 64 * NVC * 2, NA_OFF_W = NA_OFF_RPB + 1920, NA_LDS = NA_OFF_W + 576 * NWK * 2;
static_assert(64 * NWV * 2 <= 576 * NWK * 2 && NA_OFF_W % 16 == 0, "NA window");
DI void na_ctx_wave(const bf16_t* __restrict__ Q, bf16_t* __restrict__ o, const bf16_t* Kc, const bf16_t* Vc, int b, int h, int qb, int lane) {
  const int g = lane >> 4, l16 = lane & 15; const size_t tokbase = (size_t)b * PB; const int qpos = qb * 16 + l16;
  const bf16_t* qp = Q + (tokbase + qpos) * 1024 + h * 64 + g * 8;
  const bf16x8 q0 = *(const bf16x8*)qp, q1 = *(const bf16x8*)(qp + 32);
  f32x4 S[16];
#pragma unroll
  for (int kt = 0; kt < 16; ++kt) { const bf16_t* kp = Kc + (16 * kt + l16) * NKC + g * 8;
    f32x4 s = mfma16(*(const bf16x8*)kp, q0, (f32x4){0.f, 0.f, 0.f, 0.f}); s = mfma16(*(const bf16x8*)(kp + 32), q1, s); S[kt] = s * LOG2E; }
  float mx = S[0][0];
#pragma unroll
  for (int kt = 0; kt < 16; ++kt) mx = fmaxf(fmaxf(fmaxf(mx, S[kt][0]), fmaxf(S[kt][1], S[kt][2])), S[kt][3]);
  mx = fmaxf(mx, __shfl_xor(mx, 16)); mx = fmaxf(mx, __shfl_xor(mx, 32));
  float ls = 0.f;
#pragma unroll
  for (int kt = 0; kt < 16; ++kt)
#pragma unroll
    for (int rr = 0; rr < 4; ++rr) { S[kt][rr] = __builtin_amdgcn_exp2f(S[kt][rr] - mx); ls += S[kt][rr]; }
  ls += __shfl_xor(ls, 16); ls += __shfl_xor(ls, 32);
  f32x4 O[4];
#pragma unroll
  for (int dt = 0; dt < 4; ++dt) O[dt] = (f32x4){0.f, 0.f, 0.f, 0.f};
#pragma unroll
  for (int kk = 0; kk < 8; ++kk) {
    const bf16x8 pf = pack8(S[2 * kk][0], S[2 * kk][1], S[2 * kk][2], S[2 * kk][3], S[2 * kk + 1][0], S[2 * kk + 1][1], S[2 * kk + 1][2], S[2 * kk + 1][3]);
#pragma unroll
    for (int dt = 0; dt < 4; ++dt) { const bf16_t* vp = Vc + (dt * 16 + l16) * NVC + 32 * kk + 4 * g; const bf16x8 vf = cat44(*(const s16x4*)vp, *(const s16x4*)(vp + 16)); O[dt] = mfma16(vf, pf, O[dt]); }
  }
  const float inv = 1.f / ls; bf16_t* op = o + (tokbase + qpos) * 1024 + h * 64 + 4 * g;
#pragma unroll
  for (int dt = 0; dt < 4; ++dt) st4bf(op + 16 * dt, O[dt] * inv);
}
DI void na_attn_phase(const Params& p, char* lds) {
  const bf16_t* Q = (const bf16_t*)(p.ws + N_Q); const bf16_t* K = (const bf16_t*)(p.ws + N_K); const bf16_t* vT = (const bf16_t*)(p.ws + N_VT); bf16_t* o = (bf16_t*)(p.ws + OFF_A);
  bf16_t* Kc = (bf16_t*)lds; bf16_t* Vc = (bf16_t*)(lds + NA_OFF_VC); float* rl = (float*)(lds + NA_OFF_RPB); bf16_t* W = (bf16_t*)(lds + NA_OFF_W);
  const int tid = threadIdx.x, lane = tid & 63, w = tid >> 6, g = lane >> 4, l16 = lane & 15;
  for (int item = blockIdx.x; item < 256; item += gridDim.x) {
    const int qtr = item & 3, h = (item >> 2) & 15, b = item >> 6; const size_t tokbase = (size_t)b * PB;
    const bf16_t* kbase = K + (tokbase + LC) * 1024 + h * 64; const bf16_t* vbase = vT + (size_t)(b * 16 + h) * 64 * PB + LC;
    __syncthreads();
#pragma unroll
    for (int i = 0; i < 4; ++i) { const int e = tid + NTHR * i; const int key = e >> 3, kc = e & 7; *(u32x4*)(Kc + key * NKC + kc * 8) = *(const u32x4*)(K + (tokbase + key) * 1024 + h * 64 + kc * 8); }
#pragma unroll
    for (int i = 0; i < 4; ++i) { const int e = tid + NTHR * i; const int d = e >> 5, pc = e & 31; *(u32x4*)(Vc + d * NVC + pc * 8) = *(const u32x4*)(vT + ((size_t)(b * 16 + h) * 64 + d) * PB + pc * 8); }
    for (int e = tid; e < 465; e += NTHR) rl[e] = p.na_rpb[h * 465 + e];
    u32x4 rw[9];
#pragma unroll 1
    for (int j = 0; j < 16; ++j) {
      int ln = lane, tt = tid; asm volatile("" : "+v"(ln), "+v"(tt)); const int gg = ln >> 4, ll = ln & 15;
      const int r0 = qtr * 32 + 2 * j, rs0 = clampi(r0 - 4, 0, 120), r = r0 + (w >> 2), n = w & 3, rs = clampi(r - 4, 0, 120), dr = rs - rs0, band0 = clampi(16 * n - 8, 0, 32);
      const int qpos = LC + r * 64 + n * 16 + ll;
#pragma unroll
      for (int i = 0; i < 9; ++i) { const int e = tt + NTHR * i; rw[i] = *(const u32x4*)(kbase + (size_t)(rs0 * 64 + (e >> 3)) * 1024 + (e & 7) * 8); }
      __syncthreads();
#pragma unroll
      for (int i = 0; i < 9; ++i) { const int e = tt + NTHR * i; *(u32x4*)(W + (e >> 3) * NWK + (e & 7) * 8) = rw[i]; }
      __syncthreads();
      const bf16_t* qp = Q + (tokbase + qpos) * 1024 + h * 64 + gg * 8;
      const bf16x8 q0 = *(const bf16x8*)qp, q1 = *(const bf16x8*)(qp + 32);
      f32x4 S[32];
#pragma unroll
      for (int kt = 0; kt < 32; ++kt) {
        f32x4 s;
        if (kt < 16) {
          const bf16_t* kp = W + ((dr + (kt >> 1)) * 64 + band0 + 16 * (kt & 1) + ll) * NWK + gg * 8;
          s = mfma16(*(const bf16x8*)kp, q0, (f32x4){0.f, 0.f, 0.f, 0.f}); s = mfma16(*(const bf16x8*)(kp + 32), q1, s);
          const int qcol = 16 * n + ll, wstart = clampi(qcol - 8, 0, 48); const float* bp = rl + (rs + (kt >> 1) - r + 7) * 31;
#pragma unroll
          for (int rr = 0; rr < 4; ++rr) { const int kcol = band0 + 16 * (kt & 1) + 4 * gg + rr; const bool ok = kcol >= wstart && kcol < wstart + 16;
            s[rr] = ok ? (s[rr] + bp[clampi(kcol - qcol + 15, 0, 30)]) * LOG2E : -1e30f; }
        } else {
          const bf16_t* kp = Kc + (16 * (kt - 16) + ll) * NKC + gg * 8;
          s = mfma16(*(const bf16x8*)kp, q0, (f32x4){0.f, 0.f, 0.f, 0.f}); s = mfma16(*(const bf16x8*)(kp + 32), q1, s);
          s = s * LOG2E;
        }
        S[kt] = s;
        if ((kt & 7) == 7) asm volatile("" ::: "memory");
      }
      float mx = S[0][0];
#pragma unroll
      for (int kt = 0; kt < 32; ++kt) mx = fmaxf(fmaxf(fmaxf(mx, S[kt][0]), fmaxf(S[kt][1], S[kt][2])), S[kt][3]);
      mx = fmaxf(mx, __shfl_xor(mx, 16)); mx = fmaxf(mx, __shfl_xor(mx, 32));
      float ls = 0.f;
#pragma unroll
      for (int kt = 0; kt < 32; ++kt)
#pragma unroll
        for (int rr = 0; rr < 4; ++rr) { S[kt][rr] = __builtin_amdgcn_exp2f(S[kt][rr] - mx); ls += S[kt][rr]; }
      ls += __shfl_xor(ls, 16); ls += __shfl_xor(ls, 32);
      bf16x8 pf[16];
#pragma unroll
      for (int kk = 0; kk < 16; ++kk) pf[kk] = pack8(S[2 * kk][0], S[2 * kk][1], S[2 * kk][2], S[2 * kk][3], S[2 * kk + 1][0], S[2 * kk + 1][1], S[2 * kk + 1][2], S[2 * kk + 1][3]);
#pragma unroll
      for (int i = 0; i < 9; ++i) { const int e = tt + NTHR * i, d = e / 72, pc = e - d * 72; rw[i] = *(const u32x4*)(vbase + (size_t)d * PB + rs0 * 64 + pc * 8); }
      __syncthreads();
#pragma unroll
      for (int i = 0; i < 9; ++i) { const int e = tt + NTHR * i, d = e / 72, pc = e - d * 72; *(u32x4*)(W + d * NWV + pc * 8) = rw[i]; }
      __syncthreads();
      f32x4 O[4];
#pragma unroll
      for (int dt = 0; dt < 4; ++dt) O[dt] = (f32x4){0.f, 0.f, 0.f, 0.f};
#pragma unroll
      for (int kk = 0; kk < 16; ++kk) {
        if (kk < 8) {
#pragma unroll
          for (int dt = 0; dt < 4; ++dt) { const bf16_t* vp = W + (dt * 16 + ll) * NWV + (dr + kk) * 64 + band0 + 4 * gg; const bf16x8 vf = cat44(*(const s16x4*)vp, *(const s16x4*)(vp + 16)); O[dt] = mfma16(vf, pf[kk], O[dt]); }
        } else {
#pragma unroll
          for (int dt = 0; dt < 4; ++dt) { const bf16_t* vp = Vc + (dt * 16 + ll) * NVC + 32 * (kk - 8) + 4 * gg; const bf16x8 vf = cat44(*(const s16x4*)vp, *(const s16x4*)(vp + 16)); O[dt] = mfma16(vf, pf[kk], O[dt]); }
        }
        if ((kk & 3) == 3) asm volatile("" ::: "memory");
      }
      const float inv = 1.f / ls; bf16_t* op = o + (tokbase + qpos) * 1024 + h * 64 + 4 * gg;
#pragma unroll
      for (int dt = 0; dt < 4; ++dt) st4bf(op + 16 * dt, O[dt] * inv);
    }
    if (w < 4) na_ctx_wave(Q, o, Kc, Vc, b, h, qtr * 4 + w, lane);
  }
}

template <int DK> struct ScanLds { static constexpr int QLD = DK + 8, TLD = 72;
  static constexpr int OFF_QD = 0, OFF_KD = OFF_QD + 64 * QLD * 2, OFF_VT = OFF_KD + 64 * QLD * 2, OFF_ATT = OFF_VT + 64 * TLD * 2, OFF_ST = OFF_ATT + 64 * TLD * 2, OFF_EB = OFF_ST + 64 * QLD * 2, OFF_QS = OFF_EB + DK * 4, TOTAL = OFF_QS + 8 * DK * 4; };
DI int scan_pos(int dir, int i, int tl) { if (dir == 0) return i * 64 + tl; return i < 4 ? 255 - (i * 64 + tl) : 8447 - ((i - 4) * 64 + tl); }
DI bf16x8 gather8(const bf16_t* p, int stride) {
  const unsigned a0 = p[0], a1 = p[stride], a2 = p[2 * stride], a3 = p[3 * stride], a4 = p[4 * stride], a5 = p[5 * stride], a6 = p[6 * stride], a7 = p[7 * stride];
  u32x4 r; r.x = a0 | (a1 << 16); r.y = a2 | (a3 << 16); r.z = a4 | (a5 << 16); r.w = a6 | (a7 << 16); return __builtin_bit_cast(bf16x8, r);
}

template <int DK, bool HG>
DI void scan_phase(const Params& p, char* lds) {
  typedef ScanLds<DK> L;
  bf16_t* Qd = (bf16_t*)(lds + L::OFF_QD); bf16_t* Kd = (bf16_t*)(lds + L::OFF_KD); bf16_t* Vt = (bf16_t*)(lds + L::OFF_VT);
  bf16_t* Att = (bf16_t*)(lds + L::OFF_ATT); bf16_t* St = (bf16_t*)(lds + L::OFF_ST); float* eb = (float*)(lds + L::OFF_EB); float* qs = (float*)(lds + L::OFF_QS);
  constexpr int QLD = L::QLD, TLD = L::TLD, KT = DK / 16 / 8;
  const int tid = tid_(), lane = tid & 63, w = tid >> 6, g4 = lane >> 4, l16 = lane & 15;
  const int nitems = HG ? 128 : 256;
  const float* lbv = (const float*)(p.ws + OFF_LBV);
  for (int item = blockIdx.x; item < nitems; item += gridDim.x) {
    int b, h, sl, dir; if (HG) { sl = item & 1; h = (item >> 1) & 7; b = (item >> 4) & 3; dir = item >> 6; } else { sl = item & 7; h = (item >> 3) & 3; b = (item >> 5) & 3; dir = item >> 7; }
    const size_t tokbase = (size_t)b * PB;
    const bf16_t *qsrc, *ksrc, *vsrc; int ldq, ldv; bf16_t *octx, *olat; int ldo;
    if (HG) { const bf16_t* ph = (const bf16_t*)(p.ws + H_P); qsrc = ph + h * 128; ksrc = ph + 1024 + dir * 1024 + h * 128; vsrc = ph + 3072 + h * 128 + sl * 64; ldq = 5120; ldv = 5120; ldo = 1024;
      octx = (bf16_t*)(p.ws + (dir ? OFF_W0 : OFF_A)) + tokbase * 1024 + h * 128 + sl * 64; olat = octx + (size_t)LC * 1024; }
    else { const bf16_t* qk = (const bf16_t*)(p.ws + R_QK); qsrc = qk + h * 256; ksrc = qk + 1024 + h * 256; vsrc = (const bf16_t*)(p.ws + R_V) + h * 512 + sl * 64; ldq = 2048; ldv = 2048; ldo = 2048;
      if (dir == 0) { octx = (bf16_t*)(p.ws + R_O) + tokbase * 2048 + h * 512 + sl * 64; olat = octx + (size_t)LC * 2048; }
      else { octx = (bf16_t*)(p.ws + OFF_HCTX) + (size_t)b * LC * 2048 + h * 512 + sl * 64; olat = (bf16_t*)p.out + (size_t)b * LL * 2048 + h * 512 + sl * 64; } }
    float lg = 0.f; if (!HG) lg = -__expf(p.ret_decay[dir * 4 + h]);
    float lb0 = 0.f, lb1 = 0.f; if (HG) { lb0 = lbv[h * 128 + 2 * (tid & 63)]; lb1 = lbv[h * 128 + 2 * (tid & 63) + 1]; }
    f32x4 sacc[KT][4];
#pragma unroll
    for (int a = 0; a < KT; ++a)
#pragma unroll
      for (int v = 0; v < 4; ++v) sacc[a][v] = (f32x4){0.f, 0.f, 0.f, 0.f};
    u32x4 rq[4], rk[4], rvv; unsigned rf[8], rqq[8]; float bl[16], qv[16], kv[16];
    const int vtl = tid & 63, vvc = tid >> 6;
    auto issue = [&](int i) {
      if (HG) { const int kp = tid & 63, seg = tid >> 6;
#pragma unroll
        for (int j = 0; j < 8; ++j) { const size_t row = tokbase + scan_pos(dir, i, seg * 8 + j); rf[j] = *(const unsigned*)(ksrc + row * ldq + 2 * kp); rqq[j] = *(const unsigned*)(qsrc + row * ldq + 2 * kp); } }
      else {
#pragma unroll
        for (int it = 0; it < 4; ++it) { const int e = tid + NTHR * it, tl = e >> 5, kc = e & 31; const size_t row = tokbase + scan_pos(dir, i, tl); rq[it] = *(const u32x4*)(qsrc + row * ldq + kc * 8); rk[it] = *(const u32x4*)(ksrc + row * ldq + kc * 8); } }
      { const size_t row = tokbase + scan_pos(dir, i, vtl); rvv = *(const u32x4*)(vsrc + row * ldv + vvc * 8); }
    };
    auto prep = [&]() {
      const int kp = tid & 63, seg = tid >> 6; float run0 = 1.f, run1 = 1.f;
#pragma unroll
      for (int j = 0; j < 8; ++j) { const float f0 = bflo(rf[j]), f1 = bfhi(rf[j]); qv[2 * j] = bflo(rqq[j]); qv[2 * j + 1] = bfhi(rqq[j]);
        const float s0 = __builtin_amdgcn_rcpf(1.f + __expf(-f0)), s1 = __builtin_amdgcn_rcpf(1.f + __expf(-f1)); const float g0 = lb0 + (1.f - lb0) * s0, g1 = lb1 + (1.f - lb1) * s1;
        kv[2 * j] = 1.f - g0; kv[2 * j + 1] = 1.f - g1; run0 *= g0; run1 *= g1; bl[2 * j] = run0; bl[2 * j + 1] = run1; }
      qs[seg * DK + 2 * kp] = run0; qs[seg * DK + 2 * kp + 1] = run1;
    };
    __syncthreads();
    issue(0); if (HG) prep();
    __syncthreads();
    for (int i = 0; i < 132; ++i) {
      if (HG) { const int kp = tid & 63, seg = tid >> 6; float off0 = 1.f, off1 = 1.f;
#pragma unroll
        for (int q = 0; q < 7; ++q) if (q < seg) { off0 *= qs[q * DK + 2 * kp]; off1 *= qs[q * DK + 2 * kp + 1]; }
        if (seg == 7) { eb[2 * kp] = off0 * bl[14]; eb[2 * kp + 1] = off1 * bl[15]; }
#pragma unroll
        for (int j = 0; j < 8; ++j) { const int tl = seg * 8 + j; const float p0 = bl[2 * j] * off0, p1 = bl[2 * j + 1] * off1;
          *(unsigned*)(Qd + tl * QLD + 2 * kp) = pk2(qv[2 * j] * p0, qv[2 * j + 1] * p1);
          *(unsigned*)(Kd + tl * QLD + 2 * kp) = pk2(kv[2 * j] * __builtin_amdgcn_rcpf(p0), kv[2 * j + 1] * __builtin_amdgcn_rcpf(p1)); } }
      else {
        if (tid < DK) eb[tid] = __expf(64.f * lg);
#pragma unroll
        for (int it = 0; it < 4; ++it) { const int e = tid + NTHR * it, tl = e >> 5, kc = e & 31; const u32x4 qr = rq[it], kr = rk[it];
          const float eq = __expf((float)(tl + 1) * lg), ek = __expf(-(float)(tl + 1) * lg);
          u32x4 qo, ko; qo.x = pk2(bflo(qr.x) * eq, bfhi(qr.x) * eq); qo.y = pk2(bflo(qr.y) * eq, bfhi(qr.y) * eq); qo.z = pk2(bflo(qr.z) * eq, bfhi(qr.z) * eq); qo.w = pk2(bflo(qr.w) * eq, bfhi(qr.w) * eq);
          ko.x = pk2(bflo(kr.x) * ek, bfhi(kr.x) * ek); ko.y = pk2(bflo(kr.y) * ek, bfhi(kr.y) * ek); ko.z = pk2(bflo(kr.z) * ek, bfhi(kr.z) * ek); ko.w = pk2(bflo(kr.w) * ek, bfhi(kr.w) * ek);
          *(u32x4*)(Qd + tl * QLD + kc * 8) = qo; *(u32x4*)(Kd + tl * QLD + kc * 8) = ko; } }
      { bf16_t* vt = Vt + (vvc * 8) * TLD + vtl; const u32x4 vr = rvv;
        vt[0] = (bf16_t)(vr.x & 0xffff); vt[TLD] = (bf16_t)(vr.x >> 16); vt[2 * TLD] = (bf16_t)(vr.y & 0xffff); vt[3 * TLD] = (bf16_t)(vr.y >> 16);
        vt[4 * TLD] = (bf16_t)(vr.z & 0xffff); vt[5 * TLD] = (bf16_t)(vr.z >> 16); vt[6 * TLD] = (bf16_t)(vr.w & 0xffff); vt[7 * TLD] = (bf16_t)(vr.w >> 16); }
#pragma unroll
      for (int a = 0; a < KT; ++a) { const int ki = w * KT + a;
#pragma unroll
        for (int vi = 0; vi < 4; ++vi) st4bf(St + (16 * vi + l16) * QLD + 16 * ki + 4 * g4, sacc[a][vi]); }
      __syncthreads();
      if (i + 1 < 132) issue(i + 1);
#pragma unroll
      for (int u = 0; u < 2; ++u) { const int id = 2 * w + u, ti = id >> 2, si = id & 3; f32x4 d = (f32x4){0.f, 0.f, 0.f, 0.f};
        if (si <= ti) {
#pragma unroll
          for (int ks = 0; ks < DK / 32; ++ks) { const bf16x8 kf = *(const bf16x8*)(Kd + (16 * si + l16) * QLD + ks * 32 + g4 * 8), qf = *(const bf16x8*)(Qd + (16 * ti + l16) * QLD + ks * 32 + g4 * 8); d = mfma16(kf, qf, d); } }
        const int t = 16 * ti + l16, s0 = 16 * si + 4 * g4;
#pragma unroll
        for (int rr = 0; rr < 4; ++rr) if (s0 + rr > t) d[rr] = 0.f;
        st4bf(Att + t * TLD + s0, d); }
      __syncthreads();
#pragma unroll
      for (int u = 0; u < 2; ++u) { const int id = 2 * w + u, vi = id >> 2, ti = id & 3; f32x4 d = (f32x4){0.f, 0.f, 0.f, 0.f};
#pragma unroll
        for (int ks = 0; ks < 2; ++ks) { const bf16x8 xf = *(const bf16x8*)(Vt + (16 * vi + l16) * TLD + ks * 32 + g4 * 8), yf = *(const bf16x8*)(Att + (16 * ti + l16) * TLD + ks * 32 + g4 * 8); d = mfma16(xf, yf, d); }
#pragma unroll
        for (int ks = 0; ks < DK / 32; ++ks) { const bf16x8 xf = *(const bf16x8*)(St + (16 * vi + l16) * QLD + ks * 32 + g4 * 8), yf = *(const bf16x8*)(Qd + (16 * ti + l16) * QLD + ks * 32 + g4 * 8); d = mfma16(xf, yf, d); }
        const int pos = scan_pos(dir, i, 16 * ti + l16); bf16_t* op = (pos < LC ? octx + (size_t)pos * ldo : olat + (size_t)(pos - LC) * ldo) + 16 * vi + 4 * g4;
        st4bf(op, d); }
#pragma unroll
      for (int a = 0; a < KT; ++a) { const int ki = w * KT + a;
#pragma unroll
        for (int ks = 0; ks < 2; ++ks) { const bf16x8 xf = gather8(Kd + (ks * 32 + g4 * 8) * QLD + 16 * ki + l16, QLD);
#pragma unroll
          for (int vi = 0; vi < 4; ++vi) { const bf16x8 yf = *(const bf16x8*)(Vt + (16 * vi + l16) * TLD + ks * 32 + g4 * 8); sacc[a][vi] = mfma16(xf, yf, sacc[a][vi]); } }
        const f32x4 e4 = *(const f32x4*)(eb + 16 * ki + 4 * g4);
#pragma unroll
        for (int vi = 0; vi < 4; ++vi) sacc[a][vi] = sacc[a][vi] * e4; }
      if (HG && i + 1 < 132) prep();
      __syncthreads();
    }
  }
}

DI float bsum2(unsigned a, unsigned b, float& lo, float& hi) { lo = bflo(a) + bflo(b); hi = bfhi(a) + bfhi(b); return lo * lo + hi * hi; }
DI void ret_readout_phase(const Params& p) {
  bf16_t* O = (bf16_t*)(p.ws + R_O); const bf16_t* G = (const bf16_t*)(p.ws + R_QK);
  const int tid = threadIdx.x, lane = tid & 63, gw = blockIdx.x * 8 + (tid >> 6), nw = gridDim.x * 8;
  for (int t = gw; t < T_ALL; t += nw) {
    const int b = t / PB, pp = t - b * PB;
    const bf16_t* ob = (pp < LC ? (const bf16_t*)(p.ws + OFF_HCTX) + (size_t)(b * LC + pp) * 2048 : (const bf16_t*)p.out + (size_t)(b * LL + pp - LC) * 2048) + lane * 32;
    bf16_t* op = O + (size_t)t * 2048 + lane * 32; const bf16_t* gp = G + (size_t)t * 2048 + lane * 32;
    float ov[32]; u32x4 gv[4]; float sq = 0.f;
#pragma unroll
    for (int i = 0; i < 4; ++i) { const u32x4 x = *(const u32x4*)(op + i * 8), y = *(const u32x4*)(ob + i * 8); gv[i] = *(const u32x4*)(gp + i * 8);
      sq += bsum2(x.x, y.x, ov[8 * i], ov[8 * i + 1]) + bsum2(x.y, y.y, ov[8 * i + 2], ov[8 * i + 3]) + bsum2(x.z, y.z, ov[8 * i + 4], ov[8 * i + 5]) + bsum2(x.w, y.w, ov[8 * i + 6], ov[8 * i + 7]); }
    sq += __shfl_xor(sq, 1); sq += __shfl_xor(sq, 2); sq += __shfl_xor(sq, 4); sq += __shfl_xor(sq, 8);
    const float rstd = rsqrtf(sq * (1.f / 512.f) + 1e-6f);
#pragma unroll
    for (int i = 0; i < 4; ++i) { u32x4 r;
      r.x = pk2(siluf(bflo(gv[i].x)) * ov[8 * i] * rstd, siluf(bfhi(gv[i].x)) * ov[8 * i + 1] * rstd); r.y = pk2(siluf(bflo(gv[i].y)) * ov[8 * i + 2] * rstd, siluf(bfhi(gv[i].y)) * ov[8 * i + 3] * rstd);
      r.z = pk2(siluf(bflo(gv[i].z)) * ov[8 * i + 4] * rstd, siluf(bfhi(gv[i].z)) * ov[8 * i + 5] * rstd); r.w = pk2(siluf(bflo(gv[i].w)) * ov[8 * i + 6] * rstd, siluf(bfhi(gv[i].w)) * ov[8 * i + 7] * rstd);
      *(u32x4*)(op + i * 8) = r; }
  }
}
DI void hg_readout_phase(const Params& p) {
  bf16_t* O = (bf16_t*)(p.ws + OFF_A); const bf16_t* OB = (const bf16_t*)(p.ws + OFF_W0); const bf16_t* ph = (const bf16_t*)(p.ws + H_P);
  const int tid = threadIdx.x, lane = tid & 63, gw = blockIdx.x * 8 + (tid >> 6), nw = gridDim.x * 8;
  for (int t = gw; t < T_ALL; t += nw) {
    bf16_t* op = O + (size_t)t * 1024 + lane * 16; const bf16_t* ob = OB + (size_t)t * 1024 + lane * 16; const bf16_t* gp = ph + (size_t)t * 5120 + 4096 + lane * 16; const float* ng = p.hg_norm_g + (lane & 7) * 16;
    float ov[16]; u32x4 gv[2]; float sq = 0.f;
#pragma unroll
    for (int i = 0; i < 2; ++i) { const u32x4 x = *(const u32x4*)(op + i * 8), y = *(const u32x4*)(ob + i * 8); gv[i] = *(const u32x4*)(gp + i * 8);
      sq += bsum2(x.x, y.x, ov[8 * i], ov[8 * i + 1]) + bsum2(x.y, y.y, ov[8 * i + 2], ov[8 * i + 3]) + bsum2(x.z, y.z, ov[8 * i + 4], ov[8 * i + 5]) + bsum2(x.w, y.w, ov[8 * i + 6], ov[8 * i + 7]); }
    sq += __shfl_xor(sq, 1); sq += __shfl_xor(sq, 2); sq += __shfl_xor(sq, 4);
    const float rstd = rsqrtf(sq * (1.f / 128.f) + 1e-6f);
#pragma unroll
    for (int i = 0; i < 2; ++i) { u32x4 r; const float* n8 = ng + i * 8;
      r.x = pk2(siluf(bflo(gv[i].x)) * ov[8 * i] * rstd * n8[0], siluf(bfhi(gv[i].x)) * ov[8 * i + 1] * rstd * n8[1]); r.y = pk2(siluf(bflo(gv[i].y)) * ov[8 * i + 2] * rstd * n8[2], siluf(bfhi(gv[i].y)) * ov[8 * i + 3] * rstd * n8[3]);
      r.z = pk2(siluf(bflo(gv[i].z)) * ov[8 * i + 4] * rstd * n8[4], siluf(bfhi(gv[i].z)) * ov[8 * i + 5] * rstd * n8[5]); r.w = pk2(siluf(bflo(gv[i].w)) * ov[8 * i + 6] * rstd * n8[6], siluf(bfhi(gv[i].w)) * ov[8 * i + 7] * rstd * n8[7]);
      *(u32x4*)(op + i * 8) = r; }
  }
}

#define XB_TMO      128
#define XB_XCNT(j)  (256  + 64 * (j))
#define XB_XSUB(j)  (1280 + 64 * (j))
#define XB_XGEN(j)  (2304 + 64 * (j))
#define XB_TOP      3328
#define XB_TOPGEN   3392
#define XCD_BAR_WORDS 3456
#define XB_SPIN_CAP (1u << 23)
#define LAS PG8_LAS

__device__ __forceinline__ unsigned xb_ld(unsigned* p)              { return __hip_atomic_load(p, __ATOMIC_RELAXED, __HIP_MEMORY_SCOPE_AGENT); }
__device__ __forceinline__ unsigned xb_add(unsigned* p, unsigned v) { return __hip_atomic_fetch_add(p, v, __ATOMIC_RELAXED, __HIP_MEMORY_SCOPE_AGENT); }
__device__ __forceinline__ unsigned xb_xcc_id() { return (unsigned)__builtin_amdgcn_s_getreg((3 << 11) | 20) & 0xFu; }
#define XB_SPIN(cond, bar) do { unsigned _sp = 0; while (cond) { __builtin_amdgcn_s_sleep(1); \
    if ((++_sp & 255u) == 0u) { if (xb_ld(&(bar)[XB_TMO])) break; if (_sp > XB_SPIN_CAP) { atomicAdd(&(bar)[XB_TMO], 1u); break; } } } } while (0)

struct XcdBarrier {
    unsigned* bar; unsigned x;
    volatile LAS unsigned* st;
};

__device__ __forceinline__ XcdBarrier xcd_barrier_post(unsigned* bar, volatile LAS unsigned* st) {
    XcdBarrier b; b.bar = bar; b.x = xb_xcc_id(); b.st = st;
    if (threadIdx.x == 0) (void)xb_add(&bar[XB_XCNT(b.x)], 1u);
    return b;
}
__device__ __forceinline__ void xcd_barrier_complete(unsigned* bar, unsigned x, unsigned& nloc, unsigned& nx) {
    const unsigned G = gridDim.x * gridDim.y * gridDim.z;
    unsigned sum, cnt, mine, sp = 0u;
    for (;;) {
        sum = 0u; cnt = 0u; mine = 0u;
#pragma unroll
        for (unsigned j = 0; j < 16; ++j) { const unsigned c = xb_ld(&bar[XB_XCNT(j)]); sum += c; cnt += (c > 0u) ? 1u : 0u; mine = (j == x) ? c : mine; }
        if (sum == G) break;
        __builtin_amdgcn_s_sleep(1);
        if ((++sp & 255u) == 0u) { if (xb_ld(&bar[XB_TMO])) break; if (sp > XB_SPIN_CAP) { atomicAdd(&bar[XB_TMO], 1u); break; } }
    }
    nloc = mine > 0u ? mine : 1u; nx = cnt > 0u ? cnt : 1u;
}

__device__ __forceinline__ void xcd_barrier(const XcdBarrier& b) {
    asm volatile("s_waitcnt vmcnt(0)" ::: "memory");
    __syncthreads();
    if (threadIdx.x == 0) {
        unsigned* bar = b.bar;
        __builtin_amdgcn_s_waitcnt(0);
        unsigned nloc = b.st[0], nx = b.st[1];
        if (nloc == 0u) { xcd_barrier_complete(bar, b.x, nloc, nx); b.st[0] = nloc; b.st[1] = nx; }
        const unsigned old = xb_add(&bar[XB_XSUB(b.x)], 1u);
        const unsigned gen = old / nloc;
        if (old + 1u == (gen + 1u) * nloc) {
            __builtin_amdgcn_fence(__ATOMIC_RELEASE, "agent");
            asm volatile("s_waitcnt vmcnt(0)" ::: "memory");
            const unsigned og = xb_add(&bar[XB_TOP], 1u);
            const unsigned tg = og / nx;
            if (og + 1u == (tg + 1u) * nx) xb_add(&bar[XB_TOPGEN], 1u);
            else XB_SPIN(xb_ld(&bar[XB_TOPGEN]) == tg, bar);
            __builtin_amdgcn_fence(__ATOMIC_ACQUIRE, "agent");
            xb_add(&bar[XB_XGEN(b.x)], 1u);
            asm volatile("s_waitcnt vmcnt(0)" ::: "memory");
        } else {
            XB_SPIN(xb_ld(&bar[XB_XGEN(b.x)]) == gen, bar);
            __builtin_amdgcn_fence(__ATOMIC_ACQUIRE, "agent");
            asm volatile("s_waitcnt vmcnt(0)" ::: "memory");
        }
    }
    __syncthreads();
}

constexpr int LDS_BYTES0 = ScanLds<256>::TOTAL > pg8::STAGE_BYTES ? ScanLds<256>::TOTAL : pg8::STAGE_BYTES;
constexpr int LDS_BYTES = LDS_BYTES0 > NA_LDS ? LDS_BYTES0 : NA_LDS;
static_assert(LDS_BYTES <= 163840, "LDS");
static_assert(LDS_BYTES >= (256 + 128) * LDT * 2 && LDS_BYTES >= 3 * 64 * (KLD + VLD) * 2 && LDS_BYTES >= (5120 + 8 * 5 * 64) * 4, "LDS phases");

DI void ffn_and_ln(const Params& p, const XcdBarrier& xb, char* lds, int layer, const bf16_t* w13, const bf16_t* w2) {
  const float* mods = (const float*)(p.ws + OFF_MODS); float* hctx = (float*)(p.ws + OFF_HCTX); bf16_t* a = (bf16_t*)(p.ws + OFF_A); bf16_t* U = (bf16_t*)(p.ws + F_U);
  { EpiSwiglu e{U}; big_gemm(a, w13, T_ALL, 5632, 1024, e, lds, layer == 3); }
  xcd_barrier(xb);
  { EpiResid e{p.out, hctx, p.out, hctx, mods + (size_t)layer * 5 * 6144 + 5 * 1024, (const float2*)(p.ws + OFF_LNS), p.ln_g + (size_t)(layer * 2) * 1024, p.ln_b + (size_t)(layer * 2) * 1024}; big_gemm(U, w2, T_ALL, 1024, FF, e, lds, layer == 3); }
  xcd_barrier(xb);
  ln_phase(p, layer, 1, layer < 3 ? layer + 1 : 3, 0, layer == 3);
  xcd_barrier(xb);
}

__global__ void __launch_bounds__(NTHR) mega(Params p) {
  __shared__ __attribute__((aligned(16))) char lds[LDS_BYTES];
  cg::grid_group grid = cg::this_grid();
  __shared__ uint4 xb_words;
  if (threadIdx.x == 0) xb_words = make_uint4(0u, 0u, 0u, 0u);
  __syncthreads();
  const XcdBarrier xb = xcd_barrier_post((unsigned*)(p.ws + OFF_BAR), (volatile LAS unsigned*)&xb_words);
  float* ldsf = (float*)lds;
  const float* mods = (const float*)(p.ws + OFF_MODS); float* hctx = (float*)(p.ws + OFF_HCTX); bf16_t* a = (bf16_t*)(p.ws + OFF_A);
  const float2* tabR = (const float2*)(p.ws + OFF_TABR); const float2* tabM = (const float2*)(p.ws + OFF_TABM); float* rs = (float*)(p.ws + OFF_RS);
  ada_phase(p, ldsf);
  tables_phase(p);
  convert_w<2>(p.ret_w_in, 6144, 1024, (bf16_t*)(p.ws + W0_RETIN), 6144, nullptr, ldsf);
  convert_w<0>(p.ret_w_out, 1024, 2048, (bf16_t*)(p.ws + W0_RETOUT), 1024, nullptr, ldsf);
  convert_w<1>(p.w13, 5632, 1024, (bf16_t*)(p.ws + W0_W13), 5632, nullptr, ldsf);
  convert_w<0>(p.w2, 1024, FF, (bf16_t*)(p.ws + W0_W2), 1024, nullptr, ldsf);
  grid.sync();
  modulate_phase(p, p.x, p.ctx, 0);
  xcd_barrier(xb);
  { const bf16_t* wi = (const bf16_t*)(p.ws + W0_RETIN);
    { EpiRetQK e{(bf16_t*)(p.ws + R_QK), tabR}; big_gemm(a, wi, T_ALL, 2048, 1024, e, lds); }
    { EpiStore e{(bf16_t*)(p.ws + R_V), (bf16_t*)(p.ws + R_V), 1 << 30, 2048, 2048, 1.f}; big_gemm(a, wi + (size_t)2048 * 1024, T_ALL, 2048, 1024, e, lds); }
    xcd_barrier(xb);
    scan_phase<256, false>(p, lds);
    xcd_barrier(xb);
    { EpiStore e{(bf16_t*)(p.ws + R_QK), (bf16_t*)(p.ws + R_QK), 1 << 30, 2048, 2048, 1.f}; big_gemm(a, wi + (size_t)4096 * 1024, T_ALL, 2048, 1024, e, lds); }
    xcd_barrier(xb);
    ret_readout_phase(p);
    xcd_barrier(xb);
    { EpiResid e{p.x, p.ctx, p.out, hctx, mods + 2 * 1024, nullptr, nullptr, nullptr}; big_gemm((const bf16_t*)(p.ws + R_O), (const bf16_t*)(p.ws + W0_RETOUT), T_ALL, 1024, 2048, e, lds); }
    xcd_barrier(xb);
    ln_phase(p, 0, 0, 0, 3, false);
    convert_w<0>(p.na_w_qkv, 3072, 1024, (bf16_t*)(p.ws + W1_QKV), 3072, nullptr, ldsf);
    convert_w<0>(p.na_w_out, 1024, 1024, (bf16_t*)(p.ws + W1_OUT), 1024, nullptr, ldsf);
    convert_w<1>(p.w13 + (size_t)1 * 1024 * 5632, 5632, 1024, (bf16_t*)(p.ws + W1_W13), 5632, nullptr, ldsf);
    convert_w<0>(p.w2 + (size_t)1 * FF * 1024, 1024, FF, (bf16_t*)(p.ws + W1_W2), 1024, nullptr, ldsf);
    convert_w<5>(p.mla_w_down, 800, 1024, (bf16_t*)(p.ws + W2_DOWN), 1024, nullptr, ldsf);
    convert_w<3>(p.mla_w_uq, 1536, 512, (bf16_t*)(p.ws + W2_UQ), 1536, p.mla_q_norm, ldsf);
    convert_w<4>(p.mla_w_ukv, 2048, 256, (bf16_t*)(p.ws + W2_UKV), 2048, p.mla_kv_norm, ldsf);
    convert_w<0>(p.mla_w_out, 1024, 1024, (bf16_t*)(p.ws + W2_OUT), 1024, nullptr, ldsf);
    convert_w<1>(p.w13 + (size_t)2 * 1024 * 5632, 5632, 1024, (bf16_t*)(p.ws + W2_W13), 5632, nullptr, ldsf);
    convert_w<0>(p.w2 + (size_t)2 * FF * 1024, 1024, FF, (bf16_t*)(p.ws + W2_W2), 1024, nullptr, ldsf);
    convert_w<0>(p.hg_w_in, 5120, 1024, (bf16_t*)(p.ws + W3_IN), 5120, nullptr, ldsf);
    convert_w<0>(p.hg_w_out, 1024, 1024, (bf16_t*)(p.ws + W3_OUT), 1024, nullptr, ldsf);
    convert_w<1>(p.w13 + (size_t)3 * 1024 * 5632, 5632, 1024, (bf16_t*)(p.ws + W3_W13), 5632, nullptr, ldsf);
    convert_w<0>(p.w2 + (size_t)3 * FF * 1024, 1024, FF, (bf16_t*)(p.ws + W3_W2), 1024, nullptr, ldsf);
    xcd_barrier(xb);
    ffn_and_ln(p, xb, lds, 0, (const bf16_t*)(p.ws + W0_W13), (const bf16_t*)(p.ws + W0_W2));
  }
  { const bf16_t* wq = (const bf16_t*)(p.ws + W1_QKV);
    { EpiStore e{(bf16_t*)(p.ws + N_Q), (bf16_t*)(p.ws + N_K), 1024, 1024, 1024, 0.125f}; big_gemm(a, wq, T_ALL, 2048, 1024, e, lds); }
    { GemmArgs g{a, 1024, wq + (size_t)2048 * 1024, 1024, T_ALL, 1024, 1024}; EpiVT e{(bf16_t*)(p.ws + N_VT), nullptr}; gemm_phase<true>(g, e, lds); }
    xcd_barrier(xb);
    na_attn_phase(p, lds);
    xcd_barrier(xb);
    { EpiResid e{p.out, hctx, p.out, hctx, mods + (size_t)1 * 5 * 6144 + 2 * 1024, (const float2*)(p.ws + OFF_LNS), p.ln_g + (size_t)(0 * 2 + 1) * 1024, p.ln_b + (size_t)(0 * 2 + 1) * 1024}; big_gemm(a, (const bf16_t*)(p.ws + W1_OUT), T_ALL, 1024, 1024, e, lds); }
    xcd_barrier(xb);
    ln_phase(p, 1, 0, 1, 3, false);
    xcd_barrier(xb);
    ffn_and_ln(p, xb, lds, 1, (const bf16_t*)(p.ws + W1_W13), (const bf16_t*)(p.ws + W1_W2));
  }
  { const bf16_t* d0 = (const bf16_t*)(p.ws + M_D0);
    { EpiStore e{(bf16_t*)(p.ws + M_D0), (bf16_t*)(p.ws + M_D0), 1 << 30, 1024, 1024, 1.f}; big_gemm(a, (const bf16_t*)(p.ws + W2_DOWN), T_ALL, 1024, 1024, e, lds); }
    xcd_barrier(xb);
    mla_stats_phase(p);
    xcd_barrier(xb);
    { GemmArgs g{d0, 1024, (const bf16_t*)(p.ws + W2_UQ), 512, T_ALL, 1536, 512}; EpiMlaQ e{(bf16_t*)(p.ws + M_Q), rs, tabM}; gemm_phase<false>(g, e, lds); }
    { GemmArgs g{d0 + 512, 1024, (const bf16_t*)(p.ws + W2_UKV), 256, T_ALL, 1024, 256}; EpiMlaK e{(bf16_t*)(p.ws + M_K), rs}; gemm_phase<false>(g, e, lds); }
    { GemmArgs g{d0 + 512, 1024, (const bf16_t*)(p.ws + W2_UKV) + (size_t)1024 * 256, 256, T_ALL, 1024, 256}; EpiVT e{(bf16_t*)(p.ws + M_VT), rs}; gemm_phase<true>(g, e, lds); }
    xcd_barrier(xb);
    mla_attn_phase(p, lds);
    xcd_barrier(xb);
    { EpiResid e{p.out, hctx, p.out, hctx, mods + (size_t)2 * 5 * 6144 + 2 * 1024, (const float2*)(p.ws + OFF_LNS), p.ln_g + (size_t)(1 * 2 + 1) * 1024, p.ln_b + (size_t)(1 * 2 + 1) * 1024}; big_gemm(a, (const bf16_t*)(p.ws + W2_OUT), T_ALL, 1024, 1024, e, lds); }
    xcd_barrier(xb);
    ln_phase(p, 2, 0, 2, 3, false);
    xcd_barrier(xb);
    ffn_and_ln(p, xb, lds, 2, (const bf16_t*)(p.ws + W2_W13), (const bf16_t*)(p.ws + W2_W2));
  }
  { { EpiHg e{(bf16_t*)(p.ws + H_P)}; big_gemm(a, (const bf16_t*)(p.ws + W3_IN), T_ALL, 5120, 1024, e, lds); }
    xcd_barrier(xb);
    scan_phase<128, true>(p, lds);
    xcd_barrier(xb);
    hg_readout_phase(p);
    xcd_barrier(xb);
    { EpiResid e{p.out, hctx, p.out, hctx, mods + (size_t)3 * 5 * 6144 + 2 * 1024, (const float2*)(p.ws + OFF_LNS), p.ln_g + (size_t)(2 * 2 + 1) * 1024, p.ln_b + (size_t)(2 * 2 + 1) * 1024}; big_gemm(a, (const bf16_t*)(p.ws + W3_OUT), T_ALL, 1024, 1024, e, lds, 1); }
    xcd_barrier(xb);
    ln_phase(p, 3, 0, 3, 3, false);
    xcd_barrier(xb);
    ffn_and_ln(p, xb, lds, 3, (const bf16_t*)(p.ws + W3_W13), (const bf16_t*)(p.ws + W3_W2));
  }
}

extern "C" void kernel_launch(void* const* d_in, const int* in_sizes, int n_in, void* d_out, int out_size, void* d_ws, size_t ws_size, hipStream_t stream) {
  static int grid_blocks = 0;
  if (!grid_blocks) {
    int dev = 0, cus = 0, per_cu = 0;
    (void)hipGetDevice(&dev);
    (void)hipDeviceGetAttribute(&cus, hipDeviceAttributeMultiprocessorCount, dev);
    (void)hipOccupancyMaxActiveBlocksPerMultiprocessor(&per_cu, mega, NTHR, 0);
    if (per_cu != 1) per_cu = 1;
    grid_blocks = cus * per_cu;
  }
  if (ws_size < WS_NEED) { fprintf(stderr, "workspace too small: %zu\n", ws_size); return; }
  Params p{};
  const float** f = (const float**)&p;
  for (int i = 0; i < 26; ++i) f[i] = (const float*)d_in[i];
  p.out = (float*)d_out; p.ws = (char*)d_ws;
  (void)hipMemsetAsync((char*)d_ws + OFF_BAR, 0, XCD_BAR_WORDS * 4, stream);
  void* args[] = {&p};
  hipError_t e = hipLaunchCooperativeKernel((void*)mega, dim3(grid_blocks), dim3(NTHR), args, 0, stream);
  if (e != hipSuccess) fprintf(stderr, "cooperative launch failed: %s (grid %d)\n", hipGetErrorString(e), grid_blocks);
}
```

```cpp
#include <hip/hip_runtime.h>
#include <hip/hip_cooperative_groups.h>
#include <cstdio>
#include <cstdint>
namespace cg = cooperative_groups;

#define DI __device__ __forceinline__
DI int tid_() { int t = threadIdx.x; asm volatile("" : "+v"(t)); return t; }
typedef unsigned short bf16_t;
typedef short bf16x8 __attribute__((ext_vector_type(8)));
typedef short s16x4 __attribute__((ext_vector_type(4)));
typedef float f32x4 __attribute__((ext_vector_type(4)));
typedef float f32x16 __attribute__((ext_vector_type(16)));
typedef unsigned u32x4 __attribute__((ext_vector_type(4)));
typedef unsigned u32x2 __attribute__((ext_vector_type(2)));

constexpr int NTHR = 512;
constexpr int T_ALL = 33792, PB = 8448, LC = 256, LL = 8192, DM = 1024, FF = 2816;
constexpr float ALPHA = 1.681792830507429f;
constexpr float LOG2E = 1.4426950408889634f;
constexpr size_t MiB = 1048576;

struct Params {
  const float *x, *c, *ctx, *cctx, *ada_w, *ada_b, *ln_g, *ln_b, *w13, *w2;
  const float *ret_w_in, *ret_decay, *ret_w_out, *na_w_qkv, *na_rpb, *na_w_out;
  const float *mla_w_down, *mla_q_norm, *mla_kv_norm, *mla_w_uq, *mla_w_ukv, *mla_w_out;
  const float *hg_w_in, *hg_lb, *hg_norm_g, *hg_w_out;
  float* out; char* ws;
};

constexpr size_t OFF_MODS = 0;
constexpr size_t OFF_TABR = 512 * 1024;
constexpr size_t OFF_TABM = OFF_TABR + 65536;
constexpr size_t OFF_LBV = OFF_TABM + 8192;
constexpr size_t OFF_RS = OFF_LBV + 4096;
constexpr size_t OFF_BAR = 896 * 1024;
constexpr size_t OFF_HCTX = 1 * MiB;
constexpr size_t OFF_A = 5 * MiB;
constexpr size_t OFF_W0 = 71 * MiB;
constexpr size_t OFF_BIG = 104 * MiB;
constexpr size_t OFF_WR = OFF_BIG;
constexpr size_t OFF_S = 180 * MiB;
constexpr size_t WS_NEED = 512 * MiB;
constexpr size_t OFF_LNS = 510 * MiB;
constexpr size_t W0_RETIN = OFF_W0, W0_RETOUT = W0_RETIN + (size_t)6144 * 1024 * 2, W0_W13 = W0_RETOUT + (size_t)1024 * 2048 * 2, W0_W2 = W0_W13 + (size_t)5632 * 1024 * 2;
constexpr size_t SZ_W13 = (size_t)5632 * 1024 * 2, SZ_W2 = (size_t)1024 * 2816 * 2, SZ_SQ = (size_t)1024 * 1024 * 2;
constexpr size_t W1_QKV = OFF_WR, W1_OUT = W1_QKV + (size_t)3072 * 1024 * 2, W1_W13 = W1_OUT + SZ_SQ, W1_W2 = W1_W13 + SZ_W13;
constexpr size_t W2_DOWN = W1_W2 + SZ_W2, W2_UQ = W2_DOWN + (size_t)1024 * 1024 * 2, W2_UKV = W2_UQ + (size_t)1536 * 512 * 2, W2_OUT = W2_UKV + (size_t)2048 * 256 * 2, W2_W13 = W2_OUT + SZ_SQ, W2_W2 = W2_W13 + SZ_W13;
constexpr size_t W3_IN = W2_W2 + SZ_W2, W3_OUT = W3_IN + (size_t)5120 * 1024 * 2, W3_W13 = W3_OUT + SZ_SQ, W3_W2 = W3_W13 + SZ_W13, W3_END = W3_W2 + SZ_W2;
static_assert(W3_END <= OFF_S, "rest weights overflow");
static_assert(W0_W2 + SZ_W2 <= OFF_BIG, "W0 overflow");
constexpr size_t SZ_T2048 = (size_t)T_ALL * 2048 * 2, SZ_T1024 = (size_t)T_ALL * 1024 * 2;
constexpr size_t R_QK = OFF_BIG, R_V = R_QK + SZ_T2048, R_O = R_V + SZ_T2048;
static_assert(R_O + SZ_T2048 <= WS_NEED, "retention overflow");
constexpr size_t N_Q = OFF_S, N_K = N_Q + SZ_T1024, N_VT = N_K + SZ_T1024;
constexpr size_t M_D0 = OFF_S, M_Q = M_D0 + (size_t)T_ALL * 1024 * 2, M_K = M_Q + (size_t)T_ALL * 1536 * 2, M_VT = M_K + (size_t)T_ALL * 1536 * 2;
static_assert(M_VT + SZ_T1024 <= WS_NEED, "mla overflow");
constexpr size_t H_P = OFF_S;
static_assert(H_P + (size_t)T_ALL * 5120 * 2 <= WS_NEED, "hgrn overflow");
constexpr size_t F_U = OFF_S;

typedef float f32x2 __attribute__((ext_vector_type(2)));
typedef __bf16 bf16x2_t __attribute__((ext_vector_type(2)));
DI unsigned pk2(float lo, float hi) { const f32x2 v = {lo, hi}; const bf16x2_t r = __builtin_convertvector(v, bf16x2_t); return __builtin_bit_cast(unsigned, r); }
DI float bflo(unsigned u) { return __uint_as_float(u << 16); }
DI float bfhi(unsigned u) { return __uint_as_float(u & 0xffff0000u); }
DI float bf2f(bf16_t v) { return __uint_as_float(((unsigned)v) << 16); }
DI bf16_t f2bf(float x) { return (bf16_t)(pk2(x, 0.f) & 0xffffu); }
DI float siluf(float x) { return x / (1.f + __expf(-x)); }
DI f32x4 mfma16(bf16x8 a, bf16x8 b, f32x4 c) { return __builtin_amdgcn_mfma_f32_16x16x32_bf16(a, b, c, 0, 0, 0); }
DI f32x16 mfma32(bf16x8 a, bf16x8 b, f32x16 c) { return __builtin_amdgcn_mfma_f32_32x32x16_bf16(a, b, c, 0, 0, 0); }
DI bf16x8 cat44(s16x4 lo, s16x4 hi) { return __builtin_shufflevector(lo, hi, 0, 1, 2, 3, 4, 5, 6, 7); }
DI bf16x8 pack8(float a0, float a1, float a2, float a3, float a4, float a5, float a6, float a7) {
  u32x4 p; p.x = pk2(a0, a1); p.y = pk2(a2, a3); p.z = pk2(a4, a5); p.w = pk2(a6, a7); return __builtin_bit_cast(bf16x8, p);
}
DI int clampi(int v, int lo, int hi) { return v < lo ? lo : (v > hi ? hi : v); }
DI float* hrow(float* hlat, float* hctx, int t) { const int b = t / PB, p = t - b * PB; return p < LC ? hctx + (size_t)(b * LC + p) * DM : hlat + (size_t)(b * LL + p - LC) * DM; }
DI const float* hrowc(const float* hlat, const float* hctx, int t) { const int b = t / PB, p = t - b * PB; return p < LC ? hctx + (size_t)(b * LC + p) * DM : hlat + (size_t)(b * LL + p - LC) * DM; }
DI int modvec(int t) { const int b = t / PB, p = t - b * PB; return p < LC ? 4 : b; }

template <int MODE> DI int srccol(int n) {
  if (MODE == 0) return n;
  if (MODE == 1) { const int c = n >> 5, s = (n >> 4) & 1, i = n & 15; return s * FF + 16 * c + i; }
  if (MODE == 2) { if (n >= 2048) return n; const int w = n & 255, j = w >> 1, s = w & 1; return (n & ~255) + s * 128 + j; }
  if (MODE == 3) { const int h = n / 96, w = n - h * 96; if (w < 64) return n; const int wp = w - 64, j = wp >> 1, s = wp & 1; return h * 96 + 64 + s * 16 + j; }
  if (MODE == 4) { if (n < 1024) return (n >> 6) * 128 + (n & 63); const int m = n - 1024; return (m >> 6) * 128 + 64 + (m & 63); }
  if (MODE == 5) return n < 800 ? n : -1;
  return n;
}
template <int MODE> DI f32x4 cvt_load4(const float* __restrict__ row, int n) {
  if (MODE == 2 && n < 2048) { const int w = n & 255, j = w >> 1; const float* b = row + (n & ~255) + j; const f32x2 lo = *(const f32x2*)b, hi = *(const f32x2*)(b + 128); return (f32x4){lo[0], hi[0], lo[1], hi[1]}; }
  if (MODE == 3) { return (f32x4){row[srccol<3>(n)], row[srccol<3>(n + 1)], row[srccol<3>(n + 2)], row[srccol<3>(n + 3)]}; }
  const int sc = srccol<MODE>(n); if (sc < 0) return (f32x4){0.f, 0.f, 0.f, 0.f};
  return *(const f32x4*)(row + sc);
}
template <int MODE>
DI void convert_w(const float* __restrict__ src, int Nsrc, int K, bf16_t* __restrict__ dst, int Ndst, const float* __restrict__ kscale, float* ldsf) {
  const int tid = threadIdx.x, tn = Ndst / 64, tk = K / 64;
  for (int tile = blockIdx.x; tile < tn * tk; tile += gridDim.x) {
    const int n0 = (tile % tn) * 64, k0 = (tile / tn) * 64;
    __syncthreads();
#pragma unroll
    for (int i = 0; i < 2; ++i) { const int kk = (tid >> 4) + 32 * i, nn = (tid & 15) * 4;
      f32x4 v = cvt_load4<MODE>(src + (size_t)(k0 + kk) * Nsrc, n0 + nn);
      if (kscale) v = v * kscale[k0 + kk];
      float* lp = ldsf + kk * 65 + nn; lp[0] = v[0]; lp[1] = v[1]; lp[2] = v[2]; lp[3] = v[3]; }
    __syncthreads();
    { const int nn = tid >> 3, kc = tid & 7; const float* lp = ldsf + (kc * 8) * 65 + nn;
      u32x4 o; o.x = pk2(lp[0], lp[65]); o.y = pk2(lp[130], lp[195]); o.z = pk2(lp[260], lp[325]); o.w = pk2(lp[390], lp[455]);
      *(u32x4*)(dst + (size_t)(n0 + nn) * K + k0 + kc * 8) = o; }
  }
}

DI void ada_phase(const Params& p, float* ldsf) {
  const int tid = threadIdx.x, lane = tid & 63, w = tid >> 6;
  float* mods = (float*)(p.ws + OFF_MODS);
  __syncthreads();
  for (int e = tid; e < 5120; e += NTHR) { const int mv = e >> 10, k = e & 1023; const float cv = mv < 4 ? p.c[mv * 1024 + k] : p.cctx[k]; ldsf[e] = siluf(cv); }
  __syncthreads();
  float* red = ldsf + 5120;
  for (int item = blockIdx.x; item < 4 * 96; item += gridDim.x) {
    const int i = item / 96, n0 = (item % 96) * 64;
    const float* wp = p.ada_w + (size_t)i * 1024 * 6144 + n0 + lane;
    float a0 = 0.f, a1 = 0.f, a2 = 0.f, a3 = 0.f, a4 = 0.f;
#pragma unroll 8
    for (int kk = 0; kk < 128; ++kk) { const int k = w * 128 + kk; const float wv = wp[(size_t)k * 6144];
      a0 += ldsf[k] * wv; a1 += ldsf[1024 + k] * wv; a2 += ldsf[2048 + k] * wv; a3 += ldsf[3072 + k] * wv; a4 += ldsf[4096 + k] * wv; }
    red[(w * 5 + 0) * 64 + lane] = a0; red[(w * 5 + 1) * 64 + lane] = a1; red[(w * 5 + 2) * 64 + lane] = a2; red[(w * 5 + 3) * 64 + lane] = a3; red[(w * 5 + 4) * 64 + lane] = a4;
    __syncthreads();
    if (tid < 320) { const int mv = tid >> 6; float s = 0.f;
#pragma unroll
      for (int ww = 0; ww < 8; ++ww) s += red[(ww * 5 + mv) * 64 + lane];
      mods[(size_t)(i * 5 + mv) * 6144 + n0 + lane] = s + p.ada_b[i * 6144 + n0 + lane]; }
    __syncthreads();
  }
}
DI void tables_phase(const Params& p) {
  const int gt = blockIdx.x * NTHR + threadIdx.x, gn = gridDim.x * NTHR;
  float2* tabR = (float2*)(p.ws + OFF_TABR); float2* tabM = (float2*)(p.ws + OFF_TABM); float* lbv = (float*)(p.ws + OFF_LBV);
  for (int e = gt; e < 128 * 64; e += gn) { const int v = e >> 6, i = e & 63; const float inv = powf(10000.f, -(float)i / 64.f); const float ang = (float)v * inv; tabR[e] = make_float2(cosf(ang), sinf(ang)); }
  for (int e = gt; e < 128 * 8; e += gn) { const int v = e >> 3, i = e & 7; const float inv = powf(10000.f, -(float)i / 8.f); const float ang = (float)v * inv; tabM[e] = make_float2(cosf(ang), sinf(ang)); }
  for (int e = gt; e < 1024; e += gn) { const float l0 = p.hg_lb[e], l1 = p.hg_lb[1024 + e], l2 = p.hg_lb[2048 + e], l3 = p.hg_lb[3072 + e];
    const float mx = fmaxf(fmaxf(l0, l1), fmaxf(l2, l3)); const float e0 = expf(l0 - mx), e1 = expf(l1 - mx), e2 = expf(l2 - mx), e3 = expf(l3 - mx);
    lbv[e] = (e1 + e2 + e3) / (e0 + e1 + e2 + e3); }
}

DI void modulate_phase(const Params& p, const float* slat, const float* sctx, int layer) {
  const float* mods = (const float*)(p.ws + OFF_MODS); bf16_t* a = (bf16_t*)(p.ws + OFF_A);
  const int gt = blockIdx.x * NTHR + threadIdx.x, gn = gridDim.x * NTHR;
  for (int e = gt; e < T_ALL * 128; e += gn) {
    const int t = e >> 7, c0 = (e & 127) * 8; const float* s = hrowc(slat, sctx, t) + c0; const float* m = mods + (size_t)(layer * 5 + modvec(t)) * 6144;
    const f32x4 x0 = *(const f32x4*)s, x1 = *(const f32x4*)(s + 4), sh0 = *(const f32x4*)(m + c0), sh1 = *(const f32x4*)(m + c0 + 4), sc0 = *(const f32x4*)(m + 1024 + c0), sc1 = *(const f32x4*)(m + 1024 + c0 + 4);
    const f32x4 y0 = x0 * (1.f + sc0) + sh0, y1 = x1 * (1.f + sc1) + sh1;
    u32x4 o; o.x = pk2(y0[0], y0[1]); o.y = pk2(y0[2], y0[3]); o.z = pk2(y1[0], y1[1]); o.w = pk2(y1[2], y1[3]);
    *(u32x4*)(a + (size_t)t * 1024 + c0) = o;
  }
}
DI void ln_phase(const Params& p, int lnlayer, int lnidx, int ml, int js, bool final_out) {
  const float* mods = (const float*)(p.ws + OFF_MODS); bf16_t* a = (bf16_t*)(p.ws + OFF_A); float* hctx = (float*)(p.ws + OFF_HCTX); float2* lns = (float2*)(p.ws + OFF_LNS);
  const int tid = threadIdx.x, lane = tid & 63, gw = blockIdx.x * 8 + (tid >> 6), nw = gridDim.x * 8;
  const float* gp = p.ln_g + (size_t)(lnlayer * 2 + lnidx) * 1024; const float* bp = p.ln_b + (size_t)(lnlayer * 2 + lnidx) * 1024;
  for (int t = gw; t < T_ALL; t += nw) {
    float* hr = hrow(p.out, hctx, t);
    f32x4 v[4]; float s = 0.f;
#pragma unroll
    for (int i = 0; i < 4; ++i) { v[i] = *(const f32x4*)(hr + i * 256 + lane * 4); s += (v[i][0] + v[i][1]) + (v[i][2] + v[i][3]); }
#pragma unroll
    for (int o = 1; o < 64; o <<= 1) s += __shfl_xor(s, o);
    const float mean = s * (1.f / 1024.f); float q = 0.f;
#pragma unroll
    for (int i = 0; i < 4; ++i) { v[i] = v[i] - mean; q += (v[i][0] * v[i][0] + v[i][1] * v[i][1]) + (v[i][2] * v[i][2] + v[i][3] * v[i][3]); }
#pragma unroll
    for (int o = 1; o < 64; o <<= 1) q += __shfl_xor(q, o);
    const float rstd = rsqrtf(q * (1.f / 1024.f) + 1e-5f);
    if (!final_out && lane == 0) lns[t] = make_float2(mean, rstd);
    const float* m = mods + (size_t)(ml * 5 + modvec(t)) * 6144 + (size_t)js * 1024;
#pragma unroll
    for (int i = 0; i < 4; ++i) { const int c0 = i * 256 + lane * 4;
      const f32x4 y = v[i] * rstd * *(const f32x4*)(gp + c0) + *(const f32x4*)(bp + c0);
      if (final_out) *(f32x4*)(hr + c0) = y;
      else { const f32x4 z = y * (1.f + *(const f32x4*)(m + 1024 + c0)) + *(const f32x4*)(m + c0); u32x2 o; o.x = pk2(z[0], z[1]); o.y = pk2(z[2], z[3]); *(u32x2*)(a + (size_t)t * 1024 + c0) = o; } }
  }
}

namespace pg8 {
#define PG8_LAS __attribute__((address_space(3)))
typedef unsigned short bf16_t;
typedef short bf16x8 __attribute__((ext_vector_type(8)));
typedef float f32x4 __attribute__((ext_vector_type(4)));
typedef unsigned u32x4 __attribute__((ext_vector_type(4)));
constexpr int BM = 256, BK = 64, HALF = 128, HTB = HALF * BK * 2  , STAGE_BYTES = 8 * HTB, NXCD = 8, WGM = 8;

__host__ __device__ __forceinline__ int lds_byte(int r, int c) { const int st = (r >> 4) * 2 + (c >> 5), rr = r & 15, cc = c & 31, ob = rr * 64 + cc * 2; return st * 1024 + (ob ^ (((ob >> 9) & 1) << 5)); }
__host__ __device__ __forceinline__ void stage_rc(int b, int& R, int& C) { const int st = b / 1024, sb = b % 1024, swz = sb ^ (((sb >> 9) & 1) << 5); R = (st >> 1) * 16 + swz / 64; C = (st & 1) * 32 + (swz % 64) / 2; }
__host__ __device__ __forceinline__ int perm32(int rho) { const int n = rho >> 4, i = rho & 15; return 8 * (i >> 2) + 4 * n + (i & 3); }

struct Unit { int pm, pn; };
struct Gemm { const bf16_t* A; const bf16_t* Bt; int M, N, K; };

struct StaticOrder {
    int nM, nN, nwg, G, c, lat;
    __host__ __device__ void init(int M, int N, int G_, int c_, int lat_ = 0) { lat = lat_; nM = lat ? 128 : M / BM; nN = N / BM; nwg = nM * nN; G = G_; c = c_; }
    __host__ __device__ bool next(int i, Unit& u) const {
        const long L = (long)i * G + c; if (L >= nwg) return false;
        int wgid = (int)L; { const int q = nwg / NXCD, r = nwg % NXCD, xcd = wgid % NXCD, off = wgid / NXCD; wgid = (xcd < r ? xcd * (q + 1) : r * (q + 1) + (xcd - r) * q) + off; }
        const int nig = WGM * nN, gid = wgid / nig, fm = gid * WGM, gsz = (nM - fm) < WGM ? (nM - fm) : WGM;
        u.pm = fm + ((wgid % nig) % gsz); u.pn = (wgid % nig) / gsz; if (lat) u.pm += (u.pm >> 5) + 1; return true;
    }
    __device__ __forceinline__ void a_ready(const Unit&) const {}
    __device__ __forceinline__ void done(const Unit&) const {}
};
template <class Epi, class Sched, bool ALIGN_EPI = false, bool SP2 = false>
__device__ __forceinline__ void gemm_phase(PG8_LAS unsigned char* lds, const Gemm g, const Sched& S, const Epi& E) {
    const int tid = tid_(), wid = __builtin_amdgcn_readfirstlane(tid >> 6), lane = tid & 63, wr = wid >> 2, wc = wid & 3, fr = lane & 15, fq = lane >> 4;
    const int K = g.K, nt = K / BK;
    unsigned voffA[2], voffB[2];
#pragma unroll
    for (int i = 0; i < 2; ++i) { int R, C; stage_rc(tid * 16 + i * 8192, R, C); const int Rb = Epi::PERM ? ((R & ~31) + perm32(R & 31)) : R;
        voffA[i] = (unsigned)(R * K + C) * 2u; voffB[i] = (unsigned)(Rb * K + C) * 2u; }
    const size_t kstep = (size_t)(BK * 2);
    const size_t hstep = (size_t)HALF * K * 2;
    const size_t tstep = 2 * hstep;
    const unsigned ldsw = (unsigned)wid * 1024u;
    const int aoff = lds_byte(wr * 64 + fr, fq * 8), boff = lds_byte(wc * 32 + fr, fq * 8);
#define PG8_SA(b, h) (((b) * 2 + (h)) * HTB)
#define PG8_SB(b, h) ((4 + (b) * 2 + (h)) * HTB)
#define PG8_STAGE(bufoff, gbase, voff) do { _Pragma("unroll") for (int _i = 0; _i < 2; ++_i) \
        __builtin_amdgcn_global_load_lds((const unsigned*)((const char*)(gbase) + (voff)[_i]), (PG8_LAS unsigned*)(lds + (bufoff) + ldsw + _i * 8192), 16, 0, 0); } while (0)
#define PG8_LDA(dst, b, h) do { _Pragma("unroll") for (int m = 0; m < 4; ++m) _Pragma("unroll") for (int k = 0; k < 2; ++k) dst[m][k] = *(const PG8_LAS bf16x8*)(lds + PG8_SA(b, h) + aoff + m * 2048 + k * 1024); } while (0)
#define PG8_LDB(dst, b, h) do { _Pragma("unroll") for (int n = 0; n < 2; ++n) _Pragma("unroll") for (int k = 0; k < 2; ++k) dst[n][k] = *(const PG8_LAS bf16x8*)(lds + PG8_SB(b, h) + boff + n * 2048 + k * 1024); } while (0)
#define PG8_MMA(ai, bj, At, Bt) do { __builtin_amdgcn_s_setprio(1); _Pragma("unroll") for (int m = 0; m < 4; ++m) _Pragma("unroll") for (int n = 0; n < 2; ++n) _Pragma("unroll") for (int k = 0; k < 2; ++k) \
        acc[ai][bj][m][n] = __builtin_amdgcn_mfma_f32_16x16x32_bf16(Bt[n][k], At[m][k], acc[ai][bj][m][n], 0, 0, 0); __builtin_amdgcn_s_setprio(0); } while (0)
#define PG8_WAIT_V(n) asm volatile("s_waitcnt vmcnt(" #n ")" ::: "memory")
#define PG8_WAIT_L(n) asm volatile("s_waitcnt lgkmcnt(" #n ")" ::: "memory")
#define PG8_BAR __builtin_amdgcn_s_barrier()
#define PG8_SCHED __builtin_amdgcn_sched_barrier(0)
    Unit cur, nxt; int ui = 0;
    if (!S.next(0, cur)) return;
    f32x4 acc[2][2][4][2];
#pragma unroll
    for (int a = 0; a < 2; ++a)
#pragma unroll
        for (int b = 0; b < 2; ++b)
#pragma unroll
            for (int m = 0; m < 4; ++m)
#pragma unroll
                for (int n = 0; n < 2; ++n) acc[a][b][m][n] = (f32x4){0.f, 0.f, 0.f, 0.f};
    bf16x8 At[4][2], B0[2][2], B1[2][2];
    const char* cA = (const char*)g.A + (size_t)cur.pm * tstep; const char* cB = (const char*)g.Bt + (size_t)cur.pn * tstep;
    S.a_ready(cur);
    if constexpr (SP2) {
        PG8_STAGE(PG8_SB(0, 0), cB, voffB); PG8_STAGE(PG8_SB(0, 1), cB + hstep, voffB); PG8_STAGE(PG8_SA(0, 0), cA, voffA); PG8_STAGE(PG8_SA(0, 1), cA + hstep, voffA);
        if (wr == 1) PG8_BAR;
        PG8_WAIT_V(2); PG8_BAR;
        PG8_STAGE(PG8_SB(1, 0), cB + kstep, voffB); PG8_STAGE(PG8_SA(1, 0), cA + kstep, voffA); PG8_STAGE(PG8_SB(1, 1), cB + hstep + kstep, voffB);
        PG8_WAIT_V(6); PG8_BAR;
    } else {
        PG8_STAGE(PG8_SB(0, 0), cB, voffB); PG8_STAGE(PG8_SA(0, 0), cA, voffA); PG8_STAGE(PG8_SB(0, 1), cB + hstep, voffB); PG8_STAGE(PG8_SA(0, 1), cA + hstep, voffA);
        if (wr == 1) PG8_BAR;
        PG8_WAIT_V(4); PG8_BAR;
        PG8_STAGE(PG8_SB(1, 0), cB + kstep, voffB); PG8_STAGE(PG8_SA(1, 0), cA + kstep, voffA); PG8_STAGE(PG8_SB(1, 1), cB + hstep + kstep, voffB);
        PG8_WAIT_V(6); PG8_BAR;
    }
    for (;;) {
        const bool has_next = S.next(ui + 1, nxt);
        const char* nA = has_next ? (const char*)g.A + (size_t)nxt.pm * tstep : cA; const char* nB = has_next ? (const char*)g.Bt + (size_t)nxt.pn * tstep : cB;
        for (int t = 0; t < nt; t += 2) {
            const bool last = (t == nt - 2);
            const char* a1 = cA + (size_t)(t + 1) * kstep;
            const char* a2 = last ? nA : cA + (size_t)(t + 2) * kstep; const char* b2 = last ? nB : cB + (size_t)(t + 2) * kstep;
            const char* a3 = a2 + kstep; const char* b3 = b2 + kstep;
            if (last && has_next) S.a_ready(nxt);
            if constexpr (SP2) {
            PG8_LDB(B0, 0, 0); PG8_LDB(B1, 0, 1); PG8_SCHED; PG8_LDA(At, 0, 0); PG8_STAGE(PG8_SA(1, 1), a1 + hstep, voffA);
            PG8_WAIT_V(8); PG8_WAIT_L(0); PG8_BAR; PG8_MMA(0, 0, At, B0); PG8_MMA(0, 1, At, B1); PG8_BAR; PG8_SCHED;
            PG8_LDA(At, 0, 1); PG8_STAGE(PG8_SB(0, 0), b2, voffB); PG8_STAGE(PG8_SB(0, 1), b2 + hstep, voffB); PG8_STAGE(PG8_SA(0, 0), a2, voffA);
            PG8_WAIT_V(8); PG8_WAIT_L(0); PG8_BAR; PG8_MMA(1, 0, At, B0); PG8_MMA(1, 1, At, B1); PG8_BAR; PG8_SCHED;
            PG8_LDB(B0, 1, 0); PG8_LDB(B1, 1, 1); PG8_SCHED; PG8_LDA(At, 1, 0); PG8_STAGE(PG8_SA(0, 1), a2 + hstep, voffA);
            PG8_WAIT_V(8); PG8_WAIT_L(0); PG8_BAR; PG8_MMA(0, 0, At, B0); PG8_MMA(0, 1, At, B1); PG8_BAR; PG8_SCHED;
            PG8_LDA(At, 1, 1); PG8_STAGE(PG8_SB(1, 0), b3, voffB); PG8_STAGE(PG8_SB(1, 1), b3 + hstep, voffB); PG8_STAGE(PG8_SA(1, 0), a3, voffA);
            PG8_WAIT_V(8); PG8_WAIT_L(0); PG8_BAR; PG8_MMA(1, 0, At, B0); PG8_MMA(1, 1, At, B1); PG8_BAR; PG8_SCHED;
            } else {
            PG8_LDB(B0, 0, 0); PG8_SCHED; PG8_LDA(At, 0, 0); PG8_STAGE(PG8_SA(1, 1), a1 + hstep, voffA);
            PG8_WAIT_L(8); PG8_BAR; PG8_WAIT_L(0); PG8_MMA(0, 0, At, B0); PG8_BAR; PG8_SCHED;
            PG8_LDB(B1, 0, 1); PG8_STAGE(PG8_SB(0, 0), b2, voffB);
            PG8_BAR; PG8_WAIT_L(0); PG8_MMA(0, 1, At, B1); PG8_BAR;
            PG8_LDA(At, 0, 1); PG8_STAGE(PG8_SA(0, 0), a2, voffA);
            PG8_BAR; PG8_WAIT_L(0); PG8_MMA(1, 0, At, B0); PG8_BAR; PG8_SCHED;
            PG8_STAGE(PG8_SB(0, 1), b2 + hstep, voffB);
            PG8_WAIT_V(6); PG8_BAR; PG8_MMA(1, 1, At, B1); PG8_BAR;
            PG8_LDB(B0, 1, 0); PG8_SCHED; PG8_LDA(At, 1, 0); PG8_STAGE(PG8_SA(0, 1), a2 + hstep, voffA);
            PG8_WAIT_L(8); PG8_BAR; PG8_WAIT_L(0); PG8_MMA(0, 0, At, B0); PG8_BAR; PG8_SCHED;
            PG8_LDB(B1, 1, 1); PG8_STAGE(PG8_SB(1, 0), b3, voffB);
            PG8_BAR; PG8_WAIT_L(0); PG8_MMA(0, 1, At, B1); PG8_BAR;
            PG8_LDA(At, 1, 1); PG8_STAGE(PG8_SA(1, 0), a3, voffA);
            PG8_BAR; PG8_WAIT_L(0); PG8_MMA(1, 0, At, B0); PG8_BAR; PG8_SCHED;
            PG8_STAGE(PG8_SB(1, 1), b3 + hstep, voffB);
            PG8_WAIT_V(6); PG8_BAR; PG8_MMA(1, 1, At, B1); PG8_BAR;
            }
        }
        if constexpr (ALIGN_EPI) { if (wr == 0) PG8_BAR; }
        if constexpr (!Epi::AFTER_DRAIN) { E(acc, cur, wr, wc, fr, fq); S.done(cur); }
        if (!has_next) break;
#pragma unroll
        for (int a = 0; a < 2; ++a)
#pragma unroll
            for (int b = 0; b < 2; ++b)
#pragma unroll
                for (int m = 0; m < 4; ++m)
#pragma unroll
                    for (int n = 0; n < 2; ++n) acc[a][b][m][n] = (f32x4){0.f, 0.f, 0.f, 0.f};
        cur = nxt; cA = nA; cB = nB; ++ui;
        if constexpr (ALIGN_EPI) { if (wr == 1) PG8_BAR; }
    }
    PG8_WAIT_V(0);
    if constexpr (!ALIGN_EPI) { if (wr == 0) PG8_BAR; }
    PG8_BAR;
    if constexpr (Epi::AFTER_DRAIN) { E.fused(acc, cur, wr, wc, fr, fq, lds, wid, lane); S.done(cur); }
#undef PG8_SA
#undef PG8_SB
#undef PG8_STAGE
#undef PG8_LDA
#undef PG8_LDB
#undef PG8_MMA
#undef PG8_WAIT_V
#undef PG8_WAIT_L
#undef PG8_BAR
#undef PG8_SCHED
}
}

template <class E4> struct EpiWrap { static constexpr bool PERM = false, AFTER_DRAIN = false; E4 e;
  DI void operator()(const f32x4 (&acc)[2][2][4][2], const pg8::Unit& u, int wr, int wc, int fr, int fq) const {
#pragma unroll
    for (int ai = 0; ai < 2; ++ai)
#pragma unroll
      for (int m = 0; m < 4; ++m) { const int row = u.pm * 256 + ai * 128 + wr * 64 + m * 16 + fr;
#pragma unroll
        for (int bj = 0; bj < 2; ++bj) { const int col = u.pn * 256 + bj * 128 + wc * 32 + 4 * fq;
          if constexpr (E4::PAIR) e.pair(row, ((col - 4 * fq) >> 1) + 4 * fq, acc[ai][bj][m][0], acc[ai][bj][m][1]);
          else { e(row, col, acc[ai][bj][m][0]); e(row, col + 16, acc[ai][bj][m][1]); } }
        asm volatile("" ::: "memory"); }
  } };
template <class E4>
DI void big_gemm(const bf16_t* A, const bf16_t* W, int M, int N, int K, const E4& e4, char* lds, int lat_only = 0) {
  __syncthreads();
  pg8::Gemm g{A, W, M, N, K}; pg8::StaticOrder S; S.init(M, N, (int)gridDim.x, (int)blockIdx.x, lat_only); EpiWrap<E4> E{e4};
  pg8::gemm_phase<EpiWrap<E4>, pg8::StaticOrder, true, true>((PG8_LAS unsigned char*)lds, g, S, E);
  __syncthreads();
}
struct GemmArgs { const bf16_t* A; int lda; const bf16_t* W; int ldw; int M, N, K; };
constexpr int LDT = 72;
template <bool TRANS, class Epi>
DI void gemm_phase(const GemmArgs g, const Epi epi, char* lds) {
  const int tid = threadIdx.x, lane = tid & 63, w = tid >> 6, wm = w & 3, wn = w >> 2, g4 = lane >> 4, l16 = lane & 15;
  const int nN = g.N / 128, ntiles = (g.M / 256) * nN, nk = g.K / 64;
  bf16_t* As = (bf16_t*)lds; bf16_t* Bs = As + 256 * LDT;
  for (int tile = blockIdx.x; tile < ntiles; tile += gridDim.x) {
    const int pm = tile / nN, pn = tile - pm * nN;
    const bf16_t* Ag = g.A + (size_t)(pm * 256) * g.lda; const bf16_t* Wg = g.W + (size_t)(pn * 128) * g.ldw;
    f32x4 acc[4][4];
#pragma unroll
    for (int i = 0; i < 4; ++i)
#pragma unroll
      for (int j = 0; j < 4; ++j) acc[i][j] = (f32x4){0.f, 0.f, 0.f, 0.f};
    u32x4 ra[4], rb[2];
#pragma unroll
    for (int i = 0; i < 4; ++i) { const int c = tid + NTHR * i; ra[i] = *(const u32x4*)(Ag + (size_t)(c >> 3) * g.lda + (c & 7) * 8); }
#pragma unroll
    for (int i = 0; i < 2; ++i) { const int c = tid + NTHR * i; rb[i] = *(const u32x4*)(Wg + (size_t)(c >> 3) * g.ldw + (c & 7) * 8); }
    for (int kt = 0; kt < nk; ++kt) {
      __syncthreads();
#pragma unroll
      for (int i = 0; i < 4; ++i) { const int c = tid + NTHR * i; *(u32x4*)(As + (c >> 3) * LDT + (c & 7) * 8) = ra[i]; }
#pragma unroll
      for (int i = 0; i < 2; ++i) { const int c = tid + NTHR * i; *(u32x4*)(Bs + (c >> 3) * LDT + (c & 7) * 8) = rb[i]; }
      __syncthreads();
      if (kt + 1 < nk) { const int k0 = (kt + 1) * 64;
#pragma unroll
        for (int i = 0; i < 4; ++i) { const int c = tid + NTHR * i; ra[i] = *(const u32x4*)(Ag + (size_t)(c >> 3) * g.lda + k0 + (c & 7) * 8); }
#pragma unroll
        for (int i = 0; i < 2; ++i) { const int c = tid + NTHR * i; rb[i] = *(const u32x4*)(Wg + (size_t)(c >> 3) * g.ldw + k0 + (c & 7) * 8); } }
#pragma unroll
      for (int ks = 0; ks < 2; ++ks) {
        bf16x8 af[4], wf[4];
#pragma unroll
        for (int i = 0; i < 4; ++i) af[i] = *(const bf16x8*)(As + (wm * 64 + i * 16 + l16) * LDT + ks * 32 + g4 * 8);
#pragma unroll
        for (int j = 0; j < 4; ++j) wf[j] = *(const bf16x8*)(Bs + (wn * 64 + j * 16 + l16) * LDT + ks * 32 + g4 * 8);
#pragma unroll
        for (int i = 0; i < 4; ++i)
#pragma unroll
          for (int j = 0; j < 4; ++j) acc[i][j] = TRANS ? mfma16(af[i], wf[j], acc[i][j]) : mfma16(wf[j], af[i], acc[i][j]);
      }
    }
    const int mb = pm * 256 + wm * 64, nb = pn * 128 + wn * 64;
    if constexpr (Epi::PAIR) {
#pragma unroll
      for (int i = 0; i < 4; ++i)
#pragma unroll
        for (int j = 0; j < 2; ++j) epi.pair(mb + i * 16 + l16, (nb >> 1) + 16 * j + 4 * g4, acc[i][2 * j], acc[i][2 * j + 1]);
    } else {
#pragma unroll
      for (int i = 0; i < 4; ++i)
#pragma unroll
        for (int j = 0; j < 4; ++j) { if (TRANS) epi(mb + i * 16 + 4 * g4, nb + j * 16 + l16, acc[i][j]); else epi(mb + i * 16 + l16, nb + j * 16 + 4 * g4, acc[i][j]); }
    }
  }
}
DI void st4bf(bf16_t* p, f32x4 v) { u32x2 o; o.x = pk2(v[0], v[1]); o.y = pk2(v[2], v[3]); *(u32x2*)p = o; }
struct EpiStore { static constexpr bool PAIR = false; bf16_t* d0; bf16_t* d1; int split, ld0, ld1; float s0;
  DI void operator()(int m, int n, f32x4 v) const { if (n < split) st4bf(d0 + (size_t)m * ld0 + n, v * s0); else st4bf(d1 + (size_t)m * ld1 + (n - split), v); } };
struct EpiVT { static constexpr bool PAIR = false; bf16_t* vt; const float* rs;
  DI void operator()(int m, int n, f32x4 v) const { const int b = m / PB, pos = m - b * PB;
    if (rs) { v[0] *= rs[2 * m + 1]; v[1] *= rs[2 * m + 3]; v[2] *= rs[2 * m + 5]; v[3] *= rs[2 * m + 7]; }
    st4bf(vt + ((size_t)(b * 1024 + n)) * PB + pos, v); } };
struct EpiResid { static constexpr bool PAIR = false; const float* slat; const float* sctx; float* dlat; float* dctx; const float* gate;
  const float2* lns; const float* lg; const float* lb;
  DI void operator()(int m, int n, f32x4 v) const { const int mv = modvec(m); f32x4 hv = *(const f32x4*)(hrowc(slat, sctx, m) + n); const f32x4 gt = *(const f32x4*)(gate + (size_t)mv * 6144 + n);
    if (lns) { const float2 st = lns[m]; hv = (hv - st.x) * st.y * *(const f32x4*)(lg + n) + *(const f32x4*)(lb + n); }
    *(f32x4*)(hrow(dlat, dctx, m) + n) = ALPHA * hv + gt * v; } };
struct EpiSwiglu { static constexpr bool PAIR = true; bf16_t* u;
  DI void pair(int m, int f, f32x4 gt, f32x4 up) const { f32x4 r; r[0] = siluf(gt[0]) * up[0]; r[1] = siluf(gt[1]) * up[1]; r[2] = siluf(gt[2]) * up[2]; r[3] = siluf(gt[3]) * up[3]; st4bf(u + (size_t)m * FF + f, r); } };
struct EpiRetQK { static constexpr bool PAIR = false; bf16_t* qk; const float2* tabR;
  DI void operator()(int m, int n, f32x4 v) const { const int b = m / PB, pp = m - b * PB;
    if (pp >= LC) { const int pos = pp - LC, row = pos >> 6, col = pos & 63; const int j0 = (n & 255) >> 1;
      const int vv = j0 < 64 ? row : col; const float2 c0 = tabR[vv * 64 + (j0 & 63)], c1 = tabR[vv * 64 + ((j0 + 1) & 63)];
      const float a0 = v[0] * c0.x - v[1] * c0.y, b0 = v[0] * c0.y + v[1] * c0.x, a1 = v[2] * c1.x - v[3] * c1.y, b1 = v[2] * c1.y + v[3] * c1.x; v = (f32x4){a0, b0, a1, b1}; }
    if (n >= 1024) v = v * 0.0625f;
    st4bf(qk + (size_t)m * 2048 + n, v); } };
struct EpiHg { static constexpr bool PAIR = false; bf16_t* ph;
  DI void operator()(int m, int n, f32x4 v) const { if (n < 1024) { v[0] = siluf(v[0]); v[1] = siluf(v[1]); v[2] = siluf(v[2]); v[3] = siluf(v[3]); v = v * 0.08838834764831845f; } st4bf(ph + (size_t)m * 5120 + n, v); } };
struct EpiMlaQ { static constexpr bool PAIR = false; bf16_t* q; const float* rs; const float2* tabM;
  DI void operator()(int m, int n, f32x4 v) const { v = v * (rs[2 * m] * 0.10206207261596577f * LOG2E); const int h = n / 96, w = n - h * 96; const int b = m / PB, pp = m - b * PB;
    if (w >= 64 && pp >= LC) { const int pos = pp - LC, row = pos >> 6, col = pos & 63; const int j0 = (w - 64) >> 1; const int vv = j0 < 8 ? row : col; const float2 c0 = tabM[vv * 8 + (j0 & 7)], c1 = tabM[vv * 8 + ((j0 + 1) & 7)];
      const float a0 = v[0] * c0.x - v[1] * c0.y, b0 = v[0] * c0.y + v[1] * c0.x, a1 = v[2] * c1.x - v[3] * c1.y, b1 = v[2] * c1.y + v[3] * c1.x; v = (f32x4){a0, b0, a1, b1}; }
    st4bf(q + (size_t)m * 1536 + n, v); } };
struct EpiMlaK { static constexpr bool PAIR = false; bf16_t* k; const float* rs;
  DI void operator()(int m, int n, f32x4 v) const { v = v * rs[2 * m + 1]; st4bf(k + (size_t)m * 1536 + (n >> 6) * 96 + (n & 63), v); } };

DI void mla_stats_phase(const Params& p) {
  const bf16_t* d0 = (const bf16_t*)(p.ws + M_D0); bf16_t* km = (bf16_t*)(p.ws + M_K); float* rs = (float*)(p.ws + OFF_RS); const float2* tabM = (const float2*)(p.ws + OFF_TABM);
  const int tid = threadIdx.x, lane = tid & 63, gw = blockIdx.x * 8 + (tid >> 6), nw = gridDim.x * 8;
  for (int t = gw; t < T_ALL; t += nw) {
    const bf16_t* r = d0 + (size_t)t * 1024;
    const u32x4 a = *(const u32x4*)(r + lane * 8); const u32x2 c = *(const u32x2*)(r + 512 + lane * 4);
    float sq = bflo(a.x) * bflo(a.x) + bfhi(a.x) * bfhi(a.x) + bflo(a.y) * bflo(a.y) + bfhi(a.y) * bfhi(a.y) + bflo(a.z) * bflo(a.z) + bfhi(a.z) * bfhi(a.z) + bflo(a.w) * bflo(a.w) + bfhi(a.w) * bfhi(a.w);
    float sk = bflo(c.x) * bflo(c.x) + bfhi(c.x) * bfhi(c.x) + bflo(c.y) * bflo(c.y) + bfhi(c.y) * bfhi(c.y);
#pragma unroll
    for (int o = 1; o < 64; o <<= 1) { sq += __shfl_xor(sq, o); sk += __shfl_xor(sk, o); }
    if (lane == 0) { rs[2 * t] = rsqrtf(sq * (1.f / 512.f) + 1e-6f); rs[2 * t + 1] = rsqrtf(sk * (1.f / 256.f) + 1e-6f); }
    if (lane < 16) { const int j = lane; float x1 = bf2f(r[768 + j]), x2 = bf2f(r[768 + 16 + j]); const int b = t / PB, pp = t - b * PB;
      if (pp >= LC) { const int pos = pp - LC, row = pos >> 6, col = pos & 63; const float2 cs = tabM[(j < 8 ? row : col) * 8 + (j & 7)]; const float o1 = x1 * cs.x - x2 * cs.y, o2 = x1 * cs.y + x2 * cs.x; x1 = o1; x2 = o2; }
      const unsigned pr = pk2(x1, x2);
#pragma unroll
      for (int h = 0; h < 16; ++h) *(unsigned*)(km + (size_t)t * 1536 + h * 96 + 64 + 2 * j) = pr; }
  }
}

constexpr int KLD = 104, VLD = 72;
DI void mla_attn_phase(const Params& p, char* lds) {
  const bf16_t* Qm = (const bf16_t*)(p.ws + M_Q); const bf16_t* Km = (const bf16_t*)(p.ws + M_K); const bf16_t* vT = (const bf16_t*)(p.ws + M_VT); bf16_t* o = (bf16_t*)(p.ws + OFF_A);
  const int tid = threadIdx.x, lane = tid & 63, w = tid >> 6, c = lane & 31, hh = lane >> 5;
  constexpr int KB = 64 * KLD, VB = 64 * VLD;
  bf16_t* Ks = (bf16_t*)lds; bf16_t* Vs = Ks + 3 * KB;
  for (int item = blockIdx.x; item < 2048 + 64; item += gridDim.x) {
    int b, h, qbase, nkt;
    if (item < 2048) { b = item >> 9; h = (item >> 5) & 15; qbase = LC + (item & 31) * 256; nkt = 132; } else { const int it = item - 2048; b = it >> 4; h = it & 15; qbase = 0; nkt = 4; }
    const size_t tokbase = (size_t)b * PB;
    const bf16_t* qp = Qm + (tokbase + qbase + w * 32 + c) * 1536 + h * 96 + hh * 8;
    bf16x8 qf[6];
#pragma unroll
    for (int ks = 0; ks < 6; ++ks) qf[ks] = *(const bf16x8*)(qp + ks * 16);
    const bf16_t* kg = Km + tokbase * 1536 + h * 96; const bf16_t* vg = vT + (size_t)(b * 16 + h) * 64 * PB;
    const int kr0 = tid / 12, kc0 = tid - kr0 * 12, e1 = tid + NTHR, kr1 = e1 / 12, kc1 = e1 - kr1 * 12; const bool k1ok = e1 < 768; const int vd = tid >> 3, vc = tid & 7;
    u32x4 rk0, rk1 = (u32x4){0, 0, 0, 0}, rv;
    auto gload = [&](int t) { const size_t key0 = (size_t)t * 64;
      rk0 = *(const u32x4*)(kg + (key0 + kr0) * 1536 + kc0 * 8); if (k1ok) rk1 = *(const u32x4*)(kg + (key0 + kr1) * 1536 + kc1 * 8); rv = *(const u32x4*)(vg + (size_t)vd * PB + key0 + vc * 8); };
    auto lstore = [&](int buf) { bf16_t* Kn = Ks + buf * KB; bf16_t* Vn = Vs + buf * VB;
      *(u32x4*)(Kn + kr0 * KLD + kc0 * 8) = rk0; if (k1ok) *(u32x4*)(Kn + kr1 * KLD + kc1 * 8) = rk1; *(u32x4*)(Vn + vd * VLD + vc * 8) = rv; };
    f32x16 oacc[2];
#pragma unroll
    for (int i = 0; i < 16; ++i) { oacc[0][i] = 0.f; oacc[1][i] = 0.f; }
    float mrow = -1e30f, lsum = 0.f;
    auto qk = [&](int buf, f32x16 (&s)[2]) { const bf16_t* Kc = Ks + buf * KB;
#pragma unroll
      for (int j = 0; j < 2; ++j) {
#pragma unroll
        for (int i = 0; i < 16; ++i) s[j][i] = 0.f;
#pragma unroll
        for (int ks = 0; ks < 6; ++ks) { const bf16x8 kf = *(const bf16x8*)(Kc + (32 * j + c) * KLD + ks * 16 + hh * 8); s[j] = mfma32(kf, qf[ks], s[j]); }
      } };
    auto smpv = [&](int buf, f32x16 (&s)[2]) { const bf16_t* Vc = Vs + buf * VB;
      float mx = s[0][0];
#pragma unroll
      for (int j = 0; j < 2; ++j)
#pragma unroll
        for (int i = 0; i < 16; ++i) mx = fmaxf(mx, s[j][i]);
      if (__builtin_amdgcn_ballot_w64(mx > mrow + 8.f) != 0ull) {
        mx = fmaxf(mx, __shfl_xor(mx, 32));
        const float mnew = fmaxf(mrow, mx), alpha = __builtin_amdgcn_exp2f(mrow - mnew); mrow = mnew;
        lsum *= alpha;
#pragma unroll
        for (int i = 0; i < 16; ++i) { oacc[0][i] *= alpha; oacc[1][i] *= alpha; }
      }
      float ps0 = 0.f, ps1 = 0.f;
#pragma unroll
      for (int j = 0; j < 2; ++j)
#pragma unroll
        for (int i = 0; i < 16; i += 2) { s[j][i] = __builtin_amdgcn_exp2f(s[j][i] - mrow); ps0 += s[j][i]; s[j][i + 1] = __builtin_amdgcn_exp2f(s[j][i + 1] - mrow); ps1 += s[j][i + 1]; }
      lsum += ps0 + ps1;
#pragma unroll
      for (int j = 0; j < 2; ++j)
#pragma unroll
        for (int sx = 0; sx < 2; ++sx) {
          const bf16x8 pf = pack8(s[j][8 * sx], s[j][8 * sx + 1], s[j][8 * sx + 2], s[j][8 * sx + 3], s[j][8 * sx + 4], s[j][8 * sx + 5], s[j][8 * sx + 6], s[j][8 * sx + 7]);
#pragma unroll
          for (int dt = 0; dt < 2; ++dt) { const bf16_t* vp = Vc + (32 * dt + c) * VLD + 32 * j + 16 * sx + 4 * hh;
            const bf16x8 vf = cat44(*(const s16x4*)vp, *(const s16x4*)(vp + 8)); oacc[dt] = mfma32(vf, pf, oacc[dt]); }
        } };
    __syncthreads();
    gload(0); lstore(0); gload(1); lstore(1); if (nkt > 2) gload(2);
    __syncthreads();
    f32x16 sA[2], sB[2];
    qk(0, sA);
    int b0 = 0, b1 = 1, b2 = 2;
    for (int kt = 0; kt < nkt; kt += 2) {
      __syncthreads();
      if (kt + 2 < nkt) { lstore(b2); if (kt + 3 < nkt) gload(kt + 3); }
      qk(b1, sB);
      smpv(b0, sA);
      __syncthreads();
      if (kt + 3 < nkt) { lstore(b0); if (kt + 4 < nkt) gload(kt + 4); }
      if (kt + 2 < nkt) qk(b2, sA);
      smpv(b1, sB);
      { const int t0 = b0; b0 = b2; b2 = b1; b1 = t0; }
    }
    lsum += __shfl_xor(lsum, 32); const float inv = 1.f / lsum;
    bf16_t* op = o + (tokbase + qbase + w * 32 + c) * 1024 + h * 64 + 4 * hh;
#pragma unroll
    for (int dt = 0; dt < 2; ++dt)
#pragma unroll
      for (int rg = 0; rg < 4; ++rg) st4bf(op + 32 * dt + 8 * rg, (f32x4){oacc[dt][4 * rg] * inv, oacc[dt][4 * rg + 1] * inv, oacc[dt][4 * rg + 2] * inv, oacc[dt][4 * rg + 3] * inv});
  }
}

constexpr int NKC = 72, NVC = 264;
constexpr int NWK = 72, NWV = 584;
constexpr int NA_OFF_VC = 256 * NKC * 2, NA_OFF_RPB = NA_OFF_VC + 64 * NVC * 2, NA_OFF_W = NA_OFF_RPB + 1920, NA_LDS = NA_OFF_W + 576 * NWK * 2;
static_assert(64 * NWV * 2 <= 576 * NWK * 2 && NA_OFF_W % 16 == 0, "NA window");
DI void na_ctx_wave(const bf16_t* __restrict__ Q, bf16_t* __restrict__ o, const bf16_t* Kc, const bf16_t* Vc, int b, int h, int qb, int lane) {
  const int g = lane >> 4, l16 = lane & 15; const size_t tokbase = (size_t)b * PB; const int qpos = qb * 16 + l16;
  const bf16_t* qp = Q + (tokbase + qpos) * 1024 + h * 64 + g * 8;
  const bf16x8 q0 = *(const bf16x8*)qp, q1 = *(const bf16x8*)(qp + 32);
  f32x4 S[16];
#pragma unroll
  for (int kt = 0; kt < 16; ++kt) { const bf16_t* kp = Kc + (16 * kt + l16) * NKC + g * 8;
    f32x4 s = mfma16(*(const bf16x8*)kp, q0, (f32x4){0.f, 0.f, 0.f, 0.f}); s = mfma16(*(const bf16x8*)(kp + 32), q1, s); S[kt] = s * LOG2E; }
  float mx = S[0][0];
#pragma unroll
  for (int kt = 0; kt < 16; ++kt) mx = fmaxf(fmaxf(fmaxf(mx, S[kt][0]), fmaxf(S[kt][1], S[kt][2])), S[kt][3]);
  mx = fmaxf(mx, __shfl_xor(mx, 16)); mx = fmaxf(mx, __shfl_xor(mx, 32));
  float ls = 0.f;
#pragma unroll
  for (int kt = 0; kt < 16; ++kt)
#pragma unroll
    for (int rr = 0; rr < 4; ++rr) { S[kt][rr] = __builtin_amdgcn_exp2f(S[kt][rr] - mx); ls += S[kt][rr]; }
  ls += __shfl_xor(ls, 16); ls += __shfl_xor(ls, 32);
  f32x4 O[4];
#pragma unroll
  for (int dt = 0; dt < 4; ++dt) O[dt] = (f32x4){0.f, 0.f, 0.f, 0.f};
#pragma unroll
  for (int kk = 0; kk < 8; ++kk) {
    const bf16x8 pf = pack8(S[2 * kk][0], S[2 * kk][1], S[2 * kk][2], S[2 * kk][3], S[2 * kk + 1][0], S[2 * kk + 1][1], S[2 * kk + 1][2], S[2 * kk + 1][3]);
#pragma unroll
    for (int dt = 0; dt < 4; ++dt) { const bf16_t* vp = Vc + (dt * 16 + l16) * NVC + 32 * kk + 4 * g; const bf16x8 vf = cat44(*(const s16x4*)vp, *(const s16x4*)(vp + 16)); O[dt] = mfma16(vf, pf, O[dt]); }
  }
  const float inv = 1.f / ls; bf16_t* op = o + (tokbase + qpos) * 1024 + h * 64 + 4 * g;
#pragma unroll
  for (int dt = 0; dt < 4; ++dt) st4bf(op + 16 * dt, O[dt] * inv);
}
DI void na_attn_phase(const Params& p, char* lds) {
  const bf16_t* Q = (const bf16_t*)(p.ws + N_Q); const bf16_t* K = (const bf16_t*)(p.ws + N_K); const bf16_t* vT = (const bf16_t*)(p.ws + N_VT); bf16_t* o = (bf16_t*)(p.ws + OFF_A);
  bf16_t* Kc = (bf16_t*)lds; bf16_t* Vc = (bf16_t*)(lds + NA_OFF_VC); float* rl = (float*)(lds + NA_OFF_RPB); bf16_t* W = (bf16_t*)(lds + NA_OFF_W);
  const int tid = threadIdx.x, lane = tid & 63, w = tid >> 6, g = lane >> 4, l16 = lane & 15;
  for (int item = blockIdx.x; item < 256; item += gridDim.x) {
    const int qtr = item & 3, h = (item >> 2) & 15, b = item >> 6; const size_t tokbase = (size_t)b * PB;
    const bf16_t* kbase = K + (tokbase + LC) * 1024 + h * 64; const bf16_t* vbase = vT + (size_t)(b * 16 + h) * 64 * PB + LC;
    __syncthreads();
#pragma unroll
    for (int i = 0; i < 4; ++i) { const int e = tid + NTHR * i; const int key = e >> 3, kc = e & 7; *(u32x4*)(Kc + key * NKC + kc * 8) = *(const u32x4*)(K + (tokbase + key) * 1024 + h * 64 + kc * 8); }
#pragma unroll
    for (int i = 0; i < 4; ++i) { const int e = tid + NTHR * i; const int d = e >> 5, pc = e & 31; *(u32x4*)(Vc + d * NVC + pc * 8) = *(const u32x4*)(vT + ((size_t)(b * 16 + h) * 64 + d) * PB + pc * 8); }
    for (int e = tid; e < 465; e += NTHR) rl[e] = p.na_rpb[h * 465 + e];
    u32x4 rw[9];
#pragma unroll 1
    for (int j = 0; j < 16; ++j) {
      int ln = lane, tt = tid; asm volatile("" : "+v"(ln), "+v"(tt)); const int gg = ln >> 4, ll = ln & 15;
      const int r0 = qtr * 32 + 2 * j, rs0 = clampi(r0 - 4, 0, 120), r = r0 + (w >> 2), n = w & 3, rs = clampi(r - 4, 0, 120), dr = rs - rs0, band0 = clampi(16 * n - 8, 0, 32);
      const int qpos = LC + r * 64 + n * 16 + ll;
#pragma unroll
      for (int i = 0; i < 9; ++i) { const int e = tt + NTHR * i; rw[i] = *(const u32x4*)(kbase + (size_t)(rs0 * 64 + (e >> 3)) * 1024 + (e & 7) * 8); }
      __syncthreads();
#pragma unroll
      for (int i = 0; i < 9; ++i) { const int e = tt + NTHR * i; *(u32x4*)(W + (e >> 3) * NWK + (e & 7) * 8) = rw[i]; }
      __syncthreads();
      const bf16_t* qp = Q + (tokbase + qpos) * 1024 + h * 64 + gg * 8;
      const bf16x8 q0 = *(const bf16x8*)qp, q1 = *(const bf16x8*)(qp + 32);
      f32x4 S[32];
#pragma unroll
      for (int kt = 0; kt < 32; ++kt) {
        f32x4 s;
        if (kt < 16) {
          const bf16_t* kp = W + ((dr + (kt >> 1)) * 64 + band0 + 16 * (kt & 1) + ll) * NWK + gg * 8;
          s = mfma16(*(const bf16x8*)kp, q0, (f32x4){0.f, 0.f, 0.f, 0.f}); s = mfma16(*(const bf16x8*)(kp + 32), q1, s);
          const int qcol = 16 * n + ll, wstart = clampi(qcol - 8, 0, 48); const float* bp = rl + (rs + (kt >> 1) - r + 7) * 31;
#pragma unroll
          for (int rr = 0; rr < 4; ++rr) { const int kcol = band0 + 16 * (kt & 1) + 4 * gg + rr; const bool ok = kcol >= wstart && kcol < wstart + 16;
            s[rr] = ok ? (s[rr] + bp[clampi(kcol - qcol + 15, 0, 30)]) * LOG2E : -1e30f; }
        } else {
          const bf16_t* kp = Kc + (16 * (kt - 16) + ll) * NKC + gg * 8;
          s = mfma16(*(const bf16x8*)kp, q0, (f32x4){0.f, 0.f, 0.f, 0.f}); s = mfma16(*(const bf16x8*)(kp + 32), q1, s);
          s = s * LOG2E;
        }
        S[kt] = s;
        if ((kt & 7) == 7) asm volatile("" ::: "memory");
      }
      float mx = S[0][0];
#pragma unroll
      for (int kt = 0; kt < 32; ++kt) mx = fmaxf(fmaxf(fmaxf(mx, S[kt][0]), fmaxf(S[kt][1], S[kt][2])), S[kt][3]);
      mx = fmaxf(mx, __shfl_xor(mx, 16)); mx = fmaxf(mx, __shfl_xor(mx, 32));
      float ls = 0.f;
#pragma unroll
      for (int kt = 0; kt < 32; ++kt)
#pragma unroll
        for (int rr = 0; rr < 4; ++rr) { S[kt][rr] = __builtin_amdgcn_exp2f(S[kt][rr] - mx); ls += S[kt][rr]; }
      ls += __shfl_xor(ls, 16); ls += __shfl_xor(ls, 32);
      bf16x8 pf[16];
#pragma unroll
      for (int kk = 0; kk < 16; ++kk) pf[kk] = pack8(S[2 * kk][0], S[2 * kk][1], S[2 * kk][2], S[2 * kk][3], S[2 * kk + 1][0], S[2 * kk + 1][1], S[2 * kk + 1][2], S[2 * kk + 1][3]);
#pragma unroll
      for (int i = 0; i < 9; ++i) { const int e = tt + NTHR * i, d = e / 72, pc = e - d * 72; rw[i] = *(const u32x4*)(vbase + (size_t)d * PB + rs0 * 64 + pc * 8); }
      __syncthreads();
#pragma unroll
      for (int i = 0; i < 9; ++i) { const int e = tt + NTHR * i, d = e / 72, pc = e - d * 72; *(u32x4*)(W + d * NWV + pc * 8) = rw[i]; }
      __syncthreads();
      f32x4 O[4];
#pragma unroll
      for (int dt = 0; dt < 4; ++dt) O[dt] = (f32x4){0.f, 0.f, 0.f, 0.f};
#pragma unroll
      for (int kk = 0; kk < 16; ++kk) {
        if (kk < 8) {
#pragma unroll
          for (int dt = 0; dt < 4; ++dt) { const bf16_t* vp = W + (dt * 16 + ll) * NWV + (dr + kk) * 64 + band0 + 4 * gg; const bf16x8 vf = cat44(*(const s16x4*)vp, *(const s16x4*)(vp + 16)); O[dt] = mfma16(vf, pf[kk], O[dt]); }
        } else {
#pragma unroll
          for (int dt = 0; dt < 4; ++dt) { const bf16_t* vp = Vc + (dt * 16 + ll) * NVC + 32 * (kk - 8) + 4 * gg; const bf16x8 vf = cat44(*(const s16x4*)vp, *(const s16x4*)(vp + 16)); O[dt] = mfma16(vf, pf[kk], O[dt]); }
        }
        if ((kk & 3) == 3) asm volatile("" ::: "memory");
      }
      const float inv = 1.f / ls; bf16_t* op = o + (tokbase + qpos) * 1024 + h * 64 + 4 * gg;
#pragma unroll
      for (int dt = 0; dt < 4; ++dt) st4bf(op + 16 * dt, O[dt] * inv);
    }
    if (w < 4) na_ctx_wave(Q, o, Kc, Vc, b, h, qtr * 4 + w, lane);
  }
}

template <int DK> struct ScanLds { static constexpr int QLD = DK + 8, TLD = 72;
  static constexpr int OFF_QD = 0, OFF_KD = OFF_QD + 64 * QLD * 2, OFF_VT = OFF_KD + 64 * QLD * 2, OFF_ATT = OFF_VT + 64 * TLD * 2, OFF_ST = OFF_ATT + 64 * TLD * 2, OFF_EB = OFF_ST + 64 * QLD * 2, OFF_QS = OFF_EB + DK * 4, TOTAL = OFF_QS + 8 * DK * 4; };
DI int scan_pos(int dir, int i, int tl) { if (dir == 0) return i * 64 + tl; return i < 4 ? 255 - (i * 64 + tl) : 8447 - ((i - 4) * 64 + tl); }
DI bf16x8 gather8(const bf16_t* p, int stride) {
  const unsigned a0 = p[0], a1 = p[stride], a2 = p[2 * stride], a3 = p[3 * stride], a4 = p[4 * stride], a5 = p[5 * stride], a6 = p[6 * stride], a7 = p[7 * stride];
  u32x4 r; r.x = a0 | (a1 << 16); r.y = a2 | (a3 << 16); r.z = a4 | (a5 << 16); r.w = a6 | (a7 << 16); return __builtin_bit_cast(bf16x8, r);
}

template <int N> DI void pin_frags(bf16x8 (&f)[N]) {
  if constexpr (N == 8) asm volatile("" : "+v"(f[0]), "+v"(f[1]), "+v"(f[2]), "+v"(f[3]), "+v"(f[4]), "+v"(f[5]), "+v"(f[6]), "+v"(f[7]));
  else if constexpr (N == 4) asm volatile("" : "+v"(f[0]), "+v"(f[1]), "+v"(f[2]), "+v"(f[3]));
  else if constexpr (N == 2) asm volatile("" : "+v"(f[0]), "+v"(f[1]));
}
template <int DK, bool HG, int DVS>
DI void scan_phase(const Params& p, char* lds) {
  typedef ScanLds<DK> L;
  bf16_t* Qd = (bf16_t*)(lds + L::OFF_QD); bf16_t* Kd = (bf16_t*)(lds + L::OFF_KD); bf16_t* Vt = (bf16_t*)(lds + L::OFF_VT);
  bf16_t* Att = (bf16_t*)(lds + L::OFF_ATT); bf16_t* St = (bf16_t*)(lds + L::OFF_ST); float* eb = (float*)(lds + L::OFF_EB); float* qs = (float*)(lds + L::OFF_QS);
  constexpr int QLD = L::QLD, TLD = L::TLD, KT = DK / 16 / 8;
  const int tid = tid_(), lane = tid & 63, w = tid >> 6, g4 = lane >> 4, l16 = lane & 15;
  const int nitems = 256; constexpr int NVI = DVS / 16, NTO = NVI * 4 / 8;
  const float* lbv = (const float*)(p.ws + OFF_LBV);
  for (int item = blockIdx.x; item < nitems; item += gridDim.x) {
    const int xcd = item & 7, yy = item >> 3; int b, h, sl, dir;
    if (HG) { const int grp = xcd * 8 + (yy >> 2); sl = yy & 3; h = grp & 7; b = (grp >> 3) & 3; dir = grp >> 5; }
    else { const int grp = xcd * 4 + (yy >> 3); sl = yy & 7; h = grp & 3; b = (grp >> 2) & 3; dir = grp >> 4; }
    const size_t tokbase = (size_t)b * PB;
    const bf16_t *qsrc, *ksrc, *vsrc; int ldq, ldv; bf16_t *octx, *olat; int ldo;
    if (HG) { const bf16_t* ph = (const bf16_t*)(p.ws + H_P); qsrc = ph + h * 128; ksrc = ph + 1024 + dir * 1024 + h * 128; vsrc = ph + 3072 + h * 128 + sl * DVS; ldq = 5120; ldv = 5120; ldo = 1024;
      octx = (bf16_t*)(p.ws + (dir ? OFF_W0 : OFF_A)) + tokbase * 1024 + h * 128 + sl * DVS; olat = octx + (size_t)LC * 1024; }
    else { const bf16_t* qk = (const bf16_t*)(p.ws + R_QK); qsrc = qk + h * 256; ksrc = qk + 1024 + h * 256; vsrc = (const bf16_t*)(p.ws + R_V) + h * 512 + sl * 64; ldq = 2048; ldv = 2048; ldo = 2048;
      if (dir == 0) { octx = (bf16_t*)(p.ws + R_O) + tokbase * 2048 + h * 512 + sl * 64; olat = octx + (size_t)LC * 2048; }
      else { octx = (bf16_t*)(p.ws + OFF_HCTX) + (size_t)b * LC * 2048 + h * 512 + sl * 64; olat = (bf16_t*)p.out + (size_t)b * LL * 2048 + h * 512 + sl * 64; } }
    float lg = 0.f; if (!HG) lg = -__expf(p.ret_decay[dir * 4 + h]);
    float lb0 = 0.f, lb1 = 0.f; if (HG) { lb0 = lbv[h * 128 + 2 * (tid & 63)]; lb1 = lbv[h * 128 + 2 * (tid & 63) + 1]; }
    f32x4 sacc[KT][NVI];
#pragma unroll
    for (int a = 0; a < KT; ++a)
#pragma unroll
      for (int v = 0; v < NVI; ++v) sacc[a][v] = (f32x4){0.f, 0.f, 0.f, 0.f};
    u32x4 rq[4], rk[4], rvv; unsigned rf[8], rqq[8]; float bl[16], qv[16], kv[16];
    const int vtl = tid & 63, vvc = tid >> 6;
    auto issue = [&](int i) {
      if (HG) { const int kp = tid & 63, seg = tid >> 6;
#pragma unroll
        for (int j = 0; j < 8; ++j) { const size_t row = tokbase + scan_pos(dir, i, seg * 8 + j); rf[j] = *(const unsigned*)(ksrc + row * ldq + 2 * kp); rqq[j] = *(const unsigned*)(qsrc + row * ldq + 2 * kp); } }
      else {
#pragma unroll
        for (int it = 0; it < 4; ++it) { const int e = tid + NTHR * it, tl = e >> 5, kc = e & 31; const size_t row = tokbase + scan_pos(dir, i, tl); rq[it] = *(const u32x4*)(qsrc + row * ldq + kc * 8); rk[it] = *(const u32x4*)(ksrc + row * ldq + kc * 8); } }
      if (vvc < DVS / 8) { const size_t row = tokbase + scan_pos(dir, i, vtl); rvv = *(const u32x4*)(vsrc + row * ldv + vvc * 8); }
    };
    auto prep = [&]() {
      const int kp = tid & 63, seg = tid >> 6; float run0 = 1.f, run1 = 1.f;
#pragma unroll
      for (int j = 0; j < 8; ++j) { const float f0 = bflo(rf[j]), f1 = bfhi(rf[j]); qv[2 * j] = bflo(rqq[j]); qv[2 * j + 1] = bfhi(rqq[j]);
        const float s0 = __builtin_amdgcn_rcpf(1.f + __expf(-f0)), s1 = __builtin_amdgcn_rcpf(1.f + __expf(-f1)); const float g0 = lb0 + (1.f - lb0) * s0, g1 = lb1 + (1.f - lb1) * s1;
        kv[2 * j] = 1.f - g0; kv[2 * j + 1] = 1.f - g1; run0 *= g0; run1 *= g1; bl[2 * j] = run0; bl[2 * j + 1] = run1; }
      qs[seg * DK + 2 * kp] = run0; qs[seg * DK + 2 * kp + 1] = run1;
    };
    __syncthreads();
    issue(0); if (HG) prep();
    __syncthreads();
    for (int i = 0; i < 132; ++i) {
      if (HG) { const int kp = tid & 63, seg = tid >> 6; float off0 = 1.f, off1 = 1.f;
#pragma unroll
        for (int q = 0; q < 7; ++q) if (q < seg) { off0 *= qs[q * DK + 2 * kp]; off1 *= qs[q * DK + 2 * kp + 1]; }
        if (seg == 7) { eb[2 * kp] = off0 * bl[14]; eb[2 * kp + 1] = off1 * bl[15]; }
#pragma unroll
        for (int j = 0; j < 8; ++j) { const int tl = seg * 8 + j; const float p0 = bl[2 * j] * off0, p1 = bl[2 * j + 1] * off1;
          *(unsigned*)(Qd + tl * QLD + 2 * kp) = pk2(qv[2 * j] * p0, qv[2 * j + 1] * p1);
          *(unsigned*)(Kd + tl * QLD + 2 * kp) = pk2(kv[2 * j] * __builtin_amdgcn_rcpf(p0), kv[2 * j + 1] * __builtin_amdgcn_rcpf(p1)); } }
      else {
        if (tid < DK) eb[tid] = __expf(64.f * lg);
#pragma unroll
        for (int it = 0; it < 4; ++it) { const int e = tid + NTHR * it, tl = e >> 5, kc = e & 31; const u32x4 qr = rq[it], kr = rk[it];
          const float eq = __expf((float)(tl + 1) * lg), ek = __expf(-(float)(tl + 1) * lg);
          u32x4 qo, ko; qo.x = pk2(bflo(qr.x) * eq, bfhi(qr.x) * eq); qo.y = pk2(bflo(qr.y) * eq, bfhi(qr.y) * eq); qo.z = pk2(bflo(qr.z) * eq, bfhi(qr.z) * eq); qo.w = pk2(bflo(qr.w) * eq, bfhi(qr.w) * eq);
          ko.x = pk2(bflo(kr.x) * ek, bfhi(kr.x) * ek); ko.y = pk2(bflo(kr.y) * ek, bfhi(kr.y) * ek); ko.z = pk2(bflo(kr.z) * ek, bfhi(kr.z) * ek); ko.w = pk2(bflo(kr.w) * ek, bfhi(kr.w) * ek);
          *(u32x4*)(Qd + tl * QLD + kc * 8) = qo; *(u32x4*)(Kd + tl * QLD + kc * 8) = ko; } }
      if (vvc < DVS / 8) { bf16_t* vt = Vt + (vvc * 8) * TLD + vtl; const u32x4 vr = rvv;
        vt[0] = (bf16_t)(vr.x & 0xffff); vt[TLD] = (bf16_t)(vr.x >> 16); vt[2 * TLD] = (bf16_t)(vr.y & 0xffff); vt[3 * TLD] = (bf16_t)(vr.y >> 16);
        vt[4 * TLD] = (bf16_t)(vr.z & 0xffff); vt[5 * TLD] = (bf16_t)(vr.z >> 16); vt[6 * TLD] = (bf16_t)(vr.w & 0xffff); vt[7 * TLD] = (bf16_t)(vr.w >> 16); }
#pragma unroll
      for (int a = 0; a < KT; ++a) { const int ki = w * KT + a;
#pragma unroll
        for (int vi = 0; vi < NVI; ++vi) st4bf(St + (16 * vi + l16) * QLD + 16 * ki + 4 * g4, sacc[a][vi]); }
      __syncthreads();
      if (i + 1 < 132) issue(i + 1);
      { const int ti = w >> 1;
        bf16x8 qf[DK / 32];
#pragma unroll
        for (int ks = 0; ks < DK / 32; ++ks) qf[ks] = *(const bf16x8*)(Qd + (16 * ti + l16) * QLD + ks * 32 + g4 * 8);
#pragma unroll
        for (int u = 0; u < 2; ++u) { const int si = (2 * w + u) & 3; f32x4 d = (f32x4){0.f, 0.f, 0.f, 0.f};
          if (si <= ti) { bf16x8 kf[DK / 32];
#pragma unroll
            for (int ks = 0; ks < DK / 32; ++ks) kf[ks] = *(const bf16x8*)(Kd + (16 * si + l16) * QLD + ks * 32 + g4 * 8);
            pin_frags(kf);
#pragma unroll
            for (int ks = 0; ks < DK / 32; ++ks) d = mfma16(kf[ks], qf[ks], d); }
          const int t = 16 * ti + l16, s0 = 16 * si + 4 * g4;
#pragma unroll
          for (int rr = 0; rr < 4; ++rr) if (s0 + rr > t) d[rr] = 0.f;
          st4bf(Att + t * TLD + s0, d); } }
      __syncthreads();
      { const int vi = (NTO * w) >> 2;
        bf16x8 xv[2], xs[DK / 32];
#pragma unroll
        for (int ks = 0; ks < 2; ++ks) xv[ks] = *(const bf16x8*)(Vt + (16 * vi + l16) * TLD + ks * 32 + g4 * 8);
#pragma unroll
        for (int ks = 0; ks < DK / 32; ++ks) xs[ks] = *(const bf16x8*)(St + (16 * vi + l16) * QLD + ks * 32 + g4 * 8);
        pin_frags(xv); pin_frags(xs);
#pragma unroll
        for (int u = 0; u < NTO; ++u) { const int ti = (NTO * w + u) & 3; bf16x8 ya[2], yq[DK / 32];
#pragma unroll
          for (int ks = 0; ks < 2; ++ks) ya[ks] = *(const bf16x8*)(Att + (16 * ti + l16) * TLD + ks * 32 + g4 * 8);
#pragma unroll
          for (int ks = 0; ks < DK / 32; ++ks) yq[ks] = *(const bf16x8*)(Qd + (16 * ti + l16) * QLD + ks * 32 + g4 * 8);
          pin_frags(ya); pin_frags(yq);
          f32x4 d = (f32x4){0.f, 0.f, 0.f, 0.f};
#pragma unroll
          for (int ks = 0; ks < 2; ++ks) d = mfma16(xv[ks], ya[ks], d);
#pragma unroll
          for (int ks = 0; ks < DK / 32; ++ks) d = mfma16(xs[ks], yq[ks], d);
          const int pos = scan_pos(dir, i, 16 * ti + l16); bf16_t* op = (pos < LC ? octx + (size_t)pos * ldo : olat + (size_t)(pos - LC) * ldo) + 16 * vi + 4 * g4;
          st4bf(op, d); } }
      { bf16x8 yv[NVI][2];
#pragma unroll
        for (int vi = 0; vi < NVI; ++vi)
#pragma unroll
          for (int ks = 0; ks < 2; ++ks) yv[vi][ks] = *(const bf16x8*)(Vt + (16 * vi + l16) * TLD + ks * 32 + g4 * 8);
#pragma unroll
        for (int a = 0; a < KT; ++a) { const int ki = w * KT + a; bf16x8 xf[2];
#pragma unroll
          for (int ks = 0; ks < 2; ++ks) xf[ks] = gather8(Kd + (ks * 32 + g4 * 8) * QLD + 16 * ki + l16, QLD);
#pragma unroll
          for (int ks = 0; ks < 2; ++ks)
#pragma unroll
            for (int vi = 0; vi < NVI; ++vi) sacc[a][vi] = mfma16(xf[ks], yv[vi][ks], sacc[a][vi]);
          const f32x4 e4 = *(const f32x4*)(eb + 16 * ki + 4 * g4);
#pragma unroll
          for (int vi = 0; vi < NVI; ++vi) sacc[a][vi] = sacc[a][vi] * e4; } }
      if (HG && i + 1 < 132) prep();
      __syncthreads();
    }
  }
}

DI float bsum2(unsigned a, unsigned b, float& lo, float& hi) { lo = bflo(a) + bflo(b); hi = bfhi(a) + bfhi(b); return lo * lo + hi * hi; }
DI void ret_readout_phase(const Params& p) {
  bf16_t* O = (bf16_t*)(p.ws + R_O); const bf16_t* G = (const bf16_t*)(p.ws + R_QK);
  const int tid = threadIdx.x, lane = tid & 63, gw = blockIdx.x * 8 + (tid >> 6), nw = gridDim.x * 8;
  for (int t = gw; t < T_ALL; t += nw) {
    const int b = t / PB, pp = t - b * PB;
    const bf16_t* ob = (pp < LC ? (const bf16_t*)(p.ws + OFF_HCTX) + (size_t)(b * LC + pp) * 2048 : (const bf16_t*)p.out + (size_t)(b * LL + pp - LC) * 2048) + lane * 32;
    bf16_t* op = O + (size_t)t * 2048 + lane * 32; const bf16_t* gp = G + (size_t)t * 2048 + lane * 32;
    float ov[32]; u32x4 gv[4]; float sq = 0.f;
#pragma unroll
    for (int i = 0; i < 4; ++i) { const u32x4 x = *(const u32x4*)(op + i * 8), y = *(const u32x4*)(ob + i * 8); gv[i] = *(const u32x4*)(gp + i * 8);
      sq += bsum2(x.x, y.x, ov[8 * i], ov[8 * i + 1]) + bsum2(x.y, y.y, ov[8 * i + 2], ov[8 * i + 3]) + bsum2(x.z, y.z, ov[8 * i + 4], ov[8 * i + 5]) + bsum2(x.w, y.w, ov[8 * i + 6], ov[8 * i + 7]); }
    sq += __shfl_xor(sq, 1); sq += __shfl_xor(sq, 2); sq += __shfl_xor(sq, 4); sq += __shfl_xor(sq, 8);
    const float rstd = rsqrtf(sq * (1.f / 512.f) + 1e-6f);
#pragma unroll
    for (int i = 0; i < 4; ++i) { u32x4 r;
      r.x = pk2(siluf(bflo(gv[i].x)) * ov[8 * i] * rstd, siluf(bfhi(gv[i].x)) * ov[8 * i + 1] * rstd); r.y = pk2(siluf(bflo(gv[i].y)) * ov[8 * i + 2] * rstd, siluf(bfhi(gv[i].y)) * ov[8 * i + 3] * rstd);
      r.z = pk2(siluf(bflo(gv[i].z)) * ov[8 * i + 4] * rstd, siluf(bfhi(gv[i].z)) * ov[8 * i + 5] * rstd); r.w = pk2(siluf(bflo(gv[i].w)) * ov[8 * i + 6] * rstd, siluf(bfhi(gv[i].w)) * ov[8 * i + 7] * rstd);
      *(u32x4*)(op + i * 8) = r; }
  }
}
DI void hg_readout_phase(const Params& p) {
  bf16_t* O = (bf16_t*)(p.ws + OFF_A); const bf16_t* OB = (const bf16_t*)(p.ws + OFF_W0); const bf16_t* ph = (const bf16_t*)(p.ws + H_P);
  const int tid = threadIdx.x, lane = tid & 63, gw = blockIdx.x * 8 + (tid >> 6), nw = gridDim.x * 8;
  for (int t = gw; t < T_ALL; t += nw) {
    bf16_t* op = O + (size_t)t * 1024 + lane * 16; const bf16_t* ob = OB + (size_t)t * 1024 + lane * 16; const bf16_t* gp = ph + (size_t)t * 5120 + 4096 + lane * 16; const float* ng = p.hg_norm_g + (lane & 7) * 16;
    float ov[16]; u32x4 gv[2]; float sq = 0.f;
#pragma unroll
    for (int i = 0; i < 2; ++i) { const u32x4 x = *(const u32x4*)(op + i * 8), y = *(const u32x4*)(ob + i * 8); gv[i] = *(const u32x4*)(gp + i * 8);
      sq += bsum2(x.x, y.x, ov[8 * i], ov[8 * i + 1]) + bsum2(x.y, y.y, ov[8 * i + 2], ov[8 * i + 3]) + bsum2(x.z, y.z, ov[8 * i + 4], ov[8 * i + 5]) + bsum2(x.w, y.w, ov[8 * i + 6], ov[8 * i + 7]); }
    sq += __shfl_xor(sq, 1); sq += __shfl_xor(sq, 2); sq += __shfl_xor(sq, 4);
    const float rstd = rsqrtf(sq * (1.f / 128.f) + 1e-6f);
#pragma unroll
    for (int i = 0; i < 2; ++i) { u32x4 r; const float* n8 = ng + i * 8;
      r.x = pk2(siluf(bflo(gv[i].x)) * ov[8 * i] * rstd * n8[0], siluf(bfhi(gv[i].x)) * ov[8 * i + 1] * rstd * n8[1]); r.y = pk2(siluf(bflo(gv[i].y)) * ov[8 * i + 2] * rstd * n8[2], siluf(bfhi(gv[i].y)) * ov[8 * i + 3] * rstd * n8[3]);
      r.z = pk2(siluf(bflo(gv[i].z)) * ov[8 * i + 4] * rstd * n8[4], siluf(bfhi(gv[i].z)) * ov[8 * i + 5] * rstd * n8[5]); r.w = pk2(siluf(bflo(gv[i].w)) * ov[8 * i + 6] * rstd * n8[6], siluf(bfhi(gv[i].w)) * ov[8 * i + 7] * rstd * n8[7]);
      *(u32x4*)(op + i * 8) = r; }
  }
}

#define XB_TMO      128
#define XB_XCNT(j)  (256  + 64 * (j))
#define XB_XSUB(j)  (1280 + 64 * (j))
#define XB_XGEN(j)  (2304 + 64 * (j))
#define XB_TOP      3328
#define XB_TOPGEN   3392
#define XCD_BAR_WORDS 3456
#define XB_SPIN_CAP (1u << 23)
#define LAS PG8_LAS

__device__ __forceinline__ unsigned xb_ld(unsigned* p)              { return __hip_atomic_load(p, __ATOMIC_RELAXED, __HIP_MEMORY_SCOPE_AGENT); }
__device__ __forceinline__ unsigned xb_add(unsigned* p, unsigned v) { return __hip_atomic_fetch_add(p, v, __ATOMIC_RELAXED, __HIP_MEMORY_SCOPE_AGENT); }
__device__ __forceinline__ unsigned xb_xcc_id() { return (unsigned)__builtin_amdgcn_s_getreg((3 << 11) | 20) & 0xFu; }
#define XB_SPIN(cond, bar) do { unsigned _sp = 0; while (cond) { __builtin_amdgcn_s_sleep(1); \
    if ((++_sp & 255u) == 0u) { if (xb_ld(&(bar)[XB_TMO])) break; if (_sp > XB_SPIN_CAP) { atomicAdd(&(bar)[XB_TMO], 1u); break; } } } } while (0)

struct XcdBarrier {
    unsigned* bar; unsigned x;
    volatile LAS unsigned* st;
};

__device__ __forceinline__ XcdBarrier xcd_barrier_post(unsigned* bar, volatile LAS unsigned* st) {
    XcdBarrier b; b.bar = bar; b.x = xb_xcc_id(); b.st = st;
    if (threadIdx.x == 0) (void)xb_add(&bar[XB_XCNT(b.x)], 1u);
    return b;
}
__device__ __forceinline__ void xcd_barrier_complete(unsigned* bar, unsigned x, unsigned& nloc, unsigned& nx) {
    const unsigned G = gridDim.x * gridDim.y * gridDim.z;
    unsigned sum, cnt, mine, sp = 0u;
    for (;;) {
        sum = 0u; cnt = 0u; mine = 0u;
#pragma unroll
        for (unsigned j = 0; j < 16; ++j) { const unsigned c = xb_ld(&bar[XB_XCNT(j)]); sum += c; cnt += (c > 0u) ? 1u : 0u; mine = (j == x) ? c : mine; }
        if (sum == G) break;
        __builtin_amdgcn_s_sleep(1);
        if ((++sp & 255u) == 0u) { if (xb_ld(&bar[XB_TMO])) break; if (sp > XB_SPIN_CAP) { atomicAdd(&bar[XB_TMO], 1u); break; } }
    }
    nloc = mine > 0u ? mine : 1u; nx = cnt > 0u ? cnt : 1u;
}

__device__ __forceinline__ void xcd_barrier(const XcdBarrier& b) {
    asm volatile("s_waitcnt vmcnt(0)" ::: "memory");
    __syncthreads();
    if (threadIdx.x == 0) {
        unsigned* bar = b.bar;
        __builtin_amdgcn_s_waitcnt(0);
        unsigned nloc = b.st[0], nx = b.st[1];
        if (nloc == 0u) { xcd_barrier_complete(bar, b.x, nloc, nx); b.st[0] = nloc; b.st[1] = nx; }
        const unsigned old = xb_add(&bar[XB_XSUB(b.x)], 1u);
        const unsigned gen = old / nloc;
        if (old + 1u == (gen + 1u) * nloc) {
            __builtin_amdgcn_fence(__ATOMIC_RELEASE, "agent");
            asm volatile("s_waitcnt vmcnt(0)" ::: "memory");
            const unsigned og = xb_add(&bar[XB_TOP], 1u);
            const unsigned tg = og / nx;
            if (og + 1u == (tg + 1u) * nx) xb_add(&bar[XB_TOPGEN], 1u);
            else XB_SPIN(xb_ld(&bar[XB_TOPGEN]) == tg, bar);
            __builtin_amdgcn_fence(__ATOMIC_ACQUIRE, "agent");
            xb_add(&bar[XB_XGEN(b.x)], 1u);
            asm volatile("s_waitcnt vmcnt(0)" ::: "memory");
        } else {
            XB_SPIN(xb_ld(&bar[XB_XGEN(b.x)]) == gen, bar);
            __builtin_amdgcn_fence(__ATOMIC_ACQUIRE, "agent");
            asm volatile("s_waitcnt vmcnt(0)" ::: "memory");
        }
    }
    __syncthreads();
}

constexpr int LDS_BYTES0 = ScanLds<256>::TOTAL > pg8::STAGE_BYTES ? ScanLds<256>::TOTAL : pg8::STAGE_BYTES;
constexpr int LDS_BYTES = LDS_BYTES0 > NA_LDS ? LDS_BYTES0 : NA_LDS;
static_assert(LDS_BYTES <= 163840, "LDS");
static_assert(LDS_BYTES >= (256 + 128) * LDT * 2 && LDS_BYTES >= 3 * 64 * (KLD + VLD) * 2 && LDS_BYTES >= (5120 + 8 * 5 * 64) * 4, "LDS phases");

DI void ffn_and_ln(const Params& p, const XcdBarrier& xb, char* lds, int layer, const bf16_t* w13, const bf16_t* w2) {
  const float* mods = (const float*)(p.ws + OFF_MODS); float* hctx = (float*)(p.ws + OFF_HCTX); bf16_t* a = (bf16_t*)(p.ws + OFF_A); bf16_t* U = (bf16_t*)(p.ws + F_U);
  { EpiSwiglu e{U}; big_gemm(a, w13, T_ALL, 5632, 1024, e, lds, layer == 3); }
  xcd_barrier(xb);
  { EpiResid e{p.out, hctx, p.out, hctx, mods + (size_t)layer * 5 * 6144 + 5 * 1024, (const float2*)(p.ws + OFF_LNS), p.ln_g + (size_t)(layer * 2) * 1024, p.ln_b + (size_t)(layer * 2) * 1024}; big_gemm(U, w2, T_ALL, 1024, FF, e, lds, layer == 3); }
  xcd_barrier(xb);
  ln_phase(p, layer, 1, layer < 3 ? layer + 1 : 3, 0, layer == 3);
  xcd_barrier(xb);
}

__global__ void __launch_bounds__(NTHR) mega(Params p) {
  __shared__ __attribute__((aligned(16))) char lds[LDS_BYTES];
  cg::grid_group grid = cg::this_grid();
  __shared__ uint4 xb_words;
  if (threadIdx.x == 0) xb_words = make_uint4(0u, 0u, 0u, 0u);
  __syncthreads();
  const XcdBarrier xb = xcd_barrier_post((unsigned*)(p.ws + OFF_BAR), (volatile LAS unsigned*)&xb_words);
  float* ldsf = (float*)lds;
  const float* mods = (const float*)(p.ws + OFF_MODS); float* hctx = (float*)(p.ws + OFF_HCTX); bf16_t* a = (bf16_t*)(p.ws + OFF_A);
  const float2* tabR = (const float2*)(p.ws + OFF_TABR); const float2* tabM = (const float2*)(p.ws + OFF_TABM); float* rs = (float*)(p.ws + OFF_RS);
  ada_phase(p, ldsf);
  tables_phase(p);
  convert_w<2>(p.ret_w_in, 6144, 1024, (bf16_t*)(p.ws + W0_RETIN), 6144, nullptr, ldsf);
  convert_w<0>(p.ret_w_out, 1024, 2048, (bf16_t*)(p.ws + W0_RETOUT), 1024, nullptr, ldsf);
  convert_w<1>(p.w13, 5632, 1024, (bf16_t*)(p.ws + W0_W13), 5632, nullptr, ldsf);
  convert_w<0>(p.w2, 1024, FF, (bf16_t*)(p.ws + W0_W2), 1024, nullptr, ldsf);
  grid.sync();
  modulate_phase(p, p.x, p.ctx, 0);
  xcd_barrier(xb);
  { const bf16_t* wi = (const bf16_t*)(p.ws + W0_RETIN);
    { EpiRetQK e{(bf16_t*)(p.ws + R_QK), tabR}; big_gemm(a, wi, T_ALL, 2048, 1024, e, lds); }
    { EpiStore e{(bf16_t*)(p.ws + R_V), (bf16_t*)(p.ws + R_V), 1 << 30, 2048, 2048, 1.f}; big_gemm(a, wi + (size_t)2048 * 1024, T_ALL, 2048, 1024, e, lds); }
    xcd_barrier(xb);
    scan_phase<256, false, 64>(p, lds);
    xcd_barrier(xb);
    { EpiStore e{(bf16_t*)(p.ws + R_QK), (bf16_t*)(p.ws + R_QK), 1 << 30, 2048, 2048, 1.f}; big_gemm(a, wi + (size_t)4096 * 1024, T_ALL, 2048, 1024, e, lds); }
    xcd_barrier(xb);
    ret_readout_phase(p);
    xcd_barrier(xb);
    { EpiResid e{p.x, p.ctx, p.out, hctx, mods + 2 * 1024, nullptr, nullptr, nullptr}; big_gemm((const bf16_t*)(p.ws + R_O), (const bf16_t*)(p.ws + W0_RETOUT), T_ALL, 1024, 2048, e, lds); }
    xcd_barrier(xb);
    ln_phase(p, 0, 0, 0, 3, false);
    convert_w<0>(p.na_w_qkv, 3072, 1024, (bf16_t*)(p.ws + W1_QKV), 3072, nullptr, ldsf);
    convert_w<0>(p.na_w_out, 1024, 1024, (bf16_t*)(p.ws + W1_OUT), 1024, nullptr, ldsf);
    convert_w<1>(p.w13 + (size_t)1 * 1024 * 5632, 5632, 1024, (bf16_t*)(p.ws + W1_W13), 5632, nullptr, ldsf);
    convert_w<0>(p.w2 + (size_t)1 * FF * 1024, 1024, FF, (bf16_t*)(p.ws + W1_W2), 1024, nullptr, ldsf);
    convert_w<5>(p.mla_w_down, 800, 1024, (bf16_t*)(p.ws + W2_DOWN), 1024, nullptr, ldsf);
    convert_w<3>(p.mla_w_uq, 1536, 512, (bf16_t*)(p.ws + W2_UQ), 1536, p.mla_q_norm, ldsf);
    convert_w<4>(p.mla_w_ukv, 2048, 256, (bf16_t*)(p.ws + W2_UKV), 2048, p.mla_kv_norm, ldsf);
    convert_w<0>(p.mla_w_out, 1024, 1024, (bf16_t*)(p.ws + W2_OUT), 1024, nullptr, ldsf);
    convert_w<1>(p.w13 + (size_t)2 * 1024 * 5632, 5632, 1024, (bf16_t*)(p.ws + W2_W13), 5632, nullptr, ldsf);
    convert_w<0>(p.w2 + (size_t)2 * FF * 1024, 1024, FF, (bf16_t*)(p.ws + W2_W2), 1024, nullptr, ldsf);
    convert_w<0>(p.hg_w_in, 5120, 1024, (bf16_t*)(p.ws + W3_IN), 5120, nullptr, ldsf);
    convert_w<0>(p.hg_w_out, 1024, 1024, (bf16_t*)(p.ws + W3_OUT), 1024, nullptr, ldsf);
    convert_w<1>(p.w13 + (size_t)3 * 1024 * 5632, 5632, 1024, (bf16_t*)(p.ws + W3_W13), 5632, nullptr, ldsf);
    convert_w<0>(p.w2 + (size_t)3 * FF * 1024, 1024, FF, (bf16_t*)(p.ws + W3_W2), 1024, nullptr, ldsf);
    xcd_barrier(xb);
    ffn_and_ln(p, xb, lds, 0, (const bf16_t*)(p.ws + W0_W13), (const bf16_t*)(p.ws + W0_W2));
  }
  { const bf16_t* wq = (const bf16_t*)(p.ws + W1_QKV);
    { EpiStore e{(bf16_t*)(p.ws + N_Q), (bf16_t*)(p.ws + N_K), 1024, 1024, 1024, 0.125f}; big_gemm(a, wq, T_ALL, 2048, 1024, e, lds); }
    { GemmArgs g{a, 1024, wq + (size_t)2048 * 1024, 1024, T_ALL, 1024, 1024}; EpiVT e{(bf16_t*)(p.ws + N_VT), nullptr}; gemm_phase<true>(g, e, lds); }
    xcd_barrier(xb);
    na_attn_phase(p, lds);
    xcd_barrier(xb);
    { EpiResid e{p.out, hctx, p.out, hctx, mods + (size_t)1 * 5 * 6144 + 2 * 1024, (const float2*)(p.ws + OFF_LNS), p.ln_g + (size_t)(0 * 2 + 1) * 1024, p.ln_b + (size_t)(0 * 2 + 1) * 1024}; big_gemm(a, (const bf16_t*)(p.ws + W1_OUT), T_ALL, 1024, 1024, e, lds); }
    xcd_barrier(xb);
    ln_phase(p, 1, 0, 1, 3, false);
    xcd_barrier(xb);
    ffn_and_ln(p, xb, lds, 1, (const bf16_t*)(p.ws + W1_W13), (const bf16_t*)(p.ws + W1_W2));
  }
  { const bf16_t* d0 = (const bf16_t*)(p.ws + M_D0);
    { EpiStore e{(bf16_t*)(p.ws + M_D0), (bf16_t*)(p.ws + M_D0), 1 << 30, 1024, 1024, 1.f}; big_gemm(a, (const bf16_t*)(p.ws + W2_DOWN), T_ALL, 1024, 1024, e, lds); }
    xcd_barrier(xb);
    mla_stats_phase(p);
    xcd_barrier(xb);
    { GemmArgs g{d0, 1024, (const bf16_t*)(p.ws + W2_UQ), 512, T_ALL, 1536, 512}; EpiMlaQ e{(bf16_t*)(p.ws + M_Q), rs, tabM}; gemm_phase<false>(g, e, lds); }
    { GemmArgs g{d0 + 512, 1024, (const bf16_t*)(p.ws + W2_UKV), 256, T_ALL, 1024, 256}; EpiMlaK e{(bf16_t*)(p.ws + M_K), rs}; gemm_phase<false>(g, e, lds); }
    { GemmArgs g{d0 + 512, 1024, (const bf16_t*)(p.ws + W2_UKV) + (size_t)1024 * 256, 256, T_ALL, 1024, 256}; EpiVT e{(bf16_t*)(p.ws + M_VT), rs}; gemm_phase<true>(g, e, lds); }
    xcd_barrier(xb);
    mla_attn_phase(p, lds);
    xcd_barrier(xb);
    { EpiResid e{p.out, hctx, p.out, hctx, mods + (size_t)2 * 5 * 6144 + 2 * 1024, (const float2*)(p.ws + OFF_LNS), p.ln_g + (size_t)(1 * 2 + 1) * 1024, p.ln_b + (size_t)(1 * 2 + 1) * 1024}; big_gemm(a, (const bf16_t*)(p.ws + W2_OUT), T_ALL, 1024, 1024, e, lds); }
    xcd_barrier(xb);
    ln_phase(p, 2, 0, 2, 3, false);
    xcd_barrier(xb);
    ffn_and_ln(p, xb, lds, 2, (const bf16_t*)(p.ws + W2_W13), (const bf16_t*)(p.ws + W2_W2));
  }
  { { EpiHg e{(bf16_t*)(p.ws + H_P)}; big_gemm(a, (const bf16_t*)(p.ws + W3_IN), T_ALL, 5120, 1024, e, lds); }
    xcd_barrier(xb);
    scan_phase<128, true, 32>(p, lds);
    xcd_barrier(xb);
    hg_readout_phase(p);
    xcd_barrier(xb);
    { EpiResid e{p.out, hctx, p.out, hctx, mods + (size_t)3 * 5 * 6144 + 2 * 1024, (const float2*)(p.ws + OFF_LNS), p.ln_g + (size_t)(2 * 2 + 1) * 1024, p.ln_b + (size_t)(2 * 2 + 1) * 1024}; big_gemm(a, (const bf16_t*)(p.ws + W3_OUT), T_ALL, 1024, 1024, e, lds, 1); }
    xcd_barrier(xb);
    ln_phase(p, 3, 0, 3, 3, false);
    xcd_barrier(xb);
    ffn_and_ln(p, xb, lds, 3, (const bf16_t*)(p.ws + W3_W13), (const bf16_t*)(p.ws + W3_W2));
  }
}

extern "C" void kernel_launch(void* const* d_in, const int* in_sizes, int n_in, void* d_out, int out_size, void* d_ws, size_t ws_size, hipStream_t stream) {
  static int grid_blocks = 0;
  if (!grid_blocks) {
    int dev = 0, cus = 0, per_cu = 0;
    (void)hipGetDevice(&dev);
    (void)hipDeviceGetAttribute(&cus, hipDeviceAttributeMultiprocessorCount, dev);
    (void)hipOccupancyMaxActiveBlocksPerMultiprocessor(&per_cu, mega, NTHR, 0);
    if (per_cu != 1) per_cu = 1;
    grid_blocks = cus * per_cu;
  }
  if (ws_size < WS_NEED) { fprintf(stderr, "workspace too small: %zu\n", ws_size); return; }
  Params p{};
  const float** f = (const float**)&p;
  for (int i = 0; i < 26; ++i) f[i] = (const float*)d_in[i];
  p.out = (float*)d_out; p.ws = (char*)d_ws;
  (void)hipMemsetAsync((char*)d_ws + OFF_BAR, 0, XCD_BAR_WORDS * 4, stream);
  void* args[] = {&p};
  hipError_t e = hipLaunchCooperativeKernel((void*)mega, dim3(grid_blocks), dim3(NTHR), args, 0, stream);
  if (e != hipSuccess) fprintf(stderr, "cooperative launch failed: %s (grid %d)\n", hipGetErrorString(e), grid_blocks);
}
```

```cpp
#include <hip/hip_runtime.h>
#include <hip/hip_cooperative_groups.h>
#include <cstdio>
#include <cstdint>
namespace cg = cooperative_groups;

#define DI __device__ __forceinline__
DI int tid_() { int t = threadIdx.x; asm volatile("" : "+v"(t)); return t; }
typedef unsigned short bf16_t;
typedef short bf16x8 __attribute__((ext_vector_type(8)));
typedef short s16x4 __attribute__((ext_vector_type(4)));
typedef float f32x4 __attribute__((ext_vector_type(4)));
typedef float f32x16 __attribute__((ext_vector_type(16)));
typedef unsigned u32x4 __attribute__((ext_vector_type(4)));
typedef unsigned u32x2 __attribute__((ext_vector_type(2)));

constexpr int NTHR = 512;
constexpr int T_ALL = 33792, PB = 8448, LC = 256, LL = 8192, DM = 1024, FF = 2816;
constexpr float ALPHA = 1.681792830507429f;
constexpr float LOG2E = 1.4426950408889634f;
constexpr size_t MiB = 1048576;

struct Params {
  const float *x, *c, *ctx, *cctx, *ada_w, *ada_b, *ln_g, *ln_b, *w13, *w2;
  const float *ret_w_in, *ret_decay, *ret_w_out, *na_w_qkv, *na_rpb, *na_w_out;
  const float *mla_w_down, *mla_q_norm, *mla_kv_norm, *mla_w_uq, *mla_w_ukv, *mla_w_out;
  const float *hg_w_in, *hg_lb, *hg_norm_g, *hg_w_out;
  float* out; char* ws;
};

constexpr size_t OFF_MODS = 0;
constexpr size_t OFF_TABR = 512 * 1024;
constexpr size_t OFF_TABM = OFF_TABR + 65536;
constexpr size_t OFF_LBV = OFF_TABM + 8192;
constexpr size_t OFF_RS = OFF_LBV + 4096;
constexpr size_t OFF_BAR = 896 * 1024;
constexpr size_t OFF_HCTX = 1 * MiB;
constexpr size_t OFF_A = 5 * MiB;
constexpr size_t OFF_W0 = 71 * MiB;
constexpr size_t OFF_BIG = 104 * MiB;
constexpr size_t OFF_WR = OFF_BIG;
constexpr size_t OFF_S = 180 * MiB;
constexpr size_t WS_NEED = 512 * MiB;
constexpr size_t OFF_LNS = 510 * MiB;
constexpr size_t W0_RETIN = OFF_W0, W0_RETOUT = W0_RETIN + (size_t)6144 * 1024 * 2, W0_W13 = W0_RETOUT + (size_t)1024 * 2048 * 2, W0_W2 = W0_W13 + (size_t)5632 * 1024 * 2;
constexpr size_t SZ_W13 = (size_t)5632 * 1024 * 2, SZ_W2 = (size_t)1024 * 2816 * 2, SZ_SQ = (size_t)1024 * 1024 * 2;
constexpr size_t W1_QKV = OFF_WR, W1_OUT = W1_QKV + (size_t)3072 * 1024 * 2, W1_W13 = W1_OUT + SZ_SQ, W1_W2 = W1_W13 + SZ_W13;
constexpr size_t W2_DOWN = W1_W2 + SZ_W2, W2_UQ = W2_DOWN + (size_t)1024 * 1024 * 2, W2_UKV = W2_UQ + (size_t)1536 * 512 * 2, W2_OUT = W2_UKV + (size_t)2048 * 256 * 2, W2_W13 = W2_OUT + SZ_SQ, W2_W2 = W2_W13 + SZ_W13;
constexpr size_t W3_IN = W2_W2 + SZ_W2, W3_OUT = W3_IN + (size_t)5120 * 1024 * 2, W3_W13 = W3_OUT + SZ_SQ, W3_W2 = W3_W13 + SZ_W13, W3_END = W3_W2 + SZ_W2;
static_assert(W3_END <= OFF_S, "rest weights overflow");
static_assert(W0_W2 + SZ_W2 <= OFF_BIG, "W0 overflow");
constexpr size_t SZ_T2048 = (size_t)T_ALL * 2048 * 2, SZ_T1024 = (size_t)T_ALL * 1024 * 2;
constexpr size_t R_QK = OFF_BIG, R_V = R_QK + SZ_T2048, R_O = R_V + SZ_T2048;
static_assert(R_O + SZ_T2048 <= WS_NEED, "retention overflow");
constexpr size_t N_Q = OFF_S, N_K = N_Q + SZ_T1024, N_VT = N_K + SZ_T1024;
constexpr size_t M_D0 = OFF_S, M_Q = M_D0 + (size_t)T_ALL * 1024 * 2, M_K = M_Q + (size_t)T_ALL * 1536 * 2, M_VT = M_K + (size_t)T_ALL * 1536 * 2;
static_assert(M_VT + SZ_T1024 <= WS_NEED, "mla overflow");
constexpr size_t H_P = OFF_S;
static_assert(H_P + (size_t)T_ALL * 5120 * 2 <= WS_NEED, "hgrn overflow");
constexpr size_t F_U = OFF_S;

typedef float f32x2 __attribute__((ext_vector_type(2)));
typedef __bf16 bf16x2_t __attribute__((ext_vector_type(2)));
DI unsigned pk2(float lo, float hi) { const f32x2 v = {lo, hi}; const bf16x2_t r = __builtin_convertvector(v, bf16x2_t); return __builtin_bit_cast(unsigned, r); }
DI float bflo(unsigned u) { return __uint_as_float(u << 16); }
DI float bfhi(unsigned u) { return __uint_as_float(u & 0xffff0000u); }
DI float bf2f(bf16_t v) { return __uint_as_float(((unsigned)v) << 16); }
DI bf16_t f2bf(float x) { return (bf16_t)(pk2(x, 0.f) & 0xffffu); }
DI float siluf(float x) { return x / (1.f + __expf(-x)); }
DI f32x4 mfma16(bf16x8 a, bf16x8 b, f32x4 c) { return __builtin_amdgcn_mfma_f32_16x16x32_bf16(a, b, c, 0, 0, 0); }
DI f32x16 mfma32(bf16x8 a, bf16x8 b, f32x16 c) { return __builtin_amdgcn_mfma_f32_32x32x16_bf16(a, b, c, 0, 0, 0); }
DI bf16x8 cat44(s16x4 lo, s16x4 hi) { return __builtin_shufflevector(lo, hi, 0, 1, 2, 3, 4, 5, 6, 7); }
DI bf16x8 pack8(float a0, float a1, float a2, float a3, float a4, float a5, float a6, float a7) {
  u32x4 p; p.x = pk2(a0, a1); p.y = pk2(a2, a3); p.z = pk2(a4, a5); p.w = pk2(a6, a7); return __builtin_bit_cast(bf16x8, p);
}
DI int clampi(int v, int lo, int hi) { return v < lo ? lo : (v > hi ? hi : v); }
DI float* hrow(float* hlat, float* hctx, int t) { const int b = t / PB, p = t - b * PB; return p < LC ? hctx + (size_t)(b * LC + p) * DM : hlat + (size_t)(b * LL + p - LC) * DM; }
DI const float* hrowc(const float* hlat, const float* hctx, int t) { const int b = t / PB, p = t - b * PB; return p < LC ? hctx + (size_t)(b * LC + p) * DM : hlat + (size_t)(b * LL + p - LC) * DM; }
DI int modvec(int t) { const int b = t / PB, p = t - b * PB; return p < LC ? 4 : b; }

template <int MODE> DI int srccol(int n) {
  if (MODE == 0) return n;
  if (MODE == 1) { const int c = n >> 5, s = (n >> 4) & 1, i = n & 15; return s * FF + 16 * c + i; }
  if (MODE == 2) { if (n >= 2048) return n; const int w = n & 255, j = w >> 1, s = w & 1; return (n & ~255) + s * 128 + j; }
  if (MODE == 3) { const int h = n / 96, w = n - h * 96; if (w < 64) return n; const int wp = w - 64, j = wp >> 1, s = wp & 1; return h * 96 + 64 + s * 16 + j; }
  if (MODE == 4) { if (n < 1024) return (n >> 6) * 128 + (n & 63); const int m = n - 1024; return (m >> 6) * 128 + 64 + (m & 63); }
  if (MODE == 5) return n < 800 ? n : -1;
  return n;
}
template <int MODE> DI f32x4 cvt_load4(const float* __restrict__ row, int n) {
  if (MODE == 2 && n < 2048) { const int w = n & 255, j = w >> 1; const float* b = row + (n & ~255) + j; const f32x2 lo = *(const f32x2*)b, hi = *(const f32x2*)(b + 128); return (f32x4){lo[0], hi[0], lo[1], hi[1]}; }
  if (MODE == 3) { return (f32x4){row[srccol<3>(n)], row[srccol<3>(n + 1)], row[srccol<3>(n + 2)], row[srccol<3>(n + 3)]}; }
  const int sc = srccol<MODE>(n); if (sc < 0) return (f32x4){0.f, 0.f, 0.f, 0.f};
  return *(const f32x4*)(row + sc);
}
template <int MODE>
DI void convert_w(const float* __restrict__ src, int Nsrc, int K, bf16_t* __restrict__ dst, int Ndst, const float* __restrict__ kscale, float* ldsf) {
  const int tid = threadIdx.x, tn = Ndst / 64, tk = K / 64;
  for (int tile = blockIdx.x; tile < tn * tk; tile += gridDim.x) {
    const int n0 = (tile % tn) * 64, k0 = (tile / tn) * 64;
    __syncthreads();
#pragma unroll
    for (int i = 0; i < 2; ++i) { const int kk = (tid >> 4) + 32 * i, nn = (tid & 15) * 4;
      f32x4 v = cvt_load4<MODE>(src + (size_t)(k0 + kk) * Nsrc, n0 + nn);
      if (kscale) v = v * kscale[k0 + kk];
      float* lp = ldsf + kk * 65 + nn; lp[0] = v[0]; lp[1] = v[1]; lp[2] = v[2]; lp[3] = v[3]; }
    __syncthreads();
    { const int nn = tid >> 3, kc = tid & 7; const float* lp = ldsf + (kc * 8) * 65 + nn;
      u32x4 o; o.x = pk2(lp[0], lp[65]); o.y = pk2(lp[130], lp[195]); o.z = pk2(lp[260], lp[325]); o.w = pk2(lp[390], lp[455]);
      *(u32x4*)(dst + (size_t)(n0 + nn) * K + k0 + kc * 8) = o; }
  }
}

DI void ada_phase(const Params& p, float* ldsf) {
  const int tid = threadIdx.x, lane = tid & 63, w = tid >> 6;
  float* mods = (float*)(p.ws + OFF_MODS);
  __syncthreads();
  for (int e = tid; e < 5120; e += NTHR) { const int mv = e >> 10, k = e & 1023; const float cv = mv < 4 ? p.c[mv * 1024 + k] : p.cctx[k]; ldsf[e] = siluf(cv); }
  __syncthreads();
  float* red = ldsf + 5120;
  for (int item = blockIdx.x; item < 4 * 96; item += gridDim.x) {
    const int i = item / 96, n0 = (item % 96) * 64;
    const float* wp = p.ada_w + (size_t)i * 1024 * 6144 + n0 + lane;
    float a0 = 0.f, a1 = 0.f, a2 = 0.f, a3 = 0.f, a4 = 0.f;
#pragma unroll 8
    for (int kk = 0; kk < 128; ++kk) { const int k = w * 128 + kk; const float wv = wp[(size_t)k * 6144];
      a0 += ldsf[k] * wv; a1 += ldsf[1024 + k] * wv; a2 += ldsf[2048 + k] * wv; a3 += ldsf[3072 + k] * wv; a4 += ldsf[4096 + k] * wv; }
    red[(w * 5 + 0) * 64 + lane] = a0; red[(w * 5 + 1) * 64 + lane] = a1; red[(w * 5 + 2) * 64 + lane] = a2; red[(w * 5 + 3) * 64 + lane] = a3; red[(w * 5 + 4) * 64 + lane] = a4;
    __syncthreads();
    if (tid < 320) { const int mv = tid >> 6; float s = 0.f;
#pragma unroll
      for (int ww = 0; ww < 8; ++ww) s += red[(ww * 5 + mv) * 64 + lane];
      mods[(size_t)(i * 5 + mv) * 6144 + n0 + lane] = s + p.ada_b[i * 6144 + n0 + lane]; }
    __syncthreads();
  }
}
DI void tables_phase(const Params& p) {
  const int gt = blockIdx.x * NTHR + threadIdx.x, gn = gridDim.x * NTHR;
  float2* tabR = (float2*)(p.ws + OFF_TABR); float2* tabM = (float2*)(p.ws + OFF_TABM); float* lbv = (float*)(p.ws + OFF_LBV);
  for (int e = gt; e < 128 * 64; e += gn) { const int v = e >> 6, i = e & 63; const float inv = powf(10000.f, -(float)i / 64.f); const float ang = (float)v * inv; tabR[e] = make_float2(cosf(ang), sinf(ang)); }
  for (int e = gt; e < 128 * 8; e += gn) { const int v = e >> 3, i = e & 7; const float inv = powf(10000.f, -(float)i / 8.f); const float ang = (float)v * inv; tabM[e] = make_float2(cosf(ang), sinf(ang)); }
  for (int e = gt; e < 1024; e += gn) { const float l0 = p.hg_lb[e], l1 = p.hg_lb[1024 + e], l2 = p.hg_lb[2048 + e], l3 = p.hg_lb[3072 + e];
    const float mx = fmaxf(fmaxf(l0, l1), fmaxf(l2, l3)); const float e0 = expf(l0 - mx), e1 = expf(l1 - mx), e2 = expf(l2 - mx), e3 = expf(l3 - mx);
    lbv[e] = (e1 + e2 + e3) / (e0 + e1 + e2 + e3); }
}

DI void modulate_phase(const Params& p, const float* slat, const float* sctx, int layer) {
  const float* mods = (const float*)(p.ws + OFF_MODS); bf16_t* a = (bf16_t*)(p.ws + OFF_A);
  const int gt = blockIdx.x * NTHR + threadIdx.x, gn = gridDim.x * NTHR;
  for (int e = gt; e < T_ALL * 128; e += gn) {
    const int t = e >> 7, c0 = (e & 127) * 8; const float* s = hrowc(slat, sctx, t) + c0; const float* m = mods + (size_t)(layer * 5 + modvec(t)) * 6144;
    const f32x4 x0 = *(const f32x4*)s, x1 = *(const f32x4*)(s + 4), sh0 = *(const f32x4*)(m + c0), sh1 = *(const f32x4*)(m + c0 + 4), sc0 = *(const f32x4*)(m + 1024 + c0), sc1 = *(const f32x4*)(m + 1024 + c0 + 4);
    const f32x4 y0 = x0 * (1.f + sc0) + sh0, y1 = x1 * (1.f + sc1) + sh1;
    u32x4 o; o.x = pk2(y0[0], y0[1]); o.y = pk2(y0[2], y0[3]); o.z = pk2(y1[0], y1[1]); o.w = pk2(y1[2], y1[3]);
    *(u32x4*)(a + (size_t)t * 1024 + c0) = o;
  }
}
DI void ln_phase(const Params& p, int lnlayer, int lnidx, int ml, int js, bool final_out) {
  const float* mods = (const float*)(p.ws + OFF_MODS); bf16_t* a = (bf16_t*)(p.ws + OFF_A); float* hctx = (float*)(p.ws + OFF_HCTX); float2* lns = (float2*)(p.ws + OFF_LNS);
  const int tid = threadIdx.x, lane = tid & 63, gw = blockIdx.x * 8 + (tid >> 6), nw = gridDim.x * 8;
  const float* gp = p.ln_g + (size_t)(lnlayer * 2 + lnidx) * 1024; const float* bp = p.ln_b + (size_t)(lnlayer * 2 + lnidx) * 1024;
  for (int t = gw; t < T_ALL; t += nw) {
    float* hr = hrow(p.out, hctx, t);
    f32x4 v[4]; float s = 0.f;
#pragma unroll
    for (int i = 0; i < 4; ++i) { v[i] = *(const f32x4*)(hr + i * 256 + lane * 4); s += (v[i][0] + v[i][1]) + (v[i][2] + v[i][3]); }
#pragma unroll
    for (int o = 1; o < 64; o <<= 1) s += __shfl_xor(s, o);
    const float mean = s * (1.f / 1024.f); float q = 0.f;
#pragma unroll
    for (int i = 0; i < 4; ++i) { v[i] = v[i] - mean; q += (v[i][0] * v[i][0] + v[i][1] * v[i][1]) + (v[i][2] * v[i][2] + v[i][3] * v[i][3]); }
#pragma unroll
    for (int o = 1; o < 64; o <<= 1) q += __shfl_xor(q, o);
    const float rstd = rsqrtf(q * (1.f / 1024.f) + 1e-5f);
    if (!final_out && lane == 0) lns[t] = make_float2(mean, rstd);
    const float* m = mods + (size_t)(ml * 5 + modvec(t)) * 6144 + (size_t)js * 1024;
#pragma unroll
    for (int i = 0; i < 4; ++i) { const int c0 = i * 256 + lane * 4;
      const f32x4 y = v[i] * rstd * *(const f32x4*)(gp + c0) + *(const f32x4*)(bp + c0);
      if (final_out) *(f32x4*)(hr + c0) = y;
      else { const f32x4 z = y * (1.f + *(const f32x4*)(m + 1024 + c0)) + *(const f32x4*)(m + c0); u32x2 o; o.x = pk2(z[0], z[1]); o.y = pk2(z[2], z[3]); *(u32x2*)(a + (size_t)t * 1024 + c0) = o; } }
  }
}

namespace pg8 {
#define PG8_LAS __attribute__((address_space(3)))
typedef unsigned short bf16_t;
typedef short bf16x8 __attribute__((ext_vector_type(8)));
typedef float f32x4 __attribute__((ext_vector_type(4)));
typedef unsigned u32x4 __attribute__((ext_vector_type(4)));
constexpr int BM = 256, BK = 64, HALF = 128, HTB = HALF * BK * 2  , STAGE_BYTES = 8 * HTB, NXCD = 8, WGM = 8;

__host__ __device__ __forceinline__ int lds_byte(int r, int c) { const int st = (r >> 4) * 2 + (c >> 5), rr = r & 15, cc = c & 31, ob = rr * 64 + cc * 2; return st * 1024 + (ob ^ (((ob >> 9) & 1) << 5)); }
__host__ __device__ __forceinline__ void stage_rc(int b, int& R, int& C) { const int st = b / 1024, sb = b % 1024, swz = sb ^ (((sb >> 9) & 1) << 5); R = (st >> 1) * 16 + swz / 64; C = (st & 1) * 32 + (swz % 64) / 2; }
__host__ __device__ __forceinline__ int perm32(int rho) { const int n = rho >> 4, i = rho & 15; return 8 * (i >> 2) + 4 * n + (i & 3); }

struct Unit { int pm, pn; };
struct Gemm { const bf16_t* A; const bf16_t* Bt; int M, N, K; };

struct StaticOrder {
    int nM, nN, nwg, G, c, lat;
    __host__ __device__ void init(int M, int N, int G_, int c_, int lat_ = 0) { lat = lat_; nM = lat ? 128 : M / BM; nN = N / BM; nwg = nM * nN; G = G_; c = c_; }
    __host__ __device__ bool next(int i, Unit& u) const {
        const long L = (long)i * G + c; if (L >= nwg) return false;
        int wgid = (int)L; { const int q = nwg / NXCD, r = nwg % NXCD, xcd = wgid % NXCD, off = wgid / NXCD; wgid = (xcd < r ? xcd * (q + 1) : r * (q + 1) + (xcd - r) * q) + off; }
        const int nig = WGM * nN, gid = wgid / nig, fm = gid * WGM, gsz = (nM - fm) < WGM ? (nM - fm) : WGM;
        u.pm = fm + ((wgid % nig) % gsz); u.pn = (wgid % nig) / gsz; if (lat) u.pm += (u.pm >> 5) + 1; return true;
    }
    __device__ __forceinline__ void a_ready(const Unit&) const {}
    __device__ __forceinline__ void done(const Unit&) const {}
};
template <class Epi, class Sched, bool ALIGN_EPI = false, bool SP2 = false>
__device__ __forceinline__ void gemm_phase(PG8_LAS unsigned char* lds, const Gemm g, const Sched& S, const Epi& E) {
    const int tid = tid_(), wid = __builtin_amdgcn_readfirstlane(tid >> 6), lane = tid & 63, wr = wid >> 2, wc = wid & 3, fr = lane & 15, fq = lane >> 4;
    const int K = g.K, nt = K / BK;
    unsigned voffA[2], voffB[2];
#pragma unroll
    for (int i = 0; i < 2; ++i) { int R, C; stage_rc(tid * 16 + i * 8192, R, C); const int Rb = Epi::PERM ? ((R & ~31) + perm32(R & 31)) : R;
        voffA[i] = (unsigned)(R * K + C) * 2u; voffB[i] = (unsigned)(Rb * K + C) * 2u; }
    const size_t kstep = (size_t)(BK * 2);
    const size_t hstep = (size_t)HALF * K * 2;
    const size_t tstep = 2 * hstep;
    const unsigned ldsw = (unsigned)wid * 1024u;
    const int aoff = lds_byte(wr * 64 + fr, fq * 8), boff = lds_byte(wc * 32 + fr, fq * 8);
#define PG8_SA(b, h) (((b) * 2 + (h)) * HTB)
#define PG8_SB(b, h) ((4 + (b) * 2 + (h)) * HTB)
#define PG8_STAGE(bufoff, gbase, voff) do { _Pragma("unroll") for (int _i = 0; _i < 2; ++_i) \
        __builtin_amdgcn_global_load_lds((const unsigned*)((const char*)(gbase) + (voff)[_i]), (PG8_LAS unsigned*)(lds + (bufoff) + ldsw + _i * 8192), 16, 0, 0); } while (0)
#define PG8_LDA(dst, b, h) do { _Pragma("unroll") for (int m = 0; m < 4; ++m) _Pragma("unroll") for (int k = 0; k < 2; ++k) dst[m][k] = *(const PG8_LAS bf16x8*)(lds + PG8_SA(b, h) + aoff + m * 2048 + k * 1024); } while (0)
#define PG8_LDB(dst, b, h) do { _Pragma("unroll") for (int n = 0; n < 2; ++n) _Pragma("unroll") for (int k = 0; k < 2; ++k) dst[n][k] = *(const PG8_LAS bf16x8*)(lds + PG8_SB(b, h) + boff + n * 2048 + k * 1024); } while (0)
#define PG8_MMA(ai, bj, At, Bt) do { __builtin_amdgcn_s_setprio(1); _Pragma("unroll") for (int m = 0; m < 4; ++m) _Pragma("unroll") for (int n = 0; n < 2; ++n) _Pragma("unroll") for (int k = 0; k < 2; ++k) \
        acc[ai][bj][m][n] = __builtin_amdgcn_mfma_f32_16x16x32_bf16(Bt[n][k], At[m][k], acc[ai][bj][m][n], 0, 0, 0); __builtin_amdgcn_s_setprio(0); } while (0)
#define PG8_WAIT_V(n) asm volatile("s_waitcnt vmcnt(" #n ")" ::: "memory")
#define PG8_WAIT_L(n) asm volatile("s_waitcnt lgkmcnt(" #n ")" ::: "memory")
#define PG8_BAR __builtin_amdgcn_s_barrier()
#define PG8_SCHED __builtin_amdgcn_sched_barrier(0)
    Unit cur, nxt; int ui = 0;
    if (!S.next(0, cur)) return;
    f32x4 acc[2][2][4][2];
#pragma unroll
    for (int a = 0; a < 2; ++a)
#pragma unroll
        for (int b = 0; b < 2; ++b)
#pragma unroll
            for (int m = 0; m < 4; ++m)
#pragma unroll
                for (int n = 0; n < 2; ++n) acc[a][b][m][n] = (f32x4){0.f, 0.f, 0.f, 0.f};
    bf16x8 At[4][2], B0[2][2], B1[2][2];
    const char* cA = (const char*)g.A + (size_t)cur.pm * tstep; const char* cB = (const char*)g.Bt + (size_t)cur.pn * tstep;
    S.a_ready(cur);
    if constexpr (SP2) {
        PG8_STAGE(PG8_SB(0, 0), cB, voffB); PG8_STAGE(PG8_SB(0, 1), cB + hstep, voffB); PG8_STAGE(PG8_SA(0, 0), cA, voffA); PG8_STAGE(PG8_SA(0, 1), cA + hstep, voffA);
        if (wr == 1) PG8_BAR;
        PG8_WAIT_V(2); PG8_BAR;
        PG8_STAGE(PG8_SB(1, 0), cB + kstep, voffB); PG8_STAGE(PG8_SA(1, 0), cA + kstep, voffA); PG8_STAGE(PG8_SB(1, 1), cB + hstep + kstep, voffB);
        PG8_WAIT_V(6); PG8_BAR;
    } else {
        PG8_STAGE(PG8_SB(0, 0), cB, voffB); PG8_STAGE(PG8_SA(0, 0), cA, voffA); PG8_STAGE(PG8_SB(0, 1), cB + hstep, voffB); PG8_STAGE(PG8_SA(0, 1), cA + hstep, voffA);
        if (wr == 1) PG8_BAR;
        PG8_WAIT_V(4); PG8_BAR;
        PG8_STAGE(PG8_SB(1, 0), cB + kstep, voffB); PG8_STAGE(PG8_SA(1, 0), cA + kstep, voffA); PG8_STAGE(PG8_SB(1, 1), cB + hstep + kstep, voffB);
        PG8_WAIT_V(6); PG8_BAR;
    }
    for (;;) {
        const bool has_next = S.next(ui + 1, nxt);
        const char* nA = has_next ? (const char*)g.A + (size_t)nxt.pm * tstep : cA; const char* nB = has_next ? (const char*)g.Bt + (size_t)nxt.pn * tstep : cB;
        for (int t = 0; t < nt; t += 2) {
            const bool last = (t == nt - 2);
            const char* a1 = cA + (size_t)(t + 1) * kstep;
            const char* a2 = last ? nA : cA + (size_t)(t + 2) * kstep; const char* b2 = last ? nB : cB + (size_t)(t + 2) * kstep;
            const char* a3 = a2 + kstep; const char* b3 = b2 + kstep;
            if (last && has_next) S.a_ready(nxt);
            if constexpr (SP2) {
            PG8_LDB(B0, 0, 0); PG8_LDB(B1, 0, 1); PG8_SCHED; PG8_LDA(At, 0, 0); PG8_STAGE(PG8_SA(1, 1), a1 + hstep, voffA);
            PG8_WAIT_V(8); PG8_WAIT_L(0); PG8_BAR; PG8_MMA(0, 0, At, B0); PG8_MMA(0, 1, At, B1); PG8_BAR; PG8_SCHED;
            PG8_LDA(At, 0, 1); PG8_STAGE(PG8_SB(0, 0), b2, voffB); PG8_STAGE(PG8_SB(0, 1), b2 + hstep, voffB); PG8_STAGE(PG8_SA(0, 0), a2, voffA);
            PG8_WAIT_V(8); PG8_WAIT_L(0); PG8_BAR; PG8_MMA(1, 0, At, B0); PG8_MMA(1, 1, At, B1); PG8_BAR; PG8_SCHED;
            PG8_LDB(B0, 1, 0); PG8_LDB(B1, 1, 1); PG8_SCHED; PG8_LDA(At, 1, 0); PG8_STAGE(PG8_SA(0, 1), a2 + hstep, voffA);
            PG8_WAIT_V(8); PG8_WAIT_L(0); PG8_BAR; PG8_MMA(0, 0, At, B0); PG8_MMA(0, 1, At, B1); PG8_BAR; PG8_SCHED;
            PG8_LDA(At, 1, 1); PG8_STAGE(PG8_SB(1, 0), b3, voffB); PG8_STAGE(PG8_SB(1, 1), b3 + hstep, voffB); PG8_STAGE(PG8_SA(1, 0), a3, voffA);
            PG8_WAIT_V(8); PG8_WAIT_L(0); PG8_BAR; PG8_MMA(1, 0, At, B0); PG8_MMA(1, 1, At, B1); PG8_BAR; PG8_SCHED;
            } else {
            PG8_LDB(B0, 0, 0); PG8_SCHED; PG8_LDA(At, 0, 0); PG8_STAGE(PG8_SA(1, 1), a1 + hstep, voffA);
            PG8_WAIT_L(8); PG8_BAR; PG8_WAIT_L(0); PG8_MMA(0, 0, At, B0); PG8_BAR; PG8_SCHED;
            PG8_LDB(B1, 0, 1); PG8_STAGE(PG8_SB(0, 0), b2, voffB);
            PG8_BAR; PG8_WAIT_L(0); PG8_MMA(0, 1, At, B1); PG8_BAR;
            PG8_LDA(At, 0, 1); PG8_STAGE(PG8_SA(0, 0), a2, voffA);
            PG8_BAR; PG8_WAIT_L(0); PG8_MMA(1, 0, At, B0); PG8_BAR; PG8_SCHED;
            PG8_STAGE(PG8_SB(0, 1), b2 + hstep, voffB);
            PG8_WAIT_V(6); PG8_BAR; PG8_MMA(1, 1, At, B1); PG8_BAR;
            PG8_LDB(B0, 1, 0); PG8_SCHED; PG8_LDA(At, 1, 0); PG8_STAGE(PG8_SA(0, 1), a2 + hstep, voffA);
            PG8_WAIT_L(8); PG8_BAR; PG8_WAIT_L(0); PG8_MMA(0, 0, At, B0); PG8_BAR; PG8_SCHED;
            PG8_LDB(B1, 1, 1); PG8_STAGE(PG8_SB(1, 0), b3, voffB);
            PG8_BAR; PG8_WAIT_L(0); PG8_MMA(0, 1, At, B1); PG8_BAR;
            PG8_LDA(At, 1, 1); PG8_STAGE(PG8_SA(1, 0), a3, voffA);
            PG8_BAR; PG8_WAIT_L(0); PG8_MMA(1, 0, At, B0); PG8_BAR; PG8_SCHED;
            PG8_STAGE(PG8_SB(1, 1), b3 + hstep, voffB);
            PG8_WAIT_V(6); PG8_BAR; PG8_MMA(1, 1, At, B1); PG8_BAR;
            }
        }
        if constexpr (ALIGN_EPI) { if (wr == 0) PG8_BAR; }
        if constexpr (!Epi::AFTER_DRAIN) { E(acc, cur, wr, wc, fr, fq); S.done(cur); }
        if (!has_next) break;
#pragma unroll
        for (int a = 0; a < 2; ++a)
#pragma unroll
            for (int b = 0; b < 2; ++b)
#pragma unroll
                for (int m = 0; m < 4; ++m)
#pragma unroll
                    for (int n = 0; n < 2; ++n) acc[a][b][m][n] = (f32x4){0.f, 0.f, 0.f, 0.f};
        cur = nxt; cA = nA; cB = nB; ++ui;
        if constexpr (ALIGN_EPI) { if (wr == 1) PG8_BAR; }
    }
    PG8_WAIT_V(0);
    if constexpr (!ALIGN_EPI) { if (wr == 0) PG8_BAR; }
    PG8_BAR;
    if constexpr (Epi::AFTER_DRAIN) { E.fused(acc, cur, wr, wc, fr, fq, lds, wid, lane); S.done(cur); }
#undef PG8_SA
#undef PG8_SB
#undef PG8_STAGE
#undef PG8_LDA
#undef PG8_LDB
#undef PG8_MMA
#undef PG8_WAIT_V
#undef PG8_WAIT_L
#undef PG8_BAR
#undef PG8_SCHED
}
}

template <class E4> struct EpiWrap { static constexpr bool PERM = false, AFTER_DRAIN = false; E4 e;
  DI void operator()(const f32x4 (&acc)[2][2][4][2], const pg8::Unit& u, int wr, int wc, int fr, int fq) const {
#pragma unroll
    for (int ai = 0; ai < 2; ++ai)
#pragma unroll
      for (int m = 0; m < 4; ++m) { const int row = u.pm * 256 + ai * 128 + wr * 64 + m * 16 + fr;
#pragma unroll
        for (int bj = 0; bj < 2; ++bj) { const int col = u.pn * 256 + bj * 128 + wc * 32 + 4 * fq;
          if constexpr (E4::PAIR) e.pair(row, ((col - 4 * fq) >> 1) + 4 * fq, acc[ai][bj][m][0], acc[ai][bj][m][1]);
          else { e(row, col, acc[ai][bj][m][0]); e(row, col + 16, acc[ai][bj][m][1]); } }
        asm volatile("" ::: "memory"); }
  } };
template <class E4>
DI void big_gemm(const bf16_t* A, const bf16_t* W, int M, int N, int K, const E4& e4, char* lds, int lat_only = 0) {
  __syncthreads();
  pg8::Gemm g{A, W, M, N, K}; pg8::StaticOrder S; S.init(M, N, (int)gridDim.x, (int)blockIdx.x, lat_only); EpiWrap<E4> E{e4};
  pg8::gemm_phase<EpiWrap<E4>, pg8::StaticOrder, true, true>((PG8_LAS unsigned char*)lds, g, S, E);
  __syncthreads();
}
struct GemmArgs { const bf16_t* A; int lda; const bf16_t* W; int ldw; int M, N, K; };
constexpr int LDT = 72;
template <bool TRANS, class Epi>
DI void gemm_phase(const GemmArgs g, const Epi epi, char* lds) {
  const int tid = threadIdx.x, lane = tid & 63, w = tid >> 6, wm = w & 3, wn = w >> 2, g4 = lane >> 4, l16 = lane & 15;
  const int nN = g.N / 128, ntiles = (g.M / 256) * nN, nk = g.K / 64;
  bf16_t* As = (bf16_t*)lds; bf16_t* Bs = As + 256 * LDT;
  for (int tile = blockIdx.x; tile < ntiles; tile += gridDim.x) {
    const int pm = tile / nN, pn = tile - pm * nN;
    const bf16_t* Ag = g.A + (size_t)(pm * 256) * g.lda; const bf16_t* Wg = g.W + (size_t)(pn * 128) * g.ldw;
    f32x4 acc[4][4];
#pragma unroll
    for (int i = 0; i < 4; ++i)
#pragma unroll
      for (int j = 0; j < 4; ++j) acc[i][j] = (f32x4){0.f, 0.f, 0.f, 0.f};
    u32x4 ra[4], rb[2];
#pragma unroll
    for (int i = 0; i < 4; ++i) { const int c = tid + NTHR * i; ra[i] = *(const u32x4*)(Ag + (size_t)(c >> 3) * g.lda + (c & 7) * 8); }
#pragma unroll
    for (int i = 0; i < 2; ++i) { const int c = tid + NTHR * i; rb[i] = *(const u32x4*)(Wg + (size_t)(c >> 3) * g.ldw + (c & 7) * 8); }
    for (int kt = 0; kt < nk; ++kt) {
      __syncthreads();
#pragma unroll
      for (int i = 0; i < 4; ++i) { const int c = tid + NTHR * i; *(u32x4*)(As + (c >> 3) * LDT + (c & 7) * 8) = ra[i]; }
#pragma unroll
      for (int i = 0; i < 2; ++i) { const int c = tid + NTHR * i; *(u32x4*)(Bs + (c >> 3) * LDT + (c & 7) * 8) = rb[i]; }
      __syncthreads();
      if (kt + 1 < nk) { const int k0 = (kt + 1) * 64;
#pragma unroll
        for (int i = 0; i < 4; ++i) { const int c = tid + NTHR * i; ra[i] = *(const u32x4*)(Ag + (size_t)(c >> 3) * g.lda + k0 + (c & 7) * 8); }
#pragma unroll
        for (int i = 0; i < 2; ++i) { const int c = tid + NTHR * i; rb[i] = *(const u32x4*)(Wg + (size_t)(c >> 3) * g.ldw + k0 + (c & 7) * 8); } }
#pragma unroll
      for (int ks = 0; ks < 2; ++ks) {
        bf16x8 af[4], wf[4];
#pragma unroll
        for (int i = 0; i < 4; ++i) af[i] = *(const bf16x8*)(As + (wm * 64 + i * 16 + l16) * LDT + ks * 32 + g4 * 8);
#pragma unroll
        for (int j = 0; j < 4; ++j) wf[j] = *(const bf16x8*)(Bs + (wn * 64 + j * 16 + l16) * LDT + ks * 32 + g4 * 8);
#pragma unroll
        for (int i = 0; i < 4; ++i)
#pragma unroll
          for (int j = 0; j < 4; ++j) acc[i][j] = TRANS ? mfma16(af[i], wf[j], acc[i][j]) : mfma16(wf[j], af[i], acc[i][j]);
      }
    }
    const int mb = pm * 256 + wm * 64, nb = pn * 128 + wn * 64;
    if constexpr (Epi::PAIR) {
#pragma unroll
      for (int i = 0; i < 4; ++i)
#pragma unroll
        for (int j = 0; j < 2; ++j) epi.pair(mb + i * 16 + l16, (nb >> 1) + 16 * j + 4 * g4, acc[i][2 * j], acc[i][2 * j + 1]);
    } else {
#pragma unroll
      for (int i = 0; i < 4; ++i)
#pragma unroll
        for (int j = 0; j < 4; ++j) { if (TRANS) epi(mb + i * 16 + 4 * g4, nb + j * 16 + l16, acc[i][j]); else epi(mb + i * 16 + l16, nb + j * 16 + 4 * g4, acc[i][j]); }
    }
  }
}
DI void st4bf(bf16_t* p, f32x4 v) { u32x2 o; o.x = pk2(v[0], v[1]); o.y = pk2(v[2], v[3]); *(u32x2*)p = o; }
struct EpiStore { static constexpr bool PAIR = false; bf16_t* d0; bf16_t* d1; int split, ld0, ld1; float s0;
  DI void operator()(int m, int n, f32x4 v) const { if (n < split) st4bf(d0 + (size_t)m * ld0 + n, v * s0); else st4bf(d1 + (size_t)m * ld1 + (n - split), v); } };
struct EpiVT { static constexpr bool PAIR = false; bf16_t* vt; const float* rs;
  DI void operator()(int m, int n, f32x4 v) const { const int b = m / PB, pos = m - b * PB;
    if (rs) { v[0] *= rs[2 * m + 1]; v[1] *= rs[2 * m + 3]; v[2] *= rs[2 * m + 5]; v[3] *= rs[2 * m + 7]; }
    st4bf(vt + ((size_t)(b * 1024 + n)) * PB + pos, v); } };
struct EpiResid { static constexpr bool PAIR = false; const float* slat; const float* sctx; float* dlat; float* dctx; const float* gate;
  const float2* lns; const float* lg; const float* lb;
  DI void operator()(int m, int n, f32x4 v) const { const int mv = modvec(m); f32x4 hv = *(const f32x4*)(hrowc(slat, sctx, m) + n); const f32x4 gt = *(const f32x4*)(gate + (size_t)mv * 6144 + n);
    if (lns) { const float2 st = lns[m]; hv = (hv - st.x) * st.y * *(const f32x4*)(lg + n) + *(const f32x4*)(lb + n); }
    *(f32x4*)(hrow(dlat, dctx, m) + n) = ALPHA * hv + gt * v; } };
struct EpiSwiglu { static constexpr bool PAIR = true; bf16_t* u;
  DI void pair(int m, int f, f32x4 gt, f32x4 up) const { f32x4 r; r[0] = siluf(gt[0]) * up[0]; r[1] = siluf(gt[1]) * up[1]; r[2] = siluf(gt[2]) * up[2]; r[3] = siluf(gt[3]) * up[3]; st4bf(u + (size_t)m * FF + f, r); } };
struct EpiRetQK { static constexpr bool PAIR = false; bf16_t* qk; const float2* tabR;
  DI void operator()(int m, int n, f32x4 v) const { const int b = m / PB, pp = m - b * PB;
    if (pp >= LC) { const int pos = pp - LC, row = pos >> 6, col = pos & 63; const int j0 = (n & 255) >> 1;
      const int vv = j0 < 64 ? row : col; const float2 c0 = tabR[vv * 64 + (j0 & 63)], c1 = tabR[vv * 64 + ((j0 + 1) & 63)];
      const float a0 = v[0] * c0.x - v[1] * c0.y, b0 = v[0] * c0.y + v[1] * c0.x, a1 = v[2] * c1.x - v[3] * c1.y, b1 = v[2] * c1.y + v[3] * c1.x; v = (f32x4){a0, b0, a1, b1}; }
    if (n >= 1024) v = v * 0.0625f;
    st4bf(qk + (size_t)m * 2048 + n, v); } };
struct EpiHg { static constexpr bool PAIR = false; bf16_t* ph;
  DI void operator()(int m, int n, f32x4 v) const { if (n < 1024) { v[0] = siluf(v[0]); v[1] = siluf(v[1]); v[2] = siluf(v[2]); v[3] = siluf(v[3]); v = v * 0.08838834764831845f; } st4bf(ph + (size_t)m * 5120 + n, v); } };
struct EpiMlaQ { static constexpr bool PAIR = false; bf16_t* q; const float* rs; const float2* tabM;
  DI void operator()(int m, int n, f32x4 v) const { v = v * (rs[2 * m] * 0.10206207261596577f * LOG2E); const int h = n / 96, w = n - h * 96; const int b = m / PB, pp = m - b * PB;
    if (w >= 64 && pp >= LC) { const int pos = pp - LC, row = pos >> 6, col = pos & 63; const int j0 = (w - 64) >> 1; const int vv = j0 < 8 ? row : col; const float2 c0 = tabM[vv * 8 + (j0 & 7)], c1 = tabM[vv * 8 + ((j0 + 1) & 7)];
      const float a0 = v[0] * c0.x - v[1] * c0.y, b0 = v[0] * c0.y + v[1] * c0.x, a1 = v[2] * c1.x - v[3] * c1.y, b1 = v[2] * c1.y + v[3] * c1.x; v = (f32x4){a0, b0, a1, b1}; }
    st4bf(q + (size_t)m * 1536 + n, v); } };
struct EpiMlaK { static constexpr bool PAIR = false; bf16_t* k; const float* rs;
  DI void operator()(int m, int n, f32x4 v) const { v = v * rs[2 * m + 1]; st4bf(k + (size_t)m * 1536 + (n >> 6) * 96 + (n & 63), v); } };

DI void mla_stats_phase(const Params& p) {
  const bf16_t* d0 = (const bf16_t*)(p.ws + M_D0); bf16_t* km = (bf16_t*)(p.ws + M_K); float* rs = (float*)(p.ws + OFF_RS); const float2* tabM = (const float2*)(p.ws + OFF_TABM);
  const int tid = threadIdx.x, lane = tid & 63, gw = blockIdx.x * 8 + (tid >> 6), nw = gridDim.x * 8;
  for (int t = gw; t < T_ALL; t += nw) {
    const bf16_t* r = d0 + (size_t)t * 1024;
    const u32x4 a = *(const u32x4*)(r + lane * 8); const u32x2 c = *(const u32x2*)(r + 512 + lane * 4);
    float sq = bflo(a.x) * bflo(a.x) + bfhi(a.x) * bfhi(a.x) + bflo(a.y) * bflo(a.y) + bfhi(a.y) * bfhi(a.y) + bflo(a.z) * bflo(a.z) + bfhi(a.z) * bfhi(a.z) + bflo(a.w) * bflo(a.w) + bfhi(a.w) * bfhi(a.w);
    float sk = bflo(c.x) * bflo(c.x) + bfhi(c.x) * bfhi(c.x) + bflo(c.y) * bflo(c.y) + bfhi(c.y) * bfhi(c.y);
#pragma unroll
    for (int o = 1; o < 64; o <<= 1) { sq += __shfl_xor(sq, o); sk += __shfl_xor(sk, o); }
    if (lane == 0) { rs[2 * t] = rsqrtf(sq * (1.f / 512.f) + 1e-6f); rs[2 * t + 1] = rsqrtf(sk * (1.f / 256.f) + 1e-6f); }
    if (lane < 16) { const int j = lane; float x1 = bf2f(r[768 + j]), x2 = bf2f(r[768 + 16 + j]); const int b = t / PB, pp = t - b * PB;
      if (pp >= LC) { const int pos = pp - LC, row = pos >> 6, col = pos & 63; const float2 cs = tabM[(j < 8 ? row : col) * 8 + (j & 7)]; const float o1 = x1 * cs.x - x2 * cs.y, o2 = x1 * cs.y + x2 * cs.x; x1 = o1; x2 = o2; }
      const unsigned pr = pk2(x1, x2);
#pragma unroll
      for (int h = 0; h < 16; ++h) *(unsigned*)(km + (size_t)t * 1536 + h * 96 + 64 + 2 * j) = pr; }
  }
}

constexpr int KLD = 104, VLD = 72;
DI void mla_attn_phase(const Params& p, char* lds) {
  const bf16_t* Qm = (const bf16_t*)(p.ws + M_Q); const bf16_t* Km = (const bf16_t*)(p.ws + M_K); const bf16_t* vT = (const bf16_t*)(p.ws + M_VT); bf16_t* o = (bf16_t*)(p.ws + OFF_A);
  const int tid = threadIdx.x, lane = tid & 63, w = tid >> 6, c = lane & 31, hh = lane >> 5;
  constexpr int KB = 64 * KLD, VB = 64 * VLD;
  bf16_t* Ks = (bf16_t*)lds; bf16_t* Vs = Ks + 3 * KB;
  for (int item = blockIdx.x; item < 2048 + 64; item += gridDim.x) {
    int b, h, qbase, nkt;
    if (item < 2048) { b = item >> 9; h = (item >> 5) & 15; qbase = LC + (item & 31) * 256; nkt = 132; } else { const int it = item - 2048; b = it >> 4; h = it & 15; qbase = 0; nkt = 4; }
    const size_t tokbase = (size_t)b * PB;
    const bf16_t* qp = Qm + (tokbase + qbase + w * 32 + c) * 1536 + h * 96 + hh * 8;
    bf16x8 qf[6];
#pragma unroll
    for (int ks = 0; ks < 6; ++ks) qf[ks] = *(const bf16x8*)(qp + ks * 16);
    const bf16_t* kg = Km + tokbase * 1536 + h * 96; const bf16_t* vg = vT + (size_t)(b * 16 + h) * 64 * PB;
    const int kr0 = tid / 12, kc0 = tid - kr0 * 12, e1 = tid + NTHR, kr1 = e1 / 12, kc1 = e1 - kr1 * 12; const bool k1ok = e1 < 768; const int vd = tid >> 3, vc = tid & 7;
    u32x4 rk0, rk1 = (u32x4){0, 0, 0, 0}, rv;
    auto gload = [&](int t) { const size_t key0 = (size_t)t * 64;
      rk0 = *(const u32x4*)(kg + (key0 + kr0) * 1536 + kc0 * 8); if (k1ok) rk1 = *(const u32x4*)(kg + (key0 + kr1) * 1536 + kc1 * 8); rv = *(const u32x4*)(vg + (size_t)vd * PB + key0 + vc * 8); };
    auto lstore = [&](int buf) { bf16_t* Kn = Ks + buf * KB; bf16_t* Vn = Vs + buf * VB;
      *(u32x4*)(Kn + kr0 * KLD + kc0 * 8) = rk0; if (k1ok) *(u32x4*)(Kn + kr1 * KLD + kc1 * 8) = rk1; *(u32x4*)(Vn + vd * VLD + vc * 8) = rv; };
    f32x16 oacc[2];
#pragma unroll
    for (int i = 0; i < 16; ++i) { oacc[0][i] = 0.f; oacc[1][i] = 0.f; }
    float mrow = -1e30f, lsum = 0.f;
    auto qk = [&](int buf, f32x16 (&s)[2]) { const bf16_t* Kc = Ks + buf * KB;
#pragma unroll
      for (int j = 0; j < 2; ++j) {
#pragma unroll
        for (int i = 0; i < 16; ++i) s[j][i] = 0.f;
#pragma unroll
        for (int ks = 0; ks < 6; ++ks) { const bf16x8 kf = *(const bf16x8*)(Kc + (32 * j + c) * KLD + ks * 16 + hh * 8); s[j] = mfma32(kf, qf[ks], s[j]); }
      } };
    auto smpv = [&](int buf, f32x16 (&s)[2]) { const bf16_t* Vc = Vs + buf * VB;
      float mx = s[0][0];
#pragma unroll
      for (int j = 0; j < 2; ++j)
#pragma unroll
        for (int i = 0; i < 16; ++i) mx = fmaxf(mx, s[j][i]);
      if (__builtin_amdgcn_ballot_w64(mx > mrow + 8.f) != 0ull) {
        mx = fmaxf(mx, __shfl_xor(mx, 32));
        const float mnew = fmaxf(mrow, mx), alpha = __builtin_amdgcn_exp2f(mrow - mnew); mrow = mnew;
        lsum *= alpha;
#pragma unroll
        for (int i = 0; i < 16; ++i) { oacc[0][i] *= alpha; oacc[1][i] *= alpha; }
      }
      float ps0 = 0.f, ps1 = 0.f;
#pragma unroll
      for (int j = 0; j < 2; ++j)
#pragma unroll
        for (int i = 0; i < 16; i += 2) { s[j][i] = __builtin_amdgcn_exp2f(s[j][i] - mrow); ps0 += s[j][i]; s[j][i + 1] = __builtin_amdgcn_exp2f(s[j][i + 1] - mrow); ps1 += s[j][i + 1]; }
      lsum += ps0 + ps1;
#pragma unroll
      for (int j = 0; j < 2; ++j)
#pragma unroll
        for (int sx = 0; sx < 2; ++sx) {
          const bf16x8 pf = pack8(s[j][8 * sx], s[j][8 * sx + 1], s[j][8 * sx + 2], s[j][8 * sx + 3], s[j][8 * sx + 4], s[j][8 * sx + 5], s[j][8 * sx + 6], s[j][8 * sx + 7]);
#pragma unroll
          for (int dt = 0; dt < 2; ++dt) { const bf16_t* vp = Vc + (32 * dt + c) * VLD + 32 * j + 16 * sx + 4 * hh;
            const bf16x8 vf = cat44(*(const s16x4*)vp, *(const s16x4*)(vp + 8)); oacc[dt] = mfma32(vf, pf, oacc[dt]); }
        } };
    __syncthreads();
    gload(0); lstore(0); gload(1); lstore(1); if (nkt > 2) gload(2);
    __syncthreads();
    f32x16 sA[2], sB[2];
    qk(0, sA);
    int b0 = 0, b1 = 1, b2 = 2;
    for (int kt = 0; kt < nkt; kt += 2) {
      __syncthreads();
      if (kt + 2 < nkt) { lstore(b2); if (kt + 3 < nkt) gload(kt + 3); }
      qk(b1, sB);
      smpv(b0, sA);
      __syncthreads();
      if (kt + 3 < nkt) { lstore(b0); if (kt + 4 < nkt) gload(kt + 4); }
      if (kt + 2 < nkt) qk(b2, sA);
      smpv(b1, sB);
      { const int t0 = b0; b0 = b2; b2 = b1; b1 = t0; }
    }
    lsum += __shfl_xor(lsum, 32); const float inv = 1.f / lsum;
    bf16_t* op = o + (tokbase + qbase + w * 32 + c) * 1024 + h * 64 + 4 * hh;
#pragma unroll
    for (int dt = 0; dt < 2; ++dt)
#pragma unroll
      for (int rg = 0; rg < 4; ++rg) st4bf(op + 32 * dt + 8 * rg, (f32x4){oacc[dt][4 * rg] * inv, oacc[dt][4 * rg + 1] * inv, oacc[dt][4 * rg + 2] * inv, oacc[dt][4 * rg + 3] * inv});
  }
}

template <int N> DI void pin_frags(bf16x8 (&f)[N]) {
  if constexpr (N == 8) asm volatile("" : "+v"(f[0]), "+v"(f[1]), "+v"(f[2]), "+v"(f[3]), "+v"(f[4]), "+v"(f[5]), "+v"(f[6]), "+v"(f[7]));
  else if constexpr (N == 4) asm volatile("" : "+v"(f[0]), "+v"(f[1]), "+v"(f[2]), "+v"(f[3]));
  else if constexpr (N == 2) asm volatile("" : "+v"(f[0]), "+v"(f[1]));
}
constexpr int NKC = 72, NVC = 264;
constexpr int NWK = 72, NWV = 584;
constexpr int NA_OFF_VC = 256 * NKC * 2, NA_OFF_RPB = NA_OFF_VC + 64 * NVC * 2, NA_OFF_W = NA_OFF_RPB + 1920, NA_LDS = NA_OFF_W + 576 * NWK * 2;
static_assert(64 * NWV * 2 <= 576 * NWK * 2 && NA_OFF_W % 16 == 0, "NA window");
DI void na_ctx_wave(const bf16_t* __restrict__ Q, bf16_t* __restrict__ o, const bf16_t* Kc, const bf16_t* Vc, int b, int h, int qb, int lane) {
  const int g = lane >> 4, l16 = lane & 15; const size_t tokbase = (size_t)b * PB; const int qpos = qb * 16 + l16;
  const bf16_t* qp = Q + (tokbase + qpos) * 1024 + h * 64 + g * 8;
  const bf16x8 q0 = *(const bf16x8*)qp, q1 = *(const bf16x8*)(qp + 32);
  f32x4 S[16];
#pragma unroll
  for (int kt = 0; kt < 16; ++kt) { const bf16_t* kp = Kc + (16 * kt + l16) * NKC + g * 8;
    f32x4 s = mfma16(*(const bf16x8*)kp, q0, (f32x4){0.f, 0.f, 0.f, 0.f}); s = mfma16(*(const bf16x8*)(kp + 32), q1, s); S[kt] = s * LOG2E; }
  float mx = S[0][0];
#pragma unroll
  for (int kt = 0; kt < 16; ++kt) mx = fmaxf(fmaxf(fmaxf(mx, S[kt][0]), fmaxf(S[kt][1], S[kt][2])), S[kt][3]);
  mx = fmaxf(mx, __shfl_xor(mx, 16)); mx = fmaxf(mx, __shfl_xor(mx, 32));
  float ls = 0.f;
#pragma unroll
  for (int kt = 0; kt < 16; ++kt)
#pragma unroll
    for (int rr = 0; rr < 4; ++rr) { S[kt][rr] = __builtin_amdgcn_exp2f(S[kt][rr] - mx); ls += S[kt][rr]; }
  ls += __shfl_xor(ls, 16); ls += __shfl_xor(ls, 32);
  f32x4 O[4];
#pragma unroll
  for (int dt = 0; dt < 4; ++dt) O[dt] = (f32x4){0.f, 0.f, 0.f, 0.f};
#pragma unroll
  for (int kk = 0; kk < 8; ++kk) {
    const bf16x8 pf = pack8(S[2 * kk][0], S[2 * kk][1], S[2 * kk][2], S[2 * kk][3], S[2 * kk + 1][0], S[2 * kk + 1][1], S[2 * kk + 1][2], S[2 * kk + 1][3]);
#pragma unroll
    for (int dt = 0; dt < 4; ++dt) { const bf16_t* vp = Vc + (dt * 16 + l16) * NVC + 32 * kk + 4 * g; const bf16x8 vf = cat44(*(const s16x4*)vp, *(const s16x4*)(vp + 16)); O[dt] = mfma16(vf, pf, O[dt]); }
  }
  const float inv = 1.f / ls; bf16_t* op = o + (tokbase + qpos) * 1024 + h * 64 + 4 * g;
#pragma unroll
  for (int dt = 0; dt < 4; ++dt) st4bf(op + 16 * dt, O[dt] * inv);
}
DI void na_attn_phase(const Params& p, char* lds) {
  const bf16_t* Q = (const bf16_t*)(p.ws + N_Q); const bf16_t* K = (const bf16_t*)(p.ws + N_K); const bf16_t* vT = (const bf16_t*)(p.ws + N_VT); bf16_t* o = (bf16_t*)(p.ws + OFF_A);
  bf16_t* Kc = (bf16_t*)lds; bf16_t* Vc = (bf16_t*)(lds + NA_OFF_VC); float* rl = (float*)(lds + NA_OFF_RPB); bf16_t* W = (bf16_t*)(lds + NA_OFF_W);
  const int tid = threadIdx.x, lane = tid & 63, w = tid >> 6, g = lane >> 4, l16 = lane & 15;
  for (int item = blockIdx.x; item < 256; item += gridDim.x) {
    const int qtr = item & 3, h = (item >> 2) & 15, b = item >> 6; const size_t tokbase = (size_t)b * PB;
    const bf16_t* kbase = K + (tokbase + LC) * 1024 + h * 64; const bf16_t* vbase = vT + (size_t)(b * 16 + h) * 64 * PB + LC;
    __syncthreads();
#pragma unroll
    for (int i = 0; i < 4; ++i) { const int e = tid + NTHR * i; const int key = e >> 3, kc = e & 7; *(u32x4*)(Kc + key * NKC + kc * 8) = *(const u32x4*)(K + (tokbase + key) * 1024 + h * 64 + kc * 8); }
#pragma unroll
    for (int i = 0; i < 4; ++i) { const int e = tid + NTHR * i; const int d = e >> 5, pc = e & 31; *(u32x4*)(Vc + d * NVC + pc * 8) = *(const u32x4*)(vT + ((size_t)(b * 16 + h) * 64 + d) * PB + pc * 8); }
    for (int e = tid; e < 465; e += NTHR) rl[e] = p.na_rpb[h * 465 + e];
    u32x4 rw[9];
#pragma unroll 1
    for (int j = 0; j < 16; ++j) {
      int ln = lane, tt = tid; asm volatile("" : "+v"(ln), "+v"(tt)); const int gg = ln >> 4, ll = ln & 15;
      const int r0 = qtr * 32 + 2 * j, rs0 = clampi(r0 - 4, 0, 120), r = r0 + (w >> 2), n = w & 3, rs = clampi(r - 4, 0, 120), dr = rs - rs0, band0 = clampi(16 * n - 8, 0, 32);
      const int qpos = LC + r * 64 + n * 16 + ll;
#pragma unroll
      for (int i = 0; i < 9; ++i) { const int e = tt + NTHR * i; rw[i] = *(const u32x4*)(kbase + (size_t)(rs0 * 64 + (e >> 3)) * 1024 + (e & 7) * 8); }
      __syncthreads();
#pragma unroll
      for (int i = 0; i < 9; ++i) { const int e = tt + NTHR * i; *(u32x4*)(W + (e >> 3) * NWK + (e & 7) * 8) = rw[i]; }
      __syncthreads();
      const bf16_t* qp = Q + (tokbase + qpos) * 1024 + h * 64 + gg * 8;
      const bf16x8 q0 = *(const bf16x8*)qp, q1 = *(const bf16x8*)(qp + 32);
      f32x4 S[32];
#pragma unroll
      for (int kg = 0; kg < 8; ++kg) {
        bf16x8 ka[4], kb[4];
#pragma unroll
        for (int u = 0; u < 4; ++u) { const int kt = 4 * kg + u;
          const bf16_t* kp = kt < 16 ? W + ((dr + (kt >> 1)) * 64 + band0 + 16 * (kt & 1) + ll) * NWK + gg * 8 : Kc + (16 * (kt - 16) + ll) * NKC + gg * 8;
          ka[u] = *(const bf16x8*)kp; kb[u] = *(const bf16x8*)(kp + 32); }
        pin_frags(ka); pin_frags(kb);
#pragma unroll
        for (int u = 0; u < 4; ++u) { const int kt = 4 * kg + u;
          f32x4 s = mfma16(ka[u], q0, (f32x4){0.f, 0.f, 0.f, 0.f}); s = mfma16(kb[u], q1, s);
          if (kt < 16) {
            const int qcol = 16 * n + ll, wstart = clampi(qcol - 8, 0, 48); const float* bp = rl + (rs + (kt >> 1) - r + 7) * 31;
#pragma unroll
            for (int rr = 0; rr < 4; ++rr) { const int kcol = band0 + 16 * (kt & 1) + 4 * gg + rr; const bool ok = kcol >= wstart && kcol < wstart + 16;
              s[rr] = ok ? (s[rr] + bp[clampi(kcol - qcol + 15, 0, 30)]) * LOG2E : -1e30f; }
          } else s = s * LOG2E;
          S[kt] = s; }
      }
      float mx = S[0][0];
#pragma unroll
      for (int kt = 0; kt < 32; ++kt) mx = fmaxf(fmaxf(fmaxf(mx, S[kt][0]), fmaxf(S[kt][1], S[kt][2])), S[kt][3]);
      mx = fmaxf(mx, __shfl_xor(mx, 16)); mx = fmaxf(mx, __shfl_xor(mx, 32));
      float ls = 0.f;
#pragma unroll
      for (int kt = 0; kt < 32; ++kt)
#pragma unroll
        for (int rr = 0; rr < 4; ++rr) { S[kt][rr] = __builtin_amdgcn_exp2f(S[kt][rr] - mx); ls += S[kt][rr]; }
      ls += __shfl_xor(ls, 16); ls += __shfl_xor(ls, 32);
      bf16x8 pf[16];
#pragma unroll
      for (int kk = 0; kk < 16; ++kk) pf[kk] = pack8(S[2 * kk][0], S[2 * kk][1], S[2 * kk][2], S[2 * kk][3], S[2 * kk + 1][0], S[2 * kk + 1][1], S[2 * kk + 1][2], S[2 * kk + 1][3]);
#pragma unroll
      for (int i = 0; i < 9; ++i) { const int e = tt + NTHR * i, d = e / 72, pc = e - d * 72; rw[i] = *(const u32x4*)(vbase + (size_t)d * PB + rs0 * 64 + pc * 8); }
      __syncthreads();
#pragma unroll
      for (int i = 0; i < 9; ++i) { const int e = tt + NTHR * i, d = e / 72, pc = e - d * 72; *(u32x4*)(W + d * NWV + pc * 8) = rw[i]; }
      __syncthreads();
      f32x4 O[4];
#pragma unroll
      for (int dt = 0; dt < 4; ++dt) O[dt] = (f32x4){0.f, 0.f, 0.f, 0.f};
#pragma unroll
      for (int kk = 0; kk < 16; ++kk) {
        bf16x8 vf[4];
#pragma unroll
        for (int dt = 0; dt < 4; ++dt) { const bf16_t* vp = kk < 8 ? W + (dt * 16 + ll) * NWV + (dr + kk) * 64 + band0 + 4 * gg : Vc + (dt * 16 + ll) * NVC + 32 * (kk - 8) + 4 * gg;
          vf[dt] = cat44(*(const s16x4*)vp, *(const s16x4*)(vp + 16)); }
        pin_frags(vf);
#pragma unroll
        for (int dt = 0; dt < 4; ++dt) O[dt] = mfma16(vf[dt], pf[kk], O[dt]);
      }
      const float inv = 1.f / ls; bf16_t* op = o + (tokbase + qpos) * 1024 + h * 64 + 4 * gg;
#pragma unroll
      for (int dt = 0; dt < 4; ++dt) st4bf(op + 16 * dt, O[dt] * inv);
    }
    if (w < 4) na_ctx_wave(Q, o, Kc, Vc, b, h, qtr * 4 + w, lane);
  }
}

template <int DK> struct ScanLds { static constexpr int QLD = DK + 8, TLD = 72;
  static constexpr int OFF_QD = 0, OFF_KD = OFF_QD + 64 * QLD * 2, OFF_VT = OFF_KD + 64 * QLD * 2, OFF_ATT = OFF_VT + 64 * TLD * 2, OFF_ST = OFF_ATT + 64 * TLD * 2, OFF_EB = OFF_ST + 64 * QLD * 2, OFF_QS = OFF_EB + DK * 4, TOTAL = OFF_QS + 8 * DK * 4; };
DI int scan_pos(int dir, int i, int tl) { if (dir == 0) return i * 64 + tl; return i < 4 ? 255 - (i * 64 + tl) : 8447 - ((i - 4) * 64 + tl); }
DI bf16x8 gather8(const bf16_t* p, int stride) {
  const unsigned a0 = p[0], a1 = p[stride], a2 = p[2 * stride], a3 = p[3 * stride], a4 = p[4 * stride], a5 = p[5 * stride], a6 = p[6 * stride], a7 = p[7 * stride];
  u32x4 r; r.x = a0 | (a1 << 16); r.y = a2 | (a3 << 16); r.z = a4 | (a5 << 16); r.w = a6 | (a7 << 16); return __builtin_bit_cast(bf16x8, r);
}

template <int DK, bool HG, int DVS>
DI void scan_phase(const Params& p, char* lds) {
  typedef ScanLds<DK> L;
  bf16_t* Qd = (bf16_t*)(lds + L::OFF_QD); bf16_t* Kd = (bf16_t*)(lds + L::OFF_KD); bf16_t* Vt = (bf16_t*)(lds + L::OFF_VT);
  bf16_t* Att = (bf16_t*)(lds + L::OFF_ATT); bf16_t* St = (bf16_t*)(lds + L::OFF_ST); float* eb = (float*)(lds + L::OFF_EB); float* qs = (float*)(lds + L::OFF_QS);
  constexpr int QLD = L::QLD, TLD = L::TLD, KT = DK / 16 / 8;
  const int tid = tid_(), lane = tid & 63, w = tid >> 6, g4 = lane >> 4, l16 = lane & 15;
  const int nitems = 256; constexpr int NVI = DVS / 16, NTO = NVI * 4 / 8;
  const float* lbv = (const float*)(p.ws + OFF_LBV);
  for (int item = blockIdx.x; item < nitems; item += gridDim.x) {
    const int xcd = item & 7, yy = item >> 3; int b, h, sl, dir;
    if (HG) { const int grp = xcd * 8 + (yy >> 2); sl = yy & 3; h = grp & 7; b = (grp >> 3) & 3; dir = grp >> 5; }
    else { const int grp = xcd * 4 + (yy >> 3); sl = yy & 7; h = grp & 3; b = (grp >> 2) & 3; dir = grp >> 4; }
    const size_t tokbase = (size_t)b * PB;
    const bf16_t *qsrc, *ksrc, *vsrc; int ldq, ldv; bf16_t *octx, *olat; int ldo;
    if (HG) { const bf16_t* ph = (const bf16_t*)(p.ws + H_P); qsrc = ph + h * 128; ksrc = ph + 1024 + dir * 1024 + h * 128; vsrc = ph + 3072 + h * 128 + sl * DVS; ldq = 5120; ldv = 5120; ldo = 1024;
      octx = (bf16_t*)(p.ws + (dir ? OFF_W0 : OFF_A)) + tokbase * 1024 + h * 128 + sl * DVS; olat = octx + (size_t)LC * 1024; }
    else { const bf16_t* qk = (const bf16_t*)(p.ws + R_QK); qsrc = qk + h * 256; ksrc = qk + 1024 + h * 256; vsrc = (const bf16_t*)(p.ws + R_V) + h * 512 + sl * 64; ldq = 2048; ldv = 2048; ldo = 2048;
      if (dir == 0) { octx = (bf16_t*)(p.ws + R_O) + tokbase * 2048 + h * 512 + sl * 64; olat = octx + (size_t)LC * 2048; }
      else { octx = (bf16_t*)(p.ws + OFF_HCTX) + (size_t)b * LC * 2048 + h * 512 + sl * 64; olat = (bf16_t*)p.out + (size_t)b * LL * 2048 + h * 512 + sl * 64; } }
    float lg = 0.f; if (!HG) lg = -__expf(p.ret_decay[dir * 4 + h]);
    float lb0 = 0.f, lb1 = 0.f; if (HG) { lb0 = lbv[h * 128 + 2 * (tid & 63)]; lb1 = lbv[h * 128 + 2 * (tid & 63) + 1]; }
    f32x4 sacc[KT][NVI];
#pragma unroll
    for (int a = 0; a < KT; ++a)
#pragma unroll
      for (int v = 0; v < NVI; ++v) sacc[a][v] = (f32x4){0.f, 0.f, 0.f, 0.f};
    u32x4 rq[4], rk[4], rvv; unsigned rf[8], rqq[8]; float bl[16], qv[16], kv[16];
    const int vtl = tid & 63, vvc = tid >> 6;
    auto issue = [&](int i) {
      if (HG) { const int kp = tid & 63, seg = tid >> 6;
#pragma unroll
        for (int j = 0; j < 8; ++j) { const size_t row = tokbase + scan_pos(dir, i, seg * 8 + j); rf[j] = *(const unsigned*)(ksrc + row * ldq + 2 * kp); rqq[j] = *(const unsigned*)(qsrc + row * ldq + 2 * kp); } }
      else {
#pragma unroll
        for (int it = 0; it < 4; ++it) { const int e = tid + NTHR * it, tl = e >> 5, kc = e & 31; const size_t row = tokbase + scan_pos(dir, i, tl); rq[it] = *(const u32x4*)(qsrc + row * ldq + kc * 8); rk[it] = *(const u32x4*)(ksrc + row * ldq + kc * 8); } }
      if (vvc < DVS / 8) { const size_t row = tokbase + scan_pos(dir, i, vtl); rvv = *(const u32x4*)(vsrc + row * ldv + vvc * 8); }
    };
    auto prep = [&]() {
      const int kp = tid & 63, seg = tid >> 6; float run0 = 1.f, run1 = 1.f;
#pragma unroll
      for (int j = 0; j < 8; ++j) { const float f0 = bflo(rf[j]), f1 = bfhi(rf[j]); qv[2 * j] = bflo(rqq[j]); qv[2 * j + 1] = bfhi(rqq[j]);
        const float s0 = __builtin_amdgcn_rcpf(1.f + __expf(-f0)), s1 = __builtin_amdgcn_rcpf(1.f + __expf(-f1)); const float g0 = lb0 + (1.f - lb0) * s0, g1 = lb1 + (1.f - lb1) * s1;
        kv[2 * j] = 1.f - g0; kv[2 * j + 1] = 1.f - g1; run0 *= g0; run1 *= g1; bl[2 * j] = run0; bl[2 * j + 1] = run1; }
      qs[seg * DK + 2 * kp] = run0; qs[seg * DK + 2 * kp + 1] = run1;
    };
    __syncthreads();
    issue(0); if (HG) prep();
    __syncthreads();
    for (int i = 0; i < 132; ++i) {
      if (HG) { const int kp = tid & 63, seg = tid >> 6; float off0 = 1.f, off1 = 1.f;
#pragma unroll
        for (int q = 0; q < 7; ++q) if (q < seg) { off0 *= qs[q * DK + 2 * kp]; off1 *= qs[q * DK + 2 * kp + 1]; }
        if (seg == 7) { eb[2 * kp] = off0 * bl[14]; eb[2 * kp + 1] = off1 * bl[15]; }
#pragma unroll
        for (int j = 0; j < 8; ++j) { const int tl = seg * 8 + j; const float p0 = bl[2 * j] * off0, p1 = bl[2 * j + 1] * off1;
          *(unsigned*)(Qd + tl * QLD + 2 * kp) = pk2(qv[2 * j] * p0, qv[2 * j + 1] * p1);
          *(unsigned*)(Kd + tl * QLD + 2 * kp) = pk2(kv[2 * j] * __builtin_amdgcn_rcpf(p0), kv[2 * j + 1] * __builtin_amdgcn_rcpf(p1)); } }
      else {
        if (tid < DK) eb[tid] = __expf(64.f * lg);
#pragma unroll
        for (int it = 0; it < 4; ++it) { const int e = tid + NTHR * it, tl = e >> 5, kc = e & 31; const u32x4 qr = rq[it], kr = rk[it];
          const float eq = __expf((float)(tl + 1) * lg), ek = __expf(-(float)(tl + 1) * lg);
          u32x4 qo, ko; qo.x = pk2(bflo(qr.x) * eq, bfhi(qr.x) * eq); qo.y = pk2(bflo(qr.y) * eq, bfhi(qr.y) * eq); qo.z = pk2(bflo(qr.z) * eq, bfhi(qr.z) * eq); qo.w = pk2(bflo(qr.w) * eq, bfhi(qr.w) * eq);
          ko.x = pk2(bflo(kr.x) * ek, bfhi(kr.x) * ek); ko.y = pk2(bflo(kr.y) * ek, bfhi(kr.y) * ek); ko.z = pk2(bflo(kr.z) * ek, bfhi(kr.z) * ek); ko.w = pk2(bflo(kr.w) * ek, bfhi(kr.w) * ek);
          *(u32x4*)(Qd + tl * QLD + kc * 8) = qo; *(u32x4*)(Kd + tl * QLD + kc * 8) = ko; } }
      if (vvc < DVS / 8) { bf16_t* vt = Vt + (vvc * 8) * TLD + vtl; const u32x4 vr = rvv;
        vt[0] = (bf16_t)(vr.x & 0xffff); vt[TLD] = (bf16_t)(vr.x >> 16); vt[2 * TLD] = (bf16_t)(vr.y & 0xffff); vt[3 * TLD] = (bf16_t)(vr.y >> 16);
        vt[4 * TLD] = (bf16_t)(vr.z & 0xffff); vt[5 * TLD] = (bf16_t)(vr.z >> 16); vt[6 * TLD] = (bf16_t)(vr.w & 0xffff); vt[7 * TLD] = (bf16_t)(vr.w >> 16); }
#pragma unroll
      for (int a = 0; a < KT; ++a) { const int ki = w * KT + a;
#pragma unroll
        for (int vi = 0; vi < NVI; ++vi) st4bf(St + (16 * vi + l16) * QLD + 16 * ki + 4 * g4, sacc[a][vi]); }
      __syncthreads();
      if (i + 1 < 132) issue(i + 1);
      { const int ti = w >> 1;
        bf16x8 qf[DK / 32];
#pragma unroll
        for (int ks = 0; ks < DK / 32; ++ks) qf[ks] = *(const bf16x8*)(Qd + (16 * ti + l16) * QLD + ks * 32 + g4 * 8);
#pragma unroll
        for (int u = 0; u < 2; ++u) { const int si = (2 * w + u) & 3; f32x4 d = (f32x4){0.f, 0.f, 0.f, 0.f};
          if (si <= ti) { bf16x8 kf[DK / 32];
#pragma unroll
            for (int ks = 0; ks < DK / 32; ++ks) kf[ks] = *(const bf16x8*)(Kd + (16 * si + l16) * QLD + ks * 32 + g4 * 8);
            pin_frags(kf);
#pragma unroll
            for (int ks = 0; ks < DK / 32; ++ks) d = mfma16(kf[ks], qf[ks], d); }
          const int t = 16 * ti + l16, s0 = 16 * si + 4 * g4;
#pragma unroll
          for (int rr = 0; rr < 4; ++rr) if (s0 + rr > t) d[rr] = 0.f;
          st4bf(Att + t * TLD + s0, d); } }
      __syncthreads();
      { const int vi = (NTO * w) >> 2;
        bf16x8 xv[2], xs[DK / 32];
#pragma unroll
        for (int ks = 0; ks < 2; ++ks) xv[ks] = *(const bf16x8*)(Vt + (16 * vi + l16) * TLD + ks * 32 + g4 * 8);
#pragma unroll
        for (int ks = 0; ks < DK / 32; ++ks) xs[ks] = *(const bf16x8*)(St + (16 * vi + l16) * QLD + ks * 32 + g4 * 8);
        pin_frags(xv); pin_frags(xs);
#pragma unroll
        for (int u = 0; u < NTO; ++u) { const int ti = (NTO * w + u) & 3; bf16x8 ya[2], yq[DK / 32];
#pragma unroll
          for (int ks = 0; ks < 2; ++ks) ya[ks] = *(const bf16x8*)(Att + (16 * ti + l16) * TLD + ks * 32 + g4 * 8);
#pragma unroll
          for (int ks = 0; ks < DK / 32; ++ks) yq[ks] = *(const bf16x8*)(Qd + (16 * ti + l16) * QLD + ks * 32 + g4 * 8);
          pin_frags(ya); pin_frags(yq);
          f32x4 d = (f32x4){0.f, 0.f, 0.f, 0.f};
#pragma unroll
          for (int ks = 0; ks < 2; ++ks) d = mfma16(xv[ks], ya[ks], d);
#pragma unroll
          for (int ks = 0; ks < DK / 32; ++ks) d = mfma16(xs[ks], yq[ks], d);
          const int pos = scan_pos(dir, i, 16 * ti + l16); bf16_t* op = (pos < LC ? octx + (size_t)pos * ldo : olat + (size_t)(pos - LC) * ldo) + 16 * vi + 4 * g4;
          st4bf(op, d); } }
      { bf16x8 yv[NVI][2];
#pragma unroll
        for (int vi = 0; vi < NVI; ++vi)
#pragma unroll
          for (int ks = 0; ks < 2; ++ks) yv[vi][ks] = *(const bf16x8*)(Vt + (16 * vi + l16) * TLD + ks * 32 + g4 * 8);
#pragma unroll
        for (int a = 0; a < KT; ++a) { const int ki = w * KT + a; bf16x8 xf[2];
#pragma unroll
          for (int ks = 0; ks < 2; ++ks) xf[ks] = gather8(Kd + (ks * 32 + g4 * 8) * QLD + 16 * ki + l16, QLD);
#pragma unroll
          for (int ks = 0; ks < 2; ++ks)
#pragma unroll
            for (int vi = 0; vi < NVI; ++vi) sacc[a][vi] = mfma16(xf[ks], yv[vi][ks], sacc[a][vi]);
          const f32x4 e4 = *(const f32x4*)(eb + 16 * ki + 4 * g4);
#pragma unroll
          for (int vi = 0; vi < NVI; ++vi) sacc[a][vi] = sacc[a][vi] * e4; } }
      if (HG && i + 1 < 132) prep();
      __syncthreads();
    }
  }
}

DI float bsum2(unsigned a, unsigned b, float& lo, float& hi) { lo = bflo(a) + bflo(b); hi = bfhi(a) + bfhi(b); return lo * lo + hi * hi; }
DI void ret_readout_phase(const Params& p) {
  bf16_t* O = (bf16_t*)(p.ws + R_O); const bf16_t* G = (const bf16_t*)(p.ws + R_QK);
  const int tid = threadIdx.x, lane = tid & 63, gw = blockIdx.x * 8 + (tid >> 6), nw = gridDim.x * 8;
  for (int t = gw; t < T_ALL; t += nw) {
    const int b = t / PB, pp = t - b * PB;
    const bf16_t* ob = (pp < LC ? (const bf16_t*)(p.ws + OFF_HCTX) + (size_t)(b * LC + pp) * 2048 : (const bf16_t*)p.out + (size_t)(b * LL + pp - LC) * 2048) + lane * 32;
    bf16_t* op = O + (size_t)t * 2048 + lane * 32; const bf16_t* gp = G + (size_t)t * 2048 + lane * 32;
    float ov[32]; u32x4 gv[4]; float sq = 0.f;
#pragma unroll
    for (int i = 0; i < 4; ++i) { const u32x4 x = *(const u32x4*)(op + i * 8), y = *(const u32x4*)(ob + i * 8); gv[i] = *(const u32x4*)(gp + i * 8);
      sq += bsum2(x.x, y.x, ov[8 * i], ov[8 * i + 1]) + bsum2(x.y, y.y, ov[8 * i + 2], ov[8 * i + 3]) + bsum2(x.z, y.z, ov[8 * i + 4], ov[8 * i + 5]) + bsum2(x.w, y.w, ov[8 * i + 6], ov[8 * i + 7]); }
    sq += __shfl_xor(sq, 1); sq += __shfl_xor(sq, 2); sq += __shfl_xor(sq, 4); sq += __shfl_xor(sq, 8);
    const float rstd = rsqrtf(sq * (1.f / 512.f) + 1e-6f);
#pragma unroll
    for (int i = 0; i < 4; ++i) { u32x4 r;
      r.x = pk2(siluf(bflo(gv[i].x)) * ov[8 * i] * rstd, siluf(bfhi(gv[i].x)) * ov[8 * i + 1] * rstd); r.y = pk2(siluf(bflo(gv[i].y)) * ov[8 * i + 2] * rstd, siluf(bfhi(gv[i].y)) * ov[8 * i + 3] * rstd);
      r.z = pk2(siluf(bflo(gv[i].z)) * ov[8 * i + 4] * rstd, siluf(bfhi(gv[i].z)) * ov[8 * i + 5] * rstd); r.w = pk2(siluf(bflo(gv[i].w)) * ov[8 * i + 6] * rstd, siluf(bfhi(gv[i].w)) * ov[8 * i + 7] * rstd);
      *(u32x4*)(op + i * 8) = r; }
  }
}
DI void hg_readout_phase(const Params& p) {
  bf16_t* O = (bf16_t*)(p.ws + OFF_A); const bf16_t* OB = (const bf16_t*)(p.ws + OFF_W0); const bf16_t* ph = (const bf16_t*)(p.ws + H_P);
  const int tid = threadIdx.x, lane = tid & 63, gw = blockIdx.x * 8 + (tid >> 6), nw = gridDim.x * 8;
  for (int t = gw; t < T_ALL; t += nw) {
    bf16_t* op = O + (size_t)t * 1024 + lane * 16; const bf16_t* ob = OB + (size_t)t * 1024 + lane * 16; const bf16_t* gp = ph + (size_t)t * 5120 + 4096 + lane * 16; const float* ng = p.hg_norm_g + (lane & 7) * 16;
    float ov[16]; u32x4 gv[2]; float sq = 0.f;
#pragma unroll
    for (int i = 0; i < 2; ++i) { const u32x4 x = *(const u32x4*)(op + i * 8), y = *(const u32x4*)(ob + i * 8); gv[i] = *(const u32x4*)(gp + i * 8);
      sq += bsum2(x.x, y.x, ov[8 * i], ov[8 * i + 1]) + bsum2(x.y, y.y, ov[8 * i + 2], ov[8 * i + 3]) + bsum2(x.z, y.z, ov[8 * i + 4], ov[8 * i + 5]) + bsum2(x.w, y.w, ov[8 * i + 6], ov[8 * i + 7]); }
    sq += __shfl_xor(sq, 1); sq += __shfl_xor(sq, 2); sq += __shfl_xor(sq, 4);
    const float rstd = rsqrtf(sq * (1.f / 128.f) + 1e-6f);
#pragma unroll
    for (int i = 0; i < 2; ++i) { u32x4 r; const float* n8 = ng + i * 8;
      r.x = pk2(siluf(bflo(gv[i].x)) * ov[8 * i] * rstd * n8[0], siluf(bfhi(gv[i].x)) * ov[8 * i + 1] * rstd * n8[1]); r.y = pk2(siluf(bflo(gv[i].y)) * ov[8 * i + 2] * rstd * n8[2], siluf(bfhi(gv[i].y)) * ov[8 * i + 3] * rstd * n8[3]);
      r.z = pk2(siluf(bflo(gv[i].z)) * ov[8 * i + 4] * rstd * n8[4], siluf(bfhi(gv[i].z)) * ov[8 * i + 5] * rstd * n8[5]); r.w = pk2(siluf(bflo(gv[i].w)) * ov[8 * i + 6] * rstd * n8[6], siluf(bfhi(gv[i].w)) * ov[8 * i + 7] * rstd * n8[7]);
      *(u32x4*)(op + i * 8) = r; }
  }
}

#define XB_TMO      128
#define XB_XCNT(j)  (256  + 64 * (j))
#define XB_XSUB(j)  (1280 + 64 * (j))
#define XB_XGEN(j)  (2304 + 64 * (j))
#define XB_TOP      3328
#define XB_TOPGEN   3392
#define XCD_BAR_WORDS 3456
#define XB_SPIN_CAP (1u << 23)
#define LAS PG8_LAS

__device__ __forceinline__ unsigned xb_ld(unsigned* p)              { return __hip_atomic_load(p, __ATOMIC_RELAXED, __HIP_MEMORY_SCOPE_AGENT); }
__device__ __forceinline__ unsigned xb_add(unsigned* p, unsigned v) { return __hip_atomic_fetch_add(p, v, __ATOMIC_RELAXED, __HIP_MEMORY_SCOPE_AGENT); }
__device__ __forceinline__ unsigned xb_xcc_id() { return (unsigned)__builtin_amdgcn_s_getreg((3 << 11) | 20) & 0xFu; }
#define XB_SPIN(cond, bar) do { unsigned _sp = 0; while (cond) { __builtin_amdgcn_s_sleep(1); \
    if ((++_sp & 255u) == 0u) { if (xb_ld(&(bar)[XB_TMO])) break; if (_sp > XB_SPIN_CAP) { atomicAdd(&(bar)[XB_TMO], 1u); break; } } } } while (0)

struct XcdBarrier {
    unsigned* bar; unsigned x;
    volatile LAS unsigned* st;
};

__device__ __forceinline__ XcdBarrier xcd_barrier_post(unsigned* bar, volatile LAS unsigned* st) {
    XcdBarrier b; b.bar = bar; b.x = xb_xcc_id(); b.st = st;
    if (threadIdx.x == 0) (void)xb_add(&bar[XB_XCNT(b.x)], 1u);
    return b;
}
__device__ __forceinline__ void xcd_barrier_complete(unsigned* bar, unsigned x, unsigned& nloc, unsigned& nx) {
    const unsigned G = gridDim.x * gridDim.y * gridDim.z;
    unsigned sum, cnt, mine, sp = 0u;
    for (;;) {
        sum = 0u; cnt = 0u; mine = 0u;
#pragma unroll
        for (unsigned j = 0; j < 16; ++j) { const unsigned c = xb_ld(&bar[XB_XCNT(j)]); sum += c; cnt += (c > 0u) ? 1u : 0u; mine = (j == x) ? c : mine; }
        if (sum == G) break;
        __builtin_amdgcn_s_sleep(1);
        if ((++sp & 255u) == 0u) { if (xb_ld(&bar[XB_TMO])) break; if (sp > XB_SPIN_CAP) { atomicAdd(&bar[XB_TMO], 1u); break; } }
    }
    nloc = mine > 0u ? mine : 1u; nx = cnt > 0u ? cnt : 1u;
}

__device__ __forceinline__ void xcd_barrier(const XcdBarrier& b) {
    asm volatile("s_waitcnt vmcnt(0)" ::: "memory");
    __syncthreads();
    if (threadIdx.x == 0) {
        unsigned* bar = b.bar;
        __builtin_amdgcn_s_waitcnt(0);
        unsigned nloc = b.st[0], nx = b.st[1];
        if (nloc == 0u) { xcd_barrier_complete(bar, b.x, nloc, nx); b.st[0] = nloc; b.st[1] = nx; }
        const unsigned old = xb_add(&bar[XB_XSUB(b.x)], 1u);
        const unsigned gen = old / nloc;
        if (old + 1u == (gen + 1u) * nloc) {
            __builtin_amdgcn_fence(__ATOMIC_RELEASE, "agent");
            asm volatile("s_waitcnt vmcnt(0)" ::: "memory");
            const unsigned og = xb_add(&bar[XB_TOP], 1u);
            const unsigned tg = og / nx;
            if (og + 1u == (tg + 1u) * nx) xb_add(&bar[XB_TOPGEN], 1u);
            else XB_SPIN(xb_ld(&bar[XB_TOPGEN]) == tg, bar);
            __builtin_amdgcn_fence(__ATOMIC_ACQUIRE, "agent");
            xb_add(&bar[XB_XGEN(b.x)], 1u);
            asm volatile("s_waitcnt vmcnt(0)" ::: "memory");
        } else {
            XB_SPIN(xb_ld(&bar[XB_XGEN(b.x)]) == gen, bar);
            __builtin_amdgcn_fence(__ATOMIC_ACQUIRE, "agent");
            asm volatile("s_waitcnt vmcnt(0)" ::: "memory");
        }
    }
    __syncthreads();
}

constexpr int LDS_BYTES0 = ScanLds<256>::TOTAL > pg8::STAGE_BYTES ? ScanLds<256>::TOTAL : pg8::STAGE_BYTES;
constexpr int LDS_BYTES = LDS_BYTES0 > NA_LDS ? LDS_BYTES0 : NA_LDS;
static_assert(LDS_BYTES <= 163840, "LDS");
static_assert(LDS_BYTES >= (256 + 128) * LDT * 2 && LDS_BYTES >= 3 * 64 * (KLD + VLD) * 2 && LDS_BYTES >= (5120 + 8 * 5 * 64) * 4, "LDS phases");

DI void ffn_and_ln(const Params& p, const XcdBarrier& xb, char* lds, int layer, const bf16_t* w13, const bf16_t* w2) {
  const float* mods = (const float*)(p.ws + OFF_MODS); float* hctx = (float*)(p.ws + OFF_HCTX); bf16_t* a = (bf16_t*)(p.ws + OFF_A); bf16_t* U = (bf16_t*)(p.ws + F_U);
  { EpiSwiglu e{U}; big_gemm(a, w13, T_ALL, 5632, 1024, e, lds, layer == 3); }
  xcd_barrier(xb);
  { EpiResid e{p.out, hctx, p.out, hctx, mods + (size_t)layer * 5 * 6144 + 5 * 1024, (const float2*)(p.ws + OFF_LNS), p.ln_g + (size_t)(layer * 2) * 1024, p.ln_b + (size_t)(layer * 2) * 1024}; big_gemm(U, w2, T_ALL, 1024, FF, e, lds, layer == 3); }
  xcd_barrier(xb);
  ln_phase(p, layer, 1, layer < 3 ? layer + 1 : 3, 0, layer == 3);
  xcd_barrier(xb);
}

__global__ void __launch_bounds__(NTHR) mega(Params p) {
  __shared__ __attribute__((aligned(16))) char lds[LDS_BYTES];
  cg::grid_group grid = cg::this_grid();
  __shared__ uint4 xb_words;
  if (threadIdx.x == 0) xb_words = make_uint4(0u, 0u, 0u, 0u);
  __syncthreads();
  const XcdBarrier xb = xcd_barrier_post((unsigned*)(p.ws + OFF_BAR), (volatile LAS unsigned*)&xb_words);
  float* ldsf = (float*)lds;
  const float* mods = (const float*)(p.ws + OFF_MODS); float* hctx = (float*)(p.ws + OFF_HCTX); bf16_t* a = (bf16_t*)(p.ws + OFF_A);
  const float2* tabR = (const float2*)(p.ws + OFF_TABR); const float2* tabM = (const float2*)(p.ws + OFF_TABM); float* rs = (float*)(p.ws + OFF_RS);
  ada_phase(p, ldsf);
  tables_phase(p);
  convert_w<2>(p.ret_w_in, 6144, 1024, (bf16_t*)(p.ws + W0_RETIN), 6144, nullptr, ldsf);
  convert_w<0>(p.ret_w_out, 1024, 2048, (bf16_t*)(p.ws + W0_RETOUT), 1024, nullptr, ldsf);
  convert_w<1>(p.w13, 5632, 1024, (bf16_t*)(p.ws + W0_W13), 5632, nullptr, ldsf);
  convert_w<0>(p.w2, 1024, FF, (bf16_t*)(p.ws + W0_W2), 1024, nullptr, ldsf);
  grid.sync();
  modulate_phase(p, p.x, p.ctx, 0);
  xcd_barrier(xb);
  { const bf16_t* wi = (const bf16_t*)(p.ws + W0_RETIN);
    { EpiRetQK e{(bf16_t*)(p.ws + R_QK), tabR}; big_gemm(a, wi, T_ALL, 2048, 1024, e, lds); }
    { EpiStore e{(bf16_t*)(p.ws + R_V), (bf16_t*)(p.ws + R_V), 1 << 30, 2048, 2048, 1.f}; big_gemm(a, wi + (size_t)2048 * 1024, T_ALL, 2048, 1024, e, lds); }
    xcd_barrier(xb);
    scan_phase<256, false, 64>(p, lds);
    xcd_barrier(xb);
    { EpiStore e{(bf16_t*)(p.ws + R_QK), (bf16_t*)(p.ws + R_QK), 1 << 30, 2048, 2048, 1.f}; big_gemm(a, wi + (size_t)4096 * 1024, T_ALL, 2048, 1024, e, lds); }
    xcd_barrier(xb);
    ret_readout_phase(p);
    xcd_barrier(xb);
    { EpiResid e{p.x, p.ctx, p.out, hctx, mods + 2 * 1024, nullptr, nullptr, nullptr}; big_gemm((const bf16_t*)(p.ws + R_O), (const bf16_t*)(p.ws + W0_RETOUT), T_ALL, 1024, 2048, e, lds); }
    xcd_barrier(xb);
    ln_phase(p, 0, 0, 0, 3, false);
    convert_w<0>(p.na_w_qkv, 3072, 1024, (bf16_t*)(p.ws + W1_QKV), 3072, nullptr, ldsf);
    convert_w<0>(p.na_w_out, 1024, 1024, (bf16_t*)(p.ws + W1_OUT), 1024, nullptr, ldsf);
    convert_w<1>(p.w13 + (size_t)1 * 1024 * 5632, 5632, 1024, (bf16_t*)(p.ws + W1_W13), 5632, nullptr, ldsf);
    convert_w<0>(p.w2 + (size_t)1 * FF * 1024, 1024, FF, (bf16_t*)(p.ws + W1_W2), 1024, nullptr, ldsf);
    convert_w<5>(p.mla_w_down, 800, 1024, (bf16_t*)(p.ws + W2_DOWN), 1024, nullptr, ldsf);
    convert_w<3>(p.mla_w_uq, 1536, 512, (bf16_t*)(p.ws + W2_UQ), 1536, p.mla_q_norm, ldsf);
    convert_w<4>(p.mla_w_ukv, 2048, 256, (bf16_t*)(p.ws + W2_UKV), 2048, p.mla_kv_norm, ldsf);
    convert_w<0>(p.mla_w_out, 1024, 1024, (bf16_t*)(p.ws + W2_OUT), 1024, nullptr, ldsf);
    convert_w<1>(p.w13 + (size_t)2 * 1024 * 5632, 5632, 1024, (bf16_t*)(p.ws + W2_W13), 5632, nullptr, ldsf);
    convert_w<0>(p.w2 + (size_t)2 * FF * 1024, 1024, FF, (bf16_t*)(p.ws + W2_W2), 1024, nullptr, ldsf);
    convert_w<0>(p.hg_w_in, 5120, 1024, (bf16_t*)(p.ws + W3_IN), 5120, nullptr, ldsf);
    convert_w<0>(p.hg_w_out, 1024, 1024, (bf16_t*)(p.ws + W3_OUT), 1024, nullptr, ldsf);
    convert_w<1>(p.w13 + (size_t)3 * 1024 * 5632, 5632, 1024, (bf16_t*)(p.ws + W3_W13), 5632, nullptr, ldsf);
    convert_w<0>(p.w2 + (size_t)3 * FF * 1024, 1024, FF, (bf16_t*)(p.ws + W3_W2), 1024, nullptr, ldsf);
    xcd_barrier(xb);
    ffn_and_ln(p, xb, lds, 0, (const bf16_t*)(p.ws + W0_W13), (const bf16_t*)(p.ws + W0_W2));
  }
  { const bf16_t* wq = (const bf16_t*)(p.ws + W1_QKV);
    { EpiStore e{(bf16_t*)(p.ws + N_Q), (bf16_t*)(p.ws + N_K), 1024, 1024, 1024, 0.125f}; big_gemm(a, wq, T_ALL, 2048, 1024, e, lds); }
    { GemmArgs g{a, 1024, wq + (size_t)2048 * 1024, 1024, T_ALL, 1024, 1024}; EpiVT e{(bf16_t*)(p.ws + N_VT), nullptr}; gemm_phase<true>(g, e, lds); }
    xcd_barrier(xb);
    na_attn_phase(p, lds);
    xcd_barrier(xb);
    { EpiResid e{p.out, hctx, p.out, hctx, mods + (size_t)1 * 5 * 6144 + 2 * 1024, (const float2*)(p.ws + OFF_LNS), p.ln_g + (size_t)(0 * 2 + 1) * 1024, p.ln_b + (size_t)(0 * 2 + 1) * 1024}; big_gemm(a, (const bf16_t*)(p.ws + W1_OUT), T_ALL, 1024, 1024, e, lds); }
    xcd_barrier(xb);
    ln_phase(p, 1, 0, 1, 3, false);
    xcd_barrier(xb);
    ffn_and_ln(p, xb, lds, 1, (const bf16_t*)(p.ws + W1_W13), (const bf16_t*)(p.ws + W1_W2));
  }
  { const bf16_t* d0 = (const bf16_t*)(p.ws + M_D0);
    { EpiStore e{(bf16_t*)(p.ws + M_D0), (bf16_t*)(p.ws + M_D0), 1 << 30, 1024, 1024, 1.f}; big_gemm(a, (const bf16_t*)(p.ws + W2_DOWN), T_ALL, 1024, 1024, e, lds); }
    xcd_barrier(xb);
    mla_stats_phase(p);
    xcd_barrier(xb);
    { GemmArgs g{d0, 1024, (const bf16_t*)(p.ws + W2_UQ), 512, T_ALL, 1536, 512}; EpiMlaQ e{(bf16_t*)(p.ws + M_Q), rs, tabM}; gemm_phase<false>(g, e, lds); }
    { GemmArgs g{d0 + 512, 1024, (const bf16_t*)(p.ws + W2_UKV), 256, T_ALL, 1024, 256}; EpiMlaK e{(bf16_t*)(p.ws + M_K), rs}; gemm_phase<false>(g, e, lds); }
    { GemmArgs g{d0 + 512, 1024, (const bf16_t*)(p.ws + W2_UKV) + (size_t)1024 * 256, 256, T_ALL, 1024, 256}; EpiVT e{(bf16_t*)(p.ws + M_VT), rs}; gemm_phase<true>(g, e, lds); }
    xcd_barrier(xb);
    mla_attn_phase(p, lds);
    xcd_barrier(xb);
    { EpiResid e{p.out, hctx, p.out, hctx, mods + (size_t)2 * 5 * 6144 + 2 * 1024, (const float2*)(p.ws + OFF_LNS), p.ln_g + (size_t)(1 * 2 + 1) * 1024, p.ln_b + (size_t)(1 * 2 + 1) * 1024}; big_gemm(a, (const bf16_t*)(p.ws + W2_OUT), T_ALL, 1024, 1024, e, lds); }
    xcd_barrier(xb);
    ln_phase(p, 2, 0, 2, 3, false);
    xcd_barrier(xb);
    ffn_and_ln(p, xb, lds, 2, (const bf16_t*)(p.ws + W2_W13), (const bf16_t*)(p.ws + W2_W2));
  }
  { { EpiHg e{(bf16_t*)(p.ws + H_P)}; big_gemm(a, (const bf16_t*)(p.ws + W3_IN), T_ALL, 5120, 1024, e, lds); }
    xcd_barrier(xb);
    scan_phase<128, true, 32>(p, lds);
    xcd_barrier(xb);
    hg_readout_phase(p);
    xcd_barrier(xb);
    { EpiResid e{p.out, hctx, p.out, hctx, mods + (size_t)3 * 5 * 6144 + 2 * 1024, (const float2*)(p.ws + OFF_LNS), p.ln_g + (size_t)(2 * 2 + 1) * 1024, p.ln_b + (size_t)(2 * 2 + 1) * 1024}; big_gemm(a, (const bf16_t*)(p.ws + W3_OUT), T_ALL, 1024, 1024, e, lds, 1); }
    xcd_barrier(xb);
    ln_phase(p, 3, 0, 3, 3, false);
    xcd_barrier(xb);
    ffn_and_ln(p, xb, lds, 3, (const bf16_t*)(p.ws + W3_W13), (const bf16_t*)(p.ws + W3_W2));
  }
}

extern "C" void kernel_launch(void* const* d_in, const int* in_sizes, int n_in, void* d_out, int out_size, void* d_ws, size_t ws_size, hipStream_t stream) {
  static int grid_blocks = 0;
  if (!grid_blocks) {
    int dev = 0, cus = 0, per_cu = 0;
    (void)hipGetDevice(&dev);
    (void)hipDeviceGetAttribute(&cus, hipDeviceAttributeMultiprocessorCount, dev);
    (void)hipOccupancyMaxActiveBlocksPerMultiprocessor(&per_cu, mega, NTHR, 0);
    if (per_cu != 1) per_cu = 1;
    grid_blocks = cus * per_cu;
  }
  if (ws_size < WS_NEED) { fprintf(stderr, "workspace too small: %zu\n", ws_size); return; }
  Params p{};
  const float** f = (const float**)&p;
  for (int i = 0; i < 26; ++i) f[i] = (const float*)d_in[i];
  p.out = (float*)d_out; p.ws = (char*)d_ws;
  (void)hipMemsetAsync((char*)d_ws + OFF_BAR, 0, XCD_BAR_WORDS * 4, stream);
  void* args[] = {&p};
  hipError_t e = hipLaunchCooperativeKernel((void*)mega, dim3(grid_blocks), dim3(NTHR), args, 0, stream);
  if (e != hipSuccess) fprintf(stderr, "cooperative launch failed: %s (grid %d)\n", hipGetErrorString(e), grid_blocks);
}
```

```cpp
#include <hip/hip_runtime.h>
#include <hip/hip_cooperative_groups.h>
#include <cstdio>
#include <cstdint>
namespace cg = cooperative_groups;

#define DI __device__ __forceinline__
DI int tid_() { int t = threadIdx.x; asm volatile("" : "+v"(t)); return t; }
typedef unsigned short bf16_t;
typedef short bf16x8 __attribute__((ext_vector_type(8)));
typedef short s16x4 __attribute__((ext_vector_type(4)));
typedef float f32x4 __attribute__((ext_vector_type(4)));
typedef float f32x16 __attribute__((ext_vector_type(16)));
typedef unsigned u32x4 __attribute__((ext_vector_type(4)));
typedef unsigned u32x2 __attribute__((ext_vector_type(2)));

constexpr int NTHR = 512;
constexpr int T_ALL = 33792, PB = 8448, LC = 256, LL = 8192, DM = 1024, FF = 2816;
constexpr float ALPHA = 1.681792830507429f;
constexpr float LOG2E = 1.4426950408889634f;
constexpr size_t MiB = 1048576;

struct Params {
  const float *x, *c, *ctx, *cctx, *ada_w, *ada_b, *ln_g, *ln_b, *w13, *w2;
  const float *ret_w_in, *ret_decay, *ret_w_out, *na_w_qkv, *na_rpb, *na_w_out;
  const float *mla_w_down, *mla_q_norm, *mla_kv_norm, *mla_w_uq, *mla_w_ukv, *mla_w_out;
  const float *hg_w_in, *hg_lb, *hg_norm_g, *hg_w_out;
  float* out; char* ws;
};

constexpr size_t OFF_MODS = 0;
constexpr size_t OFF_TABR = 512 * 1024;
constexpr size_t OFF_TABM = OFF_TABR + 65536;
constexpr size_t OFF_LBV = OFF_TABM + 8192;
constexpr size_t OFF_RS = OFF_LBV + 4096;
constexpr size_t OFF_BAR = 896 * 1024;
constexpr size_t OFF_HCTX = 1 * MiB;
constexpr size_t OFF_A = 5 * MiB;
constexpr size_t OFF_W0 = 71 * MiB;
constexpr size_t OFF_BIG = 104 * MiB;
constexpr size_t OFF_WR = OFF_BIG;
constexpr size_t OFF_S = 180 * MiB;
constexpr size_t WS_NEED = 512 * MiB;
constexpr size_t OFF_LNS = 510 * MiB;
constexpr size_t W0_RETIN = OFF_W0, W0_RETOUT = W0_RETIN + (size_t)6144 * 1024 * 2, W0_W13 = W0_RETOUT + (size_t)1024 * 2048 * 2, W0_W2 = W0_W13 + (size_t)5632 * 1024 * 2;
constexpr size_t SZ_W13 = (size_t)5632 * 1024 * 2, SZ_W2 = (size_t)1024 * 2816 * 2, SZ_SQ = (size_t)1024 * 1024 * 2;
constexpr size_t W1_QKV = OFF_WR, W1_OUT = W1_QKV + (size_t)3072 * 1024 * 2, W1_W13 = W1_OUT + SZ_SQ, W1_W2 = W1_W13 + SZ_W13;
constexpr size_t W2_DOWN = W1_W2 + SZ_W2, W2_UQ = W2_DOWN + (size_t)1024 * 1024 * 2, W2_UKV = W2_UQ + (size_t)1536 * 512 * 2, W2_OUT = W2_UKV + (size_t)2048 * 256 * 2, W2_W13 = W2_OUT + SZ_SQ, W2_W2 = W2_W13 + SZ_W13;
constexpr size_t W3_IN = W2_W2 + SZ_W2, W3_OUT = W3_IN + (size_t)5120 * 1024 * 2, W3_W13 = W3_OUT + SZ_SQ, W3_W2 = W3_W13 + SZ_W13, W3_END = W3_W2 + SZ_W2;
static_assert(W3_END <= OFF_S, "rest weights overflow");
static_assert(W0_W2 + SZ_W2 <= OFF_BIG, "W0 overflow");
constexpr size_t SZ_T2048 = (size_t)T_ALL * 2048 * 2, SZ_T1024 = (size_t)T_ALL * 1024 * 2;
constexpr size_t R_QK = OFF_BIG, R_V = R_QK + SZ_T2048, R_O = R_V + SZ_T2048;
static_assert(R_O + SZ_T2048 <= WS_NEED, "retention overflow");
constexpr size_t N_Q = OFF_S, N_K = N_Q + SZ_T1024, N_VT = N_K + SZ_T1024;
constexpr size_t M_D0 = OFF_S, M_Q = M_D0 + (size_t)T_ALL * 1024 * 2, M_K = M_Q + (size_t)T_ALL * 1536 * 2, M_VT = M_K + (size_t)T_ALL * 1536 * 2;
static_assert(M_VT + SZ_T1024 <= WS_NEED, "mla overflow");
constexpr size_t H_P = OFF_S;
static_assert(H_P + (size_t)T_ALL * 5120 * 2 <= WS_NEED, "hgrn overflow");
constexpr size_t F_U = OFF_S;

typedef float f32x2 __attribute__((ext_vector_type(2)));
typedef __bf16 bf16x2_t __attribute__((ext_vector_type(2)));
DI unsigned pk2(float lo, float hi) { const f32x2 v = {lo, hi}; const bf16x2_t r = __builtin_convertvector(v, bf16x2_t); return __builtin_bit_cast(unsigned, r); }
DI float bflo(unsigned u) { return __uint_as_float(u << 16); }
DI float bfhi(unsigned u) { return __uint_as_float(u & 0xffff0000u); }
DI float bf2f(bf16_t v) { return __uint_as_float(((unsigned)v) << 16); }
DI bf16_t f2bf(float x) { return (bf16_t)(pk2(x, 0.f) & 0xffffu); }
DI float siluf(float x) { return x / (1.f + __expf(-x)); }
DI f32x4 mfma16(bf16x8 a, bf16x8 b, f32x4 c) { return __builtin_amdgcn_mfma_f32_16x16x32_bf16(a, b, c, 0, 0, 0); }
DI f32x16 mfma32(bf16x8 a, bf16x8 b, f32x16 c) { return __builtin_amdgcn_mfma_f32_32x32x16_bf16(a, b, c, 0, 0, 0); }
DI bf16x8 cat44(s16x4 lo, s16x4 hi) { return __builtin_shufflevector(lo, hi, 0, 1, 2, 3, 4, 5, 6, 7); }
DI bf16x8 pack8(float a0, float a1, float a2, float a3, float a4, float a5, float a6, float a7) {
  u32x4 p; p.x = pk2(a0, a1); p.y = pk2(a2, a3); p.z = pk2(a4, a5); p.w = pk2(a6, a7); return __builtin_bit_cast(bf16x8, p);
}
DI int clampi(int v, int lo, int hi) { return v < lo ? lo : (v > hi ? hi : v); }
DI float* hrow(float* hlat, float* hctx, int t) { const int b = t / PB, p = t - b * PB; return p < LC ? hctx + (size_t)(b * LC + p) * DM : hlat + (size_t)(b * LL + p - LC) * DM; }
DI const float* hrowc(const float* hlat, const float* hctx, int t) { const int b = t / PB, p = t - b * PB; return p < LC ? hctx + (size_t)(b * LC + p) * DM : hlat + (size_t)(b * LL + p - LC) * DM; }
DI int modvec(int t) { const int b = t / PB, p = t - b * PB; return p < LC ? 4 : b; }

template <int MODE> DI int srccol(int n) {
  if (MODE == 0) return n;
  if (MODE == 1) { const int c = n >> 5, s = (n >> 4) & 1, i = n & 15; return s * FF + 16 * c + i; }
  if (MODE == 2) { if (n >= 2048) return n; const int w = n & 255, j = w >> 1, s = w & 1; return (n & ~255) + s * 128 + j; }
  if (MODE == 3) { const int h = n / 96, w = n - h * 96; if (w < 64) return n; const int wp = w - 64, j = wp >> 1, s = wp & 1; return h * 96 + 64 + s * 16 + j; }
  if (MODE == 4) { if (n < 1024) return (n >> 6) * 128 + (n & 63); const int m = n - 1024; return (m >> 6) * 128 + 64 + (m & 63); }
  if (MODE == 5) return n < 800 ? n : -1;
  return n;
}
template <int MODE> DI f32x4 cvt_load4(const float* __restrict__ row, int n) {
  if (MODE == 2 && n < 2048) { const int w = n & 255, j = w >> 1; const float* b = row + (n & ~255) + j; const f32x2 lo = *(const f32x2*)b, hi = *(const f32x2*)(b + 128); return (f32x4){lo[0], hi[0], lo[1], hi[1]}; }
  if (MODE == 3) { return (f32x4){row[srccol<3>(n)], row[srccol<3>(n + 1)], row[srccol<3>(n + 2)], row[srccol<3>(n + 3)]}; }
  const int sc = srccol<MODE>(n); if (sc < 0) return (f32x4){0.f, 0.f, 0.f, 0.f};
  return *(const f32x4*)(row + sc);
}
template <int MODE>
DI void convert_w(const float* __restrict__ src, int Nsrc, int K, bf16_t* __restrict__ dst, int Ndst, const float* __restrict__ kscale, float* ldsf) {
  const int tid = threadIdx.x, tn = Ndst / 64, tk = K / 64;
  for (int tile = blockIdx.x; tile < tn * tk; tile += gridDim.x) {
    const int n0 = (tile % tn) * 64, k0 = (tile / tn) * 64;
    __syncthreads();
#pragma unroll
    for (int i = 0; i < 2; ++i) { const int kk = (tid >> 4) + 32 * i, nn = (tid & 15) * 4;
      f32x4 v = cvt_load4<MODE>(src + (size_t)(k0 + kk) * Nsrc, n0 + nn);
      if (kscale) v = v * kscale[k0 + kk];
      float* lp = ldsf + kk * 65 + nn; lp[0] = v[0]; lp[1] = v[1]; lp[2] = v[2]; lp[3] = v[3]; }
    __syncthreads();
    { const int nn = tid >> 3, kc = tid & 7; const float* lp = ldsf + (kc * 8) * 65 + nn;
      u32x4 o; o.x = pk2(lp[0], lp[65]); o.y = pk2(lp[130], lp[195]); o.z = pk2(lp[260], lp[325]); o.w = pk2(lp[390], lp[455]);
      *(u32x4*)(dst + (size_t)(n0 + nn) * K + k0 + kc * 8) = o; }
  }
}

DI void ada_phase(const Params& p, float* ldsf) {
  const int tid = threadIdx.x, lane = tid & 63, w = tid >> 6;
  float* mods = (float*)(p.ws + OFF_MODS);
  __syncthreads();
  for (int e = tid; e < 5120; e += NTHR) { const int mv = e >> 10, k = e & 1023; const float cv = mv < 4 ? p.c[mv * 1024 + k] : p.cctx[k]; ldsf[e] = siluf(cv); }
  __syncthreads();
  float* red = ldsf + 5120;
  for (int item = blockIdx.x; item < 4 * 96; item += gridDim.x) {
    const int i = item / 96, n0 = (item % 96) * 64;
    const float* wp = p.ada_w + (size_t)i * 1024 * 6144 + n0 + lane;
    float a0 = 0.f, a1 = 0.f, a2 = 0.f, a3 = 0.f, a4 = 0.f;
#pragma unroll 8
    for (int kk = 0; kk < 128; ++kk) { const int k = w * 128 + kk; const float wv = wp[(size_t)k * 6144];
      a0 += ldsf[k] * wv; a1 += ldsf[1024 + k] * wv; a2 += ldsf[2048 + k] * wv; a3 += ldsf[3072 + k] * wv; a4 += ldsf[4096 + k] * wv; }
    red[(w * 5 + 0) * 64 + lane] = a0; red[(w * 5 + 1) * 64 + lane] = a1; red[(w * 5 + 2) * 64 + lane] = a2; red[(w * 5 + 3) * 64 + lane] = a3; red[(w * 5 + 4) * 64 + lane] = a4;
    __syncthreads();
    if (tid < 320) { const int mv = tid >> 6; float s = 0.f;
#pragma unroll
      for (int ww = 0; ww < 8; ++ww) s += red[(ww * 5 + mv) * 64 + lane];
      mods[(size_t)(i * 5 + mv) * 6144 + n0 + lane] = s + p.ada_b[i * 6144 + n0 + lane]; }
    __syncthreads();
  }
}
DI void tables_phase(const Params& p) {
  const int gt = blockIdx.x * NTHR + threadIdx.x, gn = gridDim.x * NTHR;
  float2* tabR = (float2*)(p.ws + OFF_TABR); float2* tabM = (float2*)(p.ws + OFF_TABM); float* lbv = (float*)(p.ws + OFF_LBV);
  for (int e = gt; e < 128 * 64; e += gn) { const int v = e >> 6, i = e & 63; const float inv = powf(10000.f, -(float)i / 64.f); const float ang = (float)v * inv; tabR[e] = make_float2(cosf(ang), sinf(ang)); }
  for (int e = gt; e < 128 * 8; e += gn) { const int v = e >> 3, i = e & 7; const float inv = powf(10000.f, -(float)i / 8.f); const float ang = (float)v * inv; tabM[e] = make_float2(cosf(ang), sinf(ang)); }
  for (int e = gt; e < 1024; e += gn) { const float l0 = p.hg_lb[e], l1 = p.hg_lb[1024 + e], l2 = p.hg_lb[2048 + e], l3 = p.hg_lb[3072 + e];
    const float mx = fmaxf(fmaxf(l0, l1), fmaxf(l2, l3)); const float e0 = expf(l0 - mx), e1 = expf(l1 - mx), e2 = expf(l2 - mx), e3 = expf(l3 - mx);
    lbv[e] = (e1 + e2 + e3) / (e0 + e1 + e2 + e3); }
}

DI void modulate_phase(const Params& p, const float* slat, const float* sctx, int layer) {
  const float* mods = (const float*)(p.ws + OFF_MODS); bf16_t* a = (bf16_t*)(p.ws + OFF_A);
  const int gt = blockIdx.x * NTHR + threadIdx.x, gn = gridDim.x * NTHR;
  for (int e = gt; e < T_ALL * 128; e += gn) {
    const int t = e >> 7, c0 = (e & 127) * 8; const float* s = hrowc(slat, sctx, t) + c0; const float* m = mods + (size_t)(layer * 5 + modvec(t)) * 6144;
    const f32x4 x0 = *(const f32x4*)s, x1 = *(const f32x4*)(s + 4), sh0 = *(const f32x4*)(m + c0), sh1 = *(const f32x4*)(m + c0 + 4), sc0 = *(const f32x4*)(m + 1024 + c0), sc1 = *(const f32x4*)(m + 1024 + c0 + 4);
    const f32x4 y0 = x0 * (1.f + sc0) + sh0, y1 = x1 * (1.f + sc1) + sh1;
    u32x4 o; o.x = pk2(y0[0], y0[1]); o.y = pk2(y0[2], y0[3]); o.z = pk2(y1[0], y1[1]); o.w = pk2(y1[2], y1[3]);
    *(u32x4*)(a + (size_t)t * 1024 + c0) = o;
  }
}
DI void ln_phase(const Params& p, int lnlayer, int lnidx, int ml, int js, bool final_out) {
  const float* mods = (const float*)(p.ws + OFF_MODS); bf16_t* a = (bf16_t*)(p.ws + OFF_A); float* hctx = (float*)(p.ws + OFF_HCTX); float2* lns = (float2*)(p.ws + OFF_LNS);
  const int tid = threadIdx.x, lane = tid & 63, gw = blockIdx.x * 8 + (tid >> 6), nw = gridDim.x * 8;
  const float* gp = p.ln_g + (size_t)(lnlayer * 2 + lnidx) * 1024; const float* bp = p.ln_b + (size_t)(lnlayer * 2 + lnidx) * 1024;
  for (int t = gw; t < T_ALL; t += nw) {
    float* hr = hrow(p.out, hctx, t);
    f32x4 v[4]; float s = 0.f;
#pragma unroll
    for (int i = 0; i < 4; ++i) { v[i] = *(const f32x4*)(hr + i * 256 + lane * 4); s += (v[i][0] + v[i][1]) + (v[i][2] + v[i][3]); }
#pragma unroll
    for (int o = 1; o < 64; o <<= 1) s += __shfl_xor(s, o);
    const float mean = s * (1.f / 1024.f); float q = 0.f;
#pragma unroll
    for (int i = 0; i < 4; ++i) { v[i] = v[i] - mean; q += (v[i][0] * v[i][0] + v[i][1] * v[i][1]) + (v[i][2] * v[i][2] + v[i][3] * v[i][3]); }
#pragma unroll
    for (int o = 1; o < 64; o <<= 1) q += __shfl_xor(q, o);
    const float rstd = rsqrtf(q * (1.f / 1024.f) + 1e-5f);
    if (!final_out && lane == 0) lns[t] = make_float2(mean, rstd);
    const float* m = mods + (size_t)(ml * 5 + modvec(t)) * 6144 + (size_t)js * 1024;
#pragma unroll
    for (int i = 0; i < 4; ++i) { const int c0 = i * 256 + lane * 4;
      const f32x4 y = v[i] * rstd * *(const f32x4*)(gp + c0) + *(const f32x4*)(bp + c0);
      if (final_out) *(f32x4*)(hr + c0) = y;
      else { const f32x4 z = y * (1.f + *(const f32x4*)(m + 1024 + c0)) + *(const f32x4*)(m + c0); u32x2 o; o.x = pk2(z[0], z[1]); o.y = pk2(z[2], z[3]); *(u32x2*)(a + (size_t)t * 1024 + c0) = o; } }
  }
}

namespace pg8 {
#define PG8_LAS __attribute__((address_space(3)))
typedef unsigned short bf16_t;
typedef short bf16x8 __attribute__((ext_vector_type(8)));
typedef float f32x4 __attribute__((ext_vector_type(4)));
typedef unsigned u32x4 __attribute__((ext_vector_type(4)));
constexpr int BM = 256, BK = 64, HALF = 128, HTB = HALF * BK * 2  , STAGE_BYTES = 8 * HTB, NXCD = 8, WGM = 8;

__host__ __device__ __forceinline__ int lds_byte(int r, int c) { const int st = (r >> 4) * 2 + (c >> 5), rr = r & 15, cc = c & 31, ob = rr * 64 + cc * 2; return st * 1024 + (ob ^ (((ob >> 9) & 1) << 5)); }
__host__ __device__ __forceinline__ void stage_rc(int b, int& R, int& C) { const int st = b / 1024, sb = b % 1024, swz = sb ^ (((sb >> 9) & 1) << 5); R = (st >> 1) * 16 + swz / 64; C = (st & 1) * 32 + (swz % 64) / 2; }
__host__ __device__ __forceinline__ int perm32(int rho) { const int n = rho >> 4, i = rho & 15; return 8 * (i >> 2) + 4 * n + (i & 3); }

struct Unit { int pm, pn; };
struct Gemm { const bf16_t* A; const bf16_t* Bt; int M, N, K; };

struct StaticOrder {
    int nM, nN, nwg, G, c, lat;
    __host__ __device__ void init(int M, int N, int G_, int c_, int lat_ = 0) { lat = lat_; nM = lat ? 128 : M / BM; nN = N / BM; nwg = nM * nN; G = G_; c = c_; }
    __host__ __device__ bool next(int i, Unit& u) const {
        const long L = (long)i * G + c; if (L >= nwg) return false;
        int wgid = (int)L; { const int q = nwg / NXCD, r = nwg % NXCD, xcd = wgid % NXCD, off = wgid / NXCD; wgid = (xcd < r ? xcd * (q + 1) : r * (q + 1) + (xcd - r) * q) + off; }
        const int nig = WGM * nN, gid = wgid / nig, fm = gid * WGM, gsz = (nM - fm) < WGM ? (nM - fm) : WGM;
        u.pm = fm + ((wgid % nig) % gsz); u.pn = (wgid % nig) / gsz; if (lat) u.pm += (u.pm >> 5) + 1; return true;
    }
    __device__ __forceinline__ void a_ready(const Unit&) const {}
    __device__ __forceinline__ void done(const Unit&) const {}
};
template <class Epi, class Sched, bool ALIGN_EPI = false, bool SP2 = false>
__device__ __forceinline__ void gemm_phase(PG8_LAS unsigned char* lds, const Gemm g, const Sched& S, const Epi& E) {
    const int tid = tid_(), wid = __builtin_amdgcn_readfirstlane(tid >> 6), lane = tid & 63, wr = wid >> 2, wc = wid & 3, fr = lane & 15, fq = lane >> 4;
    const int K = g.K, nt = K / BK;
    unsigned voffA[2], voffB[2];
#pragma unroll
    for (int i = 0; i < 2; ++i) { int R, C; stage_rc(tid * 16 + i * 8192, R, C); const int Rb = Epi::PERM ? ((R & ~31) + perm32(R & 31)) : R;
        voffA[i] = (unsigned)(R * K + C) * 2u; voffB[i] = (unsigned)(Rb * K + C) * 2u; }
    const size_t kstep = (size_t)(BK * 2);
    const size_t hstep = (size_t)HALF * K * 2;
    const size_t tstep = 2 * hstep;
    const unsigned ldsw = (unsigned)wid * 1024u;
    const int aoff = lds_byte(wr * 64 + fr, fq * 8), boff = lds_byte(wc * 32 + fr, fq * 8);
#define PG8_SA(b, h) (((b) * 2 + (h)) * HTB)
#define PG8_SB(b, h) ((4 + (b) * 2 + (h)) * HTB)
#define PG8_STAGE(bufoff, gbase, voff) do { _Pragma("unroll") for (int _i = 0; _i < 2; ++_i) \
        __builtin_amdgcn_global_load_lds((const unsigned*)((const char*)(gbase) + (voff)[_i]), (PG8_LAS unsigned*)(lds + (bufoff) + ldsw + _i * 8192), 16, 0, 0); } while (0)
#define PG8_LDA(dst, b, h) do { _Pragma("unroll") for (int m = 0; m < 4; ++m) _Pragma("unroll") for (int k = 0; k < 2; ++k) dst[m][k] = *(const PG8_LAS bf16x8*)(lds + PG8_SA(b, h) + aoff + m * 2048 + k * 1024); } while (0)
#define PG8_LDB(dst, b, h) do { _Pragma("unroll") for (int n = 0; n < 2; ++n) _Pragma("unroll") for (int k = 0; k < 2; ++k) dst[n][k] = *(const PG8_LAS bf16x8*)(lds + PG8_SB(b, h) + boff + n * 2048 + k * 1024); } while (0)
#define PG8_MMA(ai, bj, At, Bt) do { __builtin_amdgcn_s_setprio(1); _Pragma("unroll") for (int m = 0; m < 4; ++m) _Pragma("unroll") for (int n = 0; n < 2; ++n) _Pragma("unroll") for (int k = 0; k < 2; ++k) \
        acc[ai][bj][m][n] = __builtin_amdgcn_mfma_f32_16x16x32_bf16(Bt[n][k], At[m][k], acc[ai][bj][m][n], 0, 0, 0); __builtin_amdgcn_s_setprio(0); } while (0)
#define PG8_WAIT_V(n) asm volatile("s_waitcnt vmcnt(" #n ")" ::: "memory")
#define PG8_WAIT_L(n) asm volatile("s_waitcnt lgkmcnt(" #n ")" ::: "memory")
#define PG8_BAR __builtin_amdgcn_s_barrier()
#define PG8_SCHED __builtin_amdgcn_sched_barrier(0)
    Unit cur, nxt; int ui = 0;
    if (!S.next(0, cur)) return;
    f32x4 acc[2][2][4][2];
#pragma unroll
    for (int a = 0; a < 2; ++a)
#pragma unroll
        for (int b = 0; b < 2; ++b)
#pragma unroll
            for (int m = 0; m < 4; ++m)
#pragma unroll
                for (int n = 0; n < 2; ++n) acc[a][b][m][n] = (f32x4){0.f, 0.f, 0.f, 0.f};
    bf16x8 At[4][2], B0[2][2], B1[2][2];
    const char* cA = (const char*)g.A + (size_t)cur.pm * tstep; const char* cB = (const char*)g.Bt + (size_t)cur.pn * tstep;
    S.a_ready(cur);
    if constexpr (SP2) {
        PG8_STAGE(PG8_SB(0, 0), cB, voffB); PG8_STAGE(PG8_SB(0, 1), cB + hstep, voffB); PG8_STAGE(PG8_SA(0, 0), cA, voffA); PG8_STAGE(PG8_SA(0, 1), cA + hstep, voffA);
        if (wr == 1) PG8_BAR;
        PG8_WAIT_V(2); PG8_BAR;
        PG8_STAGE(PG8_SB(1, 0), cB + kstep, voffB); PG8_STAGE(PG8_SA(1, 0), cA + kstep, voffA); PG8_STAGE(PG8_SB(1, 1), cB + hstep + kstep, voffB);
        PG8_WAIT_V(6); PG8_BAR;
    } else {
        PG8_STAGE(PG8_SB(0, 0), cB, voffB); PG8_STAGE(PG8_SA(0, 0), cA, voffA); PG8_STAGE(PG8_SB(0, 1), cB + hstep, voffB); PG8_STAGE(PG8_SA(0, 1), cA + hstep, voffA);
        if (wr == 1) PG8_BAR;
        PG8_WAIT_V(4); PG8_BAR;
        PG8_STAGE(PG8_SB(1, 0), cB + kstep, voffB); PG8_STAGE(PG8_SA(1, 0), cA + kstep, voffA); PG8_STAGE(PG8_SB(1, 1), cB + hstep + kstep, voffB);
        PG8_WAIT_V(6); PG8_BAR;
    }
    for (;;) {
        const bool has_next = S.next(ui + 1, nxt);
        const char* nA = has_next ? (const char*)g.A + (size_t)nxt.pm * tstep : cA; const char* nB = has_next ? (const char*)g.Bt + (size_t)nxt.pn * tstep : cB;
        for (int t = 0; t < nt; t += 2) {
            const bool last = (t == nt - 2);
            const char* a1 = cA + (size_t)(t + 1) * kstep;
            const char* a2 = last ? nA : cA + (size_t)(t + 2) * kstep; const char* b2 = last ? nB : cB + (size_t)(t + 2) * kstep;
            const char* a3 = a2 + kstep; const char* b3 = b2 + kstep;
            if (last && has_next) S.a_ready(nxt);
            if constexpr (SP2) {
            PG8_LDB(B0, 0, 0); PG8_LDB(B1, 0, 1); PG8_SCHED; PG8_LDA(At, 0, 0); PG8_STAGE(PG8_SA(1, 1), a1 + hstep, voffA);
            PG8_WAIT_V(8); PG8_WAIT_L(0); PG8_BAR; PG8_MMA(0, 0, At, B0); PG8_MMA(0, 1, At, B1); PG8_BAR; PG8_SCHED;
            PG8_LDA(At, 0, 1); PG8_STAGE(PG8_SB(0, 0), b2, voffB); PG8_STAGE(PG8_SB(0, 1), b2 + hstep, voffB); PG8_STAGE(PG8_SA(0, 0), a2, voffA);
            PG8_WAIT_V(8); PG8_WAIT_L(0); PG8_BAR; PG8_MMA(1, 0, At, B0); PG8_MMA(1, 1, At, B1); PG8_BAR; PG8_SCHED;
            PG8_LDB(B0, 1, 0); PG8_LDB(B1, 1, 1); PG8_SCHED; PG8_LDA(At, 1, 0); PG8_STAGE(PG8_SA(0, 1), a2 + hstep, voffA);
            PG8_WAIT_V(8); PG8_WAIT_L(0); PG8_BAR; PG8_MMA(0, 0, At, B0); PG8_MMA(0, 1, At, B1); PG8_BAR; PG8_SCHED;
            PG8_LDA(At, 1, 1); PG8_STAGE(PG8_SB(1, 0), b3, voffB); PG8_STAGE(PG8_SB(1, 1), b3 + hstep, voffB); PG8_STAGE(PG8_SA(1, 0), a3, voffA);
            PG8_WAIT_V(8); PG8_WAIT_L(0); PG8_BAR; PG8_MMA(1, 0, At, B0); PG8_MMA(1, 1, At, B1); PG8_BAR; PG8_SCHED;
            } else {
            PG8_LDB(B0, 0, 0); PG8_SCHED; PG8_LDA(At, 0, 0); PG8_STAGE(PG8_SA(1, 1), a1 + hstep, voffA);
            PG8_WAIT_L(8); PG8_BAR; PG8_WAIT_L(0); PG8_MMA(0, 0, At, B0); PG8_BAR; PG8_SCHED;
            PG8_LDB(B1, 0, 1); PG8_STAGE(PG8_SB(0, 0), b2, voffB);
            PG8_BAR; PG8_WAIT_L(0); PG8_MMA(0, 1, At, B1); PG8_BAR;
            PG8_LDA(At, 0, 1); PG8_STAGE(PG8_SA(0, 0), a2, voffA);
            PG8_BAR; PG8_WAIT_L(0); PG8_MMA(1, 0, At, B0); PG8_BAR; PG8_SCHED;
            PG8_STAGE(PG8_SB(0, 1), b2 + hstep, voffB);
            PG8_WAIT_V(6); PG8_BAR; PG8_MMA(1, 1, At, B1); PG8_BAR;
            PG8_LDB(B0, 1, 0); PG8_SCHED; PG8_LDA(At, 1, 0); PG8_STAGE(PG8_SA(0, 1), a2 + hstep, voffA);
            PG8_WAIT_L(8); PG8_BAR; PG8_WAIT_L(0); PG8_MMA(0, 0, At, B0); PG8_BAR; PG8_SCHED;
            PG8_LDB(B1, 1, 1); PG8_STAGE(PG8_SB(1, 0), b3, voffB);
            PG8_BAR; PG8_WAIT_L(0); PG8_MMA(0, 1, At, B1); PG8_BAR;
            PG8_LDA(At, 1, 1); PG8_STAGE(PG8_SA(1, 0), a3, voffA);
            PG8_BAR; PG8_WAIT_L(0); PG8_MMA(1, 0, At, B0); PG8_BAR; PG8_SCHED;
            PG8_STAGE(PG8_SB(1, 1), b3 + hstep, voffB);
            PG8_WAIT_V(6); PG8_BAR; PG8_MMA(1, 1, At, B1); PG8_BAR;
            }
        }
        if constexpr (ALIGN_EPI) { if (wr == 0) PG8_BAR; }
        if constexpr (!Epi::AFTER_DRAIN) { E(acc, cur, wr, wc, fr, fq); S.done(cur); }
        if (!has_next) break;
#pragma unroll
        for (int a = 0; a < 2; ++a)
#pragma unroll
            for (int b = 0; b < 2; ++b)
#pragma unroll
                for (int m = 0; m < 4; ++m)
#pragma unroll
                    for (int n = 0; n < 2; ++n) acc[a][b][m][n] = (f32x4){0.f, 0.f, 0.f, 0.f};
        cur = nxt; cA = nA; cB = nB; ++ui;
        if constexpr (ALIGN_EPI) { if (wr == 1) PG8_BAR; }
    }
    PG8_WAIT_V(0);
    if constexpr (!ALIGN_EPI) { if (wr == 0) PG8_BAR; }
    PG8_BAR;
    if constexpr (Epi::AFTER_DRAIN) { E.fused(acc, cur, wr, wc, fr, fq, lds, wid, lane); S.done(cur); }
#undef PG8_SA
#undef PG8_SB
#undef PG8_STAGE
#undef PG8_LDA
#undef PG8_LDB
#undef PG8_MMA
#undef PG8_WAIT_V
#undef PG8_WAIT_L
#undef PG8_BAR
#undef PG8_SCHED
}
}

template <class E4> struct EpiWrap { static constexpr bool PERM = false, AFTER_DRAIN = false; E4 e;
  DI void operator()(const f32x4 (&acc)[2][2][4][2], const pg8::Unit& u, int wr, int wc, int fr, int fq) const {
#pragma unroll
    for (int ai = 0; ai < 2; ++ai)
#pragma unroll
      for (int m = 0; m < 4; ++m) { const int row = u.pm * 256 + ai * 128 + wr * 64 + m * 16 + fr;
#pragma unroll
        for (int bj = 0; bj < 2; ++bj) { const int col = u.pn * 256 + bj * 128 + wc * 32 + 4 * fq;
          if constexpr (E4::PAIR) e.pair(row, ((col - 4 * fq) >> 1) + 4 * fq, acc[ai][bj][m][0], acc[ai][bj][m][1]);
          else { e(row, col, acc[ai][bj][m][0]); e(row, col + 16, acc[ai][bj][m][1]); } }
        asm volatile("" ::: "memory"); }
  } };
template <class E4>
DI void big_gemm(const bf16_t* A, const bf16_t* W, int M, int N, int K, const E4& e4, char* lds, int lat_only = 0) {
  __syncthreads();
  pg8::Gemm g{A, W, M, N, K}; pg8::StaticOrder S; S.init(M, N, (int)gridDim.x, (int)blockIdx.x, lat_only); EpiWrap<E4> E{e4};
  pg8::gemm_phase<EpiWrap<E4>, pg8::StaticOrder, true, true>((PG8_LAS unsigned char*)lds, g, S, E);
  __syncthreads();
}
struct GemmArgs { const bf16_t* A; int lda; const bf16_t* W; int ldw; int M, N, K; };
constexpr int LDT = 72;
template <bool TRANS, class Epi>
DI void gemm_phase(const GemmArgs g, const Epi epi, char* lds) {
  const int tid = threadIdx.x, lane = tid & 63, w = tid >> 6, wm = w & 3, wn = w >> 2, g4 = lane >> 4, l16 = lane & 15;
  const int nN = g.N / 128, ntiles = (g.M / 256) * nN, nk = g.K / 64;
  bf16_t* As = (bf16_t*)lds; bf16_t* Bs = As + 256 * LDT;
  for (int tile = blockIdx.x; tile < ntiles; tile += gridDim.x) {
    const int pm = tile / nN, pn = tile - pm * nN;
    const bf16_t* Ag = g.A + (size_t)(pm * 256) * g.lda; const bf16_t* Wg = g.W + (size_t)(pn * 128) * g.ldw;
    f32x4 acc[4][4];
#pragma unroll
    for (int i = 0; i < 4; ++i)
#pragma unroll
      for (int j = 0; j < 4; ++j) acc[i][j] = (f32x4){0.f, 0.f, 0.f, 0.f};
    u32x4 ra[4], rb[2];
#pragma unroll
    for (int i = 0; i < 4; ++i) { const int c = tid + NTHR * i; ra[i] = *(const u32x4*)(Ag + (size_t)(c >> 3) * g.lda + (c & 7) * 8); }
#pragma unroll
    for (int i = 0; i < 2; ++i) { const int c = tid + NTHR * i; rb[i] = *(const u32x4*)(Wg + (size_t)(c >> 3) * g.ldw + (c & 7) * 8); }
    for (int kt = 0; kt < nk; ++kt) {
      __syncthreads();
#pragma unroll
      for (int i = 0; i < 4; ++i) { const int c = tid + NTHR * i; *(u32x4*)(As + (c >> 3) * LDT + (c & 7) * 8) = ra[i]; }
#pragma unroll
      for (int i = 0; i < 2; ++i) { const int c = tid + NTHR * i; *(u32x4*)(Bs + (c >> 3) * LDT + (c & 7) * 8) = rb[i]; }
      __syncthreads();
      if (kt + 1 < nk) { const int k0 = (kt + 1) * 64;
#pragma unroll
        for (int i = 0; i < 4; ++i) { const int c = tid + NTHR * i; ra[i] = *(const u32x4*)(Ag + (size_t)(c >> 3) * g.lda + k0 + (c & 7) * 8); }
#pragma unroll
        for (int i = 0; i < 2; ++i) { const int c = tid + NTHR * i; rb[i] = *(const u32x4*)(Wg + (size_t)(c >> 3) * g.ldw + k0 + (c & 7) * 8); } }
#pragma unroll
      for (int ks = 0; ks < 2; ++ks) {
        bf16x8 af[4], wf[4];
#pragma unroll
        for (int i = 0; i < 4; ++i) af[i] = *(const bf16x8*)(As + (wm * 64 + i * 16 + l16) * LDT + ks * 32 + g4 * 8);
#pragma unroll
        for (int j = 0; j < 4; ++j) wf[j] = *(const bf16x8*)(Bs + (wn * 64 + j * 16 + l16) * LDT + ks * 32 + g4 * 8);
#pragma unroll
        for (int i = 0; i < 4; ++i)
#pragma unroll
          for (int j = 0; j < 4; ++j) acc[i][j] = TRANS ? mfma16(af[i], wf[j], acc[i][j]) : mfma16(wf[j], af[i], acc[i][j]);
      }
    }
    const int mb = pm * 256 + wm * 64, nb = pn * 128 + wn * 64;
    if constexpr (Epi::PAIR) {
#pragma unroll
      for (int i = 0; i < 4; ++i)
#pragma unroll
        for (int j = 0; j < 2; ++j) epi.pair(mb + i * 16 + l16, (nb >> 1) + 16 * j + 4 * g4, acc[i][2 * j], acc[i][2 * j + 1]);
    } else {
#pragma unroll
      for (int i = 0; i < 4; ++i)
#pragma unroll
        for (int j = 0; j < 4; ++j) { if (TRANS) epi(mb + i * 16 + 4 * g4, nb + j * 16 + l16, acc[i][j]); else epi(mb + i * 16 + l16, nb + j * 16 + 4 * g4, acc[i][j]); }
    }
  }
}
DI void st4bf(bf16_t* p, f32x4 v) { u32x2 o; o.x = pk2(v[0], v[1]); o.y = pk2(v[2], v[3]); *(u32x2*)p = o; }
struct EpiStore { static constexpr bool PAIR = false; bf16_t* d0; bf16_t* d1; int split, ld0, ld1; float s0;
  DI void operator()(int m, int n, f32x4 v) const { if (n < split) st4bf(d0 + (size_t)m * ld0 + n, v * s0); else st4bf(d1 + (size_t)m * ld1 + (n - split), v); } };
struct EpiVT { static constexpr bool PAIR = false; bf16_t* vt; const float* rs;
  DI void operator()(int m, int n, f32x4 v) const { const int b = m / PB, pos = m - b * PB;
    if (rs) { v[0] *= rs[2 * m + 1]; v[1] *= rs[2 * m + 3]; v[2] *= rs[2 * m + 5]; v[3] *= rs[2 * m + 7]; }
    st4bf(vt + ((size_t)(b * 1024 + n)) * PB + pos, v); } };
struct EpiResid { static constexpr bool PAIR = false; const float* slat; const float* sctx; float* dlat; float* dctx; const float* gate;
  const float2* lns; const float* lg; const float* lb;
  DI void operator()(int m, int n, f32x4 v) const { const int mv = modvec(m); f32x4 hv = *(const f32x4*)(hrowc(slat, sctx, m) + n); const f32x4 gt = *(const f32x4*)(gate + (size_t)mv * 6144 + n);
    if (lns) { const float2 st = lns[m]; hv = (hv - st.x) * st.y * *(const f32x4*)(lg + n) + *(const f32x4*)(lb + n); }
    *(f32x4*)(hrow(dlat, dctx, m) + n) = ALPHA * hv + gt * v; } };
constexpr int CLD = 264;
template <class Epi>
DI void ctx_gemm(const bf16_t* __restrict__ A, const bf16_t* __restrict__ W, int K, const Epi& epi, char* lds) {
  const int tid = threadIdx.x, lane = tid & 63, w = tid >> 6, g4 = lane >> 4, l16 = lane & 15, wm = w & 3, wn = w >> 2;
  bf16_t* As = (bf16_t*)lds; bf16_t* Ws = As + 64 * CLD;
  const int nk = K / 256;
  for (int tile = blockIdx.x; tile < 256; tile += gridDim.x) {
    const int b = tile >> 6, mt = (tile >> 4) & 3, nt = tile & 15;
    const size_t row0 = (size_t)b * PB + mt * 64;
    const bf16_t* Ag = A + row0 * K; const bf16_t* Wg = W + (size_t)(nt * 64) * K;
    u32x4 ra[4], rw[4];
#pragma unroll
    for (int i = 0; i < 4; ++i) { const int c = tid + NTHR * i, r = c >> 5, kc = c & 31; ra[i] = *(const u32x4*)(Ag + (size_t)r * K + kc * 8); rw[i] = *(const u32x4*)(Wg + (size_t)r * K + kc * 8); }
    f32x4 acc[2] = {(f32x4){0.f, 0.f, 0.f, 0.f}, (f32x4){0.f, 0.f, 0.f, 0.f}};
    for (int kt = 0; kt < nk; ++kt) {
      __syncthreads();
#pragma unroll
      for (int i = 0; i < 4; ++i) { const int c = tid + NTHR * i, r = c >> 5, kc = c & 31; *(u32x4*)(As + r * CLD + kc * 8) = ra[i]; *(u32x4*)(Ws + r * CLD + kc * 8) = rw[i]; }
      __syncthreads();
      if (kt + 1 < nk) { const int k0 = (kt + 1) * 256;
#pragma unroll
        for (int i = 0; i < 4; ++i) { const int c = tid + NTHR * i, r = c >> 5, kc = c & 31; ra[i] = *(const u32x4*)(Ag + (size_t)r * K + k0 + kc * 8); rw[i] = *(const u32x4*)(Wg + (size_t)r * K + k0 + kc * 8); } }
#pragma unroll
      for (int ks = 0; ks < 8; ++ks) {
        const bf16x8 af = *(const bf16x8*)(As + (wm * 16 + l16) * CLD + ks * 32 + g4 * 8);
        const bf16x8 w0 = *(const bf16x8*)(Ws + (wn * 32 + l16) * CLD + ks * 32 + g4 * 8), w1 = *(const bf16x8*)(Ws + (wn * 32 + 16 + l16) * CLD + ks * 32 + g4 * 8);
        acc[0] = mfma16(w0, af, acc[0]); acc[1] = mfma16(w1, af, acc[1]);
      }
    }
    const int m = (int)row0 + wm * 16 + l16, n = nt * 64 + wn * 32 + 4 * g4;
    epi(m, n, acc[0]); epi(m, n + 16, acc[1]);
  }
  __syncthreads();
}
struct EpiSwiglu { static constexpr bool PAIR = true; bf16_t* u;
  DI void pair(int m, int f, f32x4 gt, f32x4 up) const { f32x4 r; r[0] = siluf(gt[0]) * up[0]; r[1] = siluf(gt[1]) * up[1]; r[2] = siluf(gt[2]) * up[2]; r[3] = siluf(gt[3]) * up[3]; st4bf(u + (size_t)m * FF + f, r); } };
struct EpiRetQK { static constexpr bool PAIR = false; bf16_t* qk; const float2* tabR;
  DI void operator()(int m, int n, f32x4 v) const { const int b = m / PB, pp = m - b * PB;
    if (pp >= LC) { const int pos = pp - LC, row = pos >> 6, col = pos & 63; const int j0 = (n & 255) >> 1;
      const int vv = j0 < 64 ? row : col; const float2 c0 = tabR[vv * 64 + (j0 & 63)], c1 = tabR[vv * 64 + ((j0 + 1) & 63)];
      const float a0 = v[0] * c0.x - v[1] * c0.y, b0 = v[0] * c0.y + v[1] * c0.x, a1 = v[2] * c1.x - v[3] * c1.y, b1 = v[2] * c1.y + v[3] * c1.x; v = (f32x4){a0, b0, a1, b1}; }
    if (n >= 1024) v = v * 0.0625f;
    st4bf(qk + (size_t)m * 2048 + n, v); } };
struct EpiHg { static constexpr bool PAIR = false; bf16_t* ph;
  DI void operator()(int m, int n, f32x4 v) const { if (n < 1024) { v[0] = siluf(v[0]); v[1] = siluf(v[1]); v[2] = siluf(v[2]); v[3] = siluf(v[3]); v = v * 0.08838834764831845f; } st4bf(ph + (size_t)m * 5120 + n, v); } };
struct EpiMlaQ { static constexpr bool PAIR = false; bf16_t* q; const float* rs; const float2* tabM;
  DI void operator()(int m, int n, f32x4 v) const { v = v * (rs[2 * m] * 0.10206207261596577f * LOG2E); const int h = n / 96, w = n - h * 96; const int b = m / PB, pp = m - b * PB;
    if (w >= 64 && pp >= LC) { const int pos = pp - LC, row = pos >> 6, col = pos & 63; const int j0 = (w - 64) >> 1; const int vv = j0 < 8 ? row : col; const float2 c0 = tabM[vv * 8 + (j0 & 7)], c1 = tabM[vv * 8 + ((j0 + 1) & 7)];
      const float a0 = v[0] * c0.x - v[1] * c0.y, b0 = v[0] * c0.y + v[1] * c0.x, a1 = v[2] * c1.x - v[3] * c1.y, b1 = v[2] * c1.y + v[3] * c1.x; v = (f32x4){a0, b0, a1, b1}; }
    st4bf(q + (size_t)m * 1536 + n, v); } };
struct EpiMlaK { static constexpr bool PAIR = false; bf16_t* k; const float* rs;
  DI void operator()(int m, int n, f32x4 v) const { v = v * rs[2 * m + 1]; st4bf(k + (size_t)m * 1536 + (n >> 6) * 96 + (n & 63), v); } };

DI void mla_stats_phase(const Params& p) {
  const bf16_t* d0 = (const bf16_t*)(p.ws + M_D0); bf16_t* km = (bf16_t*)(p.ws + M_K); float* rs = (float*)(p.ws + OFF_RS); const float2* tabM = (const float2*)(p.ws + OFF_TABM);
  const int tid = threadIdx.x, lane = tid & 63, gw = blockIdx.x * 8 + (tid >> 6), nw = gridDim.x * 8;
  for (int t = gw; t < T_ALL; t += nw) {
    const bf16_t* r = d0 + (size_t)t * 1024;
    const u32x4 a = *(const u32x4*)(r + lane * 8); const u32x2 c = *(const u32x2*)(r + 512 + lane * 4);
    float sq = bflo(a.x) * bflo(a.x) + bfhi(a.x) * bfhi(a.x) + bflo(a.y) * bflo(a.y) + bfhi(a.y) * bfhi(a.y) + bflo(a.z) * bflo(a.z) + bfhi(a.z) * bfhi(a.z) + bflo(a.w) * bflo(a.w) + bfhi(a.w) * bfhi(a.w);
    float sk = bflo(c.x) * bflo(c.x) + bfhi(c.x) * bfhi(c.x) + bflo(c.y) * bflo(c.y) + bfhi(c.y) * bfhi(c.y);
#pragma unroll
    for (int o = 1; o < 64; o <<= 1) { sq += __shfl_xor(sq, o); sk += __shfl_xor(sk, o); }
    if (lane == 0) { rs[2 * t] = rsqrtf(sq * (1.f / 512.f) + 1e-6f); rs[2 * t + 1] = rsqrtf(sk * (1.f / 256.f) + 1e-6f); }
    if (lane < 16) { const int j = lane; float x1 = bf2f(r[768 + j]), x2 = bf2f(r[768 + 16 + j]); const int b = t / PB, pp = t - b * PB;
      if (pp >= LC) { const int pos = pp - LC, row = pos >> 6, col = pos & 63; const float2 cs = tabM[(j < 8 ? row : col) * 8 + (j & 7)]; const float o1 = x1 * cs.x - x2 * cs.y, o2 = x1 * cs.y + x2 * cs.x; x1 = o1; x2 = o2; }
      const unsigned pr = pk2(x1, x2);
#pragma unroll
      for (int h = 0; h < 16; ++h) *(unsigned*)(km + (size_t)t * 1536 + h * 96 + 64 + 2 * j) = pr; }
  }
}

constexpr int KLD = 104, VLD = 72;
DI void mla_attn_phase(const Params& p, char* lds) {
  const bf16_t* Qm = (const bf16_t*)(p.ws + M_Q); const bf16_t* Km = (const bf16_t*)(p.ws + M_K); const bf16_t* vT = (const bf16_t*)(p.ws + M_VT); bf16_t* o = (bf16_t*)(p.ws + OFF_A);
  const int tid = threadIdx.x, lane = tid & 63, w = tid >> 6, c = lane & 31, hh = lane >> 5;
  constexpr int KB = 64 * KLD, VB = 64 * VLD;
  bf16_t* Ks = (bf16_t*)lds; bf16_t* Vs = Ks + 3 * KB;
  for (int item = blockIdx.x; item < 2048 + 64; item += gridDim.x) {
    int b, h, qbase, nkt;
    if (item < 2048) { b = item >> 9; h = (item >> 5) & 15; qbase = LC + (item & 31) * 256; nkt = 132; } else { const int it = item - 2048; b = it >> 4; h = it & 15; qbase = 0; nkt = 4; }
    const size_t tokbase = (size_t)b * PB;
    const bf16_t* qp = Qm + (tokbase + qbase + w * 32 + c) * 1536 + h * 96 + hh * 8;
    bf16x8 qf[6];
#pragma unroll
    for (int ks = 0; ks < 6; ++ks) qf[ks] = *(const bf16x8*)(qp + ks * 16);
    const bf16_t* kg = Km + tokbase * 1536 + h * 96; const bf16_t* vg = vT + (size_t)(b * 16 + h) * 64 * PB;
    const int kr0 = tid / 12, kc0 = tid - kr0 * 12, e1 = tid + NTHR, kr1 = e1 / 12, kc1 = e1 - kr1 * 12; const bool k1ok = e1 < 768; const int vd = tid >> 3, vc = tid & 7;
    u32x4 rk0, rk1 = (u32x4){0, 0, 0, 0}, rv;
    auto gload = [&](int t) { const size_t key0 = (size_t)t * 64;
      rk0 = *(const u32x4*)(kg + (key0 + kr0) * 1536 + kc0 * 8); if (k1ok) rk1 = *(const u32x4*)(kg + (key0 + kr1) * 1536 + kc1 * 8); rv = *(const u32x4*)(vg + (size_t)vd * PB + key0 + vc * 8); };
    auto lstore = [&](int buf) { bf16_t* Kn = Ks + buf * KB; bf16_t* Vn = Vs + buf * VB;
      *(u32x4*)(Kn + kr0 * KLD + kc0 * 8) = rk0; if (k1ok) *(u32x4*)(Kn + kr1 * KLD + kc1 * 8) = rk1; *(u32x4*)(Vn + vd * VLD + vc * 8) = rv; };
    f32x16 oacc[2];
#pragma unroll
    for (int i = 0; i < 16; ++i) { oacc[0][i] = 0.f; oacc[1][i] = 0.f; }
    float mrow = -1e30f, lsum = 0.f;
    auto qk = [&](int buf, f32x16 (&s)[2]) { const bf16_t* Kc = Ks + buf * KB;
#pragma unroll
      for (int j = 0; j < 2; ++j) {
#pragma unroll
        for (int i = 0; i < 16; ++i) s[j][i] = 0.f;
#pragma unroll
        for (int ks = 0; ks < 6; ++ks) { const bf16x8 kf = *(const bf16x8*)(Kc + (32 * j + c) * KLD + ks * 16 + hh * 8); s[j] = mfma32(kf, qf[ks], s[j]); }
      } };
    auto smpv = [&](int buf, f32x16 (&s)[2]) { const bf16_t* Vc = Vs + buf * VB;
      float mx = s[0][0];
#pragma unroll
      for (int j = 0; j < 2; ++j)
#pragma unroll
        for (int i = 0; i < 16; ++i) mx = fmaxf(mx, s[j][i]);
      if (__builtin_amdgcn_ballot_w64(mx > mrow + 8.f) != 0ull) {
        mx = fmaxf(mx, __shfl_xor(mx, 32));
        const float mnew = fmaxf(mrow, mx), alpha = __builtin_amdgcn_exp2f(mrow - mnew); mrow = mnew;
        lsum *= alpha;
#pragma unroll
        for (int i = 0; i < 16; ++i) { oacc[0][i] *= alpha; oacc[1][i] *= alpha; }
      }
      float ps0 = 0.f, ps1 = 0.f;
#pragma unroll
      for (int j = 0; j < 2; ++j)
#pragma unroll
        for (int i = 0; i < 16; i += 2) { s[j][i] = __builtin_amdgcn_exp2f(s[j][i] - mrow); ps0 += s[j][i]; s[j][i + 1] = __builtin_amdgcn_exp2f(s[j][i + 1] - mrow); ps1 += s[j][i + 1]; }
      lsum += ps0 + ps1;
#pragma unroll
      for (int j = 0; j < 2; ++j)
#pragma unroll
        for (int sx = 0; sx < 2; ++sx) {
          const bf16x8 pf = pack8(s[j][8 * sx], s[j][8 * sx + 1], s[j][8 * sx + 2], s[j][8 * sx + 3], s[j][8 * sx + 4], s[j][8 * sx + 5], s[j][8 * sx + 6], s[j][8 * sx + 7]);
#pragma unroll
          for (int dt = 0; dt < 2; ++dt) { const bf16_t* vp = Vc + (32 * dt + c) * VLD + 32 * j + 16 * sx + 4 * hh;
            const bf16x8 vf = cat44(*(const s16x4*)vp, *(const s16x4*)(vp + 8)); oacc[dt] = mfma32(vf, pf, oacc[dt]); }
        } };
    __syncthreads();
    gload(0); lstore(0); gload(1); lstore(1); if (nkt > 2) gload(2);
    __syncthreads();
    f32x16 sA[2], sB[2];
    qk(0, sA);
    int b0 = 0, b1 = 1, b2 = 2;
    for (int kt = 0; kt < nkt; kt += 2) {
      __syncthreads();
      if (kt + 2 < nkt) { lstore(b2); if (kt + 3 < nkt) gload(kt + 3); }
      qk(b1, sB);
      smpv(b0, sA);
      __syncthreads();
      if (kt + 3 < nkt) { lstore(b0); if (kt + 4 < nkt) gload(kt + 4); }
      if (kt + 2 < nkt) qk(b2, sA);
      smpv(b1, sB);
      { const int t0 = b0; b0 = b2; b2 = b1; b1 = t0; }
    }
    lsum += __shfl_xor(lsum, 32); const float inv = 1.f / lsum;
    bf16_t* op = o + (tokbase + qbase + w * 32 + c) * 1024 + h * 64 + 4 * hh;
#pragma unroll
    for (int dt = 0; dt < 2; ++dt)
#pragma unroll
      for (int rg = 0; rg < 4; ++rg) st4bf(op + 32 * dt + 8 * rg, (f32x4){oacc[dt][4 * rg] * inv, oacc[dt][4 * rg + 1] * inv, oacc[dt][4 * rg + 2] * inv, oacc[dt][4 * rg + 3] * inv});
  }
}

template <int N> DI void pin_frags(bf16x8 (&f)[N]) {
  if constexpr (N == 8) asm volatile("" : "+v"(f[0]), "+v"(f[1]), "+v"(f[2]), "+v"(f[3]), "+v"(f[4]), "+v"(f[5]), "+v"(f[6]), "+v"(f[7]));
  else if constexpr (N == 4) asm volatile("" : "+v"(f[0]), "+v"(f[1]), "+v"(f[2]), "+v"(f[3]));
  else if constexpr (N == 2) asm volatile("" : "+v"(f[0]), "+v"(f[1]));
}
constexpr int NKC = 72, NVC = 264;
constexpr int NWK = 72, NWV = 584;
constexpr int NA_OFF_VC = 256 * NKC * 2, NA_OFF_RPB = NA_OFF_VC + 64 * NVC * 2, NA_OFF_W = NA_OFF_RPB + 1920, NA_LDS = NA_OFF_W + 576 * NWK * 2;
static_assert(64 * NWV * 2 <= 576 * NWK * 2 && NA_OFF_W % 16 == 0, "NA window");
DI void na_ctx_wave(const bf16_t* __restrict__ Q, bf16_t* __restrict__ o, const bf16_t* Kc, const bf16_t* Vc, int b, int h, int qb, int lane) {
  const int g = lane >> 4, l16 = lane & 15; const size_t tokbase = (size_t)b * PB; const int qpos = qb * 16 + l16;
  const bf16_t* qp = Q + (tokbase + qpos) * 1024 + h * 64 + g * 8;
  const bf16x8 q0 = *(const bf16x8*)qp, q1 = *(const bf16x8*)(qp + 32);
  f32x4 S[16];
#pragma unroll
  for (int kt = 0; kt < 16; ++kt) { const bf16_t* kp = Kc + (16 * kt + l16) * NKC + g * 8;
    f32x4 s = mfma16(*(const bf16x8*)kp, q0, (f32x4){0.f, 0.f, 0.f, 0.f}); s = mfma16(*(const bf16x8*)(kp + 32), q1, s); S[kt] = s * LOG2E; }
  float mx = S[0][0];
#pragma unroll
  for (int kt = 0; kt < 16; ++kt) mx = fmaxf(fmaxf(fmaxf(mx, S[kt][0]), fmaxf(S[kt][1], S[kt][2])), S[kt][3]);
  mx = fmaxf(mx, __shfl_xor(mx, 16)); mx = fmaxf(mx, __shfl_xor(mx, 32));
  float ls = 0.f;
#pragma unroll
  for (int kt = 0; kt < 16; ++kt)
#pragma unroll
    for (int rr = 0; rr < 4; ++rr) { S[kt][rr] = __builtin_amdgcn_exp2f(S[kt][rr] - mx); ls += S[kt][rr]; }
  ls += __shfl_xor(ls, 16); ls += __shfl_xor(ls, 32);
  f32x4 O[4];
#pragma unroll
  for (int dt = 0; dt < 4; ++dt) O[dt] = (f32x4){0.f, 0.f, 0.f, 0.f};
#pragma unroll
  for (int kk = 0; kk < 8; ++kk) {
    const bf16x8 pf = pack8(S[2 * kk][0], S[2 * kk][1], S[2 * kk][2], S[2 * kk][3], S[2 * kk + 1][0], S[2 * kk + 1][1], S[2 * kk + 1][2], S[2 * kk + 1][3]);
#pragma unroll
    for (int dt = 0; dt < 4; ++dt) { const bf16_t* vp = Vc + (dt * 16 + l16) * NVC + 32 * kk + 4 * g; const bf16x8 vf = cat44(*(const s16x4*)vp, *(const s16x4*)(vp + 16)); O[dt] = mfma16(vf, pf, O[dt]); }
  }
  const float inv = 1.f / ls; bf16_t* op = o + (tokbase + qpos) * 1024 + h * 64 + 4 * g;
#pragma unroll
  for (int dt = 0; dt < 4; ++dt) st4bf(op + 16 * dt, O[dt] * inv);
}
DI void na_attn_phase(const Params& p, char* lds) {
  const bf16_t* Q = (const bf16_t*)(p.ws + N_Q); const bf16_t* K = (const bf16_t*)(p.ws + N_K); const bf16_t* vT = (const bf16_t*)(p.ws + N_VT); bf16_t* o = (bf16_t*)(p.ws + OFF_A);
  bf16_t* Kc = (bf16_t*)lds; bf16_t* Vc = (bf16_t*)(lds + NA_OFF_VC); float* rl = (float*)(lds + NA_OFF_RPB); bf16_t* W = (bf16_t*)(lds + NA_OFF_W);
  const int tid = threadIdx.x, lane = tid & 63, w = tid >> 6, g = lane >> 4, l16 = lane & 15;
  for (int item = blockIdx.x; item < 256; item += gridDim.x) {
    const int qtr = item & 3, h = (item >> 2) & 15, b = item >> 6; const size_t tokbase = (size_t)b * PB;
    const bf16_t* kbase = K + (tokbase + LC) * 1024 + h * 64; const bf16_t* vbase = vT + (size_t)(b * 16 + h) * 64 * PB + LC;
    __syncthreads();
#pragma unroll
    for (int i = 0; i < 4; ++i) { const int e = tid + NTHR * i; const int key = e >> 3, kc = e & 7; *(u32x4*)(Kc + key * NKC + kc * 8) = *(const u32x4*)(K + (tokbase + key) * 1024 + h * 64 + kc * 8); }
#pragma unroll
    for (int i = 0; i < 4; ++i) { const int e = tid + NTHR * i; const int d = e >> 5, pc = e & 31; *(u32x4*)(Vc + d * NVC + pc * 8) = *(const u32x4*)(vT + ((size_t)(b * 16 + h) * 64 + d) * PB + pc * 8); }
    for (int e = tid; e < 465; e += NTHR) rl[e] = p.na_rpb[h * 465 + e];
    u32x4 rw[9];
#pragma unroll 1
    for (int j = 0; j < 16; ++j) {
      int ln = lane, tt = tid; asm volatile("" : "+v"(ln), "+v"(tt)); const int gg = ln >> 4, ll = ln & 15;
      const int r0 = qtr * 32 + 2 * j, rs0 = clampi(r0 - 4, 0, 120), r = r0 + (w >> 2), n = w & 3, rs = clampi(r - 4, 0, 120), dr = rs - rs0, band0 = clampi(16 * n - 8, 0, 32);
      const int qpos = LC + r * 64 + n * 16 + ll;
#pragma unroll
      for (int i = 0; i < 9; ++i) { const int e = tt + NTHR * i; rw[i] = *(const u32x4*)(kbase + (size_t)(rs0 * 64 + (e >> 3)) * 1024 + (e & 7) * 8); }
      __syncthreads();
#pragma unroll
      for (int i = 0; i < 9; ++i) { const int e = tt + NTHR * i; *(u32x4*)(W + (e >> 3) * NWK + (e & 7) * 8) = rw[i]; }
      __syncthreads();
      const bf16_t* qp = Q + (tokbase + qpos) * 1024 + h * 64 + gg * 8;
      const bf16x8 q0 = *(const bf16x8*)qp, q1 = *(const bf16x8*)(qp + 32);
      f32x4 S[32];
#pragma unroll
      for (int kg = 0; kg < 8; ++kg) {
        bf16x8 ka[4], kb[4];
#pragma unroll
        for (int u = 0; u < 4; ++u) { const int kt = 4 * kg + u;
          const bf16_t* kp = kt < 16 ? W + ((dr + (kt >> 1)) * 64 + band0 + 16 * (kt & 1) + ll) * NWK + gg * 8 : Kc + (16 * (kt - 16) + ll) * NKC + gg * 8;
          ka[u] = *(const bf16x8*)kp; kb[u] = *(const bf16x8*)(kp + 32); }
        pin_frags(ka); pin_frags(kb);
#pragma unroll
        for (int u = 0; u < 4; ++u) { const int kt = 4 * kg + u;
          f32x4 s = mfma16(ka[u], q0, (f32x4){0.f, 0.f, 0.f, 0.f}); s = mfma16(kb[u], q1, s);
          if (kt < 16) {
            const int qcol = 16 * n + ll, wstart = clampi(qcol - 8, 0, 48); const float* bp = rl + (rs + (kt >> 1) - r + 7) * 31;
#pragma unroll
            for (int rr = 0; rr < 4; ++rr) { const int kcol = band0 + 16 * (kt & 1) + 4 * gg + rr; const bool ok = kcol >= wstart && kcol < wstart + 16;
              s[rr] = ok ? (s[rr] + bp[clampi(kcol - qcol + 15, 0, 30)]) * LOG2E : -1e30f; }
          } else s = s * LOG2E;
          S[kt] = s; }
      }
      float mx = S[0][0];
#pragma unroll
      for (int kt = 0; kt < 32; ++kt) mx = fmaxf(fmaxf(fmaxf(mx, S[kt][0]), fmaxf(S[kt][1], S[kt][2])), S[kt][3]);
      mx = fmaxf(mx, __shfl_xor(mx, 16)); mx = fmaxf(mx, __shfl_xor(mx, 32));
      float ls = 0.f;
#pragma unroll
      for (int kt = 0; kt < 32; ++kt)
#pragma unroll
        for (int rr = 0; rr < 4; ++rr) { S[kt][rr] = __builtin_amdgcn_exp2f(S[kt][rr] - mx); ls += S[kt][rr]; }
      ls += __shfl_xor(ls, 16); ls += __shfl_xor(ls, 32);
      bf16x8 pf[16];
#pragma unroll
      for (int kk = 0; kk < 16; ++kk) pf[kk] = pack8(S[2 * kk][0], S[2 * kk][1], S[2 * kk][2], S[2 * kk][3], S[2 * kk + 1][0], S[2 * kk + 1][1], S[2 * kk + 1][2], S[2 * kk + 1][3]);
#pragma unroll
      for (int i = 0; i < 9; ++i) { const int e = tt + NTHR * i, d = e / 72, pc = e - d * 72; rw[i] = *(const u32x4*)(vbase + (size_t)d * PB + rs0 * 64 + pc * 8); }
      __syncthreads();
#pragma unroll
      for (int i = 0; i < 9; ++i) { const int e = tt + NTHR * i, d = e / 72, pc = e - d * 72; *(u32x4*)(W + d * NWV + pc * 8) = rw[i]; }
      __syncthreads();
      f32x4 O[4];
#pragma unroll
      for (int dt = 0; dt < 4; ++dt) O[dt] = (f32x4){0.f, 0.f, 0.f, 0.f};
#pragma unroll
      for (int kk = 0; kk < 16; ++kk) {
        bf16x8 vf[4];
#pragma unroll
        for (int dt = 0; dt < 4; ++dt) { const bf16_t* vp = kk < 8 ? W + (dt * 16 + ll) * NWV + (dr + kk) * 64 + band0 + 4 * gg : Vc + (dt * 16 + ll) * NVC + 32 * (kk - 8) + 4 * gg;
          vf[dt] = cat44(*(const s16x4*)vp, *(const s16x4*)(vp + 16)); }
        pin_frags(vf);
#pragma unroll
        for (int dt = 0; dt < 4; ++dt) O[dt] = mfma16(vf[dt], pf[kk], O[dt]);
      }
      const float inv = 1.f / ls; bf16_t* op = o + (tokbase + qpos) * 1024 + h * 64 + 4 * gg;
#pragma unroll
      for (int dt = 0; dt < 4; ++dt) st4bf(op + 16 * dt, O[dt] * inv);
    }
    if (w < 4) na_ctx_wave(Q, o, Kc, Vc, b, h, qtr * 4 + w, lane);
  }
}

template <int DK> struct ScanLds { static constexpr int QLD = DK + 8, TLD = 72;
  static constexpr int OFF_QD = 0, OFF_KD = OFF_QD + 64 * QLD * 2, OFF_VT = OFF_KD + 64 * QLD * 2, OFF_ATT = OFF_VT + 64 * TLD * 2, OFF_ST = OFF_ATT + 64 * TLD * 2, OFF_EB = OFF_ST + 64 * QLD * 2, OFF_QS = OFF_EB + DK * 4, TOTAL = OFF_QS + 8 * DK * 4; };
DI int scan_pos(int dir, int i, int tl) { if (dir == 0) return i * 64 + tl; return i < 4 ? 255 - (i * 64 + tl) : 8447 - ((i - 4) * 64 + tl); }
DI bf16x8 gather8(const bf16_t* p, int stride) {
  const unsigned a0 = p[0], a1 = p[stride], a2 = p[2 * stride], a3 = p[3 * stride], a4 = p[4 * stride], a5 = p[5 * stride], a6 = p[6 * stride], a7 = p[7 * stride];
  u32x4 r; r.x = a0 | (a1 << 16); r.y = a2 | (a3 << 16); r.z = a4 | (a5 << 16); r.w = a6 | (a7 << 16); return __builtin_bit_cast(bf16x8, r);
}

template <int DK, bool HG, int DVS>
DI void scan_phase(const Params& p, char* lds) {
  typedef ScanLds<DK> L;
  bf16_t* Qd = (bf16_t*)(lds + L::OFF_QD); bf16_t* Kd = (bf16_t*)(lds + L::OFF_KD); bf16_t* Vt = (bf16_t*)(lds + L::OFF_VT);
  bf16_t* Att = (bf16_t*)(lds + L::OFF_ATT); bf16_t* St = (bf16_t*)(lds + L::OFF_ST); float* eb = (float*)(lds + L::OFF_EB); float* qs = (float*)(lds + L::OFF_QS);
  constexpr int QLD = L::QLD, TLD = L::TLD, KT = DK / 16 / 8;
  const int tid = tid_(), lane = tid & 63, w = tid >> 6, g4 = lane >> 4, l16 = lane & 15;
  const int nitems = 256; constexpr int NVI = DVS / 16, NTO = NVI * 4 / 8;
  const float* lbv = (const float*)(p.ws + OFF_LBV);
  for (int item = blockIdx.x; item < nitems; item += gridDim.x) {
    const int xcd = item & 7, yy = item >> 3; int b, h, sl, dir;
    if (HG) { const int grp = xcd * 8 + (yy >> 2); sl = yy & 3; h = grp & 7; b = (grp >> 3) & 3; dir = grp >> 5; }
    else { const int grp = xcd * 4 + (yy >> 3); sl = yy & 7; h = grp & 3; b = (grp >> 2) & 3; dir = grp >> 4; }
    const size_t tokbase = (size_t)b * PB;
    const bf16_t *qsrc, *ksrc, *vsrc; int ldq, ldv; bf16_t *octx, *olat; int ldo;
    if (HG) { const bf16_t* ph = (const bf16_t*)(p.ws + H_P); qsrc = ph + h * 128; ksrc = ph + 1024 + dir * 1024 + h * 128; vsrc = ph + 3072 + h * 128 + sl * DVS; ldq = 5120; ldv = 5120; ldo = 1024;
      octx = (bf16_t*)(p.ws + (dir ? OFF_W0 : OFF_A)) + tokbase * 1024 + h * 128 + sl * DVS; olat = octx + (size_t)LC * 1024; }
    else { const bf16_t* qk = (const bf16_t*)(p.ws + R_QK); qsrc = qk + h * 256; ksrc = qk + 1024 + h * 256; vsrc = (const bf16_t*)(p.ws + R_V) + h * 512 + sl * 64; ldq = 2048; ldv = 2048; ldo = 2048;
      if (dir == 0) { octx = (bf16_t*)(p.ws + R_O) + tokbase * 2048 + h * 512 + sl * 64; olat = octx + (size_t)LC * 2048; }
      else { octx = (bf16_t*)(p.ws + OFF_HCTX) + (size_t)b * LC * 2048 + h * 512 + sl * 64; olat = (bf16_t*)p.out + (size_t)b * LL * 2048 + h * 512 + sl * 64; } }
    float lg = 0.f; if (!HG) lg = -__expf(p.ret_decay[dir * 4 + h]);
    float lb0 = 0.f, lb1 = 0.f; if (HG) { lb0 = lbv[h * 128 + 2 * (tid & 63)]; lb1 = lbv[h * 128 + 2 * (tid & 63) + 1]; }
    f32x4 sacc[KT][NVI];
#pragma unroll
    for (int a = 0; a < KT; ++a)
#pragma unroll
      for (int v = 0; v < NVI; ++v) sacc[a][v] = (f32x4){0.f, 0.f, 0.f, 0.f};
    u32x4 rq[4], rk[4], rvv; unsigned rf[8], rqq[8]; float bl[16], qv[16], kv[16];
    const int vtl = tid & 63, vvc = tid >> 6;
    auto issue = [&](int i) {
      if (HG) { const int kp = tid & 63, seg = tid >> 6;
#pragma unroll
        for (int j = 0; j < 8; ++j) { const size_t row = tokbase + scan_pos(dir, i, seg * 8 + j); rf[j] = *(const unsigned*)(ksrc + row * ldq + 2 * kp); rqq[j] = *(const unsigned*)(qsrc + row * ldq + 2 * kp); } }
      else {
#pragma unroll
        for (int it = 0; it < 4; ++it) { const int e = tid + NTHR * it, tl = e >> 5, kc = e & 31; const size_t row = tokbase + scan_pos(dir, i, tl); rq[it] = *(const u32x4*)(qsrc + row * ldq + kc * 8); rk[it] = *(const u32x4*)(ksrc + row * ldq + kc * 8); } }
      if (vvc < DVS / 8) { const size_t row = tokbase + scan_pos(dir, i, vtl); rvv = *(const u32x4*)(vsrc + row * ldv + vvc * 8); }
    };
    auto prep = [&]() {
      const int kp = tid & 63, seg = tid >> 6; float run0 = 1.f, run1 = 1.f;
#pragma unroll
      for (int j = 0; j < 8; ++j) { const float f0 = bflo(rf[j]), f1 = bfhi(rf[j]); qv[2 * j] = bflo(rqq[j]); qv[2 * j + 1] = bfhi(rqq[j]);
        const float s0 = __builtin_amdgcn_rcpf(1.f + __expf(-f0)), s1 = __builtin_amdgcn_rcpf(1.f + __expf(-f1)); const float g0 = lb0 + (1.f - lb0) * s0, g1 = lb1 + (1.f - lb1) * s1;
        kv[2 * j] = 1.f - g0; kv[2 * j + 1] = 1.f - g1; run0 *= g0; run1 *= g1; bl[2 * j] = run0; bl[2 * j + 1] = run1; }
      qs[seg * DK + 2 * kp] = run0; qs[seg * DK + 2 * kp + 1] = run1;
    };
    __syncthreads();
    issue(0); if (HG) prep();
    __syncthreads();
    for (int i = 0; i < 132; ++i) {
      if (HG) { const int kp = tid & 63, seg = tid >> 6; float off0 = 1.f, off1 = 1.f;
#pragma unroll
        for (int q = 0; q < 7; ++q) if (q < seg) { off0 *= qs[q * DK + 2 * kp]; off1 *= qs[q * DK + 2 * kp + 1]; }
        if (seg == 7) { eb[2 * kp] = off0 * bl[14]; eb[2 * kp + 1] = off1 * bl[15]; }
#pragma unroll
        for (int j = 0; j < 8; ++j) { const int tl = seg * 8 + j; const float p0 = bl[2 * j] * off0, p1 = bl[2 * j + 1] * off1;
          *(unsigned*)(Qd + tl * QLD + 2 * kp) = pk2(qv[2 * j] * p0, qv[2 * j + 1] * p1);
          *(unsigned*)(Kd + tl * QLD + 2 * kp) = pk2(kv[2 * j] * __builtin_amdgcn_rcpf(p0), kv[2 * j + 1] * __builtin_amdgcn_rcpf(p1)); } }
      else {
        if (tid < DK) eb[tid] = __expf(64.f * lg);
#pragma unroll
        for (int it = 0; it < 4; ++it) { const int e = tid + NTHR * it, tl = e >> 5, kc = e & 31; const u32x4 qr = rq[it], kr = rk[it];
          const float eq = __expf((float)(tl + 1) * lg), ek = __expf(-(float)(tl + 1) * lg);
          u32x4 qo, ko; qo.x = pk2(bflo(qr.x) * eq, bfhi(qr.x) * eq); qo.y = pk2(bflo(qr.y) * eq, bfhi(qr.y) * eq); qo.z = pk2(bflo(qr.z) * eq, bfhi(qr.z) * eq); qo.w = pk2(bflo(qr.w) * eq, bfhi(qr.w) * eq);
          ko.x = pk2(bflo(kr.x) * ek, bfhi(kr.x) * ek); ko.y = pk2(bflo(kr.y) * ek, bfhi(kr.y) * ek); ko.z = pk2(bflo(kr.z) * ek, bfhi(kr.z) * ek); ko.w = pk2(bflo(kr.w) * ek, bfhi(kr.w) * ek);
          *(u32x4*)(Qd + tl * QLD + kc * 8) = qo; *(u32x4*)(Kd + tl * QLD + kc * 8) = ko; } }
      if (vvc < DVS / 8) { bf16_t* vt = Vt + (vvc * 8) * TLD + vtl; const u32x4 vr = rvv;
        vt[0] = (bf16_t)(vr.x & 0xffff); vt[TLD] = (bf16_t)(vr.x >> 16); vt[2 * TLD] = (bf16_t)(vr.y & 0xffff); vt[3 * TLD] = (bf16_t)(vr.y >> 16);
        vt[4 * TLD] = (bf16_t)(vr.z & 0xffff); vt[5 * TLD] = (bf16_t)(vr.z >> 16); vt[6 * TLD] = (bf16_t)(vr.w & 0xffff); vt[7 * TLD] = (bf16_t)(vr.w >> 16); }
#pragma unroll
      for (int a = 0; a < KT; ++a) { const int ki = w * KT + a;
#pragma unroll
        for (int vi = 0; vi < NVI; ++vi) st4bf(St + (16 * vi + l16) * QLD + 16 * ki + 4 * g4, sacc[a][vi]); }
      __syncthreads();
      if (i + 1 < 132) issue(i + 1);
      { const int ti = w >> 1;
        bf16x8 qf[DK / 32];
#pragma unroll
        for (int ks = 0; ks < DK / 32; ++ks) qf[ks] = *(const bf16x8*)(Qd + (16 * ti + l16) * QLD + ks * 32 + g4 * 8);
#pragma unroll
        for (int u = 0; u < 2; ++u) { const int si = (2 * w + u) & 3; f32x4 d = (f32x4){0.f, 0.f, 0.f, 0.f};
          if (si <= ti) { bf16x8 kf[DK / 32];
#pragma unroll
            for (int ks = 0; ks < DK / 32; ++ks) kf[ks] = *(const bf16x8*)(Kd + (16 * si + l16) * QLD + ks * 32 + g4 * 8);
            pin_frags(kf);
#pragma unroll
            for (int ks = 0; ks < DK / 32; ++ks) d = mfma16(kf[ks], qf[ks], d); }
          const int t = 16 * ti + l16, s0 = 16 * si + 4 * g4;
#pragma unroll
          for (int rr = 0; rr < 4; ++rr) if (s0 + rr > t) d[rr] = 0.f;
          st4bf(Att + t * TLD + s0, d); } }
      __syncthreads();
      { const int vi = (NTO * w) >> 2;
        bf16x8 xv[2], xs[DK / 32];
#pragma unroll
        for (int ks = 0; ks < 2; ++ks) xv[ks] = *(const bf16x8*)(Vt + (16 * vi + l16) * TLD + ks * 32 + g4 * 8);
#pragma unroll
        for (int ks = 0; ks < DK / 32; ++ks) xs[ks] = *(const bf16x8*)(St + (16 * vi + l16) * QLD + ks * 32 + g4 * 8);
        pin_frags(xv); pin_frags(xs);
#pragma unroll
        for (int u = 0; u < NTO; ++u) { const int ti = (NTO * w + u) & 3; bf16x8 ya[2], yq[DK / 32];
#pragma unroll
          for (int ks = 0; ks < 2; ++ks) ya[ks] = *(const bf16x8*)(Att + (16 * ti + l16) * TLD + ks * 32 + g4 * 8);
#pragma unroll
          for (int ks = 0; ks < DK / 32; ++ks) yq[ks] = *(const bf16x8*)(Qd + (16 * ti + l16) * QLD + ks * 32 + g4 * 8);
          pin_frags(ya); pin_frags(yq);
          f32x4 d = (f32x4){0.f, 0.f, 0.f, 0.f};
#pragma unroll
          for (int ks = 0; ks < 2; ++ks) d = mfma16(xv[ks], ya[ks], d);
#pragma unroll
          for (int ks = 0; ks < DK / 32; ++ks) d = mfma16(xs[ks], yq[ks], d);
          const int pos = scan_pos(dir, i, 16 * ti + l16); bf16_t* op = (pos < LC ? octx + (size_t)pos * ldo : olat + (size_t)(pos - LC) * ldo) + 16 * vi + 4 * g4;
          st4bf(op, d); } }
      { bf16x8 yv[NVI][2];
#pragma unroll
        for (int vi = 0; vi < NVI; ++vi)
#pragma unroll
          for (int ks = 0; ks < 2; ++ks) yv[vi][ks] = *(const bf16x8*)(Vt + (16 * vi + l16) * TLD + ks * 32 + g4 * 8);
#pragma unroll
        for (int a = 0; a < KT; ++a) { const int ki = w * KT + a; bf16x8 xf[2];
#pragma unroll
          for (int ks = 0; ks < 2; ++ks) xf[ks] = gather8(Kd + (ks * 32 + g4 * 8) * QLD + 16 * ki + l16, QLD);
#pragma unroll
          for (int ks = 0; ks < 2; ++ks)
#pragma unroll
            for (int vi = 0; vi < NVI; ++vi) sacc[a][vi] = mfma16(xf[ks], yv[vi][ks], sacc[a][vi]);
          const f32x4 e4 = *(const f32x4*)(eb + 16 * ki + 4 * g4);
#pragma unroll
          for (int vi = 0; vi < NVI; ++vi) sacc[a][vi] = sacc[a][vi] * e4; } }
      if (HG && i + 1 < 132) prep();
      __syncthreads();
    }
  }
}

DI float bsum2(unsigned a, unsigned b, float& lo, float& hi) { lo = bflo(a) + bflo(b); hi = bfhi(a) + bfhi(b); return lo * lo + hi * hi; }
DI void ret_readout_phase(const Params& p) {
  bf16_t* O = (bf16_t*)(p.ws + R_O); const bf16_t* G = (const bf16_t*)(p.ws + R_QK);
  const int tid = threadIdx.x, lane = tid & 63, gw = blockIdx.x * 8 + (tid >> 6), nw = gridDim.x * 8;
  for (int t = gw; t < T_ALL; t += nw) {
    const int b = t / PB, pp = t - b * PB;
    const bf16_t* ob = (pp < LC ? (const bf16_t*)(p.ws + OFF_HCTX) + (size_t)(b * LC + pp) * 2048 : (const bf16_t*)p.out + (size_t)(b * LL + pp - LC) * 2048) + lane * 32;
    bf16_t* op = O + (size_t)t * 2048 + lane * 32; const bf16_t* gp = G + (size_t)t * 2048 + lane * 32;
    float ov[32]; u32x4 gv[4]; float sq = 0.f;
#pragma unroll
    for (int i = 0; i < 4; ++i) { const u32x4 x = *(const u32x4*)(op + i * 8), y = *(const u32x4*)(ob + i * 8); gv[i] = *(const u32x4*)(gp + i * 8);
      sq += bsum2(x.x, y.x, ov[8 * i], ov[8 * i + 1]) + bsum2(x.y, y.y, ov[8 * i + 2], ov[8 * i + 3]) + bsum2(x.z, y.z, ov[8 * i + 4], ov[8 * i + 5]) + bsum2(x.w, y.w, ov[8 * i + 6], ov[8 * i + 7]); }
    sq += __shfl_xor(sq, 1); sq += __shfl_xor(sq, 2); sq += __shfl_xor(sq, 4); sq += __shfl_xor(sq, 8);
    const float rstd = rsqrtf(sq * (1.f / 512.f) + 1e-6f);
#pragma unroll
    for (int i = 0; i < 4; ++i) { u32x4 r;
      r.x = pk2(siluf(bflo(gv[i].x)) * ov[8 * i] * rstd, siluf(bfhi(gv[i].x)) * ov[8 * i + 1] * rstd); r.y = pk2(siluf(bflo(gv[i].y)) * ov[8 * i + 2] * rstd, siluf(bfhi(gv[i].y)) * ov[8 * i + 3] * rstd);
      r.z = pk2(siluf(bflo(gv[i].z)) * ov[8 * i + 4] * rstd, siluf(bfhi(gv[i].z)) * ov[8 * i + 5] * rstd); r.w = pk2(siluf(bflo(gv[i].w)) * ov[8 * i + 6] * rstd, siluf(bfhi(gv[i].w)) * ov[8 * i + 7] * rstd);
      *(u32x4*)(op + i * 8) = r; }
  }
}
DI void hg_readout_phase(const Params& p) {
  bf16_t* O = (bf16_t*)(p.ws + OFF_A); const bf16_t* OB = (const bf16_t*)(p.ws + OFF_W0); const bf16_t* ph = (const bf16_t*)(p.ws + H_P);
  const int tid = threadIdx.x, lane = tid & 63, gw = blockIdx.x * 8 + (tid >> 6), nw = gridDim.x * 8;
  for (int t = gw; t < T_ALL; t += nw) {
    bf16_t* op = O + (size_t)t * 1024 + lane * 16; const bf16_t* ob = OB + (size_t)t * 1024 + lane * 16; const bf16_t* gp = ph + (size_t)t * 5120 + 4096 + lane * 16; const float* ng = p.hg_norm_g + (lane & 7) * 16;
    float ov[16]; u32x4 gv[2]; float sq = 0.f;
#pragma unroll
    for (int i = 0; i < 2; ++i) { const u32x4 x = *(const u32x4*)(op + i * 8), y = *(const u32x4*)(ob + i * 8); gv[i] = *(const u32x4*)(gp + i * 8);
      sq += bsum2(x.x, y.x, ov[8 * i], ov[8 * i + 1]) + bsum2(x.y, y.y, ov[8 * i + 2], ov[8 * i + 3]) + bsum2(x.z, y.z, ov[8 * i + 4], ov[8 * i + 5]) + bsum2(x.w, y.w, ov[8 * i + 6], ov[8 * i + 7]); }
    sq += __shfl_xor(sq, 1); sq += __shfl_xor(sq, 2); sq += __shfl_xor(sq, 4);
    const float rstd = rsqrtf(sq * (1.f / 128.f) + 1e-6f);
#pragma unroll
    for (int i = 0; i < 2; ++i) { u32x4 r; const float* n8 = ng + i * 8;
      r.x = pk2(siluf(bflo(gv[i].x)) * ov[8 * i] * rstd * n8[0], siluf(bfhi(gv[i].x)) * ov[8 * i + 1] * rstd * n8[1]); r.y = pk2(siluf(bflo(gv[i].y)) * ov[8 * i + 2] * rstd * n8[2], siluf(bfhi(gv[i].y)) * ov[8 * i + 3] * rstd * n8[3]);
      r.z = pk2(siluf(bflo(gv[i].z)) * ov[8 * i + 4] * rstd * n8[4], siluf(bfhi(gv[i].z)) * ov[8 * i + 5] * rstd * n8[5]); r.w = pk2(siluf(bflo(gv[i].w)) * ov[8 * i + 6] * rstd * n8[6], siluf(bfhi(gv[i].w)) * ov[8 * i + 7] * rstd * n8[7]);
      *(u32x4*)(op + i * 8) = r; }
  }
}

#define XB_TMO      128
#define XB_XCNT(j)  (256  + 64 * (j))
#define XB_XSUB(j)  (1280 + 64 * (j))
#define XB_XGEN(j)  (2304 + 64 * (j))
#define XB_TOP      3328
#define XB_TOPGEN   3392
#define XCD_BAR_WORDS 3456
#define XB_SPIN_CAP (1u << 23)
#define LAS PG8_LAS

__device__ __forceinline__ unsigned xb_ld(unsigned* p)              { return __hip_atomic_load(p, __ATOMIC_RELAXED, __HIP_MEMORY_SCOPE_AGENT); }
__device__ __forceinline__ unsigned xb_add(unsigned* p, unsigned v) { return __hip_atomic_fetch_add(p, v, __ATOMIC_RELAXED, __HIP_MEMORY_SCOPE_AGENT); }
__device__ __forceinline__ unsigned xb_xcc_id() { return (unsigned)__builtin_amdgcn_s_getreg((3 << 11) | 20) & 0xFu; }
#define XB_SPIN(cond, bar) do { unsigned _sp = 0; while (cond) { __builtin_amdgcn_s_sleep(1); \
    if ((++_sp & 255u) == 0u) { if (xb_ld(&(bar)[XB_TMO])) break; if (_sp > XB_SPIN_CAP) { atomicAdd(&(bar)[XB_TMO], 1u); break; } } } } while (0)

struct XcdBarrier {
    unsigned* bar; unsigned x;
    volatile LAS unsigned* st;
};

__device__ __forceinline__ XcdBarrier xcd_barrier_post(unsigned* bar, volatile LAS unsigned* st) {
    XcdBarrier b; b.bar = bar; b.x = xb_xcc_id(); b.st = st;
    if (threadIdx.x == 0) (void)xb_add(&bar[XB_XCNT(b.x)], 1u);
    return b;
}
__device__ __forceinline__ void xcd_barrier_complete(unsigned* bar, unsigned x, unsigned& nloc, unsigned& nx) {
    const unsigned G = gridDim.x * gridDim.y * gridDim.z;
    unsigned sum, cnt, mine, sp = 0u;
    for (;;) {
        sum = 0u; cnt = 0u; mine = 0u;
#pragma unroll
        for (unsigned j = 0; j < 16; ++j) { const unsigned c = xb_ld(&bar[XB_XCNT(j)]); sum += c; cnt += (c > 0u) ? 1u : 0u; mine = (j == x) ? c : mine; }
        if (sum == G) break;
        __builtin_amdgcn_s_sleep(1);
        if ((++sp & 255u) == 0u) { if (xb_ld(&bar[XB_TMO])) break; if (sp > XB_SPIN_CAP) { atomicAdd(&bar[XB_TMO], 1u); break; } }
    }
    nloc = mine > 0u ? mine : 1u; nx = cnt > 0u ? cnt : 1u;
}

__device__ __forceinline__ void xcd_barrier(const XcdBarrier& b) {
    asm volatile("s_waitcnt vmcnt(0)" ::: "memory");
    __syncthreads();
    if (threadIdx.x == 0) {
        unsigned* bar = b.bar;
        __builtin_amdgcn_s_waitcnt(0);
        unsigned nloc = b.st[0], nx = b.st[1];
        if (nloc == 0u) { xcd_barrier_complete(bar, b.x, nloc, nx); b.st[0] = nloc; b.st[1] = nx; }
        const unsigned old = xb_add(&bar[XB_XSUB(b.x)], 1u);
        const unsigned gen = old / nloc;
        if (old + 1u == (gen + 1u) * nloc) {
            __builtin_amdgcn_fence(__ATOMIC_RELEASE, "agent");
            asm volatile("s_waitcnt vmcnt(0)" ::: "memory");
            const unsigned og = xb_add(&bar[XB_TOP], 1u);
            const unsigned tg = og / nx;
            if (og + 1u == (tg + 1u) * nx) xb_add(&bar[XB_TOPGEN], 1u);
            else XB_SPIN(xb_ld(&bar[XB_TOPGEN]) == tg, bar);
            __builtin_amdgcn_fence(__ATOMIC_ACQUIRE, "agent");
            xb_add(&bar[XB_XGEN(b.x)], 1u);
            asm volatile("s_waitcnt vmcnt(0)" ::: "memory");
        } else {
            XB_SPIN(xb_ld(&bar[XB_XGEN(b.x)]) == gen, bar);
            __builtin_amdgcn_fence(__ATOMIC_ACQUIRE, "agent");
            asm volatile("s_waitcnt vmcnt(0)" ::: "memory");
        }
    }
    __syncthreads();
}

constexpr int LDS_BYTES0 = ScanLds<256>::TOTAL > pg8::STAGE_BYTES ? ScanLds<256>::TOTAL : pg8::STAGE_BYTES;
constexpr int LDS_BYTES = LDS_BYTES0 > NA_LDS ? LDS_BYTES0 : NA_LDS;
static_assert(LDS_BYTES <= 163840, "LDS");
static_assert(LDS_BYTES >= (256 + 128) * LDT * 2 && LDS_BYTES >= 3 * 64 * (KLD + VLD) * 2 && LDS_BYTES >= (5120 + 8 * 5 * 64) * 4, "LDS phases");

DI void ffn_and_ln(const Params& p, const XcdBarrier& xb, char* lds, int layer, const bf16_t* w13, const bf16_t* w2) {
  const float* mods = (const float*)(p.ws + OFF_MODS); float* hctx = (float*)(p.ws + OFF_HCTX); bf16_t* a = (bf16_t*)(p.ws + OFF_A); bf16_t* U = (bf16_t*)(p.ws + F_U);
  { EpiSwiglu e{U}; big_gemm(a, w13, T_ALL, 5632, 1024, e, lds, layer == 3); }
  xcd_barrier(xb);
  { EpiResid e{p.out, hctx, p.out, hctx, mods + (size_t)layer * 5 * 6144 + 5 * 1024, (const float2*)(p.ws + OFF_LNS), p.ln_g + (size_t)(layer * 2) * 1024, p.ln_b + (size_t)(layer * 2) * 1024}; big_gemm(U, w2, T_ALL, 1024, FF, e, lds, 1); if (layer < 3) ctx_gemm(U, w2, FF, e, lds); }
  xcd_barrier(xb);
  ln_phase(p, layer, 1, layer < 3 ? layer + 1 : 3, 0, layer == 3);
  xcd_barrier(xb);
}

__global__ void __launch_bounds__(NTHR) mega(Params p) {
  __shared__ __attribute__((aligned(16))) char lds[LDS_BYTES];
  cg::grid_group grid = cg::this_grid();
  __shared__ uint4 xb_words;
  if (threadIdx.x == 0) xb_words = make_uint4(0u, 0u, 0u, 0u);
  __syncthreads();
  const XcdBarrier xb = xcd_barrier_post((unsigned*)(p.ws + OFF_BAR), (volatile LAS unsigned*)&xb_words);
  float* ldsf = (float*)lds;
  const float* mods = (const float*)(p.ws + OFF_MODS); float* hctx = (float*)(p.ws + OFF_HCTX); bf16_t* a = (bf16_t*)(p.ws + OFF_A);
  const float2* tabR = (const float2*)(p.ws + OFF_TABR); const float2* tabM = (const float2*)(p.ws + OFF_TABM); float* rs = (float*)(p.ws + OFF_RS);
  ada_phase(p, ldsf);
  tables_phase(p);
  convert_w<2>(p.ret_w_in, 6144, 1024, (bf16_t*)(p.ws + W0_RETIN), 6144, nullptr, ldsf);
  convert_w<0>(p.ret_w_out, 1024, 2048, (bf16_t*)(p.ws + W0_RETOUT), 1024, nullptr, ldsf);
  convert_w<1>(p.w13, 5632, 1024, (bf16_t*)(p.ws + W0_W13), 5632, nullptr, ldsf);
  convert_w<0>(p.w2, 1024, FF, (bf16_t*)(p.ws + W0_W2), 1024, nullptr, ldsf);
  grid.sync();
  modulate_phase(p, p.x, p.ctx, 0);
  xcd_barrier(xb);
  { const bf16_t* wi = (const bf16_t*)(p.ws + W0_RETIN);
    { EpiRetQK e{(bf16_t*)(p.ws + R_QK), tabR}; big_gemm(a, wi, T_ALL, 2048, 1024, e, lds); }
    { EpiStore e{(bf16_t*)(p.ws + R_V), (bf16_t*)(p.ws + R_V), 1 << 30, 2048, 2048, 1.f}; big_gemm(a, wi + (size_t)2048 * 1024, T_ALL, 2048, 1024, e, lds); }
    xcd_barrier(xb);
    scan_phase<256, false, 64>(p, lds);
    xcd_barrier(xb);
    { EpiStore e{(bf16_t*)(p.ws + R_QK), (bf16_t*)(p.ws + R_QK), 1 << 30, 2048, 2048, 1.f}; big_gemm(a, wi + (size_t)4096 * 1024, T_ALL, 2048, 1024, e, lds); }
    xcd_barrier(xb);
    ret_readout_phase(p);
    xcd_barrier(xb);
    { EpiResid e{p.x, p.ctx, p.out, hctx, mods + 2 * 1024, nullptr, nullptr, nullptr}; big_gemm((const bf16_t*)(p.ws + R_O), (const bf16_t*)(p.ws + W0_RETOUT), T_ALL, 1024, 2048, e, lds, 1); ctx_gemm((const bf16_t*)(p.ws + R_O), (const bf16_t*)(p.ws + W0_RETOUT), 2048, e, lds); }
    xcd_barrier(xb);
    ln_phase(p, 0, 0, 0, 3, false);
    convert_w<0>(p.na_w_qkv, 3072, 1024, (bf16_t*)(p.ws + W1_QKV), 3072, nullptr, ldsf);
    convert_w<0>(p.na_w_out, 1024, 1024, (bf16_t*)(p.ws + W1_OUT), 1024, nullptr, ldsf);
    convert_w<1>(p.w13 + (size_t)1 * 1024 * 5632, 5632, 1024, (bf16_t*)(p.ws + W1_W13), 5632, nullptr, ldsf);
    convert_w<0>(p.w2 + (size_t)1 * FF * 1024, 1024, FF, (bf16_t*)(p.ws + W1_W2), 1024, nullptr, ldsf);
    convert_w<5>(p.mla_w_down, 800, 1024, (bf16_t*)(p.ws + W2_DOWN), 1024, nullptr, ldsf);
    convert_w<3>(p.mla_w_uq, 1536, 512, (bf16_t*)(p.ws + W2_UQ), 1536, p.mla_q_norm, ldsf);
    convert_w<4>(p.mla_w_ukv, 2048, 256, (bf16_t*)(p.ws + W2_UKV), 2048, p.mla_kv_norm, ldsf);
    convert_w<0>(p.mla_w_out, 1024, 1024, (bf16_t*)(p.ws + W2_OUT), 1024, nullptr, ldsf);
    convert_w<1>(p.w13 + (size_t)2 * 1024 * 5632, 5632, 1024, (bf16_t*)(p.ws + W2_W13), 5632, nullptr, ldsf);
    convert_w<0>(p.w2 + (size_t)2 * FF * 1024, 1024, FF, (bf16_t*)(p.ws + W2_W2), 1024, nullptr, ldsf);
    convert_w<0>(p.hg_w_in, 5120, 1024, (bf16_t*)(p.ws + W3_IN), 5120, nullptr, ldsf);
    convert_w<0>(p.hg_w_out, 1024, 1024, (bf16_t*)(p.ws + W3_OUT), 1024, nullptr, ldsf);
    convert_w<1>(p.w13 + (size_t)3 * 1024 * 5632, 5632, 1024, (bf16_t*)(p.ws + W3_W13), 5632, nullptr, ldsf);
    convert_w<0>(p.w2 + (size_t)3 * FF * 1024, 1024, FF, (bf16_t*)(p.ws + W3_W2), 1024, nullptr, ldsf);
    xcd_barrier(xb);
    ffn_and_ln(p, xb, lds, 0, (const bf16_t*)(p.ws + W0_W13), (const bf16_t*)(p.ws + W0_W2));
  }
  { const bf16_t* wq = (const bf16_t*)(p.ws + W1_QKV);
    { EpiStore e{(bf16_t*)(p.ws + N_Q), (bf16_t*)(p.ws + N_K), 1024, 1024, 1024, 0.125f}; big_gemm(a, wq, T_ALL, 2048, 1024, e, lds); }
    { GemmArgs g{a, 1024, wq + (size_t)2048 * 1024, 1024, T_ALL, 1024, 1024}; EpiVT e{(bf16_t*)(p.ws + N_VT), nullptr}; gemm_phase<true>(g, e, lds); }
    xcd_barrier(xb);
    na_attn_phase(p, lds);
    xcd_barrier(xb);
    { EpiResid e{p.out, hctx, p.out, hctx, mods + (size_t)1 * 5 * 6144 + 2 * 1024, (const float2*)(p.ws + OFF_LNS), p.ln_g + (size_t)(0 * 2 + 1) * 1024, p.ln_b + (size_t)(0 * 2 + 1) * 1024}; big_gemm(a, (const bf16_t*)(p.ws + W1_OUT), T_ALL, 1024, 1024, e, lds, 1); ctx_gemm(a, (const bf16_t*)(p.ws + W1_OUT), 1024, e, lds); }
    xcd_barrier(xb);
    ln_phase(p, 1, 0, 1, 3, false);
    xcd_barrier(xb);
    ffn_and_ln(p, xb, lds, 1, (const bf16_t*)(p.ws + W1_W13), (const bf16_t*)(p.ws + W1_W2));
  }
  { const bf16_t* d0 = (const bf16_t*)(p.ws + M_D0);
    { EpiStore e{(bf16_t*)(p.ws + M_D0), (bf16_t*)(p.ws + M_D0), 1 << 30, 1024, 1024, 1.f}; big_gemm(a, (const bf16_t*)(p.ws + W2_DOWN), T_ALL, 1024, 1024, e, lds); }
    xcd_barrier(xb);
    mla_stats_phase(p);
    xcd_barrier(xb);
    { GemmArgs g{d0, 1024, (const bf16_t*)(p.ws + W2_UQ), 512, T_ALL, 1536, 512}; EpiMlaQ e{(bf16_t*)(p.ws + M_Q), rs, tabM}; gemm_phase<false>(g, e, lds); }
    { GemmArgs g{d0 + 512, 1024, (const bf16_t*)(p.ws + W2_UKV), 256, T_ALL, 1024, 256}; EpiMlaK e{(bf16_t*)(p.ws + M_K), rs}; gemm_phase<false>(g, e, lds); }
    { GemmArgs g{d0 + 512, 1024, (const bf16_t*)(p.ws + W2_UKV) + (size_t)1024 * 256, 256, T_ALL, 1024, 256}; EpiVT e{(bf16_t*)(p.ws + M_VT), rs}; gemm_phase<true>(g, e, lds); }
    xcd_barrier(xb);
    mla_attn_phase(p, lds);
    xcd_barrier(xb);
    { EpiResid e{p.out, hctx, p.out, hctx, mods + (size_t)2 * 5 * 6144 + 2 * 1024, (const float2*)(p.ws + OFF_LNS), p.ln_g + (size_t)(1 * 2 + 1) * 1024, p.ln_b + (size_t)(1 * 2 + 1) * 1024}; big_gemm(a, (const bf16_t*)(p.ws + W2_OUT), T_ALL, 1024, 1024, e, lds, 1); ctx_gemm(a, (const bf16_t*)(p.ws + W2_OUT), 1024, e, lds); }
    xcd_barrier(xb);
    ln_phase(p, 2, 0, 2, 3, false);
    xcd_barrier(xb);
    ffn_and_ln(p, xb, lds, 2, (const bf16_t*)(p.ws + W2_W13), (const bf16_t*)(p.ws + W2_W2));
  }
  { { EpiHg e{(bf16_t*)(p.ws + H_P)}; big_gemm(a, (const bf16_t*)(p.ws + W3_IN), T_ALL, 5120, 1024, e, lds); }
    xcd_barrier(xb);
    scan_phase<128, true, 32>(p, lds);
    xcd_barrier(xb);
    hg_readout_phase(p);
    xcd_barrier(xb);
    { EpiResid e{p.out, hctx, p.out, hctx, mods + (size_t)3 * 5 * 6144 + 2 * 1024, (const float2*)(p.ws + OFF_LNS), p.ln_g + (size_t)(2 * 2 + 1) * 1024, p.ln_b + (size_t)(2 * 2 + 1) * 1024}; big_gemm(a, (const bf16_t*)(p.ws + W3_OUT), T_ALL, 1024, 1024, e, lds, 1); }
    xcd_barrier(xb);
    ln_phase(p, 3, 0, 3, 3, false);
    xcd_barrier(xb);
    ffn_and_ln(p, xb, lds, 3, (const bf16_t*)(p.ws + W3_W13), (const bf16_t*)(p.ws + W3_W2));
  }
}

extern "C" void kernel_launch(void* const* d_in, const int* in_sizes, int n_in, void* d_out, int out_size, void* d_ws, size_t ws_size, hipStream_t stream) {
  static int grid_blocks = 0;
  if (!grid_blocks) {
    int dev = 0, cus = 0, per_cu = 0;
    (void)hipGetDevice(&dev);
    (void)hipDeviceGetAttribute(&cus, hipDeviceAttributeMultiprocessorCount, dev);
    (void)hipOccupancyMaxActiveBlocksPerMultiprocessor(&per_cu, mega, NTHR, 0);
    if (per_cu != 1) per_cu = 1;
    grid_blocks = cus * per_cu;
  }
  if (ws_size < WS_NEED) { fprintf(stderr, "workspace too small: %zu\n", ws_size); return; }
  Params p{};
  const float** f = (const float**)&p;
  for (int i = 0; i < 26; ++i) f[i] = (const float*)d_in[i];
  p.out = (float*)d_out; p.ws = (char*)d_ws;
  (void)hipMemsetAsync((char*)d_ws + OFF_BAR, 0, XCD_BAR_WORDS * 4, stream);
  void* args[] = {&p};
  hipError_t e = hipLaunchCooperativeKernel((void*)mega, dim3(grid_blocks), dim3(NTHR), args, 0, stream);
  if (e != hipSuccess) fprintf(stderr, "cooperative launch failed: %s (grid %d)\n", hipGetErrorString(e), grid_blocks);
}
```

```cpp
#include <hip/hip_runtime.h>
#include <hip/hip_cooperative_groups.h>
#include <cstdio>
#include <cstdint>
namespace cg = cooperative_groups;

#define DI __device__ __forceinline__
DI int tid_() { int t = threadIdx.x; asm volatile("" : "+v"(t)); return t; }
typedef unsigned short bf16_t;
typedef short bf16x8 __attribute__((ext_vector_type(8)));
typedef short s16x4 __attribute__((ext_vector_type(4)));
typedef float f32x4 __attribute__((ext_vector_type(4)));
typedef float f32x16 __attribute__((ext_vector_type(16)));
typedef unsigned u32x4 __attribute__((ext_vector_type(4)));
typedef unsigned u32x2 __attribute__((ext_vector_type(2)));

constexpr int NTHR = 512;
constexpr int T_ALL = 33792, PB = 8448, LC = 256, LL = 8192, DM = 1024, FF = 2816;
constexpr float ALPHA = 1.681792830507429f;
constexpr float LOG2E = 1.4426950408889634f;
constexpr size_t MiB = 1048576;

struct Params {
  const float *x, *c, *ctx, *cctx, *ada_w, *ada_b, *ln_g, *ln_b, *w13, *w2;
  const float *ret_w_in, *ret_decay, *ret_w_out, *na_w_qkv, *na_rpb, *na_w_out;
  const float *mla_w_down, *mla_q_norm, *mla_kv_norm, *mla_w_uq, *mla_w_ukv, *mla_w_out;
  const float *hg_w_in, *hg_lb, *hg_norm_g, *hg_w_out;
  float* out; char* ws;
};

constexpr size_t OFF_MODS = 0;
constexpr size_t OFF_TABR = 512 * 1024;
constexpr size_t OFF_TABM = OFF_TABR + 65536;
constexpr size_t OFF_LBV = OFF_TABM + 8192;
constexpr size_t OFF_RS = OFF_LBV + 4096;
constexpr size_t OFF_BAR = 896 * 1024;
constexpr size_t OFF_HCTX = 1 * MiB;
constexpr size_t OFF_A = 5 * MiB;
constexpr size_t OFF_W0 = 71 * MiB;
constexpr size_t OFF_BIG = 104 * MiB;
constexpr size_t OFF_WR = OFF_BIG;
constexpr size_t OFF_S = 180 * MiB;
constexpr size_t WS_NEED = 512 * MiB;
constexpr size_t OFF_LNS = 510 * MiB;
constexpr size_t W0_RETIN = OFF_W0, W0_RETOUT = W0_RETIN + (size_t)6144 * 1024 * 2, W0_W13 = W0_RETOUT + (size_t)1024 * 2048 * 2, W0_W2 = W0_W13 + (size_t)5632 * 1024 * 2;
constexpr size_t SZ_W13 = (size_t)5632 * 1024 * 2, SZ_W2 = (size_t)1024 * 2816 * 2, SZ_SQ = (size_t)1024 * 1024 * 2;
constexpr size_t W1_QKV = OFF_WR, W1_OUT = W1_QKV + (size_t)3072 * 1024 * 2, W1_W13 = W1_OUT + SZ_SQ, W1_W2 = W1_W13 + SZ_W13;
constexpr size_t W2_DOWN = W1_W2 + SZ_W2, W2_UQ = W2_DOWN + (size_t)1024 * 1024 * 2, W2_UKV = W2_UQ + (size_t)1536 * 512 * 2, W2_OUT = W2_UKV + (size_t)2048 * 256 * 2, W2_W13 = W2_OUT + SZ_SQ, W2_W2 = W2_W13 + SZ_W13;
constexpr size_t W3_IN = W2_W2 + SZ_W2, W3_OUT = W3_IN + (size_t)5120 * 1024 * 2, W3_W13 = W3_OUT + SZ_SQ, W3_W2 = W3_W13 + SZ_W13, W3_END = W3_W2 + SZ_W2;
static_assert(W3_END <= OFF_S, "rest weights overflow");
static_assert(W0_W2 + SZ_W2 <= OFF_BIG, "W0 overflow");
constexpr size_t SZ_T2048 = (size_t)T_ALL * 2048 * 2, SZ_T1024 = (size_t)T_ALL * 1024 * 2;
constexpr size_t R_QK = OFF_BIG, R_V = R_QK + SZ_T2048, R_O = R_V + SZ_T2048;
static_assert(R_O + SZ_T2048 <= WS_NEED, "retention overflow");
constexpr size_t N_Q = OFF_S, N_K = N_Q + SZ_T1024, N_VT = N_K + SZ_T1024;
constexpr size_t M_D0 = OFF_S, M_CKV = M_D0 + (size_t)T_ALL * 512 * 2, M_KR = M_CKV + (size_t)T_ALL * 256 * 2, M_Q = M_D0 + (size_t)T_ALL * 1024 * 2, M_K = M_Q + (size_t)T_ALL * 1536 * 2, M_VT = M_K + (size_t)T_ALL * 1536 * 2;
static_assert(M_VT + SZ_T1024 <= WS_NEED, "mla overflow");
constexpr size_t H_P = OFF_S;
static_assert(H_P + (size_t)T_ALL * 5120 * 2 <= WS_NEED, "hgrn overflow");
constexpr size_t F_U = OFF_S;

typedef float f32x2 __attribute__((ext_vector_type(2)));
typedef __bf16 bf16x2_t __attribute__((ext_vector_type(2)));
DI unsigned pk2(float lo, float hi) { const f32x2 v = {lo, hi}; const bf16x2_t r = __builtin_convertvector(v, bf16x2_t); return __builtin_bit_cast(unsigned, r); }
DI float bflo(unsigned u) { return __uint_as_float(u << 16); }
DI float bfhi(unsigned u) { return __uint_as_float(u & 0xffff0000u); }
DI float bf2f(bf16_t v) { return __uint_as_float(((unsigned)v) << 16); }
DI bf16_t f2bf(float x) { return (bf16_t)(pk2(x, 0.f) & 0xffffu); }
DI float siluf(float x) { return x / (1.f + __expf(-x)); }
DI f32x4 mfma16(bf16x8 a, bf16x8 b, f32x4 c) { return __builtin_amdgcn_mfma_f32_16x16x32_bf16(a, b, c, 0, 0, 0); }
DI f32x16 mfma32(bf16x8 a, bf16x8 b, f32x16 c) { return __builtin_amdgcn_mfma_f32_32x32x16_bf16(a, b, c, 0, 0, 0); }
DI bf16x8 cat44(s16x4 lo, s16x4 hi) { return __builtin_shufflevector(lo, hi, 0, 1, 2, 3, 4, 5, 6, 7); }
DI bf16x8 pack8(float a0, float a1, float a2, float a3, float a4, float a5, float a6, float a7) {
  u32x4 p; p.x = pk2(a0, a1); p.y = pk2(a2, a3); p.z = pk2(a4, a5); p.w = pk2(a6, a7); return __builtin_bit_cast(bf16x8, p);
}
DI int clampi(int v, int lo, int hi) { return v < lo ? lo : (v > hi ? hi : v); }
DI float* hrow(float* hlat, float* hctx, int t) { const int b = t / PB, p = t - b * PB; return p < LC ? hctx + (size_t)(b * LC + p) * DM : hlat + (size_t)(b * LL + p - LC) * DM; }
DI const float* hrowc(const float* hlat, const float* hctx, int t) { const int b = t / PB, p = t - b * PB; return p < LC ? hctx + (size_t)(b * LC + p) * DM : hlat + (size_t)(b * LL + p - LC) * DM; }
DI int modvec(int t) { const int b = t / PB, p = t - b * PB; return p < LC ? 4 : b; }

template <int MODE> DI int srccol(int n) {
  if (MODE == 0) return n;
  if (MODE == 1) { const int c = n >> 5, s = (n >> 4) & 1, i = n & 15; return s * FF + 16 * c + i; }
  if (MODE == 2) { if (n >= 2048) return n; const int w = n & 255, j = w >> 1, s = w & 1; return (n & ~255) + s * 128 + j; }
  if (MODE == 3) { const int h = n / 96, w = n - h * 96; if (w < 64) return n; const int wp = w - 64, j = wp >> 1, s = wp & 1; return h * 96 + 64 + s * 16 + j; }
  if (MODE == 4) { if (n < 1024) return (n >> 6) * 128 + (n & 63); const int m = n - 1024; return (m >> 6) * 128 + 64 + (m & 63); }
  if (MODE == 5) return n < 800 ? n : -1;
  return n;
}
template <int MODE> DI f32x4 cvt_load4(const float* __restrict__ row, int n) {
  if (MODE == 2 && n < 2048) { const int w = n & 255, j = w >> 1; const float* b = row + (n & ~255) + j; const f32x2 lo = *(const f32x2*)b, hi = *(const f32x2*)(b + 128); return (f32x4){lo[0], hi[0], lo[1], hi[1]}; }
  if (MODE == 3) { return (f32x4){row[srccol<3>(n)], row[srccol<3>(n + 1)], row[srccol<3>(n + 2)], row[srccol<3>(n + 3)]}; }
  const int sc = srccol<MODE>(n); if (sc < 0) return (f32x4){0.f, 0.f, 0.f, 0.f};
  return *(const f32x4*)(row + sc);
}
template <int MODE>
DI void convert_w(const float* __restrict__ src, int Nsrc, int K, bf16_t* __restrict__ dst, int Ndst, const float* __restrict__ kscale, float* ldsf) {
  const int tid = threadIdx.x, tn = Ndst / 64, tk = K / 64;
  for (int tile = blockIdx.x; tile < tn * tk; tile += gridDim.x) {
    const int n0 = (tile % tn) * 64, k0 = (tile / tn) * 64;
    __syncthreads();
#pragma unroll
    for (int i = 0; i < 2; ++i) { const int kk = (tid >> 4) + 32 * i, nn = (tid & 15) * 4;
      f32x4 v = cvt_load4<MODE>(src + (size_t)(k0 + kk) * Nsrc, n0 + nn);
      if (kscale) v = v * kscale[k0 + kk];
      float* lp = ldsf + kk * 65 + nn; lp[0] = v[0]; lp[1] = v[1]; lp[2] = v[2]; lp[3] = v[3]; }
    __syncthreads();
    { const int nn = tid >> 3, kc = tid & 7; const float* lp = ldsf + (kc * 8) * 65 + nn;
      u32x4 o; o.x = pk2(lp[0], lp[65]); o.y = pk2(lp[130], lp[195]); o.z = pk2(lp[260], lp[325]); o.w = pk2(lp[390], lp[455]);
      *(u32x4*)(dst + (size_t)(n0 + nn) * K + k0 + kc * 8) = o; }
  }
}

DI void ada_phase(const Params& p, float* ldsf) {
  const int tid = threadIdx.x, lane = tid & 63, w = tid >> 6;
  float* mods = (float*)(p.ws + OFF_MODS);
  __syncthreads();
  for (int e = tid; e < 5120; e += NTHR) { const int mv = e >> 10, k = e & 1023; const float cv = mv < 4 ? p.c[mv * 1024 + k] : p.cctx[k]; ldsf[e] = siluf(cv); }
  __syncthreads();
  float* red = ldsf + 5120;
  for (int item = blockIdx.x; item < 4 * 96; item += gridDim.x) {
    const int i = item / 96, n0 = (item % 96) * 64;
    const float* wp = p.ada_w + (size_t)i * 1024 * 6144 + n0 + lane;
    float a0 = 0.f, a1 = 0.f, a2 = 0.f, a3 = 0.f, a4 = 0.f;
#pragma unroll 8
    for (int kk = 0; kk < 128; ++kk) { const int k = w * 128 + kk; const float wv = wp[(size_t)k * 6144];
      a0 += ldsf[k] * wv; a1 += ldsf[1024 + k] * wv; a2 += ldsf[2048 + k] * wv; a3 += ldsf[3072 + k] * wv; a4 += ldsf[4096 + k] * wv; }
    red[(w * 5 + 0) * 64 + lane] = a0; red[(w * 5 + 1) * 64 + lane] = a1; red[(w * 5 + 2) * 64 + lane] = a2; red[(w * 5 + 3) * 64 + lane] = a3; red[(w * 5 + 4) * 64 + lane] = a4;
    __syncthreads();
    if (tid < 320) { const int mv = tid >> 6; float s = 0.f;
#pragma unroll
      for (int ww = 0; ww < 8; ++ww) s += red[(ww * 5 + mv) * 64 + lane];
      mods[(size_t)(i * 5 + mv) * 6144 + n0 + lane] = s + p.ada_b[i * 6144 + n0 + lane]; }
    __syncthreads();
  }
}
DI void tables_phase(const Params& p) {
  const int gt = blockIdx.x * NTHR + threadIdx.x, gn = gridDim.x * NTHR;
  float2* tabR = (float2*)(p.ws + OFF_TABR); float2* tabM = (float2*)(p.ws + OFF_TABM); float* lbv = (float*)(p.ws + OFF_LBV);
  for (int e = gt; e < 128 * 64; e += gn) { const int v = e >> 6, i = e & 63; const float inv = powf(10000.f, -(float)i / 64.f); const float ang = (float)v * inv; tabR[e] = make_float2(cosf(ang), sinf(ang)); }
  for (int e = gt; e < 128 * 8; e += gn) { const int v = e >> 3, i = e & 7; const float inv = powf(10000.f, -(float)i / 8.f); const float ang = (float)v * inv; tabM[e] = make_float2(cosf(ang), sinf(ang)); }
  for (int e = gt; e < 1024; e += gn) { const float l0 = p.hg_lb[e], l1 = p.hg_lb[1024 + e], l2 = p.hg_lb[2048 + e], l3 = p.hg_lb[3072 + e];
    const float mx = fmaxf(fmaxf(l0, l1), fmaxf(l2, l3)); const float e0 = expf(l0 - mx), e1 = expf(l1 - mx), e2 = expf(l2 - mx), e3 = expf(l3 - mx);
    lbv[e] = (e1 + e2 + e3) / (e0 + e1 + e2 + e3); }
}

DI void modulate_phase(const Params& p, const float* slat, const float* sctx, int layer) {
  const float* mods = (const float*)(p.ws + OFF_MODS); bf16_t* a = (bf16_t*)(p.ws + OFF_A);
  const int gt = blockIdx.x * NTHR + threadIdx.x, gn = gridDim.x * NTHR;
  for (int e = gt; e < T_ALL * 128; e += gn) {
    const int t = e >> 7, c0 = (e & 127) * 8; const float* s = hrowc(slat, sctx, t) + c0; const float* m = mods + (size_t)(layer * 5 + modvec(t)) * 6144;
    const f32x4 x0 = *(const f32x4*)s, x1 = *(const f32x4*)(s + 4), sh0 = *(const f32x4*)(m + c0), sh1 = *(const f32x4*)(m + c0 + 4), sc0 = *(const f32x4*)(m + 1024 + c0), sc1 = *(const f32x4*)(m + 1024 + c0 + 4);
    const f32x4 y0 = x0 * (1.f + sc0) + sh0, y1 = x1 * (1.f + sc1) + sh1;
    u32x4 o; o.x = pk2(y0[0], y0[1]); o.y = pk2(y0[2], y0[3]); o.z = pk2(y1[0], y1[1]); o.w = pk2(y1[2], y1[3]);
    *(u32x4*)(a + (size_t)t * 1024 + c0) = o;
  }
}
DI void ln_phase(const Params& p, int lnlayer, int lnidx, int ml, int js, bool final_out) {
  const float* mods = (const float*)(p.ws + OFF_MODS); bf16_t* a = (bf16_t*)(p.ws + OFF_A); float* hctx = (float*)(p.ws + OFF_HCTX); float2* lns = (float2*)(p.ws + OFF_LNS);
  const int tid = threadIdx.x, lane = tid & 63, gw = blockIdx.x * 8 + (tid >> 6), nw = gridDim.x * 8;
  const float* gp = p.ln_g + (size_t)(lnlayer * 2 + lnidx) * 1024; const float* bp = p.ln_b + (size_t)(lnlayer * 2 + lnidx) * 1024;
  for (int t = gw; t < T_ALL; t += nw) {
    float* hr = hrow(p.out, hctx, t);
    f32x4 v[4]; float s = 0.f;
#pragma unroll
    for (int i = 0; i < 4; ++i) { v[i] = *(const f32x4*)(hr + i * 256 + lane * 4); s += (v[i][0] + v[i][1]) + (v[i][2] + v[i][3]); }
#pragma unroll
    for (int o = 1; o < 64; o <<= 1) s += __shfl_xor(s, o);
    const float mean = s * (1.f / 1024.f); float q = 0.f;
#pragma unroll
    for (int i = 0; i < 4; ++i) { v[i] = v[i] - mean; q += (v[i][0] * v[i][0] + v[i][1] * v[i][1]) + (v[i][2] * v[i][2] + v[i][3] * v[i][3]); }
#pragma unroll
    for (int o = 1; o < 64; o <<= 1) q += __shfl_xor(q, o);
    const float rstd = rsqrtf(q * (1.f / 1024.f) + 1e-5f);
    if (!final_out && lane == 0) lns[t] = make_float2(mean, rstd);
    const float* m = mods + (size_t)(ml * 5 + modvec(t)) * 6144 + (size_t)js * 1024;
#pragma unroll
    for (int i = 0; i < 4; ++i) { const int c0 = i * 256 + lane * 4;
      const f32x4 y = v[i] * rstd * *(const f32x4*)(gp + c0) + *(const f32x4*)(bp + c0);
      if (final_out) *(f32x4*)(hr + c0) = y;
      else { const f32x4 z = y * (1.f + *(const f32x4*)(m + 1024 + c0)) + *(const f32x4*)(m + c0); u32x2 o; o.x = pk2(z[0], z[1]); o.y = pk2(z[2], z[3]); *(u32x2*)(a + (size_t)t * 1024 + c0) = o; } }
  }
}

namespace pg8 {
#define PG8_LAS __attribute__((address_space(3)))
typedef unsigned short bf16_t;
typedef short bf16x8 __attribute__((ext_vector_type(8)));
typedef float f32x4 __attribute__((ext_vector_type(4)));
typedef unsigned u32x4 __attribute__((ext_vector_type(4)));
constexpr int BM = 256, BK = 64, HALF = 128, HTB = HALF * BK * 2  , STAGE_BYTES = 8 * HTB, NXCD = 8, WGM = 8;

__host__ __device__ __forceinline__ int lds_byte(int r, int c) { const int st = (r >> 4) * 2 + (c >> 5), rr = r & 15, cc = c & 31, ob = rr * 64 + cc * 2; return st * 1024 + (ob ^ (((ob >> 9) & 1) << 5)); }
__host__ __device__ __forceinline__ void stage_rc(int b, int& R, int& C) { const int st = b / 1024, sb = b % 1024, swz = sb ^ (((sb >> 9) & 1) << 5); R = (st >> 1) * 16 + swz / 64; C = (st & 1) * 32 + (swz % 64) / 2; }
__host__ __device__ __forceinline__ int perm32(int rho) { const int n = rho >> 4, i = rho & 15; return 8 * (i >> 2) + 4 * n + (i & 3); }

struct Unit { int pm, pn; };
struct Gemm { const bf16_t* A; const bf16_t* Bt; int M, N, K; };

struct StaticOrder {
    int nM, nN, nwg, G, c, lat;
    __host__ __device__ void init(int M, int N, int G_, int c_, int lat_ = 0) { lat = lat_; nM = lat ? 128 : M / BM; nN = N / BM; nwg = nM * nN; G = G_; c = c_; }
    __host__ __device__ bool next(int i, Unit& u) const {
        const long L = (long)i * G + c; if (L >= nwg) return false;
        int wgid = (int)L; { const int q = nwg / NXCD, r = nwg % NXCD, xcd = wgid % NXCD, off = wgid / NXCD; wgid = (xcd < r ? xcd * (q + 1) : r * (q + 1) + (xcd - r) * q) + off; }
        const int nig = WGM * nN, gid = wgid / nig, fm = gid * WGM, gsz = (nM - fm) < WGM ? (nM - fm) : WGM;
        u.pm = fm + ((wgid % nig) % gsz); u.pn = (wgid % nig) / gsz; if (lat) u.pm += (u.pm >> 5) + 1; return true;
    }
    __device__ __forceinline__ void a_ready(const Unit&) const {}
    __device__ __forceinline__ void done(const Unit&) const {}
};
template <class Epi, class Sched, bool ALIGN_EPI = false, bool SP2 = false>
__device__ __forceinline__ void gemm_phase(PG8_LAS unsigned char* lds, const Gemm g, const Sched& S, const Epi& E) {
    const int tid = tid_(), wid = __builtin_amdgcn_readfirstlane(tid >> 6), lane = tid & 63, wr = wid >> 2, wc = wid & 3, fr = lane & 15, fq = lane >> 4;
    const int K = g.K, nt = K / BK;
    unsigned voffA[2], voffB[2];
#pragma unroll
    for (int i = 0; i < 2; ++i) { int R, C; stage_rc(tid * 16 + i * 8192, R, C); const int Rb = Epi::PERM ? ((R & ~31) + perm32(R & 31)) : R;
        voffA[i] = (unsigned)(R * K + C) * 2u; voffB[i] = (unsigned)(Rb * K + C) * 2u; }
    const size_t kstep = (size_t)(BK * 2);
    const size_t hstep = (size_t)HALF * K * 2;
    const size_t tstep = 2 * hstep;
    const unsigned ldsw = (unsigned)wid * 1024u;
    const int aoff = lds_byte(wr * 64 + fr, fq * 8), boff = lds_byte(wc * 32 + fr, fq * 8);
#define PG8_SA(b, h) (((b) * 2 + (h)) * HTB)
#define PG8_SB(b, h) ((4 + (b) * 2 + (h)) * HTB)
#define PG8_STAGE(bufoff, gbase, voff) do { _Pragma("unroll") for (int _i = 0; _i < 2; ++_i) \
        __builtin_amdgcn_global_load_lds((const unsigned*)((const char*)(gbase) + (voff)[_i]), (PG8_LAS unsigned*)(lds + (bufoff) + ldsw + _i * 8192), 16, 0, 0); } while (0)
#define PG8_LDA(dst, b, h) do { _Pragma("unroll") for (int m = 0; m < 4; ++m) _Pragma("unroll") for (int k = 0; k < 2; ++k) dst[m][k] = *(const PG8_LAS bf16x8*)(lds + PG8_SA(b, h) + aoff + m * 2048 + k * 1024); } while (0)
#define PG8_LDB(dst, b, h) do { _Pragma("unroll") for (int n = 0; n < 2; ++n) _Pragma("unroll") for (int k = 0; k < 2; ++k) dst[n][k] = *(const PG8_LAS bf16x8*)(lds + PG8_SB(b, h) + boff + n * 2048 + k * 1024); } while (0)
#define PG8_MMA(ai, bj, At, Bt) do { __builtin_amdgcn_s_setprio(1); _Pragma("unroll") for (int m = 0; m < 4; ++m) _Pragma("unroll") for (int n = 0; n < 2; ++n) _Pragma("unroll") for (int k = 0; k < 2; ++k) \
        acc[ai][bj][m][n] = __builtin_amdgcn_mfma_f32_16x16x32_bf16(Bt[n][k], At[m][k], acc[ai][bj][m][n], 0, 0, 0); __builtin_amdgcn_s_setprio(0); } while (0)
#define PG8_WAIT_V(n) asm volatile("s_waitcnt vmcnt(" #n ")" ::: "memory")
#define PG8_WAIT_L(n) asm volatile("s_waitcnt lgkmcnt(" #n ")" ::: "memory")
#define PG8_BAR __builtin_amdgcn_s_barrier()
#define PG8_SCHED __builtin_amdgcn_sched_barrier(0)
    Unit cur, nxt; int ui = 0;
    if (!S.next(0, cur)) return;
    f32x4 acc[2][2][4][2];
#pragma unroll
    for (int a = 0; a < 2; ++a)
#pragma unroll
        for (int b = 0; b < 2; ++b)
#pragma unroll
            for (int m = 0; m < 4; ++m)
#pragma unroll
                for (int n = 0; n < 2; ++n) acc[a][b][m][n] = (f32x4){0.f, 0.f, 0.f, 0.f};
    bf16x8 At[4][2], B0[2][2], B1[2][2];
    const char* cA = (const char*)g.A + (size_t)cur.pm * tstep; const char* cB = (const char*)g.Bt + (size_t)cur.pn * tstep;
    S.a_ready(cur);
    if constexpr (SP2) {
        PG8_STAGE(PG8_SB(0, 0), cB, voffB); PG8_STAGE(PG8_SB(0, 1), cB + hstep, voffB); PG8_STAGE(PG8_SA(0, 0), cA, voffA); PG8_STAGE(PG8_SA(0, 1), cA + hstep, voffA);
        if (wr == 1) PG8_BAR;
        PG8_WAIT_V(2); PG8_BAR;
        PG8_STAGE(PG8_SB(1, 0), cB + kstep, voffB); PG8_STAGE(PG8_SA(1, 0), cA + kstep, voffA); PG8_STAGE(PG8_SB(1, 1), cB + hstep + kstep, voffB);
        PG8_WAIT_V(6); PG8_BAR;
    } else {
        PG8_STAGE(PG8_SB(0, 0), cB, voffB); PG8_STAGE(PG8_SA(0, 0), cA, voffA); PG8_STAGE(PG8_SB(0, 1), cB + hstep, voffB); PG8_STAGE(PG8_SA(0, 1), cA + hstep, voffA);
        if (wr == 1) PG8_BAR;
        PG8_WAIT_V(4); PG8_BAR;
        PG8_STAGE(PG8_SB(1, 0), cB + kstep, voffB); PG8_STAGE(PG8_SA(1, 0), cA + kstep, voffA); PG8_STAGE(PG8_SB(1, 1), cB + hstep + kstep, voffB);
        PG8_WAIT_V(6); PG8_BAR;
    }
    for (;;) {
        const bool has_next = S.next(ui + 1, nxt);
        const char* nA = has_next ? (const char*)g.A + (size_t)nxt.pm * tstep : cA; const char* nB = has_next ? (const char*)g.Bt + (size_t)nxt.pn * tstep : cB;
        for (int t = 0; t < nt; t += 2) {
            const bool last = (t == nt - 2);
            const char* a1 = cA + (size_t)(t + 1) * kstep;
            const char* a2 = last ? nA : cA + (size_t)(t + 2) * kstep; const char* b2 = last ? nB : cB + (size_t)(t + 2) * kstep;
            const char* a3 = a2 + kstep; const char* b3 = b2 + kstep;
            if (last && has_next) S.a_ready(nxt);
            if constexpr (SP2) {
            PG8_LDB(B0, 0, 0); PG8_LDB(B1, 0, 1); PG8_SCHED; PG8_LDA(At, 0, 0); PG8_STAGE(PG8_SA(1, 1), a1 + hstep, voffA);
            PG8_WAIT_V(8); PG8_WAIT_L(0); PG8_BAR; PG8_MMA(0, 0, At, B0); PG8_MMA(0, 1, At, B1); PG8_BAR; PG8_SCHED;
            PG8_LDA(At, 0, 1); PG8_STAGE(PG8_SB(0, 0), b2, voffB); PG8_STAGE(PG8_SB(0, 1), b2 + hstep, voffB); PG8_STAGE(PG8_SA(0, 0), a2, voffA);
            PG8_WAIT_V(8); PG8_WAIT_L(0); PG8_BAR; PG8_MMA(1, 0, At, B0); PG8_MMA(1, 1, At, B1); PG8_BAR; PG8_SCHED;
            PG8_LDB(B0, 1, 0); PG8_LDB(B1, 1, 1); PG8_SCHED; PG8_LDA(At, 1, 0); PG8_STAGE(PG8_SA(0, 1), a2 + hstep, voffA);
            PG8_WAIT_V(8); PG8_WAIT_L(0); PG8_BAR; PG8_MMA(0, 0, At, B0); PG8_MMA(0, 1, At, B1); PG8_BAR; PG8_SCHED;
            PG8_LDA(At, 1, 1); PG8_STAGE(PG8_SB(1, 0), b3, voffB); PG8_STAGE(PG8_SB(1, 1), b3 + hstep, voffB); PG8_STAGE(PG8_SA(1, 0), a3, voffA);
            PG8_WAIT_V(8); PG8_WAIT_L(0); PG8_BAR; PG8_MMA(1, 0, At, B0); PG8_MMA(1, 1, At, B1); PG8_BAR; PG8_SCHED;
            } else {
            PG8_LDB(B0, 0, 0); PG8_SCHED; PG8_LDA(At, 0, 0); PG8_STAGE(PG8_SA(1, 1), a1 + hstep, voffA);
            PG8_WAIT_L(8); PG8_BAR; PG8_WAIT_L(0); PG8_MMA(0, 0, At, B0); PG8_BAR; PG8_SCHED;
            PG8_LDB(B1, 0, 1); PG8_STAGE(PG8_SB(0, 0), b2, voffB);
            PG8_BAR; PG8_WAIT_L(0); PG8_MMA(0, 1, At, B1); PG8_BAR;
            PG8_LDA(At, 0, 1); PG8_STAGE(PG8_SA(0, 0), a2, voffA);
            PG8_BAR; PG8_WAIT_L(0); PG8_MMA(1, 0, At, B0); PG8_BAR; PG8_SCHED;
            PG8_STAGE(PG8_SB(0, 1), b2 + hstep, voffB);
            PG8_WAIT_V(6); PG8_BAR; PG8_MMA(1, 1, At, B1); PG8_BAR;
            PG8_LDB(B0, 1, 0); PG8_SCHED; PG8_LDA(At, 1, 0); PG8_STAGE(PG8_SA(0, 1), a2 + hstep, voffA);
            PG8_WAIT_L(8); PG8_BAR; PG8_WAIT_L(0); PG8_MMA(0, 0, At, B0); PG8_BAR; PG8_SCHED;
            PG8_LDB(B1, 1, 1); PG8_STAGE(PG8_SB(1, 0), b3, voffB);
            PG8_BAR; PG8_WAIT_L(0); PG8_MMA(0, 1, At, B1); PG8_BAR;
            PG8_LDA(At, 1, 1); PG8_STAGE(PG8_SA(1, 0), a3, voffA);
            PG8_BAR; PG8_WAIT_L(0); PG8_MMA(1, 0, At, B0); PG8_BAR; PG8_SCHED;
            PG8_STAGE(PG8_SB(1, 1), b3 + hstep, voffB);
            PG8_WAIT_V(6); PG8_BAR; PG8_MMA(1, 1, At, B1); PG8_BAR;
            }
        }
        if constexpr (ALIGN_EPI) { if (wr == 0) PG8_BAR; }
        if constexpr (!Epi::AFTER_DRAIN) { E(acc, cur, wr, wc, fr, fq); S.done(cur); }
        if (!has_next) break;
#pragma unroll
        for (int a = 0; a < 2; ++a)
#pragma unroll
            for (int b = 0; b < 2; ++b)
#pragma unroll
                for (int m = 0; m < 4; ++m)
#pragma unroll
                    for (int n = 0; n < 2; ++n) acc[a][b][m][n] = (f32x4){0.f, 0.f, 0.f, 0.f};
        cur = nxt; cA = nA; cB = nB; ++ui;
        if constexpr (ALIGN_EPI) { if (wr == 1) PG8_BAR; }
    }
    PG8_WAIT_V(0);
    if constexpr (!ALIGN_EPI) { if (wr == 0) PG8_BAR; }
    PG8_BAR;
    if constexpr (Epi::AFTER_DRAIN) { E.fused(acc, cur, wr, wc, fr, fq, lds, wid, lane); S.done(cur); }
#undef PG8_SA
#undef PG8_SB
#undef PG8_STAGE
#undef PG8_LDA
#undef PG8_LDB
#undef PG8_MMA
#undef PG8_WAIT_V
#undef PG8_WAIT_L
#undef PG8_BAR
#undef PG8_SCHED
}
}

template <class E4> struct EpiWrap { static constexpr bool PERM = false, AFTER_DRAIN = false; E4 e;
  DI void operator()(const f32x4 (&acc)[2][2][4][2], const pg8::Unit& u, int wr, int wc, int fr, int fq) const {
#pragma unroll
    for (int ai = 0; ai < 2; ++ai)
#pragma unroll
      for (int m = 0; m < 4; ++m) { const int row = u.pm * 256 + ai * 128 + wr * 64 + m * 16 + fr;
#pragma unroll
        for (int bj = 0; bj < 2; ++bj) { const int col = u.pn * 256 + bj * 128 + wc * 32 + 4 * fq;
          if constexpr (E4::PAIR) e.pair(row, ((col - 4 * fq) >> 1) + 4 * fq, acc[ai][bj][m][0], acc[ai][bj][m][1]);
          else { e(row, col, acc[ai][bj][m][0]); e(row, col + 16, acc[ai][bj][m][1]); } }
        asm volatile("" ::: "memory"); }
  } };
template <class E4>
DI void big_gemm(const bf16_t* A, const bf16_t* W, int M, int N, int K, const E4& e4, char* lds, int lat_only = 0) {
  __syncthreads();
  pg8::Gemm g{A, W, M, N, K}; pg8::StaticOrder S; S.init(M, N, (int)gridDim.x, (int)blockIdx.x, lat_only); EpiWrap<E4> E{e4};
  pg8::gemm_phase<EpiWrap<E4>, pg8::StaticOrder, true, true>((PG8_LAS unsigned char*)lds, g, S, E);
  __syncthreads();
}
struct GemmArgs { const bf16_t* A; int lda; const bf16_t* W; int ldw; int M, N, K; };
constexpr int LDT = 72;
template <bool TRANS, class Epi>
DI void gemm_phase(const GemmArgs g, const Epi epi, char* lds) {
  const int tid = threadIdx.x, lane = tid & 63, w = tid >> 6, wm = w & 3, wn = w >> 2, g4 = lane >> 4, l16 = lane & 15;
  const int nN = g.N / 128, ntiles = (g.M / 256) * nN, nk = g.K / 64;
  bf16_t* As = (bf16_t*)lds; bf16_t* Bs = As + 256 * LDT;
  for (int tile = blockIdx.x; tile < ntiles; tile += gridDim.x) {
    const int pm = tile / nN, pn = tile - pm * nN;
    const bf16_t* Ag = g.A + (size_t)(pm * 256) * g.lda; const bf16_t* Wg = g.W + (size_t)(pn * 128) * g.ldw;
    f32x4 acc[4][4];
#pragma unroll
    for (int i = 0; i < 4; ++i)
#pragma unroll
      for (int j = 0; j < 4; ++j) acc[i][j] = (f32x4){0.f, 0.f, 0.f, 0.f};
    u32x4 ra[4], rb[2];
#pragma unroll
    for (int i = 0; i < 4; ++i) { const int c = tid + NTHR * i; ra[i] = *(const u32x4*)(Ag + (size_t)(c >> 3) * g.lda + (c & 7) * 8); }
#pragma unroll
    for (int i = 0; i < 2; ++i) { const int c = tid + NTHR * i; rb[i] = *(const u32x4*)(Wg + (size_t)(c >> 3) * g.ldw + (c & 7) * 8); }
    for (int kt = 0; kt < nk; ++kt) {
      __syncthreads();
#pragma unroll
      for (int i = 0; i < 4; ++i) { const int c = tid + NTHR * i; *(u32x4*)(As + (c >> 3) * LDT + (c & 7) * 8) = ra[i]; }
#pragma unroll
      for (int i = 0; i < 2; ++i) { const int c = tid + NTHR * i; *(u32x4*)(Bs + (c >> 3) * LDT + (c & 7) * 8) = rb[i]; }
      __syncthreads();
      if (kt + 1 < nk) { const int k0 = (kt + 1) * 64;
#pragma unroll
        for (int i = 0; i < 4; ++i) { const int c = tid + NTHR * i; ra[i] = *(const u32x4*)(Ag + (size_t)(c >> 3) * g.lda + k0 + (c & 7) * 8); }
#pragma unroll
        for (int i = 0; i < 2; ++i) { const int c = tid + NTHR * i; rb[i] = *(const u32x4*)(Wg + (size_t)(c >> 3) * g.ldw + k0 + (c & 7) * 8); } }
#pragma unroll
      for (int ks = 0; ks < 2; ++ks) {
        bf16x8 af[4], wf[4];
#pragma unroll
        for (int i = 0; i < 4; ++i) af[i] = *(const bf16x8*)(As + (wm * 64 + i * 16 + l16) * LDT + ks * 32 + g4 * 8);
#pragma unroll
        for (int j = 0; j < 4; ++j) wf[j] = *(const bf16x8*)(Bs + (wn * 64 + j * 16 + l16) * LDT + ks * 32 + g4 * 8);
#pragma unroll
        for (int i = 0; i < 4; ++i)
#pragma unroll
          for (int j = 0; j < 4; ++j) acc[i][j] = TRANS ? mfma16(af[i], wf[j], acc[i][j]) : mfma16(wf[j], af[i], acc[i][j]);
      }
    }
    const int mb = pm * 256 + wm * 64, nb = pn * 128 + wn * 64;
    if constexpr (Epi::PAIR) {
#pragma unroll
      for (int i = 0; i < 4; ++i)
#pragma unroll
        for (int j = 0; j < 2; ++j) epi.pair(mb + i * 16 + l16, (nb >> 1) + 16 * j + 4 * g4, acc[i][2 * j], acc[i][2 * j + 1]);
    } else {
#pragma unroll
      for (int i = 0; i < 4; ++i)
#pragma unroll
        for (int j = 0; j < 4; ++j) { if (TRANS) epi(mb + i * 16 + 4 * g4, nb + j * 16 + l16, acc[i][j]); else epi(mb + i * 16 + l16, nb + j * 16 + 4 * g4, acc[i][j]); }
    }
  }
}
DI void st4bf(bf16_t* p, f32x4 v) { u32x2 o; o.x = pk2(v[0], v[1]); o.y = pk2(v[2], v[3]); *(u32x2*)p = o; }
struct EpiStore { static constexpr bool PAIR = false; bf16_t* d0; bf16_t* d1; int split, ld0, ld1; float s0;
  DI void operator()(int m, int n, f32x4 v) const { if (n < split) st4bf(d0 + (size_t)m * ld0 + n, v * s0); else st4bf(d1 + (size_t)m * ld1 + (n - split), v); } };
struct EpiVT { static constexpr bool PAIR = false; bf16_t* vt; const float* rs;
  DI void operator()(int m, int n, f32x4 v) const { const int b = m / PB, pos = m - b * PB;
    if (rs) { v[0] *= rs[2 * m + 1]; v[1] *= rs[2 * m + 3]; v[2] *= rs[2 * m + 5]; v[3] *= rs[2 * m + 7]; }
    st4bf(vt + ((size_t)(b * 1024 + n)) * PB + pos, v); } };
struct EpiVTn { static constexpr bool PAIR = false; bf16_t* vt; const float* rs;
  DI void operator()(int m, int n, f32x4 v) const { const int b = m / PB, pos = m - b * PB; if (rs) v = v * rs[2 * m + 1];
    bf16_t* q = vt + (size_t)(b * 1024 + n) * PB + pos; q[0] = f2bf(v[0]); q[PB] = f2bf(v[1]); q[2 * (size_t)PB] = f2bf(v[2]); q[3 * (size_t)PB] = f2bf(v[3]); } };
struct EpiD0 { static constexpr bool PAIR = false; bf16_t* cq; bf16_t* ckv; bf16_t* kr;
  DI void operator()(int m, int n, f32x4 v) const { if (n < 512) st4bf(cq + (size_t)m * 512 + n, v); else if (n < 768) st4bf(ckv + (size_t)m * 256 + (n - 512), v); else if (n < 800) st4bf(kr + (size_t)m * 32 + (n - 768), v); } };
struct EpiResid { static constexpr bool PAIR = false; const float* slat; const float* sctx; float* dlat; float* dctx; const float* gate;
  const float2* lns; const float* lg; const float* lb;
  DI void operator()(int m, int n, f32x4 v) const { const int mv = modvec(m); f32x4 hv = *(const f32x4*)(hrowc(slat, sctx, m) + n); const f32x4 gt = *(const f32x4*)(gate + (size_t)mv * 6144 + n);
    if (lns) { const float2 st = lns[m]; hv = (hv - st.x) * st.y * *(const f32x4*)(lg + n) + *(const f32x4*)(lb + n); }
    *(f32x4*)(hrow(dlat, dctx, m) + n) = ALPHA * hv + gt * v; } };
constexpr int CLD = 264;
template <class Epi>
DI void ctx_gemm(const bf16_t* __restrict__ A, const bf16_t* __restrict__ W, int K, const Epi& epi, char* lds, int N = 1024) {
  const int tid = threadIdx.x, lane = tid & 63, w = tid >> 6, g4 = lane >> 4, l16 = lane & 15, wm = w & 3, wn = w >> 2;
  bf16_t* As = (bf16_t*)lds; bf16_t* Ws = As + 64 * CLD;
  const int nk = K / 256, per = N / 64;
  for (int tile = blockIdx.x; tile < 16 * per; tile += gridDim.x) {
    const int nt = tile % per, rem = tile / per, mt = rem & 3, b = rem >> 2;
    const size_t row0 = (size_t)b * PB + mt * 64;
    const bf16_t* Ag = A + row0 * K; const bf16_t* Wg = W + (size_t)(nt * 64) * K;
    u32x4 ra[4], rw[4], ra2[4], rw2[4];
    auto gl = [&](int kt, u32x4 (&xa)[4], u32x4 (&xw)[4]) { const int k0 = kt * 256;
#pragma unroll
      for (int i = 0; i < 4; ++i) { const int c = tid + NTHR * i, r = c >> 5, kc = c & 31; xa[i] = *(const u32x4*)(Ag + (size_t)r * K + k0 + kc * 8); xw[i] = *(const u32x4*)(Wg + (size_t)r * K + k0 + kc * 8); } };
    f32x4 acc[2] = {(f32x4){0.f, 0.f, 0.f, 0.f}, (f32x4){0.f, 0.f, 0.f, 0.f}};
    auto stepk = [&](int kt, u32x4 (&xa)[4], u32x4 (&xw)[4]) {
      __syncthreads();
#pragma unroll
      for (int i = 0; i < 4; ++i) { const int c = tid + NTHR * i, r = c >> 5, kc = c & 31; *(u32x4*)(As + r * CLD + kc * 8) = xa[i]; *(u32x4*)(Ws + r * CLD + kc * 8) = xw[i]; }
      __syncthreads();
      if (kt + 2 < nk) gl(kt + 2, xa, xw);
#pragma unroll
      for (int ks = 0; ks < 8; ++ks) {
        const bf16x8 af = *(const bf16x8*)(As + (wm * 16 + l16) * CLD + ks * 32 + g4 * 8);
        const bf16x8 w0 = *(const bf16x8*)(Ws + (wn * 32 + l16) * CLD + ks * 32 + g4 * 8), w1 = *(const bf16x8*)(Ws + (wn * 32 + 16 + l16) * CLD + ks * 32 + g4 * 8);
        acc[0] = mfma16(w0, af, acc[0]); acc[1] = mfma16(w1, af, acc[1]);
      } };
    gl(0, ra, rw); if (nk > 1) gl(1, ra2, rw2);
    for (int kt = 0; kt < nk; kt += 2) { stepk(kt, ra, rw); if (kt + 1 < nk) stepk(kt + 1, ra2, rw2); }
    const int m = (int)row0 + wm * 16 + l16, n = nt * 64 + wn * 32 + 4 * g4;
    epi(m, n, acc[0]); epi(m, n + 16, acc[1]);
  }
  __syncthreads();
}
struct EpiSwiglu { static constexpr bool PAIR = true; bf16_t* u;
  DI void pair(int m, int f, f32x4 gt, f32x4 up) const { f32x4 r; r[0] = siluf(gt[0]) * up[0]; r[1] = siluf(gt[1]) * up[1]; r[2] = siluf(gt[2]) * up[2]; r[3] = siluf(gt[3]) * up[3]; st4bf(u + (size_t)m * FF + f, r); } };
struct EpiRetQK { static constexpr bool PAIR = false; bf16_t* qk; const float2* tabR;
  DI void operator()(int m, int n, f32x4 v) const { const int b = m / PB, pp = m - b * PB;
    if (pp >= LC) { const int pos = pp - LC, row = pos >> 6, col = pos & 63; const int j0 = (n & 255) >> 1;
      const int vv = j0 < 64 ? row : col; const float2 c0 = tabR[vv * 64 + (j0 & 63)], c1 = tabR[vv * 64 + ((j0 + 1) & 63)];
      const float a0 = v[0] * c0.x - v[1] * c0.y, b0 = v[0] * c0.y + v[1] * c0.x, a1 = v[2] * c1.x - v[3] * c1.y, b1 = v[2] * c1.y + v[3] * c1.x; v = (f32x4){a0, b0, a1, b1}; }
    if (n >= 1024) v = v * 0.0625f;
    st4bf(qk + (size_t)m * 2048 + n, v); } };
struct EpiHg { static constexpr bool PAIR = false; bf16_t* ph;
  DI void operator()(int m, int n, f32x4 v) const { if (n < 1024) { v[0] = siluf(v[0]); v[1] = siluf(v[1]); v[2] = siluf(v[2]); v[3] = siluf(v[3]); v = v * 0.08838834764831845f; } st4bf(ph + (size_t)m * 5120 + n, v); } };
struct EpiMlaQ { static constexpr bool PAIR = false; bf16_t* q; const float* rs; const float2* tabM;
  DI void operator()(int m, int n, f32x4 v) const { v = v * (rs[2 * m] * 0.10206207261596577f * LOG2E); const int h = n / 96, w = n - h * 96; const int b = m / PB, pp = m - b * PB;
    if (w >= 64 && pp >= LC) { const int pos = pp - LC, row = pos >> 6, col = pos & 63; const int j0 = (w - 64) >> 1; const int vv = j0 < 8 ? row : col; const float2 c0 = tabM[vv * 8 + (j0 & 7)], c1 = tabM[vv * 8 + ((j0 + 1) & 7)];
      const float a0 = v[0] * c0.x - v[1] * c0.y, b0 = v[0] * c0.y + v[1] * c0.x, a1 = v[2] * c1.x - v[3] * c1.y, b1 = v[2] * c1.y + v[3] * c1.x; v = (f32x4){a0, b0, a1, b1}; }
    st4bf(q + (size_t)m * 1536 + n, v); } };
struct EpiMlaK { static constexpr bool PAIR = false; bf16_t* k; const float* rs;
  DI void operator()(int m, int n, f32x4 v) const { v = v * rs[2 * m + 1]; st4bf(k + (size_t)m * 1536 + (n >> 6) * 96 + (n & 63), v); } };

DI void mla_stats_phase(const Params& p) {
  const bf16_t* cqb = (const bf16_t*)(p.ws + M_D0); const bf16_t* ckvb = (const bf16_t*)(p.ws + M_CKV); const bf16_t* krb = (const bf16_t*)(p.ws + M_KR); bf16_t* km = (bf16_t*)(p.ws + M_K); float* rs = (float*)(p.ws + OFF_RS); const float2* tabM = (const float2*)(p.ws + OFF_TABM);
  const int tid = threadIdx.x, lane = tid & 63, gw = blockIdx.x * 8 + (tid >> 6), nw = gridDim.x * 8;
  for (int t = gw; t < T_ALL; t += nw) {
    const bf16_t* r = krb + (size_t)t * 32;
    const u32x4 a = *(const u32x4*)(cqb + (size_t)t * 512 + lane * 8); const u32x2 c = *(const u32x2*)(ckvb + (size_t)t * 256 + lane * 4);
    float sq = bflo(a.x) * bflo(a.x) + bfhi(a.x) * bfhi(a.x) + bflo(a.y) * bflo(a.y) + bfhi(a.y) * bfhi(a.y) + bflo(a.z) * bflo(a.z) + bfhi(a.z) * bfhi(a.z) + bflo(a.w) * bflo(a.w) + bfhi(a.w) * bfhi(a.w);
    float sk = bflo(c.x) * bflo(c.x) + bfhi(c.x) * bfhi(c.x) + bflo(c.y) * bflo(c.y) + bfhi(c.y) * bfhi(c.y);
#pragma unroll
    for (int o = 1; o < 64; o <<= 1) { sq += __shfl_xor(sq, o); sk += __shfl_xor(sk, o); }
    if (lane == 0) { rs[2 * t] = rsqrtf(sq * (1.f / 512.f) + 1e-6f); rs[2 * t + 1] = rsqrtf(sk * (1.f / 256.f) + 1e-6f); }
    if (lane < 16) { const int j = lane; float x1 = bf2f(r[j]), x2 = bf2f(r[16 + j]); const int b = t / PB, pp = t - b * PB;
      if (pp >= LC) { const int pos = pp - LC, row = pos >> 6, col = pos & 63; const float2 cs = tabM[(j < 8 ? row : col) * 8 + (j & 7)]; const float o1 = x1 * cs.x - x2 * cs.y, o2 = x1 * cs.y + x2 * cs.x; x1 = o1; x2 = o2; }
      const unsigned pr = pk2(x1, x2);
#pragma unroll
      for (int h = 0; h < 16; ++h) *(unsigned*)(km + (size_t)t * 1536 + h * 96 + 64 + 2 * j) = pr; }
  }
}

constexpr int KLD = 104, VLD = 72;
DI void mla_attn_phase(const Params& p, char* lds) {
  const bf16_t* Qm = (const bf16_t*)(p.ws + M_Q); const bf16_t* Km = (const bf16_t*)(p.ws + M_K); const bf16_t* vT = (const bf16_t*)(p.ws + M_VT); bf16_t* o = (bf16_t*)(p.ws + OFF_A);
  const int tid = threadIdx.x, lane = tid & 63, w = tid >> 6, c = lane & 31, hh = lane >> 5;
  constexpr int KB = 64 * KLD, VB = 64 * VLD;
  bf16_t* Ks = (bf16_t*)lds; bf16_t* Vs = Ks + 3 * KB;
  for (int item = blockIdx.x; item < 2048 + 64; item += gridDim.x) {
    int b, h, qbase, nkt;
    if (item < 2048) { b = item >> 9; h = (item >> 5) & 15; qbase = LC + (item & 31) * 256; nkt = 132; } else { const int it = item - 2048; b = it >> 4; h = it & 15; qbase = 0; nkt = 4; }
    const size_t tokbase = (size_t)b * PB;
    const bf16_t* qp = Qm + (tokbase + qbase + w * 32 + c) * 1536 + h * 96 + hh * 8;
    bf16x8 qf[6];
#pragma unroll
    for (int ks = 0; ks < 6; ++ks) qf[ks] = *(const bf16x8*)(qp + ks * 16);
    const bf16_t* kg = Km + tokbase * 1536 + h * 96; const bf16_t* vg = vT + (size_t)(b * 16 + h) * 64 * PB;
    const int kr0 = tid / 12, kc0 = tid - kr0 * 12, e1 = tid + NTHR, kr1 = e1 / 12, kc1 = e1 - kr1 * 12; const bool k1ok = e1 < 768; const int vd = tid >> 3, vc = tid & 7;
    u32x4 rk0, rk1 = (u32x4){0, 0, 0, 0}, rv;
    auto gload = [&](int t) { const size_t key0 = (size_t)t * 64;
      rk0 = *(const u32x4*)(kg + (key0 + kr0) * 1536 + kc0 * 8); if (k1ok) rk1 = *(const u32x4*)(kg + (key0 + kr1) * 1536 + kc1 * 8); rv = *(const u32x4*)(vg + (size_t)vd * PB + key0 + vc * 8); };
    auto lstore = [&](int buf) { bf16_t* Kn = Ks + buf * KB; bf16_t* Vn = Vs + buf * VB;
      *(u32x4*)(Kn + kr0 * KLD + kc0 * 8) = rk0; if (k1ok) *(u32x4*)(Kn + kr1 * KLD + kc1 * 8) = rk1; *(u32x4*)(Vn + vd * VLD + vc * 8) = rv; };
    f32x16 oacc[2];
#pragma unroll
    for (int i = 0; i < 16; ++i) { oacc[0][i] = 0.f; oacc[1][i] = 0.f; }
    float mrow = -1e30f, lsum = 0.f;
    auto qk = [&](int buf, f32x16 (&s)[2]) { const bf16_t* Kc = Ks + buf * KB;
#pragma unroll
      for (int j = 0; j < 2; ++j) {
#pragma unroll
        for (int i = 0; i < 16; ++i) s[j][i] = 0.f;
#pragma unroll
        for (int ks = 0; ks < 6; ++ks) { const bf16x8 kf = *(const bf16x8*)(Kc + (32 * j + c) * KLD + ks * 16 + hh * 8); s[j] = mfma32(kf, qf[ks], s[j]); }
      } };
    auto smpv = [&](int buf, f32x16 (&s)[2]) { const bf16_t* Vc = Vs + buf * VB;
      float mx = s[0][0];
#pragma unroll
      for (int j = 0; j < 2; ++j)
#pragma unroll
        for (int i = 0; i < 16; ++i) mx = fmaxf(mx, s[j][i]);
      if (__builtin_amdgcn_ballot_w64(mx > mrow + 8.f) != 0ull) {
        mx = fmaxf(mx, __shfl_xor(mx, 32));
        const float mnew = fmaxf(mrow, mx), alpha = __builtin_amdgcn_exp2f(mrow - mnew); mrow = mnew;
        lsum *= alpha;
#pragma unroll
        for (int i = 0; i < 16; ++i) { oacc[0][i] *= alpha; oacc[1][i] *= alpha; }
      }
      float ps0 = 0.f, ps1 = 0.f;
#pragma unroll
      for (int j = 0; j < 2; ++j)
#pragma unroll
        for (int i = 0; i < 16; i += 2) { s[j][i] = __builtin_amdgcn_exp2f(s[j][i] - mrow); ps0 += s[j][i]; s[j][i + 1] = __builtin_amdgcn_exp2f(s[j][i + 1] - mrow); ps1 += s[j][i + 1]; }
      lsum += ps0 + ps1;
#pragma unroll
      for (int j = 0; j < 2; ++j)
#pragma unroll
        for (int sx = 0; sx < 2; ++sx) {
          const bf16x8 pf = pack8(s[j][8 * sx], s[j][8 * sx + 1], s[j][8 * sx + 2], s[j][8 * sx + 3], s[j][8 * sx + 4], s[j][8 * sx + 5], s[j][8 * sx + 6], s[j][8 * sx + 7]);
#pragma unroll
          for (int dt = 0; dt < 2; ++dt) { const bf16_t* vp = Vc + (32 * dt + c) * VLD + 32 * j + 16 * sx + 4 * hh;
            const bf16x8 vf = cat44(*(const s16x4*)vp, *(const s16x4*)(vp + 8)); oacc[dt] = mfma32(vf, pf, oacc[dt]); }
        } };
    __syncthreads();
    gload(0); lstore(0); gload(1); lstore(1); if (nkt > 2) gload(2);
    __syncthreads();
    f32x16 sA[2], sB[2];
    qk(0, sA);
    int b0 = 0, b1 = 1, b2 = 2;
    for (int kt = 0; kt < nkt; kt += 2) {
      __syncthreads();
      if (kt + 2 < nkt) { lstore(b2); if (kt + 3 < nkt) gload(kt + 3); }
      qk(b1, sB);
      smpv(b0, sA);
      __syncthreads();
      if (kt + 3 < nkt) { lstore(b0); if (kt + 4 < nkt) gload(kt + 4); }
      if (kt + 2 < nkt) qk(b2, sA);
      smpv(b1, sB);
      { const int t0 = b0; b0 = b2; b2 = b1; b1 = t0; }
    }
    lsum += __shfl_xor(lsum, 32); const float inv = 1.f / lsum;
    bf16_t* op = o + (tokbase + qbase + w * 32 + c) * 1024 + h * 64 + 4 * hh;
#pragma unroll
    for (int dt = 0; dt < 2; ++dt)
#pragma unroll
      for (int rg = 0; rg < 4; ++rg) st4bf(op + 32 * dt + 8 * rg, (f32x4){oacc[dt][4 * rg] * inv, oacc[dt][4 * rg + 1] * inv, oacc[dt][4 * rg + 2] * inv, oacc[dt][4 * rg + 3] * inv});
  }
}

template <int N> DI void pin_frags(bf16x8 (&f)[N]) {
  if constexpr (N == 8) asm volatile("" : "+v"(f[0]), "+v"(f[1]), "+v"(f[2]), "+v"(f[3]), "+v"(f[4]), "+v"(f[5]), "+v"(f[6]), "+v"(f[7]));
  else if constexpr (N == 4) asm volatile("" : "+v"(f[0]), "+v"(f[1]), "+v"(f[2]), "+v"(f[3]));
  else if constexpr (N == 2) asm volatile("" : "+v"(f[0]), "+v"(f[1]));
}
constexpr int NKC = 72, NVC = 264;
constexpr int NWK = 72, NWV = 584;
constexpr int NA_OFF_VC = 256 * NKC * 2, NA_OFF_RPB = NA_OFF_VC + 64 * NVC * 2, NA_OFF_W = NA_OFF_RPB + 1920, NA_LDS = NA_OFF_W + 576 * NWK * 2;
static_assert(64 * NWV * 2 <= 576 * NWK * 2 && NA_OFF_W % 16 == 0, "NA window");
DI void na_ctx_wave(const bf16_t* __restrict__ Q, bf16_t* __restrict__ o, const bf16_t* Kc, const bf16_t* Vc, int b, int h, int qb, int lane) {
  const int g = lane >> 4, l16 = lane & 15; const size_t tokbase = (size_t)b * PB; const int qpos = qb * 16 + l16;
  const bf16_t* qp = Q + (tokbase + qpos) * 1024 + h * 64 + g * 8;
  const bf16x8 q0 = *(const bf16x8*)qp, q1 = *(const bf16x8*)(qp + 32);
  f32x4 S[16];
#pragma unroll
  for (int kt = 0; kt < 16; ++kt) { const bf16_t* kp = Kc + (16 * kt + l16) * NKC + g * 8;
    f32x4 s = mfma16(*(const bf16x8*)kp, q0, (f32x4){0.f, 0.f, 0.f, 0.f}); s = mfma16(*(const bf16x8*)(kp + 32), q1, s); S[kt] = s * LOG2E; }
  float mx = S[0][0];
#pragma unroll
  for (int kt = 0; kt < 16; ++kt) mx = fmaxf(fmaxf(fmaxf(mx, S[kt][0]), fmaxf(S[kt][1], S[kt][2])), S[kt][3]);
  mx = fmaxf(mx, __shfl_xor(mx, 16)); mx = fmaxf(mx, __shfl_xor(mx, 32));
  float ls = 0.f;
#pragma unroll
  for (int kt = 0; kt < 16; ++kt)
#pragma unroll
    for (int rr = 0; rr < 4; ++rr) { S[kt][rr] = __builtin_amdgcn_exp2f(S[kt][rr] - mx); ls += S[kt][rr]; }
  ls += __shfl_xor(ls, 16); ls += __shfl_xor(ls, 32);
  f32x4 O[4];
#pragma unroll
  for (int dt = 0; dt < 4; ++dt) O[dt] = (f32x4){0.f, 0.f, 0.f, 0.f};
#pragma unroll
  for (int kk = 0; kk < 8; ++kk) {
    const bf16x8 pf = pack8(S[2 * kk][0], S[2 * kk][1], S[2 * kk][2], S[2 * kk][3], S[2 * kk + 1][0], S[2 * kk + 1][1], S[2 * kk + 1][2], S[2 * kk + 1][3]);
#pragma unroll
    for (int dt = 0; dt < 4; ++dt) { const bf16_t* vp = Vc + (dt * 16 + l16) * NVC + 32 * kk + 4 * g; const bf16x8 vf = cat44(*(const s16x4*)vp, *(const s16x4*)(vp + 16)); O[dt] = mfma16(vf, pf, O[dt]); }
  }
  const float inv = 1.f / ls; bf16_t* op = o + (tokbase + qpos) * 1024 + h * 64 + 4 * g;
#pragma unroll
  for (int dt = 0; dt < 4; ++dt) st4bf(op + 16 * dt, O[dt] * inv);
}
DI void na_attn_phase(const Params& p, char* lds) {
  const bf16_t* Q = (const bf16_t*)(p.ws + N_Q); const bf16_t* K = (const bf16_t*)(p.ws + N_K); const bf16_t* vT = (const bf16_t*)(p.ws + N_VT); bf16_t* o = (bf16_t*)(p.ws + OFF_A);
  bf16_t* Kc = (bf16_t*)lds; bf16_t* Vc = (bf16_t*)(lds + NA_OFF_VC); float* rl = (float*)(lds + NA_OFF_RPB); bf16_t* W = (bf16_t*)(lds + NA_OFF_W);
  const int tid = threadIdx.x, lane = tid & 63, w = tid >> 6, g = lane >> 4, l16 = lane & 15;
  for (int item = blockIdx.x; item < 256; item += gridDim.x) {
    const int qtr = item & 3, h = (item >> 2) & 15, b = item >> 6; const size_t tokbase = (size_t)b * PB;
    const bf16_t* kbase = K + (tokbase + LC) * 1024 + h * 64; const bf16_t* vbase = vT + (size_t)(b * 16 + h) * 64 * PB + LC;
    __syncthreads();
#pragma unroll
    for (int i = 0; i < 4; ++i) { const int e = tid + NTHR * i; const int key = e >> 3, kc = e & 7; *(u32x4*)(Kc + key * NKC + kc * 8) = *(const u32x4*)(K + (tokbase + key) * 1024 + h * 64 + kc * 8); }
#pragma unroll
    for (int i = 0; i < 4; ++i) { const int e = tid + NTHR * i; const int d = e >> 5, pc = e & 31; *(u32x4*)(Vc + d * NVC + pc * 8) = *(const u32x4*)(vT + ((size_t)(b * 16 + h) * 64 + d) * PB + pc * 8); }
    for (int e = tid; e < 465; e += NTHR) rl[e] = p.na_rpb[h * 465 + e];
    u32x4 rw[9];
#pragma unroll 1
    for (int j = 0; j < 16; ++j) {
      int ln = lane, tt = tid; asm volatile("" : "+v"(ln), "+v"(tt)); const int gg = ln >> 4, ll = ln & 15;
      const int r0 = qtr * 32 + 2 * j, rs0 = clampi(r0 - 4, 0, 120), r = r0 + (w >> 2), n = w & 3, rs = clampi(r - 4, 0, 120), dr = rs - rs0, band0 = clampi(16 * n - 8, 0, 32);
      const int qpos = LC + r * 64 + n * 16 + ll;
#pragma unroll
      for (int i = 0; i < 9; ++i) { const int e = tt + NTHR * i; rw[i] = *(const u32x4*)(kbase + (size_t)(rs0 * 64 + (e >> 3)) * 1024 + (e & 7) * 8); }
      __syncthreads();
#pragma unroll
      for (int i = 0; i < 9; ++i) { const int e = tt + NTHR * i; *(u32x4*)(W + (e >> 3) * NWK + (e & 7) * 8) = rw[i]; }
      __syncthreads();
      const bf16_t* qp = Q + (tokbase + qpos) * 1024 + h * 64 + gg * 8;
      const bf16x8 q0 = *(const bf16x8*)qp, q1 = *(const bf16x8*)(qp + 32);
      f32x4 S[32];
#pragma unroll
      for (int kg = 0; kg < 8; ++kg) {
        bf16x8 ka[4], kb[4];
#pragma unroll
        for (int u = 0; u < 4; ++u) { const int kt = 4 * kg + u;
          const bf16_t* kp = kt < 16 ? W + ((dr + (kt >> 1)) * 64 + band0 + 16 * (kt & 1) + ll) * NWK + gg * 8 : Kc + (16 * (kt - 16) + ll) * NKC + gg * 8;
          ka[u] = *(const bf16x8*)kp; kb[u] = *(const bf16x8*)(kp + 32); }
        pin_frags(ka); pin_frags(kb);
#pragma unroll
        for (int u = 0; u < 4; ++u) { const int kt = 4 * kg + u;
          f32x4 s = mfma16(ka[u], q0, (f32x4){0.f, 0.f, 0.f, 0.f}); s = mfma16(kb[u], q1, s);
          if (kt < 16) {
            const int qcol = 16 * n + ll, wstart = clampi(qcol - 8, 0, 48); const float* bp = rl + (rs + (kt >> 1) - r + 7) * 31;
#pragma unroll
            for (int rr = 0; rr < 4; ++rr) { const int kcol = band0 + 16 * (kt & 1) + 4 * gg + rr; const bool ok = kcol >= wstart && kcol < wstart + 16;
              s[rr] = ok ? (s[rr] + bp[clampi(kcol - qcol + 15, 0, 30)]) * LOG2E : -1e30f; }
          } else s = s * LOG2E;
          S[kt] = s; }
      }
      float mx = S[0][0];
#pragma unroll
      for (int kt = 0; kt < 32; ++kt) mx = fmaxf(fmaxf(fmaxf(mx, S[kt][0]), fmaxf(S[kt][1], S[kt][2])), S[kt][3]);
      mx = fmaxf(mx, __shfl_xor(mx, 16)); mx = fmaxf(mx, __shfl_xor(mx, 32));
      float ls = 0.f;
#pragma unroll
      for (int kt = 0; kt < 32; ++kt)
#pragma unroll
        for (int rr = 0; rr < 4; ++rr) { S[kt][rr] = __builtin_amdgcn_exp2f(S[kt][rr] - mx); ls += S[kt][rr]; }
      ls += __shfl_xor(ls, 16); ls += __shfl_xor(ls, 32);
      bf16x8 pf[16];
#pragma unroll
      for (int kk = 0; kk < 16; ++kk) pf[kk] = pack8(S[2 * kk][0], S[2 * kk][1], S[2 * kk][2], S[2 * kk][3], S[2 * kk + 1][0], S[2 * kk + 1][1], S[2 * kk + 1][2], S[2 * kk + 1][3]);
#pragma unroll
      for (int i = 0; i < 9; ++i) { const int e = tt + NTHR * i, d = e / 72, pc = e - d * 72; rw[i] = *(const u32x4*)(vbase + (size_t)d * PB + rs0 * 64 + pc * 8); }
      __syncthreads();
#pragma unroll
      for (int i = 0; i < 9; ++i) { const int e = tt + NTHR * i, d = e / 72, pc = e - d * 72; *(u32x4*)(W + d * NWV + pc * 8) = rw[i]; }
      __syncthreads();
      f32x4 O[4];
#pragma unroll
      for (int dt = 0; dt < 4; ++dt) O[dt] = (f32x4){0.f, 0.f, 0.f, 0.f};
#pragma unroll
      for (int kk = 0; kk < 16; ++kk) {
        bf16x8 vf[4];
#pragma unroll
        for (int dt = 0; dt < 4; ++dt) { const bf16_t* vp = kk < 8 ? W + (dt * 16 + ll) * NWV + (dr + kk) * 64 + band0 + 4 * gg : Vc + (dt * 16 + ll) * NVC + 32 * (kk - 8) + 4 * gg;
          vf[dt] = cat44(*(const s16x4*)vp, *(const s16x4*)(vp + 16)); }
        pin_frags(vf);
#pragma unroll
        for (int dt = 0; dt < 4; ++dt) O[dt] = mfma16(vf[dt], pf[kk], O[dt]);
      }
      const float inv = 1.f / ls; bf16_t* op = o + (tokbase + qpos) * 1024 + h * 64 + 4 * gg;
#pragma unroll
      for (int dt = 0; dt < 4; ++dt) st4bf(op + 16 * dt, O[dt] * inv);
    }
    if (w < 4) na_ctx_wave(Q, o, Kc, Vc, b, h, qtr * 4 + w, lane);
  }
}

template <int DK> struct ScanLds { static constexpr int QLD = DK + 8, TLD = 72;
  static constexpr int OFF_QD = 0, OFF_KD = OFF_QD + 64 * QLD * 2, OFF_VT = OFF_KD + 64 * QLD * 2, OFF_ATT = OFF_VT + 64 * TLD * 2, OFF_ST = OFF_ATT + 64 * TLD * 2, OFF_EB = OFF_ST + 64 * QLD * 2, OFF_QS = OFF_EB + DK * 4, TOTAL = OFF_QS + 8 * DK * 4; };
DI int scan_pos(int dir, int i, int tl) { if (dir == 0) return i * 64 + tl; return i < 4 ? 255 - (i * 64 + tl) : 8447 - ((i - 4) * 64 + tl); }
DI bf16x8 gather8(const bf16_t* p, int stride) {
  const unsigned a0 = p[0], a1 = p[stride], a2 = p[2 * stride], a3 = p[3 * stride], a4 = p[4 * stride], a5 = p[5 * stride], a6 = p[6 * stride], a7 = p[7 * stride];
  u32x4 r; r.x = a0 | (a1 << 16); r.y = a2 | (a3 << 16); r.z = a4 | (a5 << 16); r.w = a6 | (a7 << 16); return __builtin_bit_cast(bf16x8, r);
}

template <int DK, bool HG, int DVS>
DI void scan_phase(const Params& p, char* lds) {
  typedef ScanLds<DK> L;
  bf16_t* Qd = (bf16_t*)(lds + L::OFF_QD); bf16_t* Kd = (bf16_t*)(lds + L::OFF_KD); bf16_t* Vt = (bf16_t*)(lds + L::OFF_VT);
  bf16_t* Att = (bf16_t*)(lds + L::OFF_ATT); bf16_t* St = (bf16_t*)(lds + L::OFF_ST); float* eb = (float*)(lds + L::OFF_EB); float* qs = (float*)(lds + L::OFF_QS);
  constexpr int QLD = L::QLD, TLD = L::TLD, KT = DK / 16 / 8;
  const int tid = tid_(), lane = tid & 63, w = tid >> 6, g4 = lane >> 4, l16 = lane & 15;
  const int nitems = 256; constexpr int NVI = DVS / 16, NTO = NVI * 4 / 8;
  const float* lbv = (const float*)(p.ws + OFF_LBV);
  for (int item = blockIdx.x; item < nitems; item += gridDim.x) {
    const int xcd = item & 7, yy = item >> 3; int b, h, sl, dir;
    if (HG) { const int grp = xcd * 8 + (yy >> 2); sl = yy & 3; h = grp & 7; b = (grp >> 3) & 3; dir = grp >> 5; }
    else { const int grp = xcd * 4 + (yy >> 3); sl = yy & 7; h = grp & 3; b = (grp >> 2) & 3; dir = grp >> 4; }
    const size_t tokbase = (size_t)b * PB;
    const bf16_t *qsrc, *ksrc, *vsrc; int ldq, ldv; bf16_t *octx, *olat; int ldo;
    if (HG) { const bf16_t* ph = (const bf16_t*)(p.ws + H_P); qsrc = ph + h * 128; ksrc = ph + 1024 + dir * 1024 + h * 128; vsrc = ph + 3072 + h * 128 + sl * DVS; ldq = 5120; ldv = 5120; ldo = 1024;
      octx = (bf16_t*)(p.ws + (dir ? OFF_W0 : OFF_A)) + tokbase * 1024 + h * 128 + sl * DVS; olat = octx + (size_t)LC * 1024; }
    else { const bf16_t* qk = (const bf16_t*)(p.ws + R_QK); qsrc = qk + h * 256; ksrc = qk + 1024 + h * 256; vsrc = (const bf16_t*)(p.ws + R_V) + h * 512 + sl * 64; ldq = 2048; ldv = 2048; ldo = 2048;
      if (dir == 0) { octx = (bf16_t*)(p.ws + R_O) + tokbase * 2048 + h * 512 + sl * 64; olat = octx + (size_t)LC * 2048; }
      else { octx = (bf16_t*)(p.ws + OFF_HCTX) + (size_t)b * LC * 2048 + h * 512 + sl * 64; olat = (bf16_t*)p.out + (size_t)b * LL * 2048 + h * 512 + sl * 64; } }
    float lg = 0.f; if (!HG) lg = -__expf(p.ret_decay[dir * 4 + h]);
    float lb0 = 0.f, lb1 = 0.f; if (HG) { lb0 = lbv[h * 128 + 2 * (tid & 63)]; lb1 = lbv[h * 128 + 2 * (tid & 63) + 1]; }
    f32x4 sacc[KT][NVI];
#pragma unroll
    for (int a = 0; a < KT; ++a)
#pragma unroll
      for (int v = 0; v < NVI; ++v) sacc[a][v] = (f32x4){0.f, 0.f, 0.f, 0.f};
    u32x4 rq[4], rk[4], rvv; unsigned rf[8], rqq[8]; float bl[16], qv[16], kv[16];
    const int vtl = tid & 63, vvc = tid >> 6;
    auto issue = [&](int i) {
      if (HG) { const int kp = tid & 63, seg = tid >> 6;
#pragma unroll
        for (int j = 0; j < 8; ++j) { const size_t row = tokbase + scan_pos(dir, i, seg * 8 + j); rf[j] = *(const unsigned*)(ksrc + row * ldq + 2 * kp); rqq[j] = *(const unsigned*)(qsrc + row * ldq + 2 * kp); } }
      else {
#pragma unroll
        for (int it = 0; it < 4; ++it) { const int e = tid + NTHR * it, tl = e >> 5, kc = e & 31; const size_t row = tokbase + scan_pos(dir, i, tl); rq[it] = *(const u32x4*)(qsrc + row * ldq + kc * 8); rk[it] = *(const u32x4*)(ksrc + row * ldq + kc * 8); } }
      if (vvc < DVS / 8) { const size_t row = tokbase + scan_pos(dir, i, vtl); rvv = *(const u32x4*)(vsrc + row * ldv + vvc * 8); }
    };
    auto prep = [&]() {
      const int kp = tid & 63, seg = tid >> 6; float run0 = 1.f, run1 = 1.f;
#pragma unroll
      for (int j = 0; j < 8; ++j) { const float f0 = bflo(rf[j]), f1 = bfhi(rf[j]); qv[2 * j] = bflo(rqq[j]); qv[2 * j + 1] = bfhi(rqq[j]);
        const float s0 = __builtin_amdgcn_rcpf(1.f + __expf(-f0)), s1 = __builtin_amdgcn_rcpf(1.f + __expf(-f1)); const float g0 = lb0 + (1.f - lb0) * s0, g1 = lb1 + (1.f - lb1) * s1;
        kv[2 * j] = 1.f - g0; kv[2 * j + 1] = 1.f - g1; run0 *= g0; run1 *= g1; bl[2 * j] = run0; bl[2 * j + 1] = run1; }
      qs[seg * DK + 2 * kp] = run0; qs[seg * DK + 2 * kp + 1] = run1;
    };
    __syncthreads();
    issue(0); if (HG) prep();
    __syncthreads();
    for (int i = 0; i < 132; ++i) {
      if (HG) { const int kp = tid & 63, seg = tid >> 6; float off0 = 1.f, off1 = 1.f;
#pragma unroll
        for (int q = 0; q < 7; ++q) if (q < seg) { off0 *= qs[q * DK + 2 * kp]; off1 *= qs[q * DK + 2 * kp + 1]; }
        if (seg == 7) { eb[2 * kp] = off0 * bl[14]; eb[2 * kp + 1] = off1 * bl[15]; }
#pragma unroll
        for (int j = 0; j < 8; ++j) { const int tl = seg * 8 + j; const float p0 = bl[2 * j] * off0, p1 = bl[2 * j + 1] * off1;
          *(unsigned*)(Qd + tl * QLD + 2 * kp) = pk2(qv[2 * j] * p0, qv[2 * j + 1] * p1);
          *(unsigned*)(Kd + tl * QLD + 2 * kp) = pk2(kv[2 * j] * __builtin_amdgcn_rcpf(p0), kv[2 * j + 1] * __builtin_amdgcn_rcpf(p1)); } }
      else {
        if (tid < DK) eb[tid] = __expf(64.f * lg);
#pragma unroll
        for (int it = 0; it < 4; ++it) { const int e = tid + NTHR * it, tl = e >> 5, kc = e & 31; const u32x4 qr = rq[it], kr = rk[it];
          const float eq = __expf((float)(tl + 1) * lg), ek = __expf(-(float)(tl + 1) * lg);
          u32x4 qo, ko; qo.x = pk2(bflo(qr.x) * eq, bfhi(qr.x) * eq); qo.y = pk2(bflo(qr.y) * eq, bfhi(qr.y) * eq); qo.z = pk2(bflo(qr.z) * eq, bfhi(qr.z) * eq); qo.w = pk2(bflo(qr.w) * eq, bfhi(qr.w) * eq);
          ko.x = pk2(bflo(kr.x) * ek, bfhi(kr.x) * ek); ko.y = pk2(bflo(kr.y) * ek, bfhi(kr.y) * ek); ko.z = pk2(bflo(kr.z) * ek, bfhi(kr.z) * ek); ko.w = pk2(bflo(kr.w) * ek, bfhi(kr.w) * ek);
          *(u32x4*)(Qd + tl * QLD + kc * 8) = qo; *(u32x4*)(Kd + tl * QLD + kc * 8) = ko; } }
      if (vvc < DVS / 8) { bf16_t* vt = Vt + (vvc * 8) * TLD + vtl; const u32x4 vr = rvv;
        vt[0] = (bf16_t)(vr.x & 0xffff); vt[TLD] = (bf16_t)(vr.x >> 16); vt[2 * TLD] = (bf16_t)(vr.y & 0xffff); vt[3 * TLD] = (bf16_t)(vr.y >> 16);
        vt[4 * TLD] = (bf16_t)(vr.z & 0xffff); vt[5 * TLD] = (bf16_t)(vr.z >> 16); vt[6 * TLD] = (bf16_t)(vr.w & 0xffff); vt[7 * TLD] = (bf16_t)(vr.w >> 16); }
#pragma unroll
      for (int a = 0; a < KT; ++a) { const int ki = w * KT + a;
#pragma unroll
        for (int vi = 0; vi < NVI; ++vi) st4bf(St + (16 * vi + l16) * QLD + 16 * ki + 4 * g4, sacc[a][vi]); }
      __syncthreads();
      if (i + 1 < 132) issue(i + 1);
      { const int ti = w >> 1;
        bf16x8 qf[DK / 32];
#pragma unroll
        for (int ks = 0; ks < DK / 32; ++ks) qf[ks] = *(const bf16x8*)(Qd + (16 * ti + l16) * QLD + ks * 32 + g4 * 8);
#pragma unroll
        for (int u = 0; u < 2; ++u) { const int si = (2 * w + u) & 3; f32x4 d = (f32x4){0.f, 0.f, 0.f, 0.f};
          if (si <= ti) { bf16x8 kf[DK / 32];
#pragma unroll
            for (int ks = 0; ks < DK / 32; ++ks) kf[ks] = *(const bf16x8*)(Kd + (16 * si + l16) * QLD + ks * 32 + g4 * 8);
            pin_frags(kf);
#pragma unroll
            for (int ks = 0; ks < DK / 32; ++ks) d = mfma16(kf[ks], qf[ks], d); }
          const int t = 16 * ti + l16, s0 = 16 * si + 4 * g4;
#pragma unroll
          for (int rr = 0; rr < 4; ++rr) if (s0 + rr > t) d[rr] = 0.f;
          st4bf(Att + t * TLD + s0, d); } }
      __syncthreads();
      { const int vi = (NTO * w) >> 2;
        bf16x8 xv[2], xs[DK / 32];
#pragma unroll
        for (int ks = 0; ks < 2; ++ks) xv[ks] = *(const bf16x8*)(Vt + (16 * vi + l16) * TLD + ks * 32 + g4 * 8);
#pragma unroll
        for (int ks = 0; ks < DK / 32; ++ks) xs[ks] = *(const bf16x8*)(St + (16 * vi + l16) * QLD + ks * 32 + g4 * 8);
        pin_frags(xv); pin_frags(xs);
#pragma unroll
        for (int u = 0; u < NTO; ++u) { const int ti = (NTO * w + u) & 3; bf16x8 ya[2], yq[DK / 32];
#pragma unroll
          for (int ks = 0; ks < 2; ++ks) ya[ks] = *(const bf16x8*)(Att + (16 * ti + l16) * TLD + ks * 32 + g4 * 8);
#pragma unroll
          for (int ks = 0; ks < DK / 32; ++ks) yq[ks] = *(const bf16x8*)(Qd + (16 * ti + l16) * QLD + ks * 32 + g4 * 8);
          pin_frags(ya); pin_frags(yq);
          f32x4 d = (f32x4){0.f, 0.f, 0.f, 0.f};
#pragma unroll
          for (int ks = 0; ks < 2; ++ks) d = mfma16(xv[ks], ya[ks], d);
#pragma unroll
          for (int ks = 0; ks < DK / 32; ++ks) d = mfma16(xs[ks], yq[ks], d);
          const int pos = scan_pos(dir, i, 16 * ti + l16); bf16_t* op = (pos < LC ? octx + (size_t)pos * ldo : olat + (size_t)(pos - LC) * ldo) + 16 * vi + 4 * g4;
          st4bf(op, d); } }
      { bf16x8 yv[NVI][2];
#pragma unroll
        for (int vi = 0; vi < NVI; ++vi)
#pragma unroll
          for (int ks = 0; ks < 2; ++ks) yv[vi][ks] = *(const bf16x8*)(Vt + (16 * vi + l16) * TLD + ks * 32 + g4 * 8);
#pragma unroll
        for (int a = 0; a < KT; ++a) { const int ki = w * KT + a; bf16x8 xf[2];
#pragma unroll
          for (int ks = 0; ks < 2; ++ks) xf[ks] = gather8(Kd + (ks * 32 + g4 * 8) * QLD + 16 * ki + l16, QLD);
#pragma unroll
          for (int ks = 0; ks < 2; ++ks)
#pragma unroll
            for (int vi = 0; vi < NVI; ++vi) sacc[a][vi] = mfma16(xf[ks], yv[vi][ks], sacc[a][vi]);
          const f32x4 e4 = *(const f32x4*)(eb + 16 * ki + 4 * g4);
#pragma unroll
          for (int vi = 0; vi < NVI; ++vi) sacc[a][vi] = sacc[a][vi] * e4; } }
      if (HG && i + 1 < 132) prep();
      __syncthreads();
    }
  }
}

DI float bsum2(unsigned a, unsigned b, float& lo, float& hi) { lo = bflo(a) + bflo(b); hi = bfhi(a) + bfhi(b); return lo * lo + hi * hi; }
DI void ret_readout_phase(const Params& p) {
  bf16_t* O = (bf16_t*)(p.ws + R_O); const bf16_t* G = (const bf16_t*)(p.ws + R_QK);
  const int tid = threadIdx.x, lane = tid & 63, gw = blockIdx.x * 8 + (tid >> 6), nw = gridDim.x * 8;
  for (int t = gw; t < T_ALL; t += nw) {
    const int b = t / PB, pp = t - b * PB;
    const bf16_t* ob = (pp < LC ? (const bf16_t*)(p.ws + OFF_HCTX) + (size_t)(b * LC + pp) * 2048 : (const bf16_t*)p.out + (size_t)(b * LL + pp - LC) * 2048) + lane * 32;
    bf16_t* op = O + (size_t)t * 2048 + lane * 32; const bf16_t* gp = G + (size_t)t * 2048 + lane * 32;
    float ov[32]; u32x4 gv[4]; float sq = 0.f;
#pragma unroll
    for (int i = 0; i < 4; ++i) { const u32x4 x = *(const u32x4*)(op + i * 8), y = *(const u32x4*)(ob + i * 8); gv[i] = *(const u32x4*)(gp + i * 8);
      sq += bsum2(x.x, y.x, ov[8 * i], ov[8 * i + 1]) + bsum2(x.y, y.y, ov[8 * i + 2], ov[8 * i + 3]) + bsum2(x.z, y.z, ov[8 * i + 4], ov[8 * i + 5]) + bsum2(x.w, y.w, ov[8 * i + 6], ov[8 * i + 7]); }
    sq += __shfl_xor(sq, 1); sq += __shfl_xor(sq, 2); sq += __shfl_xor(sq, 4); sq += __shfl_xor(sq, 8);
    const float rstd = rsqrtf(sq * (1.f / 512.f) + 1e-6f);
#pragma unroll
    for (int i = 0; i < 4; ++i) { u32x4 r;
      r.x = pk2(siluf(bflo(gv[i].x)) * ov[8 * i] * rstd, siluf(bfhi(gv[i].x)) * ov[8 * i + 1] * rstd); r.y = pk2(siluf(bflo(gv[i].y)) * ov[8 * i + 2] * rstd, siluf(bfhi(gv[i].y)) * ov[8 * i + 3] * rstd);
      r.z = pk2(siluf(bflo(gv[i].z)) * ov[8 * i + 4] * rstd, siluf(bfhi(gv[i].z)) * ov[8 * i + 5] * rstd); r.w = pk2(siluf(bflo(gv[i].w)) * ov[8 * i + 6] * rstd, siluf(bfhi(gv[i].w)) * ov[8 * i + 7] * rstd);
      *(u32x4*)(op + i * 8) = r; }
  }
}
DI void hg_readout_phase(const Params& p) {
  bf16_t* O = (bf16_t*)(p.ws + OFF_A); const bf16_t* OB = (const bf16_t*)(p.ws + OFF_W0); const bf16_t* ph = (const bf16_t*)(p.ws + H_P);
  const int tid = threadIdx.x, lane = tid & 63, gw = blockIdx.x * 8 + (tid >> 6), nw = gridDim.x * 8;
  for (int t = gw; t < T_ALL; t += nw) {
    bf16_t* op = O + (size_t)t * 1024 + lane * 16; const bf16_t* ob = OB + (size_t)t * 1024 + lane * 16; const bf16_t* gp = ph + (size_t)t * 5120 + 4096 + lane * 16; const float* ng = p.hg_norm_g + (lane & 7) * 16;
    float ov[16]; u32x4 gv[2]; float sq = 0.f;
#pragma unroll
    for (int i = 0; i < 2; ++i) { const u32x4 x = *(const u32x4*)(op + i * 8), y = *(const u32x4*)(ob + i * 8); gv[i] = *(const u32x4*)(gp + i * 8);
      sq += bsum2(x.x, y.x, ov[8 * i], ov[8 * i + 1]) + bsum2(x.y, y.y, ov[8 * i + 2], ov[8 * i + 3]) + bsum2(x.z, y.z, ov[8 * i + 4], ov[8 * i + 5]) + bsum2(x.w, y.w, ov[8 * i + 6], ov[8 * i + 7]); }
    sq += __shfl_xor(sq, 1); sq += __shfl_xor(sq, 2); sq += __shfl_xor(sq, 4);
    const float rstd = rsqrtf(sq * (1.f / 128.f) + 1e-6f);
#pragma unroll
    for (int i = 0; i < 2; ++i) { u32x4 r; const float* n8 = ng + i * 8;
      r.x = pk2(siluf(bflo(gv[i].x)) * ov[8 * i] * rstd * n8[0], siluf(bfhi(gv[i].x)) * ov[8 * i + 1] * rstd * n8[1]); r.y = pk2(siluf(bflo(gv[i].y)) * ov[8 * i + 2] * rstd * n8[2], siluf(bfhi(gv[i].y)) * ov[8 * i + 3] * rstd * n8[3]);
      r.z = pk2(siluf(bflo(gv[i].z)) * ov[8 * i + 4] * rstd * n8[4], siluf(bfhi(gv[i].z)) * ov[8 * i + 5] * rstd * n8[5]); r.w = pk2(siluf(bflo(gv[i].w)) * ov[8 * i + 6] * rstd * n8[6], siluf(bfhi(gv[i].w)) * ov[8 * i + 7] * rstd * n8[7]);
      *(u32x4*)(op + i * 8) = r; }
  }
}

#define XB_TMO      128
#define XB_XCNT(j)  (256  + 64 * (j))
#define XB_XSUB(j)  (1280 + 64 * (j))
#define XB_XGEN(j)  (2304 + 64 * (j))
#define XB_TOP      3328
#define XB_TOPGEN   3392
#define XCD_BAR_WORDS 3456
#define XB_SPIN_CAP (1u << 23)
#define LAS PG8_LAS

__device__ __forceinline__ unsigned xb_ld(unsigned* p)              { return __hip_atomic_load(p, __ATOMIC_RELAXED, __HIP_MEMORY_SCOPE_AGENT); }
__device__ __forceinline__ unsigned xb_add(unsigned* p, unsigned v) { return __hip_atomic_fetch_add(p, v, __ATOMIC_RELAXED, __HIP_MEMORY_SCOPE_AGENT); }
__device__ __forceinline__ unsigned xb_xcc_id() { return (unsigned)__builtin_amdgcn_s_getreg((3 << 11) | 20) & 0xFu; }
#define XB_SPIN(cond, bar) do { unsigned _sp = 0; while (cond) { __builtin_amdgcn_s_sleep(1); \
    if ((++_sp & 255u) == 0u) { if (xb_ld(&(bar)[XB_TMO])) break; if (_sp > XB_SPIN_CAP) { atomicAdd(&(bar)[XB_TMO], 1u); break; } } } } while (0)

struct XcdBarrier {
    unsigned* bar; unsigned x;
    volatile LAS unsigned* st;
};

__device__ __forceinline__ XcdBarrier xcd_barrier_post(unsigned* bar, volatile LAS unsigned* st) {
    XcdBarrier b; b.bar = bar; b.x = xb_xcc_id(); b.st = st;
    if (threadIdx.x == 0) (void)xb_add(&bar[XB_XCNT(b.x)], 1u);
    return b;
}
__device__ __forceinline__ void xcd_barrier_complete(unsigned* bar, unsigned x, unsigned& nloc, unsigned& nx) {
    const unsigned G = gridDim.x * gridDim.y * gridDim.z;
    unsigned sum, cnt, mine, sp = 0u;
    for (;;) {
        sum = 0u; cnt = 0u; mine = 0u;
#pragma unroll
        for (unsigned j = 0; j < 16; ++j) { const unsigned c = xb_ld(&bar[XB_XCNT(j)]); sum += c; cnt += (c > 0u) ? 1u : 0u; mine = (j == x) ? c : mine; }
        if (sum == G) break;
        __builtin_amdgcn_s_sleep(1);
        if ((++sp & 255u) == 0u) { if (xb_ld(&bar[XB_TMO])) break; if (sp > XB_SPIN_CAP) { atomicAdd(&bar[XB_TMO], 1u); break; } }
    }
    nloc = mine > 0u ? mine : 1u; nx = cnt > 0u ? cnt : 1u;
}

__device__ __forceinline__ void xcd_barrier(const XcdBarrier& b) {
    asm volatile("s_waitcnt vmcnt(0)" ::: "memory");
    __syncthreads();
    if (threadIdx.x == 0) {
        unsigned* bar = b.bar;
        __builtin_amdgcn_s_waitcnt(0);
        unsigned nloc = b.st[0], nx = b.st[1];
        if (nloc == 0u) { xcd_barrier_complete(bar, b.x, nloc, nx); b.st[0] = nloc; b.st[1] = nx; }
        const unsigned old = xb_add(&bar[XB_XSUB(b.x)], 1u);
        const unsigned gen = old / nloc;
        if (old + 1u == (gen + 1u) * nloc) {
            __builtin_amdgcn_fence(__ATOMIC_RELEASE, "agent");
            asm volatile("s_waitcnt vmcnt(0)" ::: "memory");
            const unsigned og = xb_add(&bar[XB_TOP], 1u);
            const unsigned tg = og / nx;
            if (og + 1u == (tg + 1u) * nx) xb_add(&bar[XB_TOPGEN], 1u);
            else XB_SPIN(xb_ld(&bar[XB_TOPGEN]) == tg, bar);
            __builtin_amdgcn_fence(__ATOMIC_ACQUIRE, "agent");
            xb_add(&bar[XB_XGEN(b.x)], 1u);
            asm volatile("s_waitcnt vmcnt(0)" ::: "memory");
        } else {
            XB_SPIN(xb_ld(&bar[XB_XGEN(b.x)]) == gen, bar);
            __builtin_amdgcn_fence(__ATOMIC_ACQUIRE, "agent");
            asm volatile("s_waitcnt vmcnt(0)" ::: "memory");
        }
    }
    __syncthreads();
}

constexpr int LDS_BYTES0 = ScanLds<256>::TOTAL > pg8::STAGE_BYTES ? ScanLds<256>::TOTAL : pg8::STAGE_BYTES;
constexpr int LDS_BYTES = LDS_BYTES0 > NA_LDS ? LDS_BYTES0 : NA_LDS;
static_assert(LDS_BYTES <= 163840, "LDS");
static_assert(LDS_BYTES >= (256 + 128) * LDT * 2 && LDS_BYTES >= 3 * 64 * (KLD + VLD) * 2 && LDS_BYTES >= (5120 + 8 * 5 * 64) * 4, "LDS phases");

DI void ffn_and_ln(const Params& p, const XcdBarrier& xb, char* lds, int layer, const bf16_t* w13, const bf16_t* w2) {
  const float* mods = (const float*)(p.ws + OFF_MODS); float* hctx = (float*)(p.ws + OFF_HCTX); bf16_t* a = (bf16_t*)(p.ws + OFF_A); bf16_t* U = (bf16_t*)(p.ws + F_U);
  { EpiSwiglu e{U}; big_gemm(a, w13, T_ALL, 5632, 1024, e, lds, layer == 3); }
  xcd_barrier(xb);
  { EpiResid e{p.out, hctx, p.out, hctx, mods + (size_t)layer * 5 * 6144 + 5 * 1024, (const float2*)(p.ws + OFF_LNS), p.ln_g + (size_t)(layer * 2) * 1024, p.ln_b + (size_t)(layer * 2) * 1024}; big_gemm(U, w2, T_ALL, 1024, FF, e, lds, 1); if (layer < 3) ctx_gemm(U, w2, FF, e, lds); }
  xcd_barrier(xb);
  ln_phase(p, layer, 1, layer < 3 ? layer + 1 : 3, 0, layer == 3);
  xcd_barrier(xb);
}

__global__ void __launch_bounds__(NTHR) mega(Params p) {
  __shared__ __attribute__((aligned(16))) char lds[LDS_BYTES];
  cg::grid_group grid = cg::this_grid();
  __shared__ uint4 xb_words;
  if (threadIdx.x == 0) xb_words = make_uint4(0u, 0u, 0u, 0u);
  __syncthreads();
  const XcdBarrier xb = xcd_barrier_post((unsigned*)(p.ws + OFF_BAR), (volatile LAS unsigned*)&xb_words);
  float* ldsf = (float*)lds;
  const float* mods = (const float*)(p.ws + OFF_MODS); float* hctx = (float*)(p.ws + OFF_HCTX); bf16_t* a = (bf16_t*)(p.ws + OFF_A);
  const float2* tabR = (const float2*)(p.ws + OFF_TABR); const float2* tabM = (const float2*)(p.ws + OFF_TABM); float* rs = (float*)(p.ws + OFF_RS);
  ada_phase(p, ldsf);
  tables_phase(p);
  convert_w<2>(p.ret_w_in, 6144, 1024, (bf16_t*)(p.ws + W0_RETIN), 6144, nullptr, ldsf);
  convert_w<0>(p.ret_w_out, 1024, 2048, (bf16_t*)(p.ws + W0_RETOUT), 1024, nullptr, ldsf);
  convert_w<1>(p.w13, 5632, 1024, (bf16_t*)(p.ws + W0_W13), 5632, nullptr, ldsf);
  convert_w<0>(p.w2, 1024, FF, (bf16_t*)(p.ws + W0_W2), 1024, nullptr, ldsf);
  grid.sync();
  modulate_phase(p, p.x, p.ctx, 0);
  xcd_barrier(xb);
  { const bf16_t* wi = (const bf16_t*)(p.ws + W0_RETIN);
    { EpiRetQK e{(bf16_t*)(p.ws + R_QK), tabR}; big_gemm(a, wi, T_ALL, 2048, 1024, e, lds, 1); ctx_gemm(a, wi, 1024, e, lds, 2048); }
    { EpiStore e{(bf16_t*)(p.ws + R_V), (bf16_t*)(p.ws + R_V), 1 << 30, 2048, 2048, 1.f}; big_gemm(a, wi + (size_t)2048 * 1024, T_ALL, 2048, 1024, e, lds, 1); ctx_gemm(a, wi + (size_t)2048 * 1024, 1024, e, lds, 2048); }
    xcd_barrier(xb);
    scan_phase<256, false, 64>(p, lds);
    xcd_barrier(xb);
    { EpiStore e{(bf16_t*)(p.ws + R_QK), (bf16_t*)(p.ws + R_QK), 1 << 30, 2048, 2048, 1.f}; big_gemm(a, wi + (size_t)4096 * 1024, T_ALL, 2048, 1024, e, lds, 1); ctx_gemm(a, wi + (size_t)4096 * 1024, 1024, e, lds, 2048); }
    xcd_barrier(xb);
    ret_readout_phase(p);
    xcd_barrier(xb);
    { EpiResid e{p.x, p.ctx, p.out, hctx, mods + 2 * 1024, nullptr, nullptr, nullptr}; big_gemm((const bf16_t*)(p.ws + R_O), (const bf16_t*)(p.ws + W0_RETOUT), T_ALL, 1024, 2048, e, lds, 1); ctx_gemm((const bf16_t*)(p.ws + R_O), (const bf16_t*)(p.ws + W0_RETOUT), 2048, e, lds); }
    xcd_barrier(xb);
    ln_phase(p, 0, 0, 0, 3, false);
    convert_w<0>(p.na_w_qkv, 3072, 1024, (bf16_t*)(p.ws + W1_QKV), 3072, nullptr, ldsf);
    convert_w<0>(p.na_w_out, 1024, 1024, (bf16_t*)(p.ws + W1_OUT), 1024, nullptr, ldsf);
    convert_w<1>(p.w13 + (size_t)1 * 1024 * 5632, 5632, 1024, (bf16_t*)(p.ws + W1_W13), 5632, nullptr, ldsf);
    convert_w<0>(p.w2 + (size_t)1 * FF * 1024, 1024, FF, (bf16_t*)(p.ws + W1_W2), 1024, nullptr, ldsf);
    convert_w<5>(p.mla_w_down, 800, 1024, (bf16_t*)(p.ws + W2_DOWN), 1024, nullptr, ldsf);
    convert_w<3>(p.mla_w_uq, 1536, 512, (bf16_t*)(p.ws + W2_UQ), 1536, p.mla_q_norm, ldsf);
    convert_w<4>(p.mla_w_ukv, 2048, 256, (bf16_t*)(p.ws + W2_UKV), 2048, p.mla_kv_norm, ldsf);
    convert_w<0>(p.mla_w_out, 1024, 1024, (bf16_t*)(p.ws + W2_OUT), 1024, nullptr, ldsf);
    convert_w<1>(p.w13 + (size_t)2 * 1024 * 5632, 5632, 1024, (bf16_t*)(p.ws + W2_W13), 5632, nullptr, ldsf);
    convert_w<0>(p.w2 + (size_t)2 * FF * 1024, 1024, FF, (bf16_t*)(p.ws + W2_W2), 1024, nullptr, ldsf);
    convert_w<0>(p.hg_w_in, 5120, 1024, (bf16_t*)(p.ws + W3_IN), 5120, nullptr, ldsf);
    convert_w<0>(p.hg_w_out, 1024, 1024, (bf16_t*)(p.ws + W3_OUT), 1024, nullptr, ldsf);
    convert_w<1>(p.w13 + (size_t)3 * 1024 * 5632, 5632, 1024, (bf16_t*)(p.ws + W3_W13), 5632, nullptr, ldsf);
    convert_w<0>(p.w2 + (size_t)3 * FF * 1024, 1024, FF, (bf16_t*)(p.ws + W3_W2), 1024, nullptr, ldsf);
    xcd_barrier(xb);
    ffn_and_ln(p, xb, lds, 0, (const bf16_t*)(p.ws + W0_W13), (const bf16_t*)(p.ws + W0_W2));
  }
  { const bf16_t* wq = (const bf16_t*)(p.ws + W1_QKV);
    { EpiStore e{(bf16_t*)(p.ws + N_Q), (bf16_t*)(p.ws + N_K), 1024, 1024, 1024, 0.125f}; big_gemm(a, wq, T_ALL, 2048, 1024, e, lds, 1); ctx_gemm(a, wq, 1024, e, lds, 2048); }
    { EpiVTn e{(bf16_t*)(p.ws + N_VT), nullptr}; big_gemm(a, wq + (size_t)2048 * 1024, T_ALL, 1024, 1024, e, lds, 1); ctx_gemm(a, wq + (size_t)2048 * 1024, 1024, e, lds); }
    xcd_barrier(xb);
    na_attn_phase(p, lds);
    xcd_barrier(xb);
    { EpiResid e{p.out, hctx, p.out, hctx, mods + (size_t)1 * 5 * 6144 + 2 * 1024, (const float2*)(p.ws + OFF_LNS), p.ln_g + (size_t)(0 * 2 + 1) * 1024, p.ln_b + (size_t)(0 * 2 + 1) * 1024}; big_gemm(a, (const bf16_t*)(p.ws + W1_OUT), T_ALL, 1024, 1024, e, lds, 1); ctx_gemm(a, (const bf16_t*)(p.ws + W1_OUT), 1024, e, lds); }
    xcd_barrier(xb);
    ln_phase(p, 1, 0, 1, 3, false);
    xcd_barrier(xb);
    ffn_and_ln(p, xb, lds, 1, (const bf16_t*)(p.ws + W1_W13), (const bf16_t*)(p.ws + W1_W2));
  }
  { const bf16_t* d0 = (const bf16_t*)(p.ws + M_D0);
    { EpiD0 e{(bf16_t*)(p.ws + M_D0), (bf16_t*)(p.ws + M_CKV), (bf16_t*)(p.ws + M_KR)}; big_gemm(a, (const bf16_t*)(p.ws + W2_DOWN), T_ALL, 1024, 1024, e, lds, 1); ctx_gemm(a, (const bf16_t*)(p.ws + W2_DOWN), 1024, e, lds); }
    xcd_barrier(xb);
    mla_stats_phase(p);
    xcd_barrier(xb);
    { EpiMlaQ e{(bf16_t*)(p.ws + M_Q), rs, tabM}; big_gemm(d0, (const bf16_t*)(p.ws + W2_UQ), T_ALL, 1536, 512, e, lds, 1); ctx_gemm(d0, (const bf16_t*)(p.ws + W2_UQ), 512, e, lds, 1536); }
    { GemmArgs g{(const bf16_t*)(p.ws + M_CKV), 256, (const bf16_t*)(p.ws + W2_UKV), 256, T_ALL, 1024, 256}; EpiMlaK e{(bf16_t*)(p.ws + M_K), rs}; gemm_phase<false>(g, e, lds); }
    { EpiVTn e{(bf16_t*)(p.ws + M_VT), rs}; big_gemm((const bf16_t*)(p.ws + M_CKV), (const bf16_t*)(p.ws + W2_UKV) + (size_t)1024 * 256, T_ALL, 1024, 256, e, lds, 1); ctx_gemm((const bf16_t*)(p.ws + M_CKV), (const bf16_t*)(p.ws + W2_UKV) + (size_t)1024 * 256, 256, e, lds); }
    xcd_barrier(xb);
    mla_attn_phase(p, lds);
    xcd_barrier(xb);
    { EpiResid e{p.out, hctx, p.out, hctx, mods + (size_t)2 * 5 * 6144 + 2 * 1024, (const float2*)(p.ws + OFF_LNS), p.ln_g + (size_t)(1 * 2 + 1) * 1024, p.ln_b + (size_t)(1 * 2 + 1) * 1024}; big_gemm(a, (const bf16_t*)(p.ws + W2_OUT), T_ALL, 1024, 1024, e, lds, 1); ctx_gemm(a, (const bf16_t*)(p.ws + W2_OUT), 1024, e, lds); }
    xcd_barrier(xb);
    ln_phase(p, 2, 0, 2, 3, false);
    xcd_barrier(xb);
    ffn_and_ln(p, xb, lds, 2, (const bf16_t*)(p.ws + W2_W13), (const bf16_t*)(p.ws + W2_W2));
  }
  { { EpiHg e{(bf16_t*)(p.ws + H_P)}; big_gemm(a, (const bf16_t*)(p.ws + W3_IN), T_ALL, 5120, 1024, e, lds); }
    xcd_barrier(xb);
    scan_phase<128, true, 32>(p, lds);
    xcd_barrier(xb);
    hg_readout_phase(p);
    xcd_barrier(xb);
    { EpiResid e{p.out, hctx, p.out, hctx, mods + (size_t)3 * 5 * 6144 + 2 * 1024, (const float2*)(p.ws + OFF_LNS), p.ln_g + (size_t)(2 * 2 + 1) * 1024, p.ln_b + (size_t)(2 * 2 + 1) * 1024}; big_gemm(a, (const bf16_t*)(p.ws + W3_OUT), T_ALL, 1024, 1024, e, lds, 1); }
    xcd_barrier(xb);
    ln_phase(p, 3, 0, 3, 3, false);
    xcd_barrier(xb);
    ffn_and_ln(p, xb, lds, 3, (const bf16_t*)(p.ws + W3_W13), (const bf16_t*)(p.ws + W3_W2));
  }
}

extern "C" void kernel_launch(void* const* d_in, const int* in_sizes, int n_in, void* d_out, int out_size, void* d_ws, size_t ws_size, hipStream_t stream) {
  static int grid_blocks = 0;
  if (!grid_blocks) {
    int dev = 0, cus = 0, per_cu = 0;
    (void)hipGetDevice(&dev);
    (void)hipDeviceGetAttribute(&cus, hipDeviceAttributeMultiprocessorCount, dev);
    (void)hipOccupancyMaxActiveBlocksPerMultiprocessor(&per_cu, mega, NTHR, 0);
    if (per_cu != 1) per_cu = 1;
    grid_blocks = cus * per_cu;
  }
  if (ws_size < WS_NEED) { fprintf(stderr, "workspace too small: %zu\n", ws_size); return; }
  Params p{};
  const float** f = (const float**)&p;
  for (int i = 0; i < 26; ++i) f[i] = (const float*)d_in[i];
  p.out = (float*)d_out; p.ws = (char*)d_ws;
  (void)hipMemsetAsync((char*)d_ws + OFF_BAR, 0, XCD_BAR_WORDS * 4, stream);
  void* args[] = {&p};
  hipError_t e = hipLaunchCooperativeKernel((void*)mega, dim3(grid_blocks), dim3(NTHR), args, 0, stream);
  if (e != hipSuccess) fprintf(stderr, "cooperative launch failed: %s (grid %d)\n", hipGetErrorString(e), grid_blocks);
}
```

```cpp
#include <hip/hip_runtime.h>
#include <hip/hip_cooperative_groups.h>
#include <cstdio>
#include <cstdint>
namespace cg = cooperative_groups;

#define DI __device__ __forceinline__
DI int tid_() { int t = threadIdx.x; asm volatile("" : "+v"(t)); return t; }
typedef unsigned short bf16_t;
typedef short bf16x8 __attribute__((ext_vector_type(8)));
typedef short s16x4 __attribute__((ext_vector_type(4)));
typedef float f32x4 __attribute__((ext_vector_type(4)));
typedef float f32x16 __attribute__((ext_vector_type(16)));
typedef unsigned u32x4 __attribute__((ext_vector_type(4)));
typedef unsigned u32x2 __attribute__((ext_vector_type(2)));

constexpr int NTHR = 512;
constexpr int T_ALL = 33792, PB = 8448, LC = 256, LL = 8192, DM = 1024, FF = 2816;
constexpr float ALPHA = 1.681792830507429f;
constexpr float LOG2E = 1.4426950408889634f;
constexpr size_t MiB = 1048576;

struct Params {
  const float *x, *c, *ctx, *cctx, *ada_w, *ada_b, *ln_g, *ln_b, *w13, *w2;
  const float *ret_w_in, *ret_decay, *ret_w_out, *na_w_qkv, *na_rpb, *na_w_out;
  const float *mla_w_down, *mla_q_norm, *mla_kv_norm, *mla_w_uq, *mla_w_ukv, *mla_w_out;
  const float *hg_w_in, *hg_lb, *hg_norm_g, *hg_w_out;
  float* out; char* ws;
};

constexpr size_t OFF_MODS = 0;
constexpr size_t OFF_TABR = 512 * 1024;
constexpr size_t OFF_TABM = OFF_TABR + 65536;
constexpr size_t OFF_LBV = OFF_TABM + 8192;
constexpr size_t OFF_RS = OFF_LBV + 4096;
constexpr size_t OFF_BAR = 896 * 1024;
constexpr size_t OFF_HCTX = 1 * MiB;
constexpr size_t OFF_A = 5 * MiB;
constexpr size_t OFF_W0 = 71 * MiB;
constexpr size_t OFF_BIG = 104 * MiB;
constexpr size_t OFF_WR = OFF_BIG;
constexpr size_t OFF_S = 180 * MiB;
constexpr size_t WS_NEED = 512 * MiB;
constexpr size_t OFF_LNS = 510 * MiB;
constexpr size_t W0_RETIN = OFF_W0, W0_RETOUT = W0_RETIN + (size_t)6144 * 1024 * 2, W0_W13 = W0_RETOUT + (size_t)1024 * 2048 * 2, W0_W2 = W0_W13 + (size_t)5632 * 1024 * 2;
constexpr size_t SZ_W13 = (size_t)5632 * 1024 * 2, SZ_W2 = (size_t)1024 * 2816 * 2, SZ_SQ = (size_t)1024 * 1024 * 2;
constexpr size_t W1_QKV = OFF_WR, W1_OUT = W1_QKV + (size_t)3072 * 1024 * 2, W1_W13 = W1_OUT + SZ_SQ, W1_W2 = W1_W13 + SZ_W13;
constexpr size_t W2_DOWN = W1_W2 + SZ_W2, W2_UQ = W2_DOWN + (size_t)1024 * 1024 * 2, W2_UKV = W2_UQ + (size_t)1536 * 512 * 2, W2_OUT = W2_UKV + (size_t)2048 * 256 * 2, W2_W13 = W2_OUT + SZ_SQ, W2_W2 = W2_W13 + SZ_W13;
constexpr size_t W3_IN = W2_W2 + SZ_W2, W3_OUT = W3_IN + (size_t)5120 * 1024 * 2, W3_W13 = W3_OUT + SZ_SQ, W3_W2 = W3_W13 + SZ_W13, W3_END = W3_W2 + SZ_W2;
static_assert(W3_END <= OFF_S, "rest weights overflow");
static_assert(W0_W2 + SZ_W2 <= OFF_BIG, "W0 overflow");
constexpr size_t SZ_T2048 = (size_t)T_ALL * 2048 * 2, SZ_T1024 = (size_t)T_ALL * 1024 * 2;
constexpr size_t R_QK = OFF_BIG, R_V = R_QK + SZ_T2048, R_O = R_V + SZ_T2048;
static_assert(R_O + SZ_T2048 <= WS_NEED, "retention overflow");
constexpr size_t N_Q = OFF_S, N_K = N_Q + SZ_T1024, N_VT = N_K + SZ_T1024;
constexpr size_t M_D0 = OFF_S, M_CKV = M_D0 + (size_t)T_ALL * 512 * 2, M_KR = M_CKV + (size_t)T_ALL * 256 * 2, M_Q = M_D0 + (size_t)T_ALL * 1024 * 2, M_K = M_Q + (size_t)T_ALL * 1536 * 2, M_VT = M_K + (size_t)T_ALL * 1536 * 2;
static_assert(M_VT + SZ_T1024 <= WS_NEED, "mla overflow");
constexpr size_t H_P = OFF_S;
static_assert(H_P + (size_t)T_ALL * 5120 * 2 <= WS_NEED, "hgrn overflow");
constexpr size_t F_U = OFF_S;

typedef float f32x2 __attribute__((ext_vector_type(2)));
typedef __bf16 bf16x2_t __attribute__((ext_vector_type(2)));
DI unsigned pk2(float lo, float hi) { const f32x2 v = {lo, hi}; const bf16x2_t r = __builtin_convertvector(v, bf16x2_t); return __builtin_bit_cast(unsigned, r); }
DI float bflo(unsigned u) { return __uint_as_float(u << 16); }
DI float bfhi(unsigned u) { return __uint_as_float(u & 0xffff0000u); }
DI float bf2f(bf16_t v) { return __uint_as_float(((unsigned)v) << 16); }
DI bf16_t f2bf(float x) { return (bf16_t)(pk2(x, 0.f) & 0xffffu); }
DI float siluf(float x) { return x * __builtin_amdgcn_rcpf(1.f + __expf(-x)); }
DI f32x4 mfma16(bf16x8 a, bf16x8 b, f32x4 c) { return __builtin_amdgcn_mfma_f32_16x16x32_bf16(a, b, c, 0, 0, 0); }
DI f32x16 mfma32(bf16x8 a, bf16x8 b, f32x16 c) { return __builtin_amdgcn_mfma_f32_32x32x16_bf16(a, b, c, 0, 0, 0); }
DI bf16x8 cat44(s16x4 lo, s16x4 hi) { return __builtin_shufflevector(lo, hi, 0, 1, 2, 3, 4, 5, 6, 7); }
DI bf16x8 pack8(float a0, float a1, float a2, float a3, float a4, float a5, float a6, float a7) {
  u32x4 p; p.x = pk2(a0, a1); p.y = pk2(a2, a3); p.z = pk2(a4, a5); p.w = pk2(a6, a7); return __builtin_bit_cast(bf16x8, p);
}
DI int clampi(int v, int lo, int hi) { return v < lo ? lo : (v > hi ? hi : v); }
DI float* hrow(float* hlat, float* hctx, int t) { const int b = t / PB, p = t - b * PB; return p < LC ? hctx + (size_t)(b * LC + p) * DM : hlat + (size_t)(b * LL + p - LC) * DM; }
DI const float* hrowc(const float* hlat, const float* hctx, int t) { const int b = t / PB, p = t - b * PB; return p < LC ? hctx + (size_t)(b * LC + p) * DM : hlat + (size_t)(b * LL + p - LC) * DM; }
DI int modvec(int t) { const int b = t / PB, p = t - b * PB; return p < LC ? 4 : b; }

template <int MODE> DI int srccol(int n) {
  if (MODE == 0) return n;
  if (MODE == 1) { const int c = n >> 5, s = (n >> 4) & 1, i = n & 15; return s * FF + 16 * c + i; }
  if (MODE == 2) { if (n >= 2048) return n; const int w = n & 255, j = w >> 1, s = w & 1; return (n & ~255) + s * 128 + j; }
  if (MODE == 3) { const int h = n / 96, w = n - h * 96; if (w < 64) return n; const int wp = w - 64, j = wp >> 1, s = wp & 1; return h * 96 + 64 + s * 16 + j; }
  if (MODE == 4) { if (n < 1024) return (n >> 6) * 128 + (n & 63); const int m = n - 1024; return (m >> 6) * 128 + 64 + (m & 63); }
  if (MODE == 5) return n < 800 ? n : -1;
  return n;
}
template <int MODE> DI f32x4 cvt_load4(const float* __restrict__ row, int n) {
  if (MODE == 2 && n < 2048) { const int w = n & 255, j = w >> 1; const float* b = row + (n & ~255) + j; const f32x2 lo = *(const f32x2*)b, hi = *(const f32x2*)(b + 128); return (f32x4){lo[0], hi[0], lo[1], hi[1]}; }
  if (MODE == 3) { return (f32x4){row[srccol<3>(n)], row[srccol<3>(n + 1)], row[srccol<3>(n + 2)], row[srccol<3>(n + 3)]}; }
  const int sc = srccol<MODE>(n); if (sc < 0) return (f32x4){0.f, 0.f, 0.f, 0.f};
  return *(const f32x4*)(row + sc);
}
template <int MODE>
DI void convert_w(const float* __restrict__ src, int Nsrc, int K, bf16_t* __restrict__ dst, int Ndst, const float* __restrict__ kscale, float* ldsf) {
  const int tid = threadIdx.x, tn = Ndst / 64, tk = K / 64;
  for (int tile = blockIdx.x; tile < tn * tk; tile += gridDim.x) {
    const int n0 = (tile % tn) * 64, k0 = (tile / tn) * 64;
    __syncthreads();
#pragma unroll
    for (int i = 0; i < 2; ++i) { const int kk = (tid >> 4) + 32 * i, nn = (tid & 15) * 4;
      f32x4 v = cvt_load4<MODE>(src + (size_t)(k0 + kk) * Nsrc, n0 + nn);
      if (kscale) v = v * kscale[k0 + kk];
      float* lp = ldsf + kk * 65 + nn; lp[0] = v[0]; lp[1] = v[1]; lp[2] = v[2]; lp[3] = v[3]; }
    __syncthreads();
    { const int nn = tid >> 3, kc = tid & 7; const float* lp = ldsf + (kc * 8) * 65 + nn;
      u32x4 o; o.x = pk2(lp[0], lp[65]); o.y = pk2(lp[130], lp[195]); o.z = pk2(lp[260], lp[325]); o.w = pk2(lp[390], lp[455]);
      *(u32x4*)(dst + (size_t)(n0 + nn) * K + k0 + kc * 8) = o; }
  }
}

DI void ada_phase(const Params& p, float* ldsf) {
  const int tid = threadIdx.x, lane = tid & 63, w = tid >> 6;
  float* mods = (float*)(p.ws + OFF_MODS);
  __syncthreads();
  for (int e = tid; e < 5120; e += NTHR) { const int mv = e >> 10, k = e & 1023; const float cv = mv < 4 ? p.c[mv * 1024 + k] : p.cctx[k]; ldsf[e] = siluf(cv); }
  __syncthreads();
  float* red = ldsf + 5120;
  for (int item = blockIdx.x; item < 4 * 96; item += gridDim.x) {
    const int i = item / 96, n0 = (item % 96) * 64;
    const float* wp = p.ada_w + (size_t)i * 1024 * 6144 + n0 + lane;
    float a0 = 0.f, a1 = 0.f, a2 = 0.f, a3 = 0.f, a4 = 0.f;
#pragma unroll 8
    for (int kk = 0; kk < 128; ++kk) { const int k = w * 128 + kk; const float wv = wp[(size_t)k * 6144];
      a0 += ldsf[k] * wv; a1 += ldsf[1024 + k] * wv; a2 += ldsf[2048 + k] * wv; a3 += ldsf[3072 + k] * wv; a4 += ldsf[4096 + k] * wv; }
    red[(w * 5 + 0) * 64 + lane] = a0; red[(w * 5 + 1) * 64 + lane] = a1; red[(w * 5 + 2) * 64 + lane] = a2; red[(w * 5 + 3) * 64 + lane] = a3; red[(w * 5 + 4) * 64 + lane] = a4;
    __syncthreads();
    if (tid < 320) { const int mv = tid >> 6; float s = 0.f;
#pragma unroll
      for (int ww = 0; ww < 8; ++ww) s += red[(ww * 5 + mv) * 64 + lane];
      mods[(size_t)(i * 5 + mv) * 6144 + n0 + lane] = s + p.ada_b[i * 6144 + n0 + lane]; }
    __syncthreads();
  }
}
DI void tables_phase(const Params& p) {
  const int gt = blockIdx.x * NTHR + threadIdx.x, gn = gridDim.x * NTHR;
  float2* tabR = (float2*)(p.ws + OFF_TABR); float2* tabM = (float2*)(p.ws + OFF_TABM); float* lbv = (float*)(p.ws + OFF_LBV);
  for (int e = gt; e < 128 * 64; e += gn) { const int v = e >> 6, i = e & 63; const float inv = powf(10000.f, -(float)i / 64.f); const float ang = (float)v * inv; tabR[e] = make_float2(cosf(ang), sinf(ang)); }
  for (int e = gt; e < 128 * 8; e += gn) { const int v = e >> 3, i = e & 7; const float inv = powf(10000.f, -(float)i / 8.f); const float ang = (float)v * inv; tabM[e] = make_float2(cosf(ang), sinf(ang)); }
  for (int e = gt; e < 1024; e += gn) { const float l0 = p.hg_lb[e], l1 = p.hg_lb[1024 + e], l2 = p.hg_lb[2048 + e], l3 = p.hg_lb[3072 + e];
    const float mx = fmaxf(fmaxf(l0, l1), fmaxf(l2, l3)); const float e0 = expf(l0 - mx), e1 = expf(l1 - mx), e2 = expf(l2 - mx), e3 = expf(l3 - mx);
    lbv[e] = (e1 + e2 + e3) / (e0 + e1 + e2 + e3); }
}

DI void modulate_phase(const Params& p, const float* slat, const float* sctx, int layer) {
  const float* mods = (const float*)(p.ws + OFF_MODS); bf16_t* a = (bf16_t*)(p.ws + OFF_A);
  const int gt = blockIdx.x * NTHR + threadIdx.x, gn = gridDim.x * NTHR;
  for (int e = gt; e < T_ALL * 128; e += gn) {
    const int t = e >> 7, c0 = (e & 127) * 8; const float* s = hrowc(slat, sctx, t) + c0; const float* m = mods + (size_t)(layer * 5 + modvec(t)) * 6144;
    const f32x4 x0 = *(const f32x4*)s, x1 = *(const f32x4*)(s + 4), sh0 = *(const f32x4*)(m + c0), sh1 = *(const f32x4*)(m + c0 + 4), sc0 = *(const f32x4*)(m + 1024 + c0), sc1 = *(const f32x4*)(m + 1024 + c0 + 4);
    const f32x4 y0 = x0 * (1.f + sc0) + sh0, y1 = x1 * (1.f + sc1) + sh1;
    u32x4 o; o.x = pk2(y0[0], y0[1]); o.y = pk2(y0[2], y0[3]); o.z = pk2(y1[0], y1[1]); o.w = pk2(y1[2], y1[3]);
    *(u32x4*)(a + (size_t)t * 1024 + c0) = o;
  }
}
DI void ln_phase(const Params& p, int lnlayer, int lnidx, int ml, int js, bool final_out) {
  const float* mods = (const float*)(p.ws + OFF_MODS); bf16_t* a = (bf16_t*)(p.ws + OFF_A); float* hctx = (float*)(p.ws + OFF_HCTX); float2* lns = (float2*)(p.ws + OFF_LNS);
  const int tid = threadIdx.x, lane = tid & 63, gw = blockIdx.x * 8 + (tid >> 6), nw = gridDim.x * 8;
  const float* gp = p.ln_g + (size_t)(lnlayer * 2 + lnidx) * 1024; const float* bp = p.ln_b + (size_t)(lnlayer * 2 + lnidx) * 1024;
  for (int t = gw; t < T_ALL; t += nw) {
    float* hr = hrow(p.out, hctx, t);
    f32x4 v[4]; float s = 0.f;
#pragma unroll
    for (int i = 0; i < 4; ++i) { v[i] = *(const f32x4*)(hr + i * 256 + lane * 4); s += (v[i][0] + v[i][1]) + (v[i][2] + v[i][3]); }
#pragma unroll
    for (int o = 1; o < 64; o <<= 1) s += __shfl_xor(s, o);
    const float mean = s * (1.f / 1024.f); float q = 0.f;
#pragma unroll
    for (int i = 0; i < 4; ++i) { v[i] = v[i] - mean; q += (v[i][0] * v[i][0] + v[i][1] * v[i][1]) + (v[i][2] * v[i][2] + v[i][3] * v[i][3]); }
#pragma unroll
    for (int o = 1; o < 64; o <<= 1) q += __shfl_xor(q, o);
    const float rstd = rsqrtf(q * (1.f / 1024.f) + 1e-5f);
    if (!final_out && lane == 0) lns[t] = make_float2(mean, rstd);
    const float* m = mods + (size_t)(ml * 5 + modvec(t)) * 6144 + (size_t)js * 1024;
#pragma unroll
    for (int i = 0; i < 4; ++i) { const int c0 = i * 256 + lane * 4;
      const f32x4 y = v[i] * rstd * *(const f32x4*)(gp + c0) + *(const f32x4*)(bp + c0);
      if (final_out) *(f32x4*)(hr + c0) = y;
      else { const f32x4 z = y * (1.f + *(const f32x4*)(m + 1024 + c0)) + *(const f32x4*)(m + c0); u32x2 o; o.x = pk2(z[0], z[1]); o.y = pk2(z[2], z[3]); *(u32x2*)(a + (size_t)t * 1024 + c0) = o; } }
  }
}

namespace pg8 {
#define PG8_LAS __attribute__((address_space(3)))
typedef unsigned short bf16_t;
typedef short bf16x8 __attribute__((ext_vector_type(8)));
typedef float f32x4 __attribute__((ext_vector_type(4)));
typedef unsigned u32x4 __attribute__((ext_vector_type(4)));
constexpr int BM = 256, BK = 64, HALF = 128, HTB = HALF * BK * 2  , STAGE_BYTES = 8 * HTB, NXCD = 8, WGM = 8;

__host__ __device__ __forceinline__ int lds_byte(int r, int c) { const int st = (r >> 4) * 2 + (c >> 5), rr = r & 15, cc = c & 31, ob = rr * 64 + cc * 2; return st * 1024 + (ob ^ (((ob >> 9) & 1) << 5)); }
__host__ __device__ __forceinline__ void stage_rc(int b, int& R, int& C) { const int st = b / 1024, sb = b % 1024, swz = sb ^ (((sb >> 9) & 1) << 5); R = (st >> 1) * 16 + swz / 64; C = (st & 1) * 32 + (swz % 64) / 2; }
__host__ __device__ __forceinline__ int perm32(int rho) { const int n = rho >> 4, i = rho & 15; return 8 * (i >> 2) + 4 * n + (i & 3); }

struct Unit { int pm, pn; };
struct Gemm { const bf16_t* A; const bf16_t* Bt; int M, N, K; };

struct StaticOrder {
    int nM, nN, nwg, G, c, lat;
    __host__ __device__ void init(int M, int N, int G_, int c_, int lat_ = 0) { lat = lat_; nM = lat ? 128 : M / BM; nN = N / BM; nwg = nM * nN; G = G_; c = c_; }
    __host__ __device__ bool next(int i, Unit& u) const {
        const long L = (long)i * G + c; if (L >= nwg) return false;
        int wgid = (int)L; { const int q = nwg / NXCD, r = nwg % NXCD, xcd = wgid % NXCD, off = wgid / NXCD; wgid = (xcd < r ? xcd * (q + 1) : r * (q + 1) + (xcd - r) * q) + off; }
        const int nig = WGM * nN, gid = wgid / nig, fm = gid * WGM, gsz = (nM - fm) < WGM ? (nM - fm) : WGM;
        u.pm = fm + ((wgid % nig) % gsz); u.pn = (wgid % nig) / gsz; if (lat) u.pm += (u.pm >> 5) + 1; return true;
    }
    __device__ __forceinline__ void a_ready(const Unit&) const {}
    __device__ __forceinline__ void done(const Unit&) const {}
};
template <class Epi, class Sched, bool ALIGN_EPI = false, bool SP2 = false>
__device__ __forceinline__ void gemm_phase(PG8_LAS unsigned char* lds, const Gemm g, const Sched& S, const Epi& E) {
    const int tid = tid_(), wid = __builtin_amdgcn_readfirstlane(tid >> 6), lane = tid & 63, wr = wid >> 2, wc = wid & 3, fr = lane & 15, fq = lane >> 4;
    const int K = g.K, nt = K / BK;
    unsigned voffA[2], voffB[2];
#pragma unroll
    for (int i = 0; i < 2; ++i) { int R, C; stage_rc(tid * 16 + i * 8192, R, C); const int Rb = Epi::PERM ? ((R & ~31) + perm32(R & 31)) : R;
        voffA[i] = (unsigned)(R * K + C) * 2u; voffB[i] = (unsigned)(Rb * K + C) * 2u; }
    const size_t kstep = (size_t)(BK * 2);
    const size_t hstep = (size_t)HALF * K * 2;
    const size_t tstep = 2 * hstep;
    const unsigned ldsw = (unsigned)wid * 1024u;
    const int aoff = lds_byte(wr * 64 + fr, fq * 8), boff = lds_byte(wc * 32 + fr, fq * 8);
#define PG8_SA(b, h) (((b) * 2 + (h)) * HTB)
#define PG8_SB(b, h) ((4 + (b) * 2 + (h)) * HTB)
#define PG8_STAGE(bufoff, gbase, voff) do { _Pragma("unroll") for (int _i = 0; _i < 2; ++_i) \
        __builtin_amdgcn_global_load_lds((const unsigned*)((const char*)(gbase) + (voff)[_i]), (PG8_LAS unsigned*)(lds + (bufoff) + ldsw + _i * 8192), 16, 0, 0); } while (0)
#define PG8_LDA(dst, b, h) do { _Pragma("unroll") for (int m = 0; m < 4; ++m) _Pragma("unroll") for (int k = 0; k < 2; ++k) dst[m][k] = *(const PG8_LAS bf16x8*)(lds + PG8_SA(b, h) + aoff + m * 2048 + k * 1024); } while (0)
#define PG8_LDB(dst, b, h) do { _Pragma("unroll") for (int n = 0; n < 2; ++n) _Pragma("unroll") for (int k = 0; k < 2; ++k) dst[n][k] = *(const PG8_LAS bf16x8*)(lds + PG8_SB(b, h) + boff + n * 2048 + k * 1024); } while (0)
#define PG8_MMA(ai, bj, At, Bt) do { __builtin_amdgcn_s_setprio(1); _Pragma("unroll") for (int m = 0; m < 4; ++m) _Pragma("unroll") for (int n = 0; n < 2; ++n) _Pragma("unroll") for (int k = 0; k < 2; ++k) \
        acc[ai][bj][m][n] = __builtin_amdgcn_mfma_f32_16x16x32_bf16(Bt[n][k], At[m][k], acc[ai][bj][m][n], 0, 0, 0); __builtin_amdgcn_s_setprio(0); } while (0)
#define PG8_WAIT_V(n) asm volatile("s_waitcnt vmcnt(" #n ")" ::: "memory")
#define PG8_WAIT_L(n) asm volatile("s_waitcnt lgkmcnt(" #n ")" ::: "memory")
#define PG8_BAR __builtin_amdgcn_s_barrier()
#define PG8_SCHED __builtin_amdgcn_sched_barrier(0)
    Unit cur, nxt; int ui = 0;
    if (!S.next(0, cur)) return;
    f32x4 acc[2][2][4][2];
#pragma unroll
    for (int a = 0; a < 2; ++a)
#pragma unroll
        for (int b = 0; b < 2; ++b)
#pragma unroll
            for (int m = 0; m < 4; ++m)
#pragma unroll
                for (int n = 0; n < 2; ++n) acc[a][b][m][n] = (f32x4){0.f, 0.f, 0.f, 0.f};
    bf16x8 At[4][2], B0[2][2], B1[2][2];
    const char* cA = (const char*)g.A + (size_t)cur.pm * tstep; const char* cB = (const char*)g.Bt + (size_t)cur.pn * tstep;
    S.a_ready(cur);
    if constexpr (SP2) {
        PG8_STAGE(PG8_SB(0, 0), cB, voffB); PG8_STAGE(PG8_SB(0, 1), cB + hstep, voffB); PG8_STAGE(PG8_SA(0, 0), cA, voffA); PG8_STAGE(PG8_SA(0, 1), cA + hstep, voffA);
        if (wr == 1) PG8_BAR;
        PG8_WAIT_V(2); PG8_BAR;
        PG8_STAGE(PG8_SB(1, 0), cB + kstep, voffB); PG8_STAGE(PG8_SA(1, 0), cA + kstep, voffA); PG8_STAGE(PG8_SB(1, 1), cB + hstep + kstep, voffB);
        PG8_WAIT_V(6); PG8_BAR;
    } else {
        PG8_STAGE(PG8_SB(0, 0), cB, voffB); PG8_STAGE(PG8_SA(0, 0), cA, voffA); PG8_STAGE(PG8_SB(0, 1), cB + hstep, voffB); PG8_STAGE(PG8_SA(0, 1), cA + hstep, voffA);
        if (wr == 1) PG8_BAR;
        PG8_WAIT_V(4); PG8_BAR;
        PG8_STAGE(PG8_SB(1, 0), cB + kstep, voffB); PG8_STAGE(PG8_SA(1, 0), cA + kstep, voffA); PG8_STAGE(PG8_SB(1, 1), cB + hstep + kstep, voffB);
        PG8_WAIT_V(6); PG8_BAR;
    }
    for (;;) {
        const bool has_next = S.next(ui + 1, nxt);
        const char* nA = has_next ? (const char*)g.A + (size_t)nxt.pm * tstep : cA; const char* nB = has_next ? (const char*)g.Bt + (size_t)nxt.pn * tstep : cB;
        for (int t = 0; t < nt; t += 2) {
            const bool last = (t == nt - 2);
            const char* a1 = cA + (size_t)(t + 1) * kstep;
            const char* a2 = last ? nA : cA + (size_t)(t + 2) * kstep; const char* b2 = last ? nB : cB + (size_t)(t + 2) * kstep;
            const char* a3 = a2 + kstep; const char* b3 = b2 + kstep;
            if (last && has_next) S.a_ready(nxt);
            if constexpr (SP2) {
            PG8_LDB(B0, 0, 0); PG8_LDB(B1, 0, 1); PG8_SCHED; PG8_LDA(At, 0, 0); PG8_STAGE(PG8_SA(1, 1), a1 + hstep, voffA);
            PG8_WAIT_V(8); PG8_WAIT_L(0); PG8_BAR; PG8_MMA(0, 0, At, B0); PG8_MMA(0, 1, At, B1); PG8_BAR; PG8_SCHED;
            PG8_LDA(At, 0, 1); PG8_STAGE(PG8_SB(0, 0), b2, voffB); PG8_STAGE(PG8_SB(0, 1), b2 + hstep, voffB); PG8_STAGE(PG8_SA(0, 0), a2, voffA);
            PG8_WAIT_V(8); PG8_WAIT_L(0); PG8_BAR; PG8_MMA(1, 0, At, B0); PG8_MMA(1, 1, At, B1); PG8_BAR; PG8_SCHED;
            PG8_LDB(B0, 1, 0); PG8_LDB(B1, 1, 1); PG8_SCHED; PG8_LDA(At, 1, 0); PG8_STAGE(PG8_SA(0, 1), a2 + hstep, voffA);
            PG8_WAIT_V(8); PG8_WAIT_L(0); PG8_BAR; PG8_MMA(0, 0, At, B0); PG8_MMA(0, 1, At, B1); PG8_BAR; PG8_SCHED;
            PG8_LDA(At, 1, 1); PG8_STAGE(PG8_SB(1, 0), b3, voffB); PG8_STAGE(PG8_SB(1, 1), b3 + hstep, voffB); PG8_STAGE(PG8_SA(1, 0), a3, voffA);
            PG8_WAIT_V(8); PG8_WAIT_L(0); PG8_BAR; PG8_MMA(1, 0, At, B0); PG8_MMA(1, 1, At, B1); PG8_BAR; PG8_SCHED;
            } else {
            PG8_LDB(B0, 0, 0); PG8_SCHED; PG8_LDA(At, 0, 0); PG8_STAGE(PG8_SA(1, 1), a1 + hstep, voffA);
            PG8_WAIT_L(8); PG8_BAR; PG8_WAIT_L(0); PG8_MMA(0, 0, At, B0); PG8_BAR; PG8_SCHED;
            PG8_LDB(B1, 0, 1); PG8_STAGE(PG8_SB(0, 0), b2, voffB);
            PG8_BAR; PG8_WAIT_L(0); PG8_MMA(0, 1, At, B1); PG8_BAR;
            PG8_LDA(At, 0, 1); PG8_STAGE(PG8_SA(0, 0), a2, voffA);
            PG8_BAR; PG8_WAIT_L(0); PG8_MMA(1, 0, At, B0); PG8_BAR; PG8_SCHED;
            PG8_STAGE(PG8_SB(0, 1), b2 + hstep, voffB);
            PG8_WAIT_V(6); PG8_BAR; PG8_MMA(1, 1, At, B1); PG8_BAR;
            PG8_LDB(B0, 1, 0); PG8_SCHED; PG8_LDA(At, 1, 0); PG8_STAGE(PG8_SA(0, 1), a2 + hstep, voffA);
            PG8_WAIT_L(8); PG8_BAR; PG8_WAIT_L(0); PG8_MMA(0, 0, At, B0); PG8_BAR; PG8_SCHED;
            PG8_LDB(B1, 1, 1); PG8_STAGE(PG8_SB(1, 0), b3, voffB);
            PG8_BAR; PG8_WAIT_L(0); PG8_MMA(0, 1, At, B1); PG8_BAR;
            PG8_LDA(At, 1, 1); PG8_STAGE(PG8_SA(1, 0), a3, voffA);
            PG8_BAR; PG8_WAIT_L(0); PG8_MMA(1, 0, At, B0); PG8_BAR; PG8_SCHED;
            PG8_STAGE(PG8_SB(1, 1), b3 + hstep, voffB);
            PG8_WAIT_V(6); PG8_BAR; PG8_MMA(1, 1, At, B1); PG8_BAR;
            }
        }
        if constexpr (ALIGN_EPI) { if (wr == 0) PG8_BAR; }
        if constexpr (!Epi::AFTER_DRAIN) { E(acc, cur, wr, wc, fr, fq); S.done(cur); }
        if (!has_next) break;
#pragma unroll
        for (int a = 0; a < 2; ++a)
#pragma unroll
            for (int b = 0; b < 2; ++b)
#pragma unroll
                for (int m = 0; m < 4; ++m)
#pragma unroll
                    for (int n = 0; n < 2; ++n) acc[a][b][m][n] = (f32x4){0.f, 0.f, 0.f, 0.f};
        cur = nxt; cA = nA; cB = nB; ++ui;
        if constexpr (ALIGN_EPI) { if (wr == 1) PG8_BAR; }
    }
    PG8_WAIT_V(0);
    if constexpr (!ALIGN_EPI) { if (wr == 0) PG8_BAR; }
    PG8_BAR;
    if constexpr (Epi::AFTER_DRAIN) { E.fused(acc, cur, wr, wc, fr, fq, lds, wid, lane); S.done(cur); }
#undef PG8_SA
#undef PG8_SB
#undef PG8_STAGE
#undef PG8_LDA
#undef PG8_LDB
#undef PG8_MMA
#undef PG8_WAIT_V
#undef PG8_WAIT_L
#undef PG8_BAR
#undef PG8_SCHED
}
}

template <class E4> struct EpiWrap { static constexpr bool PERM = false, AFTER_DRAIN = false; E4 e;
  DI void operator()(const f32x4 (&acc)[2][2][4][2], const pg8::Unit& u, int wr, int wc, int fr, int fq) const {
#pragma unroll
    for (int ai = 0; ai < 2; ++ai)
#pragma unroll
      for (int m = 0; m < 4; ++m) { const int row = u.pm * 256 + ai * 128 + wr * 64 + m * 16 + fr;
#pragma unroll
        for (int bj = 0; bj < 2; ++bj) { const int col = u.pn * 256 + bj * 128 + wc * 32 + 4 * fq;
          if constexpr (E4::PAIR) e.pair(row, ((col - 4 * fq) >> 1) + 4 * fq, acc[ai][bj][m][0], acc[ai][bj][m][1]);
          else { e(row, col, acc[ai][bj][m][0]); e(row, col + 16, acc[ai][bj][m][1]); } }
        asm volatile("" ::: "memory"); }
  } };
template <class E4>
DI void big_gemm(const bf16_t* A, const bf16_t* W, int M, int N, int K, const E4& e4, char* lds, int lat_only = 0) {
  __syncthreads();
  pg8::Gemm g{A, W, M, N, K}; pg8::StaticOrder S; S.init(M, N, (int)gridDim.x, (int)blockIdx.x, lat_only); EpiWrap<E4> E{e4};
  pg8::gemm_phase<EpiWrap<E4>, pg8::StaticOrder, true, true>((PG8_LAS unsigned char*)lds, g, S, E);
  __syncthreads();
}
struct GemmArgs { const bf16_t* A; int lda; const bf16_t* W; int ldw; int M, N, K; };
constexpr int LDT = 72;
template <bool TRANS, class Epi>
DI void gemm_phase(const GemmArgs g, const Epi epi, char* lds) {
  const int tid = threadIdx.x, lane = tid & 63, w = tid >> 6, wm = w & 3, wn = w >> 2, g4 = lane >> 4, l16 = lane & 15;
  const int nN = g.N / 128, ntiles = (g.M / 256) * nN, nk = g.K / 64;
  bf16_t* As = (bf16_t*)lds; bf16_t* Bs = As + 256 * LDT;
  for (int tile = blockIdx.x; tile < ntiles; tile += gridDim.x) {
    const int pm = tile / nN, pn = tile - pm * nN;
    const bf16_t* Ag = g.A + (size_t)(pm * 256) * g.lda; const bf16_t* Wg = g.W + (size_t)(pn * 128) * g.ldw;
    f32x4 acc[4][4];
#pragma unroll
    for (int i = 0; i < 4; ++i)
#pragma unroll
      for (int j = 0; j < 4; ++j) acc[i][j] = (f32x4){0.f, 0.f, 0.f, 0.f};
    u32x4 ra[4], rb[2];
#pragma unroll
    for (int i = 0; i < 4; ++i) { const int c = tid + NTHR * i; ra[i] = *(const u32x4*)(Ag + (size_t)(c >> 3) * g.lda + (c & 7) * 8); }
#pragma unroll
    for (int i = 0; i < 2; ++i) { const int c = tid + NTHR * i; rb[i] = *(const u32x4*)(Wg + (size_t)(c >> 3) * g.ldw + (c & 7) * 8); }
    for (int kt = 0; kt < nk; ++kt) {
      __syncthreads();
#pragma unroll
      for (int i = 0; i < 4; ++i) { const int c = tid + NTHR * i; *(u32x4*)(As + (c >> 3) * LDT + (c & 7) * 8) = ra[i]; }
#pragma unroll
      for (int i = 0; i < 2; ++i) { const int c = tid + NTHR * i; *(u32x4*)(Bs + (c >> 3) * LDT + (c & 7) * 8) = rb[i]; }
      __syncthreads();
      if (kt + 1 < nk) { const int k0 = (kt + 1) * 64;
#pragma unroll
        for (int i = 0; i < 4; ++i) { const int c = tid + NTHR * i; ra[i] = *(const u32x4*)(Ag + (size_t)(c >> 3) * g.lda + k0 + (c & 7) * 8); }
#pragma unroll
        for (int i = 0; i < 2; ++i) { const int c = tid + NTHR * i; rb[i] = *(const u32x4*)(Wg + (size_t)(c >> 3) * g.ldw + k0 + (c & 7) * 8); } }
#pragma unroll
      for (int ks = 0; ks < 2; ++ks) {
        bf16x8 af[4], wf[4];
#pragma unroll
        for (int i = 0; i < 4; ++i) af[i] = *(const bf16x8*)(As + (wm * 64 + i * 16 + l16) * LDT + ks * 32 + g4 * 8);
#pragma unroll
        for (int j = 0; j < 4; ++j) wf[j] = *(const bf16x8*)(Bs + (wn * 64 + j * 16 + l16) * LDT + ks * 32 + g4 * 8);
#pragma unroll
        for (int i = 0; i < 4; ++i)
#pragma unroll
          for (int j = 0; j < 4; ++j) acc[i][j] = TRANS ? mfma16(af[i], wf[j], acc[i][j]) : mfma16(wf[j], af[i], acc[i][j]);
      }
    }
    const int mb = pm * 256 + wm * 64, nb = pn * 128 + wn * 64;
    if constexpr (Epi::PAIR) {
#pragma unroll
      for (int i = 0; i < 4; ++i)
#pragma unroll
        for (int j = 0; j < 2; ++j) epi.pair(mb + i * 16 + l16, (nb >> 1) + 16 * j + 4 * g4, acc[i][2 * j], acc[i][2 * j + 1]);
    } else {
#pragma unroll
      for (int i = 0; i < 4; ++i)
#pragma unroll
        for (int j = 0; j < 4; ++j) { if (TRANS) epi(mb + i * 16 + 4 * g4, nb + j * 16 + l16, acc[i][j]); else epi(mb + i * 16 + l16, nb + j * 16 + 4 * g4, acc[i][j]); }
    }
  }
}
DI void st4bf(bf16_t* p, f32x4 v) { u32x2 o; o.x = pk2(v[0], v[1]); o.y = pk2(v[2], v[3]); *(u32x2*)p = o; }
struct EpiStore { static constexpr bool PAIR = false; bf16_t* d0; bf16_t* d1; int split, ld0, ld1; float s0;
  DI void operator()(int m, int n, f32x4 v) const { if (n < split) st4bf(d0 + (size_t)m * ld0 + n, v * s0); else st4bf(d1 + (size_t)m * ld1 + (n - split), v); } };
struct EpiVT { static constexpr bool PAIR = false; bf16_t* vt; const float* rs;
  DI void operator()(int m, int n, f32x4 v) const { const int b = m / PB, pos = m - b * PB;
    if (rs) { v[0] *= rs[2 * m + 1]; v[1] *= rs[2 * m + 3]; v[2] *= rs[2 * m + 5]; v[3] *= rs[2 * m + 7]; }
    st4bf(vt + ((size_t)(b * 1024 + n)) * PB + pos, v); } };
struct EpiVTn { static constexpr bool PAIR = false; bf16_t* vt; const float* rs;
  DI void operator()(int m, int n, f32x4 v) const { const int b = m / PB, pos = m - b * PB; if (rs) v = v * rs[2 * m + 1];
    bf16_t* q = vt + (size_t)(b * 1024 + n) * PB + pos; q[0] = f2bf(v[0]); q[PB] = f2bf(v[1]); q[2 * (size_t)PB] = f2bf(v[2]); q[3 * (size_t)PB] = f2bf(v[3]); } };
struct EpiD0 { static constexpr bool PAIR = false; bf16_t* cq; bf16_t* ckv; bf16_t* kr;
  DI void operator()(int m, int n, f32x4 v) const { if (n < 512) st4bf(cq + (size_t)m * 512 + n, v); else if (n < 768) st4bf(ckv + (size_t)m * 256 + (n - 512), v); else if (n < 800) st4bf(kr + (size_t)m * 32 + (n - 768), v); } };
struct EpiResid { static constexpr bool PAIR = false; const float* slat; const float* sctx; float* dlat; float* dctx; const float* gate;
  const float2* lns; const float* lg; const float* lb;
  DI void operator()(int m, int n, f32x4 v) const { const int mv = modvec(m); f32x4 hv = *(const f32x4*)(hrowc(slat, sctx, m) + n); const f32x4 gt = *(const f32x4*)(gate + (size_t)mv * 6144 + n);
    if (lns) { const float2 st = lns[m]; hv = (hv - st.x) * st.y * *(const f32x4*)(lg + n) + *(const f32x4*)(lb + n); }
    *(f32x4*)(hrow(dlat, dctx, m) + n) = ALPHA * hv + gt * v; } };
constexpr int CLD = 264;
template <class Epi>
DI void ctx_gemm(const bf16_t* __restrict__ A, const bf16_t* __restrict__ W, int K, const Epi& epi, char* lds, int N = 1024) {
  const int tid = threadIdx.x, lane = tid & 63, w = tid >> 6, g4 = lane >> 4, l16 = lane & 15, wm = w & 3, wn = w >> 2;
  bf16_t* As = (bf16_t*)lds; bf16_t* Ws = As + 64 * CLD;
  const int nk = K / 256, per = N / 64;
  for (int tile = blockIdx.x; tile < 16 * per; tile += gridDim.x) {
    const int nt = tile % per, rem = tile / per, mt = rem & 3, b = rem >> 2;
    const size_t row0 = (size_t)b * PB + mt * 64;
    const bf16_t* Ag = A + row0 * K; const bf16_t* Wg = W + (size_t)(nt * 64) * K;
    u32x4 ra[4], rw[4], ra2[4], rw2[4];
    auto gl = [&](int kt, u32x4 (&xa)[4], u32x4 (&xw)[4]) { const int k0 = kt * 256;
#pragma unroll
      for (int i = 0; i < 4; ++i) { const int c = tid + NTHR * i, r = c >> 5, kc = c & 31; xa[i] = *(const u32x4*)(Ag + (size_t)r * K + k0 + kc * 8); xw[i] = *(const u32x4*)(Wg + (size_t)r * K + k0 + kc * 8); } };
    f32x4 acc[2] = {(f32x4){0.f, 0.f, 0.f, 0.f}, (f32x4){0.f, 0.f, 0.f, 0.f}};
    auto stepk = [&](int kt, u32x4 (&xa)[4], u32x4 (&xw)[4]) {
      __syncthreads();
#pragma unroll
      for (int i = 0; i < 4; ++i) { const int c = tid + NTHR * i, r = c >> 5, kc = c & 31; *(u32x4*)(As + r * CLD + kc * 8) = xa[i]; *(u32x4*)(Ws + r * CLD + kc * 8) = xw[i]; }
      __syncthreads();
      if (kt + 2 < nk) gl(kt + 2, xa, xw);
#pragma unroll
      for (int ks = 0; ks < 8; ++ks) {
        const bf16x8 af = *(const bf16x8*)(As + (wm * 16 + l16) * CLD + ks * 32 + g4 * 8);
        const bf16x8 w0 = *(const bf16x8*)(Ws + (wn * 32 + l16) * CLD + ks * 32 + g4 * 8), w1 = *(const bf16x8*)(Ws + (wn * 32 + 16 + l16) * CLD + ks * 32 + g4 * 8);
        acc[0] = mfma16(w0, af, acc[0]); acc[1] = mfma16(w1, af, acc[1]);
      } };
    gl(0, ra, rw); if (nk > 1) gl(1, ra2, rw2);
    for (int kt = 0; kt < nk; kt += 2) { stepk(kt, ra, rw); if (kt + 1 < nk) stepk(kt + 1, ra2, rw2); }
    const int m = (int)row0 + wm * 16 + l16, n = nt * 64 + wn * 32 + 4 * g4;
    epi(m, n, acc[0]); epi(m, n + 16, acc[1]);
  }
  __syncthreads();
}
struct EpiSwiglu { static constexpr bool PAIR = true; bf16_t* u;
  DI void pair(int m, int f, f32x4 gt, f32x4 up) const { f32x4 r; r[0] = siluf(gt[0]) * up[0]; r[1] = siluf(gt[1]) * up[1]; r[2] = siluf(gt[2]) * up[2]; r[3] = siluf(gt[3]) * up[3]; st4bf(u + (size_t)m * FF + f, r); } };
struct EpiRetQK { static constexpr bool PAIR = false; bf16_t* qk; const float2* tabR;
  DI void operator()(int m, int n, f32x4 v) const { const int b = m / PB, pp = m - b * PB;
    if (pp >= LC) { const int pos = pp - LC, row = pos >> 6, col = pos & 63; const int j0 = (n & 255) >> 1;
      const int vv = j0 < 64 ? row : col; const float2 c0 = tabR[vv * 64 + (j0 & 63)], c1 = tabR[vv * 64 + ((j0 + 1) & 63)];
      const float a0 = v[0] * c0.x - v[1] * c0.y, b0 = v[0] * c0.y + v[1] * c0.x, a1 = v[2] * c1.x - v[3] * c1.y, b1 = v[2] * c1.y + v[3] * c1.x; v = (f32x4){a0, b0, a1, b1}; }
    if (n >= 1024) v = v * 0.0625f;
    st4bf(qk + (size_t)m * 2048 + n, v); } };
struct EpiHg { static constexpr bool PAIR = false; bf16_t* ph;
  DI void operator()(int m, int n, f32x4 v) const { if (n < 1024) { v[0] = siluf(v[0]); v[1] = siluf(v[1]); v[2] = siluf(v[2]); v[3] = siluf(v[3]); v = v * 0.08838834764831845f; } st4bf(ph + (size_t)m * 5120 + n, v); } };
struct EpiMlaQ { static constexpr bool PAIR = false; bf16_t* q; const float* rs; const float2* tabM;
  DI void operator()(int m, int n, f32x4 v) const { v = v * (rs[2 * m] * 0.10206207261596577f * LOG2E); const int h = n / 96, w = n - h * 96; const int b = m / PB, pp = m - b * PB;
    if (w >= 64 && pp >= LC) { const int pos = pp - LC, row = pos >> 6, col = pos & 63; const int j0 = (w - 64) >> 1; const int vv = j0 < 8 ? row : col; const float2 c0 = tabM[vv * 8 + (j0 & 7)], c1 = tabM[vv * 8 + ((j0 + 1) & 7)];
      const float a0 = v[0] * c0.x - v[1] * c0.y, b0 = v[0] * c0.y + v[1] * c0.x, a1 = v[2] * c1.x - v[3] * c1.y, b1 = v[2] * c1.y + v[3] * c1.x; v = (f32x4){a0, b0, a1, b1}; }
    st4bf(q + (size_t)m * 1536 + n, v); } };
struct EpiMlaK { static constexpr bool PAIR = false; bf16_t* k; const float* rs;
  DI void operator()(int m, int n, f32x4 v) const { v = v * rs[2 * m + 1]; st4bf(k + (size_t)m * 1536 + (n >> 6) * 96 + (n & 63), v); } };

DI void mla_stats_phase(const Params& p) {
  const bf16_t* cqb = (const bf16_t*)(p.ws + M_D0); const bf16_t* ckvb = (const bf16_t*)(p.ws + M_CKV); const bf16_t* krb = (const bf16_t*)(p.ws + M_KR); bf16_t* km = (bf16_t*)(p.ws + M_K); float* rs = (float*)(p.ws + OFF_RS); const float2* tabM = (const float2*)(p.ws + OFF_TABM);
  const int tid = threadIdx.x, lane = tid & 63, gw = blockIdx.x * 8 + (tid >> 6), nw = gridDim.x * 8;
  for (int t = gw; t < T_ALL; t += nw) {
    const bf16_t* r = krb + (size_t)t * 32;
    const u32x4 a = *(const u32x4*)(cqb + (size_t)t * 512 + lane * 8); const u32x2 c = *(const u32x2*)(ckvb + (size_t)t * 256 + lane * 4);
    float sq = bflo(a.x) * bflo(a.x) + bfhi(a.x) * bfhi(a.x) + bflo(a.y) * bflo(a.y) + bfhi(a.y) * bfhi(a.y) + bflo(a.z) * bflo(a.z) + bfhi(a.z) * bfhi(a.z) + bflo(a.w) * bflo(a.w) + bfhi(a.w) * bfhi(a.w);
    float sk = bflo(c.x) * bflo(c.x) + bfhi(c.x) * bfhi(c.x) + bflo(c.y) * bflo(c.y) + bfhi(c.y) * bfhi(c.y);
#pragma unroll
    for (int o = 1; o < 64; o <<= 1) { sq += __shfl_xor(sq, o); sk += __shfl_xor(sk, o); }
    if (lane == 0) { rs[2 * t] = rsqrtf(sq * (1.f / 512.f) + 1e-6f); rs[2 * t + 1] = rsqrtf(sk * (1.f / 256.f) + 1e-6f); }
    if (lane < 16) { const int j = lane; float x1 = bf2f(r[j]), x2 = bf2f(r[16 + j]); const int b = t / PB, pp = t - b * PB;
      if (pp >= LC) { const int pos = pp - LC, row = pos >> 6, col = pos & 63; const float2 cs = tabM[(j < 8 ? row : col) * 8 + (j & 7)]; const float o1 = x1 * cs.x - x2 * cs.y, o2 = x1 * cs.y + x2 * cs.x; x1 = o1; x2 = o2; }
      const unsigned pr = pk2(x1, x2);
#pragma unroll
      for (int h = 0; h < 16; ++h) *(unsigned*)(km + (size_t)t * 1536 + h * 96 + 64 + 2 * j) = pr; }
  }
}

constexpr int KLD = 104, VLD = 72;
DI void mla_attn_phase(const Params& p, char* lds) {
  const bf16_t* Qm = (const bf16_t*)(p.ws + M_Q); const bf16_t* Km = (const bf16_t*)(p.ws + M_K); const bf16_t* vT = (const bf16_t*)(p.ws + M_VT); bf16_t* o = (bf16_t*)(p.ws + OFF_A);
  const int tid = threadIdx.x, lane = tid & 63, w = tid >> 6, c = lane & 31, hh = lane >> 5;
  constexpr int KB = 64 * KLD, VB = 64 * VLD;
  bf16_t* Ks = (bf16_t*)lds; bf16_t* Vs = Ks + 3 * KB;
  for (int item = blockIdx.x; item < 2048 + 64; item += gridDim.x) {
    int b, h, qbase, nkt;
    if (item < 2048) { b = item >> 9; h = (item >> 5) & 15; qbase = LC + (item & 31) * 256; nkt = 132; } else { const int it = item - 2048; b = it >> 4; h = it & 15; qbase = 0; nkt = 4; }
    const size_t tokbase = (size_t)b * PB;
    const bf16_t* qp = Qm + (tokbase + qbase + w * 32 + c) * 1536 + h * 96 + hh * 8;
    bf16x8 qf[6];
#pragma unroll
    for (int ks = 0; ks < 6; ++ks) qf[ks] = *(const bf16x8*)(qp + ks * 16);
    const bf16_t* kg = Km + tokbase * 1536 + h * 96; const bf16_t* vg = vT + (size_t)(b * 16 + h) * 64 * PB;
    const int kr0 = tid / 12, kc0 = tid - kr0 * 12, e1 = tid + NTHR, kr1 = e1 / 12, kc1 = e1 - kr1 * 12; const bool k1ok = e1 < 768; const int vd = tid >> 3, vc = tid & 7;
    u32x4 rk0, rk1 = (u32x4){0, 0, 0, 0}, rv;
    auto gload = [&](int t) { const size_t key0 = (size_t)t * 64;
      rk0 = *(const u32x4*)(kg + (key0 + kr0) * 1536 + kc0 * 8); if (k1ok) rk1 = *(const u32x4*)(kg + (key0 + kr1) * 1536 + kc1 * 8); rv = *(const u32x4*)(vg + (size_t)vd * PB + key0 + vc * 8); };
    auto lstore = [&](int buf) { bf16_t* Kn = Ks + buf * KB; bf16_t* Vn = Vs + buf * VB;
      *(u32x4*)(Kn + kr0 * KLD + kc0 * 8) = rk0; if (k1ok) *(u32x4*)(Kn + kr1 * KLD + kc1 * 8) = rk1; *(u32x4*)(Vn + vd * VLD + vc * 8) = rv; };
    f32x16 oacc[2];
#pragma unroll
    for (int i = 0; i < 16; ++i) { oacc[0][i] = 0.f; oacc[1][i] = 0.f; }
    float mrow = -1e30f, lsum = 0.f;
    auto qk = [&](int buf, f32x16 (&s)[2]) { const bf16_t* Kc = Ks + buf * KB;
#pragma unroll
      for (int j = 0; j < 2; ++j) {
#pragma unroll
        for (int i = 0; i < 16; ++i) s[j][i] = 0.f;
#pragma unroll
        for (int ks = 0; ks < 6; ++ks) { const bf16x8 kf = *(const bf16x8*)(Kc + (32 * j + c) * KLD + ks * 16 + hh * 8); s[j] = mfma32(kf, qf[ks], s[j]); }
      } };
    auto smpv = [&](int buf, f32x16 (&s)[2]) { const bf16_t* Vc = Vs + buf * VB;
      float mx = s[0][0];
#pragma unroll
      for (int j = 0; j < 2; ++j)
#pragma unroll
        for (int i = 0; i < 16; ++i) mx = fmaxf(mx, s[j][i]);
      if (__builtin_amdgcn_ballot_w64(mx > mrow + 8.f) != 0ull) {
        mx = fmaxf(mx, __shfl_xor(mx, 32));
        const float mnew = fmaxf(mrow, mx), alpha = __builtin_amdgcn_exp2f(mrow - mnew); mrow = mnew;
        lsum *= alpha;
#pragma unroll
        for (int i = 0; i < 16; ++i) { oacc[0][i] *= alpha; oacc[1][i] *= alpha; }
      }
      float ps0 = 0.f, ps1 = 0.f;
#pragma unroll
      for (int j = 0; j < 2; ++j)
#pragma unroll
        for (int i = 0; i < 16; i += 2) { s[j][i] = __builtin_amdgcn_exp2f(s[j][i] - mrow); ps0 += s[j][i]; s[j][i + 1] = __builtin_amdgcn_exp2f(s[j][i + 1] - mrow); ps1 += s[j][i + 1]; }
      lsum += ps0 + ps1;
#pragma unroll
      for (int j = 0; j < 2; ++j)
#pragma unroll
        for (int sx = 0; sx < 2; ++sx) {
          const bf16x8 pf = pack8(s[j][8 * sx], s[j][8 * sx + 1], s[j][8 * sx + 2], s[j][8 * sx + 3], s[j][8 * sx + 4], s[j][8 * sx + 5], s[j][8 * sx + 6], s[j][8 * sx + 7]);
#pragma unroll
          for (int dt = 0; dt < 2; ++dt) { const bf16_t* vp = Vc + (32 * dt + c) * VLD + 32 * j + 16 * sx + 4 * hh;
            const bf16x8 vf = cat44(*(const s16x4*)vp, *(const s16x4*)(vp + 8)); oacc[dt] = mfma32(vf, pf, oacc[dt]); }
        } };
    __syncthreads();
    gload(0); lstore(0); gload(1); lstore(1); if (nkt > 2) gload(2);
    __syncthreads();
    f32x16 sA[2], sB[2];
    qk(0, sA);
    int b0 = 0, b1 = 1, b2 = 2;
    for (int kt = 0; kt < nkt; kt += 2) {
      __syncthreads();
      if (kt + 2 < nkt) { lstore(b2); if (kt + 3 < nkt) gload(kt + 3); }
      qk(b1, sB);
      smpv(b0, sA);
      __syncthreads();
      if (kt + 3 < nkt) { lstore(b0); if (kt + 4 < nkt) gload(kt + 4); }
      if (kt + 2 < nkt) qk(b2, sA);
      smpv(b1, sB);
      { const int t0 = b0; b0 = b2; b2 = b1; b1 = t0; }
    }
    lsum += __shfl_xor(lsum, 32); const float inv = 1.f / lsum;
    bf16_t* op = o + (tokbase + qbase + w * 32 + c) * 1024 + h * 64 + 4 * hh;
#pragma unroll
    for (int dt = 0; dt < 2; ++dt)
#pragma unroll
      for (int rg = 0; rg < 4; ++rg) st4bf(op + 32 * dt + 8 * rg, (f32x4){oacc[dt][4 * rg] * inv, oacc[dt][4 * rg + 1] * inv, oacc[dt][4 * rg + 2] * inv, oacc[dt][4 * rg + 3] * inv});
  }
}

template <int N> DI void pin_frags(bf16x8 (&f)[N]) {
  if constexpr (N == 8) asm volatile("" : "+v"(f[0]), "+v"(f[1]), "+v"(f[2]), "+v"(f[3]), "+v"(f[4]), "+v"(f[5]), "+v"(f[6]), "+v"(f[7]));
  else if constexpr (N == 4) asm volatile("" : "+v"(f[0]), "+v"(f[1]), "+v"(f[2]), "+v"(f[3]));
  else if constexpr (N == 2) asm volatile("" : "+v"(f[0]), "+v"(f[1]));
}
constexpr int NKC = 72, NVC = 264;
constexpr int NWK = 72, NWV = 584;
constexpr int NA_OFF_VC = 256 * NKC * 2, NA_OFF_RPB = NA_OFF_VC + 64 * NVC * 2, NA_OFF_W = NA_OFF_RPB + 1920, NA_LDS = NA_OFF_W + 576 * NWK * 2;
static_assert(64 * NWV * 2 <= 576 * NWK * 2 && NA_OFF_W % 16 == 0, "NA window");
DI void na_ctx_wave(const bf16_t* __restrict__ Q, bf16_t* __restrict__ o, const bf16_t* Kc, const bf16_t* Vc, int b, int h, int qb, int lane) {
  const int g = lane >> 4, l16 = lane & 15; const size_t tokbase = (size_t)b * PB; const int qpos = qb * 16 + l16;
  const bf16_t* qp = Q + (tokbase + qpos) * 1024 + h * 64 + g * 8;
  const bf16x8 q0 = *(const bf16x8*)qp, q1 = *(const bf16x8*)(qp + 32);
  f32x4 S[16];
#pragma unroll
  for (int kt = 0; kt < 16; ++kt) { const bf16_t* kp = Kc + (16 * kt + l16) * NKC + g * 8;
    f32x4 s = mfma16(*(const bf16x8*)kp, q0, (f32x4){0.f, 0.f, 0.f, 0.f}); s = mfma16(*(const bf16x8*)(kp + 32), q1, s); S[kt] = s * LOG2E; }
  float mx = S[0][0];
#pragma unroll
  for (int kt = 0; kt < 16; ++kt) mx = fmaxf(fmaxf(fmaxf(mx, S[kt][0]), fmaxf(S[kt][1], S[kt][2])), S[kt][3]);
  mx = fmaxf(mx, __shfl_xor(mx, 16)); mx = fmaxf(mx, __shfl_xor(mx, 32));
  float ls = 0.f;
#pragma unroll
  for (int kt = 0; kt < 16; ++kt)
#pragma unroll
    for (int rr = 0; rr < 4; ++rr) { S[kt][rr] = __builtin_amdgcn_exp2f(S[kt][rr] - mx); ls += S[kt][rr]; }
  ls += __shfl_xor(ls, 16); ls += __shfl_xor(ls, 32);
  f32x4 O[4];
#pragma unroll
  for (int dt = 0; dt < 4; ++dt) O[dt] = (f32x4){0.f, 0.f, 0.f, 0.f};
#pragma unroll
  for (int kk = 0; kk < 8; ++kk) {
    const bf16x8 pf = pack8(S[2 * kk][0], S[2 * kk][1], S[2 * kk][2], S[2 * kk][3], S[2 * kk + 1][0], S[2 * kk + 1][1], S[2 * kk + 1][2], S[2 * kk + 1][3]);
#pragma unroll
    for (int dt = 0; dt < 4; ++dt) { const bf16_t* vp = Vc + (dt * 16 + l16) * NVC + 32 * kk + 4 * g; const bf16x8 vf = cat44(*(const s16x4*)vp, *(const s16x4*)(vp + 16)); O[dt] = mfma16(vf, pf, O[dt]); }
  }
  const float inv = 1.f / ls; bf16_t* op = o + (tokbase + qpos) * 1024 + h * 64 + 4 * g;
#pragma unroll
  for (int dt = 0; dt < 4; ++dt) st4bf(op + 16 * dt, O[dt] * inv);
}
DI void na_attn_phase(const Params& p, char* lds) {
  const bf16_t* Q = (const bf16_t*)(p.ws + N_Q); const bf16_t* K = (const bf16_t*)(p.ws + N_K); const bf16_t* vT = (const bf16_t*)(p.ws + N_VT); bf16_t* o = (bf16_t*)(p.ws + OFF_A);
  bf16_t* Kc = (bf16_t*)lds; bf16_t* Vc = (bf16_t*)(lds + NA_OFF_VC); float* rl = (float*)(lds + NA_OFF_RPB); bf16_t* W = (bf16_t*)(lds + NA_OFF_W);
  const int tid = threadIdx.x, lane = tid & 63, w = tid >> 6, g = lane >> 4, l16 = lane & 15;
  for (int item = blockIdx.x; item < 256; item += gridDim.x) {
    const int qtr = item & 3, h = (item >> 2) & 15, b = item >> 6; const size_t tokbase = (size_t)b * PB;
    const bf16_t* kbase = K + (tokbase + LC) * 1024 + h * 64; const bf16_t* vbase = vT + (size_t)(b * 16 + h) * 64 * PB + LC;
    __syncthreads();
#pragma unroll
    for (int i = 0; i < 4; ++i) { const int e = tid + NTHR * i; const int key = e >> 3, kc = e & 7; *(u32x4*)(Kc + key * NKC + kc * 8) = *(const u32x4*)(K + (tokbase + key) * 1024 + h * 64 + kc * 8); }
#pragma unroll
    for (int i = 0; i < 4; ++i) { const int e = tid + NTHR * i; const int d = e >> 5, pc = e & 31; *(u32x4*)(Vc + d * NVC + pc * 8) = *(const u32x4*)(vT + ((size_t)(b * 16 + h) * 64 + d) * PB + pc * 8); }
    for (int e = tid; e < 465; e += NTHR) rl[e] = p.na_rpb[h * 465 + e];
    u32x4 rw[9];
#pragma unroll 1
    for (int j = 0; j < 16; ++j) {
      int ln = lane, tt = tid; asm volatile("" : "+v"(ln), "+v"(tt)); const int gg = ln >> 4, ll = ln & 15;
      const int r0 = qtr * 32 + 2 * j, rs0 = clampi(r0 - 4, 0, 120), r = r0 + (w >> 2), n = w & 3, rs = clampi(r - 4, 0, 120), dr = rs - rs0, band0 = clampi(16 * n - 8, 0, 32);
      const int qpos = LC + r * 64 + n * 16 + ll;
#pragma unroll
      for (int i = 0; i < 9; ++i) { const int e = tt + NTHR * i; rw[i] = *(const u32x4*)(kbase + (size_t)(rs0 * 64 + (e >> 3)) * 1024 + (e & 7) * 8); }
      __syncthreads();
#pragma unroll
      for (int i = 0; i < 9; ++i) { const int e = tt + NTHR * i; *(u32x4*)(W + (e >> 3) * NWK + (e & 7) * 8) = rw[i]; }
      __syncthreads();
      const bf16_t* qp = Q + (tokbase + qpos) * 1024 + h * 64 + gg * 8;
      const bf16x8 q0 = *(const bf16x8*)qp, q1 = *(const bf16x8*)(qp + 32);
      f32x4 S[32];
#pragma unroll
      for (int kg = 0; kg < 8; ++kg) {
        bf16x8 ka[4], kb[4];
#pragma unroll
        for (int u = 0; u < 4; ++u) { const int kt = 4 * kg + u;
          const bf16_t* kp = kt < 16 ? W + ((dr + (kt >> 1)) * 64 + band0 + 16 * (kt & 1) + ll) * NWK + gg * 8 : Kc + (16 * (kt - 16) + ll) * NKC + gg * 8;
          ka[u] = *(const bf16x8*)kp; kb[u] = *(const bf16x8*)(kp + 32); }
        pin_frags(ka); pin_frags(kb);
#pragma unroll
        for (int u = 0; u < 4; ++u) { const int kt = 4 * kg + u;
          f32x4 s = mfma16(ka[u], q0, (f32x4){0.f, 0.f, 0.f, 0.f}); s = mfma16(kb[u], q1, s);
          if (kt < 16) {
            const int qcol = 16 * n + ll, wstart = clampi(qcol - 8, 0, 48); const float* bp = rl + (rs + (kt >> 1) - r + 7) * 31;
#pragma unroll
            for (int rr = 0; rr < 4; ++rr) { const int kcol = band0 + 16 * (kt & 1) + 4 * gg + rr; const bool ok = kcol >= wstart && kcol < wstart + 16;
              s[rr] = ok ? (s[rr] + bp[clampi(kcol - qcol + 15, 0, 30)]) * LOG2E : -1e30f; }
          } else s = s * LOG2E;
          S[kt] = s; }
      }
      float mx = S[0][0];
#pragma unroll
      for (int kt = 0; kt < 32; ++kt) mx = fmaxf(fmaxf(fmaxf(mx, S[kt][0]), fmaxf(S[kt][1], S[kt][2])), S[kt][3]);
      mx = fmaxf(mx, __shfl_xor(mx, 16)); mx = fmaxf(mx, __shfl_xor(mx, 32));
      float ls = 0.f;
#pragma unroll
      for (int kt = 0; kt < 32; ++kt)
#pragma unroll
        for (int rr = 0; rr < 4; ++rr) { S[kt][rr] = __builtin_amdgcn_exp2f(S[kt][rr] - mx); ls += S[kt][rr]; }
      ls += __shfl_xor(ls, 16); ls += __shfl_xor(ls, 32);
      bf16x8 pf[16];
#pragma unroll
      for (int kk = 0; kk < 16; ++kk) pf[kk] = pack8(S[2 * kk][0], S[2 * kk][1], S[2 * kk][2], S[2 * kk][3], S[2 * kk + 1][0], S[2 * kk + 1][1], S[2 * kk + 1][2], S[2 * kk + 1][3]);
#pragma unroll
      for (int i = 0; i < 9; ++i) { const int e = tt + NTHR * i, d = e / 72, pc = e - d * 72; rw[i] = *(const u32x4*)(vbase + (size_t)d * PB + rs0 * 64 + pc * 8); }
      __syncthreads();
#pragma unroll
      for (int i = 0; i < 9; ++i) { const int e = tt + NTHR * i, d = e / 72, pc = e - d * 72; *(u32x4*)(W + d * NWV + pc * 8) = rw[i]; }
      __syncthreads();
      f32x4 O[4];
#pragma unroll
      for (int dt = 0; dt < 4; ++dt) O[dt] = (f32x4){0.f, 0.f, 0.f, 0.f};
#pragma unroll
      for (int kk = 0; kk < 16; ++kk) {
        bf16x8 vf[4];
#pragma unroll
        for (int dt = 0; dt < 4; ++dt) { const bf16_t* vp = kk < 8 ? W + (dt * 16 + ll) * NWV + (dr + kk) * 64 + band0 + 4 * gg : Vc + (dt * 16 + ll) * NVC + 32 * (kk - 8) + 4 * gg;
          vf[dt] = cat44(*(const s16x4*)vp, *(const s16x4*)(vp + 16)); }
        pin_frags(vf);
#pragma unroll
        for (int dt = 0; dt < 4; ++dt) O[dt] = mfma16(vf[dt], pf[kk], O[dt]);
      }
      const float inv = 1.f / ls; bf16_t* op = o + (tokbase + qpos) * 1024 + h * 64 + 4 * gg;
#pragma unroll
      for (int dt = 0; dt < 4; ++dt) st4bf(op + 16 * dt, O[dt] * inv);
    }
    if (w < 4) na_ctx_wave(Q, o, Kc, Vc, b, h, qtr * 4 + w, lane);
  }
}

template <int DK> struct ScanLds { static constexpr int QLD = DK + 8, TLD = 72;
  static constexpr int OFF_QD = 0, OFF_KD = OFF_QD + 64 * QLD * 2, OFF_VT = OFF_KD + 64 * QLD * 2, OFF_ATT = OFF_VT + 64 * TLD * 2, OFF_ST = OFF_ATT + 64 * TLD * 2, OFF_EB = OFF_ST + 64 * QLD * 2, OFF_QS = OFF_EB + DK * 4, TOTAL = OFF_QS + 8 * DK * 4; };
DI int scan_pos(int dir, int i, int tl) { if (dir == 0) return i * 64 + tl; return i < 4 ? 255 - (i * 64 + tl) : 8447 - ((i - 4) * 64 + tl); }
DI bf16x8 gather8(const bf16_t* p, int stride) {
  const unsigned a0 = p[0], a1 = p[stride], a2 = p[2 * stride], a3 = p[3 * stride], a4 = p[4 * stride], a5 = p[5 * stride], a6 = p[6 * stride], a7 = p[7 * stride];
  u32x4 r; r.x = a0 | (a1 << 16); r.y = a2 | (a3 << 16); r.z = a4 | (a5 << 16); r.w = a6 | (a7 << 16); return __builtin_bit_cast(bf16x8, r);
}

template <int DK, bool HG, int DVS>
DI void scan_phase(const Params& p, char* lds) {
  typedef ScanLds<DK> L;
  bf16_t* Qd = (bf16_t*)(lds + L::OFF_QD); bf16_t* Kd = (bf16_t*)(lds + L::OFF_KD); bf16_t* Vt = (bf16_t*)(lds + L::OFF_VT);
  bf16_t* Att = (bf16_t*)(lds + L::OFF_ATT); bf16_t* St = (bf16_t*)(lds + L::OFF_ST); float* eb = (float*)(lds + L::OFF_EB); float* qs = (float*)(lds + L::OFF_QS);
  constexpr int QLD = L::QLD, TLD = L::TLD, KT = DK / 16 / 8;
  const int tid = tid_(), lane = tid & 63, w = tid >> 6, g4 = lane >> 4, l16 = lane & 15;
  const int nitems = 256; constexpr int NVI = DVS / 16, NTO = NVI * 4 / 8;
  const float* lbv = (const float*)(p.ws + OFF_LBV);
  for (int item = blockIdx.x; item < nitems; item += gridDim.x) {
    const int xcd = item & 7, yy = item >> 3; int b, h, sl, dir;
    if (HG) { const int grp = xcd * 8 + (yy >> 2); sl = yy & 3; h = grp & 7; b = (grp >> 3) & 3; dir = grp >> 5; }
    else { const int grp = xcd * 4 + (yy >> 3); sl = yy & 7; h = grp & 3; b = (grp >> 2) & 3; dir = grp >> 4; }
    const size_t tokbase = (size_t)b * PB;
    const bf16_t *qsrc, *ksrc, *vsrc; int ldq, ldv; bf16_t *octx, *olat; int ldo;
    if (HG) { const bf16_t* ph = (const bf16_t*)(p.ws + H_P); qsrc = ph + h * 128; ksrc = ph + 1024 + dir * 1024 + h * 128; vsrc = ph + 3072 + h * 128 + sl * DVS; ldq = 5120; ldv = 5120; ldo = 1024;
      octx = (bf16_t*)(p.ws + (dir ? OFF_W0 : OFF_A)) + tokbase * 1024 + h * 128 + sl * DVS; olat = octx + (size_t)LC * 1024; }
    else { const bf16_t* qk = (const bf16_t*)(p.ws + R_QK); qsrc = qk + h * 256; ksrc = qk + 1024 + h * 256; vsrc = (const bf16_t*)(p.ws + R_V) + h * 512 + sl * 64; ldq = 2048; ldv = 2048; ldo = 2048;
      if (dir == 0) { octx = (bf16_t*)(p.ws + R_O) + tokbase * 2048 + h * 512 + sl * 64; olat = octx + (size_t)LC * 2048; }
      else { octx = (bf16_t*)(p.ws + OFF_HCTX) + (size_t)b * LC * 2048 + h * 512 + sl * 64; olat = (bf16_t*)p.out + (size_t)b * LL * 2048 + h * 512 + sl * 64; } }
    float lg = 0.f; if (!HG) lg = -__expf(p.ret_decay[dir * 4 + h]);
    float lb0 = 0.f, lb1 = 0.f; if (HG) { lb0 = lbv[h * 128 + 2 * (tid & 63)]; lb1 = lbv[h * 128 + 2 * (tid & 63) + 1]; }
    f32x4 sacc[KT][NVI];
#pragma unroll
    for (int a = 0; a < KT; ++a)
#pragma unroll
      for (int v = 0; v < NVI; ++v) sacc[a][v] = (f32x4){0.f, 0.f, 0.f, 0.f};
    u32x4 rq[4], rk[4], rvv; unsigned rf[8], rqq[8]; float bl[16], qv[16], kv[16];
    const int vtl = tid & 63, vvc = tid >> 6;
    auto issue = [&](int i) {
      if (HG) { const int kp = tid & 63, seg = tid >> 6;
#pragma unroll
        for (int j = 0; j < 8; ++j) { const size_t row = tokbase + scan_pos(dir, i, seg * 8 + j); rf[j] = *(const unsigned*)(ksrc + row * ldq + 2 * kp); rqq[j] = *(const unsigned*)(qsrc + row * ldq + 2 * kp); } }
      else {
#pragma unroll
        for (int it = 0; it < 4; ++it) { const int e = tid + NTHR * it, tl = e >> 5, kc = e & 31; const size_t row = tokbase + scan_pos(dir, i, tl); rq[it] = *(const u32x4*)(qsrc + row * ldq + kc * 8); rk[it] = *(const u32x4*)(ksrc + row * ldq + kc * 8); } }
      if (vvc < DVS / 8) { const size_t row = tokbase + scan_pos(dir, i, vtl); rvv = *(const u32x4*)(vsrc + row * ldv + vvc * 8); }
    };
    auto prep = [&]() {
      const int kp = tid & 63, seg = tid >> 6; float run0 = 1.f, run1 = 1.f;
#pragma unroll
      for (int j = 0; j < 8; ++j) { const float f0 = bflo(rf[j]), f1 = bfhi(rf[j]); qv[2 * j] = bflo(rqq[j]); qv[2 * j + 1] = bfhi(rqq[j]);
        const float s0 = __builtin_amdgcn_rcpf(1.f + __expf(-f0)), s1 = __builtin_amdgcn_rcpf(1.f + __expf(-f1)); const float g0 = lb0 + (1.f - lb0) * s0, g1 = lb1 + (1.f - lb1) * s1;
        kv[2 * j] = 1.f - g0; kv[2 * j + 1] = 1.f - g1; run0 *= g0; run1 *= g1; bl[2 * j] = run0; bl[2 * j + 1] = run1; }
      qs[seg * DK + 2 * kp] = run0; qs[seg * DK + 2 * kp + 1] = run1;
    };
    __syncthreads();
    issue(0); if (HG) prep();
    __syncthreads();
    for (int i = 0; i < 132; ++i) {
      if (HG) { const int kp = tid & 63, seg = tid >> 6; float off0 = 1.f, off1 = 1.f;
#pragma unroll
        for (int q = 0; q < 7; ++q) if (q < seg) { off0 *= qs[q * DK + 2 * kp]; off1 *= qs[q * DK + 2 * kp + 1]; }
        if (seg == 7) { eb[2 * kp] = off0 * bl[14]; eb[2 * kp + 1] = off1 * bl[15]; }
#pragma unroll
        for (int j = 0; j < 8; ++j) { const int tl = seg * 8 + j; const float p0 = bl[2 * j] * off0, p1 = bl[2 * j + 1] * off1;
          *(unsigned*)(Qd + tl * QLD + 2 * kp) = pk2(qv[2 * j] * p0, qv[2 * j + 1] * p1);
          *(unsigned*)(Kd + tl * QLD + 2 * kp) = pk2(kv[2 * j] * __builtin_amdgcn_rcpf(p0), kv[2 * j + 1] * __builtin_amdgcn_rcpf(p1)); } }
      else {
        if (tid < DK) eb[tid] = __expf(64.f * lg);
#pragma unroll
        for (int it = 0; it < 4; ++it) { const int e = tid + NTHR * it, tl = e >> 5, kc = e & 31; const u32x4 qr = rq[it], kr = rk[it];
          const float eq = __expf((float)(tl + 1) * lg), ek = __expf(-(float)(tl + 1) * lg);
          u32x4 qo, ko; qo.x = pk2(bflo(qr.x) * eq, bfhi(qr.x) * eq); qo.y = pk2(bflo(qr.y) * eq, bfhi(qr.y) * eq); qo.z = pk2(bflo(qr.z) * eq, bfhi(qr.z) * eq); qo.w = pk2(bflo(qr.w) * eq, bfhi(qr.w) * eq);
          ko.x = pk2(bflo(kr.x) * ek, bfhi(kr.x) * ek); ko.y = pk2(bflo(kr.y) * ek, bfhi(kr.y) * ek); ko.z = pk2(bflo(kr.z) * ek, bfhi(kr.z) * ek); ko.w = pk2(bflo(kr.w) * ek, bfhi(kr.w) * ek);
          *(u32x4*)(Qd + tl * QLD + kc * 8) = qo; *(u32x4*)(Kd + tl * QLD + kc * 8) = ko; } }
      if (vvc < DVS / 8) { bf16_t* vt = Vt + (vvc * 8) * TLD + vtl; const u32x4 vr = rvv;
        vt[0] = (bf16_t)(vr.x & 0xffff); vt[TLD] = (bf16_t)(vr.x >> 16); vt[2 * TLD] = (bf16_t)(vr.y & 0xffff); vt[3 * TLD] = (bf16_t)(vr.y >> 16);
        vt[4 * TLD] = (bf16_t)(vr.z & 0xffff); vt[5 * TLD] = (bf16_t)(vr.z >> 16); vt[6 * TLD] = (bf16_t)(vr.w & 0xffff); vt[7 * TLD] = (bf16_t)(vr.w >> 16); }
#pragma unroll
      for (int a = 0; a < KT; ++a) { const int ki = w * KT + a;
#pragma unroll
        for (int vi = 0; vi < NVI; ++vi) st4bf(St + (16 * vi + l16) * QLD + 16 * ki + 4 * g4, sacc[a][vi]); }
      __syncthreads();
      if (i + 1 < 132) issue(i + 1);
      { const int ti = w >> 1;
        bf16x8 qf[DK / 32];
#pragma unroll
        for (int ks = 0; ks < DK / 32; ++ks) qf[ks] = *(const bf16x8*)(Qd + (16 * ti + l16) * QLD + ks * 32 + g4 * 8);
#pragma unroll
        for (int u = 0; u < 2; ++u) { const int si = (2 * w + u) & 3; f32x4 d = (f32x4){0.f, 0.f, 0.f, 0.f};
          if (si <= ti) { bf16x8 kf[DK / 32];
#pragma unroll
            for (int ks = 0; ks < DK / 32; ++ks) kf[ks] = *(const bf16x8*)(Kd + (16 * si + l16) * QLD + ks * 32 + g4 * 8);
            pin_frags(kf);
#pragma unroll
            for (int ks = 0; ks < DK / 32; ++ks) d = mfma16(kf[ks], qf[ks], d); }
          const int t = 16 * ti + l16, s0 = 16 * si + 4 * g4;
#pragma unroll
          for (int rr = 0; rr < 4; ++rr) if (s0 + rr > t) d[rr] = 0.f;
          st4bf(Att + t * TLD + s0, d); } }
      __syncthreads();
      { const int vi = (NTO * w) >> 2;
        bf16x8 xv[2], xs[DK / 32];
#pragma unroll
        for (int ks = 0; ks < 2; ++ks) xv[ks] = *(const bf16x8*)(Vt + (16 * vi + l16) * TLD + ks * 32 + g4 * 8);
#pragma unroll
        for (int ks = 0; ks < DK / 32; ++ks) xs[ks] = *(const bf16x8*)(St + (16 * vi + l16) * QLD + ks * 32 + g4 * 8);
        pin_frags(xv); pin_frags(xs);
#pragma unroll
        for (int u = 0; u < NTO; ++u) { const int ti = (NTO * w + u) & 3; bf16x8 ya[2], yq[DK / 32];
#pragma unroll
          for (int ks = 0; ks < 2; ++ks) ya[ks] = *(const bf16x8*)(Att + (16 * ti + l16) * TLD + ks * 32 + g4 * 8);
#pragma unroll
          for (int ks = 0; ks < DK / 32; ++ks) yq[ks] = *(const bf16x8*)(Qd + (16 * ti + l16) * QLD + ks * 32 + g4 * 8);
          pin_frags(ya); pin_frags(yq);
          f32x4 d = (f32x4){0.f, 0.f, 0.f, 0.f};
#pragma unroll
          for (int ks = 0; ks < 2; ++ks) d = mfma16(xv[ks], ya[ks], d);
#pragma unroll
          for (int ks = 0; ks < DK / 32; ++ks) d = mfma16(xs[ks], yq[ks], d);
          const int pos = scan_pos(dir, i, 16 * ti + l16); bf16_t* op = (pos < LC ? octx + (size_t)pos * ldo : olat + (size_t)(pos - LC) * ldo) + 16 * vi + 4 * g4;
          st4bf(op, d); } }
      { bf16x8 yv[NVI][2];
#pragma unroll
        for (int vi = 0; vi < NVI; ++vi)
#pragma unroll
          for (int ks = 0; ks < 2; ++ks) yv[vi][ks] = *(const bf16x8*)(Vt + (16 * vi + l16) * TLD + ks * 32 + g4 * 8);
#pragma unroll
        for (int a = 0; a < KT; ++a) { const int ki = w * KT + a; bf16x8 xf[2];
#pragma unroll
          for (int ks = 0; ks < 2; ++ks) xf[ks] = gather8(Kd + (ks * 32 + g4 * 8) * QLD + 16 * ki + l16, QLD);
#pragma unroll
          for (int ks = 0; ks < 2; ++ks)
#pragma unroll
            for (int vi = 0; vi < NVI; ++vi) sacc[a][vi] = mfma16(xf[ks], yv[vi][ks], sacc[a][vi]);
          const f32x4 e4 = *(const f32x4*)(eb + 16 * ki + 4 * g4);
#pragma unroll
          for (int vi = 0; vi < NVI; ++vi) sacc[a][vi] = sacc[a][vi] * e4; } }
      if (HG && i + 1 < 132) prep();
      __syncthreads();
    }
  }
}

DI float bsum2(unsigned a, unsigned b, float& lo, float& hi) { lo = bflo(a) + bflo(b); hi = bfhi(a) + bfhi(b); return lo * lo + hi * hi; }
DI void ret_readout_phase(const Params& p) {
  bf16_t* O = (bf16_t*)(p.ws + R_O); const bf16_t* G = (const bf16_t*)(p.ws + R_QK);
  const int tid = threadIdx.x, lane = tid & 63, gw = blockIdx.x * 8 + (tid >> 6), nw = gridDim.x * 8;
  for (int t = gw; t < T_ALL; t += nw) {
    const int b = t / PB, pp = t - b * PB;
    const bf16_t* ob = (pp < LC ? (const bf16_t*)(p.ws + OFF_HCTX) + (size_t)(b * LC + pp) * 2048 : (const bf16_t*)p.out + (size_t)(b * LL + pp - LC) * 2048) + lane * 32;
    bf16_t* op = O + (size_t)t * 2048 + lane * 32; const bf16_t* gp = G + (size_t)t * 2048 + lane * 32;
    float ov[32]; u32x4 gv[4]; float sq = 0.f;
#pragma unroll
    for (int i = 0; i < 4; ++i) { const u32x4 x = *(const u32x4*)(op + i * 8), y = *(const u32x4*)(ob + i * 8); gv[i] = *(const u32x4*)(gp + i * 8);
      sq += bsum2(x.x, y.x, ov[8 * i], ov[8 * i + 1]) + bsum2(x.y, y.y, ov[8 * i + 2], ov[8 * i + 3]) + bsum2(x.z, y.z, ov[8 * i + 4], ov[8 * i + 5]) + bsum2(x.w, y.w, ov[8 * i + 6], ov[8 * i + 7]); }
    sq += __shfl_xor(sq, 1); sq += __shfl_xor(sq, 2); sq += __shfl_xor(sq, 4); sq += __shfl_xor(sq, 8);
    const float rstd = rsqrtf(sq * (1.f / 512.f) + 1e-6f);
#pragma unroll
    for (int i = 0; i < 4; ++i) { u32x4 r;
      r.x = pk2(siluf(bflo(gv[i].x)) * ov[8 * i] * rstd, siluf(bfhi(gv[i].x)) * ov[8 * i + 1] * rstd); r.y = pk2(siluf(bflo(gv[i].y)) * ov[8 * i + 2] * rstd, siluf(bfhi(gv[i].y)) * ov[8 * i + 3] * rstd);
      r.z = pk2(siluf(bflo(gv[i].z)) * ov[8 * i + 4] * rstd, siluf(bfhi(gv[i].z)) * ov[8 * i + 5] * rstd); r.w = pk2(siluf(bflo(gv[i].w)) * ov[8 * i + 6] * rstd, siluf(bfhi(gv[i].w)) * ov[8 * i + 7] * rstd);
      *(u32x4*)(op + i * 8) = r; }
  }
}
DI void hg_readout_phase(const Params& p) {
  bf16_t* O = (bf16_t*)(p.ws + OFF_A); const bf16_t* OB = (const bf16_t*)(p.ws + OFF_W0); const bf16_t* ph = (const bf16_t*)(p.ws + H_P);
  const int tid = threadIdx.x, lane = tid & 63, gw = blockIdx.x * 8 + (tid >> 6), nw = gridDim.x * 8;
  for (int t = gw; t < T_ALL; t += nw) {
    bf16_t* op = O + (size_t)t * 1024 + lane * 16; const bf16_t* ob = OB + (size_t)t * 1024 + lane * 16; const bf16_t* gp = ph + (size_t)t * 5120 + 4096 + lane * 16; const float* ng = p.hg_norm_g + (lane & 7) * 16;
    float ov[16]; u32x4 gv[2]; float sq = 0.f;
#pragma unroll
    for (int i = 0; i < 2; ++i) { const u32x4 x = *(const u32x4*)(op + i * 8), y = *(const u32x4*)(ob + i * 8); gv[i] = *(const u32x4*)(gp + i * 8);
      sq += bsum2(x.x, y.x, ov[8 * i], ov[8 * i + 1]) + bsum2(x.y, y.y, ov[8 * i + 2], ov[8 * i + 3]) + bsum2(x.z, y.z, ov[8 * i + 4], ov[8 * i + 5]) + bsum2(x.w, y.w, ov[8 * i + 6], ov[8 * i + 7]); }
    sq += __shfl_xor(sq, 1); sq += __shfl_xor(sq, 2); sq += __shfl_xor(sq, 4);
    const float rstd = rsqrtf(sq * (1.f / 128.f) + 1e-6f);
#pragma unroll
    for (int i = 0; i < 2; ++i) { u32x4 r; const float* n8 = ng + i * 8;
      r.x = pk2(siluf(bflo(gv[i].x)) * ov[8 * i] * rstd * n8[0], siluf(bfhi(gv[i].x)) * ov[8 * i + 1] * rstd * n8[1]); r.y = pk2(siluf(bflo(gv[i].y)) * ov[8 * i + 2] * rstd * n8[2], siluf(bfhi(gv[i].y)) * ov[8 * i + 3] * rstd * n8[3]);
      r.z = pk2(siluf(bflo(gv[i].z)) * ov[8 * i + 4] * rstd * n8[4], siluf(bfhi(gv[i].z)) * ov[8 * i + 5] * rstd * n8[5]); r.w = pk2(siluf(bflo(gv[i].w)) * ov[8 * i + 6] * rstd * n8[6], siluf(bfhi(gv[i].w)) * ov[8 * i + 7] * rstd * n8[7]);
      *(u32x4*)(op + i * 8) = r; }
  }
}

#define XB_TMO      128
#define XB_XCNT(j)  (256  + 64 * (j))
#define XB_XSUB(j)  (1280 + 64 * (j))
#define XB_XGEN(j)  (2304 + 64 * (j))
#define XB_TOP      3328
#define XB_TOPGEN   3392
#define XCD_BAR_WORDS 3456
#define XB_SPIN_CAP (1u << 23)
#define LAS PG8_LAS

__device__ __forceinline__ unsigned xb_ld(unsigned* p)              { return __hip_atomic_load(p, __ATOMIC_RELAXED, __HIP_MEMORY_SCOPE_AGENT); }
__device__ __forceinline__ unsigned xb_add(unsigned* p, unsigned v) { return __hip_atomic_fetch_add(p, v, __ATOMIC_RELAXED, __HIP_MEMORY_SCOPE_AGENT); }
__device__ __forceinline__ unsigned xb_xcc_id() { return (unsigned)__builtin_amdgcn_s_getreg((3 << 11) | 20) & 0xFu; }
#define XB_SPIN(cond, bar) do { unsigned _sp = 0; while (cond) { __builtin_amdgcn_s_sleep(1); \
    if ((++_sp & 255u) == 0u) { if (xb_ld(&(bar)[XB_TMO])) break; if (_sp > XB_SPIN_CAP) { atomicAdd(&(bar)[XB_TMO], 1u); break; } } } } while (0)

struct XcdBarrier {
    unsigned* bar; unsigned x;
    volatile LAS unsigned* st;
};

__device__ __forceinline__ XcdBarrier xcd_barrier_post(unsigned* bar, volatile LAS unsigned* st) {
    XcdBarrier b; b.bar = bar; b.x = xb_xcc_id(); b.st = st;
    if (threadIdx.x == 0) (void)xb_add(&bar[XB_XCNT(b.x)], 1u);
    return b;
}
__device__ __forceinline__ void xcd_barrier_complete(unsigned* bar, unsigned x, unsigned& nloc, unsigned& nx) {
    const unsigned G = gridDim.x * gridDim.y * gridDim.z;
    unsigned sum, cnt, mine, sp = 0u;
    for (;;) {
        sum = 0u; cnt = 0u; mine = 0u;
#pragma unroll
        for (unsigned j = 0; j < 16; ++j) { const unsigned c = xb_ld(&bar[XB_XCNT(j)]); sum += c; cnt += (c > 0u) ? 1u : 0u; mine = (j == x) ? c : mine; }
        if (sum == G) break;
        __builtin_amdgcn_s_sleep(1);
        if ((++sp & 255u) == 0u) { if (xb_ld(&bar[XB_TMO])) break; if (sp > XB_SPIN_CAP) { atomicAdd(&bar[XB_TMO], 1u); break; } }
    }
    nloc = mine > 0u ? mine : 1u; nx = cnt > 0u ? cnt : 1u;
}

__device__ __forceinline__ void xcd_barrier(const XcdBarrier& b) {
    asm volatile("s_waitcnt vmcnt(0)" ::: "memory");
    __syncthreads();
    if (threadIdx.x == 0) {
        unsigned* bar = b.bar;
        __builtin_amdgcn_s_waitcnt(0);
        unsigned nloc = b.st[0], nx = b.st[1];
        if (nloc == 0u) { xcd_barrier_complete(bar, b.x, nloc, nx); b.st[0] = nloc; b.st[1] = nx; }
        const unsigned old = xb_add(&bar[XB_XSUB(b.x)], 1u);
        const unsigned gen = old / nloc;
        if (old + 1u == (gen + 1u) * nloc) {
            __builtin_amdgcn_fence(__ATOMIC_RELEASE, "agent");
            asm volatile("s_waitcnt vmcnt(0)" ::: "memory");
            const unsigned og = xb_add(&bar[XB_TOP], 1u);
            const unsigned tg = og / nx;
            if (og + 1u == (tg + 1u) * nx) xb_add(&bar[XB_TOPGEN], 1u);
            else XB_SPIN(xb_ld(&bar[XB_TOPGEN]) == tg, bar);
            __builtin_amdgcn_fence(__ATOMIC_ACQUIRE, "agent");
            xb_add(&bar[XB_XGEN(b.x)], 1u);
            asm volatile("s_waitcnt vmcnt(0)" ::: "memory");
        } else {
            XB_SPIN(xb_ld(&bar[XB_XGEN(b.x)]) == gen, bar);
            __builtin_amdgcn_fence(__ATOMIC_ACQUIRE, "agent");
            asm volatile("s_waitcnt vmcnt(0)" ::: "memory");
        }
    }
    __syncthreads();
}

constexpr int LDS_BYTES0 = ScanLds<256>::TOTAL > pg8::STAGE_BYTES ? ScanLds<256>::TOTAL : pg8::STAGE_BYTES;
constexpr int LDS_BYTES = LDS_BYTES0 > NA_LDS ? LDS_BYTES0 : NA_LDS;
static_assert(LDS_BYTES <= 163840, "LDS");
static_assert(LDS_BYTES >= (256 + 128) * LDT * 2 && LDS_BYTES >= 3 * 64 * (KLD + VLD) * 2 && LDS_BYTES >= (5120 + 8 * 5 * 64) * 4, "LDS phases");

DI void ffn_and_ln(const Params& p, const XcdBarrier& xb, char* lds, int layer, const bf16_t* w13, const bf16_t* w2) {
  const float* mods = (const float*)(p.ws + OFF_MODS); float* hctx = (float*)(p.ws + OFF_HCTX); bf16_t* a = (bf16_t*)(p.ws + OFF_A); bf16_t* U = (bf16_t*)(p.ws + F_U);
  { EpiSwiglu e{U}; big_gemm(a, w13, T_ALL, 5632, 1024, e, lds, layer == 3); }
  xcd_barrier(xb);
  { EpiResid e{p.out, hctx, p.out, hctx, mods + (size_t)layer * 5 * 6144 + 5 * 1024, (const float2*)(p.ws + OFF_LNS), p.ln_g + (size_t)(layer * 2) * 1024, p.ln_b + (size_t)(layer * 2) * 1024}; big_gemm(U, w2, T_ALL, 1024, FF, e, lds, 1); if (layer < 3) ctx_gemm(U, w2, FF, e, lds); }
  xcd_barrier(xb);
  ln_phase(p, layer, 1, layer < 3 ? layer + 1 : 3, 0, layer == 3);
  xcd_barrier(xb);
}

__global__ void __launch_bounds__(NTHR) mega(Params p) {
  __shared__ __attribute__((aligned(16))) char lds[LDS_BYTES];
  cg::grid_group grid = cg::this_grid();
  __shared__ uint4 xb_words;
  if (threadIdx.x == 0) xb_words = make_uint4(0u, 0u, 0u, 0u);
  __syncthreads();
  const XcdBarrier xb = xcd_barrier_post((unsigned*)(p.ws + OFF_BAR), (volatile LAS unsigned*)&xb_words);
  float* ldsf = (float*)lds;
  const float* mods = (const float*)(p.ws + OFF_MODS); float* hctx = (float*)(p.ws + OFF_HCTX); bf16_t* a = (bf16_t*)(p.ws + OFF_A);
  const float2* tabR = (const float2*)(p.ws + OFF_TABR); const float2* tabM = (const float2*)(p.ws + OFF_TABM); float* rs = (float*)(p.ws + OFF_RS);
  ada_phase(p, ldsf);
  tables_phase(p);
  convert_w<2>(p.ret_w_in, 6144, 1024, (bf16_t*)(p.ws + W0_RETIN), 6144, nullptr, ldsf);
  convert_w<0>(p.ret_w_out, 1024, 2048, (bf16_t*)(p.ws + W0_RETOUT), 1024, nullptr, ldsf);
  convert_w<1>(p.w13, 5632, 1024, (bf16_t*)(p.ws + W0_W13), 5632, nullptr, ldsf);
  convert_w<0>(p.w2, 1024, FF, (bf16_t*)(p.ws + W0_W2), 1024, nullptr, ldsf);
  grid.sync();
  modulate_phase(p, p.x, p.ctx, 0);
  xcd_barrier(xb);
  { const bf16_t* wi = (const bf16_t*)(p.ws + W0_RETIN);
    { EpiRetQK e{(bf16_t*)(p.ws + R_QK), tabR}; big_gemm(a, wi, T_ALL, 2048, 1024, e, lds, 1); ctx_gemm(a, wi, 1024, e, lds, 2048); }
    { EpiStore e{(bf16_t*)(p.ws + R_V), (bf16_t*)(p.ws + R_V), 1 << 30, 2048, 2048, 1.f}; big_gemm(a, wi + (size_t)2048 * 1024, T_ALL, 2048, 1024, e, lds, 1); ctx_gemm(a, wi + (size_t)2048 * 1024, 1024, e, lds, 2048); }
    xcd_barrier(xb);
    scan_phase<256, false, 64>(p, lds);
    xcd_barrier(xb);
    { EpiStore e{(bf16_t*)(p.ws + R_QK), (bf16_t*)(p.ws + R_QK), 1 << 30, 2048, 2048, 1.f}; big_gemm(a, wi + (size_t)4096 * 1024, T_ALL, 2048, 1024, e, lds, 1); ctx_gemm(a, wi + (size_t)4096 * 1024, 1024, e, lds, 2048); }
    xcd_barrier(xb);
    ret_readout_phase(p);
    xcd_barrier(xb);
    { EpiResid e{p.x, p.ctx, p.out, hctx, mods + 2 * 1024, nullptr, nullptr, nullptr}; big_gemm((const bf16_t*)(p.ws + R_O), (const bf16_t*)(p.ws + W0_RETOUT), T_ALL, 1024, 2048, e, lds, 1); ctx_gemm((const bf16_t*)(p.ws + R_O), (const bf16_t*)(p.ws + W0_RETOUT), 2048, e, lds); }
    xcd_barrier(xb);
    ln_phase(p, 0, 0, 0, 3, false);
    convert_w<0>(p.na_w_qkv, 3072, 1024, (bf16_t*)(p.ws + W1_QKV), 3072, nullptr, ldsf);
    convert_w<0>(p.na_w_out, 1024, 1024, (bf16_t*)(p.ws + W1_OUT), 1024, nullptr, ldsf);
    convert_w<1>(p.w13 + (size_t)1 * 1024 * 5632, 5632, 1024, (bf16_t*)(p.ws + W1_W13), 5632, nullptr, ldsf);
    convert_w<0>(p.w2 + (size_t)1 * FF * 1024, 1024, FF, (bf16_t*)(p.ws + W1_W2), 1024, nullptr, ldsf);
    convert_w<5>(p.mla_w_down, 800, 1024, (bf16_t*)(p.ws + W2_DOWN), 1024, nullptr, ldsf);
    convert_w<3>(p.mla_w_uq, 1536, 512, (bf16_t*)(p.ws + W2_UQ), 1536, p.mla_q_norm, ldsf);
    convert_w<4>(p.mla_w_ukv, 2048, 256, (bf16_t*)(p.ws + W2_UKV), 2048, p.mla_kv_norm, ldsf);
    convert_w<0>(p.mla_w_out, 1024, 1024, (bf16_t*)(p.ws + W2_OUT), 1024, nullptr, ldsf);
    convert_w<1>(p.w13 + (size_t)2 * 1024 * 5632, 5632, 1024, (bf16_t*)(p.ws + W2_W13), 5632, nullptr, ldsf);
    convert_w<0>(p.w2 + (size_t)2 * FF * 1024, 1024, FF, (bf16_t*)(p.ws + W2_W2), 1024, nullptr, ldsf);
    convert_w<0>(p.hg_w_in, 5120, 1024, (bf16_t*)(p.ws + W3_IN), 5120, nullptr, ldsf);
    convert_w<0>(p.hg_w_out, 1024, 1024, (bf16_t*)(p.ws + W3_OUT), 1024, nullptr, ldsf);
    convert_w<1>(p.w13 + (size_t)3 * 1024 * 5632, 5632, 1024, (bf16_t*)(p.ws + W3_W13), 5632, nullptr, ldsf);
    convert_w<0>(p.w2 + (size_t)3 * FF * 1024, 1024, FF, (bf16_t*)(p.ws + W3_W2), 1024, nullptr, ldsf);
    xcd_barrier(xb);
    ffn_and_ln(p, xb, lds, 0, (const bf16_t*)(p.ws + W0_W13), (const bf16_t*)(p.ws + W0_W2));
  }
  { const bf16_t* wq = (const bf16_t*)(p.ws + W1_QKV);
    { EpiStore e{(bf16_t*)(p.ws + N_Q), (bf16_t*)(p.ws + N_K), 1024, 1024, 1024, 0.125f}; big_gemm(a, wq, T_ALL, 2048, 1024, e, lds, 1); ctx_gemm(a, wq, 1024, e, lds, 2048); }
    { EpiVTn e{(bf16_t*)(p.ws + N_VT), nullptr}; big_gemm(a, wq + (size_t)2048 * 1024, T_ALL, 1024, 1024, e, lds, 1); ctx_gemm(a, wq + (size_t)2048 * 1024, 1024, e, lds); }
    xcd_barrier(xb);
    na_attn_phase(p, lds);
    xcd_barrier(xb);
    { EpiResid e{p.out, hctx, p.out, hctx, mods + (size_t)1 * 5 * 6144 + 2 * 1024, (const float2*)(p.ws + OFF_LNS), p.ln_g + (size_t)(0 * 2 + 1) * 1024, p.ln_b + (size_t)(0 * 2 + 1) * 1024}; big_gemm(a, (const bf16_t*)(p.ws + W1_OUT), T_ALL, 1024, 1024, e, lds, 1); ctx_gemm(a, (const bf16_t*)(p.ws + W1_OUT), 1024, e, lds); }
    xcd_barrier(xb);
    ln_phase(p, 1, 0, 1, 3, false);
    xcd_barrier(xb);
    ffn_and_ln(p, xb, lds, 1, (const bf16_t*)(p.ws + W1_W13), (const bf16_t*)(p.ws + W1_W2));
  }
  { const bf16_t* d0 = (const bf16_t*)(p.ws + M_D0);
    { EpiD0 e{(bf16_t*)(p.ws + M_D0), (bf16_t*)(p.ws + M_CKV), (bf16_t*)(p.ws + M_KR)}; big_gemm(a, (const bf16_t*)(p.ws + W2_DOWN), T_ALL, 1024, 1024, e, lds, 1); ctx_gemm(a, (const bf16_t*)(p.ws + W2_DOWN), 1024, e, lds); }
    xcd_barrier(xb);
    mla_stats_phase(p);
    xcd_barrier(xb);
    { EpiMlaQ e{(bf16_t*)(p.ws + M_Q), rs, tabM}; big_gemm(d0, (const bf16_t*)(p.ws + W2_UQ), T_ALL, 1536, 512, e, lds, 1); ctx_gemm(d0, (const bf16_t*)(p.ws + W2_UQ), 512, e, lds, 1536); }
    { GemmArgs g{(const bf16_t*)(p.ws + M_CKV), 256, (const bf16_t*)(p.ws + W2_UKV), 256, T_ALL, 1024, 256}; EpiMlaK e{(bf16_t*)(p.ws + M_K), rs}; gemm_phase<false>(g, e, lds); }
    { EpiVTn e{(bf16_t*)(p.ws + M_VT), rs}; big_gemm((const bf16_t*)(p.ws + M_CKV), (const bf16_t*)(p.ws + W2_UKV) + (size_t)1024 * 256, T_ALL, 1024, 256, e, lds, 1); ctx_gemm((const bf16_t*)(p.ws + M_CKV), (const bf16_t*)(p.ws + W2_UKV) + (size_t)1024 * 256, 256, e, lds); }
    xcd_barrier(xb);
    mla_attn_phase(p, lds);
    xcd_barrier(xb);
    { EpiResid e{p.out, hctx, p.out, hctx, mods + (size_t)2 * 5 * 6144 + 2 * 1024, (const float2*)(p.ws + OFF_LNS), p.ln_g + (size_t)(1 * 2 + 1) * 1024, p.ln_b + (size_t)(1 * 2 + 1) * 1024}; big_gemm(a, (const bf16_t*)(p.ws + W2_OUT), T_ALL, 1024, 1024, e, lds, 1); ctx_gemm(a, (const bf16_t*)(p.ws + W2_OUT), 1024, e, lds); }
    xcd_barrier(xb);
    ln_phase(p, 2, 0, 2, 3, false);
    xcd_barrier(xb);
    ffn_and_ln(p, xb, lds, 2, (const bf16_t*)(p.ws + W2_W13), (const bf16_t*)(p.ws + W2_W2));
  }
  { { EpiHg e{(bf16_t*)(p.ws + H_P)}; big_gemm(a, (const bf16_t*)(p.ws + W3_IN), T_ALL, 5120, 1024, e, lds); }
    xcd_barrier(xb);
    scan_phase<128, true, 32>(p, lds);
    xcd_barrier(xb);
    hg_readout_phase(p);
    xcd_barrier(xb);
    { EpiResid e{p.out, hctx, p.out, hctx, mods + (size_t)3 * 5 * 6144 + 2 * 1024, (const float2*)(p.ws + OFF_LNS), p.ln_g + (size_t)(2 * 2 + 1) * 1024, p.ln_b + (size_t)(2 * 2 + 1) * 1024}; big_gemm(a, (const bf16_t*)(p.ws + W3_OUT), T_ALL, 1024, 1024, e, lds, 1); }
    xcd_barrier(xb);
    ln_phase(p, 3, 0, 3, 3, false);
    xcd_barrier(xb);
    ffn_and_ln(p, xb, lds, 3, (const bf16_t*)(p.ws + W3_W13), (const bf16_t*)(p.ws + W3_W2));
  }
}

extern "C" void kernel_launch(void* const* d_in, const int* in_sizes, int n_in, void* d_out, int out_size, void* d_ws, size_t ws_size, hipStream_t stream) {
  static int grid_blocks = 0;
  if (!grid_blocks) {
    int dev = 0, cus = 0, per_cu = 0;
    (void)hipGetDevice(&dev);
    (void)hipDeviceGetAttribute(&cus, hipDeviceAttributeMultiprocessorCount, dev);
    (void)hipOccupancyMaxActiveBlocksPerMultiprocessor(&per_cu, mega, NTHR, 0);
    if (per_cu != 1) per_cu = 1;
    grid_blocks = cus * per_cu;
  }
  if (ws_size < WS_NEED) { fprintf(stderr, "workspace too small: %zu\n", ws_size); return; }
  Params p{};
  const float** f = (const float**)&p;
  for (int i = 0; i < 26; ++i) f[i] = (const float*)d_in[i];
  p.out = (float*)d_out; p.ws = (char*)d_ws;
  (void)hipMemsetAsync((char*)d_ws + OFF_BAR, 0, XCD_BAR_WORDS * 4, stream);
  void* args[] = {&p};
  hipError_t e = hipLaunchCooperativeKernel((void*)mega, dim3(grid_blocks), dim3(NTHR), args, 0, stream);
  if (e != hipSuccess) fprintf(stderr, "cooperative launch failed: %s (grid %d)\n", hipGetErrorString(e), grid_blocks);
}
```

```cpp
#include <hip/hip_runtime.h>
#include <hip/hip_cooperative_groups.h>
#include <cstdio>
#include <cstdint>
namespace cg = cooperative_groups;

#define DI __device__ __forceinline__
DI int tid_() { int t = threadIdx.x; asm volatile("" : "+v"(t)); return t; }
typedef unsigned short bf16_t;
typedef short bf16x8 __attribute__((ext_vector_type(8)));
typedef short s16x4 __attribute__((ext_vector_type(4)));
typedef float f32x4 __attribute__((ext_vector_type(4)));
typedef float f32x16 __attribute__((ext_vector_type(16)));
typedef unsigned u32x4 __attribute__((ext_vector_type(4)));
typedef unsigned u32x2 __attribute__((ext_vector_type(2)));

constexpr int NTHR = 512;
constexpr int T_ALL = 33792, PB = 8448, LC = 256, LL = 8192, DM = 1024, FF = 2816;
constexpr float ALPHA = 1.681792830507429f;
constexpr float LOG2E = 1.4426950408889634f;
constexpr size_t MiB = 1048576;

struct Params {
  const float *x, *c, *ctx, *cctx, *ada_w, *ada_b, *ln_g, *ln_b, *w13, *w2;
  const float *ret_w_in, *ret_decay, *ret_w_out, *na_w_qkv, *na_rpb, *na_w_out;
  const float *mla_w_down, *mla_q_norm, *mla_kv_norm, *mla_w_uq, *mla_w_ukv, *mla_w_out;
  const float *hg_w_in, *hg_lb, *hg_norm_g, *hg_w_out;
  float* out; char* ws;
};

constexpr size_t OFF_MODS = 0;
constexpr size_t OFF_TABR = 512 * 1024;
constexpr size_t OFF_TABM = OFF_TABR + 65536;
constexpr size_t OFF_LBV = OFF_TABM + 8192;
constexpr size_t OFF_RS = OFF_LBV + 4096;
constexpr size_t OFF_BAR = 896 * 1024;
constexpr size_t OFF_HCTX = 1 * MiB;
constexpr size_t OFF_A = 5 * MiB;
constexpr size_t OFF_W0 = 71 * MiB;
constexpr size_t OFF_BIG = 104 * MiB;
constexpr size_t OFF_WR = OFF_BIG;
constexpr size_t OFF_S = 180 * MiB;
constexpr size_t WS_NEED = 512 * MiB;
constexpr size_t OFF_LNS = 510 * MiB;
constexpr size_t W0_RETIN = OFF_W0, W0_RETOUT = W0_RETIN + (size_t)6144 * 1024 * 2, W0_W13 = W0_RETOUT + (size_t)1024 * 2048 * 2, W0_W2 = W0_W13 + (size_t)5632 * 1024 * 2;
constexpr size_t SZ_W13 = (size_t)5632 * 1024 * 2, SZ_W2 = (size_t)1024 * 2816 * 2, SZ_SQ = (size_t)1024 * 1024 * 2;
constexpr size_t W1_QKV = OFF_WR, W1_OUT = W1_QKV + (size_t)3072 * 1024 * 2, W1_W13 = W1_OUT + SZ_SQ, W1_W2 = W1_W13 + SZ_W13;
constexpr size_t W2_DOWN = W1_W2 + SZ_W2, W2_UQ = W2_DOWN + (size_t)1024 * 1024 * 2, W2_UKV = W2_UQ + (size_t)1536 * 512 * 2, W2_OUT = W2_UKV + (size_t)2048 * 256 * 2, W2_W13 = W2_OUT + SZ_SQ, W2_W2 = W2_W13 + SZ_W13;
constexpr size_t W3_IN = W2_W2 + SZ_W2, W3_OUT = W3_IN + (size_t)5120 * 1024 * 2, W3_W13 = W3_OUT + SZ_SQ, W3_W2 = W3_W13 + SZ_W13, W3_END = W3_W2 + SZ_W2;
static_assert(W3_END <= OFF_S, "rest weights overflow");
static_assert(W0_W2 + SZ_W2 <= OFF_BIG, "W0 overflow");
constexpr size_t SZ_T2048 = (size_t)T_ALL * 2048 * 2, SZ_T1024 = (size_t)T_ALL * 1024 * 2;
constexpr size_t R_QK = OFF_BIG, R_V = R_QK + SZ_T2048, R_O = R_V + SZ_T2048;
static_assert(R_O + SZ_T2048 <= WS_NEED, "retention overflow");
constexpr size_t N_Q = OFF_S, N_K = N_Q + SZ_T1024, N_VT = N_K + SZ_T1024;
constexpr size_t M_D0 = OFF_S, M_CKV = M_D0 + (size_t)T_ALL * 512 * 2, M_KR = M_CKV + (size_t)T_ALL * 256 * 2, M_Q = M_D0 + (size_t)T_ALL * 1024 * 2, M_K = M_Q + (size_t)T_ALL * 1536 * 2, M_VT = M_K + (size_t)T_ALL * 1536 * 2;
static_assert(M_VT + SZ_T1024 <= WS_NEED, "mla overflow");
constexpr size_t H_P = OFF_S;
static_assert(H_P + (size_t)T_ALL * 5120 * 2 <= WS_NEED, "hgrn overflow");
constexpr size_t F_U = OFF_S;

typedef float f32x2 __attribute__((ext_vector_type(2)));
typedef __bf16 bf16x2_t __attribute__((ext_vector_type(2)));
DI unsigned pk2(float lo, float hi) { const f32x2 v = {lo, hi}; const bf16x2_t r = __builtin_convertvector(v, bf16x2_t); return __builtin_bit_cast(unsigned, r); }
DI float bflo(unsigned u) { return __uint_as_float(u << 16); }
DI float bfhi(unsigned u) { return __uint_as_float(u & 0xffff0000u); }
DI float bf2f(bf16_t v) { return __uint_as_float(((unsigned)v) << 16); }
DI bf16_t f2bf(float x) { return (bf16_t)(pk2(x, 0.f) & 0xffffu); }
DI float siluf(float x) { return x * __builtin_amdgcn_rcpf(1.f + __expf(-x)); }
DI f32x4 mfma16(bf16x8 a, bf16x8 b, f32x4 c) { return __builtin_amdgcn_mfma_f32_16x16x32_bf16(a, b, c, 0, 0, 0); }
DI f32x16 mfma32(bf16x8 a, bf16x8 b, f32x16 c) { return __builtin_amdgcn_mfma_f32_32x32x16_bf16(a, b, c, 0, 0, 0); }
DI bf16x8 cat44(s16x4 lo, s16x4 hi) { return __builtin_shufflevector(lo, hi, 0, 1, 2, 3, 4, 5, 6, 7); }
DI bf16x8 pack8(float a0, float a1, float a2, float a3, float a4, float a5, float a6, float a7) {
  u32x4 p; p.x = pk2(a0, a1); p.y = pk2(a2, a3); p.z = pk2(a4, a5); p.w = pk2(a6, a7); return __builtin_bit_cast(bf16x8, p);
}
DI int clampi(int v, int lo, int hi) { return v < lo ? lo : (v > hi ? hi : v); }
DI float* hrow(float* hlat, float* hctx, int t) { const int b = t / PB, p = t - b * PB; return p < LC ? hctx + (size_t)(b * LC + p) * DM : hlat + (size_t)(b * LL + p - LC) * DM; }
DI const float* hrowc(const float* hlat, const float* hctx, int t) { const int b = t / PB, p = t - b * PB; return p < LC ? hctx + (size_t)(b * LC + p) * DM : hlat + (size_t)(b * LL + p - LC) * DM; }
DI int modvec(int t) { const int b = t / PB, p = t - b * PB; return p < LC ? 4 : b; }

template <int MODE> DI int srccol(int n) {
  if (MODE == 0) return n;
  if (MODE == 1) { const int c = n >> 5, s = (n >> 4) & 1, i = n & 15; return s * FF + 16 * c + i; }
  if (MODE == 2) { if (n >= 2048) return n; const int w = n & 255, j = w >> 1, s = w & 1; return (n & ~255) + s * 128 + j; }
  if (MODE == 3) { const int h = n / 96, w = n - h * 96; if (w < 64) return n; const int wp = w - 64, j = wp >> 1, s = wp & 1; return h * 96 + 64 + s * 16 + j; }
  if (MODE == 4) { if (n < 1024) return (n >> 6) * 128 + (n & 63); const int m = n - 1024; return (m >> 6) * 128 + 64 + (m & 63); }
  if (MODE == 5) return n < 800 ? n : -1;
  return n;
}
template <int MODE> DI f32x4 cvt_load4(const float* __restrict__ row, int n) {
  if (MODE == 2 && n < 2048) { const int w = n & 255, j = w >> 1; const float* b = row + (n & ~255) + j; const f32x2 lo = *(const f32x2*)b, hi = *(const f32x2*)(b + 128); return (f32x4){lo[0], hi[0], lo[1], hi[1]}; }
  if (MODE == 3) { return (f32x4){row[srccol<3>(n)], row[srccol<3>(n + 1)], row[srccol<3>(n + 2)], row[srccol<3>(n + 3)]}; }
  const int sc = srccol<MODE>(n); if (sc < 0) return (f32x4){0.f, 0.f, 0.f, 0.f};
  return *(const f32x4*)(row + sc);
}
template <int MODE>
DI void convert_w(const float* __restrict__ src, int Nsrc, int K, bf16_t* __restrict__ dst, int Ndst, const float* __restrict__ kscale, float* ldsf) {
  const int tid = threadIdx.x, tn = Ndst / 64, tk = K / 64;
  for (int tile = blockIdx.x; tile < tn * tk; tile += gridDim.x) {
    const int n0 = (tile % tn) * 64, k0 = (tile / tn) * 64;
    __syncthreads();
#pragma unroll
    for (int i = 0; i < 2; ++i) { const int kk = (tid >> 4) + 32 * i, nn = (tid & 15) * 4;
      f32x4 v = cvt_load4<MODE>(src + (size_t)(k0 + kk) * Nsrc, n0 + nn);
      if (kscale) v = v * kscale[k0 + kk];
      float* lp = ldsf + kk * 65 + nn; lp[0] = v[0]; lp[1] = v[1]; lp[2] = v[2]; lp[3] = v[3]; }
    __syncthreads();
    { const int nn = tid >> 3, kc = tid & 7; const float* lp = ldsf + (kc * 8) * 65 + nn;
      u32x4 o; o.x = pk2(lp[0], lp[65]); o.y = pk2(lp[130], lp[195]); o.z = pk2(lp[260], lp[325]); o.w = pk2(lp[390], lp[455]);
      *(u32x4*)(dst + (size_t)(n0 + nn) * K + k0 + kc * 8) = o; }
  }
}

DI void ada_phase(const Params& p, float* ldsf) {
  const int tid = threadIdx.x, lane = tid & 63, w = tid >> 6;
  float* mods = (float*)(p.ws + OFF_MODS);
  __syncthreads();
  for (int e = tid; e < 5120; e += NTHR) { const int mv = e >> 10, k = e & 1023; const float cv = mv < 4 ? p.c[mv * 1024 + k] : p.cctx[k]; ldsf[e] = siluf(cv); }
  __syncthreads();
  float* red = ldsf + 5120;
  for (int item = blockIdx.x; item < 4 * 96; item += gridDim.x) {
    const int i = item / 96, n0 = (item % 96) * 64;
    const float* wp = p.ada_w + (size_t)i * 1024 * 6144 + n0 + lane;
    float a0 = 0.f, a1 = 0.f, a2 = 0.f, a3 = 0.f, a4 = 0.f;
#pragma unroll 8
    for (int kk = 0; kk < 128; ++kk) { const int k = w * 128 + kk; const float wv = wp[(size_t)k * 6144];
      a0 += ldsf[k] * wv; a1 += ldsf[1024 + k] * wv; a2 += ldsf[2048 + k] * wv; a3 += ldsf[3072 + k] * wv; a4 += ldsf[4096 + k] * wv; }
    red[(w * 5 + 0) * 64 + lane] = a0; red[(w * 5 + 1) * 64 + lane] = a1; red[(w * 5 + 2) * 64 + lane] = a2; red[(w * 5 + 3) * 64 + lane] = a3; red[(w * 5 + 4) * 64 + lane] = a4;
    __syncthreads();
    if (tid < 320) { const int mv = tid >> 6; float s = 0.f;
#pragma unroll
      for (int ww = 0; ww < 8; ++ww) s += red[(ww * 5 + mv) * 64 + lane];
      mods[(size_t)(i * 5 + mv) * 6144 + n0 + lane] = s + p.ada_b[i * 6144 + n0 + lane]; }
    __syncthreads();
  }
}
DI void tables_phase(const Params& p) {
  const int gt = blockIdx.x * NTHR + threadIdx.x, gn = gridDim.x * NTHR;
  float2* tabR = (float2*)(p.ws + OFF_TABR); float2* tabM = (float2*)(p.ws + OFF_TABM); float* lbv = (float*)(p.ws + OFF_LBV);
  for (int e = gt; e < 128 * 64; e += gn) { const int v = e >> 6, i = e & 63; const float inv = powf(10000.f, -(float)i / 64.f); const float ang = (float)v * inv; tabR[e] = make_float2(cosf(ang), sinf(ang)); }
  for (int e = gt; e < 128 * 8; e += gn) { const int v = e >> 3, i = e & 7; const float inv = powf(10000.f, -(float)i / 8.f); const float ang = (float)v * inv; tabM[e] = make_float2(cosf(ang), sinf(ang)); }
  for (int e = gt; e < 1024; e += gn) { const float l0 = p.hg_lb[e], l1 = p.hg_lb[1024 + e], l2 = p.hg_lb[2048 + e], l3 = p.hg_lb[3072 + e];
    const float mx = fmaxf(fmaxf(l0, l1), fmaxf(l2, l3)); const float e0 = expf(l0 - mx), e1 = expf(l1 - mx), e2 = expf(l2 - mx), e3 = expf(l3 - mx);
    lbv[e] = (e1 + e2 + e3) / (e0 + e1 + e2 + e3); }
}

DI void modulate_phase(const Params& p, const float* slat, const float* sctx, int layer) {
  const float* mods = (const float*)(p.ws + OFF_MODS); bf16_t* a = (bf16_t*)(p.ws + OFF_A);
  const int gt = blockIdx.x * NTHR + threadIdx.x, gn = gridDim.x * NTHR;
  for (int e = gt; e < T_ALL * 128; e += gn) {
    const int t = e >> 7, c0 = (e & 127) * 8; const float* s = hrowc(slat, sctx, t) + c0; const float* m = mods + (size_t)(layer * 5 + modvec(t)) * 6144;
    const f32x4 x0 = *(const f32x4*)s, x1 = *(const f32x4*)(s + 4), sh0 = *(const f32x4*)(m + c0), sh1 = *(const f32x4*)(m + c0 + 4), sc0 = *(const f32x4*)(m + 1024 + c0), sc1 = *(const f32x4*)(m + 1024 + c0 + 4);
    const f32x4 y0 = x0 * (1.f + sc0) + sh0, y1 = x1 * (1.f + sc1) + sh1;
    u32x4 o; o.x = pk2(y0[0], y0[1]); o.y = pk2(y0[2], y0[3]); o.z = pk2(y1[0], y1[1]); o.w = pk2(y1[2], y1[3]);
    *(u32x4*)(a + (size_t)t * 1024 + c0) = o;
  }
}
DI void ln_phase(const Params& p, int lnlayer, int lnidx, int ml, int js, bool final_out) {
  const float* mods = (const float*)(p.ws + OFF_MODS); bf16_t* a = (bf16_t*)(p.ws + OFF_A); float* hctx = (float*)(p.ws + OFF_HCTX); float2* lns = (float2*)(p.ws + OFF_LNS);
  const int tid = threadIdx.x, lane = tid & 63, gw = blockIdx.x * 8 + (tid >> 6), nw = gridDim.x * 8;
  const float* gp = p.ln_g + (size_t)(lnlayer * 2 + lnidx) * 1024; const float* bp = p.ln_b + (size_t)(lnlayer * 2 + lnidx) * 1024;
  for (int t = gw; t < T_ALL; t += nw) {
    float* hr = hrow(p.out, hctx, t);
    f32x4 v[4]; float s = 0.f;
#pragma unroll
    for (int i = 0; i < 4; ++i) { v[i] = *(const f32x4*)(hr + i * 256 + lane * 4); s += (v[i][0] + v[i][1]) + (v[i][2] + v[i][3]); }
#pragma unroll
    for (int o = 1; o < 64; o <<= 1) s += __shfl_xor(s, o);
    const float mean = s * (1.f / 1024.f); float q = 0.f;
#pragma unroll
    for (int i = 0; i < 4; ++i) { v[i] = v[i] - mean; q += (v[i][0] * v[i][0] + v[i][1] * v[i][1]) + (v[i][2] * v[i][2] + v[i][3] * v[i][3]); }
#pragma unroll
    for (int o = 1; o < 64; o <<= 1) q += __shfl_xor(q, o);
    const float rstd = rsqrtf(q * (1.f / 1024.f) + 1e-5f);
    if (!final_out && lane == 0) lns[t] = make_float2(mean, rstd);
    const float* m = mods + (size_t)(ml * 5 + modvec(t)) * 6144 + (size_t)js * 1024;
#pragma unroll
    for (int i = 0; i < 4; ++i) { const int c0 = i * 256 + lane * 4;
      const f32x4 y = v[i] * rstd * *(const f32x4*)(gp + c0) + *(const f32x4*)(bp + c0);
      if (final_out) *(f32x4*)(hr + c0) = y;
      else { const f32x4 z = y * (1.f + *(const f32x4*)(m + 1024 + c0)) + *(const f32x4*)(m + c0); u32x2 o; o.x = pk2(z[0], z[1]); o.y = pk2(z[2], z[3]); *(u32x2*)(a + (size_t)t * 1024 + c0) = o; } }
  }
}

namespace pg8 {
#define PG8_LAS __attribute__((address_space(3)))
typedef unsigned short bf16_t;
typedef short bf16x8 __attribute__((ext_vector_type(8)));
typedef float f32x4 __attribute__((ext_vector_type(4)));
typedef unsigned u32x4 __attribute__((ext_vector_type(4)));
constexpr int BM = 256, BK = 64, HALF = 128, HTB = HALF * BK * 2  , STAGE_BYTES = 8 * HTB, NXCD = 8, WGM = 8;

__host__ __device__ __forceinline__ int lds_byte(int r, int c) { const int st = (r >> 4) * 2 + (c >> 5), rr = r & 15, cc = c & 31, ob = rr * 64 + cc * 2; return st * 1024 + (ob ^ (((ob >> 9) & 1) << 5)); }
__host__ __device__ __forceinline__ void stage_rc(int b, int& R, int& C) { const int st = b / 1024, sb = b % 1024, swz = sb ^ (((sb >> 9) & 1) << 5); R = (st >> 1) * 16 + swz / 64; C = (st & 1) * 32 + (swz % 64) / 2; }
__host__ __device__ __forceinline__ int perm32(int rho) { const int n = rho >> 4, i = rho & 15; return 8 * (i >> 2) + 4 * n + (i & 3); }

struct Unit { int pm, pn; };
struct Gemm { const bf16_t* A; const bf16_t* Bt; int M, N, K; };

struct StaticOrder {
    int nM, nN, nwg, G, c, lat;
    __host__ __device__ void init(int M, int N, int G_, int c_, int lat_ = 0) { lat = lat_; nM = lat ? 128 : M / BM; nN = N / BM; nwg = nM * nN; G = G_; c = c_; }
    __host__ __device__ bool next(int i, Unit& u) const {
        const long L = (long)i * G + c; if (L >= nwg) return false;
        int wgid = (int)L; { const int q = nwg / NXCD, r = nwg % NXCD, xcd = wgid % NXCD, off = wgid / NXCD; wgid = (xcd < r ? xcd * (q + 1) : r * (q + 1) + (xcd - r) * q) + off; }
        const int nig = WGM * nN, gid = wgid / nig, fm = gid * WGM, gsz = (nM - fm) < WGM ? (nM - fm) : WGM;
        u.pm = fm + ((wgid % nig) % gsz); u.pn = (wgid % nig) / gsz; if (lat) u.pm += (u.pm >> 5) + 1; return true;
    }
    __device__ __forceinline__ void a_ready(const Unit&) const {}
    __device__ __forceinline__ void done(const Unit&) const {}
};
template <class Epi, class Sched, bool ALIGN_EPI = false, bool SP2 = false>
__device__ __forceinline__ void gemm_phase(PG8_LAS unsigned char* lds, const Gemm g, const Sched& S, const Epi& E) {
    const int tid = tid_(), wid = __builtin_amdgcn_readfirstlane(tid >> 6), lane = tid & 63, wr = wid >> 2, wc = wid & 3, fr = lane & 15, fq = lane >> 4;
    const int K = g.K, nt = K / BK;
    unsigned voffA[2], voffB[2];
#pragma unroll
    for (int i = 0; i < 2; ++i) { int R, C; stage_rc(tid * 16 + i * 8192, R, C); const int Rb = Epi::PERM ? ((R & ~31) + perm32(R & 31)) : R;
        voffA[i] = (unsigned)(R * K + C) * 2u; voffB[i] = (unsigned)(Rb * K + C) * 2u; }
    const size_t kstep = (size_t)(BK * 2);
    const size_t hstep = (size_t)HALF * K * 2;
    const size_t tstep = 2 * hstep;
    const unsigned ldsw = (unsigned)wid * 1024u;
    const int aoff = lds_byte(wr * 64 + fr, fq * 8), boff = lds_byte(wc * 32 + fr, fq * 8);
#define PG8_SA(b, h) (((b) * 2 + (h)) * HTB)
#define PG8_SB(b, h) ((4 + (b) * 2 + (h)) * HTB)
#define PG8_STAGE(bufoff, gbase, voff) do { _Pragma("unroll") for (int _i = 0; _i < 2; ++_i) \
        __builtin_amdgcn_global_load_lds((const unsigned*)((const char*)(gbase) + (voff)[_i]), (PG8_LAS unsigned*)(lds + (bufoff) + ldsw + _i * 8192), 16, 0, 0); } while (0)
#define PG8_LDA(dst, b, h) do { _Pragma("unroll") for (int m = 0; m < 4; ++m) _Pragma("unroll") for (int k = 0; k < 2; ++k) dst[m][k] = *(const PG8_LAS bf16x8*)(lds + PG8_SA(b, h) + aoff + m * 2048 + k * 1024); } while (0)
#define PG8_LDB(dst, b, h) do { _Pragma("unroll") for (int n = 0; n < 2; ++n) _Pragma("unroll") for (int k = 0; k < 2; ++k) dst[n][k] = *(const PG8_LAS bf16x8*)(lds + PG8_SB(b, h) + boff + n * 2048 + k * 1024); } while (0)
#define PG8_MMA(ai, bj, At, Bt) do { __builtin_amdgcn_s_setprio(1); _Pragma("unroll") for (int m = 0; m < 4; ++m) _Pragma("unroll") for (int n = 0; n < 2; ++n) _Pragma("unroll") for (int k = 0; k < 2; ++k) \
        acc[ai][bj][m][n] = __builtin_amdgcn_mfma_f32_16x16x32_bf16(Bt[n][k], At[m][k], acc[ai][bj][m][n], 0, 0, 0); __builtin_amdgcn_s_setprio(0); } while (0)
#define PG8_WAIT_V(n) asm volatile("s_waitcnt vmcnt(" #n ")" ::: "memory")
#define PG8_WAIT_L(n) asm volatile("s_waitcnt lgkmcnt(" #n ")" ::: "memory")
#define PG8_BAR __builtin_amdgcn_s_barrier()
#define PG8_SCHED __builtin_amdgcn_sched_barrier(0)
    Unit cur, nxt; int ui = 0;
    if (!S.next(0, cur)) return;
    f32x4 acc[2][2][4][2];
#pragma unroll
    for (int a = 0; a < 2; ++a)
#pragma unroll
        for (int b = 0; b < 2; ++b)
#pragma unroll
            for (int m = 0; m < 4; ++m)
#pragma unroll
                for (int n = 0; n < 2; ++n) acc[a][b][m][n] = (f32x4){0.f, 0.f, 0.f, 0.f};
    bf16x8 At[4][2], B0[2][2], B1[2][2];
    const char* cA = (const char*)g.A + (size_t)cur.pm * tstep; const char* cB = (const char*)g.Bt + (size_t)cur.pn * tstep;
    S.a_ready(cur);
    if constexpr (SP2) {
        PG8_STAGE(PG8_SB(0, 0), cB, voffB); PG8_STAGE(PG8_SB(0, 1), cB + hstep, voffB); PG8_STAGE(PG8_SA(0, 0), cA, voffA); PG8_STAGE(PG8_SA(0, 1), cA + hstep, voffA);
        if (wr == 1) PG8_BAR;
        PG8_WAIT_V(2); PG8_BAR;
        PG8_STAGE(PG8_SB(1, 0), cB + kstep, voffB); PG8_STAGE(PG8_SA(1, 0), cA + kstep, voffA); PG8_STAGE(PG8_SB(1, 1), cB + hstep + kstep, voffB);
        PG8_WAIT_V(6); PG8_BAR;
    } else {
        PG8_STAGE(PG8_SB(0, 0), cB, voffB); PG8_STAGE(PG8_SA(0, 0), cA, voffA); PG8_STAGE(PG8_SB(0, 1), cB + hstep, voffB); PG8_STAGE(PG8_SA(0, 1), cA + hstep, voffA);
        if (wr == 1) PG8_BAR;
        PG8_WAIT_V(4); PG8_BAR;
        PG8_STAGE(PG8_SB(1, 0), cB + kstep, voffB); PG8_STAGE(PG8_SA(1, 0), cA + kstep, voffA); PG8_STAGE(PG8_SB(1, 1), cB + hstep + kstep, voffB);
        PG8_WAIT_V(6); PG8_BAR;
    }
    for (;;) {
        const bool has_next = S.next(ui + 1, nxt);
        const char* nA = has_next ? (const char*)g.A + (size_t)nxt.pm * tstep : cA; const char* nB = has_next ? (const char*)g.Bt + (size_t)nxt.pn * tstep : cB;
        for (int t = 0; t < nt; t += 2) {
            const bool last = (t == nt - 2);
            const char* a1 = cA + (size_t)(t + 1) * kstep;
            const char* a2 = last ? nA : cA + (size_t)(t + 2) * kstep; const char* b2 = last ? nB : cB + (size_t)(t + 2) * kstep;
            const char* a3 = a2 + kstep; const char* b3 = b2 + kstep;
            if (last && has_next) S.a_ready(nxt);
            if constexpr (SP2) {
            PG8_LDB(B0, 0, 0); PG8_LDB(B1, 0, 1); PG8_SCHED; PG8_LDA(At, 0, 0); PG8_STAGE(PG8_SA(1, 1), a1 + hstep, voffA);
            PG8_WAIT_V(8); PG8_WAIT_L(0); PG8_BAR; PG8_MMA(0, 0, At, B0); PG8_MMA(0, 1, At, B1); PG8_BAR; PG8_SCHED;
            PG8_LDA(At, 0, 1); PG8_STAGE(PG8_SB(0, 0), b2, voffB); PG8_STAGE(PG8_SB(0, 1), b2 + hstep, voffB); PG8_STAGE(PG8_SA(0, 0), a2, voffA);
            PG8_WAIT_V(8); PG8_WAIT_L(0); PG8_BAR; PG8_MMA(1, 0, At, B0); PG8_MMA(1, 1, At, B1); PG8_BAR; PG8_SCHED;
            PG8_LDB(B0, 1, 0); PG8_LDB(B1, 1, 1); PG8_SCHED; PG8_LDA(At, 1, 0); PG8_STAGE(PG8_SA(0, 1), a2 + hstep, voffA);
            PG8_WAIT_V(8); PG8_WAIT_L(0); PG8_BAR; PG8_MMA(0, 0, At, B0); PG8_MMA(0, 1, At, B1); PG8_BAR; PG8_SCHED;
            PG8_LDA(At, 1, 1); PG8_STAGE(PG8_SB(1, 0), b3, voffB); PG8_STAGE(PG8_SB(1, 1), b3 + hstep, voffB); PG8_STAGE(PG8_SA(1, 0), a3, voffA);
            PG8_WAIT_V(8); PG8_WAIT_L(0); PG8_BAR; PG8_MMA(1, 0, At, B0); PG8_MMA(1, 1, At, B1); PG8_BAR; PG8_SCHED;
            } else {
            PG8_LDB(B0, 0, 0); PG8_SCHED; PG8_LDA(At, 0, 0); PG8_STAGE(PG8_SA(1, 1), a1 + hstep, voffA);
            PG8_WAIT_L(8); PG8_BAR; PG8_WAIT_L(0); PG8_MMA(0, 0, At, B0); PG8_BAR; PG8_SCHED;
            PG8_LDB(B1, 0, 1); PG8_STAGE(PG8_SB(0, 0), b2, voffB);
            PG8_BAR; PG8_WAIT_L(0); PG8_MMA(0, 1, At, B1); PG8_BAR;
            PG8_LDA(At, 0, 1); PG8_STAGE(PG8_SA(0, 0), a2, voffA);
            PG8_BAR; PG8_WAIT_L(0); PG8_MMA(1, 0, At, B0); PG8_BAR; PG8_SCHED;
            PG8_STAGE(PG8_SB(0, 1), b2 + hstep, voffB);
            PG8_WAIT_V(6); PG8_BAR; PG8_MMA(1, 1, At, B1); PG8_BAR;
            PG8_LDB(B0, 1, 0); PG8_SCHED; PG8_LDA(At, 1, 0); PG8_STAGE(PG8_SA(0, 1), a2 + hstep, voffA);
            PG8_WAIT_L(8); PG8_BAR; PG8_WAIT_L(0); PG8_MMA(0, 0, At, B0); PG8_BAR; PG8_SCHED;
            PG8_LDB(B1, 1, 1); PG8_STAGE(PG8_SB(1, 0), b3, voffB);
            PG8_BAR; PG8_WAIT_L(0); PG8_MMA(0, 1, At, B1); PG8_BAR;
            PG8_LDA(At, 1, 1); PG8_STAGE(PG8_SA(1, 0), a3, voffA);
            PG8_BAR; PG8_WAIT_L(0); PG8_MMA(1, 0, At, B0); PG8_BAR; PG8_SCHED;
            PG8_STAGE(PG8_SB(1, 1), b3 + hstep, voffB);
            PG8_WAIT_V(6); PG8_BAR; PG8_MMA(1, 1, At, B1); PG8_BAR;
            }
        }
        if constexpr (ALIGN_EPI) { if (wr == 0) PG8_BAR; }
        if constexpr (!Epi::AFTER_DRAIN) { E(acc, cur, wr, wc, fr, fq); S.done(cur); }
        if (!has_next) break;
#pragma unroll
        for (int a = 0; a < 2; ++a)
#pragma unroll
            for (int b = 0; b < 2; ++b)
#pragma unroll
                for (int m = 0; m < 4; ++m)
#pragma unroll
                    for (int n = 0; n < 2; ++n) acc[a][b][m][n] = (f32x4){0.f, 0.f, 0.f, 0.f};
        cur = nxt; cA = nA; cB = nB; ++ui;
        if constexpr (ALIGN_EPI) { if (wr == 1) PG8_BAR; }
    }
    PG8_WAIT_V(0);
    if constexpr (!ALIGN_EPI) { if (wr == 0) PG8_BAR; }
    PG8_BAR;
    if constexpr (Epi::AFTER_DRAIN) { E.fused(acc, cur, wr, wc, fr, fq, lds, wid, lane); S.done(cur); }
#undef PG8_SA
#undef PG8_SB
#undef PG8_STAGE
#undef PG8_LDA
#undef PG8_LDB
#undef PG8_MMA
#undef PG8_WAIT_V
#undef PG8_WAIT_L
#undef PG8_BAR
#undef PG8_SCHED
}
}

template <class E4> struct EpiWrap { static constexpr bool PERM = false, AFTER_DRAIN = false; E4 e;
  DI void operator()(const f32x4 (&acc)[2][2][4][2], const pg8::Unit& u, int wr, int wc, int fr, int fq) const {
#pragma unroll
    for (int ai = 0; ai < 2; ++ai)
#pragma unroll
      for (int m = 0; m < 4; ++m) { const int row = u.pm * 256 + ai * 128 + wr * 64 + m * 16 + fr;
#pragma unroll
        for (int bj = 0; bj < 2; ++bj) { const int col = u.pn * 256 + bj * 128 + wc * 32 + 4 * fq;
          if constexpr (E4::PAIR) e.pair(row, ((col - 4 * fq) >> 1) + 4 * fq, acc[ai][bj][m][0], acc[ai][bj][m][1]);
          else { e(row, col, acc[ai][bj][m][0]); e(row, col + 16, acc[ai][bj][m][1]); } }
        asm volatile("" ::: "memory"); }
  } };
template <class E4>
DI void big_gemm(const bf16_t* A, const bf16_t* W, int M, int N, int K, const E4& e4, char* lds, int lat_only = 0) {
  __syncthreads();
  pg8::Gemm g{A, W, M, N, K}; pg8::StaticOrder S; S.init(M, N, (int)gridDim.x, (int)blockIdx.x, lat_only); EpiWrap<E4> E{e4};
  pg8::gemm_phase<EpiWrap<E4>, pg8::StaticOrder, true, true>((PG8_LAS unsigned char*)lds, g, S, E);
  __syncthreads();
}
struct GemmArgs { const bf16_t* A; int lda; const bf16_t* W; int ldw; int M, N, K; };
constexpr int LDT = 72;
template <bool TRANS, class Epi>
DI void gemm_phase(const GemmArgs g, const Epi epi, char* lds) {
  const int tid = threadIdx.x, lane = tid & 63, w = tid >> 6, wm = w & 3, wn = w >> 2, g4 = lane >> 4, l16 = lane & 15;
  const int nN = g.N / 128, ntiles = (g.M / 256) * nN, nk = g.K / 64;
  bf16_t* As = (bf16_t*)lds; bf16_t* Bs = As + 256 * LDT;
  for (int tile = blockIdx.x; tile < ntiles; tile += gridDim.x) {
    const int pm = tile / nN, pn = tile - pm * nN;
    const bf16_t* Ag = g.A + (size_t)(pm * 256) * g.lda; const bf16_t* Wg = g.W + (size_t)(pn * 128) * g.ldw;
    f32x4 acc[4][4];
#pragma unroll
    for (int i = 0; i < 4; ++i)
#pragma unroll
      for (int j = 0; j < 4; ++j) acc[i][j] = (f32x4){0.f, 0.f, 0.f, 0.f};
    u32x4 ra[4], rb[2];
#pragma unroll
    for (int i = 0; i < 4; ++i) { const int c = tid + NTHR * i; ra[i] = *(const u32x4*)(Ag + (size_t)(c >> 3) * g.lda + (c & 7) * 8); }
#pragma unroll
    for (int i = 0; i < 2; ++i) { const int c = tid + NTHR * i; rb[i] = *(const u32x4*)(Wg + (size_t)(c >> 3) * g.ldw + (c & 7) * 8); }
    for (int kt = 0; kt < nk; ++kt) {
      __syncthreads();
#pragma unroll
      for (int i = 0; i < 4; ++i) { const int c = tid + NTHR * i; *(u32x4*)(As + (c >> 3) * LDT + (c & 7) * 8) = ra[i]; }
#pragma unroll
      for (int i = 0; i < 2; ++i) { const int c = tid + NTHR * i; *(u32x4*)(Bs + (c >> 3) * LDT + (c & 7) * 8) = rb[i]; }
      __syncthreads();
      if (kt + 1 < nk) { const int k0 = (kt + 1) * 64;
#pragma unroll
        for (int i = 0; i < 4; ++i) { const int c = tid + NTHR * i; ra[i] = *(const u32x4*)(Ag + (size_t)(c >> 3) * g.lda + k0 + (c & 7) * 8); }
#pragma unroll
        for (int i = 0; i < 2; ++i) { const int c = tid + NTHR * i; rb[i] = *(const u32x4*)(Wg + (size_t)(c >> 3) * g.ldw + k0 + (c & 7) * 8); } }
#pragma unroll
      for (int ks = 0; ks < 2; ++ks) {
        bf16x8 af[4], wf[4];
#pragma unroll
        for (int i = 0; i < 4; ++i) af[i] = *(const bf16x8*)(As + (wm * 64 + i * 16 + l16) * LDT + ks * 32 + g4 * 8);
#pragma unroll
        for (int j = 0; j < 4; ++j) wf[j] = *(const bf16x8*)(Bs + (wn * 64 + j * 16 + l16) * LDT + ks * 32 + g4 * 8);
#pragma unroll
        for (int i = 0; i < 4; ++i)
#pragma unroll
          for (int j = 0; j < 4; ++j) acc[i][j] = TRANS ? mfma16(af[i], wf[j], acc[i][j]) : mfma16(wf[j], af[i], acc[i][j]);
      }
    }
    const int mb = pm * 256 + wm * 64, nb = pn * 128 + wn * 64;
    if constexpr (Epi::PAIR) {
#pragma unroll
      for (int i = 0; i < 4; ++i)
#pragma unroll
        for (int j = 0; j < 2; ++j) epi.pair(mb + i * 16 + l16, (nb >> 1) + 16 * j + 4 * g4, acc[i][2 * j], acc[i][2 * j + 1]);
    } else {
#pragma unroll
      for (int i = 0; i < 4; ++i)
#pragma unroll
        for (int j = 0; j < 4; ++j) { if (TRANS) epi(mb + i * 16 + 4 * g4, nb + j * 16 + l16, acc[i][j]); else epi(mb + i * 16 + l16, nb + j * 16 + 4 * g4, acc[i][j]); }
    }
  }
}
DI void st4bf(bf16_t* p, f32x4 v) { u32x2 o; o.x = pk2(v[0], v[1]); o.y = pk2(v[2], v[3]); *(u32x2*)p = o; }
struct EpiStore { static constexpr bool PAIR = false; bf16_t* d0; bf16_t* d1; int split, ld0, ld1; float s0;
  DI void operator()(int m, int n, f32x4 v) const { if (n < split) st4bf(d0 + (size_t)m * ld0 + n, v * s0); else st4bf(d1 + (size_t)m * ld1 + (n - split), v); } };
struct EpiVT { static constexpr bool PAIR = false; bf16_t* vt; const float* rs;
  DI void operator()(int m, int n, f32x4 v) const { const int b = m / PB, pos = m - b * PB;
    if (rs) { v[0] *= rs[2 * m + 1]; v[1] *= rs[2 * m + 3]; v[2] *= rs[2 * m + 5]; v[3] *= rs[2 * m + 7]; }
    st4bf(vt + ((size_t)(b * 1024 + n)) * PB + pos, v); } };
struct EpiVTn { static constexpr bool PAIR = false; bf16_t* vt; const float* rs;
  DI void operator()(int m, int n, f32x4 v) const { const int b = m / PB, pos = m - b * PB; if (rs) v = v * rs[2 * m + 1];
    bf16_t* q = vt + (size_t)(b * 1024 + n) * PB + pos; q[0] = f2bf(v[0]); q[PB] = f2bf(v[1]); q[2 * (size_t)PB] = f2bf(v[2]); q[3 * (size_t)PB] = f2bf(v[3]); } };
struct EpiD0 { static constexpr bool PAIR = false; bf16_t* cq; bf16_t* ckv; bf16_t* kr;
  DI void operator()(int m, int n, f32x4 v) const { if (n < 512) st4bf(cq + (size_t)m * 512 + n, v); else if (n < 768) st4bf(ckv + (size_t)m * 256 + (n - 512), v); else if (n < 800) st4bf(kr + (size_t)m * 32 + (n - 768), v); } };
struct EpiResid { static constexpr bool PAIR = false; const float* slat; const float* sctx; float* dlat; float* dctx; const float* gate;
  const float2* lns; const float* lg; const float* lb;
  DI void operator()(int m, int n, f32x4 v) const { const int mv = modvec(m); f32x4 hv = *(const f32x4*)(hrowc(slat, sctx, m) + n); const f32x4 gt = *(const f32x4*)(gate + (size_t)mv * 6144 + n);
    if (lns) { const float2 st = lns[m]; hv = (hv - st.x) * st.y * *(const f32x4*)(lg + n) + *(const f32x4*)(lb + n); }
    *(f32x4*)(hrow(dlat, dctx, m) + n) = ALPHA * hv + gt * v; } };
constexpr int CLD = 264;
template <class Epi>
DI void ctx_gemm(const bf16_t* __restrict__ A, const bf16_t* __restrict__ W, int K, const Epi& epi, char* lds, int N = 1024) {
  const int tid = threadIdx.x, lane = tid & 63, w = tid >> 6, g4 = lane >> 4, l16 = lane & 15, wm = w & 3, wn = w >> 2;
  bf16_t* As = (bf16_t*)lds; bf16_t* Ws = As + 64 * CLD;
  const int nk = K / 256, per = N / 64;
  for (int tile = blockIdx.x; tile < 16 * per; tile += gridDim.x) {
    const int nt = tile % per, rem = tile / per, mt = rem & 3, b = rem >> 2;
    const size_t row0 = (size_t)b * PB + mt * 64;
    const bf16_t* Ag = A + row0 * K; const bf16_t* Wg = W + (size_t)(nt * 64) * K;
    u32x4 ra[4], rw[4], ra2[4], rw2[4];
    auto gl = [&](int kt, u32x4 (&xa)[4], u32x4 (&xw)[4]) { const int k0 = kt * 256;
#pragma unroll
      for (int i = 0; i < 4; ++i) { const int c = tid + NTHR * i, r = c >> 5, kc = c & 31; xa[i] = *(const u32x4*)(Ag + (size_t)r * K + k0 + kc * 8); xw[i] = *(const u32x4*)(Wg + (size_t)r * K + k0 + kc * 8); } };
    f32x4 acc[2] = {(f32x4){0.f, 0.f, 0.f, 0.f}, (f32x4){0.f, 0.f, 0.f, 0.f}};
    auto stepk = [&](int kt, u32x4 (&xa)[4], u32x4 (&xw)[4]) {
      __syncthreads();
#pragma unroll
      for (int i = 0; i < 4; ++i) { const int c = tid + NTHR * i, r = c >> 5, kc = c & 31; *(u32x4*)(As + r * CLD + kc * 8) = xa[i]; *(u32x4*)(Ws + r * CLD + kc * 8) = xw[i]; }
      __syncthreads();
      if (kt + 2 < nk) gl(kt + 2, xa, xw);
#pragma unroll
      for (int ks = 0; ks < 8; ++ks) {
        const bf16x8 af = *(const bf16x8*)(As + (wm * 16 + l16) * CLD + ks * 32 + g4 * 8);
        const bf16x8 w0 = *(const bf16x8*)(Ws + (wn * 32 + l16) * CLD + ks * 32 + g4 * 8), w1 = *(const bf16x8*)(Ws + (wn * 32 + 16 + l16) * CLD + ks * 32 + g4 * 8);
        acc[0] = mfma16(w0, af, acc[0]); acc[1] = mfma16(w1, af, acc[1]);
      } };
    gl(0, ra, rw); if (nk > 1) gl(1, ra2, rw2);
    for (int kt = 0; kt < nk; kt += 2) { stepk(kt, ra, rw); if (kt + 1 < nk) stepk(kt + 1, ra2, rw2); }
    const int m = (int)row0 + wm * 16 + l16, n = nt * 64 + wn * 32 + 4 * g4;
    epi(m, n, acc[0]); epi(m, n + 16, acc[1]);
  }
  __syncthreads();
}
struct EpiSwiglu { static constexpr bool PAIR = true; bf16_t* u;
  DI void pair(int m, int f, f32x4 gt, f32x4 up) const { f32x4 r; r[0] = siluf(gt[0]) * up[0]; r[1] = siluf(gt[1]) * up[1]; r[2] = siluf(gt[2]) * up[2]; r[3] = siluf(gt[3]) * up[3]; st4bf(u + (size_t)m * FF + f, r); } };
struct EpiRetQK { static constexpr bool PAIR = false; bf16_t* qk; const float2* tabR;
  DI void operator()(int m, int n, f32x4 v) const { const int b = m / PB, pp = m - b * PB;
    if (pp >= LC) { const int pos = pp - LC, row = pos >> 6, col = pos & 63; const int j0 = (n & 255) >> 1;
      const int vv = j0 < 64 ? row : col; const float2 c0 = tabR[vv * 64 + (j0 & 63)], c1 = tabR[vv * 64 + ((j0 + 1) & 63)];
      const float a0 = v[0] * c0.x - v[1] * c0.y, b0 = v[0] * c0.y + v[1] * c0.x, a1 = v[2] * c1.x - v[3] * c1.y, b1 = v[2] * c1.y + v[3] * c1.x; v = (f32x4){a0, b0, a1, b1}; }
    if (n >= 1024) v = v * 0.0625f;
    st4bf(qk + (size_t)m * 2048 + n, v); } };
struct EpiHg { static constexpr bool PAIR = false; bf16_t* ph;
  DI void operator()(int m, int n, f32x4 v) const { if (n < 1024) { v[0] = siluf(v[0]); v[1] = siluf(v[1]); v[2] = siluf(v[2]); v[3] = siluf(v[3]); v = v * 0.08838834764831845f; } st4bf(ph + (size_t)m * 5120 + n, v); } };
struct EpiMlaQ { static constexpr bool PAIR = false; bf16_t* q; const float* rs; const float2* tabM;
  DI void operator()(int m, int n, f32x4 v) const { v = v * (rs[2 * m] * 0.10206207261596577f * LOG2E); const int h = n / 96, w = n - h * 96; const int b = m / PB, pp = m - b * PB;
    if (w >= 64 && pp >= LC) { const int pos = pp - LC, row = pos >> 6, col = pos & 63; const int j0 = (w - 64) >> 1; const int vv = j0 < 8 ? row : col; const float2 c0 = tabM[vv * 8 + (j0 & 7)], c1 = tabM[vv * 8 + ((j0 + 1) & 7)];
      const float a0 = v[0] * c0.x - v[1] * c0.y, b0 = v[0] * c0.y + v[1] * c0.x, a1 = v[2] * c1.x - v[3] * c1.y, b1 = v[2] * c1.y + v[3] * c1.x; v = (f32x4){a0, b0, a1, b1}; }
    st4bf(q + (size_t)m * 1536 + n, v); } };
struct EpiMlaK { static constexpr bool PAIR = false; bf16_t* k; const float* rs;
  DI void operator()(int m, int n, f32x4 v) const { v = v * rs[2 * m + 1]; st4bf(k + (size_t)m * 1536 + (n >> 6) * 96 + (n & 63), v); } };

DI void mla_stats_phase(const Params& p) {
  const bf16_t* cqb = (const bf16_t*)(p.ws + M_D0); const bf16_t* ckvb = (const bf16_t*)(p.ws + M_CKV); const bf16_t* krb = (const bf16_t*)(p.ws + M_KR); bf16_t* km = (bf16_t*)(p.ws + M_K); float* rs = (float*)(p.ws + OFF_RS); const float2* tabM = (const float2*)(p.ws + OFF_TABM);
  const int tid = threadIdx.x, lane = tid & 63, gw = blockIdx.x * 8 + (tid >> 6), nw = gridDim.x * 8;
  for (int t = gw; t < T_ALL; t += nw) {
    const bf16_t* r = krb + (size_t)t * 32;
    const u32x4 a = *(const u32x4*)(cqb + (size_t)t * 512 + lane * 8); const u32x2 c = *(const u32x2*)(ckvb + (size_t)t * 256 + lane * 4);
    float sq = bflo(a.x) * bflo(a.x) + bfhi(a.x) * bfhi(a.x) + bflo(a.y) * bflo(a.y) + bfhi(a.y) * bfhi(a.y) + bflo(a.z) * bflo(a.z) + bfhi(a.z) * bfhi(a.z) + bflo(a.w) * bflo(a.w) + bfhi(a.w) * bfhi(a.w);
    float sk = bflo(c.x) * bflo(c.x) + bfhi(c.x) * bfhi(c.x) + bflo(c.y) * bflo(c.y) + bfhi(c.y) * bfhi(c.y);
#pragma unroll
    for (int o = 1; o < 64; o <<= 1) { sq += __shfl_xor(sq, o); sk += __shfl_xor(sk, o); }
    if (lane == 0) { rs[2 * t] = rsqrtf(sq * (1.f / 512.f) + 1e-6f); rs[2 * t + 1] = rsqrtf(sk * (1.f / 256.f) + 1e-6f); }
    if (lane < 16) { const int j = lane; float x1 = bf2f(r[j]), x2 = bf2f(r[16 + j]); const int b = t / PB, pp = t - b * PB;
      if (pp >= LC) { const int pos = pp - LC, row = pos >> 6, col = pos & 63; const float2 cs = tabM[(j < 8 ? row : col) * 8 + (j & 7)]; const float o1 = x1 * cs.x - x2 * cs.y, o2 = x1 * cs.y + x2 * cs.x; x1 = o1; x2 = o2; }
      const unsigned pr = pk2(x1, x2);
#pragma unroll
      for (int h = 0; h < 16; ++h) *(unsigned*)(km + (size_t)t * 1536 + h * 96 + 64 + 2 * j) = pr; }
  }
}

constexpr int KLD = 104, VLD = 72;
DI void mla_attn_phase(const Params& p, char* lds) {
  const bf16_t* Qm = (const bf16_t*)(p.ws + M_Q); const bf16_t* Km = (const bf16_t*)(p.ws + M_K); const bf16_t* vT = (const bf16_t*)(p.ws + M_VT); bf16_t* o = (bf16_t*)(p.ws + OFF_A);
  const int tid = threadIdx.x, lane = tid & 63, w = tid >> 6, c = lane & 31, hh = lane >> 5;
  constexpr int KB = 64 * KLD, VB = 64 * VLD;
  bf16_t* Ks = (bf16_t*)lds; bf16_t* Vs = Ks + 3 * KB;
  for (int item = blockIdx.x; item < 2048 + 64; item += gridDim.x) {
    int b, h, qbase, nkt;
    if (item < 2048) { const int pr = (item >> 8) * 8 + (item & 7), qb = (item & 255) >> 3;
      b = pr >> 4; h = pr & 15; qbase = LC + qb * 256; nkt = 132; } else { const int it = item - 2048; b = it >> 4; h = it & 15; qbase = 0; nkt = 4; }
    const size_t tokbase = (size_t)b * PB;
    const bf16_t* qp = Qm + (tokbase + qbase + w * 32 + c) * 1536 + h * 96 + hh * 8;
    bf16x8 qf[6];
#pragma unroll
    for (int ks = 0; ks < 6; ++ks) qf[ks] = *(const bf16x8*)(qp + ks * 16);
    const bf16_t* kg = Km + tokbase * 1536 + h * 96; const bf16_t* vg = vT + (size_t)(b * 16 + h) * 64 * PB;
    const int kr0 = tid / 12, kc0 = tid - kr0 * 12, e1 = tid + NTHR, kr1 = e1 / 12, kc1 = e1 - kr1 * 12; const bool k1ok = e1 < 768; const int vd = tid >> 3, vc = tid & 7;
    u32x4 rk0, rk1 = (u32x4){0, 0, 0, 0}, rv;
    auto gload = [&](int t) { const size_t key0 = (size_t)t * 64;
      rk0 = *(const u32x4*)(kg + (key0 + kr0) * 1536 + kc0 * 8); if (k1ok) rk1 = *(const u32x4*)(kg + (key0 + kr1) * 1536 + kc1 * 8); rv = *(const u32x4*)(vg + (size_t)vd * PB + key0 + vc * 8); };
    auto lstore = [&](int buf) { bf16_t* Kn = Ks + buf * KB; bf16_t* Vn = Vs + buf * VB;
      *(u32x4*)(Kn + kr0 * KLD + kc0 * 8) = rk0; if (k1ok) *(u32x4*)(Kn + kr1 * KLD + kc1 * 8) = rk1; *(u32x4*)(Vn + vd * VLD + vc * 8) = rv; };
    f32x16 oacc[2];
#pragma unroll
    for (int i = 0; i < 16; ++i) { oacc[0][i] = 0.f; oacc[1][i] = 0.f; }
    float mrow = -1e30f, lsum = 0.f;
    auto qk = [&](int buf, f32x16 (&s)[2]) { const bf16_t* Kc = Ks + buf * KB;
#pragma unroll
      for (int j = 0; j < 2; ++j) {
#pragma unroll
        for (int i = 0; i < 16; ++i) s[j][i] = 0.f;
#pragma unroll
        for (int ks = 0; ks < 6; ++ks) { const bf16x8 kf = *(const bf16x8*)(Kc + (32 * j + c) * KLD + ks * 16 + hh * 8); s[j] = mfma32(kf, qf[ks], s[j]); }
      } };
    auto smpv = [&](int buf, f32x16 (&s)[2]) { const bf16_t* Vc = Vs + buf * VB;
      float mx = s[0][0];
#pragma unroll
      for (int j = 0; j < 2; ++j)
#pragma unroll
        for (int i = 0; i < 16; ++i) mx = fmaxf(mx, s[j][i]);
      if (__builtin_amdgcn_ballot_w64(mx > mrow + 8.f) != 0ull) {
        mx = fmaxf(mx, __shfl_xor(mx, 32));
        const float mnew = fmaxf(mrow, mx), alpha = __builtin_amdgcn_exp2f(mrow - mnew); mrow = mnew;
        lsum *= alpha;
#pragma unroll
        for (int i = 0; i < 16; ++i) { oacc[0][i] *= alpha; oacc[1][i] *= alpha; }
      }
      float ps0 = 0.f, ps1 = 0.f;
#pragma unroll
      for (int j = 0; j < 2; ++j)
#pragma unroll
        for (int i = 0; i < 16; i += 2) { s[j][i] = __builtin_amdgcn_exp2f(s[j][i] - mrow); ps0 += s[j][i]; s[j][i + 1] = __builtin_amdgcn_exp2f(s[j][i + 1] - mrow); ps1 += s[j][i + 1]; }
      lsum += ps0 + ps1;
#pragma unroll
      for (int j = 0; j < 2; ++j)
#pragma unroll
        for (int sx = 0; sx < 2; ++sx) {
          const bf16x8 pf = pack8(s[j][8 * sx], s[j][8 * sx + 1], s[j][8 * sx + 2], s[j][8 * sx + 3], s[j][8 * sx + 4], s[j][8 * sx + 5], s[j][8 * sx + 6], s[j][8 * sx + 7]);
#pragma unroll
          for (int dt = 0; dt < 2; ++dt) { const bf16_t* vp = Vc + (32 * dt + c) * VLD + 32 * j + 16 * sx + 4 * hh;
            const bf16x8 vf = cat44(*(const s16x4*)vp, *(const s16x4*)(vp + 8)); oacc[dt] = mfma32(vf, pf, oacc[dt]); }
        } };
    __syncthreads();
    gload(0); lstore(0); gload(1); lstore(1); if (nkt > 2) gload(2);
    __syncthreads();
    f32x16 sA[2], sB[2];
    qk(0, sA);
    int b0 = 0, b1 = 1, b2 = 2;
    for (int kt = 0; kt < nkt; kt += 2) {
      __syncthreads();
      if (kt + 2 < nkt) { lstore(b2); if (kt + 3 < nkt) gload(kt + 3); }
      qk(b1, sB);
      smpv(b0, sA);
      __syncthreads();
      if (kt + 3 < nkt) { lstore(b0); if (kt + 4 < nkt) gload(kt + 4); }
      if (kt + 2 < nkt) qk(b2, sA);
      smpv(b1, sB);
      { const int t0 = b0; b0 = b2; b2 = b1; b1 = t0; }
    }
    lsum += __shfl_xor(lsum, 32); const float inv = 1.f / lsum;
    bf16_t* op = o + (tokbase + qbase + w * 32 + c) * 1024 + h * 64 + 4 * hh;
#pragma unroll
    for (int dt = 0; dt < 2; ++dt)
#pragma unroll
      for (int rg = 0; rg < 4; ++rg) st4bf(op + 32 * dt + 8 * rg, (f32x4){oacc[dt][4 * rg] * inv, oacc[dt][4 * rg + 1] * inv, oacc[dt][4 * rg + 2] * inv, oacc[dt][4 * rg + 3] * inv});
  }
}

template <int N> DI void pin_frags(bf16x8 (&f)[N]) {
  if constexpr (N == 8) asm volatile("" : "+v"(f[0]), "+v"(f[1]), "+v"(f[2]), "+v"(f[3]), "+v"(f[4]), "+v"(f[5]), "+v"(f[6]), "+v"(f[7]));
  else if constexpr (N == 4) asm volatile("" : "+v"(f[0]), "+v"(f[1]), "+v"(f[2]), "+v"(f[3]));
  else if constexpr (N == 2) asm volatile("" : "+v"(f[0]), "+v"(f[1]));
}
constexpr int NKC = 72, NVC = 264;
constexpr int NWK = 72, NWV = 584;
constexpr int NA_OFF_VC = 256 * NKC * 2, NA_OFF_RPB = NA_OFF_VC + 64 * NVC * 2, NA_OFF_W = NA_OFF_RPB + 1920, NA_LDS = NA_OFF_W + 576 * NWK * 2;
static_assert(64 * NWV * 2 <= 576 * NWK * 2 && NA_OFF_W % 16 == 0, "NA window");
DI void na_ctx_wave(const bf16_t* __restrict__ Q, bf16_t* __restrict__ o, const bf16_t* Kc, const bf16_t* Vc, int b, int h, int qb, int lane) {
  const int g = lane >> 4, l16 = lane & 15; const size_t tokbase = (size_t)b * PB; const int qpos = qb * 16 + l16;
  const bf16_t* qp = Q + (tokbase + qpos) * 1024 + h * 64 + g * 8;
  const bf16x8 q0 = *(const bf16x8*)qp, q1 = *(const bf16x8*)(qp + 32);
  f32x4 S[16];
#pragma unroll
  for (int kt = 0; kt < 16; ++kt) { const bf16_t* kp = Kc + (16 * kt + l16) * NKC + g * 8;
    f32x4 s = mfma16(*(const bf16x8*)kp, q0, (f32x4){0.f, 0.f, 0.f, 0.f}); s = mfma16(*(const bf16x8*)(kp + 32), q1, s); S[kt] = s * LOG2E; }
  float mx = S[0][0];
#pragma unroll
  for (int kt = 0; kt < 16; ++kt) mx = fmaxf(fmaxf(fmaxf(mx, S[kt][0]), fmaxf(S[kt][1], S[kt][2])), S[kt][3]);
  mx = fmaxf(mx, __shfl_xor(mx, 16)); mx = fmaxf(mx, __shfl_xor(mx, 32));
  float ls = 0.f;
#pragma unroll
  for (int kt = 0; kt < 16; ++kt)
#pragma unroll
    for (int rr = 0; rr < 4; ++rr) { S[kt][rr] = __builtin_amdgcn_exp2f(S[kt][rr] - mx); ls += S[kt][rr]; }
  ls += __shfl_xor(ls, 16); ls += __shfl_xor(ls, 32);
  f32x4 O[4];
#pragma unroll
  for (int dt = 0; dt < 4; ++dt) O[dt] = (f32x4){0.f, 0.f, 0.f, 0.f};
#pragma unroll
  for (int kk = 0; kk < 8; ++kk) {
    const bf16x8 pf = pack8(S[2 * kk][0], S[2 * kk][1], S[2 * kk][2], S[2 * kk][3], S[2 * kk + 1][0], S[2 * kk + 1][1], S[2 * kk + 1][2], S[2 * kk + 1][3]);
#pragma unroll
    for (int dt = 0; dt < 4; ++dt) { const bf16_t* vp = Vc + (dt * 16 + l16) * NVC + 32 * kk + 4 * g; const bf16x8 vf = cat44(*(const s16x4*)vp, *(const s16x4*)(vp + 16)); O[dt] = mfma16(vf, pf, O[dt]); }
  }
  const float inv = 1.f / ls; bf16_t* op = o + (tokbase + qpos) * 1024 + h * 64 + 4 * g;
#pragma unroll
  for (int dt = 0; dt < 4; ++dt) st4bf(op + 16 * dt, O[dt] * inv);
}
DI void na_attn_phase(const Params& p, char* lds) {
  const bf16_t* Q = (const bf16_t*)(p.ws + N_Q); const bf16_t* K = (const bf16_t*)(p.ws + N_K); const bf16_t* vT = (const bf16_t*)(p.ws + N_VT); bf16_t* o = (bf16_t*)(p.ws + OFF_A);
  bf16_t* Kc = (bf16_t*)lds; bf16_t* Vc = (bf16_t*)(lds + NA_OFF_VC); float* rl = (float*)(lds + NA_OFF_RPB); bf16_t* W = (bf16_t*)(lds + NA_OFF_W);
  const int tid = threadIdx.x, lane = tid & 63, w = tid >> 6, g = lane >> 4, l16 = lane & 15;
  for (int item = blockIdx.x; item < 256; item += gridDim.x) {
    const int qtr = item & 3, h = (item >> 2) & 15, b = item >> 6; const size_t tokbase = (size_t)b * PB;
    const bf16_t* kbase = K + (tokbase + LC) * 1024 + h * 64; const bf16_t* vbase = vT + (size_t)(b * 16 + h) * 64 * PB + LC;
    __syncthreads();
#pragma unroll
    for (int i = 0; i < 4; ++i) { const int e = tid + NTHR * i; const int key = e >> 3, kc = e & 7; *(u32x4*)(Kc + key * NKC + kc * 8) = *(const u32x4*)(K + (tokbase + key) * 1024 + h * 64 + kc * 8); }
#pragma unroll
    for (int i = 0; i < 4; ++i) { const int e = tid + NTHR * i; const int d = e >> 5, pc = e & 31; *(u32x4*)(Vc + d * NVC + pc * 8) = *(const u32x4*)(vT + ((size_t)(b * 16 + h) * 64 + d) * PB + pc * 8); }
    for (int e = tid; e < 465; e += NTHR) rl[e] = p.na_rpb[h * 465 + e];
    u32x4 rw[9];
#pragma unroll 1
    for (int j = 0; j < 16; ++j) {
      int ln = lane, tt = tid; asm volatile("" : "+v"(ln), "+v"(tt)); const int gg = ln >> 4, ll = ln & 15;
      const int r0 = qtr * 32 + 2 * j, rs0 = clampi(r0 - 4, 0, 120), r = r0 + (w >> 2), n = w & 3, rs = clampi(r - 4, 0, 120), dr = rs - rs0, band0 = clampi(16 * n - 8, 0, 32);
      const int qpos = LC + r * 64 + n * 16 + ll;
#pragma unroll
      for (int i = 0; i < 9; ++i) { const int e = tt + NTHR * i; rw[i] = *(const u32x4*)(kbase + (size_t)(rs0 * 64 + (e >> 3)) * 1024 + (e & 7) * 8); }
      __syncthreads();
#pragma unroll
      for (int i = 0; i < 9; ++i) { const int e = tt + NTHR * i; *(u32x4*)(W + (e >> 3) * NWK + (e & 7) * 8) = rw[i]; }
      __syncthreads();
      const bf16_t* qp = Q + (tokbase + qpos) * 1024 + h * 64 + gg * 8;
      const bf16x8 q0 = *(const bf16x8*)qp, q1 = *(const bf16x8*)(qp + 32);
      f32x4 S[32];
#pragma unroll
      for (int kg = 0; kg < 8; ++kg) {
        bf16x8 ka[4], kb[4];
#pragma unroll
        for (int u = 0; u < 4; ++u) { const int kt = 4 * kg + u;
          const bf16_t* kp = kt < 16 ? W + ((dr + (kt >> 1)) * 64 + band0 + 16 * (kt & 1) + ll) * NWK + gg * 8 : Kc + (16 * (kt - 16) + ll) * NKC + gg * 8;
          ka[u] = *(const bf16x8*)kp; kb[u] = *(const bf16x8*)(kp + 32); }
        pin_frags(ka); pin_frags(kb);
#pragma unroll
        for (int u = 0; u < 4; ++u) { const int kt = 4 * kg + u;
          f32x4 s = mfma16(ka[u], q0, (f32x4){0.f, 0.f, 0.f, 0.f}); s = mfma16(kb[u], q1, s);
          if (kt < 16) {
            const int qcol = 16 * n + ll, wstart = clampi(qcol - 8, 0, 48); const float* bp = rl + (rs + (kt >> 1) - r + 7) * 31;
#pragma unroll
            for (int rr = 0; rr < 4; ++rr) { const int kcol = band0 + 16 * (kt & 1) + 4 * gg + rr; const bool ok = kcol >= wstart && kcol < wstart + 16;
              s[rr] = ok ? (s[rr] + bp[clampi(kcol - qcol + 15, 0, 30)]) * LOG2E : -1e30f; }
          } else s = s * LOG2E;
          S[kt] = s; }
      }
      float mx = S[0][0];
#pragma unroll
      for (int kt = 0; kt < 32; ++kt) mx = fmaxf(fmaxf(fmaxf(mx, S[kt][0]), fmaxf(S[kt][1], S[kt][2])), S[kt][3]);
      mx = fmaxf(mx, __shfl_xor(mx, 16)); mx = fmaxf(mx, __shfl_xor(mx, 32));
      float ls = 0.f;
#pragma unroll
      for (int kt = 0; kt < 32; ++kt)
#pragma unroll
        for (int rr = 0; rr < 4; ++rr) { S[kt][rr] = __builtin_amdgcn_exp2f(S[kt][rr] - mx); ls += S[kt][rr]; }
      ls += __shfl_xor(ls, 16); ls += __shfl_xor(ls, 32);
      bf16x8 pf[16];
#pragma unroll
      for (int kk = 0; kk < 16; ++kk) pf[kk] = pack8(S[2 * kk][0], S[2 * kk][1], S[2 * kk][2], S[2 * kk][3], S[2 * kk + 1][0], S[2 * kk + 1][1], S[2 * kk + 1][2], S[2 * kk + 1][3]);
#pragma unroll
      for (int i = 0; i < 9; ++i) { const int e = tt + NTHR * i, d = e / 72, pc = e - d * 72; rw[i] = *(const u32x4*)(vbase + (size_t)d * PB + rs0 * 64 + pc * 8); }
      __syncthreads();
#pragma unroll
      for (int i = 0; i < 9; ++i) { const int e = tt + NTHR * i, d = e / 72, pc = e - d * 72; *(u32x4*)(W + d * NWV + pc * 8) = rw[i]; }
      __syncthreads();
      f32x4 O[4];
#pragma unroll
      for (int dt = 0; dt < 4; ++dt) O[dt] = (f32x4){0.f, 0.f, 0.f, 0.f};
#pragma unroll
      for (int kk = 0; kk < 16; ++kk) {
        bf16x8 vf[4];
#pragma unroll
        for (int dt = 0; dt < 4; ++dt) { const bf16_t* vp = kk < 8 ? W + (dt * 16 + ll) * NWV + (dr + kk) * 64 + band0 + 4 * gg : Vc + (dt * 16 + ll) * NVC + 32 * (kk - 8) + 4 * gg;
          vf[dt] = cat44(*(const s16x4*)vp, *(const s16x4*)(vp + 16)); }
        pin_frags(vf);
#pragma unroll
        for (int dt = 0; dt < 4; ++dt) O[dt] = mfma16(vf[dt], pf[kk], O[dt]);
      }
      const float inv = 1.f / ls; bf16_t* op = o + (tokbase + qpos) * 1024 + h * 64 + 4 * gg;
#pragma unroll
      for (int dt = 0; dt < 4; ++dt) st4bf(op + 16 * dt, O[dt] * inv);
    }
    if (w < 4) na_ctx_wave(Q, o, Kc, Vc, b, h, qtr * 4 + w, lane);
  }
}

template <int DK> struct ScanLds { static constexpr int QLD = DK + 8, TLD = 72;
  static constexpr int OFF_QD = 0, OFF_KD = OFF_QD + 64 * QLD * 2, OFF_VT = OFF_KD + 64 * QLD * 2, OFF_ATT = OFF_VT + 64 * TLD * 2, OFF_ST = OFF_ATT + 64 * TLD * 2, OFF_EB = OFF_ST + 64 * QLD * 2, OFF_QS = OFF_EB + DK * 4, TOTAL = OFF_QS + 8 * DK * 4; };
DI int scan_pos(int dir, int i, int tl) { if (dir == 0) return i * 64 + tl; return i < 4 ? 255 - (i * 64 + tl) : 8447 - ((i - 4) * 64 + tl); }
DI bf16x8 gather8(const bf16_t* p, int stride) {
  const unsigned a0 = p[0], a1 = p[stride], a2 = p[2 * stride], a3 = p[3 * stride], a4 = p[4 * stride], a5 = p[5 * stride], a6 = p[6 * stride], a7 = p[7 * stride];
  u32x4 r; r.x = a0 | (a1 << 16); r.y = a2 | (a3 << 16); r.z = a4 | (a5 << 16); r.w = a6 | (a7 << 16); return __builtin_bit_cast(bf16x8, r);
}

template <int DK, bool HG, int DVS>
DI void scan_phase(const Params& p, char* lds) {
  typedef ScanLds<DK> L;
  bf16_t* Qd = (bf16_t*)(lds + L::OFF_QD); bf16_t* Kd = (bf16_t*)(lds + L::OFF_KD); bf16_t* Vt = (bf16_t*)(lds + L::OFF_VT);
  bf16_t* Att = (bf16_t*)(lds + L::OFF_ATT); bf16_t* St = (bf16_t*)(lds + L::OFF_ST); float* eb = (float*)(lds + L::OFF_EB); float* qs = (float*)(lds + L::OFF_QS);
  constexpr int QLD = L::QLD, TLD = L::TLD, KT = DK / 16 / 8;
  const int tid = tid_(), lane = tid & 63, w = tid >> 6, g4 = lane >> 4, l16 = lane & 15;
  const int nitems = 256; constexpr int NVI = DVS / 16, NTO = NVI * 4 / 8;
  const float* lbv = (const float*)(p.ws + OFF_LBV);
  for (int item = blockIdx.x; item < nitems; item += gridDim.x) {
    const int xcd = item & 7, yy = item >> 3; int b, h, sl, dir;
    if (HG) { const int grp = xcd * 8 + (yy >> 2); sl = yy & 3; h = grp & 7; b = (grp >> 3) & 3; dir = grp >> 5; }
    else { const int grp = xcd * 4 + (yy >> 3); sl = yy & 7; h = grp & 3; b = (grp >> 2) & 3; dir = grp >> 4; }
    const size_t tokbase = (size_t)b * PB;
    const bf16_t *qsrc, *ksrc, *vsrc; int ldq, ldv; bf16_t *octx, *olat; int ldo;
    if (HG) { const bf16_t* ph = (const bf16_t*)(p.ws + H_P); qsrc = ph + h * 128; ksrc = ph + 1024 + dir * 1024 + h * 128; vsrc = ph + 3072 + h * 128 + sl * DVS; ldq = 5120; ldv = 5120; ldo = 1024;
      octx = (bf16_t*)(p.ws + (dir ? OFF_W0 : OFF_A)) + tokbase * 1024 + h * 128 + sl * DVS; olat = octx + (size_t)LC * 1024; }
    else { const bf16_t* qk = (const bf16_t*)(p.ws + R_QK); qsrc = qk + h * 256; ksrc = qk + 1024 + h * 256; vsrc = (const bf16_t*)(p.ws + R_V) + h * 512 + sl * 64; ldq = 2048; ldv = 2048; ldo = 2048;
      if (dir == 0) { octx = (bf16_t*)(p.ws + R_O) + tokbase * 2048 + h * 512 + sl * 64; olat = octx + (size_t)LC * 2048; }
      else { octx = (bf16_t*)(p.ws + OFF_HCTX) + (size_t)b * LC * 2048 + h * 512 + sl * 64; olat = (bf16_t*)p.out + (size_t)b * LL * 2048 + h * 512 + sl * 64; } }
    float lg = 0.f; if (!HG) lg = -__expf(p.ret_decay[dir * 4 + h]);
    float lb0 = 0.f, lb1 = 0.f; if (HG) { lb0 = lbv[h * 128 + 2 * (tid & 63)]; lb1 = lbv[h * 128 + 2 * (tid & 63) + 1]; }
    f32x4 sacc[KT][NVI];
#pragma unroll
    for (int a = 0; a < KT; ++a)
#pragma unroll
      for (int v = 0; v < NVI; ++v) sacc[a][v] = (f32x4){0.f, 0.f, 0.f, 0.f};
    u32x4 rq[4], rk[4], rvv; unsigned rf[8], rqq[8]; float bl[16], qv[16], kv[16];
    const int vtl = tid & 63, vvc = tid >> 6;
    auto issue = [&](int i) {
      if (HG) { const int kp = tid & 63, seg = tid >> 6;
#pragma unroll
        for (int j = 0; j < 8; ++j) { const size_t row = tokbase + scan_pos(dir, i, seg * 8 + j); rf[j] = *(const unsigned*)(ksrc + row * ldq + 2 * kp); rqq[j] = *(const unsigned*)(qsrc + row * ldq + 2 * kp); } }
      else {
#pragma unroll
        for (int it = 0; it < 4; ++it) { const int e = tid + NTHR * it, tl = e >> 5, kc = e & 31; const size_t row = tokbase + scan_pos(dir, i, tl); rq[it] = *(const u32x4*)(qsrc + row * ldq + kc * 8); rk[it] = *(const u32x4*)(ksrc + row * ldq + kc * 8); } }
      if (vvc < DVS / 8) { const size_t row = tokbase + scan_pos(dir, i, vtl); rvv = *(const u32x4*)(vsrc + row * ldv + vvc * 8); }
    };
    auto prep = [&]() {
      const int kp = tid & 63, seg = tid >> 6; float run0 = 1.f, run1 = 1.f;
#pragma unroll
      for (int j = 0; j < 8; ++j) { const float f0 = bflo(rf[j]), f1 = bfhi(rf[j]); qv[2 * j] = bflo(rqq[j]); qv[2 * j + 1] = bfhi(rqq[j]);
        const float s0 = __builtin_amdgcn_rcpf(1.f + __expf(-f0)), s1 = __builtin_amdgcn_rcpf(1.f + __expf(-f1)); const float g0 = lb0 + (1.f - lb0) * s0, g1 = lb1 + (1.f - lb1) * s1;
        kv[2 * j] = 1.f - g0; kv[2 * j + 1] = 1.f - g1; run0 *= g0; run1 *= g1; bl[2 * j] = run0; bl[2 * j + 1] = run1; }
      qs[seg * DK + 2 * kp] = run0; qs[seg * DK + 2 * kp + 1] = run1;
    };
    __syncthreads();
    issue(0); if (HG) prep();
    __syncthreads();
    for (int i = 0; i < 132; ++i) {
      if (HG) { const int kp = tid & 63, seg = tid >> 6; float off0 = 1.f, off1 = 1.f;
#pragma unroll
        for (int q = 0; q < 7; ++q) if (q < seg) { off0 *= qs[q * DK + 2 * kp]; off1 *= qs[q * DK + 2 * kp + 1]; }
        if (seg == 7) { eb[2 * kp] = off0 * bl[14]; eb[2 * kp + 1] = off1 * bl[15]; }
#pragma unroll
        for (int j = 0; j < 8; ++j) { const int tl = seg * 8 + j; const float p0 = bl[2 * j] * off0, p1 = bl[2 * j + 1] * off1;
          *(unsigned*)(Qd + tl * QLD + 2 * kp) = pk2(qv[2 * j] * p0, qv[2 * j + 1] * p1);
          *(unsigned*)(Kd + tl * QLD + 2 * kp) = pk2(kv[2 * j] * __builtin_amdgcn_rcpf(p0), kv[2 * j + 1] * __builtin_amdgcn_rcpf(p1)); } }
      else {
        if (tid < DK) eb[tid] = __expf(64.f * lg);
#pragma unroll
        for (int it = 0; it < 4; ++it) { const int e = tid + NTHR * it, tl = e >> 5, kc = e & 31; const u32x4 qr = rq[it], kr = rk[it];
          const float eq = __expf((float)(tl + 1) * lg), ek = __expf(-(float)(tl + 1) * lg);
          u32x4 qo, ko; qo.x = pk2(bflo(qr.x) * eq, bfhi(qr.x) * eq); qo.y = pk2(bflo(qr.y) * eq, bfhi(qr.y) * eq); qo.z = pk2(bflo(qr.z) * eq, bfhi(qr.z) * eq); qo.w = pk2(bflo(qr.w) * eq, bfhi(qr.w) * eq);
          ko.x = pk2(bflo(kr.x) * ek, bfhi(kr.x) * ek); ko.y = pk2(bflo(kr.y) * ek, bfhi(kr.y) * ek); ko.z = pk2(bflo(kr.z) * ek, bfhi(kr.z) * ek); ko.w = pk2(bflo(kr.w) * ek, bfhi(kr.w) * ek);
          *(u32x4*)(Qd + tl * QLD + kc * 8) = qo; *(u32x4*)(Kd + tl * QLD + kc * 8) = ko; } }
      if (vvc < DVS / 8) { bf16_t* vt = Vt + (vvc * 8) * TLD + vtl; const u32x4 vr = rvv;
        vt[0] = (bf16_t)(vr.x & 0xffff); vt[TLD] = (bf16_t)(vr.x >> 16); vt[2 * TLD] = (bf16_t)(vr.y & 0xffff); vt[3 * TLD] = (bf16_t)(vr.y >> 16);
        vt[4 * TLD] = (bf16_t)(vr.z & 0xffff); vt[5 * TLD] = (bf16_t)(vr.z >> 16); vt[6 * TLD] = (bf16_t)(vr.w & 0xffff); vt[7 * TLD] = (bf16_t)(vr.w >> 16); }
#pragma unroll
      for (int a = 0; a < KT; ++a) { const int ki = w * KT + a;
#pragma unroll
        for (int vi = 0; vi < NVI; ++vi) st4bf(St + (16 * vi + l16) * QLD + 16 * ki + 4 * g4, sacc[a][vi]); }
      __syncthreads();
      if (i + 1 < 132) issue(i + 1);
      { const int ti = w >> 1;
        bf16x8 qf[DK / 32];
#pragma unroll
        for (int ks = 0; ks < DK / 32; ++ks) qf[ks] = *(const bf16x8*)(Qd + (16 * ti + l16) * QLD + ks * 32 + g4 * 8);
#pragma unroll
        for (int u = 0; u < 2; ++u) { const int si = (2 * w + u) & 3; f32x4 d = (f32x4){0.f, 0.f, 0.f, 0.f};
          if (si <= ti) { bf16x8 kf[DK / 32];
#pragma unroll
            for (int ks = 0; ks < DK / 32; ++ks) kf[ks] = *(const bf16x8*)(Kd + (16 * si + l16) * QLD + ks * 32 + g4 * 8);
            pin_frags(kf);
#pragma unroll
            for (int ks = 0; ks < DK / 32; ++ks) d = mfma16(kf[ks], qf[ks], d); }
          const int t = 16 * ti + l16, s0 = 16 * si + 4 * g4;
#pragma unroll
          for (int rr = 0; rr < 4; ++rr) if (s0 + rr > t) d[rr] = 0.f;
          st4bf(Att + t * TLD + s0, d); } }
      __syncthreads();
      { const int vi = (NTO * w) >> 2;
        bf16x8 xv[2], xs[DK / 32];
#pragma unroll
        for (int ks = 0; ks < 2; ++ks) xv[ks] = *(const bf16x8*)(Vt + (16 * vi + l16) * TLD + ks * 32 + g4 * 8);
#pragma unroll
        for (int ks = 0; ks < DK / 32; ++ks) xs[ks] = *(const bf16x8*)(St + (16 * vi + l16) * QLD + ks * 32 + g4 * 8);
        pin_frags(xv); pin_frags(xs);
#pragma unroll
        for (int u = 0; u < NTO; ++u) { const int ti = (NTO * w + u) & 3; bf16x8 ya[2], yq[DK / 32];
#pragma unroll
          for (int ks = 0; ks < 2; ++ks) ya[ks] = *(const bf16x8*)(Att + (16 * ti + l16) * TLD + ks * 32 + g4 * 8);
#pragma unroll
          for (int ks = 0; ks < DK / 32; ++ks) yq[ks] = *(const bf16x8*)(Qd + (16 * ti + l16) * QLD + ks * 32 + g4 * 8);
          pin_frags(ya); pin_frags(yq);
          f32x4 d = (f32x4){0.f, 0.f, 0.f, 0.f};
#pragma unroll
          for (int ks = 0; ks < 2; ++ks) d = mfma16(xv[ks], ya[ks], d);
#pragma unroll
          for (int ks = 0; ks < DK / 32; ++ks) d = mfma16(xs[ks], yq[ks], d);
          const int pos = scan_pos(dir, i, 16 * ti + l16); bf16_t* op = (pos < LC ? octx + (size_t)pos * ldo : olat + (size_t)(pos - LC) * ldo) + 16 * vi + 4 * g4;
          st4bf(op, d); } }
      { bf16x8 yv[NVI][2];
#pragma unroll
        for (int vi = 0; vi < NVI; ++vi)
#pragma unroll
          for (int ks = 0; ks < 2; ++ks) yv[vi][ks] = *(const bf16x8*)(Vt + (16 * vi + l16) * TLD + ks * 32 + g4 * 8);
#pragma unroll
        for (int a = 0; a < KT; ++a) { const int ki = w * KT + a; bf16x8 xf[2];
#pragma unroll
          for (int ks = 0; ks < 2; ++ks) xf[ks] = gather8(Kd + (ks * 32 + g4 * 8) * QLD + 16 * ki + l16, QLD);
#pragma unroll
          for (int ks = 0; ks < 2; ++ks)
#pragma unroll
            for (int vi = 0; vi < NVI; ++vi) sacc[a][vi] = mfma16(xf[ks], yv[vi][ks], sacc[a][vi]);
          const f32x4 e4 = *(const f32x4*)(eb + 16 * ki + 4 * g4);
#pragma unroll
          for (int vi = 0; vi < NVI; ++vi) sacc[a][vi] = sacc[a][vi] * e4; } }
      if (HG && i + 1 < 132) prep();
      __syncthreads();
    }
  }
}

DI float bsum2(unsigned a, unsigned b, float& lo, float& hi) { lo = bflo(a) + bflo(b); hi = bfhi(a) + bfhi(b); return lo * lo + hi * hi; }
DI void ret_readout_phase(const Params& p) {
  bf16_t* O = (bf16_t*)(p.ws + R_O); const bf16_t* G = (const bf16_t*)(p.ws + R_QK);
  const int tid = threadIdx.x, lane = tid & 63, gw = blockIdx.x * 8 + (tid >> 6), nw = gridDim.x * 8;
  for (int t = gw; t < T_ALL; t += nw) {
    const int b = t / PB, pp = t - b * PB;
    const bf16_t* ob = (pp < LC ? (const bf16_t*)(p.ws + OFF_HCTX) + (size_t)(b * LC + pp) * 2048 : (const bf16_t*)p.out + (size_t)(b * LL + pp - LC) * 2048) + lane * 32;
    bf16_t* op = O + (size_t)t * 2048 + lane * 32; const bf16_t* gp = G + (size_t)t * 2048 + lane * 32;
    float ov[32]; u32x4 gv[4]; float sq = 0.f;
#pragma unroll
    for (int i = 0; i < 4; ++i) { const u32x4 x = *(const u32x4*)(op + i * 8), y = *(const u32x4*)(ob + i * 8); gv[i] = *(const u32x4*)(gp + i * 8);
      sq += bsum2(x.x, y.x, ov[8 * i], ov[8 * i + 1]) + bsum2(x.y, y.y, ov[8 * i + 2], ov[8 * i + 3]) + bsum2(x.z, y.z, ov[8 * i + 4], ov[8 * i + 5]) + bsum2(x.w, y.w, ov[8 * i + 6], ov[8 * i + 7]); }
    sq += __shfl_xor(sq, 1); sq += __shfl_xor(sq, 2); sq += __shfl_xor(sq, 4); sq += __shfl_xor(sq, 8);
    const float rstd = rsqrtf(sq * (1.f / 512.f) + 1e-6f);
#pragma unroll
    for (int i = 0; i < 4; ++i) { u32x4 r;
      r.x = pk2(siluf(bflo(gv[i].x)) * ov[8 * i] * rstd, siluf(bfhi(gv[i].x)) * ov[8 * i + 1] * rstd); r.y = pk2(siluf(bflo(gv[i].y)) * ov[8 * i + 2] * rstd, siluf(bfhi(gv[i].y)) * ov[8 * i + 3] * rstd);
      r.z = pk2(siluf(bflo(gv[i].z)) * ov[8 * i + 4] * rstd, siluf(bfhi(gv[i].z)) * ov[8 * i + 5] * rstd); r.w = pk2(siluf(bflo(gv[i].w)) * ov[8 * i + 6] * rstd, siluf(bfhi(gv[i].w)) * ov[8 * i + 7] * rstd);
      *(u32x4*)(op + i * 8) = r; }
  }
}
DI void hg_readout_phase(const Params& p) {
  bf16_t* O = (bf16_t*)(p.ws + OFF_A); const bf16_t* OB = (const bf16_t*)(p.ws + OFF_W0); const bf16_t* ph = (const bf16_t*)(p.ws + H_P);
  const int tid = threadIdx.x, lane = tid & 63, gw = blockIdx.x * 8 + (tid >> 6), nw = gridDim.x * 8;
  for (int t = gw; t < T_ALL; t += nw) {
    bf16_t* op = O + (size_t)t * 1024 + lane * 16; const bf16_t* ob = OB + (size_t)t * 1024 + lane * 16; const bf16_t* gp = ph + (size_t)t * 5120 + 4096 + lane * 16; const float* ng = p.hg_norm_g + (lane & 7) * 16;
    float ov[16]; u32x4 gv[2]; float sq = 0.f;
#pragma unroll
    for (int i = 0; i < 2; ++i) { const u32x4 x = *(const u32x4*)(op + i * 8), y = *(const u32x4*)(ob + i * 8); gv[i] = *(const u32x4*)(gp + i * 8);
      sq += bsum2(x.x, y.x, ov[8 * i], ov[8 * i + 1]) + bsum2(x.y, y.y, ov[8 * i + 2], ov[8 * i + 3]) + bsum2(x.z, y.z, ov[8 * i + 4], ov[8 * i + 5]) + bsum2(x.w, y.w, ov[8 * i + 6], ov[8 * i + 7]); }
    sq += __shfl_xor(sq, 1); sq += __shfl_xor(sq, 2); sq += __shfl_xor(sq, 4);
    const float rstd = rsqrtf(sq * (1.f / 128.f) + 1e-6f);
#pragma unroll
    for (int i = 0; i < 2; ++i) { u32x4 r; const float* n8 = ng + i * 8;
      r.x = pk2(siluf(bflo(gv[i].x)) * ov[8 * i] * rstd * n8[0], siluf(bfhi(gv[i].x)) * ov[8 * i + 1] * rstd * n8[1]); r.y = pk2(siluf(bflo(gv[i].y)) * ov[8 * i + 2] * rstd * n8[2], siluf(bfhi(gv[i].y)) * ov[8 * i + 3] * rstd * n8[3]);
      r.z = pk2(siluf(bflo(gv[i].z)) * ov[8 * i + 4] * rstd * n8[4], siluf(bfhi(gv[i].z)) * ov[8 * i + 5] * rstd * n8[5]); r.w = pk2(siluf(bflo(gv[i].w)) * ov[8 * i + 6] * rstd * n8[6], siluf(bfhi(gv[i].w)) * ov[8 * i + 7] * rstd * n8[7]);
      *(u32x4*)(op + i * 8) = r; }
  }
}

#define XB_TMO      128
#define XB_XCNT(j)  (256  + 64 * (j))
#define XB_XSUB(j)  (1280 + 64 * (j))
#define XB_XGEN(j)  (2304 + 64 * (j))
#define XB_TOP      3328
#define XB_TOPGEN   3392
#define XCD_BAR_WORDS 3456
#define XB_SPIN_CAP (1u << 23)
#define LAS PG8_LAS

__device__ __forceinline__ unsigned xb_ld(unsigned* p)              { return __hip_atomic_load(p, __ATOMIC_RELAXED, __HIP_MEMORY_SCOPE_AGENT); }
__device__ __forceinline__ unsigned xb_add(unsigned* p, unsigned v) { return __hip_atomic_fetch_add(p, v, __ATOMIC_RELAXED, __HIP_MEMORY_SCOPE_AGENT); }
__device__ __forceinline__ unsigned xb_xcc_id() { return (unsigned)__builtin_amdgcn_s_getreg((3 << 11) | 20) & 0xFu; }
#define XB_SPIN(cond, bar) do { unsigned _sp = 0; while (cond) { __builtin_amdgcn_s_sleep(1); \
    if ((++_sp & 255u) == 0u) { if (xb_ld(&(bar)[XB_TMO])) break; if (_sp > XB_SPIN_CAP) { atomicAdd(&(bar)[XB_TMO], 1u); break; } } } } while (0)

struct XcdBarrier {
    unsigned* bar; unsigned x;
    volatile LAS unsigned* st;
};

__device__ __forceinline__ XcdBarrier xcd_barrier_post(unsigned* bar, volatile LAS unsigned* st) {
    XcdBarrier b; b.bar = bar; b.x = xb_xcc_id(); b.st = st;
    if (threadIdx.x == 0) (void)xb_add(&bar[XB_XCNT(b.x)], 1u);
    return b;
}
__device__ __forceinline__ void xcd_barrier_complete(unsigned* bar, unsigned x, unsigned& nloc, unsigned& nx) {
    const unsigned G = gridDim.x * gridDim.y * gridDim.z;
    unsigned sum, cnt, mine, sp = 0u;
    for (;;) {
        sum = 0u; cnt = 0u; mine = 0u;
#pragma unroll
        for (unsigned j = 0; j < 16; ++j) { const unsigned c = xb_ld(&bar[XB_XCNT(j)]); sum += c; cnt += (c > 0u) ? 1u : 0u; mine = (j == x) ? c : mine; }
        if (sum == G) break;
        __builtin_amdgcn_s_sleep(1);
        if ((++sp & 255u) == 0u) { if (xb_ld(&bar[XB_TMO])) break; if (sp > XB_SPIN_CAP) { atomicAdd(&bar[XB_TMO], 1u); break; } }
    }
    nloc = mine > 0u ? mine : 1u; nx = cnt > 0u ? cnt : 1u;
}

__device__ __forceinline__ void xcd_barrier(const XcdBarrier& b) {
    asm volatile("s_waitcnt vmcnt(0)" ::: "memory");
    __syncthreads();
    if (threadIdx.x == 0) {
        unsigned* bar = b.bar;
        __builtin_amdgcn_s_waitcnt(0);
        unsigned nloc = b.st[0], nx = b.st[1];
        if (nloc == 0u) { xcd_barrier_complete(bar, b.x, nloc, nx); b.st[0] = nloc; b.st[1] = nx; }
        const unsigned old = xb_add(&bar[XB_XSUB(b.x)], 1u);
        const unsigned gen = old / nloc;
        if (old + 1u == (gen + 1u) * nloc) {
            __builtin_amdgcn_fence(__ATOMIC_RELEASE, "agent");
            asm volatile("s_waitcnt vmcnt(0)" ::: "memory");
            const unsigned og = xb_add(&bar[XB_TOP], 1u);
            const unsigned tg = og / nx;
            if (og + 1u == (tg + 1u) * nx) xb_add(&bar[XB_TOPGEN], 1u);
            else XB_SPIN(xb_ld(&bar[XB_TOPGEN]) == tg, bar);
            __builtin_amdgcn_fence(__ATOMIC_ACQUIRE, "agent");
            xb_add(&bar[XB_XGEN(b.x)], 1u);
            asm volatile("s_waitcnt vmcnt(0)" ::: "memory");
        } else {
            XB_SPIN(xb_ld(&bar[XB_XGEN(b.x)]) == gen, bar);
            __builtin_amdgcn_fence(__ATOMIC_ACQUIRE, "agent");
            asm volatile("s_waitcnt vmcnt(0)" ::: "memory");
        }
    }
    __syncthreads();
}

constexpr int LDS_BYTES0 = ScanLds<256>::TOTAL > pg8::STAGE_BYTES ? ScanLds<256>::TOTAL : pg8::STAGE_BYTES;
constexpr int LDS_BYTES = LDS_BYTES0 > NA_LDS ? LDS_BYTES0 : NA_LDS;
static_assert(LDS_BYTES <= 163840, "LDS");
static_assert(LDS_BYTES >= (256 + 128) * LDT * 2 && LDS_BYTES >= 3 * 64 * (KLD + VLD) * 2 && LDS_BYTES >= (5120 + 8 * 5 * 64) * 4, "LDS phases");

DI void ffn_and_ln(const Params& p, const XcdBarrier& xb, char* lds, int layer, const bf16_t* w13, const bf16_t* w2) {
  const float* mods = (const float*)(p.ws + OFF_MODS); float* hctx = (float*)(p.ws + OFF_HCTX); bf16_t* a = (bf16_t*)(p.ws + OFF_A); bf16_t* U = (bf16_t*)(p.ws + F_U);
  { EpiSwiglu e{U}; big_gemm(a, w13, T_ALL, 5632, 1024, e, lds, layer == 3); }
  xcd_barrier(xb);
  { EpiResid e{p.out, hctx, p.out, hctx, mods + (size_t)layer * 5 * 6144 + 5 * 1024, (const float2*)(p.ws + OFF_LNS), p.ln_g + (size_t)(layer * 2) * 1024, p.ln_b + (size_t)(layer * 2) * 1024}; big_gemm(U, w2, T_ALL, 1024, FF, e, lds, 1); if (layer < 3) ctx_gemm(U, w2, FF, e, lds); }
  xcd_barrier(xb);
  ln_phase(p, layer, 1, layer < 3 ? layer + 1 : 3, 0, layer == 3);
  xcd_barrier(xb);
}

__global__ void __launch_bounds__(NTHR) mega(Params p) {
  __shared__ __attribute__((aligned(16))) char lds[LDS_BYTES];
  cg::grid_group grid = cg::this_grid();
  __shared__ uint4 xb_words;
  if (threadIdx.x == 0) xb_words = make_uint4(0u, 0u, 0u, 0u);
  __syncthreads();
  const XcdBarrier xb = xcd_barrier_post((unsigned*)(p.ws + OFF_BAR), (volatile LAS unsigned*)&xb_words);
  float* ldsf = (float*)lds;
  const float* mods = (const float*)(p.ws + OFF_MODS); float* hctx = (float*)(p.ws + OFF_HCTX); bf16_t* a = (bf16_t*)(p.ws + OFF_A);
  const float2* tabR = (const float2*)(p.ws + OFF_TABR); const float2* tabM = (const float2*)(p.ws + OFF_TABM); float* rs = (float*)(p.ws + OFF_RS);
  ada_phase(p, ldsf);
  tables_phase(p);
  convert_w<2>(p.ret_w_in, 6144, 1024, (bf16_t*)(p.ws + W0_RETIN), 6144, nullptr, ldsf);
  convert_w<0>(p.ret_w_out, 1024, 2048, (bf16_t*)(p.ws + W0_RETOUT), 1024, nullptr, ldsf);
  convert_w<1>(p.w13, 5632, 1024, (bf16_t*)(p.ws + W0_W13), 5632, nullptr, ldsf);
  convert_w<0>(p.w2, 1024, FF, (bf16_t*)(p.ws + W0_W2), 1024, nullptr, ldsf);
  grid.sync();
  modulate_phase(p, p.x, p.ctx, 0);
  xcd_barrier(xb);
  { const bf16_t* wi = (const bf16_t*)(p.ws + W0_RETIN);
    { EpiRetQK e{(bf16_t*)(p.ws + R_QK), tabR}; big_gemm(a, wi, T_ALL, 2048, 1024, e, lds, 1); ctx_gemm(a, wi, 1024, e, lds, 2048); }
    { EpiStore e{(bf16_t*)(p.ws + R_V), (bf16_t*)(p.ws + R_V), 1 << 30, 2048, 2048, 1.f}; big_gemm(a, wi + (size_t)2048 * 1024, T_ALL, 2048, 1024, e, lds, 1); ctx_gemm(a, wi + (size_t)2048 * 1024, 1024, e, lds, 2048); }
    xcd_barrier(xb);
    scan_phase<256, false, 64>(p, lds);
    xcd_barrier(xb);
    { EpiStore e{(bf16_t*)(p.ws + R_QK), (bf16_t*)(p.ws + R_QK), 1 << 30, 2048, 2048, 1.f}; big_gemm(a, wi + (size_t)4096 * 1024, T_ALL, 2048, 1024, e, lds, 1); ctx_gemm(a, wi + (size_t)4096 * 1024, 1024, e, lds, 2048); }
    xcd_barrier(xb);
    ret_readout_phase(p);
    xcd_barrier(xb);
    { EpiResid e{p.x, p.ctx, p.out, hctx, mods + 2 * 1024, nullptr, nullptr, nullptr}; big_gemm((const bf16_t*)(p.ws + R_O), (const bf16_t*)(p.ws + W0_RETOUT), T_ALL, 1024, 2048, e, lds, 1); ctx_gemm((const bf16_t*)(p.ws + R_O), (const bf16_t*)(p.ws + W0_RETOUT), 2048, e, lds); }
    xcd_barrier(xb);
    ln_phase(p, 0, 0, 0, 3, false);
    convert_w<0>(p.na_w_qkv, 3072, 1024, (bf16_t*)(p.ws + W1_QKV), 3072, nullptr, ldsf);
    convert_w<0>(p.na_w_out, 1024, 1024, (bf16_t*)(p.ws + W1_OUT), 1024, nullptr, ldsf);
    convert_w<1>(p.w13 + (size_t)1 * 1024 * 5632, 5632, 1024, (bf16_t*)(p.ws + W1_W13), 5632, nullptr, ldsf);
    convert_w<0>(p.w2 + (size_t)1 * FF * 1024, 1024, FF, (bf16_t*)(p.ws + W1_W2), 1024, nullptr, ldsf);
    convert_w<5>(p.mla_w_down, 800, 1024, (bf16_t*)(p.ws + W2_DOWN), 1024, nullptr, ldsf);
    convert_w<3>(p.mla_w_uq, 1536, 512, (bf16_t*)(p.ws + W2_UQ), 1536, p.mla_q_norm, ldsf);
    convert_w<4>(p.mla_w_ukv, 2048, 256, (bf16_t*)(p.ws + W2_UKV), 2048, p.mla_kv_norm, ldsf);
    convert_w<0>(p.mla_w_out, 1024, 1024, (bf16_t*)(p.ws + W2_OUT), 1024, nullptr, ldsf);
    convert_w<1>(p.w13 + (size_t)2 * 1024 * 5632, 5632, 1024, (bf16_t*)(p.ws + W2_W13), 5632, nullptr, ldsf);
    convert_w<0>(p.w2 + (size_t)2 * FF * 1024, 1024, FF, (bf16_t*)(p.ws + W2_W2), 1024, nullptr, ldsf);
    convert_w<0>(p.hg_w_in, 5120, 1024, (bf16_t*)(p.ws + W3_IN), 5120, nullptr, ldsf);
    convert_w<0>(p.hg_w_out, 1024, 1024, (bf16_t*)(p.ws + W3_OUT), 1024, nullptr, ldsf);
    convert_w<1>(p.w13 + (size_t)3 * 1024 * 5632, 5632, 1024, (bf16_t*)(p.ws + W3_W13), 5632, nullptr, ldsf);
    convert_w<0>(p.w2 + (size_t)3 * FF * 1024, 1024, FF, (bf16_t*)(p.ws + W3_W2), 1024, nullptr, ldsf);
    xcd_barrier(xb);
    ffn_and_ln(p, xb, lds, 0, (const bf16_t*)(p.ws + W0_W13), (const bf16_t*)(p.ws + W0_W2));
  }
  { const bf16_t* wq = (const bf16_t*)(p.ws + W1_QKV);
    { EpiStore e{(bf16_t*)(p.ws + N_Q), (bf16_t*)(p.ws + N_K), 1024, 1024, 1024, 0.125f}; big_gemm(a, wq, T_ALL, 2048, 1024, e, lds, 1); ctx_gemm(a, wq, 1024, e, lds, 2048); }
    { EpiVTn e{(bf16_t*)(p.ws + N_VT), nullptr}; big_gemm(a, wq + (size_t)2048 * 1024, T_ALL, 1024, 1024, e, lds, 1); ctx_gemm(a, wq + (size_t)2048 * 1024, 1024, e, lds); }
    xcd_barrier(xb);
    na_attn_phase(p, lds);
    xcd_barrier(xb);
    { EpiResid e{p.out, hctx, p.out, hctx, mods + (size_t)1 * 5 * 6144 + 2 * 1024, (const float2*)(p.ws + OFF_LNS), p.ln_g + (size_t)(0 * 2 + 1) * 1024, p.ln_b + (size_t)(0 * 2 + 1) * 1024}; big_gemm(a, (const bf16_t*)(p.ws + W1_OUT), T_ALL, 1024, 1024, e, lds, 1); ctx_gemm(a, (const bf16_t*)(p.ws + W1_OUT), 1024, e, lds); }
    xcd_barrier(xb);
    ln_phase(p, 1, 0, 1, 3, false);
    xcd_barrier(xb);
    ffn_and_ln(p, xb, lds, 1, (const bf16_t*)(p.ws + W1_W13), (const bf16_t*)(p.ws + W1_W2));
  }
  { const bf16_t* d0 = (const bf16_t*)(p.ws + M_D0);
    { EpiD0 e{(bf16_t*)(p.ws + M_D0), (bf16_t*)(p.ws + M_CKV), (bf16_t*)(p.ws + M_KR)}; big_gemm(a, (const bf16_t*)(p.ws + W2_DOWN), T_ALL, 1024, 1024, e, lds, 1); ctx_gemm(a, (const bf16_t*)(p.ws + W2_DOWN), 1024, e, lds); }
    xcd_barrier(xb);
    mla_stats_phase(p);
    xcd_barrier(xb);
    { EpiMlaQ e{(bf16_t*)(p.ws + M_Q), rs, tabM}; big_gemm(d0, (const bf16_t*)(p.ws + W2_UQ), T_ALL, 1536, 512, e, lds, 1); ctx_gemm(d0, (const bf16_t*)(p.ws + W2_UQ), 512, e, lds, 1536); }
    { GemmArgs g{(const bf16_t*)(p.ws + M_CKV), 256, (const bf16_t*)(p.ws + W2_UKV), 256, T_ALL, 1024, 256}; EpiMlaK e{(bf16_t*)(p.ws + M_K), rs}; gemm_phase<false>(g, e, lds); }
    { EpiVTn e{(bf16_t*)(p.ws + M_VT), rs}; big_gemm((const bf16_t*)(p.ws + M_CKV), (const bf16_t*)(p.ws + W2_UKV) + (size_t)1024 * 256, T_ALL, 1024, 256, e, lds, 1); ctx_gemm((const bf16_t*)(p.ws + M_CKV), (const bf16_t*)(p.ws + W2_UKV) + (size_t)1024 * 256, 256, e, lds); }
    xcd_barrier(xb);
    mla_attn_phase(p, lds);
    xcd_barrier(xb);
    { EpiResid e{p.out, hctx, p.out, hctx, mods + (size_t)2 * 5 * 6144 + 2 * 1024, (const float2*)(p.ws + OFF_LNS), p.ln_g + (size_t)(1 * 2 + 1) * 1024, p.ln_b + (size_t)(1 * 2 + 1) * 1024}; big_gemm(a, (const bf16_t*)(p.ws + W2_OUT), T_ALL, 1024, 1024, e, lds, 1); ctx_gemm(a, (const bf16_t*)(p.ws + W2_OUT), 1024, e, lds); }
    xcd_barrier(xb);
    ln_phase(p, 2, 0, 2, 3, false);
    xcd_barrier(xb);
    ffn_and_ln(p, xb, lds, 2, (const bf16_t*)(p.ws + W2_W13), (const bf16_t*)(p.ws + W2_W2));
  }
  { { EpiHg e{(bf16_t*)(p.ws + H_P)}; big_gemm(a, (const bf16_t*)(p.ws + W3_IN), T_ALL, 5120, 1024, e, lds); }
    xcd_barrier(xb);
    scan_phase<128, true, 32>(p, lds);
    xcd_barrier(xb);
    hg_readout_phase(p);
    xcd_barrier(xb);
    { EpiResid e{p.out, hctx, p.out, hctx, mods + (size_t)3 * 5 * 6144 + 2 * 1024, (const float2*)(p.ws + OFF_LNS), p.ln_g + (size_t)(2 * 2 + 1) * 1024, p.ln_b + (size_t)(2 * 2 + 1) * 1024}; big_gemm(a, (const bf16_t*)(p.ws + W3_OUT), T_ALL, 1024, 1024, e, lds, 1); }
    xcd_barrier(xb);
    ln_phase(p, 3, 0, 3, 3, false);
    xcd_barrier(xb);
    ffn_and_ln(p, xb, lds, 3, (const bf16_t*)(p.ws + W3_W13), (const bf16_t*)(p.ws + W3_W2));
  }
}

extern "C" void kernel_launch(void* const* d_in, const int* in_sizes, int n_in, void* d_out, int out_size, void* d_ws, size_t ws_size, hipStream_t stream) {
  static int grid_blocks = 0;
  if (!grid_blocks) {
    int dev = 0, cus = 0, per_cu = 0;
    (void)hipGetDevice(&dev);
    (void)hipDeviceGetAttribute(&cus, hipDeviceAttributeMultiprocessorCount, dev);
    (void)hipOccupancyMaxActiveBlocksPerMultiprocessor(&per_cu, mega, NTHR, 0);
    if (per_cu != 1) per_cu = 1;
    grid_blocks = cus * per_cu;
  }
  if (ws_size < WS_NEED) { fprintf(stderr, "workspace too small: %zu\n", ws_size); return; }
  Params p{};
  const float** f = (const float**)&p;
  for (int i = 0; i < 26; ++i) f[i] = (const float*)d_in[i];
  p.out = (float*)d_out; p.ws = (char*)d_ws;
  (void)hipMemsetAsync((char*)d_ws + OFF_BAR, 0, XCD_BAR_WORDS * 4, stream);
  void* args[] = {&p};
  hipError_t e = hipLaunchCooperativeKernel((void*)mega, dim3(grid_blocks), dim3(NTHR), args, 0, stream);
  if (e != hipSuccess) fprintf(stderr, "cooperative launch failed: %s (grid %d)\n", hipGetErrorString(e), grid_blocks);
}
```

```cpp
#include <hip/hip_runtime.h>
#include <hip/hip_cooperative_groups.h>
#include <cstdio>
#include <cstdint>
namespace cg = cooperative_groups;

#define DI __device__ __forceinline__
DI int tid_() { int t = threadIdx.x; asm volatile("" : "+v"(t)); return t; }
typedef unsigned short bf16_t;
typedef short bf16x8 __attribute__((ext_vector_type(8)));
typedef short s16x4 __attribute__((ext_vector_type(4)));
typedef float f32x4 __attribute__((ext_vector_type(4)));
typedef float f32x16 __attribute__((ext_vector_type(16)));
typedef unsigned u32x4 __attribute__((ext_vector_type(4)));
typedef unsigned u32x2 __attribute__((ext_vector_type(2)));

constexpr int NTHR = 512;
constexpr int T_ALL = 33792, PB = 8448, LC = 256, LL = 8192, DM = 1024, FF = 2816;
constexpr float ALPHA = 1.681792830507429f;
constexpr float LOG2E = 1.4426950408889634f;
constexpr size_t MiB = 1048576;

struct Params {
  const float *x, *c, *ctx, *cctx, *ada_w, *ada_b, *ln_g, *ln_b, *w13, *w2;
  const float *ret_w_in, *ret_decay, *ret_w_out, *na_w_qkv, *na_rpb, *na_w_out;
  const float *mla_w_down, *mla_q_norm, *mla_kv_norm, *mla_w_uq, *mla_w_ukv, *mla_w_out;
  const float *hg_w_in, *hg_lb, *hg_norm_g, *hg_w_out;
  float* out; char* ws;
};

constexpr size_t OFF_MODS = 0;
constexpr size_t OFF_TABR = 512 * 1024;
constexpr size_t OFF_TABM = OFF_TABR + 65536;
constexpr size_t OFF_LBV = OFF_TABM + 8192;
constexpr size_t OFF_RS = OFF_LBV + 4096;
constexpr size_t OFF_BAR = 896 * 1024;
constexpr size_t OFF_HCTX = 1 * MiB;
constexpr size_t OFF_A = 5 * MiB;
constexpr size_t OFF_W0 = 71 * MiB;
constexpr size_t OFF_BIG = 104 * MiB;
constexpr size_t OFF_WR = OFF_BIG;
constexpr size_t OFF_S = 180 * MiB;
constexpr size_t WS_NEED = 512 * MiB;
constexpr size_t OFF_LNS = 510 * MiB;
constexpr size_t W0_RETIN = OFF_W0, W0_RETOUT = W0_RETIN + (size_t)6144 * 1024 * 2, W0_W13 = W0_RETOUT + (size_t)1024 * 2048 * 2, W0_W2 = W0_W13 + (size_t)5632 * 1024 * 2;
constexpr size_t SZ_W13 = (size_t)5632 * 1024 * 2, SZ_W2 = (size_t)1024 * 2816 * 2, SZ_SQ = (size_t)1024 * 1024 * 2;
constexpr size_t W1_QKV = OFF_WR, W1_OUT = W1_QKV + (size_t)3072 * 1024 * 2, W1_W13 = W1_OUT + SZ_SQ, W1_W2 = W1_W13 + SZ_W13;
constexpr size_t W2_DOWN = W1_W2 + SZ_W2, W2_UQ = W2_DOWN + (size_t)1024 * 1024 * 2, W2_UKV = W2_UQ + (size_t)1536 * 512 * 2, W2_OUT = W2_UKV + (size_t)2048 * 256 * 2, W2_W13 = W2_OUT + SZ_SQ, W2_W2 = W2_W13 + SZ_W13;
constexpr size_t W3_IN = W2_W2 + SZ_W2, W3_OUT = W3_IN + (size_t)5120 * 1024 * 2, W3_W13 = W3_OUT + SZ_SQ, W3_W2 = W3_W13 + SZ_W13, W3_END = W3_W2 + SZ_W2;
static_assert(W3_END <= OFF_S, "rest weights overflow");
static_assert(W0_W2 + SZ_W2 <= OFF_BIG, "W0 overflow");
constexpr size_t SZ_T2048 = (size_t)T_ALL * 2048 * 2, SZ_T1024 = (size_t)T_ALL * 1024 * 2;
constexpr size_t R_QK = OFF_BIG, R_V = R_QK + SZ_T2048, R_O = R_V + SZ_T2048;
static_assert(R_O + SZ_T2048 <= WS_NEED, "retention overflow");
constexpr size_t N_Q = OFF_S, N_K = N_Q + SZ_T1024, N_VT = N_K + SZ_T1024;
constexpr size_t M_D0 = OFF_S, M_CKV = M_D0 + (size_t)T_ALL * 512 * 2, M_KR = M_CKV + (size_t)T_ALL * 256 * 2, M_Q = M_D0 + (size_t)T_ALL * 1024 * 2, M_K = M_Q + (size_t)T_ALL * 1536 * 2, M_VT = M_K + (size_t)T_ALL * 1536 * 2;
static_assert(M_VT + SZ_T1024 <= WS_NEED, "mla overflow");
constexpr size_t H_P = OFF_S;
static_assert(H_P + (size_t)T_ALL * 5120 * 2 <= WS_NEED, "hgrn overflow");
constexpr size_t F_U = OFF_S;

typedef float f32x2 __attribute__((ext_vector_type(2)));
typedef __bf16 bf16x2_t __attribute__((ext_vector_type(2)));
DI unsigned pk2(float lo, float hi) { const f32x2 v = {lo, hi}; const bf16x2_t r = __builtin_convertvector(v, bf16x2_t); return __builtin_bit_cast(unsigned, r); }
DI float bflo(unsigned u) { return __uint_as_float(u << 16); }
DI float bfhi(unsigned u) { return __uint_as_float(u & 0xffff0000u); }
DI float bf2f(bf16_t v) { return __uint_as_float(((unsigned)v) << 16); }
DI bf16_t f2bf(float x) { return (bf16_t)(pk2(x, 0.f) & 0xffffu); }
DI float siluf(float x) { return x * __builtin_amdgcn_rcpf(1.f + __expf(-x)); }
DI f32x4 mfma16(bf16x8 a, bf16x8 b, f32x4 c) { return __builtin_amdgcn_mfma_f32_16x16x32_bf16(a, b, c, 0, 0, 0); }
DI f32x16 mfma32(bf16x8 a, bf16x8 b, f32x16 c) { return __builtin_amdgcn_mfma_f32_32x32x16_bf16(a, b, c, 0, 0, 0); }
DI bf16x8 cat44(s16x4 lo, s16x4 hi) { return __builtin_shufflevector(lo, hi, 0, 1, 2, 3, 4, 5, 6, 7); }
DI bf16x8 pack8(float a0, float a1, float a2, float a3, float a4, float a5, float a6, float a7) {
  u32x4 p; p.x = pk2(a0, a1); p.y = pk2(a2, a3); p.z = pk2(a4, a5); p.w = pk2(a6, a7); return __builtin_bit_cast(bf16x8, p);
}
DI int clampi(int v, int lo, int hi) { return v < lo ? lo : (v > hi ? hi : v); }
DI float* hrow(float* hlat, float* hctx, int t) { const int b = t / PB, p = t - b * PB; return p < LC ? hctx + (size_t)(b * LC + p) * DM : hlat + (size_t)(b * LL + p - LC) * DM; }
DI const float* hrowc(const float* hlat, const float* hctx, int t) { const int b = t / PB, p = t - b * PB; return p < LC ? hctx + (size_t)(b * LC + p) * DM : hlat + (size_t)(b * LL + p - LC) * DM; }
DI int modvec(int t) { const int b = t / PB, p = t - b * PB; return p < LC ? 4 : b; }

template <int MODE> DI int srccol(int n) {
  if (MODE == 0) return n;
  if (MODE == 1) { const int c = n >> 5, s = (n >> 4) & 1, i = n & 15; return s * FF + 16 * c + i; }
  if (MODE == 2) { if (n >= 2048) return n; const int w = n & 255, j = w >> 1, s = w & 1; return (n & ~255) + s * 128 + j; }
  if (MODE == 3) { const int h = n / 96, w = n - h * 96; if (w < 64) return n; const int wp = w - 64, j = wp >> 1, s = wp & 1; return h * 96 + 64 + s * 16 + j; }
  if (MODE == 4) { if (n < 1024) return (n >> 6) * 128 + (n & 63); const int m = n - 1024; return (m >> 6) * 128 + 64 + (m & 63); }
  if (MODE == 5) return n < 800 ? n : -1;
  return n;
}
template <int MODE> DI f32x4 cvt_load4(const float* __restrict__ row, int n) {
  if (MODE == 2 && n < 2048) { const int w = n & 255, j = w >> 1; const float* b = row + (n & ~255) + j; const f32x2 lo = *(const f32x2*)b, hi = *(const f32x2*)(b + 128); return (f32x4){lo[0], hi[0], lo[1], hi[1]}; }
  if (MODE == 3) { return (f32x4){row[srccol<3>(n)], row[srccol<3>(n + 1)], row[srccol<3>(n + 2)], row[srccol<3>(n + 3)]}; }
  const int sc = srccol<MODE>(n); if (sc < 0) return (f32x4){0.f, 0.f, 0.f, 0.f};
  return *(const f32x4*)(row + sc);
}
template <int MODE>
DI void convert_w(const float* __restrict__ src, int Nsrc, int K, bf16_t* __restrict__ dst, int Ndst, const float* __restrict__ kscale, float* ldsf) {
  const int tid = threadIdx.x, tn = Ndst / 64, tk = K / 64;
  for (int tile = blockIdx.x; tile < tn * tk; tile += gridDim.x) {
    const int n0 = (tile % tn) * 64, k0 = (tile / tn) * 64;
    __syncthreads();
#pragma unroll
    for (int i = 0; i < 2; ++i) { const int kk = (tid >> 4) + 32 * i, nn = (tid & 15) * 4;
      f32x4 v = cvt_load4<MODE>(src + (size_t)(k0 + kk) * Nsrc, n0 + nn);
      if (kscale) v = v * kscale[k0 + kk];
      float* lp = ldsf + kk * 65 + nn; lp[0] = v[0]; lp[1] = v[1]; lp[2] = v[2]; lp[3] = v[3]; }
    __syncthreads();
    { const int nn = tid >> 3, kc = tid & 7; const float* lp = ldsf + (kc * 8) * 65 + nn;
      u32x4 o; o.x = pk2(lp[0], lp[65]); o.y = pk2(lp[130], lp[195]); o.z = pk2(lp[260], lp[325]); o.w = pk2(lp[390], lp[455]);
      *(u32x4*)(dst + (size_t)(n0 + nn) * K + k0 + kc * 8) = o; }
  }
}

DI void ada_phase(const Params& p, float* ldsf) {
  const int tid = threadIdx.x, lane = tid & 63, w = tid >> 6;
  float* mods = (float*)(p.ws + OFF_MODS);
  __syncthreads();
  for (int e = tid; e < 5120; e += NTHR) { const int mv = e >> 10, k = e & 1023; const float cv = mv < 4 ? p.c[mv * 1024 + k] : p.cctx[k]; ldsf[e] = siluf(cv); }
  __syncthreads();
  float* red = ldsf + 5120;
  for (int item = blockIdx.x; item < 4 * 96; item += gridDim.x) {
    const int i = item / 96, n0 = (item % 96) * 64;
    const float* wp = p.ada_w + (size_t)i * 1024 * 6144 + n0 + lane;
    float a0 = 0.f, a1 = 0.f, a2 = 0.f, a3 = 0.f, a4 = 0.f;
#pragma unroll 8
    for (int kk = 0; kk < 128; ++kk) { const int k = w * 128 + kk; const float wv = wp[(size_t)k * 6144];
      a0 += ldsf[k] * wv; a1 += ldsf[1024 + k] * wv; a2 += ldsf[2048 + k] * wv; a3 += ldsf[3072 + k] * wv; a4 += ldsf[4096 + k] * wv; }
    red[(w * 5 + 0) * 64 + lane] = a0; red[(w * 5 + 1) * 64 + lane] = a1; red[(w * 5 + 2) * 64 + lane] = a2; red[(w * 5 + 3) * 64 + lane] = a3; red[(w * 5 + 4) * 64 + lane] = a4;
    __syncthreads();
    if (tid < 320) { const int mv = tid >> 6; float s = 0.f;
#pragma unroll
      for (int ww = 0; ww < 8; ++ww) s += red[(ww * 5 + mv) * 64 + lane];
      mods[(size_t)(i * 5 + mv) * 6144 + n0 + lane] = s + p.ada_b[i * 6144 + n0 + lane]; }
    __syncthreads();
  }
}
DI void tables_phase(const Params& p) {
  const int gt = blockIdx.x * NTHR + threadIdx.x, gn = gridDim.x * NTHR;
  float2* tabR = (float2*)(p.ws + OFF_TABR); float2* tabM = (float2*)(p.ws + OFF_TABM); float* lbv = (float*)(p.ws + OFF_LBV);
  for (int e = gt; e < 128 * 64; e += gn) { const int v = e >> 6, i = e & 63; const float inv = powf(10000.f, -(float)i / 64.f); const float ang = (float)v * inv; tabR[e] = make_float2(cosf(ang), sinf(ang)); }
  for (int e = gt; e < 128 * 8; e += gn) { const int v = e >> 3, i = e & 7; const float inv = powf(10000.f, -(float)i / 8.f); const float ang = (float)v * inv; tabM[e] = make_float2(cosf(ang), sinf(ang)); }
  for (int e = gt; e < 1024; e += gn) { const float l0 = p.hg_lb[e], l1 = p.hg_lb[1024 + e], l2 = p.hg_lb[2048 + e], l3 = p.hg_lb[3072 + e];
    const float mx = fmaxf(fmaxf(l0, l1), fmaxf(l2, l3)); const float e0 = expf(l0 - mx), e1 = expf(l1 - mx), e2 = expf(l2 - mx), e3 = expf(l3 - mx);
    lbv[e] = (e1 + e2 + e3) / (e0 + e1 + e2 + e3); }
}

DI void modulate_phase(const Params& p, const float* slat, const float* sctx, int layer) {
  const float* mods = (const float*)(p.ws + OFF_MODS); bf16_t* a = (bf16_t*)(p.ws + OFF_A);
  const int gt = blockIdx.x * NTHR + threadIdx.x, gn = gridDim.x * NTHR;
  for (int e = gt; e < T_ALL * 128; e += gn) {
    const int t = e >> 7, c0 = (e & 127) * 8; const float* s = hrowc(slat, sctx, t) + c0; const float* m = mods + (size_t)(layer * 5 + modvec(t)) * 6144;
    const f32x4 x0 = *(const f32x4*)s, x1 = *(const f32x4*)(s + 4), sh0 = *(const f32x4*)(m + c0), sh1 = *(const f32x4*)(m + c0 + 4), sc0 = *(const f32x4*)(m + 1024 + c0), sc1 = *(const f32x4*)(m + 1024 + c0 + 4);
    const f32x4 y0 = x0 * (1.f + sc0) + sh0, y1 = x1 * (1.f + sc1) + sh1;
    u32x4 o; o.x = pk2(y0[0], y0[1]); o.y = pk2(y0[2], y0[3]); o.z = pk2(y1[0], y1[1]); o.w = pk2(y1[2], y1[3]);
    *(u32x4*)(a + (size_t)t * 1024 + c0) = o;
  }
}
DI void ln_phase(const Params& p, int lnlayer, int lnidx, int ml, int js, bool final_out) {
  const float* mods = (const float*)(p.ws + OFF_MODS); bf16_t* a = (bf16_t*)(p.ws + OFF_A); float* hctx = (float*)(p.ws + OFF_HCTX); float2* lns = (float2*)(p.ws + OFF_LNS);
  const int tid = threadIdx.x, lane = tid & 63, gw = blockIdx.x * 8 + (tid >> 6), nw = gridDim.x * 8;
  const float* gp = p.ln_g + (size_t)(lnlayer * 2 + lnidx) * 1024; const float* bp = p.ln_b + (size_t)(lnlayer * 2 + lnidx) * 1024;
  for (int t = gw; t < T_ALL; t += nw) {
    float* hr = hrow(p.out, hctx, t);
    f32x4 v[4]; float s = 0.f;
#pragma unroll
    for (int i = 0; i < 4; ++i) { v[i] = *(const f32x4*)(hr + i * 256 + lane * 4); s += (v[i][0] + v[i][1]) + (v[i][2] + v[i][3]); }
#pragma unroll
    for (int o = 1; o < 64; o <<= 1) s += __shfl_xor(s, o);
    const float mean = s * (1.f / 1024.f); float q = 0.f;
#pragma unroll
    for (int i = 0; i < 4; ++i) { v[i] = v[i] - mean; q += (v[i][0] * v[i][0] + v[i][1] * v[i][1]) + (v[i][2] * v[i][2] + v[i][3] * v[i][3]); }
#pragma unroll
    for (int o = 1; o < 64; o <<= 1) q += __shfl_xor(q, o);
    const float rstd = rsqrtf(q * (1.f / 1024.f) + 1e-5f);
    if (!final_out && lane == 0) lns[t] = make_float2(mean, rstd);
    const float* m = mods + (size_t)(ml * 5 + modvec(t)) * 6144 + (size_t)js * 1024;
#pragma unroll
    for (int i = 0; i < 4; ++i) { const int c0 = i * 256 + lane * 4;
      const f32x4 y = v[i] * rstd * *(const f32x4*)(gp + c0) + *(const f32x4*)(bp + c0);
      if (final_out) *(f32x4*)(hr + c0) = y;
      else { const f32x4 z = y * (1.f + *(const f32x4*)(m + 1024 + c0)) + *(const f32x4*)(m + c0); u32x2 o; o.x = pk2(z[0], z[1]); o.y = pk2(z[2], z[3]); *(u32x2*)(a + (size_t)t * 1024 + c0) = o; } }
  }
}

namespace pg8 {
#define PG8_LAS __attribute__((address_space(3)))
typedef unsigned short bf16_t;
typedef short bf16x8 __attribute__((ext_vector_type(8)));
typedef float f32x4 __attribute__((ext_vector_type(4)));
typedef unsigned u32x4 __attribute__((ext_vector_type(4)));
constexpr int BM = 256, BK = 64, HALF = 128, HTB = HALF * BK * 2  , STAGE_BYTES = 8 * HTB, NXCD = 8, WGM = 8;

__host__ __device__ __forceinline__ int lds_byte(int r, int c) { const int st = (r >> 4) * 2 + (c >> 5), rr = r & 15, cc = c & 31, ob = rr * 64 + cc * 2; return st * 1024 + (ob ^ (((ob >> 9) & 1) << 5)); }
__host__ __device__ __forceinline__ void stage_rc(int b, int& R, int& C) { const int st = b / 1024, sb = b % 1024, swz = sb ^ (((sb >> 9) & 1) << 5); R = (st >> 1) * 16 + swz / 64; C = (st & 1) * 32 + (swz % 64) / 2; }
__host__ __device__ __forceinline__ int perm32(int rho) { const int n = rho >> 4, i = rho & 15; return 8 * (i >> 2) + 4 * n + (i & 3); }

struct Unit { int pm, pn; };
struct Gemm { const bf16_t* A; const bf16_t* Bt; int M, N, K; };

struct StaticOrder {
    int nM, nN, nwg, G, c, lat;
    __host__ __device__ void init(int M, int N, int G_, int c_, int lat_ = 0) { lat = lat_; nM = lat ? 128 : M / BM; nN = N / BM; nwg = nM * nN; G = G_; c = c_; }
    __host__ __device__ bool next(int i, Unit& u) const {
        const long L = (long)i * G + c; if (L >= nwg) return false;
        int wgid = (int)L; { const int q = nwg / NXCD, r = nwg % NXCD, xcd = wgid % NXCD, off = wgid / NXCD; wgid = (xcd < r ? xcd * (q + 1) : r * (q + 1) + (xcd - r) * q) + off; }
        const int nig = WGM * nN, gid = wgid / nig, fm = gid * WGM, gsz = (nM - fm) < WGM ? (nM - fm) : WGM;
        u.pm = fm + ((wgid % nig) % gsz); u.pn = (wgid % nig) / gsz; if (lat) u.pm += (u.pm >> 5) + 1; return true;
    }
    __device__ __forceinline__ void a_ready(const Unit&) const {}
    __device__ __forceinline__ void done(const Unit&) const {}
};
template <class Epi, class Sched, bool ALIGN_EPI = false, bool SP2 = false>
__device__ __forceinline__ void gemm_phase(PG8_LAS unsigned char* lds, const Gemm g, const Sched& S, const Epi& E) {
    const int tid = tid_(), wid = __builtin_amdgcn_readfirstlane(tid >> 6), lane = tid & 63, wr = wid >> 2, wc = wid & 3, fr = lane & 15, fq = lane >> 4;
    const int K = g.K, nt = K / BK;
    unsigned voffA[2], voffB[2];
#pragma unroll
    for (int i = 0; i < 2; ++i) { int R, C; stage_rc(tid * 16 + i * 8192, R, C); const int Rb = Epi::PERM ? ((R & ~31) + perm32(R & 31)) : R;
        voffA[i] = (unsigned)(R * K + C) * 2u; voffB[i] = (unsigned)(Rb * K + C) * 2u; }
    const size_t kstep = (size_t)(BK * 2);
    const size_t hstep = (size_t)HALF * K * 2;
    const size_t tstep = 2 * hstep;
    const unsigned ldsw = (unsigned)wid * 1024u;
    const int aoff = lds_byte(wr * 64 + fr, fq * 8), boff = lds_byte(wc * 32 + fr, fq * 8);
#define PG8_SA(b, h) (((b) * 2 + (h)) * HTB)
#define PG8_SB(b, h) ((4 + (b) * 2 + (h)) * HTB)
#define PG8_STAGE(bufoff, gbase, voff) do { _Pragma("unroll") for (int _i = 0; _i < 2; ++_i) \
        __builtin_amdgcn_global_load_lds((const unsigned*)((const char*)(gbase) + (voff)[_i]), (PG8_LAS unsigned*)(lds + (bufoff) + ldsw + _i * 8192), 16, 0, 0); } while (0)
#define PG8_LDA(dst, b, h) do { _Pragma("unroll") for (int m = 0; m < 4; ++m) _Pragma("unroll") for (int k = 0; k < 2; ++k) dst[m][k] = *(const PG8_LAS bf16x8*)(lds + PG8_SA(b, h) + aoff + m * 2048 + k * 1024); } while (0)
#define PG8_LDB(dst, b, h) do { _Pragma("unroll") for (int n = 0; n < 2; ++n) _Pragma("unroll") for (int k = 0; k < 2; ++k) dst[n][k] = *(const PG8_LAS bf16x8*)(lds + PG8_SB(b, h) + boff + n * 2048 + k * 1024); } while (0)
#define PG8_MMA(ai, bj, At, Bt) do { __builtin_amdgcn_s_setprio(1); _Pragma("unroll") for (int m = 0; m < 4; ++m) _Pragma("unroll") for (int n = 0; n < 2; ++n) _Pragma("unroll") for (int k = 0; k < 2; ++k) \
        acc[ai][bj][m][n] = __builtin_amdgcn_mfma_f32_16x16x32_bf16(Bt[n][k], At[m][k], acc[ai][bj][m][n], 0, 0, 0); __builtin_amdgcn_s_setprio(0); } while (0)
#define PG8_WAIT_V(n) asm volatile("s_waitcnt vmcnt(" #n ")" ::: "memory")
#define PG8_WAIT_L(n) asm volatile("s_waitcnt lgkmcnt(" #n ")" ::: "memory")
#define PG8_BAR __builtin_amdgcn_s_barrier()
#define PG8_SCHED __builtin_amdgcn_sched_barrier(0)
    Unit cur, nxt; int ui = 0;
    if (!S.next(0, cur)) return;
    f32x4 acc[2][2][4][2];
#pragma unroll
    for (int a = 0; a < 2; ++a)
#pragma unroll
        for (int b = 0; b < 2; ++b)
#pragma unroll
            for (int m = 0; m < 4; ++m)
#pragma unroll
                for (int n = 0; n < 2; ++n) acc[a][b][m][n] = (f32x4){0.f, 0.f, 0.f, 0.f};
    bf16x8 At[4][2], B0[2][2], B1[2][2];
    const char* cA = (const char*)g.A + (size_t)cur.pm * tstep; const char* cB = (const char*)g.Bt + (size_t)cur.pn * tstep;
    S.a_ready(cur);
    if constexpr (SP2) {
        PG8_STAGE(PG8_SB(0, 0), cB, voffB); PG8_STAGE(PG8_SB(0, 1), cB + hstep, voffB); PG8_STAGE(PG8_SA(0, 0), cA, voffA); PG8_STAGE(PG8_SA(0, 1), cA + hstep, voffA);
        if (wr == 1) PG8_BAR;
        PG8_WAIT_V(2); PG8_BAR;
        PG8_STAGE(PG8_SB(1, 0), cB + kstep, voffB); PG8_STAGE(PG8_SA(1, 0), cA + kstep, voffA); PG8_STAGE(PG8_SB(1, 1), cB + hstep + kstep, voffB);
        PG8_WAIT_V(6); PG8_BAR;
    } else {
        PG8_STAGE(PG8_SB(0, 0), cB, voffB); PG8_STAGE(PG8_SA(0, 0), cA, voffA); PG8_STAGE(PG8_SB(0, 1), cB + hstep, voffB); PG8_STAGE(PG8_SA(0, 1), cA + hstep, voffA);
        if (wr == 1) PG8_BAR;
        PG8_WAIT_V(4); PG8_BAR;
        PG8_STAGE(PG8_SB(1, 0), cB + kstep, voffB); PG8_STAGE(PG8_SA(1, 0), cA + kstep, voffA); PG8_STAGE(PG8_SB(1, 1), cB + hstep + kstep, voffB);
        PG8_WAIT_V(6); PG8_BAR;
    }
    for (;;) {
        const bool has_next = S.next(ui + 1, nxt);
        const char* nA = has_next ? (const char*)g.A + (size_t)nxt.pm * tstep : cA; const char* nB = has_next ? (const char*)g.Bt + (size_t)nxt.pn * tstep : cB;
        for (int t = 0; t < nt; t += 2) {
            const bool last = (t == nt - 2);
            const char* a1 = cA + (size_t)(t + 1) * kstep;
            const char* a2 = last ? nA : cA + (size_t)(t + 2) * kstep; const char* b2 = last ? nB : cB + (size_t)(t + 2) * kstep;
            const char* a3 = a2 + kstep; const char* b3 = b2 + kstep;
            if (last && has_next) S.a_ready(nxt);
            if constexpr (SP2) {
            PG8_LDB(B0, 0, 0); PG8_LDB(B1, 0, 1); PG8_SCHED; PG8_LDA(At, 0, 0); PG8_STAGE(PG8_SA(1, 1), a1 + hstep, voffA);
            PG8_WAIT_V(8); PG8_WAIT_L(0); PG8_BAR; PG8_MMA(0, 0, At, B0); PG8_MMA(0, 1, At, B1); PG8_BAR; PG8_SCHED;
            PG8_LDA(At, 0, 1); PG8_STAGE(PG8_SB(0, 0), b2, voffB); PG8_STAGE(PG8_SB(0, 1), b2 + hstep, voffB); PG8_STAGE(PG8_SA(0, 0), a2, voffA);
            PG8_WAIT_V(8); PG8_WAIT_L(0); PG8_BAR; PG8_MMA(1, 0, At, B0); PG8_MMA(1, 1, At, B1); PG8_BAR; PG8_SCHED;
            PG8_LDB(B0, 1, 0); PG8_LDB(B1, 1, 1); PG8_SCHED; PG8_LDA(At, 1, 0); PG8_STAGE(PG8_SA(0, 1), a2 + hstep, voffA);
            PG8_WAIT_V(8); PG8_WAIT_L(0); PG8_BAR; PG8_MMA(0, 0, At, B0); PG8_MMA(0, 1, At, B1); PG8_BAR; PG8_SCHED;
            PG8_LDA(At, 1, 1); PG8_STAGE(PG8_SB(1, 0), b3, voffB); PG8_STAGE(PG8_SB(1, 1), b3 + hstep, voffB); PG8_STAGE(PG8_SA(1, 0), a3, voffA);
            PG8_WAIT_V(8); PG8_WAIT_L(0); PG8_BAR; PG8_MMA(1, 0, At, B0); PG8_MMA(1, 1, At, B1); PG8_BAR; PG8_SCHED;
            } else {
            PG8_LDB(B0, 0, 0); PG8_SCHED; PG8_LDA(At, 0, 0); PG8_STAGE(PG8_SA(1, 1), a1 + hstep, voffA);
            PG8_WAIT_L(8); PG8_BAR; PG8_WAIT_L(0); PG8_MMA(0, 0, At, B0); PG8_BAR; PG8_SCHED;
            PG8_LDB(B1, 0, 1); PG8_STAGE(PG8_SB(0, 0), b2, voffB);
            PG8_BAR; PG8_WAIT_L(0); PG8_MMA(0, 1, At, B1); PG8_BAR;
            PG8_LDA(At, 0, 1); PG8_STAGE(PG8_SA(0, 0), a2, voffA);
            PG8_BAR; PG8_WAIT_L(0); PG8_MMA(1, 0, At, B0); PG8_BAR; PG8_SCHED;
            PG8_STAGE(PG8_SB(0, 1), b2 + hstep, voffB);
            PG8_WAIT_V(6); PG8_BAR; PG8_MMA(1, 1, At, B1); PG8_BAR;
            PG8_LDB(B0, 1, 0); PG8_SCHED; PG8_LDA(At, 1, 0); PG8_STAGE(PG8_SA(0, 1), a2 + hstep, voffA);
            PG8_WAIT_L(8); PG8_BAR; PG8_WAIT_L(0); PG8_MMA(0, 0, At, B0); PG8_BAR; PG8_SCHED;
            PG8_LDB(B1, 1, 1); PG8_STAGE(PG8_SB(1, 0), b3, voffB);
            PG8_BAR; PG8_WAIT_L(0); PG8_MMA(0, 1, At, B1); PG8_BAR;
            PG8_LDA(At, 1, 1); PG8_STAGE(PG8_SA(1, 0), a3, voffA);
            PG8_BAR; PG8_WAIT_L(0); PG8_MMA(1, 0, At, B0); PG8_BAR; PG8_SCHED;
            PG8_STAGE(PG8_SB(1, 1), b3 + hstep, voffB);
            PG8_WAIT_V(6); PG8_BAR; PG8_MMA(1, 1, At, B1); PG8_BAR;
            }
        }
        if constexpr (ALIGN_EPI) { if (wr == 0) PG8_BAR; }
        if constexpr (!Epi::AFTER_DRAIN) { E(acc, cur, wr, wc, fr, fq); S.done(cur); }
        if (!has_next) break;
#pragma unroll
        for (int a = 0; a < 2; ++a)
#pragma unroll
            for (int b = 0; b < 2; ++b)
#pragma unroll
                for (int m = 0; m < 4; ++m)
#pragma unroll
                    for (int n = 0; n < 2; ++n) acc[a][b][m][n] = (f32x4){0.f, 0.f, 0.f, 0.f};
        cur = nxt; cA = nA; cB = nB; ++ui;
        if constexpr (ALIGN_EPI) { if (wr == 1) PG8_BAR; }
    }
    PG8_WAIT_V(0);
    if constexpr (!ALIGN_EPI) { if (wr == 0) PG8_BAR; }
    PG8_BAR;
    if constexpr (Epi::AFTER_DRAIN) { E.fused(acc, cur, wr, wc, fr, fq, lds, wid, lane); S.done(cur); }
#undef PG8_SA
#undef PG8_SB
#undef PG8_STAGE
#undef PG8_LDA
#undef PG8_LDB
#undef PG8_MMA
#undef PG8_WAIT_V
#undef PG8_WAIT_L
#undef PG8_BAR
#undef PG8_SCHED
}
}

template <class T> struct EpiPreload { static constexpr bool value = false; };
template <class E4> struct EpiWrap { static constexpr bool PERM = false, AFTER_DRAIN = false; E4 e;
  DI void operator()(const f32x4 (&acc)[2][2][4][2], const pg8::Unit& u, int wr, int wc, int fr, int fq) const {
    if constexpr (EpiPreload<E4>::value) {
      const int row0 = u.pm * 256 + wr * 64 + fr, col0 = u.pn * 256 + wc * 32 + 4 * fq;
      f32x4 cur[4], nxt[4];
#pragma unroll
      for (int j = 0; j < 4; ++j) cur[j] = e.ld(row0, col0 + (j >> 1) * 128 + (j & 1) * 16);
#pragma unroll
      for (int g = 0; g < 8; ++g) { const int row = row0 + (g >> 2) * 128 + (g & 3) * 16;
        if (g + 1 < 8) { const int rn = row0 + ((g + 1) >> 2) * 128 + ((g + 1) & 3) * 16;
#pragma unroll
          for (int j = 0; j < 4; ++j) nxt[j] = e.ld(rn, col0 + (j >> 1) * 128 + (j & 1) * 16); }
#pragma unroll
        for (int j = 0; j < 4; ++j) e.apply(row, col0 + (j >> 1) * 128 + (j & 1) * 16, acc[g >> 2][j >> 1][g & 3][j & 1], cur[j]);
#pragma unroll
        for (int j = 0; j < 4; ++j) cur[j] = nxt[j];
        asm volatile("" ::: "memory"); }
    } else {
#pragma unroll
    for (int ai = 0; ai < 2; ++ai)
#pragma unroll
      for (int m = 0; m < 4; ++m) { const int row = u.pm * 256 + ai * 128 + wr * 64 + m * 16 + fr;
#pragma unroll
        for (int bj = 0; bj < 2; ++bj) { const int col = u.pn * 256 + bj * 128 + wc * 32 + 4 * fq;
          if constexpr (E4::PAIR) e.pair(row, ((col - 4 * fq) >> 1) + 4 * fq, acc[ai][bj][m][0], acc[ai][bj][m][1]);
          else { e(row, col, acc[ai][bj][m][0]); e(row, col + 16, acc[ai][bj][m][1]); } }
        asm volatile("" ::: "memory"); }
    }
  } };
template <class E4>
DI void big_gemm(const bf16_t* A, const bf16_t* W, int M, int N, int K, const E4& e4, char* lds, int lat_only = 0) {
  __syncthreads();
  pg8::Gemm g{A, W, M, N, K}; pg8::StaticOrder S; S.init(M, N, (int)gridDim.x, (int)blockIdx.x, lat_only); EpiWrap<E4> E{e4};
  pg8::gemm_phase<EpiWrap<E4>, pg8::StaticOrder, true, true>((PG8_LAS unsigned char*)lds, g, S, E);
  __syncthreads();
}
struct GemmArgs { const bf16_t* A; int lda; const bf16_t* W; int ldw; int M, N, K; };
constexpr int LDT = 72;
template <bool TRANS, class Epi>
DI void gemm_phase(const GemmArgs g, const Epi epi, char* lds) {
  const int tid = threadIdx.x, lane = tid & 63, w = tid >> 6, wm = w & 3, wn = w >> 2, g4 = lane >> 4, l16 = lane & 15;
  const int nN = g.N / 128, ntiles = (g.M / 256) * nN, nk = g.K / 64;
  bf16_t* As = (bf16_t*)lds; bf16_t* Bs = As + 256 * LDT;
  for (int tile = blockIdx.x; tile < ntiles; tile += gridDim.x) {
    const int pm = tile / nN, pn = tile - pm * nN;
    const bf16_t* Ag = g.A + (size_t)(pm * 256) * g.lda; const bf16_t* Wg = g.W + (size_t)(pn * 128) * g.ldw;
    f32x4 acc[4][4];
#pragma unroll
    for (int i = 0; i < 4; ++i)
#pragma unroll
      for (int j = 0; j < 4; ++j) acc[i][j] = (f32x4){0.f, 0.f, 0.f, 0.f};
    u32x4 ra[4], rb[2];
#pragma unroll
    for (int i = 0; i < 4; ++i) { const int c = tid + NTHR * i; ra[i] = *(const u32x4*)(Ag + (size_t)(c >> 3) * g.lda + (c & 7) * 8); }
#pragma unroll
    for (int i = 0; i < 2; ++i) { const int c = tid + NTHR * i; rb[i] = *(const u32x4*)(Wg + (size_t)(c >> 3) * g.ldw + (c & 7) * 8); }
    for (int kt = 0; kt < nk; ++kt) {
      __syncthreads();
#pragma unroll
      for (int i = 0; i < 4; ++i) { const int c = tid + NTHR * i; *(u32x4*)(As + (c >> 3) * LDT + (c & 7) * 8) = ra[i]; }
#pragma unroll
      for (int i = 0; i < 2; ++i) { const int c = tid + NTHR * i; *(u32x4*)(Bs + (c >> 3) * LDT + (c & 7) * 8) = rb[i]; }
      __syncthreads();
      if (kt + 1 < nk) { const int k0 = (kt + 1) * 64;
#pragma unroll
        for (int i = 0; i < 4; ++i) { const int c = tid + NTHR * i; ra[i] = *(const u32x4*)(Ag + (size_t)(c >> 3) * g.lda + k0 + (c & 7) * 8); }
#pragma unroll
        for (int i = 0; i < 2; ++i) { const int c = tid + NTHR * i; rb[i] = *(const u32x4*)(Wg + (size_t)(c >> 3) * g.ldw + k0 + (c & 7) * 8); } }
#pragma unroll
      for (int ks = 0; ks < 2; ++ks) {
        bf16x8 af[4], wf[4];
#pragma unroll
        for (int i = 0; i < 4; ++i) af[i] = *(const bf16x8*)(As + (wm * 64 + i * 16 + l16) * LDT + ks * 32 + g4 * 8);
#pragma unroll
        for (int j = 0; j < 4; ++j) wf[j] = *(const bf16x8*)(Bs + (wn * 64 + j * 16 + l16) * LDT + ks * 32 + g4 * 8);
#pragma unroll
        for (int i = 0; i < 4; ++i)
#pragma unroll
          for (int j = 0; j < 4; ++j) acc[i][j] = TRANS ? mfma16(af[i], wf[j], acc[i][j]) : mfma16(wf[j], af[i], acc[i][j]);
      }
    }
    const int mb = pm * 256 + wm * 64, nb = pn * 128 + wn * 64;
    if constexpr (Epi::PAIR) {
#pragma unroll
      for (int i = 0; i < 4; ++i)
#pragma unroll
        for (int j = 0; j < 2; ++j) epi.pair(mb + i * 16 + l16, (nb >> 1) + 16 * j + 4 * g4, acc[i][2 * j], acc[i][2 * j + 1]);
    } else {
#pragma unroll
      for (int i = 0; i < 4; ++i)
#pragma unroll
        for (int j = 0; j < 4; ++j) { if (TRANS) epi(mb + i * 16 + 4 * g4, nb + j * 16 + l16, acc[i][j]); else epi(mb + i * 16 + l16, nb + j * 16 + 4 * g4, acc[i][j]); }
    }
  }
}
DI void st4bf(bf16_t* p, f32x4 v) { u32x2 o; o.x = pk2(v[0], v[1]); o.y = pk2(v[2], v[3]); *(u32x2*)p = o; }
struct EpiStore { static constexpr bool PAIR = false; bf16_t* d0; bf16_t* d1; int split, ld0, ld1; float s0;
  DI void operator()(int m, int n, f32x4 v) const { if (n < split) st4bf(d0 + (size_t)m * ld0 + n, v * s0); else st4bf(d1 + (size_t)m * ld1 + (n - split), v); } };
struct EpiVT { static constexpr bool PAIR = false; bf16_t* vt; const float* rs;
  DI void operator()(int m, int n, f32x4 v) const { const int b = m / PB, pos = m - b * PB;
    if (rs) { v[0] *= rs[2 * m + 1]; v[1] *= rs[2 * m + 3]; v[2] *= rs[2 * m + 5]; v[3] *= rs[2 * m + 7]; }
    st4bf(vt + ((size_t)(b * 1024 + n)) * PB + pos, v); } };
struct EpiVTn { static constexpr bool PAIR = false; bf16_t* vt; const float* rs;
  DI void operator()(int m, int n, f32x4 v) const { const int b = m / PB, pos = m - b * PB; if (rs) v = v * rs[2 * m + 1];
    bf16_t* q = vt + (size_t)(b * 1024 + n) * PB + pos; q[0] = f2bf(v[0]); q[PB] = f2bf(v[1]); q[2 * (size_t)PB] = f2bf(v[2]); q[3 * (size_t)PB] = f2bf(v[3]); } };
struct EpiD0 { static constexpr bool PAIR = false; bf16_t* cq; bf16_t* ckv; bf16_t* kr;
  DI void operator()(int m, int n, f32x4 v) const { if (n < 512) st4bf(cq + (size_t)m * 512 + n, v); else if (n < 768) st4bf(ckv + (size_t)m * 256 + (n - 512), v); else if (n < 800) st4bf(kr + (size_t)m * 32 + (n - 768), v); } };
struct EpiResid { static constexpr bool PAIR = false; const float* slat; const float* sctx; float* dlat; float* dctx; const float* gate;
  const float2* lns; const float* lg; const float* lb;
  DI f32x4 ld(int m, int n) const { return *(const f32x4*)(hrowc(slat, sctx, m) + n); }
  DI void apply(int m, int n, f32x4 v, f32x4 hv) const { const int mv = modvec(m); const f32x4 gt = *(const f32x4*)(gate + (size_t)mv * 6144 + n);
    if (lns) { const float2 st = lns[m]; hv = (hv - st.x) * st.y * *(const f32x4*)(lg + n) + *(const f32x4*)(lb + n); }
    *(f32x4*)(hrow(dlat, dctx, m) + n) = ALPHA * hv + gt * v; }
  DI void operator()(int m, int n, f32x4 v) const { apply(m, n, v, ld(m, n)); } };
template <> struct EpiPreload<EpiResid> { static constexpr bool value = true; };
constexpr int CLD = 264;
template <class Epi>
DI void ctx_gemm(const bf16_t* __restrict__ A, const bf16_t* __restrict__ W, int K, const Epi& epi, char* lds, int N = 1024) {
  const int tid = threadIdx.x, lane = tid & 63, w = tid >> 6, g4 = lane >> 4, l16 = lane & 15, wm = w & 3, wn = w >> 2;
  bf16_t* As = (bf16_t*)lds; bf16_t* Ws = As + 64 * CLD;
  const int nk = K / 256, per = N / 64;
  for (int tile = blockIdx.x; tile < 16 * per; tile += gridDim.x) {
    const int nt = tile % per, rem = tile / per, mt = rem & 3, b = rem >> 2;
    const size_t row0 = (size_t)b * PB + mt * 64;
    const bf16_t* Ag = A + row0 * K; const bf16_t* Wg = W + (size_t)(nt * 64) * K;
    u32x4 ra[4], rw[4], ra2[4], rw2[4];
    auto gl = [&](int kt, u32x4 (&xa)[4], u32x4 (&xw)[4]) { const int k0 = kt * 256;
#pragma unroll
      for (int i = 0; i < 4; ++i) { const int c = tid + NTHR * i, r = c >> 5, kc = c & 31; xa[i] = *(const u32x4*)(Ag + (size_t)r * K + k0 + kc * 8); xw[i] = *(const u32x4*)(Wg + (size_t)r * K + k0 + kc * 8); } };
    f32x4 acc[2] = {(f32x4){0.f, 0.f, 0.f, 0.f}, (f32x4){0.f, 0.f, 0.f, 0.f}};
    auto stepk = [&](int kt, u32x4 (&xa)[4], u32x4 (&xw)[4]) {
      __syncthreads();
#pragma unroll
      for (int i = 0; i < 4; ++i) { const int c = tid + NTHR * i, r = c >> 5, kc = c & 31; *(u32x4*)(As + r * CLD + kc * 8) = xa[i]; *(u32x4*)(Ws + r * CLD + kc * 8) = xw[i]; }
      __syncthreads();
      if (kt + 2 < nk) gl(kt + 2, xa, xw);
#pragma unroll
      for (int ks = 0; ks < 8; ++ks) {
        const bf16x8 af = *(const bf16x8*)(As + (wm * 16 + l16) * CLD + ks * 32 + g4 * 8);
        const bf16x8 w0 = *(const bf16x8*)(Ws + (wn * 32 + l16) * CLD + ks * 32 + g4 * 8), w1 = *(const bf16x8*)(Ws + (wn * 32 + 16 + l16) * CLD + ks * 32 + g4 * 8);
        acc[0] = mfma16(w0, af, acc[0]); acc[1] = mfma16(w1, af, acc[1]);
      } };
    gl(0, ra, rw); if (nk > 1) gl(1, ra2, rw2);
    for (int kt = 0; kt < nk; kt += 2) { stepk(kt, ra, rw); if (kt + 1 < nk) stepk(kt + 1, ra2, rw2); }
    const int m = (int)row0 + wm * 16 + l16, n = nt * 64 + wn * 32 + 4 * g4;
    epi(m, n, acc[0]); epi(m, n + 16, acc[1]);
  }
  __syncthreads();
}
struct EpiSwiglu { static constexpr bool PAIR = true; bf16_t* u;
  DI void pair(int m, int f, f32x4 gt, f32x4 up) const { f32x4 r; r[0] = siluf(gt[0]) * up[0]; r[1] = siluf(gt[1]) * up[1]; r[2] = siluf(gt[2]) * up[2]; r[3] = siluf(gt[3]) * up[3]; st4bf(u + (size_t)m * FF + f, r); } };
struct EpiRetQK { static constexpr bool PAIR = false; bf16_t* qk; const float2* tabR;
  DI void operator()(int m, int n, f32x4 v) const { const int b = m / PB, pp = m - b * PB;
    if (pp >= LC) { const int pos = pp - LC, row = pos >> 6, col = pos & 63; const int j0 = (n & 255) >> 1;
      const int vv = j0 < 64 ? row : col; const float2 c0 = tabR[vv * 64 + (j0 & 63)], c1 = tabR[vv * 64 + ((j0 + 1) & 63)];
      const float a0 = v[0] * c0.x - v[1] * c0.y, b0 = v[0] * c0.y + v[1] * c0.x, a1 = v[2] * c1.x - v[3] * c1.y, b1 = v[2] * c1.y + v[3] * c1.x; v = (f32x4){a0, b0, a1, b1}; }
    if (n >= 1024) v = v * 0.0625f;
    st4bf(qk + (size_t)m * 2048 + n, v); } };
struct EpiHg { static constexpr bool PAIR = false; bf16_t* ph;
  DI void operator()(int m, int n, f32x4 v) const { if (n < 1024) { v[0] = siluf(v[0]); v[1] = siluf(v[1]); v[2] = siluf(v[2]); v[3] = siluf(v[3]); v = v * 0.08838834764831845f; } st4bf(ph + (size_t)m * 5120 + n, v); } };
struct EpiMlaQ { static constexpr bool PAIR = false; bf16_t* q; const float* rs; const float2* tabM;
  DI void operator()(int m, int n, f32x4 v) const { v = v * (rs[2 * m] * 0.10206207261596577f * LOG2E); const int h = n / 96, w = n - h * 96; const int b = m / PB, pp = m - b * PB;
    if (w >= 64 && pp >= LC) { const int pos = pp - LC, row = pos >> 6, col = pos & 63; const int j0 = (w - 64) >> 1; const int vv = j0 < 8 ? row : col; const float2 c0 = tabM[vv * 8 + (j0 & 7)], c1 = tabM[vv * 8 + ((j0 + 1) & 7)];
      const float a0 = v[0] * c0.x - v[1] * c0.y, b0 = v[0] * c0.y + v[1] * c0.x, a1 = v[2] * c1.x - v[3] * c1.y, b1 = v[2] * c1.y + v[3] * c1.x; v = (f32x4){a0, b0, a1, b1}; }
    st4bf(q + (size_t)m * 1536 + n, v); } };
struct EpiMlaK { static constexpr bool PAIR = false; bf16_t* k; const float* rs;
  DI void operator()(int m, int n, f32x4 v) const { v = v * rs[2 * m + 1]; st4bf(k + (size_t)m * 1536 + (n >> 6) * 96 + (n & 63), v); } };

DI void mla_stats_phase(const Params& p) {
  const bf16_t* cqb = (const bf16_t*)(p.ws + M_D0); const bf16_t* ckvb = (const bf16_t*)(p.ws + M_CKV); const bf16_t* krb = (const bf16_t*)(p.ws + M_KR); bf16_t* km = (bf16_t*)(p.ws + M_K); float* rs = (float*)(p.ws + OFF_RS); const float2* tabM = (const float2*)(p.ws + OFF_TABM);
  const int tid = threadIdx.x, lane = tid & 63, gw = blockIdx.x * 8 + (tid >> 6), nw = gridDim.x * 8;
  for (int t = gw; t < T_ALL; t += nw) {
    const bf16_t* r = krb + (size_t)t * 32;
    const u32x4 a = *(const u32x4*)(cqb + (size_t)t * 512 + lane * 8); const u32x2 c = *(const u32x2*)(ckvb + (size_t)t * 256 + lane * 4);
    float sq = bflo(a.x) * bflo(a.x) + bfhi(a.x) * bfhi(a.x) + bflo(a.y) * bflo(a.y) + bfhi(a.y) * bfhi(a.y) + bflo(a.z) * bflo(a.z) + bfhi(a.z) * bfhi(a.z) + bflo(a.w) * bflo(a.w) + bfhi(a.w) * bfhi(a.w);
    float sk = bflo(c.x) * bflo(c.x) + bfhi(c.x) * bfhi(c.x) + bflo(c.y) * bflo(c.y) + bfhi(c.y) * bfhi(c.y);
#pragma unroll
    for (int o = 1; o < 64; o <<= 1) { sq += __shfl_xor(sq, o); sk += __shfl_xor(sk, o); }
    if (lane == 0) { rs[2 * t] = rsqrtf(sq * (1.f / 512.f) + 1e-6f); rs[2 * t + 1] = rsqrtf(sk * (1.f / 256.f) + 1e-6f); }
    if (lane < 16) { const int j = lane; float x1 = bf2f(r[j]), x2 = bf2f(r[16 + j]); const int b = t / PB, pp = t - b * PB;
      if (pp >= LC) { const int pos = pp - LC, row = pos >> 6, col = pos & 63; const float2 cs = tabM[(j < 8 ? row : col) * 8 + (j & 7)]; const float o1 = x1 * cs.x - x2 * cs.y, o2 = x1 * cs.y + x2 * cs.x; x1 = o1; x2 = o2; }
      const unsigned pr = pk2(x1, x2);
#pragma unroll
      for (int h = 0; h < 16; ++h) *(unsigned*)(km + (size_t)t * 1536 + h * 96 + 64 + 2 * j) = pr; }
  }
}

constexpr int KLD = 104, VLD = 72;
DI void mla_attn_phase(const Params& p, char* lds) {
  const bf16_t* Qm = (const bf16_t*)(p.ws + M_Q); const bf16_t* Km = (const bf16_t*)(p.ws + M_K); const bf16_t* vT = (const bf16_t*)(p.ws + M_VT); bf16_t* o = (bf16_t*)(p.ws + OFF_A);
  const int tid = threadIdx.x, lane = tid & 63, w = tid >> 6, c = lane & 31, hh = lane >> 5;
  constexpr int KB = 64 * KLD, VB = 64 * VLD;
  bf16_t* Ks = (bf16_t*)lds; bf16_t* Vs = Ks + 3 * KB;
  for (int item = blockIdx.x; item < 2048 + 64; item += gridDim.x) {
    int b, h, qbase, nkt;
    if (item < 2048) { const int pr = (item >> 8) * 8 + (item & 7), qb = (item & 255) >> 3;
      b = pr >> 4; h = pr & 15; qbase = LC + qb * 256; nkt = 132; } else { const int it = item - 2048; b = it >> 4; h = it & 15; qbase = 0; nkt = 4; }
    const size_t tokbase = (size_t)b * PB;
    const bf16_t* qp = Qm + (tokbase + qbase + w * 32 + c) * 1536 + h * 96 + hh * 8;
    bf16x8 qf[6];
#pragma unroll
    for (int ks = 0; ks < 6; ++ks) qf[ks] = *(const bf16x8*)(qp + ks * 16);
    const bf16_t* kg = Km + tokbase * 1536 + h * 96; const bf16_t* vg = vT + (size_t)(b * 16 + h) * 64 * PB;
    const int kr0 = tid / 12, kc0 = tid - kr0 * 12, e1 = tid + NTHR, kr1 = e1 / 12, kc1 = e1 - kr1 * 12; const bool k1ok = e1 < 768; const int vd = tid >> 3, vc = tid & 7;
    u32x4 rk0, rk1 = (u32x4){0, 0, 0, 0}, rv;
    auto gload = [&](int t) { const size_t key0 = (size_t)t * 64;
      rk0 = *(const u32x4*)(kg + (key0 + kr0) * 1536 + kc0 * 8); if (k1ok) rk1 = *(const u32x4*)(kg + (key0 + kr1) * 1536 + kc1 * 8); rv = *(const u32x4*)(vg + (size_t)vd * PB + key0 + vc * 8); };
    auto lstore = [&](int buf) { bf16_t* Kn = Ks + buf * KB; bf16_t* Vn = Vs + buf * VB;
      *(u32x4*)(Kn + kr0 * KLD + kc0 * 8) = rk0; if (k1ok) *(u32x4*)(Kn + kr1 * KLD + kc1 * 8) = rk1; *(u32x4*)(Vn + vd * VLD + vc * 8) = rv; };
    f32x16 oacc[2];
#pragma unroll
    for (int i = 0; i < 16; ++i) { oacc[0][i] = 0.f; oacc[1][i] = 0.f; }
    float mrow = -1e30f, lsum = 0.f;
    auto qk = [&](int buf, f32x16 (&s)[2]) { const bf16_t* Kc = Ks + buf * KB;
#pragma unroll
      for (int j = 0; j < 2; ++j) {
#pragma unroll
        for (int i = 0; i < 16; ++i) s[j][i] = 0.f;
#pragma unroll
        for (int ks = 0; ks < 6; ++ks) { const bf16x8 kf = *(const bf16x8*)(Kc + (32 * j + c) * KLD + ks * 16 + hh * 8); s[j] = mfma32(kf, qf[ks], s[j]); }
      } };
    auto smpv = [&](int buf, f32x16 (&s)[2]) { const bf16_t* Vc = Vs + buf * VB;
      float mx = s[0][0];
#pragma unroll
      for (int j = 0; j < 2; ++j)
#pragma unroll
        for (int i = 0; i < 16; ++i) mx = fmaxf(mx, s[j][i]);
      if (__builtin_amdgcn_ballot_w64(mx > mrow + 8.f) != 0ull) {
        mx = fmaxf(mx, __shfl_xor(mx, 32));
        const float mnew = fmaxf(mrow, mx), alpha = __builtin_amdgcn_exp2f(mrow - mnew); mrow = mnew;
        lsum *= alpha;
#pragma unroll
        for (int i = 0; i < 16; ++i) { oacc[0][i] *= alpha; oacc[1][i] *= alpha; }
      }
      float ps0 = 0.f, ps1 = 0.f;
#pragma unroll
      for (int j = 0; j < 2; ++j)
#pragma unroll
        for (int i = 0; i < 16; i += 2) { s[j][i] = __builtin_amdgcn_exp2f(s[j][i] - mrow); ps0 += s[j][i]; s[j][i + 1] = __builtin_amdgcn_exp2f(s[j][i + 1] - mrow); ps1 += s[j][i + 1]; }
      lsum += ps0 + ps1;
#pragma unroll
      for (int j = 0; j < 2; ++j)
#pragma unroll
        for (int sx = 0; sx < 2; ++sx) {
          const bf16x8 pf = pack8(s[j][8 * sx], s[j][8 * sx + 1], s[j][8 * sx + 2], s[j][8 * sx + 3], s[j][8 * sx + 4], s[j][8 * sx + 5], s[j][8 * sx + 6], s[j][8 * sx + 7]);
#pragma unroll
          for (int dt = 0; dt < 2; ++dt) { const bf16_t* vp = Vc + (32 * dt + c) * VLD + 32 * j + 16 * sx + 4 * hh;
            const bf16x8 vf = cat44(*(const s16x4*)vp, *(const s16x4*)(vp + 8)); oacc[dt] = mfma32(vf, pf, oacc[dt]); }
        } };
    __syncthreads();
    gload(0); lstore(0); gload(1); lstore(1); if (nkt > 2) gload(2);
    __syncthreads();
    f32x16 sA[2], sB[2];
    qk(0, sA);
    int b0 = 0, b1 = 1, b2 = 2;
    for (int kt = 0; kt < nkt; kt += 2) {
      __syncthreads();
      if (kt + 2 < nkt) { lstore(b2); if (kt + 3 < nkt) gload(kt + 3); }
      qk(b1, sB);
      smpv(b0, sA);
      __syncthreads();
      if (kt + 3 < nkt) { lstore(b0); if (kt + 4 < nkt) gload(kt + 4); }
      if (kt + 2 < nkt) qk(b2, sA);
      smpv(b1, sB);
      { const int t0 = b0; b0 = b2; b2 = b1; b1 = t0; }
    }
    lsum += __shfl_xor(lsum, 32); const float inv = 1.f / lsum;
    bf16_t* op = o + (tokbase + qbase + w * 32 + c) * 1024 + h * 64 + 4 * hh;
#pragma unroll
    for (int dt = 0; dt < 2; ++dt)
#pragma unroll
      for (int rg = 0; rg < 4; ++rg) st4bf(op + 32 * dt + 8 * rg, (f32x4){oacc[dt][4 * rg] * inv, oacc[dt][4 * rg + 1] * inv, oacc[dt][4 * rg + 2] * inv, oacc[dt][4 * rg + 3] * inv});
  }
}

template <int N> DI void pin_frags(bf16x8 (&f)[N]) {
  if constexpr (N == 8) asm volatile("" : "+v"(f[0]), "+v"(f[1]), "+v"(f[2]), "+v"(f[3]), "+v"(f[4]), "+v"(f[5]), "+v"(f[6]), "+v"(f[7]));
  else if constexpr (N == 4) asm volatile("" : "+v"(f[0]), "+v"(f[1]), "+v"(f[2]), "+v"(f[3]));
  else if constexpr (N == 2) asm volatile("" : "+v"(f[0]), "+v"(f[1]));
}
constexpr int NKC = 72, NVC = 264;
constexpr int NWK = 72, NWV = 584;
constexpr int NA_OFF_VC = 256 * NKC * 2, NA_OFF_RPB = NA_OFF_VC + 64 * NVC * 2, NA_OFF_W = NA_OFF_RPB + 1920, NA_LDS = NA_OFF_W + 576 * NWK * 2;
static_assert(64 * NWV * 2 <= 576 * NWK * 2 && NA_OFF_W % 16 == 0, "NA window");
DI void na_ctx_wave(const bf16_t* __restrict__ Q, bf16_t* __restrict__ o, const bf16_t* Kc, const bf16_t* Vc, int b, int h, int qb, int lane) {
  const int g = lane >> 4, l16 = lane & 15; const size_t tokbase = (size_t)b * PB; const int qpos = qb * 16 + l16;
  const bf16_t* qp = Q + (tokbase + qpos) * 1024 + h * 64 + g * 8;
  const bf16x8 q0 = *(const bf16x8*)qp, q1 = *(const bf16x8*)(qp + 32);
  f32x4 S[16];
#pragma unroll
  for (int kt = 0; kt < 16; ++kt) { const bf16_t* kp = Kc + (16 * kt + l16) * NKC + g * 8;
    f32x4 s = mfma16(*(const bf16x8*)kp, q0, (f32x4){0.f, 0.f, 0.f, 0.f}); s = mfma16(*(const bf16x8*)(kp + 32), q1, s); S[kt] = s * LOG2E; }
  float mx = S[0][0];
#pragma unroll
  for (int kt = 0; kt < 16; ++kt) mx = fmaxf(fmaxf(fmaxf(mx, S[kt][0]), fmaxf(S[kt][1], S[kt][2])), S[kt][3]);
  mx = fmaxf(mx, __shfl_xor(mx, 16)); mx = fmaxf(mx, __shfl_xor(mx, 32));
  float ls = 0.f;
#pragma unroll
  for (int kt = 0; kt < 16; ++kt)
#pragma unroll
    for (int rr = 0; rr < 4; ++rr) { S[kt][rr] = __builtin_amdgcn_exp2f(S[kt][rr] - mx); ls += S[kt][rr]; }
  ls += __shfl_xor(ls, 16); ls += __shfl_xor(ls, 32);
  f32x4 O[4];
#pragma unroll
  for (int dt = 0; dt < 4; ++dt) O[dt] = (f32x4){0.f, 0.f, 0.f, 0.f};
#pragma unroll
  for (int kk = 0; kk < 8; ++kk) {
    const bf16x8 pf = pack8(S[2 * kk][0], S[2 * kk][1], S[2 * kk][2], S[2 * kk][3], S[2 * kk + 1][0], S[2 * kk + 1][1], S[2 * kk + 1][2], S[2 * kk + 1][3]);
#pragma unroll
    for (int dt = 0; dt < 4; ++dt) { const bf16_t* vp = Vc + (dt * 16 + l16) * NVC + 32 * kk + 4 * g; const bf16x8 vf = cat44(*(const s16x4*)vp, *(const s16x4*)(vp + 16)); O[dt] = mfma16(vf, pf, O[dt]); }
  }
  const float inv = 1.f / ls; bf16_t* op = o + (tokbase + qpos) * 1024 + h * 64 + 4 * g;
#pragma unroll
  for (int dt = 0; dt < 4; ++dt) st4bf(op + 16 * dt, O[dt] * inv);
}
DI void na_attn_phase(const Params& p, char* lds) {
  const bf16_t* Q = (const bf16_t*)(p.ws + N_Q); const bf16_t* K = (const bf16_t*)(p.ws + N_K); const bf16_t* vT = (const bf16_t*)(p.ws + N_VT); bf16_t* o = (bf16_t*)(p.ws + OFF_A);
  bf16_t* Kc = (bf16_t*)lds; bf16_t* Vc = (bf16_t*)(lds + NA_OFF_VC); float* rl = (float*)(lds + NA_OFF_RPB); bf16_t* W = (bf16_t*)(lds + NA_OFF_W);
  const int tid = threadIdx.x, lane = tid & 63, w = tid >> 6, g = lane >> 4, l16 = lane & 15;
  for (int item = blockIdx.x; item < 256; item += gridDim.x) {
    const int qtr = item & 3, h = (item >> 2) & 15, b = item >> 6; const size_t tokbase = (size_t)b * PB;
    const bf16_t* kbase = K + (tokbase + LC) * 1024 + h * 64; const bf16_t* vbase = vT + (size_t)(b * 16 + h) * 64 * PB + LC;
    __syncthreads();
#pragma unroll
    for (int i = 0; i < 4; ++i) { const int e = tid + NTHR * i; const int key = e >> 3, kc = e & 7; *(u32x4*)(Kc + key * NKC + kc * 8) = *(const u32x4*)(K + (tokbase + key) * 1024 + h * 64 + kc * 8); }
#pragma unroll
    for (int i = 0; i < 4; ++i) { const int e = tid + NTHR * i; const int d = e >> 5, pc = e & 31; *(u32x4*)(Vc + d * NVC + pc * 8) = *(const u32x4*)(vT + ((size_t)(b * 16 + h) * 64 + d) * PB + pc * 8); }
    for (int e = tid; e < 465; e += NTHR) rl[e] = p.na_rpb[h * 465 + e];
    u32x4 rw[9];
#pragma unroll 1
    for (int j = 0; j < 16; ++j) {
      int ln = lane, tt = tid; asm volatile("" : "+v"(ln), "+v"(tt)); const int gg = ln >> 4, ll = ln & 15;
      const int r0 = qtr * 32 + 2 * j, rs0 = clampi(r0 - 4, 0, 120), r = r0 + (w >> 2), n = w & 3, rs = clampi(r - 4, 0, 120), dr = rs - rs0, band0 = clampi(16 * n - 8, 0, 32);
      const int qpos = LC + r * 64 + n * 16 + ll;
#pragma unroll
      for (int i = 0; i < 9; ++i) { const int e = tt + NTHR * i; rw[i] = *(const u32x4*)(kbase + (size_t)(rs0 * 64 + (e >> 3)) * 1024 + (e & 7) * 8); }
      __syncthreads();
#pragma unroll
      for (int i = 0; i < 9; ++i) { const int e = tt + NTHR * i; *(u32x4*)(W + (e >> 3) * NWK + (e & 7) * 8) = rw[i]; }
      __syncthreads();
      const bf16_t* qp = Q + (tokbase + qpos) * 1024 + h * 64 + gg * 8;
      const bf16x8 q0 = *(const bf16x8*)qp, q1 = *(const bf16x8*)(qp + 32);
      f32x4 S[32];
#pragma unroll
      for (int kg = 0; kg < 8; ++kg) {
        bf16x8 ka[4], kb[4];
#pragma unroll
        for (int u = 0; u < 4; ++u) { const int kt = 4 * kg + u;
          const bf16_t* kp = kt < 16 ? W + ((dr + (kt >> 1)) * 64 + band0 + 16 * (kt & 1) + ll) * NWK + gg * 8 : Kc + (16 * (kt - 16) + ll) * NKC + gg * 8;
          ka[u] = *(const bf16x8*)kp; kb[u] = *(const bf16x8*)(kp + 32); }
        pin_frags(ka); pin_frags(kb);
#pragma unroll
        for (int u = 0; u < 4; ++u) { const int kt = 4 * kg + u;
          f32x4 s = mfma16(ka[u], q0, (f32x4){0.f, 0.f, 0.f, 0.f}); s = mfma16(kb[u], q1, s);
          if (kt < 16) {
            const int qcol = 16 * n + ll, wstart = clampi(qcol - 8, 0, 48); const float* bp = rl + (rs + (kt >> 1) - r + 7) * 31;
#pragma unroll
            for (int rr = 0; rr < 4; ++rr) { const int kcol = band0 + 16 * (kt & 1) + 4 * gg + rr; const bool ok = kcol >= wstart && kcol < wstart + 16;
              s[rr] = ok ? (s[rr] + bp[clampi(kcol - qcol + 15, 0, 30)]) * LOG2E : -1e30f; }
          } else s = s * LOG2E;
          S[kt] = s; }
      }
      float mx = S[0][0];
#pragma unroll
      for (int kt = 0; kt < 32; ++kt) mx = fmaxf(fmaxf(fmaxf(mx, S[kt][0]), fmaxf(S[kt][1], S[kt][2])), S[kt][3]);
      mx = fmaxf(mx, __shfl_xor(mx, 16)); mx = fmaxf(mx, __shfl_xor(mx, 32));
      float ls = 0.f;
#pragma unroll
      for (int kt = 0; kt < 32; ++kt)
#pragma unroll
        for (int rr = 0; rr < 4; ++rr) { S[kt][rr] = __builtin_amdgcn_exp2f(S[kt][rr] - mx); ls += S[kt][rr]; }
      ls += __shfl_xor(ls, 16); ls += __shfl_xor(ls, 32);
      bf16x8 pf[16];
#pragma unroll
      for (int kk = 0; kk < 16; ++kk) pf[kk] = pack8(S[2 * kk][0], S[2 * kk][1], S[2 * kk][2], S[2 * kk][3], S[2 * kk + 1][0], S[2 * kk + 1][1], S[2 * kk + 1][2], S[2 * kk + 1][3]);
#pragma unroll
      for (int i = 0; i < 9; ++i) { const int e = tt + NTHR * i, d = e / 72, pc = e - d * 72; rw[i] = *(const u32x4*)(vbase + (size_t)d * PB + rs0 * 64 + pc * 8); }
      __syncthreads();
#pragma unroll
      for (int i = 0; i < 9; ++i) { const int e = tt + NTHR * i, d = e / 72, pc = e - d * 72; *(u32x4*)(W + d * NWV + pc * 8) = rw[i]; }
      __syncthreads();
      f32x4 O[4];
#pragma unroll
      for (int dt = 0; dt < 4; ++dt) O[dt] = (f32x4){0.f, 0.f, 0.f, 0.f};
#pragma unroll
      for (int kk = 0; kk < 16; ++kk) {
        bf16x8 vf[4];
#pragma unroll
        for (int dt = 0; dt < 4; ++dt) { const bf16_t* vp = kk < 8 ? W + (dt * 16 + ll) * NWV + (dr + kk) * 64 + band0 + 4 * gg : Vc + (dt * 16 + ll) * NVC + 32 * (kk - 8) + 4 * gg;
          vf[dt] = cat44(*(const s16x4*)vp, *(const s16x4*)(vp + 16)); }
        pin_frags(vf);
#pragma unroll
        for (int dt = 0; dt < 4; ++dt) O[dt] = mfma16(vf[dt], pf[kk], O[dt]);
      }
      const float inv = 1.f / ls; bf16_t* op = o + (tokbase + qpos) * 1024 + h * 64 + 4 * gg;
#pragma unroll
      for (int dt = 0; dt < 4; ++dt) st4bf(op + 16 * dt, O[dt] * inv);
    }
    if (w < 4) na_ctx_wave(Q, o, Kc, Vc, b, h, qtr * 4 + w, lane);
  }
}

template <int DK> struct ScanLds { static constexpr int QLD = DK + 8, TLD = 72;
  static constexpr int OFF_QD = 0, OFF_KD = OFF_QD + 64 * QLD * 2, OFF_VT = OFF_KD + 64 * QLD * 2, OFF_ATT = OFF_VT + 64 * TLD * 2, OFF_ST = OFF_ATT + 64 * TLD * 2, OFF_EB = OFF_ST + 64 * QLD * 2, OFF_QS = OFF_EB + DK * 4, TOTAL = OFF_QS + 8 * DK * 4; };
DI int scan_pos(int dir, int i, int tl) { if (dir == 0) return i * 64 + tl; return i < 4 ? 255 - (i * 64 + tl) : 8447 - ((i - 4) * 64 + tl); }
DI bf16x8 gather8(const bf16_t* p, int stride) {
  const unsigned a0 = p[0], a1 = p[stride], a2 = p[2 * stride], a3 = p[3 * stride], a4 = p[4 * stride], a5 = p[5 * stride], a6 = p[6 * stride], a7 = p[7 * stride];
  u32x4 r; r.x = a0 | (a1 << 16); r.y = a2 | (a3 << 16); r.z = a4 | (a5 << 16); r.w = a6 | (a7 << 16); return __builtin_bit_cast(bf16x8, r);
}

template <int DK, bool HG, int DVS>
DI void scan_phase(const Params& p, char* lds) {
  typedef ScanLds<DK> L;
  bf16_t* Qd = (bf16_t*)(lds + L::OFF_QD); bf16_t* Kd = (bf16_t*)(lds + L::OFF_KD); bf16_t* Vt = (bf16_t*)(lds + L::OFF_VT);
  bf16_t* Att = (bf16_t*)(lds + L::OFF_ATT); bf16_t* St = (bf16_t*)(lds + L::OFF_ST); float* eb = (float*)(lds + L::OFF_EB); float* qs = (float*)(lds + L::OFF_QS);
  constexpr int QLD = L::QLD, TLD = L::TLD, KT = DK / 16 / 8;
  const int tid = tid_(), lane = tid & 63, w = tid >> 6, g4 = lane >> 4, l16 = lane & 15;
  const int nitems = 256; constexpr int NVI = DVS / 16, NTO = NVI * 4 / 8;
  const float* lbv = (const float*)(p.ws + OFF_LBV);
  for (int item = blockIdx.x; item < nitems; item += gridDim.x) {
    const int xcd = item & 7, yy = item >> 3; int b, h, sl, dir;
    if (HG) { const int grp = xcd * 8 + (yy >> 2); sl = yy & 3; h = grp & 7; b = (grp >> 3) & 3; dir = grp >> 5; }
    else { const int grp = xcd * 4 + (yy >> 3); sl = yy & 7; h = grp & 3; b = (grp >> 2) & 3; dir = grp >> 4; }
    const size_t tokbase = (size_t)b * PB;
    const bf16_t *qsrc, *ksrc, *vsrc; int ldq, ldv; bf16_t *octx, *olat; int ldo;
    if (HG) { const bf16_t* ph = (const bf16_t*)(p.ws + H_P); qsrc = ph + h * 128; ksrc = ph + 1024 + dir * 1024 + h * 128; vsrc = ph + 3072 + h * 128 + sl * DVS; ldq = 5120; ldv = 5120; ldo = 1024;
      octx = (bf16_t*)(p.ws + (dir ? OFF_W0 : OFF_A)) + tokbase * 1024 + h * 128 + sl * DVS; olat = octx + (size_t)LC * 1024; }
    else { const bf16_t* qk = (const bf16_t*)(p.ws + R_QK); qsrc = qk + h * 256; ksrc = qk + 1024 + h * 256; vsrc = (const bf16_t*)(p.ws + R_V) + h * 512 + sl * 64; ldq = 2048; ldv = 2048; ldo = 2048;
      if (dir == 0) { octx = (bf16_t*)(p.ws + R_O) + tokbase * 2048 + h * 512 + sl * 64; olat = octx + (size_t)LC * 2048; }
      else { octx = (bf16_t*)(p.ws + OFF_HCTX) + (size_t)b * LC * 2048 + h * 512 + sl * 64; olat = (bf16_t*)p.out + (size_t)b * LL * 2048 + h * 512 + sl * 64; } }
    float lg = 0.f; if (!HG) lg = -__expf(p.ret_decay[dir * 4 + h]);
    float lb0 = 0.f, lb1 = 0.f; if (HG) { lb0 = lbv[h * 128 + 2 * (tid & 63)]; lb1 = lbv[h * 128 + 2 * (tid & 63) + 1]; }
    f32x4 sacc[KT][NVI];
#pragma unroll
    for (int a = 0; a < KT; ++a)
#pragma unroll
      for (int v = 0; v < NVI; ++v) sacc[a][v] = (f32x4){0.f, 0.f, 0.f, 0.f};
    u32x4 rq[4], rk[4], rvv; unsigned rf[8], rqq[8]; float bl[16], qv[16], kv[16];
    const int vtl = tid & 63, vvc = tid >> 6;
    auto issue = [&](int i) {
      if (HG) { const int kp = tid & 63, seg = tid >> 6;
#pragma unroll
        for (int j = 0; j < 8; ++j) { const size_t row = tokbase + scan_pos(dir, i, seg * 8 + j); rf[j] = *(const unsigned*)(ksrc + row * ldq + 2 * kp); rqq[j] = *(const unsigned*)(qsrc + row * ldq + 2 * kp); } }
      else {
#pragma unroll
        for (int it = 0; it < 4; ++it) { const int e = tid + NTHR * it, tl = e >> 5, kc = e & 31; const size_t row = tokbase + scan_pos(dir, i, tl); rq[it] = *(const u32x4*)(qsrc + row * ldq + kc * 8); rk[it] = *(const u32x4*)(ksrc + row * ldq + kc * 8); } }
      if (vvc < DVS / 8) { const size_t row = tokbase + scan_pos(dir, i, vtl); rvv = *(const u32x4*)(vsrc + row * ldv + vvc * 8); }
    };
    auto prep = [&]() {
      const int kp = tid & 63, seg = tid >> 6; float run0 = 1.f, run1 = 1.f;
#pragma unroll
      for (int j = 0; j < 8; ++j) { const float f0 = bflo(rf[j]), f1 = bfhi(rf[j]); qv[2 * j] = bflo(rqq[j]); qv[2 * j + 1] = bfhi(rqq[j]);
        const float s0 = __builtin_amdgcn_rcpf(1.f + __expf(-f0)), s1 = __builtin_amdgcn_rcpf(1.f + __expf(-f1)); const float g0 = lb0 + (1.f - lb0) * s0, g1 = lb1 + (1.f - lb1) * s1;
        kv[2 * j] = 1.f - g0; kv[2 * j + 1] = 1.f - g1; run0 *= g0; run1 *= g1; bl[2 * j] = run0; bl[2 * j + 1] = run1; }
      qs[seg * DK + 2 * kp] = run0; qs[seg * DK + 2 * kp + 1] = run1;
    };
    __syncthreads();
    issue(0); if (HG) prep();
    __syncthreads();
    for (int i = 0; i < 132; ++i) {
      if (HG) { const int kp = tid & 63, seg = tid >> 6; float off0 = 1.f, off1 = 1.f;
#pragma unroll
        for (int q = 0; q < 7; ++q) if (q < seg) { off0 *= qs[q * DK + 2 * kp]; off1 *= qs[q * DK + 2 * kp + 1]; }
        if (seg == 7) { eb[2 * kp] = off0 * bl[14]; eb[2 * kp + 1] = off1 * bl[15]; }
#pragma unroll
        for (int j = 0; j < 8; ++j) { const int tl = seg * 8 + j; const float p0 = bl[2 * j] * off0, p1 = bl[2 * j + 1] * off1;
          *(unsigned*)(Qd + tl * QLD + 2 * kp) = pk2(qv[2 * j] * p0, qv[2 * j + 1] * p1);
          *(unsigned*)(Kd + tl * QLD + 2 * kp) = pk2(kv[2 * j] * __builtin_amdgcn_rcpf(p0), kv[2 * j + 1] * __builtin_amdgcn_rcpf(p1)); } }
      else {
        if (tid < DK) eb[tid] = __expf(64.f * lg);
#pragma unroll
        for (int it = 0; it < 4; ++it) { const int e = tid + NTHR * it, tl = e >> 5, kc = e & 31; const u32x4 qr = rq[it], kr = rk[it];
          const float eq = __expf((float)(tl + 1) * lg), ek = __expf(-(float)(tl + 1) * lg);
          u32x4 qo, ko; qo.x = pk2(bflo(qr.x) * eq, bfhi(qr.x) * eq); qo.y = pk2(bflo(qr.y) * eq, bfhi(qr.y) * eq); qo.z = pk2(bflo(qr.z) * eq, bfhi(qr.z) * eq); qo.w = pk2(bflo(qr.w) * eq, bfhi(qr.w) * eq);
          ko.x = pk2(bflo(kr.x) * ek, bfhi(kr.x) * ek); ko.y = pk2(bflo(kr.y) * ek, bfhi(kr.y) * ek); ko.z = pk2(bflo(kr.z) * ek, bfhi(kr.z) * ek); ko.w = pk2(bflo(kr.w) * ek, bfhi(kr.w) * ek);
          *(u32x4*)(Qd + tl * QLD + kc * 8) = qo; *(u32x4*)(Kd + tl * QLD + kc * 8) = ko; } }
      if (vvc < DVS / 8) { bf16_t* vt = Vt + (vvc * 8) * TLD + vtl; const u32x4 vr = rvv;
        vt[0] = (bf16_t)(vr.x & 0xffff); vt[TLD] = (bf16_t)(vr.x >> 16); vt[2 * TLD] = (bf16_t)(vr.y & 0xffff); vt[3 * TLD] = (bf16_t)(vr.y >> 16);
        vt[4 * TLD] = (bf16_t)(vr.z & 0xffff); vt[5 * TLD] = (bf16_t)(vr.z >> 16); vt[6 * TLD] = (bf16_t)(vr.w & 0xffff); vt[7 * TLD] = (bf16_t)(vr.w >> 16); }
#pragma unroll
      for (int a = 0; a < KT; ++a) { const int ki = w * KT + a;
#pragma unroll
        for (int vi = 0; vi < NVI; ++vi) st4bf(St + (16 * vi + l16) * QLD + 16 * ki + 4 * g4, sacc[a][vi]); }
      __syncthreads();
      if (i + 1 < 132) issue(i + 1);
      { const int ti = w >> 1;
        bf16x8 qf[DK / 32];
#pragma unroll
        for (int ks = 0; ks < DK / 32; ++ks) qf[ks] = *(const bf16x8*)(Qd + (16 * ti + l16) * QLD + ks * 32 + g4 * 8);
#pragma unroll
        for (int u = 0; u < 2; ++u) { const int si = (2 * w + u) & 3; f32x4 d = (f32x4){0.f, 0.f, 0.f, 0.f};
          if (si <= ti) { bf16x8 kf[DK / 32];
#pragma unroll
            for (int ks = 0; ks < DK / 32; ++ks) kf[ks] = *(const bf16x8*)(Kd + (16 * si + l16) * QLD + ks * 32 + g4 * 8);
            pin_frags(kf);
#pragma unroll
            for (int ks = 0; ks < DK / 32; ++ks) d = mfma16(kf[ks], qf[ks], d); }
          const int t = 16 * ti + l16, s0 = 16 * si + 4 * g4;
#pragma unroll
          for (int rr = 0; rr < 4; ++rr) if (s0 + rr > t) d[rr] = 0.f;
          st4bf(Att + t * TLD + s0, d); } }
      __syncthreads();
      { const int vi = (NTO * w) >> 2;
        bf16x8 xv[2], xs[DK / 32];
#pragma unroll
        for (int ks = 0; ks < 2; ++ks) xv[ks] = *(const bf16x8*)(Vt + (16 * vi + l16) * TLD + ks * 32 + g4 * 8);
#pragma unroll
        for (int ks = 0; ks < DK / 32; ++ks) xs[ks] = *(const bf16x8*)(St + (16 * vi + l16) * QLD + ks * 32 + g4 * 8);
        pin_frags(xv); pin_frags(xs);
#pragma unroll
        for (int u = 0; u < NTO; ++u) { const int ti = (NTO * w + u) & 3; bf16x8 ya[2], yq[DK / 32];
#pragma unroll
          for (int ks = 0; ks < 2; ++ks) ya[ks] = *(const bf16x8*)(Att + (16 * ti + l16) * TLD + ks * 32 + g4 * 8);
#pragma unroll
          for (int ks = 0; ks < DK / 32; ++ks) yq[ks] = *(const bf16x8*)(Qd + (16 * ti + l16) * QLD + ks * 32 + g4 * 8);
          pin_frags(ya); pin_frags(yq);
          f32x4 d = (f32x4){0.f, 0.f, 0.f, 0.f};
#pragma unroll
          for (int ks = 0; ks < 2; ++ks) d = mfma16(xv[ks], ya[ks], d);
#pragma unroll
          for (int ks = 0; ks < DK / 32; ++ks) d = mfma16(xs[ks], yq[ks], d);
          const int pos = scan_pos(dir, i, 16 * ti + l16); bf16_t* op = (pos < LC ? octx + (size_t)pos * ldo : olat + (size_t)(pos - LC) * ldo) + 16 * vi + 4 * g4;
          st4bf(op, d); } }
      { bf16x8 yv[NVI][2];
#pragma unroll
        for (int vi = 0; vi < NVI; ++vi)
#pragma unroll
          for (int ks = 0; ks < 2; ++ks) yv[vi][ks] = *(const bf16x8*)(Vt + (16 * vi + l16) * TLD + ks * 32 + g4 * 8);
#pragma unroll
        for (int a = 0; a < KT; ++a) { const int ki = w * KT + a; bf16x8 xf[2];
#pragma unroll
          for (int ks = 0; ks < 2; ++ks) xf[ks] = gather8(Kd + (ks * 32 + g4 * 8) * QLD + 16 * ki + l16, QLD);
#pragma unroll
          for (int ks = 0; ks < 2; ++ks)
#pragma unroll
            for (int vi = 0; vi < NVI; ++vi) sacc[a][vi] = mfma16(xf[ks], yv[vi][ks], sacc[a][vi]);
          const f32x4 e4 = *(const f32x4*)(eb + 16 * ki + 4 * g4);
#pragma unroll
          for (int vi = 0; vi < NVI; ++vi) sacc[a][vi] = sacc[a][vi] * e4; } }
      if (HG && i + 1 < 132) prep();
      __syncthreads();
    }
  }
}

DI float bsum2(unsigned a, unsigned b, float& lo, float& hi) { lo = bflo(a) + bflo(b); hi = bfhi(a) + bfhi(b); return lo * lo + hi * hi; }
DI void ret_readout_phase(const Params& p) {
  bf16_t* O = (bf16_t*)(p.ws + R_O); const bf16_t* G = (const bf16_t*)(p.ws + R_QK);
  const int tid = threadIdx.x, lane = tid & 63, gw = blockIdx.x * 8 + (tid >> 6), nw = gridDim.x * 8;
  for (int t = gw; t < T_ALL; t += nw) {
    const int b = t / PB, pp = t - b * PB;
    const bf16_t* ob = (pp < LC ? (const bf16_t*)(p.ws + OFF_HCTX) + (size_t)(b * LC + pp) * 2048 : (const bf16_t*)p.out + (size_t)(b * LL + pp - LC) * 2048) + lane * 32;
    bf16_t* op = O + (size_t)t * 2048 + lane * 32; const bf16_t* gp = G + (size_t)t * 2048 + lane * 32;
    float ov[32]; u32x4 gv[4]; float sq = 0.f;
#pragma unroll
    for (int i = 0; i < 4; ++i) { const u32x4 x = *(const u32x4*)(op + i * 8), y = *(const u32x4*)(ob + i * 8); gv[i] = *(const u32x4*)(gp + i * 8);
      sq += bsum2(x.x, y.x, ov[8 * i], ov[8 * i + 1]) + bsum2(x.y, y.y, ov[8 * i + 2], ov[8 * i + 3]) + bsum2(x.z, y.z, ov[8 * i + 4], ov[8 * i + 5]) + bsum2(x.w, y.w, ov[8 * i + 6], ov[8 * i + 7]); }
    sq += __shfl_xor(sq, 1); sq += __shfl_xor(sq, 2); sq += __shfl_xor(sq, 4); sq += __shfl_xor(sq, 8);
    const float rstd = rsqrtf(sq * (1.f / 512.f) + 1e-6f);
#pragma unroll
    for (int i = 0; i < 4; ++i) { u32x4 r;
      r.x = pk2(siluf(bflo(gv[i].x)) * ov[8 * i] * rstd, siluf(bfhi(gv[i].x)) * ov[8 * i + 1] * rstd); r.y = pk2(siluf(bflo(gv[i].y)) * ov[8 * i + 2] * rstd, siluf(bfhi(gv[i].y)) * ov[8 * i + 3] * rstd);
      r.z = pk2(siluf(bflo(gv[i].z)) * ov[8 * i + 4] * rstd, siluf(bfhi(gv[i].z)) * ov[8 * i + 5] * rstd); r.w = pk2(siluf(bflo(gv[i].w)) * ov[8 * i + 6] * rstd, siluf(bfhi(gv[i].w)) * ov[8 * i + 7] * rstd);
      *(u32x4*)(op + i * 8) = r; }
  }
}
DI void hg_readout_phase(const Params& p) {
  bf16_t* O = (bf16_t*)(p.ws + OFF_A); const bf16_t* OB = (const bf16_t*)(p.ws + OFF_W0); const bf16_t* ph = (const bf16_t*)(p.ws + H_P);
  const int tid = threadIdx.x, lane = tid & 63, gw = blockIdx.x * 8 + (tid >> 6), nw = gridDim.x * 8;
  for (int t = gw; t < T_ALL; t += nw) {
    bf16_t* op = O + (size_t)t * 1024 + lane * 16; const bf16_t* ob = OB + (size_t)t * 1024 + lane * 16; const bf16_t* gp = ph + (size_t)t * 5120 + 4096 + lane * 16; const float* ng = p.hg_norm_g + (lane & 7) * 16;
    float ov[16]; u32x4 gv[2]; float sq = 0.f;
#pragma unroll
    for (int i = 0; i < 2; ++i) { const u32x4 x = *(const u32x4*)(op + i * 8), y = *(const u32x4*)(ob + i * 8); gv[i] = *(const u32x4*)(gp + i * 8);
      sq += bsum2(x.x, y.x, ov[8 * i], ov[8 * i + 1]) + bsum2(x.y, y.y, ov[8 * i + 2], ov[8 * i + 3]) + bsum2(x.z, y.z, ov[8 * i + 4], ov[8 * i + 5]) + bsum2(x.w, y.w, ov[8 * i + 6], ov[8 * i + 7]); }
    sq += __shfl_xor(sq, 1); sq += __shfl_xor(sq, 2); sq += __shfl_xor(sq, 4);
    const float rstd = rsqrtf(sq * (1.f / 128.f) + 1e-6f);
#pragma unroll
    for (int i = 0; i < 2; ++i) { u32x4 r; const float* n8 = ng + i * 8;
      r.x = pk2(siluf(bflo(gv[i].x)) * ov[8 * i] * rstd * n8[0], siluf(bfhi(gv[i].x)) * ov[8 * i + 1] * rstd * n8[1]); r.y = pk2(siluf(bflo(gv[i].y)) * ov[8 * i + 2] * rstd * n8[2], siluf(bfhi(gv[i].y)) * ov[8 * i + 3] * rstd * n8[3]);
      r.z = pk2(siluf(bflo(gv[i].z)) * ov[8 * i + 4] * rstd * n8[4], siluf(bfhi(gv[i].z)) * ov[8 * i + 5] * rstd * n8[5]); r.w = pk2(siluf(bflo(gv[i].w)) * ov[8 * i + 6] * rstd * n8[6], siluf(bfhi(gv[i].w)) * ov[8 * i + 7] * rstd * n8[7]);
      *(u32x4*)(op + i * 8) = r; }
  }
}

#define XB_TMO      128
#define XB_XCNT(j)  (256  + 64 * (j))
#define XB_XSUB(j)  (1280 + 64 * (j))
#define XB_XGEN(j)  (2304 + 64 * (j))
#define XB_TOP      3328
#define XB_TOPGEN   3392
#define XCD_BAR_WORDS 3456
#define XB_SPIN_CAP (1u << 23)
#define LAS PG8_LAS

__device__ __forceinline__ unsigned xb_ld(unsigned* p)              { return __hip_atomic_load(p, __ATOMIC_RELAXED, __HIP_MEMORY_SCOPE_AGENT); }
__device__ __forceinline__ unsigned xb_add(unsigned* p, unsigned v) { return __hip_atomic_fetch_add(p, v, __ATOMIC_RELAXED, __HIP_MEMORY_SCOPE_AGENT); }
__device__ __forceinline__ unsigned xb_xcc_id() { return (unsigned)__builtin_amdgcn_s_getreg((3 << 11) | 20) & 0xFu; }
#define XB_SPIN(cond, bar) do { unsigned _sp = 0; while (cond) { __builtin_amdgcn_s_sleep(1); \
    if ((++_sp & 255u) == 0u) { if (xb_ld(&(bar)[XB_TMO])) break; if (_sp > XB_SPIN_CAP) { atomicAdd(&(bar)[XB_TMO], 1u); break; } } } } while (0)

struct XcdBarrier {
    unsigned* bar; unsigned x;
    volatile LAS unsigned* st;
};

__device__ __forceinline__ XcdBarrier xcd_barrier_post(unsigned* bar, volatile LAS unsigned* st) {
    XcdBarrier b; b.bar = bar; b.x = xb_xcc_id(); b.st = st;
    if (threadIdx.x == 0) (void)xb_add(&bar[XB_XCNT(b.x)], 1u);
    return b;
}
__device__ __forceinline__ void xcd_barrier_complete(unsigned* bar, unsigned x, unsigned& nloc, unsigned& nx) {
    const unsigned G = gridDim.x * gridDim.y * gridDim.z;
    unsigned sum, cnt, mine, sp = 0u;
    for (;;) {
        sum = 0u; cnt = 0u; mine = 0u;
#pragma unroll
        for (unsigned j = 0; j < 16; ++j) { const unsigned c = xb_ld(&bar[XB_XCNT(j)]); sum += c; cnt += (c > 0u) ? 1u : 0u; mine = (j == x) ? c : mine; }
        if (sum == G) break;
        __builtin_amdgcn_s_sleep(1);
        if ((++sp & 255u) == 0u) { if (xb_ld(&bar[XB_TMO])) break; if (sp > XB_SPIN_CAP) { atomicAdd(&bar[XB_TMO], 1u); break; } }
    }
    nloc = mine > 0u ? mine : 1u; nx = cnt > 0u ? cnt : 1u;
}

__device__ __forceinline__ void xcd_barrier(const XcdBarrier& b) {
    asm volatile("s_waitcnt vmcnt(0)" ::: "memory");
    __syncthreads();
    if (threadIdx.x == 0) {
        unsigned* bar = b.bar;
        __builtin_amdgcn_s_waitcnt(0);
        unsigned nloc = b.st[0], nx = b.st[1];
        if (nloc == 0u) { xcd_barrier_complete(bar, b.x, nloc, nx); b.st[0] = nloc; b.st[1] = nx; }
        const unsigned old = xb_add(&bar[XB_XSUB(b.x)], 1u);
        const unsigned gen = old / nloc;
        if (old + 1u == (gen + 1u) * nloc) {
            __builtin_amdgcn_fence(__ATOMIC_RELEASE, "agent");
            asm volatile("s_waitcnt vmcnt(0)" ::: "memory");
            const unsigned og = xb_add(&bar[XB_TOP], 1u);
            const unsigned tg = og / nx;
            if (og + 1u == (tg + 1u) * nx) xb_add(&bar[XB_TOPGEN], 1u);
            else XB_SPIN(xb_ld(&bar[XB_TOPGEN]) == tg, bar);
            __builtin_amdgcn_fence(__ATOMIC_ACQUIRE, "agent");
            xb_add(&bar[XB_XGEN(b.x)], 1u);
            asm volatile("s_waitcnt vmcnt(0)" ::: "memory");
        } else {
            XB_SPIN(xb_ld(&bar[XB_XGEN(b.x)]) == gen, bar);
            __builtin_amdgcn_fence(__ATOMIC_ACQUIRE, "agent");
            asm volatile("s_waitcnt vmcnt(0)" ::: "memory");
        }
    }
    __syncthreads();
}

constexpr int LDS_BYTES0 = ScanLds<256>::TOTAL > pg8::STAGE_BYTES ? ScanLds<256>::TOTAL : pg8::STAGE_BYTES;
constexpr int LDS_BYTES = LDS_BYTES0 > NA_LDS ? LDS_BYTES0 : NA_LDS;
static_assert(LDS_BYTES <= 163840, "LDS");
static_assert(LDS_BYTES >= (256 + 128) * LDT * 2 && LDS_BYTES >= 3 * 64 * (KLD + VLD) * 2 && LDS_BYTES >= (5120 + 8 * 5 * 64) * 4, "LDS phases");

DI void ffn_and_ln(const Params& p, const XcdBarrier& xb, char* lds, int layer, const bf16_t* w13, const bf16_t* w2) {
  const float* mods = (const float*)(p.ws + OFF_MODS); float* hctx = (float*)(p.ws + OFF_HCTX); bf16_t* a = (bf16_t*)(p.ws + OFF_A); bf16_t* U = (bf16_t*)(p.ws + F_U);
  { EpiSwiglu e{U}; big_gemm(a, w13, T_ALL, 5632, 1024, e, lds, layer == 3); }
  xcd_barrier(xb);
  { EpiResid e{p.out, hctx, p.out, hctx, mods + (size_t)layer * 5 * 6144 + 5 * 1024, (const float2*)(p.ws + OFF_LNS), p.ln_g + (size_t)(layer * 2) * 1024, p.ln_b + (size_t)(layer * 2) * 1024}; big_gemm(U, w2, T_ALL, 1024, FF, e, lds, 1); if (layer < 3) ctx_gemm(U, w2, FF, e, lds); }
  xcd_barrier(xb);
  ln_phase(p, layer, 1, layer < 3 ? layer + 1 : 3, 0, layer == 3);
  xcd_barrier(xb);
}

__global__ void __launch_bounds__(NTHR) mega(Params p) {
  __shared__ __attribute__((aligned(16))) char lds[LDS_BYTES];
  cg::grid_group grid = cg::this_grid();
  __shared__ uint4 xb_words;
  if (threadIdx.x == 0) xb_words = make_uint4(0u, 0u, 0u, 0u);
  __syncthreads();
  const XcdBarrier xb = xcd_barrier_post((unsigned*)(p.ws + OFF_BAR), (volatile LAS unsigned*)&xb_words);
  float* ldsf = (float*)lds;
  const float* mods = (const float*)(p.ws + OFF_MODS); float* hctx = (float*)(p.ws + OFF_HCTX); bf16_t* a = (bf16_t*)(p.ws + OFF_A);
  const float2* tabR = (const float2*)(p.ws + OFF_TABR); const float2* tabM = (const float2*)(p.ws + OFF_TABM); float* rs = (float*)(p.ws + OFF_RS);
  ada_phase(p, ldsf);
  tables_phase(p);
  convert_w<2>(p.ret_w_in, 6144, 1024, (bf16_t*)(p.ws + W0_RETIN), 6144, nullptr, ldsf);
  convert_w<0>(p.ret_w_out, 1024, 2048, (bf16_t*)(p.ws + W0_RETOUT), 1024, nullptr, ldsf);
  convert_w<1>(p.w13, 5632, 1024, (bf16_t*)(p.ws + W0_W13), 5632, nullptr, ldsf);
  convert_w<0>(p.w2, 1024, FF, (bf16_t*)(p.ws + W0_W2), 1024, nullptr, ldsf);
  grid.sync();
  modulate_phase(p, p.x, p.ctx, 0);
  xcd_barrier(xb);
  { const bf16_t* wi = (const bf16_t*)(p.ws + W0_RETIN);
    { EpiRetQK e{(bf16_t*)(p.ws + R_QK), tabR}; big_gemm(a, wi, T_ALL, 2048, 1024, e, lds, 1); ctx_gemm(a, wi, 1024, e, lds, 2048); }
    { EpiStore e{(bf16_t*)(p.ws + R_V), (bf16_t*)(p.ws + R_V), 1 << 30, 2048, 2048, 1.f}; big_gemm(a, wi + (size_t)2048 * 1024, T_ALL, 2048, 1024, e, lds, 1); ctx_gemm(a, wi + (size_t)2048 * 1024, 1024, e, lds, 2048); }
    xcd_barrier(xb);
    scan_phase<256, false, 64>(p, lds);
    xcd_barrier(xb);
    { EpiStore e{(bf16_t*)(p.ws + R_QK), (bf16_t*)(p.ws + R_QK), 1 << 30, 2048, 2048, 1.f}; big_gemm(a, wi + (size_t)4096 * 1024, T_ALL, 2048, 1024, e, lds, 1); ctx_gemm(a, wi + (size_t)4096 * 1024, 1024, e, lds, 2048); }
    xcd_barrier(xb);
    ret_readout_phase(p);
    xcd_barrier(xb);
    { EpiResid e{p.x, p.ctx, p.out, hctx, mods + 2 * 1024, nullptr, nullptr, nullptr}; big_gemm((const bf16_t*)(p.ws + R_O), (const bf16_t*)(p.ws + W0_RETOUT), T_ALL, 1024, 2048, e, lds, 1); ctx_gemm((const bf16_t*)(p.ws + R_O), (const bf16_t*)(p.ws + W0_RETOUT), 2048, e, lds); }
    xcd_barrier(xb);
    ln_phase(p, 0, 0, 0, 3, false);
    convert_w<0>(p.na_w_qkv, 3072, 1024, (bf16_t*)(p.ws + W1_QKV), 3072, nullptr, ldsf);
    convert_w<0>(p.na_w_out, 1024, 1024, (bf16_t*)(p.ws + W1_OUT), 1024, nullptr, ldsf);
    convert_w<1>(p.w13 + (size_t)1 * 1024 * 5632, 5632, 1024, (bf16_t*)(p.ws + W1_W13), 5632, nullptr, ldsf);
    convert_w<0>(p.w2 + (size_t)1 * FF * 1024, 1024, FF, (bf16_t*)(p.ws + W1_W2), 1024, nullptr, ldsf);
    convert_w<5>(p.mla_w_down, 800, 1024, (bf16_t*)(p.ws + W2_DOWN), 1024, nullptr, ldsf);
    convert_w<3>(p.mla_w_uq, 1536, 512, (bf16_t*)(p.ws + W2_UQ), 1536, p.mla_q_norm, ldsf);
    convert_w<4>(p.mla_w_ukv, 2048, 256, (bf16_t*)(p.ws + W2_UKV), 2048, p.mla_kv_norm, ldsf);
    convert_w<0>(p.mla_w_out, 1024, 1024, (bf16_t*)(p.ws + W2_OUT), 1024, nullptr, ldsf);
    convert_w<1>(p.w13 + (size_t)2 * 1024 * 5632, 5632, 1024, (bf16_t*)(p.ws + W2_W13), 5632, nullptr, ldsf);
    convert_w<0>(p.w2 + (size_t)2 * FF * 1024, 1024, FF, (bf16_t*)(p.ws + W2_W2), 1024, nullptr, ldsf);
    convert_w<0>(p.hg_w_in, 5120, 1024, (bf16_t*)(p.ws + W3_IN), 5120, nullptr, ldsf);
    convert_w<0>(p.hg_w_out, 1024, 1024, (bf16_t*)(p.ws + W3_OUT), 1024, nullptr, ldsf);
    convert_w<1>(p.w13 + (size_t)3 * 1024 * 5632, 5632, 1024, (bf16_t*)(p.ws + W3_W13), 5632, nullptr, ldsf);
    convert_w<0>(p.w2 + (size_t)3 * FF * 1024, 1024, FF, (bf16_t*)(p.ws + W3_W2), 1024, nullptr, ldsf);
    xcd_barrier(xb);
    ffn_and_ln(p, xb, lds, 0, (const bf16_t*)(p.ws + W0_W13), (const bf16_t*)(p.ws + W0_W2));
  }
  { const bf16_t* wq = (const bf16_t*)(p.ws + W1_QKV);
    { EpiStore e{(bf16_t*)(p.ws + N_Q), (bf16_t*)(p.ws + N_K), 1024, 1024, 1024, 0.125f}; big_gemm(a, wq, T_ALL, 2048, 1024, e, lds, 1); ctx_gemm(a, wq, 1024, e, lds, 2048); }
    { EpiVTn e{(bf16_t*)(p.ws + N_VT), nullptr}; big_gemm(a, wq + (size_t)2048 * 1024, T_ALL, 1024, 1024, e, lds, 1); ctx_gemm(a, wq + (size_t)2048 * 1024, 1024, e, lds); }
    xcd_barrier(xb);
    na_attn_phase(p, lds);
    xcd_barrier(xb);
    { EpiResid e{p.out, hctx, p.out, hctx, mods + (size_t)1 * 5 * 6144 + 2 * 1024, (const float2*)(p.ws + OFF_LNS), p.ln_g + (size_t)(0 * 2 + 1) * 1024, p.ln_b + (size_t)(0 * 2 + 1) * 1024}; big_gemm(a, (const bf16_t*)(p.ws + W1_OUT), T_ALL, 1024, 1024, e, lds, 1); ctx_gemm(a, (const bf16_t*)(p.ws + W1_OUT), 1024, e, lds); }
    xcd_barrier(xb);
    ln_phase(p, 1, 0, 1, 3, false);
    xcd_barrier(xb);
    ffn_and_ln(p, xb, lds, 1, (const bf16_t*)(p.ws + W1_W13), (const bf16_t*)(p.ws + W1_W2));
  }
  { const bf16_t* d0 = (const bf16_t*)(p.ws + M_D0);
    { EpiD0 e{(bf16_t*)(p.ws + M_D0), (bf16_t*)(p.ws + M_CKV), (bf16_t*)(p.ws + M_KR)}; big_gemm(a, (const bf16_t*)(p.ws + W2_DOWN), T_ALL, 1024, 1024, e, lds, 1); ctx_gemm(a, (const bf16_t*)(p.ws + W2_DOWN), 1024, e, lds); }
    xcd_barrier(xb);
    mla_stats_phase(p);
    xcd_barrier(xb);
    { EpiMlaQ e{(bf16_t*)(p.ws + M_Q), rs, tabM}; big_gemm(d0, (const bf16_t*)(p.ws + W2_UQ), T_ALL, 1536, 512, e, lds, 1); ctx_gemm(d0, (const bf16_t*)(p.ws + W2_UQ), 512, e, lds, 1536); }
    { GemmArgs g{(const bf16_t*)(p.ws + M_CKV), 256, (const bf16_t*)(p.ws + W2_UKV), 256, T_ALL, 1024, 256}; EpiMlaK e{(bf16_t*)(p.ws + M_K), rs}; gemm_phase<false>(g, e, lds); }
    { EpiVTn e{(bf16_t*)(p.ws + M_VT), rs}; big_gemm((const bf16_t*)(p.ws + M_CKV), (const bf16_t*)(p.ws + W2_UKV) + (size_t)1024 * 256, T_ALL, 1024, 256, e, lds, 1); ctx_gemm((const bf16_t*)(p.ws + M_CKV), (const bf16_t*)(p.ws + W2_UKV) + (size_t)1024 * 256, 256, e, lds); }
    xcd_barrier(xb);
    mla_attn_phase(p, lds);
    xcd_barrier(xb);
    { EpiResid e{p.out, hctx, p.out, hctx, mods + (size_t)2 * 5 * 6144 + 2 * 1024, (const float2*)(p.ws + OFF_LNS), p.ln_g + (size_t)(1 * 2 + 1) * 1024, p.ln_b + (size_t)(1 * 2 + 1) * 1024}; big_gemm(a, (const bf16_t*)(p.ws + W2_OUT), T_ALL, 1024, 1024, e, lds, 1); ctx_gemm(a, (const bf16_t*)(p.ws + W2_OUT), 1024, e, lds); }
    xcd_barrier(xb);
    ln_phase(p, 2, 0, 2, 3, false);
    xcd_barrier(xb);
    ffn_and_ln(p, xb, lds, 2, (const bf16_t*)(p.ws + W2_W13), (const bf16_t*)(p.ws + W2_W2));
  }
  { { EpiHg e{(bf16_t*)(p.ws + H_P)}; big_gemm(a, (const bf16_t*)(p.ws + W3_IN), T_ALL, 5120, 1024, e, lds); }
    xcd_barrier(xb);
    scan_phase<128, true, 32>(p, lds);
    xcd_barrier(xb);
    hg_readout_phase(p);
    xcd_barrier(xb);
    { EpiResid e{p.out, hctx, p.out, hctx, mods + (size_t)3 * 5 * 6144 + 2 * 1024, (const float2*)(p.ws + OFF_LNS), p.ln_g + (size_t)(2 * 2 + 1) * 1024, p.ln_b + (size_t)(2 * 2 + 1) * 1024}; big_gemm(a, (const bf16_t*)(p.ws + W3_OUT), T_ALL, 1024, 1024, e, lds, 1); }
    xcd_barrier(xb);
    ln_phase(p, 3, 0, 3, 3, false);
    xcd_barrier(xb);
    ffn_and_ln(p, xb, lds, 3, (const bf16_t*)(p.ws + W3_W13), (const bf16_t*)(p.ws + W3_W2));
  }
}

extern "C" void kernel_launch(void* const* d_in, const int* in_sizes, int n_in, void* d_out, int out_size, void* d_ws, size_t ws_size, hipStream_t stream) {
  static int grid_blocks = 0;
  if (!grid_blocks) {
    int dev = 0, cus = 0, per_cu = 0;
    (void)hipGetDevice(&dev);
    (void)hipDeviceGetAttribute(&cus, hipDeviceAttributeMultiprocessorCount, dev);
    (void)hipOccupancyMaxActiveBlocksPerMultiprocessor(&per_cu, mega, NTHR, 0);
    if (per_cu != 1) per_cu = 1;
    grid_blocks = cus * per_cu;
  }
  if (ws_size < WS_NEED) { fprintf(stderr, "workspace too small: %zu\n", ws_size); return; }
  Params p{};
  const float** f = (const float**)&p;
  for (int i = 0; i < 26; ++i) f[i] = (const float*)d_in[i];
  p.out = (float*)d_out; p.ws = (char*)d_ws;
  (void)hipMemsetAsync((char*)d_ws + OFF_BAR, 0, XCD_BAR_WORDS * 4, stream);
  void* args[] = {&p};
  hipError_t e = hipLaunchCooperativeKernel((void*)mega, dim3(grid_blocks), dim3(NTHR), args, 0, stream);
  if (e != hipSuccess) fprintf(stderr, "cooperative launch failed: %s (grid %d)\n", hipGetErrorString(e), grid_blocks);
}
```
